# Optimizing an MI355X kernel written in HIP

```python
import jax, jax.numpy as jnp
from jax import lax
import numpy as np

D_MODEL = 1024
BATCH = 2
SEQ = 8192
DEPTH = 2

W_SC = 1024
SC_KERNEL = 3
W_CF = 1024
CF_KERNEL = 31
W_POOL = 1024
POOL_WINDOWS = (2, 4, 8, 16)
N_POOL_GROUPS = len(POOL_WINDOWS)
POOL_GROUP = W_POOL // N_POOL_GROUPS
N_BRANCH = 3
D_FF = 3584
N_EXPERTS = 8
TOP_K = 2
N_DENSE = (DEPTH + 1) // 2
N_MOE = DEPTH // 2
RMS_EPS = 1e-6
LN_EPS = 1e-5
IN_SPLITS = [W_SC, 2 * W_SC, 3 * W_SC, 3 * W_SC + W_CF, 3 * W_SC + 2 * W_CF,
             3 * W_SC + 2 * W_CF + W_POOL]
IN_COLS = 3 * W_SC + 2 * W_CF + W_POOL + N_BRANCH * D_MODEL

kernel_name = "hybrid_conv_pool_moe_trunk"


def rms_norm(x, g):
    xf = x.astype(jnp.float32)
    y = xf * lax.rsqrt(jnp.mean(xf * xf, axis=-1, keepdims=True) + RMS_EPS)
    return (y * g.astype(jnp.float32)).astype(x.dtype)


def layer_norm(x, g, b):
    xf = x.astype(jnp.float32)
    mu = jnp.mean(xf, axis=-1, keepdims=True)
    xc = xf - mu
    var = jnp.mean(xc * xc, axis=-1, keepdims=True)
    y = xc * lax.rsqrt(var + LN_EPS) * g.astype(jnp.float32) + b.astype(jnp.float32)
    return y.astype(x.dtype)


def causal_depthwise_conv(u, w):
    k, c = w.shape
    return lax.conv_general_dilated(
        u, w[:, None, :].astype(u.dtype), window_strides=(1,), padding=[(k - 1, 0)],
        dimension_numbers=('NWC', 'WIO', 'NWC'), feature_group_count=c)


def multiscale_causal_pool(u):
    uf = u.astype(jnp.float32)
    s = uf.shape[1]
    max_w = max(POOL_WINDOWS)
    cs = jnp.cumsum(uf, axis=1)
    cs_pad = jnp.pad(cs, ((0, 0), (max_w, 0), (0, 0)))
    pos = jnp.arange(s, dtype=jnp.float32)[None, :, None]
    outs = []
    for gi, w in enumerate(POOL_WINDOWS):
        lo, hi = gi * POOL_GROUP, (gi + 1) * POOL_GROUP
        win_sum = cs[:, :, lo:hi] - cs_pad[:, max_w - w:max_w - w + s, lo:hi]
        count = jnp.minimum(pos + 1.0, float(w))
        outs.append(win_sum / count - uf[:, :, lo:hi])
    return jnp.stack(outs, axis=2).astype(u.dtype)


def hybrid_mixer(h, w_in, sc_conv_w, cf_conv_w, cf_conv_b, cf_ln_g, cf_ln_b,
                 pool_w, pool_scale, w_sc_out, w_cf_out, w_pool_out, w_o):
    b, s, _ = h.shape
    proj = jnp.einsum('bsd,dc->bsc', h, w_in)
    sc_b, sc_c, sc_x, cf_v, cf_g, pool_u, gates = jnp.split(proj, IN_SPLITS, axis=-1)

    y_a = sc_b * causal_depthwise_conv(sc_c * sc_x, sc_conv_w)
    y_a = jnp.einsum('bsc,cd->bsd', y_a, w_sc_out)

    v = cf_v * jax.nn.sigmoid(cf_g)
    v = causal_depthwise_conv(v, cf_conv_w) + cf_conv_b.astype(v.dtype)
    v = jax.nn.silu(layer_norm(v, cf_ln_g, cf_ln_b))
    y_b = jnp.einsum('bsc,cd->bsd', v, w_cf_out)

    p = multiscale_causal_pool(pool_u)
    p = jnp.einsum('bsgc,gce->bsge', p, pool_w).reshape(b, s, W_POOL) * pool_scale.astype(p.dtype)
    y_c = jnp.einsum('bsc,cd->bsd', p, w_pool_out)

    g = jax.nn.sigmoid(gates.reshape(b, s, N_BRANCH, D_MODEL))
    merged = g[:, :, 0] * y_a + g[:, :, 1] * y_b + g[:, :, 2] * y_c
    return jnp.einsum('bsd,de->bse', merged, w_o)


def swiglu(h, w1, w3, w2):
    a = jnp.einsum('bsd,df->bsf', h, w1)
    c = jnp.einsum('bsd,df->bsf', h, w3)
    return jnp.einsum('bsf,fd->bsd', jax.nn.silu(a) * c, w2)


def moe_swiglu(h, router_w, w1, w3, w2):
    logits = jnp.einsum('bsd,de->bse', h, router_w).astype(jnp.float32)
    top_v, top_i = lax.top_k(logits, TOP_K)
    probs = jax.nn.softmax(top_v, axis=-1)
    combine = jnp.sum(jax.nn.one_hot(top_i, N_EXPERTS, dtype=jnp.float32) * probs[..., None], axis=-2)
    combine = combine.astype(h.dtype)
    out = jnp.zeros_like(h)
    for e in range(N_EXPERTS):
        out = out + combine[..., e:e + 1] * swiglu(h, w1[e], w3[e], w2[e])
    return out


def setup_inputs(seed: int = 0) -> dict:
    key = jax.random.key(seed)
    ks = jax.random.split(key, 24)

    def nrm(k, shape, scale):
        return jax.random.normal(k, shape, dtype=jnp.float32) * scale

    return {
        "x": nrm(ks[0], (BATCH, SEQ, D_MODEL), 1.0),
        "norm_mix_g": 1.0 + nrm(ks[1], (DEPTH, D_MODEL), 0.02),
        "w_in": nrm(ks[2], (DEPTH, D_MODEL, IN_COLS), D_MODEL ** -0.5),
        "sc_conv_w": nrm(ks[3], (DEPTH, SC_KERNEL, W_SC), SC_KERNEL ** -0.5),
        "cf_conv_w": nrm(ks[4], (DEPTH, CF_KERNEL, W_CF), CF_KERNEL ** -0.5),
        "cf_conv_b": nrm(ks[5], (DEPTH, W_CF), 0.02),
        "cf_ln_g": 1.0 + nrm(ks[6], (DEPTH, W_CF), 0.02),
        "cf_ln_b": nrm(ks[7], (DEPTH, W_CF), 0.02),
        "pool_w": nrm(ks[8], (DEPTH, N_POOL_GROUPS, POOL_GROUP, POOL_GROUP), POOL_GROUP ** -0.5),
        "pool_scale": 1.0 + nrm(ks[9], (DEPTH, W_POOL), 0.02),
        "w_sc_out": nrm(ks[10], (DEPTH, W_SC, D_MODEL), W_SC ** -0.5),
        "w_cf_out": nrm(ks[11], (DEPTH, W_CF, D_MODEL), W_CF ** -0.5),
        "w_pool_out": nrm(ks[12], (DEPTH, W_POOL, D_MODEL), W_POOL ** -0.5),
        "w_o": nrm(ks[13], (DEPTH, D_MODEL, D_MODEL), D_MODEL ** -0.5),
        "norm_ffn_g": 1.0 + nrm(ks[14], (DEPTH, D_MODEL), 0.02),
        "dense_w1": nrm(ks[15], (N_DENSE, D_MODEL, D_FF), D_MODEL ** -0.5),
        "dense_w3": nrm(ks[16], (N_DENSE, D_MODEL, D_FF), D_MODEL ** -0.5),
        "dense_w2": nrm(ks[17], (N_DENSE, D_FF, D_MODEL), D_FF ** -0.5),
        "moe_router": nrm(ks[18], (N_MOE, D_MODEL, N_EXPERTS), D_MODEL ** -0.5),
        "moe_w1": nrm(ks[19], (N_MOE, N_EXPERTS, D_MODEL, D_FF), D_MODEL ** -0.5),
        "moe_w3": nrm(ks[20], (N_MOE, N_EXPERTS, D_MODEL, D_FF), D_MODEL ** -0.5),
        "moe_w2": nrm(ks[21], (N_MOE, N_EXPERTS, D_FF, D_MODEL), D_FF ** -0.5),
        "norm_final_g": 1.0 + nrm(ks[22], (D_MODEL,), 0.02),
    }


def reference(x, norm_mix_g, w_in, sc_conv_w, cf_conv_w, cf_conv_b, cf_ln_g, cf_ln_b,
              pool_w, pool_scale, w_sc_out, w_cf_out, w_pool_out, w_o, norm_ffn_g,
              dense_w1, dense_w3, dense_w2, moe_router, moe_w1, moe_w3, moe_w2,
              norm_final_g):
    for layer in range(DEPTH):
        h = rms_norm(x, norm_mix_g[layer])
        x = x + hybrid_mixer(h, w_in[layer], sc_conv_w[layer], cf_conv_w[layer],
                             cf_conv_b[layer], cf_ln_g[layer], cf_ln_b[layer],
                             pool_w[layer], pool_scale[layer], w_sc_out[layer],
                             w_cf_out[layer], w_pool_out[layer], w_o[layer])
        h = rms_norm(x, norm_ffn_g[layer])
        i = layer // 2
        if layer % 2 == 0:
            x = x + swiglu(h, dense_w1[i], dense_w3[i], dense_w2[i])
        else:
            x = x + moe_swiglu(h, moe_router[i], moe_w1[i], moe_w3[i], moe_w2[i])
    return rms_norm(x, norm_final_g)
```

```cpp
#include <hip/hip_runtime.h>
#include <cstdio>
#include <cstdint>

#ifndef MK_PER_PHASE
#define MK_PER_PHASE 0
#endif

#ifndef MK_REP_MASK
#define MK_REP_MASK 0u
#endif
#define REPS(bit) (1 + (int)(((MK_REP_MASK) >> (bit)) & 1u))
#define REPS2(bit) REPS(bit)

#define LAS __attribute__((address_space(3)))
typedef unsigned short bf16_t;
typedef short bf16x8 __attribute__((ext_vector_type(8)));
typedef float f32x4 __attribute__((ext_vector_type(4)));
typedef float f32x2 __attribute__((ext_vector_type(2)));
typedef unsigned u32x4 __attribute__((ext_vector_type(4)));
typedef unsigned u32x2 __attribute__((ext_vector_type(2)));

constexpr int M = 16384, D = 1024, SEQ = 8192, INC = 9216, DFF = 3584, NE = 8;
constexpr float RMS_EPS = 1e-6f, LN_EPS = 1e-5f;
constexpr int MAXSLOT = 34816;
constexpr float F8_W13_MUL = 128.f, F8_ACT_MUL = 4.f, F8_W2_MUL = 256.f;
constexpr int F8_ONE = 0x7f7f7f7f, F8_W13_SC = 0x78787878  , F8_ACT_SC = 0x7d7d7d7d  , F8_W2_SC = 0x77777777  ;

constexpr size_t MiB = 1u << 20;
constexpr size_t WS_CTL = 0, CTL_BYTES = 64 * 1024;
constexpr size_t CTL_BAR = 16384;
constexpr size_t CTL_CNT = 32768;
constexpr size_t WS_SMALL = 1 * MiB;
constexpr size_t SM_TOPE = 0, SM_TOPP = 64 * 1024, SM_TSLOT = 192 * 1024, SM_SSPERM = 320 * 1024, SM_META = 512 * 1024;
constexpr size_t WS_XB = 66 * MiB;
constexpr size_t WS_W0 = 98 * MiB;
constexpr size_t W0_WIN = 0;
constexpr size_t W0_WOUT = 36 * MiB;
constexpr size_t W0_WO = 48 * MiB;
constexpr size_t W0_POOL = 52 * MiB;
constexpr size_t W0_D13 = 53 * MiB;
constexpr size_t W0_D2 = 67 * MiB;
constexpr size_t WS_ACT = 172 * MiB;
constexpr size_t A_SCB = WS_ACT, A_SCX = WS_ACT + 32 * MiB, A_GLU = WS_ACT + 64 * MiB, A_PU = WS_ACT + 96 * MiB, A_GATES = WS_ACT + 128 * MiB,
                 A_YA = WS_ACT + 224 * MiB, A_VB = WS_ACT + 256 * MiB, A_PP = WS_ACT + 288 * MiB, A_MERGED = A_SCX, A_FFN = WS_ACT;
constexpr size_t WS_WC = 524 * MiB;
constexpr size_t WS_ACTP = 98 * MiB;
constexpr size_t WS_WMOE = 304 * MiB, WMOE_W2 = 56 * MiB;
constexpr size_t WS_Y = 400 * MiB;
constexpr size_t WS_APERM = 472 * MiB;
constexpr size_t WS_SS = 540 * MiB;
constexpr size_t WS_END = 541 * MiB;

__device__ __forceinline__ unsigned pk_bf16(float lo, float hi) { unsigned r; asm volatile("v_cvt_pk_bf16_f32 %0, %1, %2" : "=v"(r) : "v"(lo), "v"(hi)); return r; }
__device__ __forceinline__ unsigned pk_fp8x4(const f32x4 v) {
    const float a = __builtin_fminf(__builtin_fmaxf(v[0], -448.f), 448.f), b = __builtin_fminf(__builtin_fmaxf(v[1], -448.f), 448.f), c = __builtin_fminf(__builtin_fmaxf(v[2], -448.f), 448.f), d = __builtin_fminf(__builtin_fmaxf(v[3], -448.f), 448.f);
    int w = 0; w = __builtin_amdgcn_cvt_pk_fp8_f32(a, b, w, false); w = __builtin_amdgcn_cvt_pk_fp8_f32(c, d, w, true); return (unsigned)w; }
__device__ __forceinline__ float bf_lo(unsigned u) { return __uint_as_float(u << 16); }
__device__ __forceinline__ float bf_hi(unsigned u) { return __uint_as_float(u & 0xffff0000u); }
__device__ __forceinline__ float sigm(float x) { return __builtin_amdgcn_rcpf(1.f + __builtin_amdgcn_exp2f(-1.44269504f * x)); }
__device__ __forceinline__ float wave_sum(float v) {
#pragma unroll
    for (int o = 1; o < 64; o <<= 1) v += __shfl_xor(v, o);
    return v;
}
#define LDS_WAIT() asm volatile("s_waitcnt lgkmcnt(0)" ::: "memory")

namespace pg8 {
constexpr int BM = 256, BK = 64, HALF = 128, HTB = HALF * BK * 2, STAGE_BYTES = 8 * HTB, NXCD = 8;
__host__ __device__ __forceinline__ int lds_byte(int r, int c) { const int st = (r >> 4) * 2 + (c >> 5), rr = r & 15, cc = c & 31, ob = rr * 64 + cc * 2; return st * 1024 + (ob ^ (((ob >> 9) & 1) << 5)); }
__host__ __device__ __forceinline__ void stage_rc(int b, int& R, int& C) { const int st = b / 1024, sb = b % 1024, swz = sb ^ (((sb >> 9) & 1) << 5); R = (st >> 1) * 16 + swz / 64; C = (st & 1) * 32 + (swz % 64) / 2; }
__host__ __device__ __forceinline__ int perm32(int rho) { const int n = rho >> 4, i = rho & 15; return 8 * (i >> 2) + 4 * n + (i & 3); }

struct Unit { int pm, pn, aux; const char* A; const char* B; };
struct Gemm { int Kb, lda, ldb; int sa, sb; };

__device__ __forceinline__ bool tile_of(int L, int nM, int nN, int& pm, int& pn, int WGM = 4) {
    const int nwg = nM * nN; if (L >= nwg) return false;
    int wgid = L; { const int q = nwg / NXCD, r = nwg % NXCD, xcd = wgid % NXCD, off = wgid / NXCD; wgid = (xcd < r ? xcd * (q + 1) : r * (q + 1) + (xcd - r) * q) + off; }
    const int nig = WGM * nN, gid = wgid / nig, fm = gid * WGM, gsz = (nM - fm) < WGM ? (nM - fm) : WGM;
    pm = fm + ((wgid % nig) % gsz); pn = (wgid % nig) / gsz; return true;
}
struct PlainSched {
    int nM, nN, G, c; const char* A0; const char* B0; size_t astep, bstep; int wgm;
    __device__ __forceinline__ bool next(int i, Unit& u) const { int pm, pn; if (!tile_of(i * G + c, nM, nN, pm, pn, wgm)) return false; u.pm = pm; u.pn = pn; u.aux = 0; u.A = A0 + (size_t)pm * astep; u.B = B0 + (size_t)pn * bstep; return true; }
};
struct PoolSched {
    int G, c; const char* A0; const char* B0;
    __device__ __forceinline__ bool next(int i, Unit& u) const { int pm, pn; if (!tile_of(i * G + c, M / 256, 4, pm, pn)) return false; u.pm = pm; u.pn = pn; u.aux = 0;
        u.A = A0 + (size_t)pm * (256 * 1024 * 2) + (size_t)pn * 512; u.B = B0 + (size_t)pn * (256 * 256 * 2); return true; }
};
struct MergeSched {
    int G, c; const char *A0, *B0, *B2; size_t astr, bstr;
    __device__ __forceinline__ bool next(int i, Unit& u) const { const int t = i / 3, b = i - 3 * t; int pm, pn; if (!tile_of(t * G + c, M / 256, 4, pm, pn)) return false; u.pm = pm; u.pn = pn; u.aux = b;
        const char* w = b == 2 ? B2 : B0 + (size_t)b * bstr;
        u.A = A0 + (size_t)b * astr + (size_t)pm * (256 * 1024 * 2); u.B = w + (size_t)pn * (256 * 1024 * 2); return true; }
};
struct FoldSched {
    int G, c; const char *A0, *B0;
    __device__ __forceinline__ bool next(int i, Unit& u) const { const int idx = i * G + c; if (idx >= 32) return false; const int L = idx >> 4, pm = (idx >> 2) & 3, g = idx & 3; u.pm = pm; u.pn = g; u.aux = L;
        u.A = A0 + (size_t)L * (6 * MiB) + (size_t)pm * (256 * 1024 * 2) + (size_t)g * 512; u.B = B0 + (size_t)L * (512 * 1024) + (size_t)g * (256 * 256 * 2); return true; }
};
struct GroupSched {
    int nM, nN, G, c; int o1, o2, o3, o4, o5, o6, o7; const char* A0; const char* B0; size_t astep, bstep, estep; int wgm;
    __device__ __forceinline__ bool next(int i, Unit& u) const { int pm, pn; if (!tile_of(i * G + c, nM, nN, pm, pn, wgm)) return false; u.pm = pm; u.pn = pn; u.aux = 0;
        const int e = (pm >= o1) + (pm >= o2) + (pm >= o3) + (pm >= o4) + (pm >= o5) + (pm >= o6) + (pm >= o7);
        u.A = A0 + (size_t)pm * astep; u.B = B0 + (size_t)e * estep + (size_t)pn * bstep; return true; }
};

typedef f32x4 Acc[2][2][4][2];
__device__ __forceinline__ u32x4 pack8(const f32x4 v0, const f32x4 v1) { u32x4 w; w.x = pk_bf16(v0[0], v0[1]); w.y = pk_bf16(v0[2], v0[3]); w.z = pk_bf16(v1[0], v1[1]); w.w = pk_bf16(v1[2], v1[3]); return w; }
__device__ __forceinline__ f32x4 sig4(const f32x4 v) { f32x4 r; r[0] = sigm(v[0]); r[1] = sigm(v[1]); r[2] = sigm(v[2]); r[3] = sigm(v[3]); return r; }
__device__ __forceinline__ void unpack8(const u32x4 g, f32x4& lo, f32x4& hi) { lo[0] = bf_lo(g.x); lo[1] = bf_hi(g.x); lo[2] = bf_lo(g.y); lo[3] = bf_hi(g.y); hi[0] = bf_lo(g.z); hi[1] = bf_hi(g.z); hi[2] = bf_lo(g.w); hi[3] = bf_hi(g.w); }

__device__ __forceinline__ size_t gate_frag(int pm, int q, int wid, int ai, int m, int bj, int lane) { return ((size_t)((((((pm * 12 + q) * 8 + wid) * 2 + ai) * 4 + m) * 2 + bj) * 64 + lane)) * 16; }
struct EpiProj {
    bf16_t *scb, *scx, *glu, *pu, *gates; const f32x4* ss;
    __device__ __forceinline__ bool operator()(Acc& acc, const Unit& u, int wr, int wc, int fr, int fq) const {
        const int row0 = u.pm * BM + wr * 64 + fr, pn = u.pn;
        float rs[2][4];
#pragma unroll
        for (int ai = 0; ai < 2; ++ai)
#pragma unroll
            for (int m = 0; m < 4; ++m) { const f32x4 p = ss[row0 + ai * HALF + m * 16]; rs[ai][m] = __builtin_amdgcn_rsqf(((p[0] + p[1]) + (p[2] + p[3])) * (1.0f / D) + RMS_EPS); }
        if (pn >= 4 && pn < 20) {
            const bool isglu = pn >= 12; bf16_t* dst = isglu ? glu : scx; const int col0 = (isglu ? pn - 12 : pn - 4) * 128 + wc * 32 + 8 * fq;
#pragma unroll
            for (int ai = 0; ai < 2; ++ai)
#pragma unroll
                for (int m = 0; m < 4; ++m) { const float r = rs[ai][m];
                    f32x4 a0 = acc[ai][0][m][0] * r, a1 = acc[ai][0][m][1] * r, b0 = acc[ai][1][m][0] * r, b1 = acc[ai][1][m][1] * r;
                    if (isglu) { b0 = sig4(b0); b1 = sig4(b1); }
                    *(u32x4*)(dst + (size_t)(row0 + ai * HALF + m * 16) * D + col0) = pack8(a0 * b0, a1 * b1); }
        } else {
            if (pn >= 24) {
#pragma unroll
                for (int ai = 0; ai < 2; ++ai)
#pragma unroll
                    for (int m = 0; m < 4; ++m) { const float r = rs[ai][m];
#pragma unroll
                        for (int bj = 0; bj < 2; ++bj) *(u32x4*)((unsigned char*)gates + gate_frag(u.pm, pn - 24, wr * 4 + wc, ai, m, bj, fr + 16 * fq)) = pack8(acc[ai][bj][m][0] * r, acc[ai][bj][m][1] * r); }
            } else {
            bf16_t* dst = pn < 4 ? scb : pu; const int ldc = D, colb = (pn < 4 ? pn : pn - 20) * 256;
            const int col0 = colb + wc * 32 + 8 * fq;
#pragma unroll
            for (int ai = 0; ai < 2; ++ai)
#pragma unroll
                for (int m = 0; m < 4; ++m) { const float r = rs[ai][m]; bf16_t* rowp = dst + (size_t)(row0 + ai * HALF + m * 16) * ldc + col0;
#pragma unroll
                    for (int bj = 0; bj < 2; ++bj) *(u32x4*)(rowp + bj * HALF) = pack8(acc[ai][bj][m][0] * r, acc[ai][bj][m][1] * r); }
            }
        }
        return false;
    }
};
struct EpiPlain {
    bf16_t* Ob; int ldc; size_t aux_stride;
    __device__ __forceinline__ bool operator()(Acc& acc, const Unit& u, int wr, int wc, int fr, int fq) const {
        bf16_t* O = Ob + (size_t)u.aux * aux_stride;
        const int row0 = u.pm * BM + wr * 64 + fr, col0 = u.pn * BM + wc * 32 + 8 * fq;
#pragma unroll
        for (int ai = 0; ai < 2; ++ai)
#pragma unroll
            for (int m = 0; m < 4; ++m) { bf16_t* rowp = O + (size_t)(row0 + ai * HALF + m * 16) * ldc + col0;
#pragma unroll
                for (int bj = 0; bj < 2; ++bj) *(u32x4*)(rowp + bj * HALF) = pack8(acc[ai][bj][m][0], acc[ai][bj][m][1]); }
        return false;
    }
};
struct EpiMerge {
    const bf16_t* gates; bf16_t* O;
    __device__ __forceinline__ bool operator()(Acc& acc, const Unit& u, int wr, int wc, int fr, int fq) const {
        const int row0 = u.pm * BM + wr * 64 + fr, col0 = u.pn * BM + wc * 32 + 8 * fq, b = u.aux;
#pragma unroll
        for (int ai = 0; ai < 2; ++ai)
#pragma unroll
            for (int m = 0; m < 4; ++m) { const size_t row = (size_t)(row0 + ai * HALF + m * 16);
#pragma unroll
                for (int bj = 0; bj < 2; ++bj) { const unsigned char* gp = (const unsigned char*)gates + gate_frag(u.pm, 4 * b + u.pn, wr * 4 + wc, ai, m, bj, fr + 16 * fq);
                    f32x4 g0, g1; unpack8(*(const u32x4*)gp, g0, g1);
                    if (b < 2) { f32x4 h0, h1; unpack8(*(const u32x4*)(gp + gate_frag(0, 4, 0, 0, 0, 0, 0)), h0, h1);
#pragma unroll
                        for (int j = 0; j < 4; ++j) {
                            const float ea = __builtin_amdgcn_exp2f(-1.44269504f * fminf(fmaxf(g0[j], -30.f), 30.f)), eb = __builtin_amdgcn_exp2f(-1.44269504f * fminf(fmaxf(h0[j], -30.f), 30.f));
                            acc[ai][bj][m][0][j] *= (1.f + eb) * __builtin_amdgcn_rcpf(1.f + ea);
                            const float ec = __builtin_amdgcn_exp2f(-1.44269504f * fminf(fmaxf(g1[j], -30.f), 30.f)), ed = __builtin_amdgcn_exp2f(-1.44269504f * fminf(fmaxf(h1[j], -30.f), 30.f));
                            acc[ai][bj][m][1][j] *= (1.f + ed) * __builtin_amdgcn_rcpf(1.f + ec); }
                    } else {
#pragma unroll
                        for (int j = 0; j < 4; ++j) { g0[j] = sigm(fminf(fmaxf(g0[j], -30.f), 30.f)); g1[j] = sigm(fminf(fmaxf(g1[j], -30.f), 30.f)); }
                        *(u32x4*)(O + row * D + col0 + bj * HALF) = pack8(acc[ai][bj][m][0] * g0, acc[ai][bj][m][1] * g1); } } }
        return b < 2;
    }
};
struct EpiResid {
    const float* base32; bf16_t* xb; float* ssp; LAS float* red;
    __device__ __forceinline__ bool operator()(Acc& acc, const Unit& u, int wr, int wc, int fr, int fq) const {
        const int row0 = u.pm * BM + wr * 64 + fr, col0 = u.pn * BM + wc * 32 + 8 * fq;
#pragma unroll
        for (int ai = 0; ai < 2; ++ai)
#pragma unroll
            for (int m = 0; m < 4; ++m) { const size_t row = (size_t)(row0 + ai * HALF + m * 16); float q = 0.f;
#pragma unroll
                for (int bj = 0; bj < 2; ++bj) { const size_t off = row * D + col0 + bj * HALF;
                    f32x4 b0, b1; if (base32) { b0 = *(const f32x4*)(base32 + off); b1 = *(const f32x4*)(base32 + off + 4); } else unpack8(*(const u32x4*)(xb + off), b0, b1);
                    const u32x4 pk = pack8(b0 + acc[ai][bj][m][0], b1 + acc[ai][bj][m][1]); *(u32x4*)(xb + off) = pk;
                    f32x4 o0, o1; unpack8(pk, o0, o1);
                    q += (o0[0] * o0[0] + o0[1] * o0[1]) + (o0[2] * o0[2] + o0[3] * o0[3]) + (o1[0] * o1[0] + o1[1] * o1[1]) + (o1[2] * o1[2] + o1[3] * o1[3]); }
                q += __shfl_xor(q, 16); q += __shfl_xor(q, 32);
                if (fq == 0) red[(ai * HALF + wr * 64 + m * 16 + fr) * 4 + wc] = q; }
        asm volatile("s_waitcnt lgkmcnt(0)" ::: "memory"); __builtin_amdgcn_s_barrier(); asm volatile("" ::: "memory");
        int tid = threadIdx.x; asm volatile("" : "+v"(tid));
        if (tid < 256) { const f32x4 v = *(const LAS f32x4*)(red + tid * 4); ssp[(size_t)(u.pm * BM + tid) * 4 + u.pn] = (v[0] + v[1]) + (v[2] + v[3]); }
        return false;
    }
};
template <bool PART4, bool OUT8> struct EpiSwiGLU {
    bf16_t* O; int ldc; const float* ss;
    __device__ __forceinline__ bool operator()(Acc& acc, const Unit& u, int wr, int wc, int fr, int fq) const {
        const int row0 = u.pm * BM + wr * 64 + fr, col0 = u.pn * 128 + wc * 32 + 8 * fq;
#pragma unroll
        for (int ai = 0; ai < 2; ++ai)
#pragma unroll
            for (int m = 0; m < 4; ++m) { const size_t row = (size_t)(row0 + ai * HALF + m * 16); float r = 1.f;
                if (PART4) { const f32x4 p = *(const f32x4*)(ss + row * 4); r = __builtin_amdgcn_rsqf(((p[0] + p[1]) + (p[2] + p[3])) * (1.0f / D) + RMS_EPS); }
                const f32x4 a0 = acc[ai][0][m][0] * r, a1 = acc[ai][0][m][1] * r, c0 = acc[ai][1][m][0] * r, c1 = acc[ai][1][m][1] * r;
                const f32x4 h0 = a0 * sig4(a0) * c0, h1 = a1 * sig4(a1) * c1;
                if (OUT8) { *(u32x2*)((unsigned char*)O + row * ldc + col0) = (u32x2){pk_fp8x4(h0 * F8_ACT_MUL), pk_fp8x4(h1 * F8_ACT_MUL)}; }
                else *(u32x4*)(O + row * ldc + col0) = pack8(h0, h1); }
        return false;
    }
};

typedef int i32x4 __attribute__((ext_vector_type(4)));
typedef int i32x8 __attribute__((ext_vector_type(8)));
__device__ __forceinline__ i32x8 join16(const bf16x8 lo, const bf16x8 hi) { return __builtin_shufflevector(__builtin_bit_cast(i32x4, lo), __builtin_bit_cast(i32x4, hi), 0, 1, 2, 3, 4, 5, 6, 7); }
template <class Epi, class Sched, bool F8 = false>
__device__ __forceinline__ void gemm_phase(LAS unsigned char* lds, const Gemm g, const Sched& S, const Epi& E) {
    int tid_ = threadIdx.x; asm volatile("" : "+v"(tid_));
    const int tid = tid_, wid = __builtin_amdgcn_readfirstlane(tid >> 6), lane = tid & 63, wr = wid >> 2, wc = wid & 3, fr = lane & 15, fq = lane >> 4;
    const int nt = g.Kb / 128;
    int vsa = g.sa, vsb = g.sb; asm volatile("" : "+v"(vsa), "+v"(vsb));
    unsigned voffA[2], voffB[2];
#pragma unroll
    for (int i = 0; i < 2; ++i) { int R, C; stage_rc(tid * 16 + i * 8192, R, C); const int Rb = (R & ~31) + perm32(R & 31);
        voffA[i] = (unsigned)(R * g.lda + C * 2); voffB[i] = (unsigned)(Rb * g.ldb + C * 2); }
    const size_t kstep = (size_t)(BK * 2);
    const size_t hstepA = (size_t)HALF * g.lda, hstepB = (size_t)HALF * g.ldb;
    const unsigned ldsw = (unsigned)wid * 1024u;
    const int aoff = lds_byte(wr * 64 + fr, fq * 8), boff = lds_byte(wc * 32 + fr, fq * 8);
#define PG8_SA(b, h) (((b) * 2 + (h)) * HTB)
#define PG8_SB(b, h) ((4 + (b) * 2 + (h)) * HTB)
#define PG8_STAGE(bufoff, gbase, voff) do { _Pragma("unroll") for (int _i = 0; _i < 2; ++_i) \
        __builtin_amdgcn_global_load_lds((const unsigned*)((const char*)(gbase) + (voff)[_i]), (LAS unsigned*)(lds + (bufoff) + ldsw + _i * 8192), 16, 0, 0); } while (0)
#define PG8_LDA(dst, b, h) do { _Pragma("unroll") for (int m = 0; m < 4; ++m) _Pragma("unroll") for (int k = 0; k < 2; ++k) dst[m][k] = *(const LAS bf16x8*)(lds + PG8_SA(b, h) + aoff + m * 2048 + k * 1024); } while (0)
#define PG8_LDB(dst, b, h) do { _Pragma("unroll") for (int n = 0; n < 2; ++n) _Pragma("unroll") for (int k = 0; k < 2; ++k) dst[n][k] = *(const LAS bf16x8*)(lds + PG8_SB(b, h) + boff + n * 2048 + k * 1024); } while (0)
#define PG8_MMA(ai, bj, At, Bt) do { __builtin_amdgcn_s_setprio(1); _Pragma("unroll") for (int m = 0; m < 4; ++m) _Pragma("unroll") for (int n = 0; n < 2; ++n) { \
        if constexpr (F8) { const i32x8 b8_ = join16(Bt[n][0], Bt[n][1]), a8_ = join16(At[m][0], At[m][1]); \
            asm volatile("v_mfma_scale_f32_16x16x128_f8f6f4 %0, %1, %2, %0, %3, %4 op_sel_hi:[0,0,0]" : "+v"(acc[ai][bj][m][n]) : "v"(b8_), "v"(a8_), "v"(vsb), "v"(vsa)); } \
        else { _Pragma("unroll") for (int k = 0; k < 2; ++k) acc[ai][bj][m][n] = __builtin_amdgcn_mfma_f32_16x16x32_bf16(Bt[n][k], At[m][k], acc[ai][bj][m][n], 0, 0, 0); } } __builtin_amdgcn_s_setprio(0); } while (0)
#define PG8_WAIT_V(n) asm volatile("s_waitcnt vmcnt(" #n ")" ::: "memory")
#define PG8_WAIT_L(n) asm volatile("s_waitcnt lgkmcnt(" #n ")" ::: "memory")
#define PG8_BAR __builtin_amdgcn_s_barrier()
#define PG8_SCHED __builtin_amdgcn_sched_barrier(0)
    Unit cur, nxt; int ui = 0;
    if (!S.next(0, cur)) return;
    Acc acc;
#pragma unroll
    for (int a = 0; a < 2; ++a)
#pragma unroll
        for (int b = 0; b < 2; ++b)
#pragma unroll
            for (int m = 0; m < 4; ++m)
#pragma unroll
                for (int n = 0; n < 2; ++n) acc[a][b][m][n] = (f32x4){0.f, 0.f, 0.f, 0.f};
    bf16x8 At[4][2], B0[2][2], B1[2][2];
    const char* cA = cur.A; const char* cB = cur.B;
    PG8_STAGE(PG8_SB(0, 0), cB, voffB); PG8_STAGE(PG8_SB(0, 1), cB + hstepB, voffB); PG8_STAGE(PG8_SA(0, 0), cA, voffA); PG8_STAGE(PG8_SA(0, 1), cA + hstepA, voffA);
    if (wr == 1) PG8_BAR;
    PG8_WAIT_V(2); PG8_BAR;
    PG8_STAGE(PG8_SB(1, 0), cB + kstep, voffB); PG8_STAGE(PG8_SA(1, 0), cA + kstep, voffA); PG8_STAGE(PG8_SB(1, 1), cB + hstepB + kstep, voffB);
    PG8_WAIT_V(6); PG8_BAR;
    for (;;) {
        const bool has_next = S.next(ui + 1, nxt);
        const char* nA = has_next ? nxt.A : cA; const char* nB = has_next ? nxt.B : cB;
#pragma nounroll
        for (int t = 0; t < nt; t += 2) {
            const bool last = (t == nt - 2);
            const char* a1 = cA + (size_t)(t + 1) * kstep;
            const char* a2 = last ? nA : cA + (size_t)(t + 2) * kstep; const char* b2 = last ? nB : cB + (size_t)(t + 2) * kstep;
            const char* a3 = a2 + kstep; const char* b3 = b2 + kstep;
            PG8_LDB(B0, 0, 0); PG8_LDB(B1, 0, 1); PG8_SCHED; PG8_LDA(At, 0, 0); PG8_STAGE(PG8_SA(1, 1), a1 + hstepA, voffA);
            PG8_WAIT_V(8); PG8_WAIT_L(0); PG8_BAR; PG8_MMA(0, 0, At, B0); PG8_MMA(0, 1, At, B1); PG8_BAR; PG8_SCHED;
            PG8_LDA(At, 0, 1); PG8_STAGE(PG8_SB(0, 0), b2, voffB); PG8_STAGE(PG8_SB(0, 1), b2 + hstepB, voffB); PG8_STAGE(PG8_SA(0, 0), a2, voffA);
            PG8_WAIT_V(8); PG8_WAIT_L(0); PG8_BAR; PG8_MMA(1, 0, At, B0); PG8_MMA(1, 1, At, B1); PG8_BAR; PG8_SCHED;
            PG8_LDB(B0, 1, 0); PG8_LDB(B1, 1, 1); PG8_SCHED; PG8_LDA(At, 1, 0); PG8_STAGE(PG8_SA(0, 1), a2 + hstepA, voffA);
            PG8_WAIT_V(8); PG8_WAIT_L(0); PG8_BAR; PG8_MMA(0, 0, At, B0); PG8_MMA(0, 1, At, B1); PG8_BAR; PG8_SCHED;
            PG8_LDA(At, 1, 1); PG8_STAGE(PG8_SB(1, 0), b3, voffB); PG8_STAGE(PG8_SB(1, 1), b3 + hstepB, voffB); PG8_STAGE(PG8_SA(1, 0), a3, voffA);
            PG8_WAIT_V(8); PG8_WAIT_L(0); PG8_BAR; PG8_MMA(1, 0, At, B0); PG8_MMA(1, 1, At, B1); PG8_BAR; PG8_SCHED;
        }
        if constexpr (F8) asm volatile("s_nop 15\n\ts_nop 15" ::: "memory");
        if (wr == 0) PG8_BAR;
        const bool keep = E(acc, cur, wr, wc, fr, fq);
        if (!has_next) break;
        if (!keep) {
#pragma unroll
            for (int a = 0; a < 2; ++a)
#pragma unroll
                for (int b = 0; b < 2; ++b)
#pragma unroll
                    for (int m = 0; m < 4; ++m)
#pragma unroll
                        for (int n = 0; n < 2; ++n) acc[a][b][m][n] = (f32x4){0.f, 0.f, 0.f, 0.f};
        }
        cur = nxt; cA = nA; cB = nB; ++ui;
        if (wr == 1) PG8_BAR;
    }
    PG8_WAIT_V(0);
    PG8_BAR;
#undef PG8_SA
#undef PG8_SB
#undef PG8_STAGE
#undef PG8_LDA
#undef PG8_LDB
#undef PG8_MMA
#undef PG8_WAIT_V
#undef PG8_WAIT_L
#undef PG8_BAR
#undef PG8_SCHED
}
}

constexpr int RING_BYTES = 131072, MISC_OFF = RING_BYTES, RED_OFF = RING_BYTES + 1024, LDS_BYTES = 147456;

#define XB_TMO      128
#define XB_XCNT(j)  (256  + 64 * (j))
#define XB_XSUB(j)  (1280 + 64 * (j))
#define XB_XGEN(j)  (2304 + 64 * (j))
#define XB_TOP      3328
#define XB_TOPGEN   3392
#define XCD_BAR_WORDS 3456
#define XB_SPIN_CAP (1u << 18)
__device__ __forceinline__ unsigned xb_ld(unsigned* p)              { return __hip_atomic_load(p, __ATOMIC_RELAXED, __HIP_MEMORY_SCOPE_AGENT); }
__device__ __forceinline__ unsigned xb_add(unsigned* p, unsigned v) { return __hip_atomic_fetch_add(p, v, __ATOMIC_RELAXED, __HIP_MEMORY_SCOPE_AGENT); }
__device__ __forceinline__ unsigned xb_xcc_id() { return (unsigned)__builtin_amdgcn_s_getreg((3 << 11) | 20) & 0xFu; }
#define XB_SPIN(cond, bar) do { unsigned _sp = 0; while (cond) { __builtin_amdgcn_s_sleep(1); \
    if ((++_sp & 255u) == 0u) { if (xb_ld(&(bar)[XB_TMO])) break; if (_sp > XB_SPIN_CAP) { atomicAdd(&(bar)[XB_TMO], 1u); break; } } } } while (0)
struct XcdBarrier { unsigned* bar; unsigned x; volatile LAS unsigned* st; };
__device__ __forceinline__ XcdBarrier xcd_barrier_post(unsigned* bar, volatile LAS unsigned* st) {
    XcdBarrier b; b.bar = bar; b.x = xb_xcc_id(); b.st = st;
    if (threadIdx.x == 0) (void)xb_add(&bar[XB_XCNT(b.x)], 1u);
    return b;
}
__device__ __forceinline__ void xcd_barrier_complete(unsigned* bar, unsigned x, unsigned& nloc, unsigned& nx) {
    const unsigned G = gridDim.x * gridDim.y * gridDim.z;
    unsigned sum, cnt, mine, sp = 0u;
    for (;;) {
        sum = 0u; cnt = 0u; mine = 0u;
#pragma nounroll
        for (unsigned j = 0; j < 16; ++j) { const unsigned c = xb_ld(&bar[XB_XCNT(j)]); sum += c; cnt += (c > 0u) ? 1u : 0u; mine = (j == x) ? c : mine; }
        if (sum == G) break;
        __builtin_amdgcn_s_sleep(1);
        if ((++sp & 255u) == 0u) { if (xb_ld(&bar[XB_TMO])) break; if (sp > XB_SPIN_CAP) { atomicAdd(&bar[XB_TMO], 1u); break; } }
    }
    nloc = mine > 0u ? mine : 1u; nx = cnt > 0u ? cnt : 1u;
}
__device__ __forceinline__ void xcd_barrier(const XcdBarrier& b) {
    asm volatile("s_waitcnt vmcnt(0)" ::: "memory");
    __syncthreads();
    if (threadIdx.x == 0) {
        unsigned* bar = b.bar;
        __builtin_amdgcn_s_waitcnt(0);
        unsigned nloc = b.st[0], nx = b.st[1];
        if (nloc == 0u) { xcd_barrier_complete(bar, b.x, nloc, nx); b.st[0] = nloc; b.st[1] = nx; }
        const unsigned old = xb_add(&bar[XB_XSUB(b.x)], 1u);
        const unsigned gen = old / nloc;
        if (old + 1u == (gen + 1u) * nloc) {
            __builtin_amdgcn_fence(__ATOMIC_RELEASE, "agent");
            asm volatile("s_waitcnt vmcnt(0)" ::: "memory");
            const unsigned og = xb_add(&bar[XB_TOP], 1u);
            const unsigned tg = og / nx;
            if (og + 1u == (tg + 1u) * nx) xb_add(&bar[XB_TOPGEN], 1u);
            else XB_SPIN(xb_ld(&bar[XB_TOPGEN]) == tg, bar);
            __builtin_amdgcn_fence(__ATOMIC_ACQUIRE, "agent");
            xb_add(&bar[XB_XGEN(b.x)], 1u);
            asm volatile("s_waitcnt vmcnt(0)" ::: "memory");
        } else {
            XB_SPIN(xb_ld(&bar[XB_XGEN(b.x)]) == gen, bar);
            __builtin_amdgcn_fence(__ATOMIC_ACQUIRE, "agent");
            asm volatile("s_waitcnt vmcnt(0)" ::: "memory");
        }
    }
    __syncthreads();
}

struct Args { const float* in[23]; float* out; unsigned char* ws; int ph_lo, ph_hi; };
static_assert(sizeof(Args) == 23 * 8 + 8 + 8 + 8, "Args has no padding");
typedef const __attribute__((address_space(4))) Args* KArgs;
__device__ __forceinline__ KArgs kargs() { KArgs p = (KArgs)__builtin_amdgcn_kernarg_segment_ptr(); asm volatile("" : "+s"(p)); return p; }

__device__ __forceinline__ void transpose_item(const float* src, int ldn, int k0, int n0, bf16_t* dst, int ldk, const float* kscale, const float* nscale, int lane) {
    const int r4 = lane >> 4, q = lane & 15;
    f32x4 v[16];
    const float* sp = src + (size_t)(k0 + 16 * r4) * ldn + n0 + 4 * q;
#pragma unroll
    for (int i = 0; i < 16; ++i) v[i] = __builtin_nontemporal_load((const f32x4*)(sp + (size_t)i * ldn));
    f32x4 ns = (f32x4){1.f, 1.f, 1.f, 1.f}; if (nscale) ns = *(const f32x4*)(nscale + n0 + 4 * q);
    if (kscale) {
        const f32x4* kp = (const f32x4*)(kscale + k0 + 16 * r4);
#pragma unroll
        for (int g = 0; g < 4; ++g) { const f32x4 ks = kp[g];
#pragma unroll
            for (int j = 0; j < 4; ++j) v[4 * g + j] = v[4 * g + j] * ks[j]; }
    }
#pragma unroll
    for (int e = 0; e < 4; ++e) { u32x4 lo, hi;
#pragma unroll
        for (int w = 0; w < 4; ++w) { lo[w] = pk_bf16(v[2 * w][e] * ns[e], v[2 * w + 1][e] * ns[e]); hi[w] = pk_bf16(v[8 + 2 * w][e] * ns[e], v[9 + 2 * w][e] * ns[e]); }
        bf16_t* o = dst + (size_t)(4 * q + e) * ldk + k0 + 16 * r4; *(u32x4*)o = lo; *(u32x4*)(o + 8) = hi; }
}
__device__ __forceinline__ void transpose_item_f8(const float* src, int ldn, int k0, int n0, unsigned char* dst, int ldk, const float* kscale, float mul, int lane) {
    const int r4 = lane >> 4, q = lane & 15;
    f32x4 v[16];
    const float* sp = src + (size_t)(k0 + 16 * r4) * ldn + n0 + 4 * q;
#pragma unroll
    for (int i = 0; i < 16; ++i) v[i] = __builtin_nontemporal_load((const f32x4*)(sp + (size_t)i * ldn));
    {
        const f32x4* kp = (const f32x4*)(kscale + k0 + 16 * r4);
#pragma unroll
        for (int g = 0; g < 4; ++g) { f32x4 ks = (f32x4){mul, mul, mul, mul}; if (kscale) ks = kp[g] * mul;
#pragma unroll
            for (int j = 0; j < 4; ++j) v[4 * g + j] = v[4 * g + j] * ks[j]; }
    }
#pragma unroll
    for (int e = 0; e < 4; ++e) { u32x4 o;
#pragma unroll
        for (int w = 0; w < 4; ++w) o[w] = pk_fp8x4((f32x4){v[4 * w][e], v[4 * w + 1][e], v[4 * w + 2][e], v[4 * w + 3][e]});
        *(u32x4*)(dst + (size_t)(4 * q + e) * ldk + k0 + 16 * r4) = o; }
}
__device__ __forceinline__ int win_row(int n0) {
    const int seg = n0 >> 10, c = n0 & 1023;
    if (seg == 1 || seg == 2) return 1024 + (c >> 7) * 256 + (seg == 2 ? 128 : 0) + (c & 127);
    if (seg == 3 || seg == 4) return 3072 + (c >> 7) * 256 + (seg == 4 ? 128 : 0) + (c & 127);
    return n0;
}
__device__ __forceinline__ int pair_row(int f, int second) { return (f >> 7) * 256 + (second ? 128 : 0) + (f & 127); }

__device__ __forceinline__ void prologue_phase(KArgs a, LAS unsigned char* lds, int wid, int lane) {
    asm volatile("" : "+v"(lane));
    const int gw = blockIdx.x * 8 + wid, NGW = gridDim.x * 8;
    unsigned char* ws = a->ws;
    constexpr int I_WIN = 16 * 144, I_SQ = 16 * 16, I_PW = 16, I_D1 = 16 * 56, I_D2 = 56 * 16;
    constexpr int NIT = 2 * I_WIN + 8 * I_SQ + 8 * I_PW + 2 * I_D1 + I_D2;
    for (int it = gw; it < NIT; it += NGW) {
        int r = it;
        if (r < 2 * I_WIN) { const int L = r / I_WIN; r -= L * I_WIN; const int kb = r / 144, nb = r % 144, n0 = 64 * nb;
            transpose_item(a->in[2] + (size_t)L * D * INC, INC, 64 * kb, n0, (bf16_t*)(ws + WS_W0 + W0_WIN + (size_t)L * 18 * MiB) + (size_t)win_row(n0) * D, D, a->in[1] + L * D, nullptr, lane); continue; }
        r -= 2 * I_WIN;
        if (r < 8 * I_SQ) { const int j = r / I_SQ; r -= j * I_SQ; const int L = j >> 2, w = j & 3, kb = r / 16, nb = r % 16, n0 = 64 * nb;
            bf16_t* dst = w < 3 ? (bf16_t*)(ws + WS_W0 + W0_WOUT + (size_t)(L * 3 + w) * 2 * MiB) : (bf16_t*)(ws + WS_W0 + W0_WO + (size_t)L * 2 * MiB);
            transpose_item(a->in[10 + w] + (size_t)L * D * D, D, 64 * kb, n0, dst + (size_t)n0 * D, D, nullptr, nullptr, lane); continue; }
        r -= 8 * I_SQ;
        if (r < 8 * I_PW) { const int j = r / I_PW; r -= j * I_PW; const int L = j >> 2, g = j & 3;
            const float* src = a->in[8] + (size_t)(L * 4 + g) * 65536 + (size_t)r * 16 * 256; const float* sc = a->in[9] + L * D + g * 256;
            bf16_t* dst = (bf16_t*)(ws + WS_W0 + W0_POOL + (size_t)L * 512 * 1024) + (size_t)g * 65536 + (size_t)r * 16 * 256; const f32x4 s4 = *(const f32x4*)(sc + 4 * lane);
#pragma unroll
            for (int i = 0; i < 16; ++i) { const f32x4 v = *(const f32x4*)(src + i * 256 + 4 * lane) * s4; u32x2 w; w.x = pk_bf16(v[0], v[1]); w.y = pk_bf16(v[2], v[3]); *(u32x2*)(dst + i * 256 + 4 * lane) = w; }
            continue; }
        r -= 8 * I_PW;
        if (r < 2 * I_D1) { const int w = r / I_D1; r -= w * I_D1; const int kb = r / 56, nb = r % 56, n0 = 64 * nb;
            transpose_item(a->in[15 + w], DFF, 64 * kb, n0, (bf16_t*)(ws + WS_W0 + W0_D13) + (size_t)pair_row(n0, w) * D, D, a->in[14], nullptr, lane); continue; }
        r -= 2 * I_D1;
        { const int kb = r / 16, nb = r % 16, n0 = 64 * nb;
            transpose_item(a->in[17], D, 64 * kb, n0, (bf16_t*)(ws + WS_W0 + W0_D2) + (size_t)n0 * DFF, DFF, nullptr, nullptr, lane); }
    }
    const float* x = a->in[0]; bf16_t* xb = (bf16_t*)(ws + WS_XB); f32x4* ss0 = (f32x4*)(ws + WS_SS);
    for (int m = gw; m < M; m += NGW) {
        const f32x4* xr = (const f32x4*)(x + (size_t)m * D) + lane; u32x2* o = (u32x2*)(xb + (size_t)m * D) + lane; float s = 0.f;
#pragma unroll
        for (int j = 0; j < 4; ++j) { const f32x4 v = xr[64 * j]; s += (v[0] * v[0] + v[1] * v[1]) + (v[2] * v[2] + v[3] * v[3]); u32x2 w; w.x = pk_bf16(v[0], v[1]); w.y = pk_bf16(v[2], v[3]); o[64 * j] = w; }
        s = wave_sum(s); if (lane == 0) ss0[m] = (f32x4){s, 0.f, 0.f, 0.f};
    }
}

__device__ __forceinline__ void dma_block16(const bf16_t* src, LAS unsigned char* dst, int wid, int lane) {
#pragma unroll
    for (int k = 0; k < 4; ++k) { const int h = wid * 4 + k;
        __builtin_amdgcn_global_load_lds((const unsigned*)((const char*)src + h * 1024 + lane * 16), (LAS unsigned*)(dst + h * 1024), 16, 0, 0); }
}
__device__ __forceinline__ void zero_block16(LAS unsigned char* dst, int tid) {
#pragma unroll
    for (int k = 0; k < 4; ++k) *(LAS u32x4*)(dst + (size_t)(tid + 512 * k) * 16) = (u32x4){0u, 0u, 0u, 0u};
}
template <int I> __device__ __forceinline__ void conv31_pair(const LAS unsigned char* col, const unsigned (&wp)[31], f32x2 bias, f32x2 (&acc)[16]) {
    f32x2 x[46];
#pragma unroll
    for (int i = 0; i < 46; ++i) { const int r = i - 30, j = I + (r >> 4); const unsigned u = *(const LAS unsigned*)(col + ((j + 2) & 3) * 32768 + (r & 15) * 2048); x[i] = (f32x2){bf_lo(u), bf_hi(u)}; }
#pragma unroll
    for (int j = 0; j < 16; ++j) acc[j] = bias;
#pragma unroll
    for (int k = 0; k < 31; ++k) { const f32x2 wk = (f32x2){bf_lo(wp[k]), bf_hi(wp[k])};
#pragma unroll
        for (int j = 0; j < 16; ++j) acc[j] = __builtin_elementwise_fma(wk, x[j + k], acc[j]); }
}
template <int I, int CH> __device__ __forceinline__ void pool_ch(const LAS unsigned char* col, int g, int s0, float (&p)[16]) {
    float x[31], tv[16];
#pragma unroll
    for (int i = 0; i < 31; ++i) { const int r = i - 15, j = I + (r >> 4); const unsigned u = *(const LAS unsigned*)(col + ((j + 1) % 3) * 32768 + (r & 15) * 2048); x[i] = CH ? bf_hi(u) : bf_lo(u); }
#pragma unroll
    for (int j = 0; j < 16; ++j) tv[j] = x[15 + j];
#pragma unroll
    for (int i = 30; i >= 1; --i) x[i] += x[i - 1];
    if (g >= 1) {
#pragma unroll
        for (int i = 30; i >= 2; --i) x[i] += x[i - 2]; }
    if (g >= 2) {
#pragma unroll
        for (int i = 30; i >= 4; --i) x[i] += x[i - 4]; }
    if (g >= 3) {
#pragma unroll
        for (int i = 30; i >= 8; --i) x[i] += x[i - 8]; }
    const int w = 2 << g;
#pragma unroll
    for (int j = 0; j < 16; ++j) { const int cnt = min(s0 + j + 1, w); p[j] = x[15 + j] * (1.0f / (float)cnt) - tv[j]; }
}
struct ConvB { const bf16_t* GLU; __amdgpu_buffer_rsrc_t rVB; LAS unsigned char* lds; LAS float* red; LAS float* stat; f32x2 bb, gg, be; };
template <int I> __device__ __forceinline__ void convB_tile(const ConvB& c, unsigned (&wp)[31], int T0, int tid, int wid, int lane) {
    const int t0 = T0 + 16 * I; const LAS unsigned char* col = c.lds + 4 * tid;
#pragma unroll
    for (int k = 0; k < 31; ++k) asm volatile("" : "+v"(wp[k]));
    if (I < 3) dma_block16(c.GLU + (size_t)(t0 + 16) * D, c.lds + ((I + 3) & 3) * 32768, wid, lane);
    float a0[16], a1[16];
    { f32x2 ap[16]; conv31_pair<I>(col, wp, c.bb, ap);
#pragma unroll
      for (int j = 0; j < 16; ++j) { a0[j] = ap[j].x; a1[j] = ap[j].y; } }
    {
        float v[32];
#pragma unroll
        for (int j = 0; j < 16; ++j) { v[j] = a0[j] + a1[j]; v[16 + j] = a0[j] * a0[j] + a1[j] * a1[j]; }
#pragma unroll
        for (int i = 0; i < 16; ++i) { const bool b = lane & 32; const float send = b ? v[i] : v[i + 16], keep = b ? v[i + 16] : v[i]; v[i] = keep + __shfl_xor(send, 32); }
#pragma unroll
        for (int i = 0; i < 8; ++i) { const bool b = lane & 16; const float send = b ? v[i] : v[i + 8], keep = b ? v[i + 8] : v[i]; v[i] = keep + __shfl_xor(send, 16); }
#pragma unroll
        for (int i = 0; i < 4; ++i) { const bool b = lane & 8; const float send = b ? v[i] : v[i + 4], keep = b ? v[i + 4] : v[i]; v[i] = keep + __shfl_xor(send, 8); }
#pragma unroll
        for (int i = 0; i < 2; ++i) { const bool b = lane & 4; const float send = b ? v[i] : v[i + 2], keep = b ? v[i + 2] : v[i]; v[i] = keep + __shfl_xor(send, 4); }
        { const bool b = lane & 2; const float send = b ? v[0] : v[1], keep = b ? v[1] : v[0]; v[0] = keep + __shfl_xor(send, 2); }
        v[0] += __shfl_xor(v[0], 1);
        const int idx = ((lane >> 5) & 1) * 16 + ((lane >> 4) & 1) * 8 + ((lane >> 3) & 1) * 4 + ((lane >> 2) & 1) * 2 + ((lane >> 1) & 1);
        if (!(lane & 1)) c.red[wid * 32 + idx] = v[0];
    }
    __syncthreads();
    if (tid < 16) { float s = 0.f, q = 0.f;
#pragma unroll
        for (int w = 0; w < 8; ++w) { s += c.red[w * 32 + tid]; q += c.red[w * 32 + 16 + tid]; }
        const float mean = s * (1.0f / D), var = fmaxf(q * (1.0f / D) - mean * mean, 0.f);
        c.stat[2 * tid] = mean; c.stat[2 * tid + 1] = __builtin_amdgcn_rsqf(var + LN_EPS); }
    asm volatile("s_waitcnt vmcnt(0)" ::: "memory");
    __syncthreads();
#pragma unroll
    for (int j = 0; j < 16; ++j) { const float mean = c.stat[2 * j], rstd = c.stat[2 * j + 1];
        const float y0 = (a0[j] - mean) * rstd * c.gg.x + c.be.x, y1 = (a1[j] - mean) * rstd * c.gg.y + c.be.y;
        __builtin_amdgcn_raw_buffer_store_b32(pk_bf16(y0 * sigm(y0), y1 * sigm(y1)), c.rVB, 4 * tid, (t0 + j) * (D * 2), 0); }
}
struct ConvAC { const bf16_t* PU; __amdgpu_buffer_rsrc_t rSCB, rSCX, rYA, rPP; LAS unsigned char* lds; f32x2 s0w, s1w, s2w; };
__device__ __forceinline__ void convAC_load(const ConvAC& c, int t0, int tid, unsigned (&ub)[16], unsigned (&ux)[18]) {
#pragma unroll
    for (int j = 0; j < 16; ++j) ub[j] = __builtin_amdgcn_raw_buffer_load_b32(c.rSCB, 4 * tid, (t0 + j) * (D * 2), 0);
#pragma unroll
    for (int i = 0; i < 18; ++i) ux[i] = __builtin_amdgcn_raw_buffer_load_b32(c.rSCX, 4 * tid, (t0 + 62 + i) * (D * 2), 0);
}
template <int I> __device__ __forceinline__ void convAC_tile(const ConvAC& c, int T0, int tid, int wid, int lane, const unsigned (&ub)[16], const unsigned (&ux)[18], unsigned (&ubn)[16], unsigned (&uxn)[18]) {
    const int t0 = T0 + 16 * I, s0 = t0 & (SEQ - 1); const LAS unsigned char* col = c.lds + 4 * tid;
    if (I < 3) { convAC_load(c, t0 + 16, tid, ubn, uxn); dma_block16(c.PU + (size_t)(t0 + 16) * D, c.lds + ((I + 2) % 3) * 32768, wid, lane); }
    asm volatile("" ::: "memory");
    {
        float x0[18], x1[18];
#pragma unroll
        for (int i = 0; i < 18; ++i) { const unsigned u = (s0 - 2 + i) >= 0 ? ux[i] : 0u; x0[i] = bf_lo(u); x1[i] = bf_hi(u); }
#pragma unroll
        for (int j = 0; j < 16; ++j) {
            const float y0 = bf_lo(ub[j]) * (c.s0w.x * x0[j] + c.s1w.x * x0[j + 1] + c.s2w.x * x0[j + 2]), y1 = bf_hi(ub[j]) * (c.s0w.y * x1[j] + c.s1w.y * x1[j + 1] + c.s2w.y * x1[j + 2]);
            __builtin_amdgcn_raw_buffer_store_b32(pk_bf16(y0, y1), c.rYA, 4 * tid, (t0 + j) * (D * 2), 0); }
    }
    {
        float p0[16], p1[16];
        pool_ch<I, 0>(col, wid >> 1, s0, p0);
#pragma unroll
        for (int j = 0; j < 16; ++j) asm volatile("" : "+v"(p0[j]) :: "memory");
        pool_ch<I, 1>(col, wid >> 1, s0, p1);
#pragma unroll
        for (int j = 0; j < 16; ++j) __builtin_amdgcn_raw_buffer_store_b32(pk_bf16(p0[j], p1[j]), c.rPP, 4 * tid, (t0 + j) * (D * 2), 0);
    }
    if (I < 3) asm volatile("s_waitcnt vmcnt(32)" ::: "memory");
    __syncthreads();
}
__device__ __forceinline__ void conv_phase(KArgs a, int layer, LAS unsigned char* lds, int tid, int wid, int lane) {
    asm volatile("" : "+v"(tid), "+v"(lane));
    unsigned char* ws = a->ws;
    const int G = gridDim.x;
    const int vcu = (G % 8 == 0) ? (int)(blockIdx.x % 8) * (G / 8) + (int)(blockIdx.x / 8) : (int)blockIdx.x;
    const int c2 = 2 * tid;
    {
        const float* cfw = a->in[4] + layer * 31 * D; const float* cfb = a->in[5] + layer * D; const float* lng = a->in[6] + layer * D; const float* lnb = a->in[7] + layer * D;
        ConvB c; c.GLU = (const bf16_t*)(ws + A_GLU); c.rVB = __builtin_amdgcn_make_buffer_rsrc((void*)(ws + A_VB), 0, 0x7fffffff, 0x00020000);
        c.lds = lds; c.red = (LAS float*)(lds + RED_OFF); c.stat = c.red + 256;
        unsigned wp[31];
#pragma unroll
        for (int k = 0; k < 31; ++k) { const f32x2 w = *(const f32x2*)(cfw + k * D + c2); wp[k] = pk_bf16(w.x, w.y); }
        c.bb = *(const f32x2*)(cfb + c2); c.gg = *(const f32x2*)(lng + c2); c.be = *(const f32x2*)(lnb + c2);
        asm volatile("" :: "v"(c.bb.x), "v"(c.bb.y), "v"(c.gg.x), "v"(c.gg.y), "v"(c.be.x), "v"(c.be.y));
        for (int rp2 = 0; rp2 < REPS2(21); ++rp2)
        for (int sup = vcu; sup < M / 64; sup += G) {
            const int T0 = sup * 64; const bool seq0 = (T0 & (SEQ - 1)) == 0;
            if (seq0) { zero_block16(lds, tid); zero_block16(lds + 32768, tid); } else { dma_block16(c.GLU + (size_t)(T0 - 32) * D, lds, wid, lane); dma_block16(c.GLU + (size_t)(T0 - 16) * D, lds + 32768, wid, lane); }
            dma_block16(c.GLU + (size_t)T0 * D, lds + 65536, wid, lane);
            asm volatile("s_waitcnt vmcnt(0)" ::: "memory");
            __syncthreads();
            convB_tile<0>(c, wp, T0, tid, wid, lane); convB_tile<1>(c, wp, T0, tid, wid, lane); convB_tile<2>(c, wp, T0, tid, wid, lane); convB_tile<3>(c, wp, T0, tid, wid, lane);
            __syncthreads();
        }
    }
    __syncthreads();
    {
        const float* scw = a->in[3] + layer * 3 * D;
        ConvAC c; c.PU = (const bf16_t*)(ws + A_PU); c.lds = lds;
        c.rSCB = __builtin_amdgcn_make_buffer_rsrc((void*)(ws + A_SCB), 0, 0x7fffffff, 0x00020000); c.rSCX = __builtin_amdgcn_make_buffer_rsrc((void*)(ws + A_SCX - 64 * D * 2), 0, 0x7fffffff, 0x00020000);
        c.rYA = __builtin_amdgcn_make_buffer_rsrc((void*)(ws + A_YA), 0, 0x7fffffff, 0x00020000); c.rPP = __builtin_amdgcn_make_buffer_rsrc((void*)(ws + A_PP), 0, 0x7fffffff, 0x00020000);
        c.s0w = *(const f32x2*)(scw + c2); c.s1w = *(const f32x2*)(scw + D + c2); c.s2w = *(const f32x2*)(scw + 2 * D + c2);
        asm volatile("" :: "v"(c.s0w.x), "v"(c.s0w.y), "v"(c.s1w.x), "v"(c.s1w.y), "v"(c.s2w.x), "v"(c.s2w.y));
        for (int rp2 = 0; rp2 < REPS2(22); ++rp2)
        for (int sup = vcu; sup < M / 64; sup += G) {
            const int T0 = sup * 64; const bool seq0 = (T0 & (SEQ - 1)) == 0;
            if (seq0) zero_block16(lds, tid); else dma_block16(c.PU + (size_t)(T0 - 16) * D, lds, wid, lane);
            dma_block16(c.PU + (size_t)T0 * D, lds + 32768, wid, lane);
            unsigned ubA[16], uxA[18], ubB[16], uxB[18]; convAC_load(c, T0, tid, ubA, uxA);
            asm volatile("s_waitcnt vmcnt(0)" ::: "memory");
            __syncthreads();
            convAC_tile<0>(c, T0, tid, wid, lane, ubA, uxA, ubB, uxB); convAC_tile<1>(c, T0, tid, wid, lane, ubB, uxB, ubA, uxA); convAC_tile<2>(c, T0, tid, wid, lane, ubA, uxA, ubB, uxB); convAC_tile<3>(c, T0, tid, wid, lane, ubB, uxB, ubA, uxA);
        }
    }
}

__device__ __forceinline__ void route_phase(KArgs a, LAS unsigned char* lds, int tid, int wid, int lane) {
    asm volatile("" : "+v"(tid), "+v"(lane));
    unsigned char* ws = a->ws;
    const bf16_t* X = (const bf16_t*)(ws + WS_XB); const float* gn = a->in[14] + D; const float* R = a->in[18];
    const f32x4* ss3 = (const f32x4*)(ws + WS_SS) + 3 * M;
    int* tope = (int*)(ws + WS_SMALL + SM_TOPE); f32x2* topp = (f32x2*)(ws + WS_SMALL + SM_TOPP); int* cntb = (int*)(ws + WS_CTL + CTL_CNT);
    LAS int* lcnt = (LAS int*)(lds + 98304);
    float wgt[2][8][8];
#pragma unroll
    for (int h = 0; h < 2; ++h)
#pragma unroll
        for (int i = 0; i < 8; ++i) { const int k = 8 * lane + 512 * h + i; const float g = gn[k]; const f32x4 r0 = *(const f32x4*)(R + k * 8), r1 = *(const f32x4*)(R + k * 8 + 4);
#pragma unroll
            for (int e = 0; e < 4; ++e) { wgt[h][i][e] = g * r0[e]; wgt[h][i][4 + e] = g * r1[e]; } }
    for (int vb = blockIdx.x; vb < 256; vb += gridDim.x) {
        if (tid < 8) lcnt[tid] = 0;
        __syncthreads();
        for (int i8 = 0; i8 < 8; ++i8) {
            const int t = vb * 64 + wid * 8 + i8;
            float lg[8];
#pragma unroll
            for (int e = 0; e < 8; ++e) lg[e] = 0.f;
#pragma unroll
            for (int h = 0; h < 2; ++h) { f32x4 v0, v1; pg8::unpack8(*(const u32x4*)(X + (size_t)t * D + 512 * h + 8 * lane), v0, v1);
#pragma unroll
                for (int i = 0; i < 4; ++i)
#pragma unroll
                    for (int e = 0; e < 8; ++e) { lg[e] = fmaf(v0[i], wgt[h][i][e], lg[e]); lg[e] = fmaf(v1[i], wgt[h][4 + i][e], lg[e]); } }
#pragma unroll
            for (int e = 0; e < 8; ++e) lg[e] = wave_sum(lg[e]);
            const f32x4 sp = ss3[t]; const float rstd = __builtin_amdgcn_rsqf(((sp[0] + sp[1]) + (sp[2] + sp[3])) * (1.0f / D) + RMS_EPS);
            int e1 = 0; float v1 = lg[0];
#pragma unroll
            for (int e = 1; e < 8; ++e) if (lg[e] > v1) { v1 = lg[e]; e1 = e; }
            int e2 = e1 == 0 ? 1 : 0; float v2 = -__builtin_inff();
#pragma unroll
            for (int e = 0; e < 8; ++e) if (e != e1 && lg[e] > v2) { v2 = lg[e]; e2 = e; }
            const float ex = __expf((v2 - v1) * rstd), p1 = 1.0f / (1.0f + ex), p2 = ex * p1;
            if (lane == 0) { tope[t] = e1 | (e2 << 8); topp[t] = (f32x2){p1, p2}; atomicAdd((int*)&lcnt[e1], 1); atomicAdd((int*)&lcnt[e2], 1); }
        }
        __syncthreads();
        if (tid < 8) cntb[vb * 8 + tid] = lcnt[tid];
        __syncthreads();
    }
    const int gw = blockIdx.x * 8 + wid, NGW = gridDim.x * 8;
    constexpr int I_1 = 16 * 56, I_13 = 2 * I_1, I_2 = 56 * 16;
    unsigned char* w13 = ws + WS_WMOE; unsigned char* w2t = ws + WS_WMOE + WMOE_W2;
    for (int it = gw; it < NE * (I_13 + I_2); it += NGW) {
        int r = it;
        if (r < NE * I_13) { const int e = r / I_13; r -= e * I_13; const int w = r / I_1; r -= w * I_1; const int kb = r / 56, nb = r % 56, n0 = 64 * nb;
            transpose_item_f8(a->in[19 + w] + (size_t)e * D * DFF, DFF, 64 * kb, n0, w13 + (size_t)e * (2 * DFF) * D + (size_t)pair_row(n0, w) * D, D, gn, F8_W13_MUL, lane); continue; }
        r -= NE * I_13;
        { const int e = r / I_2; r -= e * I_2; const int kb = r / 16, nb = r % 16, n0 = 64 * nb;
            transpose_item_f8(a->in[21] + (size_t)e * DFF * D, D, 64 * kb, n0, w2t + (size_t)e * D * DFF + (size_t)n0 * DFF, DFF, nullptr, F8_W2_MUL, lane); }
    }
}

__device__ __forceinline__ void scatter_phase(KArgs a, LAS unsigned char* lds, int tid, int wid, int lane) {
    asm volatile("" : "+v"(tid), "+v"(lane));
    unsigned char* ws = a->ws;
    const int* tope = (const int*)(ws + WS_SMALL + SM_TOPE); int* tslot = (int*)(ws + WS_SMALL + SM_TSLOT); float* ssperm = (float*)(ws + WS_SMALL + SM_SSPERM); int* meta = (int*)(ws + WS_SMALL + SM_META);
    const int* cntb = (const int*)(ws + WS_CTL + CTL_CNT); const f32x4* ss3 = (const f32x4*)(ws + WS_SS) + 3 * M;
    const bf16_t* X = (const bf16_t*)(ws + WS_XB); unsigned char* AP = ws + WS_APERM;
    LAS int* lc = (LAS int*)lds;
    LAS int* lbase = lc + 2048;
    LAS int* lslot = lc + 2064;
    LAS int* ltot = lc + 2200;
    for (int i = tid; i < 2048; i += 512) lc[i] = __hip_atomic_load(cntb + i, __ATOMIC_RELAXED, __HIP_MEMORY_SCOPE_AGENT);
    __syncthreads();
    for (int vb = blockIdx.x; vb < 256; vb += gridDim.x) {
        if (tid < 8) { int tot = 0, pre = 0;
#pragma unroll 8
            for (int b = 0; b < 256; ++b) { const int v = lc[b * 8 + tid]; tot += v; pre += (b < vb) ? v : 0; }
            ltot[tid] = tot; lbase[tid] = pre; }
        __syncthreads();
        if (tid == 0) { int off = 0;
            for (int e = 0; e < 8; ++e) { lbase[e] += off; if (vb == 0) meta[e] = off >> 8; off += (ltot[e] + 255) & ~255; }
            if (vb == 0) meta[8] = off >> 8; }
        __syncthreads();
        if (wid == 0) {
            const int t = vb * 64 + lane; const int te = tope[t]; const int e1 = te & 0xff, e2 = (te >> 8) & 0xff;
            int s1 = 0, s2 = 0;
#pragma unroll
            for (int k = 0; k < 2; ++k) { const int ek = k ? e2 : e1; int sk = 0;
#pragma unroll
                for (int e = 0; e < 8; ++e) { const unsigned long long mask = __ballot(ek == e); const int base = lbase[e]; LDS_WAIT();
                    const int rank = __popcll(mask & ((1ull << lane) - 1ull)); if (ek == e) sk = base + rank;
                    if (lane == 0) lbase[e] = base + __popcll(mask); LDS_WAIT(); }
                if (k) s2 = sk; else s1 = sk; }
            *(int2*)(tslot + 2 * t) = make_int2(s1, s2); lslot[lane] = s1; lslot[64 + lane] = s2;
        }
        __syncthreads();
        for (int rb = 0; rb < 2; ++rb) {
            u32x4 xv[8][2]; f32x4 sp[8];
#pragma unroll
            for (int i = 0; i < 8; ++i) { const int r = wid + 8 * (rb * 8 + i), t = vb * 64 + (r & 63); const u32x4* src = (const u32x4*)(X + (size_t)t * D) + 2 * lane; xv[i][0] = src[0]; xv[i][1] = src[1]; sp[i] = ss3[t]; }
#pragma unroll
            for (int i = 0; i < 8; ++i) { const int r = wid + 8 * (rb * 8 + i), slot = lslot[r];
                const float rstd = __builtin_amdgcn_rsqf(((sp[i][0] + sp[i][1]) + (sp[i][2] + sp[i][3])) * (1.0f / D) + RMS_EPS);
                f32x4 v0, v1, v2, v3; pg8::unpack8(xv[i][0], v0, v1); pg8::unpack8(xv[i][1], v2, v3);
                *((u32x4*)(AP + (size_t)slot * D) + lane) = (u32x4){pk_fp8x4(v0 * rstd), pk_fp8x4(v1 * rstd), pk_fp8x4(v2 * rstd), pk_fp8x4(v3 * rstd)}; } }
        __syncthreads();
    }
}

__device__ __forceinline__ void combine_phase(KArgs a, int wid, int lane) {
    asm volatile("" : "+v"(lane));
    unsigned char* ws = a->ws;
    const bf16_t* X = (const bf16_t*)(ws + WS_XB); const bf16_t* Y = (const bf16_t*)(ws + WS_Y); const int* tslot = (const int*)(ws + WS_SMALL + SM_TSLOT); const f32x2* topp = (const f32x2*)(ws + WS_SMALL + SM_TOPP);
    const float* gf = a->in[22]; float* out = a->out;
    const int gw = blockIdx.x * 8 + wid, NGW = gridDim.x * 8;
    f32x4 gv[4];
#pragma unroll
    for (int h = 0; h < 2; ++h) { gv[2 * h] = *(const f32x4*)(gf + 512 * h + 8 * lane); gv[2 * h + 1] = *(const f32x4*)(gf + 512 * h + 8 * lane + 4); }
    for (int tb = gw; tb < M; tb += 4 * NGW) {
        int2 sl[4]; f32x2 p[4];
#pragma unroll
        for (int i = 0; i < 4; ++i) { const int t = min(tb + i * NGW, M - 1); sl[i] = *(const int2*)(tslot + 2 * t); p[i] = topp[t]; }
        u32x4 xr[4][2], ya[4][2], yb[4][2];
#pragma unroll
        for (int i = 0; i < 4; ++i) { const int t = min(tb + i * NGW, M - 1);
#pragma unroll
            for (int h = 0; h < 2; ++h) { const int col = 512 * h + 8 * lane;
                xr[i][h] = *(const u32x4*)(X + (size_t)t * D + col); ya[i][h] = *(const u32x4*)(Y + (size_t)sl[i].x * D + col); yb[i][h] = *(const u32x4*)(Y + (size_t)sl[i].y * D + col); } }
#pragma unroll
        for (int i = 0; i < 4; ++i) { const int t = tb + i * NGW; if (t < M) {
            f32x4 v[4]; float s = 0.f;
#pragma unroll
            for (int h = 0; h < 2; ++h) { f32x4 x0, x1, a0, a1, b0, b1; pg8::unpack8(xr[i][h], x0, x1); pg8::unpack8(ya[i][h], a0, a1); pg8::unpack8(yb[i][h], b0, b1);
                v[2 * h] = x0 + a0 * p[i].x + b0 * p[i].y; v[2 * h + 1] = x1 + a1 * p[i].x + b1 * p[i].y; }
#pragma unroll
            for (int k = 0; k < 4; ++k) s += (v[k][0] * v[k][0] + v[k][1] * v[k][1]) + (v[k][2] * v[k][2] + v[k][3] * v[k][3]);
            const float rstd = __builtin_amdgcn_rsqf(wave_sum(s) * (1.0f / D) + RMS_EPS);
#pragma unroll
            for (int h = 0; h < 2; ++h) { const int col = 512 * h + 8 * lane;
                *(f32x4*)(out + (size_t)t * D + col) = v[2 * h] * rstd * gv[2 * h]; *(f32x4*)(out + (size_t)t * D + col + 4) = v[2 * h + 1] * rstd * gv[2 * h + 1]; } } }
    }
}

#ifndef WGM_INPROJ
#define WGM_INPROJ 4
#endif
#ifndef WGM_FFN1
#define WGM_FFN1 4
#endif
#ifndef WGM_MOE1
#define WGM_MOE1 4
#endif
constexpr int NPH = 18;
#ifndef MK_PH_MASK
#define MK_PH_MASK 0xFFFFFFFFu
#endif
#define PHON(bit) ((((MK_PH_MASK) >> (bit)) & 1u) != 0u)


__device__ __forceinline__ void ph_inproj(KArgs a, int layer, LAS unsigned char* lds) {
    unsigned char* ws = a->ws;
    pg8::Gemm g{2 * D, 2 * D, 2 * D, 0, 0}; pg8::PlainSched S{M / 256, INC / 256, (int)gridDim.x, (int)blockIdx.x, (const char*)(ws + WS_XB), (const char*)(ws + WS_W0 + W0_WIN + (size_t)layer * 18 * MiB), (size_t)256 * D * 2, (size_t)256 * D * 2, WGM_INPROJ};
    pg8::EpiProj E{(bf16_t*)(ws + A_SCB), (bf16_t*)(ws + A_SCX), (bf16_t*)(ws + A_GLU), (bf16_t*)(ws + A_PU), (bf16_t*)(ws + A_GATES), (const f32x4*)(ws + WS_SS) + (size_t)(layer * 2) * M};
    pg8::gemm_phase(lds, g, S, E);
}
__device__ __forceinline__ void ph_fold(KArgs a, LAS unsigned char* lds) {
    unsigned char* ws = a->ws;
    pg8::Gemm g{512, 2 * D, 512, 0, 0}; pg8::FoldSched S{(int)gridDim.x, (int)blockIdx.x, (const char*)(ws + WS_W0 + W0_WOUT + 2 * 2 * MiB), (const char*)(ws + WS_W0 + W0_POOL)};
    pg8::EpiPlain E{(bf16_t*)(ws + WS_WC), D, (size_t)D * D};
    pg8::gemm_phase(lds, g, S, E);
}
__device__ __forceinline__ void ph_merge(KArgs a, int layer, LAS unsigned char* lds) {
    unsigned char* ws = a->ws;
    pg8::Gemm g{2 * D, 2 * D, 2 * D, 0, 0}; pg8::MergeSched S{(int)gridDim.x, (int)blockIdx.x, (const char*)(ws + A_YA), (const char*)(ws + WS_W0 + W0_WOUT + (size_t)(layer * 3) * 2 * MiB), (const char*)(ws + WS_WC + (size_t)layer * 2 * MiB), (size_t)32 * MiB, (size_t)2 * MiB};
    pg8::EpiMerge E{(const bf16_t*)(ws + A_GATES), (bf16_t*)(ws + A_MERGED)};
    pg8::gemm_phase(lds, g, S, E);
}
__device__ __forceinline__ void ph_wo(KArgs a, int layer, LAS unsigned char* lds) {
    unsigned char* ws = a->ws;
    pg8::Gemm g{2 * D, 2 * D, 2 * D, 0, 0}; pg8::PlainSched S{M / 256, D / 256, (int)gridDim.x, (int)blockIdx.x, (const char*)(ws + A_MERGED), (const char*)(ws + WS_W0 + W0_WO + (size_t)layer * 2 * MiB), (size_t)256 * D * 2, (size_t)256 * D * 2, 4};
    pg8::EpiResid E{layer == 0 ? a->in[0] : (const float*)nullptr, (bf16_t*)(ws + WS_XB), (float*)(ws + WS_SS) + (size_t)(layer * 2 + 1) * M * 4, (LAS float*)(lds + RED_OFF)};
    pg8::gemm_phase(lds, g, S, E);
}
__device__ __forceinline__ void ph_ffn1(KArgs a, LAS unsigned char* lds) {
    unsigned char* ws = a->ws;
    pg8::Gemm g{2 * D, 2 * D, 2 * D, 0, 0}; pg8::PlainSched S{M / 256, 2 * DFF / 256, (int)gridDim.x, (int)blockIdx.x, (const char*)(ws + WS_XB), (const char*)(ws + WS_W0 + W0_D13), (size_t)256 * D * 2, (size_t)256 * D * 2, WGM_FFN1};
    pg8::EpiSwiGLU<true, false> E{(bf16_t*)(ws + A_FFN), DFF, (const float*)(ws + WS_SS) + (size_t)1 * M * 4};
    pg8::gemm_phase(lds, g, S, E);
}
__device__ __forceinline__ void ph_ffn2(KArgs a, LAS unsigned char* lds) {
    unsigned char* ws = a->ws;
    pg8::Gemm g{2 * DFF, 2 * DFF, 2 * DFF, 0, 0}; pg8::PlainSched S{M / 256, D / 256, (int)gridDim.x, (int)blockIdx.x, (const char*)(ws + A_FFN), (const char*)(ws + WS_W0 + W0_D2), (size_t)256 * DFF * 2, (size_t)256 * DFF * 2, 4};
    pg8::EpiResid E{(const float*)nullptr, (bf16_t*)(ws + WS_XB), (float*)(ws + WS_SS) + (size_t)2 * M * 4, (LAS float*)(lds + RED_OFF)};
    pg8::gemm_phase(lds, g, S, E);
}
__device__ __forceinline__ void ph_moe(KArgs a, int which, LAS unsigned char* lds) {
    unsigned char* ws = a->ws;
    const int* meta = (const int*)(ws + WS_SMALL + SM_META); int o[9];
#pragma unroll
    for (int e = 0; e < 9; ++e) o[e] = __builtin_amdgcn_readfirstlane(__hip_atomic_load(meta + e, __ATOMIC_RELAXED, __HIP_MEMORY_SCOPE_AGENT));
    const int nM = o[8] > MAXSLOT / 256 ? MAXSLOT / 256 : o[8];
    if (which == 0) {
        pg8::Gemm g{D, D, D, F8_ONE, F8_W13_SC}; pg8::GroupSched S{nM, 2 * DFF / 256, (int)gridDim.x, (int)blockIdx.x, o[1], o[2], o[3], o[4], o[5], o[6], o[7], (const char*)(ws + WS_APERM), (const char*)(ws + WS_WMOE), (size_t)256 * D, (size_t)256 * D, (size_t)2 * DFF * D, WGM_MOE1};
        pg8::EpiSwiGLU<false, true> E{(bf16_t*)(ws + WS_ACTP), DFF, nullptr};
        pg8::gemm_phase<pg8::EpiSwiGLU<false, true>, pg8::GroupSched, true>(lds, g, S, E);
    } else {
        pg8::Gemm g{DFF, DFF, DFF, F8_ACT_SC, F8_W2_SC}; pg8::GroupSched S{nM, D / 256, (int)gridDim.x, (int)blockIdx.x, o[1], o[2], o[3], o[4], o[5], o[6], o[7], (const char*)(ws + WS_ACTP), (const char*)(ws + WS_WMOE + WMOE_W2), (size_t)256 * DFF, (size_t)256 * DFF, (size_t)D * DFF, 4};
        pg8::EpiPlain E{(bf16_t*)(ws + WS_Y), D, 0};
        pg8::gemm_phase<pg8::EpiPlain, pg8::GroupSched, true>(lds, g, S, E);
    }
}

__global__ void __launch_bounds__(512, 2) fwd(Args unused_args_read_through_kargs) {
    extern __shared__ __attribute__((aligned(16))) unsigned char lds_raw[];
    LAS unsigned char* lds = (LAS unsigned char*)lds_raw;
    volatile LAS unsigned* MISC = (volatile LAS unsigned*)(lds + MISC_OFF);
    const int tid = threadIdx.x, lane = tid & 63, wid = __builtin_amdgcn_readfirstlane(tid >> 6);
    if (tid < 64) MISC[tid] = 0u;
    __syncthreads();
    int lo, hi; XcdBarrier bar;
    { KArgs a = kargs(); lo = a->ph_lo; hi = a->ph_hi; unsigned* bw = (unsigned*)(a->ws + WS_CTL + CTL_BAR); bar.bar = bw; bar.x = 0; bar.st = nullptr; if (hi - lo > 1) bar = xcd_barrier_post(bw, MISC + 8); }
#define IN(k) (lo <= (k) && (k) < hi)
#define SEAM(k) do { if (IN(k) && IN((k) + 1)) xcd_barrier(bar); } while (0)

    if (PHON(0) && IN(0)) { for (int rp = 0; rp < REPS(0); ++rp) { prologue_phase(kargs(), lds, wid, lane); __syncthreads(); } } SEAM(0);
#pragma nounroll
    for (int layer = 0; layer < 2; ++layer) {
        const int pb = 1 + 7 * layer;
        if (PHON(1) && IN(pb + 0)) { for (int rp = 0; rp < REPS(1); ++rp) { if (layer == 0) { ph_fold(kargs(), lds); __syncthreads(); } ph_inproj(kargs(), layer, lds); __syncthreads(); } } SEAM(pb + 0);
        if (PHON(2) && IN(pb + 1)) { for (int rp = 0; rp < REPS(2); ++rp) { conv_phase(kargs(), layer, lds, tid, wid, lane); __syncthreads(); } } SEAM(pb + 1);
        if (PHON(4) && IN(pb + 3)) { for (int rp = 0; rp < REPS(4); ++rp) { ph_merge(kargs(), layer, lds); __syncthreads(); } } SEAM(pb + 3);
        if (PHON(5) && IN(pb + 4)) { for (int rp = 0; rp < (layer == 0 ? REPS(5) : 1); ++rp) { ph_wo(kargs(), layer, lds); __syncthreads(); } } SEAM(pb + 4);
        if (layer == 0) {
            if (PHON(6) && IN(6)) { for (int rp = 0; rp < REPS(6); ++rp) { ph_ffn1(kargs(), lds); __syncthreads(); } } SEAM(6);
            if (PHON(7) && IN(7)) { ph_ffn2(kargs(), lds); } SEAM(7);
        }
    }
    if (PHON(13) && IN(13)) { for (int rp = 0; rp < REPS(13); ++rp) { route_phase(kargs(), lds, tid, wid, lane); __syncthreads(); } } SEAM(13);
    if (PHON(14) && IN(14)) { for (int rp = 0; rp < REPS(14); ++rp) { scatter_phase(kargs(), lds, tid, wid, lane); __syncthreads(); } } SEAM(14);
    if (PHON(15) && IN(15)) { for (int rp = 0; rp < REPS(15); ++rp) { ph_moe(kargs(), 0, lds); __syncthreads(); } } SEAM(15);
    if (PHON(16) && IN(16)) { for (int rp = 0; rp < REPS(16); ++rp) { ph_moe(kargs(), 1, lds); __syncthreads(); } } SEAM(16);
    if (PHON(17) && IN(17)) { for (int rp = 0; rp < REPS(17); ++rp) { combine_phase(kargs(), wid, lane); __syncthreads(); } }
#undef IN
#undef SEAM
}

extern "C" void kernel_launch(void* const* d_in, const int* in_sizes, int n_in, void* d_out, int out_size, void* d_ws, size_t ws_size, hipStream_t stream) {
    static int grid = 0;
    if (grid == 0) {
        if (n_in != 23 || in_sizes[0] != M * D || out_size != M * D || ws_size < WS_END) { fprintf(stderr, "kernel_launch: unexpected shapes: n_in %d in0 %d out %d ws %zu (need %zu); nothing launched\n", n_in, n_in > 0 ? in_sizes[0] : -1, out_size, ws_size, (size_t)WS_END); grid = -1; return; }
        int dev = 0, cus = 0, per_cu = 0;
        if (hipGetDevice(&dev) != hipSuccess || hipDeviceGetAttribute(&cus, hipDeviceAttributeMultiprocessorCount, dev) != hipSuccess) { fprintf(stderr, "kernel_launch: device query failed\n"); grid = -1; return; }
        if (hipFuncSetAttribute((const void*)fwd, hipFuncAttributeMaxDynamicSharedMemorySize, LDS_BYTES) != hipSuccess) { fprintf(stderr, "kernel_launch: hipFuncSetAttribute failed\n"); grid = -1; return; }
        if (hipOccupancyMaxActiveBlocksPerMultiprocessor(&per_cu, (const void*)fwd, 512, LDS_BYTES) != hipSuccess || per_cu < 1) fprintf(stderr, "kernel_launch: note: occupancy query reports %d workgroups per CU\n", per_cu);
        (void)hipGetLastError();
        grid = cus;
    }
    if (grid < 0) return;
    if (hipMemsetAsync((char*)d_ws + WS_CTL, 0, CTL_BYTES, stream) != hipSuccess) { fprintf(stderr, "kernel_launch: memset failed\n"); return; }
    Args a{};
    for (int i = 0; i < 23; ++i) a.in[i] = (const float*)d_in[i];
    a.out = (float*)d_out; a.ws = (unsigned char*)d_ws;
#if MK_PER_PHASE
    for (int ph = 0; ph < NPH; ++ph) { a.ph_lo = ph; a.ph_hi = ph + 1; hipLaunchKernelGGL(fwd, dim3(grid), dim3(512), LDS_BYTES, stream, a); }
#else
    a.ph_lo = 0; a.ph_hi = NPH; hipLaunchKernelGGL(fwd, dim3(grid), dim3(512), LDS_BYTES, stream, a);
#endif
    const hipError_t le = hipPeekAtLastError();
    if (le != hipSuccess) fprintf(stderr, "kernel_launch: launch failed: %s\n", hipGetErrorName(le));
}
```

```cpp
#include <hip/hip_runtime.h>
#include <cstdio>
#include <cstdint>

#ifndef MK_PER_PHASE
#define MK_PER_PHASE 0
#endif

#ifndef MK_REP_MASK
#define MK_REP_MASK 0u
#endif
#define REPS(bit) (1 + (int)(((MK_REP_MASK) >> (bit)) & 1u))
#define REPS2(bit) REPS(bit)

#define LAS __attribute__((address_space(3)))
typedef unsigned short bf16_t;
typedef short bf16x8 __attribute__((ext_vector_type(8)));
typedef float f32x4 __attribute__((ext_vector_type(4)));
typedef float f32x2 __attribute__((ext_vector_type(2)));
typedef unsigned u32x4 __attribute__((ext_vector_type(4)));
typedef unsigned u32x2 __attribute__((ext_vector_type(2)));

constexpr int M = 16384, D = 1024, SEQ = 8192, INC = 9216, DFF = 3584, NE = 8;
constexpr float RMS_EPS = 1e-6f, LN_EPS = 1e-5f;
constexpr int MAXSLOT = 34816;
constexpr float F8_W13_MUL = 128.f, F8_ACT_MUL = 4.f, F8_W2_MUL = 256.f;
constexpr int F8_ONE = 0x7f7f7f7f, F8_W13_SC = 0x78787878  , F8_ACT_SC = 0x7d7d7d7d  , F8_W2_SC = 0x77777777  ;

constexpr size_t MiB = 1u << 20;
constexpr size_t WS_CTL = 0, CTL_BYTES = 64 * 1024;
constexpr size_t CTL_BAR = 16384;
constexpr size_t CTL_CNT = 32768;
constexpr size_t WS_SMALL = 1 * MiB;
constexpr size_t SM_TOPE = 0, SM_TOPP = 64 * 1024, SM_TSLOT = 192 * 1024, SM_SSPERM = 320 * 1024, SM_META = 512 * 1024;
constexpr size_t WS_XB = 66 * MiB;
constexpr size_t WS_W0 = 98 * MiB;
constexpr size_t W0_WIN = 0;
constexpr size_t W0_WOUT = 36 * MiB;
constexpr size_t W0_WO = 48 * MiB;
constexpr size_t W0_POOL = 52 * MiB;
constexpr size_t W0_D13 = 53 * MiB;
constexpr size_t W0_D2 = 67 * MiB;
constexpr size_t WS_ACT = 172 * MiB;
constexpr size_t A_SCB = WS_ACT, A_SCX = WS_ACT + 32 * MiB, A_GLU = WS_ACT + 64 * MiB, A_PU = WS_ACT + 96 * MiB, A_GATES = WS_ACT + 128 * MiB,
                 A_YA = WS_ACT + 224 * MiB, A_VB = WS_ACT + 256 * MiB, A_PP = WS_ACT + 288 * MiB, A_MERGED = A_SCX, A_FFN = WS_ACT;
constexpr size_t WS_WC = 524 * MiB;
constexpr size_t WS_ACTP = 98 * MiB;
constexpr size_t WS_WMOE = 304 * MiB, WMOE_W2 = 56 * MiB;
constexpr size_t WS_Y = 400 * MiB;
constexpr size_t WS_APERM = 472 * MiB;
constexpr size_t WS_SS = 540 * MiB;
constexpr size_t WS_END = 541 * MiB;

typedef __bf16 bf16x2_t __attribute__((ext_vector_type(2)));
__device__ __forceinline__ unsigned pk_bf16(float lo, float hi) { const bf16x2_t v = {(__bf16)lo, (__bf16)hi}; return __builtin_bit_cast(unsigned, v); }
__device__ __forceinline__ unsigned pk_fp8x4(const f32x4 v) {
    const float a = __builtin_fminf(__builtin_fmaxf(v[0], -448.f), 448.f), b = __builtin_fminf(__builtin_fmaxf(v[1], -448.f), 448.f), c = __builtin_fminf(__builtin_fmaxf(v[2], -448.f), 448.f), d = __builtin_fminf(__builtin_fmaxf(v[3], -448.f), 448.f);
    int w = 0; w = __builtin_amdgcn_cvt_pk_fp8_f32(a, b, w, false); w = __builtin_amdgcn_cvt_pk_fp8_f32(c, d, w, true); return (unsigned)w; }
__device__ __forceinline__ float bf_lo(unsigned u) { return __uint_as_float(u << 16); }
__device__ __forceinline__ float bf_hi(unsigned u) { return __uint_as_float(u & 0xffff0000u); }
__device__ __forceinline__ float sigm(float x) { return __builtin_amdgcn_rcpf(1.f + __builtin_amdgcn_exp2f(-1.44269504f * x)); }
__device__ __forceinline__ float wave_sum(float v) {
#pragma unroll
    for (int o = 1; o < 64; o <<= 1) v += __shfl_xor(v, o);
    return v;
}
#define LDS_WAIT() asm volatile("s_waitcnt lgkmcnt(0)" ::: "memory")

namespace pg8 {
constexpr int BM = 256, BK = 64, HALF = 128, HTB = HALF * BK * 2, STAGE_BYTES = 8 * HTB, NXCD = 8;
__host__ __device__ __forceinline__ int lds_byte(int r, int c) { const int st = (r >> 4) * 2 + (c >> 5), rr = r & 15, cc = c & 31, ob = rr * 64 + cc * 2; return st * 1024 + (ob ^ (((ob >> 9) & 1) << 5)); }
__host__ __device__ __forceinline__ void stage_rc(int b, int& R, int& C) { const int st = b / 1024, sb = b % 1024, swz = sb ^ (((sb >> 9) & 1) << 5); R = (st >> 1) * 16 + swz / 64; C = (st & 1) * 32 + (swz % 64) / 2; }
__host__ __device__ __forceinline__ int perm32(int rho) { const int n = rho >> 4, i = rho & 15; return 8 * (i >> 2) + 4 * n + (i & 3); }

struct Unit { int pm, pn, aux; const char* A; const char* B; };
struct Gemm { int Kb, lda, ldb; int sa, sb; };

__device__ __forceinline__ bool tile_of(int L, int nM, int nN, int& pm, int& pn, int WGM = 4) {
    const int nwg = nM * nN; if (L >= nwg) return false;
    int wgid = L; { const int q = nwg / NXCD, r = nwg % NXCD, xcd = wgid % NXCD, off = wgid / NXCD; wgid = (xcd < r ? xcd * (q + 1) : r * (q + 1) + (xcd - r) * q) + off; }
    const int nig = WGM * nN, gid = wgid / nig, fm = gid * WGM, gsz = (nM - fm) < WGM ? (nM - fm) : WGM;
    pm = fm + ((wgid % nig) % gsz); pn = (wgid % nig) / gsz; return true;
}
struct PlainSched {
    int nM, nN, G, c; const char* A0; const char* B0; size_t astep, bstep; int wgm;
    __device__ __forceinline__ bool next(int i, Unit& u) const { int pm, pn; if (!tile_of(i * G + c, nM, nN, pm, pn, wgm)) return false; u.pm = pm; u.pn = pn; u.aux = 0; u.A = A0 + (size_t)pm * astep; u.B = B0 + (size_t)pn * bstep; return true; }
};
struct PoolSched {
    int G, c; const char* A0; const char* B0;
    __device__ __forceinline__ bool next(int i, Unit& u) const { int pm, pn; if (!tile_of(i * G + c, M / 256, 4, pm, pn)) return false; u.pm = pm; u.pn = pn; u.aux = 0;
        u.A = A0 + (size_t)pm * (256 * 1024 * 2) + (size_t)pn * 512; u.B = B0 + (size_t)pn * (256 * 256 * 2); return true; }
};
struct MergeSched {
    int G, c; const char *A0, *B0, *B2; size_t astr, bstr;
    __device__ __forceinline__ bool next(int i, Unit& u) const { const int t = i / 3, b = i - 3 * t; int pm, pn; if (!tile_of(t * G + c, M / 256, 4, pm, pn)) return false; u.pm = pm; u.pn = pn; u.aux = b;
        const char* w = b == 2 ? B2 : B0 + (size_t)b * bstr;
        u.A = A0 + (size_t)b * astr + (size_t)pm * (256 * 1024 * 2); u.B = w + (size_t)pn * (256 * 1024 * 2); return true; }
};
struct FoldSched {
    int G, c; const char *A0, *B0;
    __device__ __forceinline__ bool next(int i, Unit& u) const { const int idx = i * G + c; if (idx >= 32) return false; const int L = idx >> 4, pm = (idx >> 2) & 3, g = idx & 3; u.pm = pm; u.pn = g; u.aux = L;
        u.A = A0 + (size_t)L * (6 * MiB) + (size_t)pm * (256 * 1024 * 2) + (size_t)g * 512; u.B = B0 + (size_t)L * (512 * 1024) + (size_t)g * (256 * 256 * 2); return true; }
};
struct GroupSched {
    int nM, nN, G, c; int o1, o2, o3, o4, o5, o6, o7; const char* A0; const char* B0; size_t astep, bstep, estep; int wgm;
    __device__ __forceinline__ bool next(int i, Unit& u) const { int pm, pn; if (!tile_of(i * G + c, nM, nN, pm, pn, wgm)) return false; u.pm = pm; u.pn = pn; u.aux = 0;
        const int e = (pm >= o1) + (pm >= o2) + (pm >= o3) + (pm >= o4) + (pm >= o5) + (pm >= o6) + (pm >= o7);
        u.A = A0 + (size_t)pm * astep; u.B = B0 + (size_t)e * estep + (size_t)pn * bstep; return true; }
};

typedef f32x4 Acc[2][2][4][2];
__device__ __forceinline__ u32x4 pack8(const f32x4 v0, const f32x4 v1) { u32x4 w; w.x = pk_bf16(v0[0], v0[1]); w.y = pk_bf16(v0[2], v0[3]); w.z = pk_bf16(v1[0], v1[1]); w.w = pk_bf16(v1[2], v1[3]); return w; }
__device__ __forceinline__ f32x4 sig4(const f32x4 v) { f32x4 r; r[0] = sigm(v[0]); r[1] = sigm(v[1]); r[2] = sigm(v[2]); r[3] = sigm(v[3]); return r; }
__device__ __forceinline__ void unpack8(const u32x4 g, f32x4& lo, f32x4& hi) { lo[0] = bf_lo(g.x); lo[1] = bf_hi(g.x); lo[2] = bf_lo(g.y); lo[3] = bf_hi(g.y); hi[0] = bf_lo(g.z); hi[1] = bf_hi(g.z); hi[2] = bf_lo(g.w); hi[3] = bf_hi(g.w); }

__device__ __forceinline__ size_t gate_frag(int pm, int q, int wid, int ai, int m, int bj, int lane) { return ((size_t)((((((pm * 12 + q) * 8 + wid) * 2 + ai) * 4 + m) * 2 + bj) * 64 + lane)) * 16; }
struct EpiProj {
    bf16_t *scb, *scx, *glu, *pu, *gates; const f32x4* ss;
    __device__ __forceinline__ bool operator()(Acc& acc, const Unit& u, int wr, int wc, int fr, int fq) const {
        const int row0 = u.pm * BM + wr * 64 + fr, pn = u.pn;
        float rs[2][4];
#pragma unroll
        for (int ai = 0; ai < 2; ++ai)
#pragma unroll
            for (int m = 0; m < 4; ++m) { const f32x4 p = ss[row0 + ai * HALF + m * 16]; rs[ai][m] = __builtin_amdgcn_rsqf(((p[0] + p[1]) + (p[2] + p[3])) * (1.0f / D) + RMS_EPS); }
        if (pn >= 4 && pn < 20) {
            const bool isglu = pn >= 12; bf16_t* dst = isglu ? glu : scx; const int col0 = (isglu ? pn - 12 : pn - 4) * 128 + wc * 32 + 8 * fq;
#pragma unroll
            for (int ai = 0; ai < 2; ++ai)
#pragma unroll
                for (int m = 0; m < 4; ++m) { const float r = rs[ai][m];
                    f32x4 a0 = acc[ai][0][m][0] * r, a1 = acc[ai][0][m][1] * r, b0 = acc[ai][1][m][0] * r, b1 = acc[ai][1][m][1] * r;
                    if (isglu) { b0 = sig4(b0); b1 = sig4(b1); }
                    *(u32x4*)(dst + (size_t)(row0 + ai * HALF + m * 16) * D + col0) = pack8(a0 * b0, a1 * b1); }
        } else {
            if (pn >= 24) {
#pragma unroll
                for (int ai = 0; ai < 2; ++ai)
#pragma unroll
                    for (int m = 0; m < 4; ++m) { const float r = rs[ai][m];
#pragma unroll
                        for (int bj = 0; bj < 2; ++bj) { f32x4 e0 = acc[ai][bj][m][0] * r, e1 = acc[ai][bj][m][1] * r;
#pragma unroll
                            for (int j = 0; j < 4; ++j) { e0[j] = __builtin_amdgcn_exp2f(-1.44269504f * __builtin_amdgcn_fmed3f(e0[j], -30.f, 30.f)); e1[j] = __builtin_amdgcn_exp2f(-1.44269504f * __builtin_amdgcn_fmed3f(e1[j], -30.f, 30.f)); }
                            *(u32x4*)((unsigned char*)gates + gate_frag(u.pm, pn - 24, wr * 4 + wc, ai, m, bj, fr + 16 * fq)) = pack8(e0, e1); } }
            } else {
            bf16_t* dst = pn < 4 ? scb : pu; const int ldc = D, colb = (pn < 4 ? pn : pn - 20) * 256;
            const int col0 = colb + wc * 32 + 8 * fq;
#pragma unroll
            for (int ai = 0; ai < 2; ++ai)
#pragma unroll
                for (int m = 0; m < 4; ++m) { const float r = rs[ai][m]; bf16_t* rowp = dst + (size_t)(row0 + ai * HALF + m * 16) * ldc + col0;
#pragma unroll
                    for (int bj = 0; bj < 2; ++bj) *(u32x4*)(rowp + bj * HALF) = pack8(acc[ai][bj][m][0] * r, acc[ai][bj][m][1] * r); }
            }
        }
        return false;
    }
};
struct EpiPlain {
    bf16_t* Ob; int ldc; size_t aux_stride;
    __device__ __forceinline__ bool operator()(Acc& acc, const Unit& u, int wr, int wc, int fr, int fq) const {
        bf16_t* O = Ob + (size_t)u.aux * aux_stride;
        const int row0 = u.pm * BM + wr * 64 + fr, col0 = u.pn * BM + wc * 32 + 8 * fq;
#pragma unroll
        for (int ai = 0; ai < 2; ++ai)
#pragma unroll
            for (int m = 0; m < 4; ++m) { bf16_t* rowp = O + (size_t)(row0 + ai * HALF + m * 16) * ldc + col0;
#pragma unroll
                for (int bj = 0; bj < 2; ++bj) *(u32x4*)(rowp + bj * HALF) = pack8(acc[ai][bj][m][0], acc[ai][bj][m][1]); }
        return false;
    }
};
struct EpiMerge {
    const bf16_t* gates; bf16_t* O;
    __device__ __forceinline__ bool operator()(Acc& acc, const Unit& u, int wr, int wc, int fr, int fq) const {
        const int row0 = u.pm * BM + wr * 64 + fr, col0 = u.pn * BM + wc * 32 + 8 * fq, b = u.aux;
#pragma unroll
        for (int ai = 0; ai < 2; ++ai)
#pragma unroll
            for (int m = 0; m < 4; ++m) { const size_t row = (size_t)(row0 + ai * HALF + m * 16);
#pragma unroll
                for (int bj = 0; bj < 2; ++bj) { const unsigned char* gp = (const unsigned char*)gates + gate_frag(u.pm, 4 * b + u.pn, wr * 4 + wc, ai, m, bj, fr + 16 * fq);
                    f32x4 g0, g1; unpack8(*(const u32x4*)gp, g0, g1);
                    if (b < 2) { f32x4 h0, h1; unpack8(*(const u32x4*)(gp + gate_frag(0, 4, 0, 0, 0, 0, 0)), h0, h1);
#pragma unroll
                        for (int j = 0; j < 4; ++j) { acc[ai][bj][m][0][j] *= (1.f + h0[j]) * __builtin_amdgcn_rcpf(1.f + g0[j]); acc[ai][bj][m][1][j] *= (1.f + h1[j]) * __builtin_amdgcn_rcpf(1.f + g1[j]); }
                    } else {
#pragma unroll
                        for (int j = 0; j < 4; ++j) { g0[j] = __builtin_amdgcn_rcpf(1.f + g0[j]); g1[j] = __builtin_amdgcn_rcpf(1.f + g1[j]); }
                        *(u32x4*)(O + row * D + col0 + bj * HALF) = pack8(acc[ai][bj][m][0] * g0, acc[ai][bj][m][1] * g1); } } }
        return b < 2;
    }
};
struct EpiResid {
    const float* base32; bf16_t* xb; float* ssp; LAS float* red;
    __device__ __forceinline__ bool operator()(Acc& acc, const Unit& u, int wr, int wc, int fr, int fq) const {
        const int row0 = u.pm * BM + wr * 64 + fr, col0 = u.pn * BM + wc * 32 + 8 * fq;
#pragma unroll
        for (int ai = 0; ai < 2; ++ai)
#pragma unroll
            for (int m = 0; m < 4; ++m) { const size_t row = (size_t)(row0 + ai * HALF + m * 16); float q = 0.f;
#pragma unroll
                for (int bj = 0; bj < 2; ++bj) { const size_t off = row * D + col0 + bj * HALF;
                    f32x4 b0, b1; if (base32) { b0 = *(const f32x4*)(base32 + off); b1 = *(const f32x4*)(base32 + off + 4); } else unpack8(*(const u32x4*)(xb + off), b0, b1);
                    const u32x4 pk = pack8(b0 + acc[ai][bj][m][0], b1 + acc[ai][bj][m][1]); *(u32x4*)(xb + off) = pk;
                    f32x4 o0, o1; unpack8(pk, o0, o1);
                    q += (o0[0] * o0[0] + o0[1] * o0[1]) + (o0[2] * o0[2] + o0[3] * o0[3]) + (o1[0] * o1[0] + o1[1] * o1[1]) + (o1[2] * o1[2] + o1[3] * o1[3]); }
                q += __shfl_xor(q, 16); q += __shfl_xor(q, 32);
                if (fq == 0) red[(ai * HALF + wr * 64 + m * 16 + fr) * 4 + wc] = q; }
        asm volatile("s_waitcnt lgkmcnt(0)" ::: "memory"); __builtin_amdgcn_s_barrier(); asm volatile("" ::: "memory");
        int tid = threadIdx.x; asm volatile("" : "+v"(tid));
        if (tid < 256) { const f32x4 v = *(const LAS f32x4*)(red + tid * 4); ssp[(size_t)(u.pm * BM + tid) * 4 + u.pn] = (v[0] + v[1]) + (v[2] + v[3]); }
        return false;
    }
};
template <bool PART4, bool OUT8> struct EpiSwiGLU {
    bf16_t* O; int ldc; const float* ss;
    __device__ __forceinline__ bool operator()(Acc& acc, const Unit& u, int wr, int wc, int fr, int fq) const {
        const int row0 = u.pm * BM + wr * 64 + fr, col0 = u.pn * 128 + wc * 32 + 8 * fq;
#pragma unroll
        for (int ai = 0; ai < 2; ++ai)
#pragma unroll
            for (int m = 0; m < 4; ++m) { const size_t row = (size_t)(row0 + ai * HALF + m * 16); float r = 1.f;
                if (PART4) { const f32x4 p = *(const f32x4*)(ss + row * 4); r = __builtin_amdgcn_rsqf(((p[0] + p[1]) + (p[2] + p[3])) * (1.0f / D) + RMS_EPS); }
                const f32x4 a0 = acc[ai][0][m][0] * r, a1 = acc[ai][0][m][1] * r, c0 = acc[ai][1][m][0] * r, c1 = acc[ai][1][m][1] * r;
                const f32x4 h0 = a0 * sig4(a0) * c0, h1 = a1 * sig4(a1) * c1;
                if (OUT8) { *(u32x2*)((unsigned char*)O + row * ldc + col0) = (u32x2){pk_fp8x4(h0 * F8_ACT_MUL), pk_fp8x4(h1 * F8_ACT_MUL)}; }
                else *(u32x4*)(O + row * ldc + col0) = pack8(h0, h1); }
        return false;
    }
};

typedef int i32x4 __attribute__((ext_vector_type(4)));
typedef int i32x8 __attribute__((ext_vector_type(8)));
__device__ __forceinline__ i32x8 join16(const bf16x8 lo, const bf16x8 hi) { return __builtin_shufflevector(__builtin_bit_cast(i32x4, lo), __builtin_bit_cast(i32x4, hi), 0, 1, 2, 3, 4, 5, 6, 7); }
template <class Epi, class Sched, bool F8 = false>
__device__ __forceinline__ void gemm_phase(LAS unsigned char* lds, const Gemm g, const Sched& S, const Epi& E) {
    int tid_ = threadIdx.x; asm volatile("" : "+v"(tid_));
    const int tid = tid_, wid = __builtin_amdgcn_readfirstlane(tid >> 6), lane = tid & 63, wr = wid >> 2, wc = wid & 3, fr = lane & 15, fq = lane >> 4;
    const int nt = g.Kb / 128;
    int vsa = g.sa, vsb = g.sb; asm volatile("" : "+v"(vsa), "+v"(vsb));
    unsigned voffA[2], voffB[2];
#pragma unroll
    for (int i = 0; i < 2; ++i) { int R, C; stage_rc(tid * 16 + i * 8192, R, C); const int Rb = (R & ~31) + perm32(R & 31);
        voffA[i] = (unsigned)(R * g.lda + C * 2); voffB[i] = (unsigned)(Rb * g.ldb + C * 2); }
    const size_t kstep = (size_t)(BK * 2);
    const size_t hstepA = (size_t)HALF * g.lda, hstepB = (size_t)HALF * g.ldb;
    const unsigned ldsw = (unsigned)wid * 1024u;
    const int aoff = lds_byte(wr * 64 + fr, fq * 8), boff = lds_byte(wc * 32 + fr, fq * 8);
#define PG8_SA(b, h) (((b) * 2 + (h)) * HTB)
#define PG8_SB(b, h) ((4 + (b) * 2 + (h)) * HTB)
#define PG8_STAGE(bufoff, gbase, voff) do { _Pragma("unroll") for (int _i = 0; _i < 2; ++_i) \
        __builtin_amdgcn_global_load_lds((const unsigned*)((const char*)(gbase) + (voff)[_i]), (LAS unsigned*)(lds + (bufoff) + ldsw + _i * 8192), 16, 0, 0); } while (0)
#define PG8_LDA(dst, b, h) do { _Pragma("unroll") for (int m = 0; m < 4; ++m) _Pragma("unroll") for (int k = 0; k < 2; ++k) dst[m][k] = *(const LAS bf16x8*)(lds + PG8_SA(b, h) + aoff + m * 2048 + k * 1024); } while (0)
#define PG8_LDB(dst, b, h) do { _Pragma("unroll") for (int n = 0; n < 2; ++n) _Pragma("unroll") for (int k = 0; k < 2; ++k) dst[n][k] = *(const LAS bf16x8*)(lds + PG8_SB(b, h) + boff + n * 2048 + k * 1024); } while (0)
#define PG8_MMA(ai, bj, At, Bt) do { __builtin_amdgcn_s_setprio(1); _Pragma("unroll") for (int m = 0; m < 4; ++m) _Pragma("unroll") for (int n = 0; n < 2; ++n) { \
        if constexpr (F8) { const i32x8 b8_ = join16(Bt[n][0], Bt[n][1]), a8_ = join16(At[m][0], At[m][1]); \
            asm volatile("v_mfma_scale_f32_16x16x128_f8f6f4 %0, %1, %2, %0, %3, %4 op_sel_hi:[0,0,0]" : "+v"(acc[ai][bj][m][n]) : "v"(b8_), "v"(a8_), "v"(vsb), "v"(vsa)); } \
        else { _Pragma("unroll") for (int k = 0; k < 2; ++k) acc[ai][bj][m][n] = __builtin_amdgcn_mfma_f32_16x16x32_bf16(Bt[n][k], At[m][k], acc[ai][bj][m][n], 0, 0, 0); } } __builtin_amdgcn_s_setprio(0); } while (0)
#define PG8_WAIT_V(n) asm volatile("s_waitcnt vmcnt(" #n ")" ::: "memory")
#define PG8_WAIT_L(n) asm volatile("s_waitcnt lgkmcnt(" #n ")" ::: "memory")
#define PG8_BAR __builtin_amdgcn_s_barrier()
#define PG8_SCHED __builtin_amdgcn_sched_barrier(0)
    Unit cur, nxt; int ui = 0;
    if (!S.next(0, cur)) return;
    Acc acc;
#pragma unroll
    for (int a = 0; a < 2; ++a)
#pragma unroll
        for (int b = 0; b < 2; ++b)
#pragma unroll
            for (int m = 0; m < 4; ++m)
#pragma unroll
                for (int n = 0; n < 2; ++n) acc[a][b][m][n] = (f32x4){0.f, 0.f, 0.f, 0.f};
    bf16x8 At[4][2], B0[2][2], B1[2][2];
    const char* cA = cur.A; const char* cB = cur.B;
    PG8_STAGE(PG8_SB(0, 0), cB, voffB); PG8_STAGE(PG8_SB(0, 1), cB + hstepB, voffB); PG8_STAGE(PG8_SA(0, 0), cA, voffA); PG8_STAGE(PG8_SA(0, 1), cA + hstepA, voffA);
    if (wr == 1) PG8_BAR;
    PG8_WAIT_V(2); PG8_BAR;
    PG8_STAGE(PG8_SB(1, 0), cB + kstep, voffB); PG8_STAGE(PG8_SA(1, 0), cA + kstep, voffA); PG8_STAGE(PG8_SB(1, 1), cB + hstepB + kstep, voffB);
    PG8_WAIT_V(6); PG8_BAR;
    for (;;) {
        const bool has_next = S.next(ui + 1, nxt);
        const char* nA = has_next ? nxt.A : cA; const char* nB = has_next ? nxt.B : cB;
#pragma nounroll
        for (int t = 0; t < nt; t += 2) {
            const bool last = (t == nt - 2);
            const char* a1 = cA + (size_t)(t + 1) * kstep;
            const char* a2 = last ? nA : cA + (size_t)(t + 2) * kstep; const char* b2 = last ? nB : cB + (size_t)(t + 2) * kstep;
            const char* a3 = a2 + kstep; const char* b3 = b2 + kstep;
            PG8_LDB(B0, 0, 0); PG8_LDB(B1, 0, 1); PG8_SCHED; PG8_LDA(At, 0, 0); PG8_STAGE(PG8_SA(1, 1), a1 + hstepA, voffA);
            PG8_WAIT_V(8); PG8_WAIT_L(0); PG8_BAR; PG8_MMA(0, 0, At, B0); PG8_MMA(0, 1, At, B1); PG8_BAR; PG8_SCHED;
            PG8_LDA(At, 0, 1); PG8_STAGE(PG8_SB(0, 0), b2, voffB); PG8_STAGE(PG8_SB(0, 1), b2 + hstepB, voffB); PG8_STAGE(PG8_SA(0, 0), a2, voffA);
            PG8_WAIT_V(8); PG8_WAIT_L(0); PG8_BAR; PG8_MMA(1, 0, At, B0); PG8_MMA(1, 1, At, B1); PG8_BAR; PG8_SCHED;
            PG8_LDB(B0, 1, 0); PG8_LDB(B1, 1, 1); PG8_SCHED; PG8_LDA(At, 1, 0); PG8_STAGE(PG8_SA(0, 1), a2 + hstepA, voffA);
            PG8_WAIT_V(8); PG8_WAIT_L(0); PG8_BAR; PG8_MMA(0, 0, At, B0); PG8_MMA(0, 1, At, B1); PG8_BAR; PG8_SCHED;
            PG8_LDA(At, 1, 1); PG8_STAGE(PG8_SB(1, 0), b3, voffB); PG8_STAGE(PG8_SB(1, 1), b3 + hstepB, voffB); PG8_STAGE(PG8_SA(1, 0), a3, voffA);
            PG8_WAIT_V(8); PG8_WAIT_L(0); PG8_BAR; PG8_MMA(1, 0, At, B0); PG8_MMA(1, 1, At, B1); PG8_BAR; PG8_SCHED;
        }
        if constexpr (F8) asm volatile("s_nop 15\n\ts_nop 15" ::: "memory");
        if (wr == 0) PG8_BAR;
        const bool keep = E(acc, cur, wr, wc, fr, fq);
        if (!has_next) break;
        if (!keep) {
#pragma unroll
            for (int a = 0; a < 2; ++a)
#pragma unroll
                for (int b = 0; b < 2; ++b)
#pragma unroll
                    for (int m = 0; m < 4; ++m)
#pragma unroll
                        for (int n = 0; n < 2; ++n) acc[a][b][m][n] = (f32x4){0.f, 0.f, 0.f, 0.f};
        }
        cur = nxt; cA = nA; cB = nB; ++ui;
        if (wr == 1) PG8_BAR;
    }
    PG8_WAIT_V(0);
    PG8_BAR;
#undef PG8_SA
#undef PG8_SB
#undef PG8_STAGE
#undef PG8_LDA
#undef PG8_LDB
#undef PG8_MMA
#undef PG8_WAIT_V
#undef PG8_WAIT_L
#undef PG8_BAR
#undef PG8_SCHED
}
}

constexpr int RING_BYTES = 131072, MISC_OFF = RING_BYTES, RED_OFF = RING_BYTES + 1024, LDS_BYTES = 147456;

#define XB_TMO      128
#define XB_XCNT(j)  (256  + 64 * (j))
#define XB_XSUB(j)  (1280 + 64 * (j))
#define XB_XGEN(j)  (2304 + 64 * (j))
#define XB_TOP      3328
#define XB_TOPGEN   3392
#define XCD_BAR_WORDS 3456
#define XB_SPIN_CAP (1u << 18)
__device__ __forceinline__ unsigned xb_ld(unsigned* p)              { return __hip_atomic_load(p, __ATOMIC_RELAXED, __HIP_MEMORY_SCOPE_AGENT); }
__device__ __forceinline__ unsigned xb_add(unsigned* p, unsigned v) { return __hip_atomic_fetch_add(p, v, __ATOMIC_RELAXED, __HIP_MEMORY_SCOPE_AGENT); }
__device__ __forceinline__ unsigned xb_xcc_id() { return (unsigned)__builtin_amdgcn_s_getreg((3 << 11) | 20) & 0xFu; }
#define XB_SPIN(cond, bar) do { unsigned _sp = 0; while (cond) { __builtin_amdgcn_s_sleep(1); \
    if ((++_sp & 255u) == 0u) { if (xb_ld(&(bar)[XB_TMO])) break; if (_sp > XB_SPIN_CAP) { atomicAdd(&(bar)[XB_TMO], 1u); break; } } } } while (0)
struct XcdBarrier { unsigned* bar; unsigned x; volatile LAS unsigned* st; };
__device__ __forceinline__ XcdBarrier xcd_barrier_post(unsigned* bar, volatile LAS unsigned* st) {
    XcdBarrier b; b.bar = bar; b.x = xb_xcc_id(); b.st = st;
    if (threadIdx.x == 0) (void)xb_add(&bar[XB_XCNT(b.x)], 1u);
    return b;
}
__device__ __forceinline__ void xcd_barrier_complete(unsigned* bar, unsigned x, unsigned& nloc, unsigned& nx) {
    const unsigned G = gridDim.x * gridDim.y * gridDim.z;
    unsigned sum, cnt, mine, sp = 0u;
    for (;;) {
        sum = 0u; cnt = 0u; mine = 0u;
#pragma nounroll
        for (unsigned j = 0; j < 16; ++j) { const unsigned c = xb_ld(&bar[XB_XCNT(j)]); sum += c; cnt += (c > 0u) ? 1u : 0u; mine = (j == x) ? c : mine; }
        if (sum == G) break;
        __builtin_amdgcn_s_sleep(1);
        if ((++sp & 255u) == 0u) { if (xb_ld(&bar[XB_TMO])) break; if (sp > XB_SPIN_CAP) { atomicAdd(&bar[XB_TMO], 1u); break; } }
    }
    nloc = mine > 0u ? mine : 1u; nx = cnt > 0u ? cnt : 1u;
}
__device__ __forceinline__ void xcd_barrier(const XcdBarrier& b) {
    asm volatile("s_waitcnt vmcnt(0)" ::: "memory");
    __syncthreads();
    if (threadIdx.x == 0) {
        unsigned* bar = b.bar;
        __builtin_amdgcn_s_waitcnt(0);
        unsigned nloc = b.st[0], nx = b.st[1];
        if (nloc == 0u) { xcd_barrier_complete(bar, b.x, nloc, nx); b.st[0] = nloc; b.st[1] = nx; }
        const unsigned old = xb_add(&bar[XB_XSUB(b.x)], 1u);
        const unsigned gen = old / nloc;
        if (old + 1u == (gen + 1u) * nloc) {
            __builtin_amdgcn_fence(__ATOMIC_RELEASE, "agent");
            asm volatile("s_waitcnt vmcnt(0)" ::: "memory");
            const unsigned og = xb_add(&bar[XB_TOP], 1u);
            const unsigned tg = og / nx;
            if (og + 1u == (tg + 1u) * nx) xb_add(&bar[XB_TOPGEN], 1u);
            else XB_SPIN(xb_ld(&bar[XB_TOPGEN]) == tg, bar);
            __builtin_amdgcn_fence(__ATOMIC_ACQUIRE, "agent");
            xb_add(&bar[XB_XGEN(b.x)], 1u);
            asm volatile("s_waitcnt vmcnt(0)" ::: "memory");
        } else {
            XB_SPIN(xb_ld(&bar[XB_XGEN(b.x)]) == gen, bar);
            __builtin_amdgcn_fence(__ATOMIC_ACQUIRE, "agent");
            asm volatile("s_waitcnt vmcnt(0)" ::: "memory");
        }
    }
    __syncthreads();
}

struct Args { const float* in[23]; float* out; unsigned char* ws; int ph_lo, ph_hi; };
static_assert(sizeof(Args) == 23 * 8 + 8 + 8 + 8, "Args has no padding");
typedef const __attribute__((address_space(4))) Args* KArgs;
__device__ __forceinline__ KArgs kargs() { KArgs p = (KArgs)__builtin_amdgcn_kernarg_segment_ptr(); asm volatile("" : "+s"(p)); return p; }

__device__ __forceinline__ void transpose_item(const float* src, int ldn, int k0, int n0, bf16_t* dst, int ldk, const float* kscale, const float* nscale, int lane) {
    const int r4 = lane >> 4, q = lane & 15;
    f32x4 v[16];
    const float* sp = src + (size_t)(k0 + 16 * r4) * ldn + n0 + 4 * q;
#pragma unroll
    for (int i = 0; i < 16; ++i) v[i] = __builtin_nontemporal_load((const f32x4*)(sp + (size_t)i * ldn));
    f32x4 ns = (f32x4){1.f, 1.f, 1.f, 1.f}; if (nscale) ns = *(const f32x4*)(nscale + n0 + 4 * q);
    if (kscale) {
        const f32x4* kp = (const f32x4*)(kscale + k0 + 16 * r4);
#pragma unroll
        for (int g = 0; g < 4; ++g) { const f32x4 ks = kp[g];
#pragma unroll
            for (int j = 0; j < 4; ++j) v[4 * g + j] = v[4 * g + j] * ks[j]; }
    }
#pragma unroll
    for (int e = 0; e < 4; ++e) { u32x4 lo, hi;
#pragma unroll
        for (int w = 0; w < 4; ++w) { lo[w] = pk_bf16(v[2 * w][e] * ns[e], v[2 * w + 1][e] * ns[e]); hi[w] = pk_bf16(v[8 + 2 * w][e] * ns[e], v[9 + 2 * w][e] * ns[e]); }
        bf16_t* o = dst + (size_t)(4 * q + e) * ldk + k0 + 16 * r4; *(u32x4*)o = lo; *(u32x4*)(o + 8) = hi; }
}
__device__ __forceinline__ void transpose_item_f8(const float* src, int ldn, int k0, int n0, unsigned char* dst, int ldk, const float* kscale, float mul, int lane) {
    const int r4 = lane >> 4, q = lane & 15;
    f32x4 v[16];
    const float* sp = src + (size_t)(k0 + 16 * r4) * ldn + n0 + 4 * q;
#pragma unroll
    for (int i = 0; i < 16; ++i) v[i] = __builtin_nontemporal_load((const f32x4*)(sp + (size_t)i * ldn));
    {
        const f32x4* kp = (const f32x4*)(kscale + k0 + 16 * r4);
#pragma unroll
        for (int g = 0; g < 4; ++g) { f32x4 ks = (f32x4){mul, mul, mul, mul}; if (kscale) ks = kp[g] * mul;
#pragma unroll
            for (int j = 0; j < 4; ++j) v[4 * g + j] = v[4 * g + j] * ks[j]; }
    }
#pragma unroll
    for (int e = 0; e < 4; ++e) { u32x4 o;
#pragma unroll
        for (int w = 0; w < 4; ++w) o[w] = pk_fp8x4((f32x4){v[4 * w][e], v[4 * w + 1][e], v[4 * w + 2][e], v[4 * w + 3][e]});
        *(u32x4*)(dst + (size_t)(4 * q + e) * ldk + k0 + 16 * r4) = o; }
}
__device__ __forceinline__ int win_row(int n0) {
    const int seg = n0 >> 10, c = n0 & 1023;
    if (seg == 1 || seg == 2) return 1024 + (c >> 7) * 256 + (seg == 2 ? 128 : 0) + (c & 127);
    if (seg == 3 || seg == 4) return 3072 + (c >> 7) * 256 + (seg == 4 ? 128 : 0) + (c & 127);
    return n0;
}
__device__ __forceinline__ int pair_row(int f, int second) { return (f >> 7) * 256 + (second ? 128 : 0) + (f & 127); }

__device__ __forceinline__ void prologue_phase(KArgs a, LAS unsigned char* lds, int wid, int lane) {
    asm volatile("" : "+v"(lane));
    const int gw = blockIdx.x * 8 + wid, NGW = gridDim.x * 8;
    unsigned char* ws = a->ws;
    constexpr int I_WIN = 16 * 144, I_SQ = 16 * 16, I_PW = 16, I_D1 = 16 * 56, I_D2 = 56 * 16;
    constexpr int NIT = 2 * I_WIN + 8 * I_SQ + 8 * I_PW + 2 * I_D1 + I_D2;
    for (int it = gw; it < NIT; it += NGW) {
        int r = it;
        if (r < 2 * I_WIN) { const int L = r / I_WIN; r -= L * I_WIN; const int kb = r / 144, nb = r % 144, n0 = 64 * nb;
            transpose_item(a->in[2] + (size_t)L * D * INC, INC, 64 * kb, n0, (bf16_t*)(ws + WS_W0 + W0_WIN + (size_t)L * 18 * MiB) + (size_t)win_row(n0) * D, D, a->in[1] + L * D, nullptr, lane); continue; }
        r -= 2 * I_WIN;
        if (r < 8 * I_SQ) { const int j = r / I_SQ; r -= j * I_SQ; const int L = j >> 2, w = j & 3, kb = r / 16, nb = r % 16, n0 = 64 * nb;
            bf16_t* dst = w < 3 ? (bf16_t*)(ws + WS_W0 + W0_WOUT + (size_t)(L * 3 + w) * 2 * MiB) : (bf16_t*)(ws + WS_W0 + W0_WO + (size_t)L * 2 * MiB);
            transpose_item(a->in[10 + w] + (size_t)L * D * D, D, 64 * kb, n0, dst + (size_t)n0 * D, D, nullptr, nullptr, lane); continue; }
        r -= 8 * I_SQ;
        if (r < 8 * I_PW) { const int j = r / I_PW; r -= j * I_PW; const int L = j >> 2, g = j & 3;
            const float* src = a->in[8] + (size_t)(L * 4 + g) * 65536 + (size_t)r * 16 * 256; const float* sc = a->in[9] + L * D + g * 256;
            bf16_t* dst = (bf16_t*)(ws + WS_W0 + W0_POOL + (size_t)L * 512 * 1024) + (size_t)g * 65536 + (size_t)r * 16 * 256; const f32x4 s4 = *(const f32x4*)(sc + 4 * lane);
#pragma unroll
            for (int i = 0; i < 16; ++i) { const f32x4 v = *(const f32x4*)(src + i * 256 + 4 * lane) * s4; u32x2 w; w.x = pk_bf16(v[0], v[1]); w.y = pk_bf16(v[2], v[3]); *(u32x2*)(dst + i * 256 + 4 * lane) = w; }
            continue; }
        r -= 8 * I_PW;
        if (r < 2 * I_D1) { const int w = r / I_D1; r -= w * I_D1; const int kb = r / 56, nb = r % 56, n0 = 64 * nb;
            transpose_item(a->in[15 + w], DFF, 64 * kb, n0, (bf16_t*)(ws + WS_W0 + W0_D13) + (size_t)pair_row(n0, w) * D, D, a->in[14], nullptr, lane); continue; }
        r -= 2 * I_D1;
        { const int kb = r / 16, nb = r % 16, n0 = 64 * nb;
            transpose_item(a->in[17], D, 64 * kb, n0, (bf16_t*)(ws + WS_W0 + W0_D2) + (size_t)n0 * DFF, DFF, nullptr, nullptr, lane); }
    }
    const float* x = a->in[0]; bf16_t* xb = (bf16_t*)(ws + WS_XB); f32x4* ss0 = (f32x4*)(ws + WS_SS);
    for (int m = gw; m < M; m += NGW) {
        const f32x4* xr = (const f32x4*)(x + (size_t)m * D) + lane; u32x2* o = (u32x2*)(xb + (size_t)m * D) + lane; float s = 0.f;
#pragma unroll
        for (int j = 0; j < 4; ++j) { const f32x4 v = xr[64 * j]; s += (v[0] * v[0] + v[1] * v[1]) + (v[2] * v[2] + v[3] * v[3]); u32x2 w; w.x = pk_bf16(v[0], v[1]); w.y = pk_bf16(v[2], v[3]); o[64 * j] = w; }
        s = wave_sum(s); if (lane == 0) ss0[m] = (f32x4){s, 0.f, 0.f, 0.f};
    }
}

__device__ __forceinline__ void dma_block16(const bf16_t* src, LAS unsigned char* dst, int wid, int lane) {
#pragma unroll
    for (int k = 0; k < 4; ++k) { const int h = wid * 4 + k;
        __builtin_amdgcn_global_load_lds((const unsigned*)((const char*)src + h * 1024 + lane * 16), (LAS unsigned*)(dst + h * 1024), 16, 0, 0); }
}
__device__ __forceinline__ void zero_block16(LAS unsigned char* dst, int tid) {
#pragma unroll
    for (int k = 0; k < 4; ++k) *(LAS u32x4*)(dst + (size_t)(tid + 512 * k) * 16) = (u32x4){0u, 0u, 0u, 0u};
}
template <int I> __device__ __forceinline__ void conv31_pair(const LAS unsigned char* col, const unsigned (&wp)[31], f32x2 bias, f32x2 (&acc)[16]) {
    f32x2 x[46];
#pragma unroll
    for (int i = 0; i < 46; ++i) { const int r = i - 30, j = I + (r >> 4); const unsigned u = *(const LAS unsigned*)(col + ((j + 2) & 3) * 32768 + (r & 15) * 2048); x[i] = (f32x2){bf_lo(u), bf_hi(u)}; }
#pragma unroll
    for (int j = 0; j < 16; ++j) acc[j] = bias;
#pragma unroll
    for (int k = 0; k < 31; ++k) { const f32x2 wk = (f32x2){bf_lo(wp[k]), bf_hi(wp[k])};
#pragma unroll
        for (int j = 0; j < 16; ++j) acc[j] = __builtin_elementwise_fma(wk, x[j + k], acc[j]); }
}
template <int I, int CH> __device__ __forceinline__ void pool_ch(const LAS unsigned char* col, int g, int s0, float (&p)[16]) {
    float x[31], tv[16];
#pragma unroll
    for (int i = 0; i < 31; ++i) { const int r = i - 15, j = I + (r >> 4); const unsigned u = *(const LAS unsigned*)(col + ((j + 1) % 3) * 32768 + (r & 15) * 2048); x[i] = CH ? bf_hi(u) : bf_lo(u); }
#pragma unroll
    for (int j = 0; j < 16; ++j) tv[j] = x[15 + j];
#pragma unroll
    for (int i = 30; i >= 1; --i) x[i] += x[i - 1];
    if (g >= 1) {
#pragma unroll
        for (int i = 30; i >= 2; --i) x[i] += x[i - 2]; }
    if (g >= 2) {
#pragma unroll
        for (int i = 30; i >= 4; --i) x[i] += x[i - 4]; }
    if (g >= 3) {
#pragma unroll
        for (int i = 30; i >= 8; --i) x[i] += x[i - 8]; }
    const int w = 2 << g;
#pragma unroll
    for (int j = 0; j < 16; ++j) { const int cnt = min(s0 + j + 1, w); p[j] = x[15 + j] * (1.0f / (float)cnt) - tv[j]; }
}
struct ConvB { const bf16_t* GLU; __amdgpu_buffer_rsrc_t rVB; LAS unsigned char* lds; LAS float* red; LAS float* stat; f32x2 bb, gg, be; };
template <int I> __device__ __forceinline__ void convB_tile(const ConvB& c, unsigned (&wp)[31], int T0, int tid, int wid, int lane) {
    const int t0 = T0 + 16 * I; const LAS unsigned char* col = c.lds + 4 * tid;
#pragma unroll
    for (int k = 0; k < 31; ++k) asm volatile("" : "+v"(wp[k]));
    if (I < 3) dma_block16(c.GLU + (size_t)(t0 + 16) * D, c.lds + ((I + 3) & 3) * 32768, wid, lane);
    float a0[16], a1[16];
    { f32x2 ap[16]; conv31_pair<I>(col, wp, c.bb, ap);
#pragma unroll
      for (int j = 0; j < 16; ++j) { a0[j] = ap[j].x; a1[j] = ap[j].y; } }
    {
        float v[32];
#pragma unroll
        for (int j = 0; j < 16; ++j) { v[j] = a0[j] + a1[j]; v[16 + j] = a0[j] * a0[j] + a1[j] * a1[j]; }
#pragma unroll
        for (int i = 0; i < 16; ++i) { const bool b = lane & 32; const float send = b ? v[i] : v[i + 16], keep = b ? v[i + 16] : v[i]; v[i] = keep + __shfl_xor(send, 32); }
#pragma unroll
        for (int i = 0; i < 8; ++i) { const bool b = lane & 16; const float send = b ? v[i] : v[i + 8], keep = b ? v[i + 8] : v[i]; v[i] = keep + __shfl_xor(send, 16); }
#pragma unroll
        for (int i = 0; i < 4; ++i) { const bool b = lane & 8; const float send = b ? v[i] : v[i + 4], keep = b ? v[i + 4] : v[i]; v[i] = keep + __shfl_xor(send, 8); }
#pragma unroll
        for (int i = 0; i < 2; ++i) { const bool b = lane & 4; const float send = b ? v[i] : v[i + 2], keep = b ? v[i + 2] : v[i]; v[i] = keep + __shfl_xor(send, 4); }
        { const bool b = lane & 2; const float send = b ? v[0] : v[1], keep = b ? v[1] : v[0]; v[0] = keep + __shfl_xor(send, 2); }
        v[0] += __shfl_xor(v[0], 1);
        const int idx = ((lane >> 5) & 1) * 16 + ((lane >> 4) & 1) * 8 + ((lane >> 3) & 1) * 4 + ((lane >> 2) & 1) * 2 + ((lane >> 1) & 1);
        if (!(lane & 1)) c.red[wid * 32 + idx] = v[0];
    }
    __syncthreads();
    if (tid < 16) { float s = 0.f, q = 0.f;
#pragma unroll
        for (int w = 0; w < 8; ++w) { s += c.red[w * 32 + tid]; q += c.red[w * 32 + 16 + tid]; }
        const float mean = s * (1.0f / D), var = fmaxf(q * (1.0f / D) - mean * mean, 0.f);
        c.stat[2 * tid] = mean; c.stat[2 * tid + 1] = __builtin_amdgcn_rsqf(var + LN_EPS); }
    asm volatile("s_waitcnt vmcnt(0)" ::: "memory");
    __syncthreads();
#pragma unroll
    for (int j = 0; j < 16; ++j) { const float mean = c.stat[2 * j], rstd = c.stat[2 * j + 1];
        const float y0 = (a0[j] - mean) * rstd * c.gg.x + c.be.x, y1 = (a1[j] - mean) * rstd * c.gg.y + c.be.y;
        __builtin_amdgcn_raw_buffer_store_b32(pk_bf16(y0 * sigm(y0), y1 * sigm(y1)), c.rVB, 4 * tid, (t0 + j) * (D * 2), 0); }
}
struct ConvAC { const bf16_t* PU; __amdgpu_buffer_rsrc_t rSCB, rSCX, rYA, rPP; LAS unsigned char* lds; f32x2 s0w, s1w, s2w; };
__device__ __forceinline__ void convAC_load(const ConvAC& c, int t0, int tid, unsigned (&ub)[16], unsigned (&ux)[18]) {
#pragma unroll
    for (int j = 0; j < 16; ++j) ub[j] = __builtin_amdgcn_raw_buffer_load_b32(c.rSCB, 4 * tid, (t0 + j) * (D * 2), 0);
#pragma unroll
    for (int i = 0; i < 18; ++i) ux[i] = __builtin_amdgcn_raw_buffer_load_b32(c.rSCX, 4 * tid, (t0 + 62 + i) * (D * 2), 0);
}
template <int I> __device__ __forceinline__ void convAC_tile(const ConvAC& c, int T0, int tid, int wid, int lane, const unsigned (&ub)[16], const unsigned (&ux)[18], unsigned (&ubn)[16], unsigned (&uxn)[18]) {
    const int t0 = T0 + 16 * I, s0 = t0 & (SEQ - 1); const LAS unsigned char* col = c.lds + 4 * tid;
    if (I < 3) { convAC_load(c, t0 + 16, tid, ubn, uxn); dma_block16(c.PU + (size_t)(t0 + 16) * D, c.lds + ((I + 2) % 3) * 32768, wid, lane); }
    asm volatile("" ::: "memory");
    {
        float x0[18], x1[18];
#pragma unroll
        for (int i = 0; i < 18; ++i) { const unsigned u = (s0 - 2 + i) >= 0 ? ux[i] : 0u; x0[i] = bf_lo(u); x1[i] = bf_hi(u); }
#pragma unroll
        for (int j = 0; j < 16; ++j) {
            const float y0 = bf_lo(ub[j]) * (c.s0w.x * x0[j] + c.s1w.x * x0[j + 1] + c.s2w.x * x0[j + 2]), y1 = bf_hi(ub[j]) * (c.s0w.y * x1[j] + c.s1w.y * x1[j + 1] + c.s2w.y * x1[j + 2]);
            __builtin_amdgcn_raw_buffer_store_b32(pk_bf16(y0, y1), c.rYA, 4 * tid, (t0 + j) * (D * 2), 0); }
    }
    {
        float p0[16], p1[16];
        pool_ch<I, 0>(col, wid >> 1, s0, p0);
#pragma unroll
        for (int j = 0; j < 16; ++j) asm volatile("" : "+v"(p0[j]) :: "memory");
        pool_ch<I, 1>(col, wid >> 1, s0, p1);
#pragma unroll
        for (int j = 0; j < 16; ++j) __builtin_amdgcn_raw_buffer_store_b32(pk_bf16(p0[j], p1[j]), c.rPP, 4 * tid, (t0 + j) * (D * 2), 0);
    }
    if (I < 3) asm volatile("s_waitcnt vmcnt(32)" ::: "memory");
    __syncthreads();
}
__device__ __forceinline__ void conv_phase(KArgs a, int layer, LAS unsigned char* lds, int tid, int wid, int lane) {
    asm volatile("" : "+v"(tid), "+v"(lane));
    unsigned char* ws = a->ws;
    const int G = gridDim.x;
    const int vcu = (G % 8 == 0) ? (int)(blockIdx.x % 8) * (G / 8) + (int)(blockIdx.x / 8) : (int)blockIdx.x;
    const int c2 = 2 * tid;
    {
        const float* cfw = a->in[4] + layer * 31 * D; const float* cfb = a->in[5] + layer * D; const float* lng = a->in[6] + layer * D; const float* lnb = a->in[7] + layer * D;
        ConvB c; c.GLU = (const bf16_t*)(ws + A_GLU); c.rVB = __builtin_amdgcn_make_buffer_rsrc((void*)(ws + A_VB), 0, 0x7fffffff, 0x00020000);
        c.lds = lds; c.red = (LAS float*)(lds + RED_OFF); c.stat = c.red + 256;
        unsigned wp[31];
#pragma unroll
        for (int k = 0; k < 31; ++k) { const f32x2 w = *(const f32x2*)(cfw + k * D + c2); wp[k] = pk_bf16(w.x, w.y); }
        c.bb = *(const f32x2*)(cfb + c2); c.gg = *(const f32x2*)(lng + c2); c.be = *(const f32x2*)(lnb + c2);
        asm volatile("" :: "v"(c.bb.x), "v"(c.bb.y), "v"(c.gg.x), "v"(c.gg.y), "v"(c.be.x), "v"(c.be.y));
        for (int rp2 = 0; rp2 < REPS2(21); ++rp2)
        for (int sup = vcu; sup < M / 64; sup += G) {
            const int T0 = sup * 64; const bool seq0 = (T0 & (SEQ - 1)) == 0;
            if (seq0) { zero_block16(lds, tid); zero_block16(lds + 32768, tid); } else { dma_block16(c.GLU + (size_t)(T0 - 32) * D, lds, wid, lane); dma_block16(c.GLU + (size_t)(T0 - 16) * D, lds + 32768, wid, lane); }
            dma_block16(c.GLU + (size_t)T0 * D, lds + 65536, wid, lane);
            asm volatile("s_waitcnt vmcnt(0)" ::: "memory");
            __syncthreads();
            convB_tile<0>(c, wp, T0, tid, wid, lane); convB_tile<1>(c, wp, T0, tid, wid, lane); convB_tile<2>(c, wp, T0, tid, wid, lane); convB_tile<3>(c, wp, T0, tid, wid, lane);
            __syncthreads();
        }
    }
    __syncthreads();
    {
        const float* scw = a->in[3] + layer * 3 * D;
        ConvAC c; c.PU = (const bf16_t*)(ws + A_PU); c.lds = lds;
        c.rSCB = __builtin_amdgcn_make_buffer_rsrc((void*)(ws + A_SCB), 0, 0x7fffffff, 0x00020000); c.rSCX = __builtin_amdgcn_make_buffer_rsrc((void*)(ws + A_SCX - 64 * D * 2), 0, 0x7fffffff, 0x00020000);
        c.rYA = __builtin_amdgcn_make_buffer_rsrc((void*)(ws + A_YA), 0, 0x7fffffff, 0x00020000); c.rPP = __builtin_amdgcn_make_buffer_rsrc((void*)(ws + A_PP), 0, 0x7fffffff, 0x00020000);
        c.s0w = *(const f32x2*)(scw + c2); c.s1w = *(const f32x2*)(scw + D + c2); c.s2w = *(const f32x2*)(scw + 2 * D + c2);
        asm volatile("" :: "v"(c.s0w.x), "v"(c.s0w.y), "v"(c.s1w.x), "v"(c.s1w.y), "v"(c.s2w.x), "v"(c.s2w.y));
        for (int rp2 = 0; rp2 < REPS2(22); ++rp2)
        for (int sup = vcu; sup < M / 64; sup += G) {
            const int T0 = sup * 64; const bool seq0 = (T0 & (SEQ - 1)) == 0;
            if (seq0) zero_block16(lds, tid); else dma_block16(c.PU + (size_t)(T0 - 16) * D, lds, wid, lane);
            dma_block16(c.PU + (size_t)T0 * D, lds + 32768, wid, lane);
            unsigned ubA[16], uxA[18], ubB[16], uxB[18]; convAC_load(c, T0, tid, ubA, uxA);
            asm volatile("s_waitcnt vmcnt(0)" ::: "memory");
            __syncthreads();
            convAC_tile<0>(c, T0, tid, wid, lane, ubA, uxA, ubB, uxB); convAC_tile<1>(c, T0, tid, wid, lane, ubB, uxB, ubA, uxA); convAC_tile<2>(c, T0, tid, wid, lane, ubA, uxA, ubB, uxB); convAC_tile<3>(c, T0, tid, wid, lane, ubB, uxB, ubA, uxA);
        }
    }
}

__device__ __forceinline__ void route_phase(KArgs a, LAS unsigned char* lds, int tid, int wid, int lane) {
    asm volatile("" : "+v"(tid), "+v"(lane));
    unsigned char* ws = a->ws;
    const bf16_t* X = (const bf16_t*)(ws + WS_XB); const float* gn = a->in[14] + D; const float* R = a->in[18];
    const f32x4* ss3 = (const f32x4*)(ws + WS_SS) + 3 * M;
    int* tope = (int*)(ws + WS_SMALL + SM_TOPE); f32x2* topp = (f32x2*)(ws + WS_SMALL + SM_TOPP); int* cntb = (int*)(ws + WS_CTL + CTL_CNT);
    LAS int* lcnt = (LAS int*)(lds + 98304);
    float wgt[2][8][8];
#pragma unroll
    for (int h = 0; h < 2; ++h)
#pragma unroll
        for (int i = 0; i < 8; ++i) { const int k = 8 * lane + 512 * h + i; const float g = gn[k]; const f32x4 r0 = *(const f32x4*)(R + k * 8), r1 = *(const f32x4*)(R + k * 8 + 4);
#pragma unroll
            for (int e = 0; e < 4; ++e) { wgt[h][i][e] = g * r0[e]; wgt[h][i][4 + e] = g * r1[e]; } }
    for (int vb = blockIdx.x; vb < 256; vb += gridDim.x) {
        if (tid < 8) lcnt[tid] = 0;
        __syncthreads();
        for (int i8 = 0; i8 < 8; ++i8) {
            const int t = vb * 64 + wid * 8 + i8;
            float lg[8];
#pragma unroll
            for (int e = 0; e < 8; ++e) lg[e] = 0.f;
#pragma unroll
            for (int h = 0; h < 2; ++h) { f32x4 v0, v1; pg8::unpack8(*(const u32x4*)(X + (size_t)t * D + 512 * h + 8 * lane), v0, v1);
#pragma unroll
                for (int i = 0; i < 4; ++i)
#pragma unroll
                    for (int e = 0; e < 8; ++e) { lg[e] = fmaf(v0[i], wgt[h][i][e], lg[e]); lg[e] = fmaf(v1[i], wgt[h][4 + i][e], lg[e]); } }
#pragma unroll
            for (int e = 0; e < 8; ++e) lg[e] = wave_sum(lg[e]);
            const f32x4 sp = ss3[t]; const float rstd = __builtin_amdgcn_rsqf(((sp[0] + sp[1]) + (sp[2] + sp[3])) * (1.0f / D) + RMS_EPS);
            int e1 = 0; float v1 = lg[0];
#pragma unroll
            for (int e = 1; e < 8; ++e) if (lg[e] > v1) { v1 = lg[e]; e1 = e; }
            int e2 = e1 == 0 ? 1 : 0; float v2 = -__builtin_inff();
#pragma unroll
            for (int e = 0; e < 8; ++e) if (e != e1 && lg[e] > v2) { v2 = lg[e]; e2 = e; }
            const float ex = __expf((v2 - v1) * rstd), p1 = 1.0f / (1.0f + ex), p2 = ex * p1;
            if (lane == 0) { tope[t] = e1 | (e2 << 8); topp[t] = (f32x2){p1, p2}; atomicAdd((int*)&lcnt[e1], 1); atomicAdd((int*)&lcnt[e2], 1); }
        }
        __syncthreads();
        if (tid < 8) cntb[vb * 8 + tid] = lcnt[tid];
        __syncthreads();
    }
    const int gw = blockIdx.x * 8 + wid, NGW = gridDim.x * 8;
    constexpr int I_1 = 16 * 56, I_13 = 2 * I_1, I_2 = 56 * 16;
    unsigned char* w13 = ws + WS_WMOE; unsigned char* w2t = ws + WS_WMOE + WMOE_W2;
    for (int it = gw; it < NE * (I_13 + I_2); it += NGW) {
        int r = it;
        if (r < NE * I_13) { const int e = r / I_13; r -= e * I_13; const int w = r / I_1; r -= w * I_1; const int kb = r / 56, nb = r % 56, n0 = 64 * nb;
            transpose_item_f8(a->in[19 + w] + (size_t)e * D * DFF, DFF, 64 * kb, n0, w13 + (size_t)e * (2 * DFF) * D + (size_t)pair_row(n0, w) * D, D, gn, F8_W13_MUL, lane); continue; }
        r -= NE * I_13;
        { const int e = r / I_2; r -= e * I_2; const int kb = r / 16, nb = r % 16, n0 = 64 * nb;
            transpose_item_f8(a->in[21] + (size_t)e * DFF * D, D, 64 * kb, n0, w2t + (size_t)e * D * DFF + (size_t)n0 * DFF, DFF, nullptr, F8_W2_MUL, lane); }
    }
}

__device__ __forceinline__ void scatter_phase(KArgs a, LAS unsigned char* lds, int tid, int wid, int lane) {
    asm volatile("" : "+v"(tid), "+v"(lane));
    unsigned char* ws = a->ws;
    const int* tope = (const int*)(ws + WS_SMALL + SM_TOPE); int* tslot = (int*)(ws + WS_SMALL + SM_TSLOT); float* ssperm = (float*)(ws + WS_SMALL + SM_SSPERM); int* meta = (int*)(ws + WS_SMALL + SM_META);
    const int* cntb = (const int*)(ws + WS_CTL + CTL_CNT); const f32x4* ss3 = (const f32x4*)(ws + WS_SS) + 3 * M;
    const bf16_t* X = (const bf16_t*)(ws + WS_XB); unsigned char* AP = ws + WS_APERM;
    LAS int* lc = (LAS int*)lds;
    LAS int* lbase = lc + 2048;
    LAS int* lslot = lc + 2064;
    LAS int* ltot = lc + 2200;
    for (int i = tid; i < 2048; i += 512) lc[i] = __hip_atomic_load(cntb + i, __ATOMIC_RELAXED, __HIP_MEMORY_SCOPE_AGENT);
    __syncthreads();
    for (int vb = blockIdx.x; vb < 256; vb += gridDim.x) {
        if (tid < 8) { int tot = 0, pre = 0;
#pragma unroll 8
            for (int b = 0; b < 256; ++b) { const int v = lc[b * 8 + tid]; tot += v; pre += (b < vb) ? v : 0; }
            ltot[tid] = tot; lbase[tid] = pre; }
        __syncthreads();
        if (tid == 0) { int off = 0;
            for (int e = 0; e < 8; ++e) { lbase[e] += off; if (vb == 0) meta[e] = off >> 8; off += (ltot[e] + 255) & ~255; }
            if (vb == 0) meta[8] = off >> 8; }
        __syncthreads();
        if (wid == 0) {
            const int t = vb * 64 + lane; const int te = tope[t]; const int e1 = te & 0xff, e2 = (te >> 8) & 0xff;
            int s1 = 0, s2 = 0;
#pragma unroll
            for (int k = 0; k < 2; ++k) { const int ek = k ? e2 : e1; int sk = 0;
#pragma unroll
                for (int e = 0; e < 8; ++e) { const unsigned long long mask = __ballot(ek == e); const int base = lbase[e]; LDS_WAIT();
                    const int rank = __popcll(mask & ((1ull << lane) - 1ull)); if (ek == e) sk = base + rank;
                    if (lane == 0) lbase[e] = base + __popcll(mask); LDS_WAIT(); }
                if (k) s2 = sk; else s1 = sk; }
            *(int2*)(tslot + 2 * t) = make_int2(s1, s2); lslot[lane] = s1; lslot[64 + lane] = s2;
        }
        __syncthreads();
        for (int rb = 0; rb < 2; ++rb) {
            u32x4 xv[8][2]; f32x4 sp[8];
#pragma unroll
            for (int i = 0; i < 8; ++i) { const int r = wid + 8 * (rb * 8 + i), t = vb * 64 + (r & 63); const u32x4* src = (const u32x4*)(X + (size_t)t * D) + 2 * lane; xv[i][0] = src[0]; xv[i][1] = src[1]; sp[i] = ss3[t]; }
#pragma unroll
            for (int i = 0; i < 8; ++i) { const int r = wid + 8 * (rb * 8 + i), slot = lslot[r];
                const float rstd = __builtin_amdgcn_rsqf(((sp[i][0] + sp[i][1]) + (sp[i][2] + sp[i][3])) * (1.0f / D) + RMS_EPS);
                f32x4 v0, v1, v2, v3; pg8::unpack8(xv[i][0], v0, v1); pg8::unpack8(xv[i][1], v2, v3);
                *((u32x4*)(AP + (size_t)slot * D) + lane) = (u32x4){pk_fp8x4(v0 * rstd), pk_fp8x4(v1 * rstd), pk_fp8x4(v2 * rstd), pk_fp8x4(v3 * rstd)}; } }
        __syncthreads();
    }
}

__device__ __forceinline__ void combine_phase(KArgs a, int wid, int lane) {
    asm volatile("" : "+v"(lane));
    unsigned char* ws = a->ws;
    const bf16_t* X = (const bf16_t*)(ws + WS_XB); const bf16_t* Y = (const bf16_t*)(ws + WS_Y); const int* tslot = (const int*)(ws + WS_SMALL + SM_TSLOT); const f32x2* topp = (const f32x2*)(ws + WS_SMALL + SM_TOPP);
    const float* gf = a->in[22]; float* out = a->out;
    const int gw = blockIdx.x * 8 + wid, NGW = gridDim.x * 8;
    f32x4 gv[4];
#pragma unroll
    for (int h = 0; h < 2; ++h) { gv[2 * h] = *(const f32x4*)(gf + 512 * h + 8 * lane); gv[2 * h + 1] = *(const f32x4*)(gf + 512 * h + 8 * lane + 4); }
    for (int tb = gw; tb < M; tb += 4 * NGW) {
        int2 sl[4]; f32x2 p[4];
#pragma unroll
        for (int i = 0; i < 4; ++i) { const int t = min(tb + i * NGW, M - 1); sl[i] = *(const int2*)(tslot + 2 * t); p[i] = topp[t]; }
        u32x4 xr[4][2], ya[4][2], yb[4][2];
#pragma unroll
        for (int i = 0; i < 4; ++i) { const int t = min(tb + i * NGW, M - 1);
#pragma unroll
            for (int h = 0; h < 2; ++h) { const int col = 512 * h + 8 * lane;
                xr[i][h] = *(const u32x4*)(X + (size_t)t * D + col); ya[i][h] = *(const u32x4*)(Y + (size_t)sl[i].x * D + col); yb[i][h] = *(const u32x4*)(Y + (size_t)sl[i].y * D + col); } }
#pragma unroll
        for (int i = 0; i < 4; ++i) { const int t = tb + i * NGW; if (t < M) {
            f32x4 v[4]; float s = 0.f;
#pragma unroll
            for (int h = 0; h < 2; ++h) { f32x4 x0, x1, a0, a1, b0, b1; pg8::unpack8(xr[i][h], x0, x1); pg8::unpack8(ya[i][h], a0, a1); pg8::unpack8(yb[i][h], b0, b1);
                v[2 * h] = x0 + a0 * p[i].x + b0 * p[i].y; v[2 * h + 1] = x1 + a1 * p[i].x + b1 * p[i].y; }
#pragma unroll
            for (int k = 0; k < 4; ++k) s += (v[k][0] * v[k][0] + v[k][1] * v[k][1]) + (v[k][2] * v[k][2] + v[k][3] * v[k][3]);
            const float rstd = __builtin_amdgcn_rsqf(wave_sum(s) * (1.0f / D) + RMS_EPS);
#pragma unroll
            for (int h = 0; h < 2; ++h) { const int col = 512 * h + 8 * lane;
                *(f32x4*)(out + (size_t)t * D + col) = v[2 * h] * rstd * gv[2 * h]; *(f32x4*)(out + (size_t)t * D + col + 4) = v[2 * h + 1] * rstd * gv[2 * h + 1]; } } }
    }
}

#ifndef WGM_INPROJ
#define WGM_INPROJ 4
#endif
#ifndef WGM_FFN1
#define WGM_FFN1 4
#endif
#ifndef WGM_MOE1
#define WGM_MOE1 4
#endif
constexpr int NPH = 18;
#ifndef MK_PH_MASK
#define MK_PH_MASK 0xFFFFFFFFu
#endif
#define PHON(bit) ((((MK_PH_MASK) >> (bit)) & 1u) != 0u)


__device__ __forceinline__ void ph_inproj(KArgs a, int layer, LAS unsigned char* lds) {
    unsigned char* ws = a->ws;
    pg8::Gemm g{2 * D, 2 * D, 2 * D, 0, 0}; pg8::PlainSched S{M / 256, INC / 256, (int)gridDim.x, (int)blockIdx.x, (const char*)(ws + WS_XB), (const char*)(ws + WS_W0 + W0_WIN + (size_t)layer * 18 * MiB), (size_t)256 * D * 2, (size_t)256 * D * 2, WGM_INPROJ};
    pg8::EpiProj E{(bf16_t*)(ws + A_SCB), (bf16_t*)(ws + A_SCX), (bf16_t*)(ws + A_GLU), (bf16_t*)(ws + A_PU), (bf16_t*)(ws + A_GATES), (const f32x4*)(ws + WS_SS) + (size_t)(layer * 2) * M};
    pg8::gemm_phase(lds, g, S, E);
}
__device__ __forceinline__ void ph_fold(KArgs a, LAS unsigned char* lds) {
    unsigned char* ws = a->ws;
    pg8::Gemm g{512, 2 * D, 512, 0, 0}; pg8::FoldSched S{(int)gridDim.x, (int)blockIdx.x, (const char*)(ws + WS_W0 + W0_WOUT + 2 * 2 * MiB), (const char*)(ws + WS_W0 + W0_POOL)};
    pg8::EpiPlain E{(bf16_t*)(ws + WS_WC), D, (size_t)D * D};
    pg8::gemm_phase(lds, g, S, E);
}
__device__ __forceinline__ void ph_merge(KArgs a, int layer, LAS unsigned char* lds) {
    unsigned char* ws = a->ws;
    pg8::Gemm g{2 * D, 2 * D, 2 * D, 0, 0}; pg8::MergeSched S{(int)gridDim.x, (int)blockIdx.x, (const char*)(ws + A_YA), (const char*)(ws + WS_W0 + W0_WOUT + (size_t)(layer * 3) * 2 * MiB), (const char*)(ws + WS_WC + (size_t)layer * 2 * MiB), (size_t)32 * MiB, (size_t)2 * MiB};
    pg8::EpiMerge E{(const bf16_t*)(ws + A_GATES), (bf16_t*)(ws + A_MERGED)};
    pg8::gemm_phase(lds, g, S, E);
}
__device__ __forceinline__ void ph_wo(KArgs a, int layer, LAS unsigned char* lds) {
    unsigned char* ws = a->ws;
    pg8::Gemm g{2 * D, 2 * D, 2 * D, 0, 0}; pg8::PlainSched S{M / 256, D / 256, (int)gridDim.x, (int)blockIdx.x, (const char*)(ws + A_MERGED), (const char*)(ws + WS_W0 + W0_WO + (size_t)layer * 2 * MiB), (size_t)256 * D * 2, (size_t)256 * D * 2, 4};
    pg8::EpiResid E{layer == 0 ? a->in[0] : (const float*)nullptr, (bf16_t*)(ws + WS_XB), (float*)(ws + WS_SS) + (size_t)(layer * 2 + 1) * M * 4, (LAS float*)(lds + RED_OFF)};
    pg8::gemm_phase(lds, g, S, E);
}
__device__ __forceinline__ void ph_ffn1(KArgs a, LAS unsigned char* lds) {
    unsigned char* ws = a->ws;
    pg8::Gemm g{2 * D, 2 * D, 2 * D, 0, 0}; pg8::PlainSched S{M / 256, 2 * DFF / 256, (int)gridDim.x, (int)blockIdx.x, (const char*)(ws + WS_XB), (const char*)(ws + WS_W0 + W0_D13), (size_t)256 * D * 2, (size_t)256 * D * 2, WGM_FFN1};
    pg8::EpiSwiGLU<true, false> E{(bf16_t*)(ws + A_FFN), DFF, (const float*)(ws + WS_SS) + (size_t)1 * M * 4};
    pg8::gemm_phase(lds, g, S, E);
}
__device__ __forceinline__ void ph_ffn2(KArgs a, LAS unsigned char* lds) {
    unsigned char* ws = a->ws;
    pg8::Gemm g{2 * DFF, 2 * DFF, 2 * DFF, 0, 0}; pg8::PlainSched S{M / 256, D / 256, (int)gridDim.x, (int)blockIdx.x, (const char*)(ws + A_FFN), (const char*)(ws + WS_W0 + W0_D2), (size_t)256 * DFF * 2, (size_t)256 * DFF * 2, 4};
    pg8::EpiResid E{(const float*)nullptr, (bf16_t*)(ws + WS_XB), (float*)(ws + WS_SS) + (size_t)2 * M * 4, (LAS float*)(lds + RED_OFF)};
    pg8::gemm_phase(lds, g, S, E);
}
__device__ __forceinline__ void ph_moe(KArgs a, int which, LAS unsigned char* lds) {
    unsigned char* ws = a->ws;
    const int* meta = (const int*)(ws + WS_SMALL + SM_META); int o[9];
#pragma unroll
    for (int e = 0; e < 9; ++e) o[e] = __builtin_amdgcn_readfirstlane(__hip_atomic_load(meta + e, __ATOMIC_RELAXED, __HIP_MEMORY_SCOPE_AGENT));
    const int nM = o[8] > MAXSLOT / 256 ? MAXSLOT / 256 : o[8];
    if (which == 0) {
        pg8::Gemm g{D, D, D, F8_ONE, F8_W13_SC}; pg8::GroupSched S{nM, 2 * DFF / 256, (int)gridDim.x, (int)blockIdx.x, o[1], o[2], o[3], o[4], o[5], o[6], o[7], (const char*)(ws + WS_APERM), (const char*)(ws + WS_WMOE), (size_t)256 * D, (size_t)256 * D, (size_t)2 * DFF * D, WGM_MOE1};
        pg8::EpiSwiGLU<false, true> E{(bf16_t*)(ws + WS_ACTP), DFF, nullptr};
        pg8::gemm_phase<pg8::EpiSwiGLU<false, true>, pg8::GroupSched, true>(lds, g, S, E);
    } else {
        pg8::Gemm g{DFF, DFF, DFF, F8_ACT_SC, F8_W2_SC}; pg8::GroupSched S{nM, D / 256, (int)gridDim.x, (int)blockIdx.x, o[1], o[2], o[3], o[4], o[5], o[6], o[7], (const char*)(ws + WS_ACTP), (const char*)(ws + WS_WMOE + WMOE_W2), (size_t)256 * DFF, (size_t)256 * DFF, (size_t)D * DFF, 4};
        pg8::EpiPlain E{(bf16_t*)(ws + WS_Y), D, 0};
        pg8::gemm_phase<pg8::EpiPlain, pg8::GroupSched, true>(lds, g, S, E);
    }
}

__global__ void __launch_bounds__(512, 2) fwd(Args unused_args_read_through_kargs) {
    extern __shared__ __attribute__((aligned(16))) unsigned char lds_raw[];
    LAS unsigned char* lds = (LAS unsigned char*)lds_raw;
    volatile LAS unsigned* MISC = (volatile LAS unsigned*)(lds + MISC_OFF);
    const int tid = threadIdx.x, lane = tid & 63, wid = __builtin_amdgcn_readfirstlane(tid >> 6);
    if (tid < 64) MISC[tid] = 0u;
    __syncthreads();
    int lo, hi; XcdBarrier bar;
    { KArgs a = kargs(); lo = a->ph_lo; hi = a->ph_hi; unsigned* bw = (unsigned*)(a->ws + WS_CTL + CTL_BAR); bar.bar = bw; bar.x = 0; bar.st = nullptr; if (hi - lo > 1) bar = xcd_barrier_post(bw, MISC + 8); }
#define IN(k) (lo <= (k) && (k) < hi)
#define SEAM(k) do { if (IN(k) && IN((k) + 1)) xcd_barrier(bar); } while (0)

    if (PHON(0) && IN(0)) { for (int rp = 0; rp < REPS(0); ++rp) { prologue_phase(kargs(), lds, wid, lane); __syncthreads(); } } SEAM(0);
#pragma nounroll
    for (int layer = 0; layer < 2; ++layer) {
        const int pb = 1 + 7 * layer;
        if (PHON(1) && IN(pb + 0)) { for (int rp = 0; rp < REPS(1); ++rp) { if (layer == 0) { ph_fold(kargs(), lds); __syncthreads(); } ph_inproj(kargs(), layer, lds); __syncthreads(); } } SEAM(pb + 0);
        if (PHON(2) && IN(pb + 1)) { for (int rp = 0; rp < REPS(2); ++rp) { conv_phase(kargs(), layer, lds, tid, wid, lane); __syncthreads(); } } SEAM(pb + 1);
        if (PHON(4) && IN(pb + 3)) { for (int rp = 0; rp < REPS(4); ++rp) { ph_merge(kargs(), layer, lds); __syncthreads(); } } SEAM(pb + 3);
        if (PHON(5) && IN(pb + 4)) { for (int rp = 0; rp < (layer == 0 ? REPS(5) : 1); ++rp) { ph_wo(kargs(), layer, lds); __syncthreads(); } } SEAM(pb + 4);
        if (layer == 0) {
            if (PHON(6) && IN(6)) { for (int rp = 0; rp < REPS(6); ++rp) { ph_ffn1(kargs(), lds); __syncthreads(); } } SEAM(6);
            if (PHON(7) && IN(7)) { ph_ffn2(kargs(), lds); } SEAM(7);
        }
    }
    if (PHON(13) && IN(13)) { for (int rp = 0; rp < REPS(13); ++rp) { route_phase(kargs(), lds, tid, wid, lane); __syncthreads(); } } SEAM(13);
    if (PHON(14) && IN(14)) { for (int rp = 0; rp < REPS(14); ++rp) { scatter_phase(kargs(), lds, tid, wid, lane); __syncthreads(); } } SEAM(14);
    if (PHON(15) && IN(15)) { for (int rp = 0; rp < REPS(15); ++rp) { ph_moe(kargs(), 0, lds); __syncthreads(); } } SEAM(15);
    if (PHON(16) && IN(16)) { for (int rp = 0; rp < REPS(16); ++rp) { ph_moe(kargs(), 1, lds); __syncthreads(); } } SEAM(16);
    if (PHON(17) && IN(17)) { for (int rp = 0; rp < REPS(17); ++rp) { combine_phase(kargs(), wid, lane); __syncthreads(); } }
#undef IN
#undef SEAM
}

extern "C" void kernel_launch(void* const* d_in, const int* in_sizes, int n_in, void* d_out, int out_size, void* d_ws, size_t ws_size, hipStream_t stream) {
    static int grid = 0;
    if (grid == 0) {
        if (n_in != 23 || in_sizes[0] != M * D || out_size != M * D || ws_size < WS_END) { fprintf(stderr, "kernel_launch: unexpected shapes: n_in %d in0 %d out %d ws %zu (need %zu); nothing launched\n", n_in, n_in > 0 ? in_sizes[0] : -1, out_size, ws_size, (size_t)WS_END); grid = -1; return; }
        int dev = 0, cus = 0, per_cu = 0;
        if (hipGetDevice(&dev) != hipSuccess || hipDeviceGetAttribute(&cus, hipDeviceAttributeMultiprocessorCount, dev) != hipSuccess) { fprintf(stderr, "kernel_launch: device query failed\n"); grid = -1; return; }
        if (hipFuncSetAttribute((const void*)fwd, hipFuncAttributeMaxDynamicSharedMemorySize, LDS_BYTES) != hipSuccess) { fprintf(stderr, "kernel_launch: hipFuncSetAttribute failed\n"); grid = -1; return; }
        if (hipOccupancyMaxActiveBlocksPerMultiprocessor(&per_cu, (const void*)fwd, 512, LDS_BYTES) != hipSuccess || per_cu < 1) fprintf(stderr, "kernel_launch: note: occupancy query reports %d workgroups per CU\n", per_cu);
        (void)hipGetLastError();
        grid = cus;
    }
    if (grid < 0) return;
    if (hipMemsetAsync((char*)d_ws + WS_CTL, 0, CTL_BYTES, stream) != hipSuccess) { fprintf(stderr, "kernel_launch: memset failed\n"); return; }
    Args a{};
    for (int i = 0; i < 23; ++i) a.in[i] = (const float*)d_in[i];
    a.out = (float*)d_out; a.ws = (unsigned char*)d_ws;
#if MK_PER_PHASE
    for (int ph = 0; ph < NPH; ++ph) { a.ph_lo = ph; a.ph_hi = ph + 1; hipLaunchKernelGGL(fwd, dim3(grid), dim3(512), LDS_BYTES, stream, a); }
#else
    a.ph_lo = 0; a.ph_hi = NPH; hipLaunchKernelGGL(fwd, dim3(grid), dim3(512), LDS_BYTES, stream, a);
#endif
    const hipError_t le = hipPeekAtLastError();
    if (le != hipSuccess) fprintf(stderr, "kernel_launch: launch failed: %s\n", hipGetErrorName(le));
}
```

```cpp
#include <hip/hip_runtime.h>
#include <cstdio>
#include <cstdint>

#ifndef MK_PER_PHASE
#define MK_PER_PHASE 0
#endif

#ifndef MK_REP_MASK
#define MK_REP_MASK 0u
#endif
#define REPS(bit) (1 + (int)(((MK_REP_MASK) >> (bit)) & 1u))
#define REPS2(bit) REPS(bit)

#define LAS __attribute__((address_space(3)))
typedef unsigned short bf16_t;
typedef short bf16x8 __attribute__((ext_vector_type(8)));
typedef float f32x4 __attribute__((ext_vector_type(4)));
typedef float f32x2 __attribute__((ext_vector_type(2)));
typedef unsigned u32x4 __attribute__((ext_vector_type(4)));
typedef unsigned u32x2 __attribute__((ext_vector_type(2)));

constexpr int M = 16384, D = 1024, SEQ = 8192, INC = 9216, DFF = 3584, NE = 8;
constexpr float RMS_EPS = 1e-6f, LN_EPS = 1e-5f;
constexpr int MAXSLOT = 34816;
constexpr float F8_W13_MUL = 128.f, F8_ACT_MUL = 4.f, F8_W2_MUL = 256.f;
constexpr int F8_ONE = 0x7f7f7f7f, F8_W13_SC = 0x78787878  , F8_ACT_SC = 0x7d7d7d7d  , F8_W2_SC = 0x77777777  ;

constexpr size_t MiB = 1u << 20;
constexpr size_t WS_CTL = 0, CTL_BYTES = 64 * 1024;
constexpr size_t CTL_BAR = 16384;
constexpr size_t CTL_CNT = 32768;
constexpr size_t WS_SMALL = 1 * MiB;
constexpr size_t SM_TOPE = 0, SM_TOPP = 64 * 1024, SM_TSLOT = 192 * 1024, SM_SSPERM = 320 * 1024, SM_META = 512 * 1024;
constexpr size_t WS_XB = 66 * MiB;
constexpr size_t WS_W0 = 98 * MiB;
constexpr size_t W0_WIN = 0;
constexpr size_t W0_WOUT = 36 * MiB;
constexpr size_t W0_WO = 48 * MiB;
constexpr size_t W0_POOL = 52 * MiB;
constexpr size_t W0_D13 = 53 * MiB;
constexpr size_t W0_D2 = 67 * MiB;
constexpr size_t WS_ACT = 172 * MiB;
constexpr size_t A_SCB = WS_ACT, A_SCX = WS_ACT + 32 * MiB, A_GLU = WS_ACT + 64 * MiB, A_PU = WS_ACT + 96 * MiB, A_GATES = WS_ACT + 128 * MiB,
                 A_YA = WS_ACT + 224 * MiB, A_VB = WS_ACT + 256 * MiB, A_PP = WS_ACT + 288 * MiB, A_MERGED = A_SCX, A_FFN = WS_ACT;
constexpr size_t WS_WC = 524 * MiB;
constexpr size_t WS_ACTP = 98 * MiB;
constexpr size_t WS_WMOE = 304 * MiB, WMOE_W2 = 56 * MiB;
constexpr size_t WS_Y = 400 * MiB;
constexpr size_t WS_APERM = 472 * MiB;
constexpr size_t WS_SS = 540 * MiB;
constexpr size_t WS_END = 541 * MiB;

typedef __bf16 bf16x2_t __attribute__((ext_vector_type(2)));
__device__ __forceinline__ unsigned pk_bf16(float lo, float hi) { const bf16x2_t v = {(__bf16)lo, (__bf16)hi}; return __builtin_bit_cast(unsigned, v); }
__device__ __forceinline__ unsigned pk_fp8x4(const f32x4 v) {
    const float a = __builtin_amdgcn_fmed3f(v[0], -448.f, 448.f), b = __builtin_amdgcn_fmed3f(v[1], -448.f, 448.f), c = __builtin_amdgcn_fmed3f(v[2], -448.f, 448.f), d = __builtin_amdgcn_fmed3f(v[3], -448.f, 448.f);
    int w = 0; w = __builtin_amdgcn_cvt_pk_fp8_f32(a, b, w, false); w = __builtin_amdgcn_cvt_pk_fp8_f32(c, d, w, true); return (unsigned)w; }
__device__ __forceinline__ float bf_lo(unsigned u) { return __uint_as_float(u << 16); }
__device__ __forceinline__ float bf_hi(unsigned u) { return __uint_as_float(u & 0xffff0000u); }
__device__ __forceinline__ float sigm(float x) { return __builtin_amdgcn_rcpf(1.f + __builtin_amdgcn_exp2f(-1.44269504f * x)); }
__device__ __forceinline__ float wave_sum(float v) {
#pragma unroll
    for (int o = 1; o < 64; o <<= 1) v += __shfl_xor(v, o);
    return v;
}
#define LDS_WAIT() asm volatile("s_waitcnt lgkmcnt(0)" ::: "memory")

namespace pg8 {
constexpr int BM = 256, BK = 64, HALF = 128, HTB = HALF * BK * 2, STAGE_BYTES = 8 * HTB, NXCD = 8;
__host__ __device__ __forceinline__ int lds_byte(int r, int c) { const int st = (r >> 4) * 2 + (c >> 5), rr = r & 15, cc = c & 31, ob = rr * 64 + cc * 2; return st * 1024 + (ob ^ (((ob >> 9) & 1) << 5)); }
__host__ __device__ __forceinline__ void stage_rc(int b, int& R, int& C) { const int st = b / 1024, sb = b % 1024, swz = sb ^ (((sb >> 9) & 1) << 5); R = (st >> 1) * 16 + swz / 64; C = (st & 1) * 32 + (swz % 64) / 2; }
__host__ __device__ __forceinline__ int perm32(int rho) { const int n = rho >> 4, i = rho & 15; return 8 * (i >> 2) + 4 * n + (i & 3); }

struct Unit { int pm, pn, aux; const char* A; const char* B; };
struct Gemm { int Kb, lda, ldb; int sa, sb; };

__device__ __forceinline__ bool tile_of(int L, int nM, int nN, int& pm, int& pn, int WGM = 4) {
    const int nwg = nM * nN; if (L >= nwg) return false;
    int wgid = L; { const int q = nwg / NXCD, r = nwg % NXCD, xcd = wgid % NXCD, off = wgid / NXCD; wgid = (xcd < r ? xcd * (q + 1) : r * (q + 1) + (xcd - r) * q) + off; }
    const int nig = WGM * nN, gid = wgid / nig, fm = gid * WGM, gsz = (nM - fm) < WGM ? (nM - fm) : WGM;
    pm = fm + ((wgid % nig) % gsz); pn = (wgid % nig) / gsz; return true;
}
struct PlainSched {
    int nM, nN, G, c; const char* A0; const char* B0; size_t astep, bstep; int wgm;
    __device__ __forceinline__ bool next(int i, Unit& u) const { int pm, pn; if (!tile_of(i * G + c, nM, nN, pm, pn, wgm)) return false; u.pm = pm; u.pn = pn; u.aux = 0; u.A = A0 + (size_t)pm * astep; u.B = B0 + (size_t)pn * bstep; return true; }
};
struct PoolSched {
    int G, c; const char* A0; const char* B0;
    __device__ __forceinline__ bool next(int i, Unit& u) const { int pm, pn; if (!tile_of(i * G + c, M / 256, 4, pm, pn)) return false; u.pm = pm; u.pn = pn; u.aux = 0;
        u.A = A0 + (size_t)pm * (256 * 1024 * 2) + (size_t)pn * 512; u.B = B0 + (size_t)pn * (256 * 256 * 2); return true; }
};
struct MergeSched {
    int G, c; const char *A0, *B0, *B2; size_t astr, bstr;
    __device__ __forceinline__ bool next(int i, Unit& u) const { const int t = i / 3, b = i - 3 * t; int pm, pn; if (!tile_of(t * G + c, M / 256, 4, pm, pn)) return false; u.pm = pm; u.pn = pn; u.aux = b;
        const char* w = b == 2 ? B2 : B0 + (size_t)b * bstr;
        u.A = A0 + (size_t)b * astr + (size_t)pm * (256 * 1024 * 2); u.B = w + (size_t)pn * (256 * 1024 * 2); return true; }
};
struct FoldSched {
    int G, c; const char *A0, *B0;
    __device__ __forceinline__ bool next(int i, Unit& u) const { const int idx = i * G + c; if (idx >= 32) return false; const int L = idx >> 4, pm = (idx >> 2) & 3, g = idx & 3; u.pm = pm; u.pn = g; u.aux = L;
        u.A = A0 + (size_t)L * (6 * MiB) + (size_t)pm * (256 * 1024 * 2) + (size_t)g * 512; u.B = B0 + (size_t)L * (512 * 1024) + (size_t)g * (256 * 256 * 2); return true; }
};
struct GroupSched {
    int nM, nN, G, c; int o1, o2, o3, o4, o5, o6, o7; const char* A0; const char* B0; size_t astep, bstep, estep; int wgm;
    __device__ __forceinline__ bool next(int i, Unit& u) const { int pm, pn; if (!tile_of(i * G + c, nM, nN, pm, pn, wgm)) return false; u.pm = pm; u.pn = pn; u.aux = 0;
        const int e = (pm >= o1) + (pm >= o2) + (pm >= o3) + (pm >= o4) + (pm >= o5) + (pm >= o6) + (pm >= o7);
        u.A = A0 + (size_t)pm * astep; u.B = B0 + (size_t)e * estep + (size_t)pn * bstep; return true; }
};

typedef f32x4 Acc[2][2][4][2];
__device__ __forceinline__ u32x4 pack8(const f32x4 v0, const f32x4 v1) { u32x4 w; w.x = pk_bf16(v0[0], v0[1]); w.y = pk_bf16(v0[2], v0[3]); w.z = pk_bf16(v1[0], v1[1]); w.w = pk_bf16(v1[2], v1[3]); return w; }
__device__ __forceinline__ f32x4 sig4(const f32x4 v) { f32x4 r; r[0] = sigm(v[0]); r[1] = sigm(v[1]); r[2] = sigm(v[2]); r[3] = sigm(v[3]); return r; }
__device__ __forceinline__ void unpack8(const u32x4 g, f32x4& lo, f32x4& hi) { lo[0] = bf_lo(g.x); lo[1] = bf_hi(g.x); lo[2] = bf_lo(g.y); lo[3] = bf_hi(g.y); hi[0] = bf_lo(g.z); hi[1] = bf_hi(g.z); hi[2] = bf_lo(g.w); hi[3] = bf_hi(g.w); }

__device__ __forceinline__ size_t gate_frag(int pm, int q, int wid, int ai, int m, int bj, int lane) { return ((size_t)((((((pm * 12 + q) * 8 + wid) * 2 + ai) * 4 + m) * 2 + bj) * 64 + lane)) * 16; }
struct EpiProj {
    bf16_t *scb, *scx, *glu, *pu, *gates; const f32x4* ss;
    __device__ __forceinline__ bool operator()(Acc& acc, const Unit& u, int wr, int wc, int fr, int fq) const {
        const int row0 = u.pm * BM + wr * 64 + fr, pn = u.pn;
        float rs[2][4];
#pragma unroll
        for (int ai = 0; ai < 2; ++ai)
#pragma unroll
            for (int m = 0; m < 4; ++m) { const f32x4 p = ss[row0 + ai * HALF + m * 16]; rs[ai][m] = __builtin_amdgcn_rsqf(((p[0] + p[1]) + (p[2] + p[3])) * (1.0f / D) + RMS_EPS); }
        if (pn >= 4 && pn < 20) {
            const bool isglu = pn >= 12; bf16_t* dst = isglu ? glu : scx; const int col0 = (isglu ? pn - 12 : pn - 4) * 128 + wc * 32 + 8 * fq;
#pragma unroll
            for (int ai = 0; ai < 2; ++ai)
#pragma unroll
                for (int m = 0; m < 4; ++m) { const float r = rs[ai][m];
                    f32x4 a0 = acc[ai][0][m][0] * r, a1 = acc[ai][0][m][1] * r, b0 = acc[ai][1][m][0] * r, b1 = acc[ai][1][m][1] * r;
                    if (isglu) { b0 = sig4(b0); b1 = sig4(b1); }
                    *(u32x4*)(dst + (size_t)(row0 + ai * HALF + m * 16) * D + col0) = pack8(a0 * b0, a1 * b1); }
        } else {
            if (pn >= 24) {
#pragma unroll
                for (int ai = 0; ai < 2; ++ai)
#pragma unroll
                    for (int m = 0; m < 4; ++m) { const float r = rs[ai][m];
#pragma unroll
                        for (int bj = 0; bj < 2; ++bj) { f32x4 e0 = acc[ai][bj][m][0] * r, e1 = acc[ai][bj][m][1] * r;
#pragma unroll
                            for (int j = 0; j < 4; ++j) { e0[j] = __builtin_amdgcn_exp2f(-1.44269504f * __builtin_amdgcn_fmed3f(e0[j], -30.f, 30.f)); e1[j] = __builtin_amdgcn_exp2f(-1.44269504f * __builtin_amdgcn_fmed3f(e1[j], -30.f, 30.f)); }
                            *(u32x4*)((unsigned char*)gates + gate_frag(u.pm, pn - 24, wr * 4 + wc, ai, m, bj, fr + 16 * fq)) = pack8(e0, e1); } }
            } else {
            bf16_t* dst = pn < 4 ? scb : pu; const int ldc = D, colb = (pn < 4 ? pn : pn - 20) * 256;
            const int col0 = colb + wc * 32 + 8 * fq;
#pragma unroll
            for (int ai = 0; ai < 2; ++ai)
#pragma unroll
                for (int m = 0; m < 4; ++m) { const float r = rs[ai][m]; bf16_t* rowp = dst + (size_t)(row0 + ai * HALF + m * 16) * ldc + col0;
#pragma unroll
                    for (int bj = 0; bj < 2; ++bj) *(u32x4*)(rowp + bj * HALF) = pack8(acc[ai][bj][m][0] * r, acc[ai][bj][m][1] * r); }
            }
        }
        return false;
    }
};
struct EpiPlain {
    bf16_t* Ob; int ldc; size_t aux_stride;
    __device__ __forceinline__ bool operator()(Acc& acc, const Unit& u, int wr, int wc, int fr, int fq) const {
        bf16_t* O = Ob + (size_t)u.aux * aux_stride;
        const int row0 = u.pm * BM + wr * 64 + fr, col0 = u.pn * BM + wc * 32 + 8 * fq;
#pragma unroll
        for (int ai = 0; ai < 2; ++ai)
#pragma unroll
            for (int m = 0; m < 4; ++m) { bf16_t* rowp = O + (size_t)(row0 + ai * HALF + m * 16) * ldc + col0;
#pragma unroll
                for (int bj = 0; bj < 2; ++bj) *(u32x4*)(rowp + bj * HALF) = pack8(acc[ai][bj][m][0], acc[ai][bj][m][1]); }
        return false;
    }
};
struct EpiMerge {
    const bf16_t* gates; bf16_t* O;
    __device__ __forceinline__ bool operator()(Acc& acc, const Unit& u, int wr, int wc, int fr, int fq) const {
        const int row0 = u.pm * BM + wr * 64 + fr, col0 = u.pn * BM + wc * 32 + 8 * fq, b = u.aux;
#pragma unroll
        for (int ai = 0; ai < 2; ++ai)
#pragma unroll
            for (int m = 0; m < 4; ++m) { const size_t row = (size_t)(row0 + ai * HALF + m * 16);
#pragma unroll
                for (int bj = 0; bj < 2; ++bj) { const unsigned char* gp = (const unsigned char*)gates + gate_frag(u.pm, 4 * b + u.pn, wr * 4 + wc, ai, m, bj, fr + 16 * fq);
                    f32x4 g0, g1; unpack8(*(const u32x4*)gp, g0, g1);
                    if (b < 2) { f32x4 h0, h1; unpack8(*(const u32x4*)(gp + gate_frag(0, 4, 0, 0, 0, 0, 0)), h0, h1);
#pragma unroll
                        for (int j = 0; j < 4; ++j) { acc[ai][bj][m][0][j] *= (1.f + h0[j]) * __builtin_amdgcn_rcpf(1.f + g0[j]); acc[ai][bj][m][1][j] *= (1.f + h1[j]) * __builtin_amdgcn_rcpf(1.f + g1[j]); }
                    } else {
#pragma unroll
                        for (int j = 0; j < 4; ++j) { g0[j] = __builtin_amdgcn_rcpf(1.f + g0[j]); g1[j] = __builtin_amdgcn_rcpf(1.f + g1[j]); }
                        *(u32x4*)(O + row * D + col0 + bj * HALF) = pack8(acc[ai][bj][m][0] * g0, acc[ai][bj][m][1] * g1); } } }
        return b < 2;
    }
};
struct EpiResid {
    const float* base32; bf16_t* xb; float* ssp; LAS float* red;
    __device__ __forceinline__ bool operator()(Acc& acc, const Unit& u, int wr, int wc, int fr, int fq) const {
        const int row0 = u.pm * BM + wr * 64 + fr, col0 = u.pn * BM + wc * 32 + 8 * fq;
#pragma unroll
        for (int ai = 0; ai < 2; ++ai)
#pragma unroll
            for (int m = 0; m < 4; ++m) { const size_t row = (size_t)(row0 + ai * HALF + m * 16); float q = 0.f;
#pragma unroll
                for (int bj = 0; bj < 2; ++bj) { const size_t off = row * D + col0 + bj * HALF;
                    f32x4 b0, b1; if (base32) { b0 = *(const f32x4*)(base32 + off); b1 = *(const f32x4*)(base32 + off + 4); } else unpack8(*(const u32x4*)(xb + off), b0, b1);
                    const u32x4 pk = pack8(b0 + acc[ai][bj][m][0], b1 + acc[ai][bj][m][1]); *(u32x4*)(xb + off) = pk;
                    f32x4 o0, o1; unpack8(pk, o0, o1);
                    q += (o0[0] * o0[0] + o0[1] * o0[1]) + (o0[2] * o0[2] + o0[3] * o0[3]) + (o1[0] * o1[0] + o1[1] * o1[1]) + (o1[2] * o1[2] + o1[3] * o1[3]); }
                q += __shfl_xor(q, 16); q += __shfl_xor(q, 32);
                if (fq == 0) red[(ai * HALF + wr * 64 + m * 16 + fr) * 4 + wc] = q; }
        asm volatile("s_waitcnt lgkmcnt(0)" ::: "memory"); __builtin_amdgcn_s_barrier(); asm volatile("" ::: "memory");
        int tid = threadIdx.x; asm volatile("" : "+v"(tid));
        if (tid < 256) { const f32x4 v = *(const LAS f32x4*)(red + tid * 4); ssp[(size_t)(u.pm * BM + tid) * 4 + u.pn] = (v[0] + v[1]) + (v[2] + v[3]); }
        return false;
    }
};
template <bool PART4, bool OUT8> struct EpiSwiGLU {
    bf16_t* O; int ldc; const float* ss;
    __device__ __forceinline__ bool operator()(Acc& acc, const Unit& u, int wr, int wc, int fr, int fq) const {
        const int row0 = u.pm * BM + wr * 64 + fr, col0 = u.pn * 128 + wc * 32 + 8 * fq;
#pragma unroll
        for (int ai = 0; ai < 2; ++ai)
#pragma unroll
            for (int m = 0; m < 4; ++m) { const size_t row = (size_t)(row0 + ai * HALF + m * 16); float r = 1.f;
                if (PART4) { const f32x4 p = *(const f32x4*)(ss + row * 4); r = __builtin_amdgcn_rsqf(((p[0] + p[1]) + (p[2] + p[3])) * (1.0f / D) + RMS_EPS); }
                const f32x4 a0 = acc[ai][0][m][0] * r, a1 = acc[ai][0][m][1] * r, c0 = acc[ai][1][m][0] * r, c1 = acc[ai][1][m][1] * r;
                const f32x4 h0 = a0 * sig4(a0) * c0, h1 = a1 * sig4(a1) * c1;
                if (OUT8) { *(u32x2*)((unsigned char*)O + row * ldc + col0) = (u32x2){pk_fp8x4(h0 * F8_ACT_MUL), pk_fp8x4(h1 * F8_ACT_MUL)}; }
                else *(u32x4*)(O + row * ldc + col0) = pack8(h0, h1); }
        return false;
    }
};

typedef int i32x4 __attribute__((ext_vector_type(4)));
typedef int i32x8 __attribute__((ext_vector_type(8)));
__device__ __forceinline__ i32x8 join16(const bf16x8 lo, const bf16x8 hi) { return __builtin_shufflevector(__builtin_bit_cast(i32x4, lo), __builtin_bit_cast(i32x4, hi), 0, 1, 2, 3, 4, 5, 6, 7); }
template <class Epi, class Sched, bool F8 = false>
__device__ __forceinline__ void gemm_phase(LAS unsigned char* lds, const Gemm g, const Sched& S, const Epi& E) {
    int tid_ = threadIdx.x; asm volatile("" : "+v"(tid_));
    const int tid = tid_, wid = __builtin_amdgcn_readfirstlane(tid >> 6), lane = tid & 63, wr = wid >> 2, wc = wid & 3, fr = lane & 15, fq = lane >> 4;
    const int nt = g.Kb / 128;
    int vsa = g.sa, vsb = g.sb; asm volatile("" : "+v"(vsa), "+v"(vsb));
    unsigned voffA[2], voffB[2];
#pragma unroll
    for (int i = 0; i < 2; ++i) { int R, C; stage_rc(tid * 16 + i * 8192, R, C); const int Rb = (R & ~31) + perm32(R & 31);
        voffA[i] = (unsigned)(R * g.lda + C * 2); voffB[i] = (unsigned)(Rb * g.ldb + C * 2); }
    const size_t kstep = (size_t)(BK * 2);
    const size_t hstepA = (size_t)HALF * g.lda, hstepB = (size_t)HALF * g.ldb;
    const unsigned ldsw = (unsigned)wid * 1024u;
    const int aoff = lds_byte(wr * 64 + fr, fq * 8), boff = lds_byte(wc * 32 + fr, fq * 8);
#define PG8_SA(b, h) (((b) * 2 + (h)) * HTB)
#define PG8_SB(b, h) ((4 + (b) * 2 + (h)) * HTB)
#define PG8_STAGE(bufoff, gbase, voff) do { _Pragma("unroll") for (int _i = 0; _i < 2; ++_i) \
        __builtin_amdgcn_global_load_lds((const unsigned*)((const char*)(gbase) + (voff)[_i]), (LAS unsigned*)(lds + (bufoff) + ldsw + _i * 8192), 16, 0, 0); } while (0)
#define PG8_LDA(dst, b, h) do { _Pragma("unroll") for (int m = 0; m < 4; ++m) _Pragma("unroll") for (int k = 0; k < 2; ++k) dst[m][k] = *(const LAS bf16x8*)(lds + PG8_SA(b, h) + aoff + m * 2048 + k * 1024); } while (0)
#define PG8_LDB(dst, b, h) do { _Pragma("unroll") for (int n = 0; n < 2; ++n) _Pragma("unroll") for (int k = 0; k < 2; ++k) dst[n][k] = *(const LAS bf16x8*)(lds + PG8_SB(b, h) + boff + n * 2048 + k * 1024); } while (0)
#define PG8_MMA(ai, bj, At, Bt) do { __builtin_amdgcn_s_setprio(1); _Pragma("unroll") for (int m = 0; m < 4; ++m) _Pragma("unroll") for (int n = 0; n < 2; ++n) { \
        if constexpr (F8) { const i32x8 b8_ = join16(Bt[n][0], Bt[n][1]), a8_ = join16(At[m][0], At[m][1]); \
            asm volatile("v_mfma_scale_f32_16x16x128_f8f6f4 %0, %1, %2, %0, %3, %4 op_sel_hi:[0,0,0]" : "+v"(acc[ai][bj][m][n]) : "v"(b8_), "v"(a8_), "v"(vsb), "v"(vsa)); } \
        else { _Pragma("unroll") for (int k = 0; k < 2; ++k) acc[ai][bj][m][n] = __builtin_amdgcn_mfma_f32_16x16x32_bf16(Bt[n][k], At[m][k], acc[ai][bj][m][n], 0, 0, 0); } } __builtin_amdgcn_s_setprio(0); } while (0)
#define PG8_WAIT_V(n) asm volatile("s_waitcnt vmcnt(" #n ")" ::: "memory")
#define PG8_WAIT_L(n) asm volatile("s_waitcnt lgkmcnt(" #n ")" ::: "memory")
#define PG8_BAR __builtin_amdgcn_s_barrier()
#define PG8_SCHED __builtin_amdgcn_sched_barrier(0)
    Unit cur, nxt; int ui = 0;
    if (!S.next(0, cur)) return;
    Acc acc;
#pragma unroll
    for (int a = 0; a < 2; ++a)
#pragma unroll
        for (int b = 0; b < 2; ++b)
#pragma unroll
            for (int m = 0; m < 4; ++m)
#pragma unroll
                for (int n = 0; n < 2; ++n) acc[a][b][m][n] = (f32x4){0.f, 0.f, 0.f, 0.f};
    bf16x8 At[4][2], B0[2][2], B1[2][2];
    const char* cA = cur.A; const char* cB = cur.B;
    PG8_STAGE(PG8_SB(0, 0), cB, voffB); PG8_STAGE(PG8_SB(0, 1), cB + hstepB, voffB); PG8_STAGE(PG8_SA(0, 0), cA, voffA); PG8_STAGE(PG8_SA(0, 1), cA + hstepA, voffA);
    if (wr == 1) PG8_BAR;
    PG8_WAIT_V(2); PG8_BAR;
    PG8_STAGE(PG8_SB(1, 0), cB + kstep, voffB); PG8_STAGE(PG8_SA(1, 0), cA + kstep, voffA); PG8_STAGE(PG8_SB(1, 1), cB + hstepB + kstep, voffB);
    PG8_WAIT_V(6); PG8_BAR;
    for (;;) {
        const bool has_next = S.next(ui + 1, nxt);
        const char* nA = has_next ? nxt.A : cA; const char* nB = has_next ? nxt.B : cB;
#pragma nounroll
        for (int t = 0; t < nt; t += 2) {
            const bool last = (t == nt - 2);
            const char* a1 = cA + (size_t)(t + 1) * kstep;
            const char* a2 = last ? nA : cA + (size_t)(t + 2) * kstep; const char* b2 = last ? nB : cB + (size_t)(t + 2) * kstep;
            const char* a3 = a2 + kstep; const char* b3 = b2 + kstep;
            PG8_LDB(B0, 0, 0); PG8_LDB(B1, 0, 1); PG8_SCHED; PG8_LDA(At, 0, 0); PG8_STAGE(PG8_SA(1, 1), a1 + hstepA, voffA);
            PG8_WAIT_V(8); PG8_WAIT_L(0); PG8_BAR; PG8_MMA(0, 0, At, B0); PG8_MMA(0, 1, At, B1); PG8_BAR; PG8_SCHED;
            PG8_LDA(At, 0, 1); PG8_STAGE(PG8_SB(0, 0), b2, voffB); PG8_STAGE(PG8_SB(0, 1), b2 + hstepB, voffB); PG8_STAGE(PG8_SA(0, 0), a2, voffA);
            PG8_WAIT_V(8); PG8_WAIT_L(0); PG8_BAR; PG8_MMA(1, 0, At, B0); PG8_MMA(1, 1, At, B1); PG8_BAR; PG8_SCHED;
            PG8_LDB(B0, 1, 0); PG8_LDB(B1, 1, 1); PG8_SCHED; PG8_LDA(At, 1, 0); PG8_STAGE(PG8_SA(0, 1), a2 + hstepA, voffA);
            PG8_WAIT_V(8); PG8_WAIT_L(0); PG8_BAR; PG8_MMA(0, 0, At, B0); PG8_MMA(0, 1, At, B1); PG8_BAR; PG8_SCHED;
            PG8_LDA(At, 1, 1); PG8_STAGE(PG8_SB(1, 0), b3, voffB); PG8_STAGE(PG8_SB(1, 1), b3 + hstepB, voffB); PG8_STAGE(PG8_SA(1, 0), a3, voffA);
            PG8_WAIT_V(8); PG8_WAIT_L(0); PG8_BAR; PG8_MMA(1, 0, At, B0); PG8_MMA(1, 1, At, B1); PG8_BAR; PG8_SCHED;
        }
        if constexpr (F8) asm volatile("s_nop 15\n\ts_nop 15" ::: "memory");
        if (wr == 0) PG8_BAR;
        const bool keep = E(acc, cur, wr, wc, fr, fq);
        if (!has_next) break;
        if (!keep) {
#pragma unroll
            for (int a = 0; a < 2; ++a)
#pragma unroll
                for (int b = 0; b < 2; ++b)
#pragma unroll
                    for (int m = 0; m < 4; ++m)
#pragma unroll
                        for (int n = 0; n < 2; ++n) acc[a][b][m][n] = (f32x4){0.f, 0.f, 0.f, 0.f};
        }
        cur = nxt; cA = nA; cB = nB; ++ui;
        if (wr == 1) PG8_BAR;
    }
    PG8_WAIT_V(0);
    PG8_BAR;
#undef PG8_SA
#undef PG8_SB
#undef PG8_STAGE
#undef PG8_LDA
#undef PG8_LDB
#undef PG8_MMA
#undef PG8_WAIT_V
#undef PG8_WAIT_L
#undef PG8_BAR
#undef PG8_SCHED
}
}

constexpr int RING_BYTES = 131072, MISC_OFF = RING_BYTES, RED_OFF = RING_BYTES + 1024, LDS_BYTES = 147456;

#define XB_TMO      128
#define XB_XCNT(j)  (256  + 64 * (j))
#define XB_XSUB(j)  (1280 + 64 * (j))
#define XB_XGEN(j)  (2304 + 64 * (j))
#define XB_TOP      3328
#define XB_TOPGEN   3392
#define XCD_BAR_WORDS 3456
#define XB_SPIN_CAP (1u << 18)
__device__ __forceinline__ unsigned xb_ld(unsigned* p)              { return __hip_atomic_load(p, __ATOMIC_RELAXED, __HIP_MEMORY_SCOPE_AGENT); }
__device__ __forceinline__ unsigned xb_add(unsigned* p, unsigned v) { return __hip_atomic_fetch_add(p, v, __ATOMIC_RELAXED, __HIP_MEMORY_SCOPE_AGENT); }
__device__ __forceinline__ unsigned xb_xcc_id() { return (unsigned)__builtin_amdgcn_s_getreg((3 << 11) | 20) & 0xFu; }
#define XB_SPIN(cond, bar) do { unsigned _sp = 0; while (cond) { __builtin_amdgcn_s_sleep(1); \
    if ((++_sp & 255u) == 0u) { if (xb_ld(&(bar)[XB_TMO])) break; if (_sp > XB_SPIN_CAP) { atomicAdd(&(bar)[XB_TMO], 1u); break; } } } } while (0)
struct XcdBarrier { unsigned* bar; unsigned x; volatile LAS unsigned* st; };
__device__ __forceinline__ XcdBarrier xcd_barrier_post(unsigned* bar, volatile LAS unsigned* st) {
    XcdBarrier b; b.bar = bar; b.x = xb_xcc_id(); b.st = st;
    if (threadIdx.x == 0) (void)xb_add(&bar[XB_XCNT(b.x)], 1u);
    return b;
}
__device__ __forceinline__ void xcd_barrier_complete(unsigned* bar, unsigned x, unsigned& nloc, unsigned& nx) {
    const unsigned G = gridDim.x * gridDim.y * gridDim.z;
    unsigned sum, cnt, mine, sp = 0u;
    for (;;) {
        sum = 0u; cnt = 0u; mine = 0u;
#pragma nounroll
        for (unsigned j = 0; j < 16; ++j) { const unsigned c = xb_ld(&bar[XB_XCNT(j)]); sum += c; cnt += (c > 0u) ? 1u : 0u; mine = (j == x) ? c : mine; }
        if (sum == G) break;
        __builtin_amdgcn_s_sleep(1);
        if ((++sp & 255u) == 0u) { if (xb_ld(&bar[XB_TMO])) break; if (sp > XB_SPIN_CAP) { atomicAdd(&bar[XB_TMO], 1u); break; } }
    }
    nloc = mine > 0u ? mine : 1u; nx = cnt > 0u ? cnt : 1u;
}
__device__ __forceinline__ void xcd_barrier(const XcdBarrier& b) {
    asm volatile("s_waitcnt vmcnt(0)" ::: "memory");
    __syncthreads();
    if (threadIdx.x == 0) {
        unsigned* bar = b.bar;
        __builtin_amdgcn_s_waitcnt(0);
        unsigned nloc = b.st[0], nx = b.st[1];
        if (nloc == 0u) { xcd_barrier_complete(bar, b.x, nloc, nx); b.st[0] = nloc; b.st[1] = nx; }
        const unsigned old = xb_add(&bar[XB_XSUB(b.x)], 1u);
        const unsigned gen = old / nloc;
        if (old + 1u == (gen + 1u) * nloc) {
            __builtin_amdgcn_fence(__ATOMIC_RELEASE, "agent");
            asm volatile("s_waitcnt vmcnt(0)" ::: "memory");
            const unsigned og = xb_add(&bar[XB_TOP], 1u);
            const unsigned tg = og / nx;
            if (og + 1u == (tg + 1u) * nx) xb_add(&bar[XB_TOPGEN], 1u);
            else XB_SPIN(xb_ld(&bar[XB_TOPGEN]) == tg, bar);
            __builtin_amdgcn_fence(__ATOMIC_ACQUIRE, "agent");
            xb_add(&bar[XB_XGEN(b.x)], 1u);
            asm volatile("s_waitcnt vmcnt(0)" ::: "memory");
        } else {
            XB_SPIN(xb_ld(&bar[XB_XGEN(b.x)]) == gen, bar);
            __builtin_amdgcn_fence(__ATOMIC_ACQUIRE, "agent");
            asm volatile("s_waitcnt vmcnt(0)" ::: "memory");
        }
    }
    __syncthreads();
}

struct Args { const float* in[23]; float* out; unsigned char* ws; int ph_lo, ph_hi; };
static_assert(sizeof(Args) == 23 * 8 + 8 + 8 + 8, "Args has no padding");
typedef const __attribute__((address_space(4))) Args* KArgs;
__device__ __forceinline__ KArgs kargs() { KArgs p = (KArgs)__builtin_amdgcn_kernarg_segment_ptr(); asm volatile("" : "+s"(p)); return p; }

__device__ __forceinline__ void transpose_item(const float* src, int ldn, int k0, int n0, bf16_t* dst, int ldk, const float* kscale, const float* nscale, int lane) {
    const int r4 = lane >> 4, q = lane & 15;
    f32x4 v[16];
    const float* sp = src + (size_t)(k0 + 16 * r4) * ldn + n0 + 4 * q;
#pragma unroll
    for (int i = 0; i < 16; ++i) v[i] = __builtin_nontemporal_load((const f32x4*)(sp + (size_t)i * ldn));
    f32x4 ns = (f32x4){1.f, 1.f, 1.f, 1.f}; if (nscale) ns = *(const f32x4*)(nscale + n0 + 4 * q);
    if (kscale) {
        const f32x4* kp = (const f32x4*)(kscale + k0 + 16 * r4);
#pragma unroll
        for (int g = 0; g < 4; ++g) { const f32x4 ks = kp[g];
#pragma unroll
            for (int j = 0; j < 4; ++j) v[4 * g + j] = v[4 * g + j] * ks[j]; }
    }
#pragma unroll
    for (int e = 0; e < 4; ++e) { u32x4 lo, hi;
#pragma unroll
        for (int w = 0; w < 4; ++w) { lo[w] = pk_bf16(v[2 * w][e] * ns[e], v[2 * w + 1][e] * ns[e]); hi[w] = pk_bf16(v[8 + 2 * w][e] * ns[e], v[9 + 2 * w][e] * ns[e]); }
        bf16_t* o = dst + (size_t)(4 * q + e) * ldk + k0 + 16 * r4; *(u32x4*)o = lo; *(u32x4*)(o + 8) = hi; }
}
__device__ __forceinline__ void transpose_item_f8(const float* src, int ldn, int k0, int n0, unsigned char* dst, int ldk, const float* kscale, float mul, int lane) {
    const int r4 = lane >> 4, q = lane & 15;
    f32x4 v[16];
    const float* sp = src + (size_t)(k0 + 16 * r4) * ldn + n0 + 4 * q;
#pragma unroll
    for (int i = 0; i < 16; ++i) v[i] = __builtin_nontemporal_load((const f32x4*)(sp + (size_t)i * ldn));
    {
        const f32x4* kp = (const f32x4*)(kscale + k0 + 16 * r4);
#pragma unroll
        for (int g = 0; g < 4; ++g) { f32x4 ks = (f32x4){mul, mul, mul, mul}; if (kscale) ks = kp[g] * mul;
#pragma unroll
            for (int j = 0; j < 4; ++j) v[4 * g + j] = v[4 * g + j] * ks[j]; }
    }
#pragma unroll
    for (int e = 0; e < 4; ++e) { u32x4 o;
#pragma unroll
        for (int w = 0; w < 4; ++w) o[w] = pk_fp8x4((f32x4){v[4 * w][e], v[4 * w + 1][e], v[4 * w + 2][e], v[4 * w + 3][e]});
        *(u32x4*)(dst + (size_t)(4 * q + e) * ldk + k0 + 16 * r4) = o; }
}
__device__ __forceinline__ int win_row(int n0) {
    const int seg = n0 >> 10, c = n0 & 1023;
    if (seg == 1 || seg == 2) return 1024 + (c >> 7) * 256 + (seg == 2 ? 128 : 0) + (c & 127);
    if (seg == 3 || seg == 4) return 3072 + (c >> 7) * 256 + (seg == 4 ? 128 : 0) + (c & 127);
    return n0;
}
__device__ __forceinline__ int pair_row(int f, int second) { return (f >> 7) * 256 + (second ? 128 : 0) + (f & 127); }

__device__ __forceinline__ void prologue_phase(KArgs a, LAS unsigned char* lds, int wid, int lane) {
    asm volatile("" : "+v"(lane));
    const int gw = blockIdx.x * 8 + wid, NGW = gridDim.x * 8;
    unsigned char* ws = a->ws;
    constexpr int I_WIN = 16 * 144, I_SQ = 16 * 16, I_PW = 16, I_D1 = 16 * 56, I_D2 = 56 * 16;
    constexpr int NIT = 2 * I_WIN + 8 * I_SQ + 8 * I_PW + 2 * I_D1 + I_D2;
    for (int it = gw; it < NIT; it += NGW) {
        int r = it;
        if (r < 2 * I_WIN) { const int L = r / I_WIN; r -= L * I_WIN; const int kb = r / 144, nb = r % 144, n0 = 64 * nb;
            transpose_item(a->in[2] + (size_t)L * D * INC, INC, 64 * kb, n0, (bf16_t*)(ws + WS_W0 + W0_WIN + (size_t)L * 18 * MiB) + (size_t)win_row(n0) * D, D, a->in[1] + L * D, nullptr, lane); continue; }
        r -= 2 * I_WIN;
        if (r < 8 * I_SQ) { const int j = r / I_SQ; r -= j * I_SQ; const int L = j >> 2, w = j & 3, kb = r / 16, nb = r % 16, n0 = 64 * nb;
            bf16_t* dst = w < 3 ? (bf16_t*)(ws + WS_W0 + W0_WOUT + (size_t)(L * 3 + w) * 2 * MiB) : (bf16_t*)(ws + WS_W0 + W0_WO + (size_t)L * 2 * MiB);
            transpose_item(a->in[10 + w] + (size_t)L * D * D, D, 64 * kb, n0, dst + (size_t)n0 * D, D, nullptr, nullptr, lane); continue; }
        r -= 8 * I_SQ;
        if (r < 8 * I_PW) { const int j = r / I_PW; r -= j * I_PW; const int L = j >> 2, g = j & 3;
            const float* src = a->in[8] + (size_t)(L * 4 + g) * 65536 + (size_t)r * 16 * 256; const float* sc = a->in[9] + L * D + g * 256;
            bf16_t* dst = (bf16_t*)(ws + WS_W0 + W0_POOL + (size_t)L * 512 * 1024) + (size_t)g * 65536 + (size_t)r * 16 * 256; const f32x4 s4 = *(const f32x4*)(sc + 4 * lane);
#pragma unroll
            for (int i = 0; i < 16; ++i) { const f32x4 v = *(const f32x4*)(src + i * 256 + 4 * lane) * s4; u32x2 w; w.x = pk_bf16(v[0], v[1]); w.y = pk_bf16(v[2], v[3]); *(u32x2*)(dst + i * 256 + 4 * lane) = w; }
            continue; }
        r -= 8 * I_PW;
        if (r < 2 * I_D1) { const int w = r / I_D1; r -= w * I_D1; const int kb = r / 56, nb = r % 56, n0 = 64 * nb;
            transpose_item(a->in[15 + w], DFF, 64 * kb, n0, (bf16_t*)(ws + WS_W0 + W0_D13) + (size_t)pair_row(n0, w) * D, D, a->in[14], nullptr, lane); continue; }
        r -= 2 * I_D1;
        { const int kb = r / 16, nb = r % 16, n0 = 64 * nb;
            transpose_item(a->in[17], D, 64 * kb, n0, (bf16_t*)(ws + WS_W0 + W0_D2) + (size_t)n0 * DFF, DFF, nullptr, nullptr, lane); }
    }
    const float* x = a->in[0]; bf16_t* xb = (bf16_t*)(ws + WS_XB); f32x4* ss0 = (f32x4*)(ws + WS_SS);
    for (int m = gw; m < M; m += NGW) {
        const f32x4* xr = (const f32x4*)(x + (size_t)m * D) + lane; u32x2* o = (u32x2*)(xb + (size_t)m * D) + lane; float s = 0.f;
#pragma unroll
        for (int j = 0; j < 4; ++j) { const f32x4 v = xr[64 * j]; s += (v[0] * v[0] + v[1] * v[1]) + (v[2] * v[2] + v[3] * v[3]); u32x2 w; w.x = pk_bf16(v[0], v[1]); w.y = pk_bf16(v[2], v[3]); o[64 * j] = w; }
        s = wave_sum(s); if (lane == 0) ss0[m] = (f32x4){s, 0.f, 0.f, 0.f};
    }
}

__device__ __forceinline__ void dma_block16(const bf16_t* src, LAS unsigned char* dst, int wid, int lane) {
#pragma unroll
    for (int k = 0; k < 4; ++k) { const int h = wid * 4 + k;
        __builtin_amdgcn_global_load_lds((const unsigned*)((const char*)src + h * 1024 + lane * 16), (LAS unsigned*)(dst + h * 1024), 16, 0, 0); }
}
__device__ __forceinline__ void zero_block16(LAS unsigned char* dst, int tid) {
#pragma unroll
    for (int k = 0; k < 4; ++k) *(LAS u32x4*)(dst + (size_t)(tid + 512 * k) * 16) = (u32x4){0u, 0u, 0u, 0u};
}
template <int I> __device__ __forceinline__ void conv31_pair(const LAS unsigned char* col, const unsigned (&wp)[31], f32x2 bias, f32x2 (&acc)[16]) {
    f32x2 x[46];
#pragma unroll
    for (int i = 0; i < 46; ++i) { const int r = i - 30, j = I + (r >> 4); const unsigned u = *(const LAS unsigned*)(col + ((j + 2) & 3) * 32768 + (r & 15) * 2048); x[i] = (f32x2){bf_lo(u), bf_hi(u)}; }
#pragma unroll
    for (int j = 0; j < 16; ++j) acc[j] = bias;
#pragma unroll
    for (int k = 0; k < 31; ++k) { const f32x2 wk = (f32x2){bf_lo(wp[k]), bf_hi(wp[k])};
#pragma unroll
        for (int j = 0; j < 16; ++j) acc[j] = __builtin_elementwise_fma(wk, x[j + k], acc[j]); }
}
template <int I, int CH> __device__ __forceinline__ void pool_ch(const LAS unsigned char* col, int g, int s0, float (&p)[16]) {
    float x[31], tv[16];
#pragma unroll
    for (int i = 0; i < 31; ++i) { const int r = i - 15, j = I + (r >> 4); const unsigned u = *(const LAS unsigned*)(col + ((j + 1) % 3) * 32768 + (r & 15) * 2048); x[i] = CH ? bf_hi(u) : bf_lo(u); }
#pragma unroll
    for (int j = 0; j < 16; ++j) tv[j] = x[15 + j];
#pragma unroll
    for (int i = 30; i >= 1; --i) x[i] += x[i - 1];
    if (g >= 1) {
#pragma unroll
        for (int i = 30; i >= 2; --i) x[i] += x[i - 2]; }
    if (g >= 2) {
#pragma unroll
        for (int i = 30; i >= 4; --i) x[i] += x[i - 4]; }
    if (g >= 3) {
#pragma unroll
        for (int i = 30; i >= 8; --i) x[i] += x[i - 8]; }
    const int w = 2 << g;
#pragma unroll
    for (int j = 0; j < 16; ++j) { const int cnt = min(s0 + j + 1, w); p[j] = x[15 + j] * (1.0f / (float)cnt) - tv[j]; }
}
struct ConvB { const bf16_t* GLU; __amdgpu_buffer_rsrc_t rVB; LAS unsigned char* lds; LAS float* red; LAS float* stat; f32x2 bb, gg, be; };
template <int I> __device__ __forceinline__ void convB_tile(const ConvB& c, unsigned (&wp)[31], int T0, int tid, int wid, int lane) {
    const int t0 = T0 + 16 * I; const LAS unsigned char* col = c.lds + 4 * tid;
#pragma unroll
    for (int k = 0; k < 31; ++k) asm volatile("" : "+v"(wp[k]));
    if (I < 3) dma_block16(c.GLU + (size_t)(t0 + 16) * D, c.lds + ((I + 3) & 3) * 32768, wid, lane);
    float a0[16], a1[16];
    { f32x2 ap[16]; conv31_pair<I>(col, wp, c.bb, ap);
#pragma unroll
      for (int j = 0; j < 16; ++j) { a0[j] = ap[j].x; a1[j] = ap[j].y; } }
    {
        float v[32];
#pragma unroll
        for (int j = 0; j < 16; ++j) { v[j] = a0[j] + a1[j]; v[16 + j] = a0[j] * a0[j] + a1[j] * a1[j]; }
#pragma unroll
        for (int i = 0; i < 16; ++i) { const bool b = lane & 32; const float send = b ? v[i] : v[i + 16], keep = b ? v[i + 16] : v[i]; v[i] = keep + __shfl_xor(send, 32); }
#pragma unroll
        for (int i = 0; i < 8; ++i) { const bool b = lane & 16; const float send = b ? v[i] : v[i + 8], keep = b ? v[i + 8] : v[i]; v[i] = keep + __shfl_xor(send, 16); }
#pragma unroll
        for (int i = 0; i < 4; ++i) { const bool b = lane & 8; const float send = b ? v[i] : v[i + 4], keep = b ? v[i + 4] : v[i]; v[i] = keep + __shfl_xor(send, 8); }
#pragma unroll
        for (int i = 0; i < 2; ++i) { const bool b = lane & 4; const float send = b ? v[i] : v[i + 2], keep = b ? v[i + 2] : v[i]; v[i] = keep + __shfl_xor(send, 4); }
        { const bool b = lane & 2; const float send = b ? v[0] : v[1], keep = b ? v[1] : v[0]; v[0] = keep + __shfl_xor(send, 2); }
        v[0] += __shfl_xor(v[0], 1);
        const int idx = ((lane >> 5) & 1) * 16 + ((lane >> 4) & 1) * 8 + ((lane >> 3) & 1) * 4 + ((lane >> 2) & 1) * 2 + ((lane >> 1) & 1);
        if (!(lane & 1)) c.red[wid * 32 + idx] = v[0];
    }
    __syncthreads();
    if (tid < 16) { float s = 0.f, q = 0.f;
#pragma unroll
        for (int w = 0; w < 8; ++w) { s += c.red[w * 32 + tid]; q += c.red[w * 32 + 16 + tid]; }
        const float mean = s * (1.0f / D), var = fmaxf(q * (1.0f / D) - mean * mean, 0.f);
        c.stat[2 * tid] = mean; c.stat[2 * tid + 1] = __builtin_amdgcn_rsqf(var + LN_EPS); }
    asm volatile("s_waitcnt vmcnt(0)" ::: "memory");
    __syncthreads();
#pragma unroll
    for (int j = 0; j < 16; ++j) { const float mean = c.stat[2 * j], rstd = c.stat[2 * j + 1];
        const float y0 = (a0[j] - mean) * rstd * c.gg.x + c.be.x, y1 = (a1[j] - mean) * rstd * c.gg.y + c.be.y;
        __builtin_amdgcn_raw_buffer_store_b32(pk_bf16(y0 * sigm(y0), y1 * sigm(y1)), c.rVB, 4 * tid, (t0 + j) * (D * 2), 0); }
}
struct ConvAC { const bf16_t* PU; __amdgpu_buffer_rsrc_t rSCB, rSCX, rYA, rPP; LAS unsigned char* lds; f32x2 s0w, s1w, s2w; };
__device__ __forceinline__ void convAC_load(const ConvAC& c, int t0, int tid, unsigned (&ub)[16], unsigned (&ux)[18]) {
#pragma unroll
    for (int j = 0; j < 16; ++j) ub[j] = __builtin_amdgcn_raw_buffer_load_b32(c.rSCB, 4 * tid, (t0 + j) * (D * 2), 0);
#pragma unroll
    for (int i = 0; i < 18; ++i) ux[i] = __builtin_amdgcn_raw_buffer_load_b32(c.rSCX, 4 * tid, (t0 + 62 + i) * (D * 2), 0);
}
template <int I> __device__ __forceinline__ void convAC_tile(const ConvAC& c, int T0, int tid, int wid, int lane, const unsigned (&ub)[16], const unsigned (&ux)[18], unsigned (&ubn)[16], unsigned (&uxn)[18]) {
    const int t0 = T0 + 16 * I, s0 = t0 & (SEQ - 1); const LAS unsigned char* col = c.lds + 4 * tid;
    if (I < 3) { convAC_load(c, t0 + 16, tid, ubn, uxn); dma_block16(c.PU + (size_t)(t0 + 16) * D, c.lds + ((I + 2) % 3) * 32768, wid, lane); }
    asm volatile("" ::: "memory");
    {
        float x0[18], x1[18];
#pragma unroll
        for (int i = 0; i < 18; ++i) { const unsigned u = (s0 - 2 + i) >= 0 ? ux[i] : 0u; x0[i] = bf_lo(u); x1[i] = bf_hi(u); }
#pragma unroll
        for (int j = 0; j < 16; ++j) {
            const float y0 = bf_lo(ub[j]) * (c.s0w.x * x0[j] + c.s1w.x * x0[j + 1] + c.s2w.x * x0[j + 2]), y1 = bf_hi(ub[j]) * (c.s0w.y * x1[j] + c.s1w.y * x1[j + 1] + c.s2w.y * x1[j + 2]);
            __builtin_amdgcn_raw_buffer_store_b32(pk_bf16(y0, y1), c.rYA, 4 * tid, (t0 + j) * (D * 2), 0); }
    }
    {
        float p0[16], p1[16];
        pool_ch<I, 0>(col, wid >> 1, s0, p0);
#pragma unroll
        for (int j = 0; j < 16; ++j) asm volatile("" : "+v"(p0[j]) :: "memory");
        pool_ch<I, 1>(col, wid >> 1, s0, p1);
#pragma unroll
        for (int j = 0; j < 16; ++j) __builtin_amdgcn_raw_buffer_store_b32(pk_bf16(p0[j], p1[j]), c.rPP, 4 * tid, (t0 + j) * (D * 2), 0);
    }
    if (I < 3) asm volatile("s_waitcnt vmcnt(32)" ::: "memory");
    __syncthreads();
}
__device__ __forceinline__ void conv_phase(KArgs a, int layer, LAS unsigned char* lds, int tid, int wid, int lane) {
    asm volatile("" : "+v"(tid), "+v"(lane));
    unsigned char* ws = a->ws;
    const int G = gridDim.x;
    const int vcu = (G % 8 == 0) ? (int)(blockIdx.x % 8) * (G / 8) + (int)(blockIdx.x / 8) : (int)blockIdx.x;
    const int c2 = 2 * tid;
    {
        const float* cfw = a->in[4] + layer * 31 * D; const float* cfb = a->in[5] + layer * D; const float* lng = a->in[6] + layer * D; const float* lnb = a->in[7] + layer * D;
        ConvB c; c.GLU = (const bf16_t*)(ws + A_GLU); c.rVB = __builtin_amdgcn_make_buffer_rsrc((void*)(ws + A_VB), 0, 0x7fffffff, 0x00020000);
        c.lds = lds; c.red = (LAS float*)(lds + RED_OFF); c.stat = c.red + 256;
        unsigned wp[31];
#pragma unroll
        for (int k = 0; k < 31; ++k) { const f32x2 w = *(const f32x2*)(cfw + k * D + c2); wp[k] = pk_bf16(w.x, w.y); }
        c.bb = *(const f32x2*)(cfb + c2); c.gg = *(const f32x2*)(lng + c2); c.be = *(const f32x2*)(lnb + c2);
        asm volatile("" :: "v"(c.bb.x), "v"(c.bb.y), "v"(c.gg.x), "v"(c.gg.y), "v"(c.be.x), "v"(c.be.y));
        for (int rp2 = 0; rp2 < REPS2(21); ++rp2)
        for (int sup = vcu; sup < M / 64; sup += G) {
            const int T0 = sup * 64; const bool seq0 = (T0 & (SEQ - 1)) == 0;
            if (seq0) { zero_block16(lds, tid); zero_block16(lds + 32768, tid); } else { dma_block16(c.GLU + (size_t)(T0 - 32) * D, lds, wid, lane); dma_block16(c.GLU + (size_t)(T0 - 16) * D, lds + 32768, wid, lane); }
            dma_block16(c.GLU + (size_t)T0 * D, lds + 65536, wid, lane);
            asm volatile("s_waitcnt vmcnt(0)" ::: "memory");
            __syncthreads();
            convB_tile<0>(c, wp, T0, tid, wid, lane); convB_tile<1>(c, wp, T0, tid, wid, lane); convB_tile<2>(c, wp, T0, tid, wid, lane); convB_tile<3>(c, wp, T0, tid, wid, lane);
            __syncthreads();
        }
    }
    __syncthreads();
    {
        const float* scw = a->in[3] + layer * 3 * D;
        ConvAC c; c.PU = (const bf16_t*)(ws + A_PU); c.lds = lds;
        c.rSCB = __builtin_amdgcn_make_buffer_rsrc((void*)(ws + A_SCB), 0, 0x7fffffff, 0x00020000); c.rSCX = __builtin_amdgcn_make_buffer_rsrc((void*)(ws + A_SCX - 64 * D * 2), 0, 0x7fffffff, 0x00020000);
        c.rYA = __builtin_amdgcn_make_buffer_rsrc((void*)(ws + A_YA), 0, 0x7fffffff, 0x00020000); c.rPP = __builtin_amdgcn_make_buffer_rsrc((void*)(ws + A_PP), 0, 0x7fffffff, 0x00020000);
        c.s0w = *(const f32x2*)(scw + c2); c.s1w = *(const f32x2*)(scw + D + c2); c.s2w = *(const f32x2*)(scw + 2 * D + c2);
        asm volatile("" :: "v"(c.s0w.x), "v"(c.s0w.y), "v"(c.s1w.x), "v"(c.s1w.y), "v"(c.s2w.x), "v"(c.s2w.y));
        for (int rp2 = 0; rp2 < REPS2(22); ++rp2)
        for (int sup = vcu; sup < M / 64; sup += G) {
            const int T0 = sup * 64; const bool seq0 = (T0 & (SEQ - 1)) == 0;
            if (seq0) zero_block16(lds, tid); else dma_block16(c.PU + (size_t)(T0 - 16) * D, lds, wid, lane);
            dma_block16(c.PU + (size_t)T0 * D, lds + 32768, wid, lane);
            unsigned ubA[16], uxA[18], ubB[16], uxB[18]; convAC_load(c, T0, tid, ubA, uxA);
            asm volatile("s_waitcnt vmcnt(0)" ::: "memory");
            __syncthreads();
            convAC_tile<0>(c, T0, tid, wid, lane, ubA, uxA, ubB, uxB); convAC_tile<1>(c, T0, tid, wid, lane, ubB, uxB, ubA, uxA); convAC_tile<2>(c, T0, tid, wid, lane, ubA, uxA, ubB, uxB); convAC_tile<3>(c, T0, tid, wid, lane, ubB, uxB, ubA, uxA);
        }
    }
}

__device__ __forceinline__ void route_phase(KArgs a, LAS unsigned char* lds, int tid, int wid, int lane) {
    asm volatile("" : "+v"(tid), "+v"(lane));
    unsigned char* ws = a->ws;
    const bf16_t* X = (const bf16_t*)(ws + WS_XB); const float* gn = a->in[14] + D; const float* R = a->in[18];
    const f32x4* ss3 = (const f32x4*)(ws + WS_SS) + 3 * M;
    int* tope = (int*)(ws + WS_SMALL + SM_TOPE); f32x2* topp = (f32x2*)(ws + WS_SMALL + SM_TOPP); int* cntb = (int*)(ws + WS_CTL + CTL_CNT);
    LAS int* lcnt = (LAS int*)(lds + 98304);
    float wgt[2][8][8];
#pragma unroll
    for (int h = 0; h < 2; ++h)
#pragma unroll
        for (int i = 0; i < 8; ++i) { const int k = 8 * lane + 512 * h + i; const float g = gn[k]; const f32x4 r0 = *(const f32x4*)(R + k * 8), r1 = *(const f32x4*)(R + k * 8 + 4);
#pragma unroll
            for (int e = 0; e < 4; ++e) { wgt[h][i][e] = g * r0[e]; wgt[h][i][4 + e] = g * r1[e]; } }
    for (int vb = blockIdx.x; vb < 256; vb += gridDim.x) {
        if (tid < 8) lcnt[tid] = 0;
        __syncthreads();
        for (int i8 = 0; i8 < 8; ++i8) {
            const int t = vb * 64 + wid * 8 + i8;
            float lg[8];
#pragma unroll
            for (int e = 0; e < 8; ++e) lg[e] = 0.f;
#pragma unroll
            for (int h = 0; h < 2; ++h) { f32x4 v0, v1; pg8::unpack8(*(const u32x4*)(X + (size_t)t * D + 512 * h + 8 * lane), v0, v1);
#pragma unroll
                for (int i = 0; i < 4; ++i)
#pragma unroll
                    for (int e = 0; e < 8; ++e) { lg[e] = fmaf(v0[i], wgt[h][i][e], lg[e]); lg[e] = fmaf(v1[i], wgt[h][4 + i][e], lg[e]); } }
#pragma unroll
            for (int e = 0; e < 8; ++e) lg[e] = wave_sum(lg[e]);
            const f32x4 sp = ss3[t]; const float rstd = __builtin_amdgcn_rsqf(((sp[0] + sp[1]) + (sp[2] + sp[3])) * (1.0f / D) + RMS_EPS);
            int e1 = 0; float v1 = lg[0];
#pragma unroll
            for (int e = 1; e < 8; ++e) if (lg[e] > v1) { v1 = lg[e]; e1 = e; }
            int e2 = e1 == 0 ? 1 : 0; float v2 = -__builtin_inff();
#pragma unroll
            for (int e = 0; e < 8; ++e) if (e != e1 && lg[e] > v2) { v2 = lg[e]; e2 = e; }
            const float ex = __expf((v2 - v1) * rstd), p1 = 1.0f / (1.0f + ex), p2 = ex * p1;
            if (lane == 0) { tope[t] = e1 | (e2 << 8); topp[t] = (f32x2){p1, p2}; atomicAdd((int*)&lcnt[e1], 1); atomicAdd((int*)&lcnt[e2], 1); }
        }
        __syncthreads();
        if (tid < 8) cntb[vb * 8 + tid] = lcnt[tid];
        __syncthreads();
    }
    const int gw = blockIdx.x * 8 + wid, NGW = gridDim.x * 8;
    constexpr int I_1 = 16 * 56, I_13 = 2 * I_1, I_2 = 56 * 16;
    unsigned char* w13 = ws + WS_WMOE; unsigned char* w2t = ws + WS_WMOE + WMOE_W2;
    for (int it = gw; it < NE * (I_13 + I_2); it += NGW) {
        int r = it;
        if (r < NE * I_13) { const int e = r / I_13; r -= e * I_13; const int w = r / I_1; r -= w * I_1; const int kb = r / 56, nb = r % 56, n0 = 64 * nb;
            transpose_item_f8(a->in[19 + w] + (size_t)e * D * DFF, DFF, 64 * kb, n0, w13 + (size_t)e * (2 * DFF) * D + (size_t)pair_row(n0, w) * D, D, gn, F8_W13_MUL, lane); continue; }
        r -= NE * I_13;
        { const int e = r / I_2; r -= e * I_2; const int kb = r / 16, nb = r % 16, n0 = 64 * nb;
            transpose_item_f8(a->in[21] + (size_t)e * DFF * D, D, 64 * kb, n0, w2t + (size_t)e * D * DFF + (size_t)n0 * DFF, DFF, nullptr, F8_W2_MUL, lane); }
    }
}

__device__ __forceinline__ void scatter_phase(KArgs a, LAS unsigned char* lds, int tid, int wid, int lane) {
    asm volatile("" : "+v"(tid), "+v"(lane));
    unsigned char* ws = a->ws;
    const int* tope = (const int*)(ws + WS_SMALL + SM_TOPE); int* tslot = (int*)(ws + WS_SMALL + SM_TSLOT); float* ssperm = (float*)(ws + WS_SMALL + SM_SSPERM); int* meta = (int*)(ws + WS_SMALL + SM_META);
    const int* cntb = (const int*)(ws + WS_CTL + CTL_CNT); const f32x4* ss3 = (const f32x4*)(ws + WS_SS) + 3 * M;
    const bf16_t* X = (const bf16_t*)(ws + WS_XB); unsigned char* AP = ws + WS_APERM;
    LAS int* lc = (LAS int*)lds;
    LAS int* lbase = lc + 2048;
    LAS int* lslot = lc + 2064;
    LAS int* ltot = lc + 2200;
    for (int i = tid; i < 2048; i += 512) lc[i] = __hip_atomic_load(cntb + i, __ATOMIC_RELAXED, __HIP_MEMORY_SCOPE_AGENT);
    __syncthreads();
    for (int vb = blockIdx.x; vb < 256; vb += gridDim.x) {
        if (tid < 8) { int tot = 0, pre = 0;
#pragma unroll 8
            for (int b = 0; b < 256; ++b) { const int v = lc[b * 8 + tid]; tot += v; pre += (b < vb) ? v : 0; }
            ltot[tid] = tot; lbase[tid] = pre; }
        __syncthreads();
        if (tid == 0) { int off = 0;
            for (int e = 0; e < 8; ++e) { lbase[e] += off; if (vb == 0) meta[e] = off >> 8; off += (ltot[e] + 255) & ~255; }
            if (vb == 0) meta[8] = off >> 8; }
        __syncthreads();
        if (wid == 0) {
            const int t = vb * 64 + lane; const int te = tope[t]; const int e1 = te & 0xff, e2 = (te >> 8) & 0xff;
            int s1 = 0, s2 = 0;
#pragma unroll
            for (int k = 0; k < 2; ++k) { const int ek = k ? e2 : e1; int sk = 0;
#pragma unroll
                for (int e = 0; e < 8; ++e) { const unsigned long long mask = __ballot(ek == e); const int base = lbase[e]; LDS_WAIT();
                    const int rank = __popcll(mask & ((1ull << lane) - 1ull)); if (ek == e) sk = base + rank;
                    if (lane == 0) lbase[e] = base + __popcll(mask); LDS_WAIT(); }
                if (k) s2 = sk; else s1 = sk; }
            *(int2*)(tslot + 2 * t) = make_int2(s1, s2); lslot[lane] = s1; lslot[64 + lane] = s2;
        }
        __syncthreads();
        for (int rb = 0; rb < 2; ++rb) {
            u32x4 xv[8][2]; f32x4 sp[8];
#pragma unroll
            for (int i = 0; i < 8; ++i) { const int r = wid + 8 * (rb * 8 + i), t = vb * 64 + (r & 63); const u32x4* src = (const u32x4*)(X + (size_t)t * D) + 2 * lane; xv[i][0] = src[0]; xv[i][1] = src[1]; sp[i] = ss3[t]; }
#pragma unroll
            for (int i = 0; i < 8; ++i) { const int r = wid + 8 * (rb * 8 + i), slot = lslot[r];
                const float rstd = __builtin_amdgcn_rsqf(((sp[i][0] + sp[i][1]) + (sp[i][2] + sp[i][3])) * (1.0f / D) + RMS_EPS);
                f32x4 v0, v1, v2, v3; pg8::unpack8(xv[i][0], v0, v1); pg8::unpack8(xv[i][1], v2, v3);
                *((u32x4*)(AP + (size_t)slot * D) + lane) = (u32x4){pk_fp8x4(v0 * rstd), pk_fp8x4(v1 * rstd), pk_fp8x4(v2 * rstd), pk_fp8x4(v3 * rstd)}; } }
        __syncthreads();
    }
}

__device__ __forceinline__ void combine_phase(KArgs a, int wid, int lane) {
    asm volatile("" : "+v"(lane));
    unsigned char* ws = a->ws;
    const bf16_t* X = (const bf16_t*)(ws + WS_XB); const bf16_t* Y = (const bf16_t*)(ws + WS_Y); const int* tslot = (const int*)(ws + WS_SMALL + SM_TSLOT); const f32x2* topp = (const f32x2*)(ws + WS_SMALL + SM_TOPP);
    const float* gf = a->in[22]; float* out = a->out;
    const int gw = blockIdx.x * 8 + wid, NGW = gridDim.x * 8;
    f32x4 gv[4];
#pragma unroll
    for (int h = 0; h < 2; ++h) { gv[2 * h] = *(const f32x4*)(gf + 512 * h + 8 * lane); gv[2 * h + 1] = *(const f32x4*)(gf + 512 * h + 8 * lane + 4); }
    for (int tb = gw; tb < M; tb += 4 * NGW) {
        int2 sl[4]; f32x2 p[4];
#pragma unroll
        for (int i = 0; i < 4; ++i) { const int t = min(tb + i * NGW, M - 1); sl[i] = *(const int2*)(tslot + 2 * t); p[i] = topp[t]; }
        u32x4 xr[4][2], ya[4][2], yb[4][2];
#pragma unroll
        for (int i = 0; i < 4; ++i) { const int t = min(tb + i * NGW, M - 1);
#pragma unroll
            for (int h = 0; h < 2; ++h) { const int col = 512 * h + 8 * lane;
                xr[i][h] = *(const u32x4*)(X + (size_t)t * D + col); ya[i][h] = *(const u32x4*)(Y + (size_t)sl[i].x * D + col); yb[i][h] = *(const u32x4*)(Y + (size_t)sl[i].y * D + col); } }
#pragma unroll
        for (int i = 0; i < 4; ++i) { const int t = tb + i * NGW; if (t < M) {
            f32x4 v[4]; float s = 0.f;
#pragma unroll
            for (int h = 0; h < 2; ++h) { f32x4 x0, x1, a0, a1, b0, b1; pg8::unpack8(xr[i][h], x0, x1); pg8::unpack8(ya[i][h], a0, a1); pg8::unpack8(yb[i][h], b0, b1);
                v[2 * h] = x0 + a0 * p[i].x + b0 * p[i].y; v[2 * h + 1] = x1 + a1 * p[i].x + b1 * p[i].y; }
#pragma unroll
            for (int k = 0; k < 4; ++k) s += (v[k][0] * v[k][0] + v[k][1] * v[k][1]) + (v[k][2] * v[k][2] + v[k][3] * v[k][3]);
            const float rstd = __builtin_amdgcn_rsqf(wave_sum(s) * (1.0f / D) + RMS_EPS);
#pragma unroll
            for (int h = 0; h < 2; ++h) { const int col = 512 * h + 8 * lane;
                *(f32x4*)(out + (size_t)t * D + col) = v[2 * h] * rstd * gv[2 * h]; *(f32x4*)(out + (size_t)t * D + col + 4) = v[2 * h + 1] * rstd * gv[2 * h + 1]; } } }
    }
}

#ifndef WGM_INPROJ
#define WGM_INPROJ 4
#endif
#ifndef WGM_FFN1
#define WGM_FFN1 4
#endif
#ifndef WGM_MOE1
#define WGM_MOE1 4
#endif
constexpr int NPH = 18;
#ifndef MK_PH_MASK
#define MK_PH_MASK 0xFFFFFFFFu
#endif
#define PHON(bit) ((((MK_PH_MASK) >> (bit)) & 1u) != 0u)


__device__ __forceinline__ void ph_inproj(KArgs a, int layer, LAS unsigned char* lds) {
    unsigned char* ws = a->ws;
    pg8::Gemm g{2 * D, 2 * D, 2 * D, 0, 0}; pg8::PlainSched S{M / 256, INC / 256, (int)gridDim.x, (int)blockIdx.x, (const char*)(ws + WS_XB), (const char*)(ws + WS_W0 + W0_WIN + (size_t)layer * 18 * MiB), (size_t)256 * D * 2, (size_t)256 * D * 2, WGM_INPROJ};
    pg8::EpiProj E{(bf16_t*)(ws + A_SCB), (bf16_t*)(ws + A_SCX), (bf16_t*)(ws + A_GLU), (bf16_t*)(ws + A_PU), (bf16_t*)(ws + A_GATES), (const f32x4*)(ws + WS_SS) + (size_t)(layer * 2) * M};
    pg8::gemm_phase(lds, g, S, E);
}
__device__ __forceinline__ void ph_fold(KArgs a, LAS unsigned char* lds) {
    unsigned char* ws = a->ws;
    pg8::Gemm g{512, 2 * D, 512, 0, 0}; pg8::FoldSched S{(int)gridDim.x, (int)blockIdx.x, (const char*)(ws + WS_W0 + W0_WOUT + 2 * 2 * MiB), (const char*)(ws + WS_W0 + W0_POOL)};
    pg8::EpiPlain E{(bf16_t*)(ws + WS_WC), D, (size_t)D * D};
    pg8::gemm_phase(lds, g, S, E);
}
__device__ __forceinline__ void ph_merge(KArgs a, int layer, LAS unsigned char* lds) {
    unsigned char* ws = a->ws;
    pg8::Gemm g{2 * D, 2 * D, 2 * D, 0, 0}; pg8::MergeSched S{(int)gridDim.x, (int)blockIdx.x, (const char*)(ws + A_YA), (const char*)(ws + WS_W0 + W0_WOUT + (size_t)(layer * 3) * 2 * MiB), (const char*)(ws + WS_WC + (size_t)layer * 2 * MiB), (size_t)32 * MiB, (size_t)2 * MiB};
    pg8::EpiMerge E{(const bf16_t*)(ws + A_GATES), (bf16_t*)(ws + A_MERGED)};
    pg8::gemm_phase(lds, g, S, E);
}
__device__ __forceinline__ void ph_wo(KArgs a, int layer, LAS unsigned char* lds) {
    unsigned char* ws = a->ws;
    pg8::Gemm g{2 * D, 2 * D, 2 * D, 0, 0}; pg8::PlainSched S{M / 256, D / 256, (int)gridDim.x, (int)blockIdx.x, (const char*)(ws + A_MERGED), (const char*)(ws + WS_W0 + W0_WO + (size_t)layer * 2 * MiB), (size_t)256 * D * 2, (size_t)256 * D * 2, 4};
    pg8::EpiResid E{layer == 0 ? a->in[0] : (const float*)nullptr, (bf16_t*)(ws + WS_XB), (float*)(ws + WS_SS) + (size_t)(layer * 2 + 1) * M * 4, (LAS float*)(lds + RED_OFF)};
    pg8::gemm_phase(lds, g, S, E);
}
__device__ __forceinline__ void ph_ffn1(KArgs a, LAS unsigned char* lds) {
    unsigned char* ws = a->ws;
    pg8::Gemm g{2 * D, 2 * D, 2 * D, 0, 0}; pg8::PlainSched S{M / 256, 2 * DFF / 256, (int)gridDim.x, (int)blockIdx.x, (const char*)(ws + WS_XB), (const char*)(ws + WS_W0 + W0_D13), (size_t)256 * D * 2, (size_t)256 * D * 2, WGM_FFN1};
    pg8::EpiSwiGLU<true, false> E{(bf16_t*)(ws + A_FFN), DFF, (const float*)(ws + WS_SS) + (size_t)1 * M * 4};
    pg8::gemm_phase(lds, g, S, E);
}
__device__ __forceinline__ void ph_ffn2(KArgs a, LAS unsigned char* lds) {
    unsigned char* ws = a->ws;
    pg8::Gemm g{2 * DFF, 2 * DFF, 2 * DFF, 0, 0}; pg8::PlainSched S{M / 256, D / 256, (int)gridDim.x, (int)blockIdx.x, (const char*)(ws + A_FFN), (const char*)(ws + WS_W0 + W0_D2), (size_t)256 * DFF * 2, (size_t)256 * DFF * 2, 4};
    pg8::EpiResid E{(const float*)nullptr, (bf16_t*)(ws + WS_XB), (float*)(ws + WS_SS) + (size_t)2 * M * 4, (LAS float*)(lds + RED_OFF)};
    pg8::gemm_phase(lds, g, S, E);
}
__device__ __forceinline__ void ph_moe(KArgs a, int which, LAS unsigned char* lds) {
    unsigned char* ws = a->ws;
    const int* meta = (const int*)(ws + WS_SMALL + SM_META); int o[9];
#pragma unroll
    for (int e = 0; e < 9; ++e) o[e] = __builtin_amdgcn_readfirstlane(__hip_atomic_load(meta + e, __ATOMIC_RELAXED, __HIP_MEMORY_SCOPE_AGENT));
    const int nM = o[8] > MAXSLOT / 256 ? MAXSLOT / 256 : o[8];
    if (which == 0) {
        pg8::Gemm g{D, D, D, F8_ONE, F8_W13_SC}; pg8::GroupSched S{nM, 2 * DFF / 256, (int)gridDim.x, (int)blockIdx.x, o[1], o[2], o[3], o[4], o[5], o[6], o[7], (const char*)(ws + WS_APERM), (const char*)(ws + WS_WMOE), (size_t)256 * D, (size_t)256 * D, (size_t)2 * DFF * D, WGM_MOE1};
        pg8::EpiSwiGLU<false, true> E{(bf16_t*)(ws + WS_ACTP), DFF, nullptr};
        pg8::gemm_phase<pg8::EpiSwiGLU<false, true>, pg8::GroupSched, true>(lds, g, S, E);
    } else {
        pg8::Gemm g{DFF, DFF, DFF, F8_ACT_SC, F8_W2_SC}; pg8::GroupSched S{nM, D / 256, (int)gridDim.x, (int)blockIdx.x, o[1], o[2], o[3], o[4], o[5], o[6], o[7], (const char*)(ws + WS_ACTP), (const char*)(ws + WS_WMOE + WMOE_W2), (size_t)256 * DFF, (size_t)256 * DFF, (size_t)D * DFF, 4};
        pg8::EpiPlain E{(bf16_t*)(ws + WS_Y), D, 0};
        pg8::gemm_phase<pg8::EpiPlain, pg8::GroupSched, true>(lds, g, S, E);
    }
}

__global__ void __launch_bounds__(512, 2) fwd(Args unused_args_read_through_kargs) {
    extern __shared__ __attribute__((aligned(16))) unsigned char lds_raw[];
    LAS unsigned char* lds = (LAS unsigned char*)lds_raw;
    volatile LAS unsigned* MISC = (volatile LAS unsigned*)(lds + MISC_OFF);
    const int tid = threadIdx.x, lane = tid & 63, wid = __builtin_amdgcn_readfirstlane(tid >> 6);
    if (tid < 64) MISC[tid] = 0u;
    __syncthreads();
    int lo, hi; XcdBarrier bar;
    { KArgs a = kargs(); lo = a->ph_lo; hi = a->ph_hi; unsigned* bw = (unsigned*)(a->ws + WS_CTL + CTL_BAR); bar.bar = bw; bar.x = 0; bar.st = nullptr; if (hi - lo > 1) bar = xcd_barrier_post(bw, MISC + 8); }
#define IN(k) (lo <= (k) && (k) < hi)
#define SEAM(k) do { if (IN(k) && IN((k) + 1)) xcd_barrier(bar); } while (0)

    if (PHON(0) && IN(0)) { for (int rp = 0; rp < REPS(0); ++rp) { prologue_phase(kargs(), lds, wid, lane); __syncthreads(); } } SEAM(0);
#pragma nounroll
    for (int layer = 0; layer < 2; ++layer) {
        const int pb = 1 + 7 * layer;
        if (PHON(1) && IN(pb + 0)) { for (int rp = 0; rp < REPS(1); ++rp) { if (layer == 0) { ph_fold(kargs(), lds); __syncthreads(); } ph_inproj(kargs(), layer, lds); __syncthreads(); } } SEAM(pb + 0);
        if (PHON(2) && IN(pb + 1)) { for (int rp = 0; rp < REPS(2); ++rp) { conv_phase(kargs(), layer, lds, tid, wid, lane); __syncthreads(); } } SEAM(pb + 1);
        if (PHON(4) && IN(pb + 3)) { for (int rp = 0; rp < REPS(4); ++rp) { ph_merge(kargs(), layer, lds); __syncthreads(); } } SEAM(pb + 3);
        if (PHON(5) && IN(pb + 4)) { for (int rp = 0; rp < (layer == 0 ? REPS(5) : 1); ++rp) { ph_wo(kargs(), layer, lds); __syncthreads(); } } SEAM(pb + 4);
        if (layer == 0) {
            if (PHON(6) && IN(6)) { for (int rp = 0; rp < REPS(6); ++rp) { ph_ffn1(kargs(), lds); __syncthreads(); } } SEAM(6);
            if (PHON(7) && IN(7)) { ph_ffn2(kargs(), lds); } SEAM(7);
        }
    }
    if (PHON(13) && IN(13)) { for (int rp = 0; rp < REPS(13); ++rp) { route_phase(kargs(), lds, tid, wid, lane); __syncthreads(); } } SEAM(13);
    if (PHON(14) && IN(14)) { for (int rp = 0; rp < REPS(14); ++rp) { scatter_phase(kargs(), lds, tid, wid, lane); __syncthreads(); } } SEAM(14);
    if (PHON(15) && IN(15)) { for (int rp = 0; rp < REPS(15); ++rp) { ph_moe(kargs(), 0, lds); __syncthreads(); } } SEAM(15);
    if (PHON(16) && IN(16)) { for (int rp = 0; rp < REPS(16); ++rp) { ph_moe(kargs(), 1, lds); __syncthreads(); } } SEAM(16);
    if (PHON(17) && IN(17)) { for (int rp = 0; rp < REPS(17); ++rp) { combine_phase(kargs(), wid, lane); __syncthreads(); } }
#undef IN
#undef SEAM
}

extern "C" void kernel_launch(void* const* d_in, const int* in_sizes, int n_in, void* d_out, int out_size, void* d_ws, size_t ws_size, hipStream_t stream) {
    static int grid = 0;
    if (grid == 0) {
        if (n_in != 23 || in_sizes[0] != M * D || out_size != M * D || ws_size < WS_END) { fprintf(stderr, "kernel_launch: unexpected shapes: n_in %d in0 %d out %d ws %zu (need %zu); nothing launched\n", n_in, n_in > 0 ? in_sizes[0] : -1, out_size, ws_size, (size_t)WS_END); grid = -1; return; }
        int dev = 0, cus = 0, per_cu = 0;
        if (hipGetDevice(&dev) != hipSuccess || hipDeviceGetAttribute(&cus, hipDeviceAttributeMultiprocessorCount, dev) != hipSuccess) { fprintf(stderr, "kernel_launch: device query failed\n"); grid = -1; return; }
        if (hipFuncSetAttribute((const void*)fwd, hipFuncAttributeMaxDynamicSharedMemorySize, LDS_BYTES) != hipSuccess) { fprintf(stderr, "kernel_launch: hipFuncSetAttribute failed\n"); grid = -1; return; }
        if (hipOccupancyMaxActiveBlocksPerMultiprocessor(&per_cu, (const void*)fwd, 512, LDS_BYTES) != hipSuccess || per_cu < 1) fprintf(stderr, "kernel_launch: note: occupancy query reports %d workgroups per CU\n", per_cu);
        (void)hipGetLastError();
        grid = cus;
    }
    if (grid < 0) return;
    if (hipMemsetAsync((char*)d_ws + WS_CTL, 0, CTL_BYTES, stream) != hipSuccess) { fprintf(stderr, "kernel_launch: memset failed\n"); return; }
    Args a{};
    for (int i = 0; i < 23; ++i) a.in[i] = (const float*)d_in[i];
    a.out = (float*)d_out; a.ws = (unsigned char*)d_ws;
#if MK_PER_PHASE
    for (int ph = 0; ph < NPH; ++ph) { a.ph_lo = ph; a.ph_hi = ph + 1; hipLaunchKernelGGL(fwd, dim3(grid), dim3(512), LDS_BYTES, stream, a); }
#else
    a.ph_lo = 0; a.ph_hi = NPH; hipLaunchKernelGGL(fwd, dim3(grid), dim3(512), LDS_BYTES, stream, a);
#endif
    const hipError_t le = hipPeekAtLastError();
    if (le != hipSuccess) fprintf(stderr, "kernel_launch: launch failed: %s\n", hipGetErrorName(le));
}
```

```cpp
#include <hip/hip_runtime.h>
#include <cstdio>
#include <cstdint>

#ifndef MK_PER_PHASE
#define MK_PER_PHASE 0
#endif

#ifndef MK_REP_MASK
#define MK_REP_MASK 0u
#endif
#define REPS(bit) (1 + (int)(((MK_REP_MASK) >> (bit)) & 1u))
#define REPS2(bit) REPS(bit)

#define LAS __attribute__((address_space(3)))
typedef unsigned short bf16_t;
typedef short bf16x8 __attribute__((ext_vector_type(8)));
typedef float f32x4 __attribute__((ext_vector_type(4)));
typedef float f32x2 __attribute__((ext_vector_type(2)));
typedef unsigned u32x4 __attribute__((ext_vector_type(4)));
typedef unsigned u32x2 __attribute__((ext_vector_type(2)));

constexpr int M = 16384, D = 1024, SEQ = 8192, INC = 9216, DFF = 3584, NE = 8;
constexpr float RMS_EPS = 1e-6f, LN_EPS = 1e-5f;
constexpr int MAXSLOT = 34816;
constexpr float F8_W13_MUL = 128.f, F8_ACT_MUL = 4.f, F8_W2_MUL = 256.f;
constexpr int F8_ONE = 0x7f7f7f7f, F8_W13_SC = 0x78787878  , F8_ACT_SC = 0x7d7d7d7d  , F8_W2_SC = 0x77777777  ;

constexpr size_t MiB = 1u << 20;
constexpr size_t WS_CTL = 0, CTL_BYTES = 64 * 1024;
constexpr size_t CTL_BAR = 16384;
constexpr size_t CTL_CNT = 32768;
constexpr size_t WS_SMALL = 1 * MiB;
constexpr size_t SM_TOPE = 0, SM_TOPP = 64 * 1024, SM_TSLOT = 192 * 1024, SM_SSPERM = 320 * 1024, SM_META = 512 * 1024;
constexpr size_t WS_X8 = 2 * MiB;
constexpr size_t WS_WG8 = 58 * MiB;
constexpr size_t WS_XB = 66 * MiB;
constexpr size_t WS_W0 = 98 * MiB;
constexpr size_t W0_WIN = 0;
constexpr size_t W0_WOUT = 36 * MiB;
constexpr size_t W0_WO = 48 * MiB;
constexpr size_t W0_POOL = 52 * MiB;
constexpr size_t W0_D13 = 53 * MiB;
constexpr size_t W0_D2 = 67 * MiB;
constexpr size_t WS_ACT = 172 * MiB;
constexpr size_t A_SCB = WS_ACT, A_SCX = WS_ACT + 32 * MiB, A_GLU = WS_ACT + 64 * MiB, A_PU = WS_ACT + 96 * MiB, A_GATES = WS_ACT + 128 * MiB,
                 A_YA = WS_ACT + 224 * MiB, A_VB = WS_ACT + 256 * MiB, A_PP = WS_ACT + 288 * MiB, A_MERGED = A_SCX, A_FFN = WS_ACT;
constexpr size_t WS_WC = 524 * MiB;
constexpr size_t WS_ACTP = 98 * MiB;
constexpr size_t WS_WMOE = 304 * MiB, WMOE_W2 = 56 * MiB;
constexpr size_t WS_Y = 400 * MiB;
constexpr size_t WS_APERM = 472 * MiB;
constexpr size_t WS_SS = 540 * MiB;
constexpr size_t WS_END = 541 * MiB;

typedef __bf16 bf16x2_t __attribute__((ext_vector_type(2)));
__device__ __forceinline__ unsigned pk_bf16(float lo, float hi) { const bf16x2_t v = {(__bf16)lo, (__bf16)hi}; return __builtin_bit_cast(unsigned, v); }
__device__ __forceinline__ unsigned pk_fp8x4(const f32x4 v) {
    const float a = __builtin_amdgcn_fmed3f(v[0], -448.f, 448.f), b = __builtin_amdgcn_fmed3f(v[1], -448.f, 448.f), c = __builtin_amdgcn_fmed3f(v[2], -448.f, 448.f), d = __builtin_amdgcn_fmed3f(v[3], -448.f, 448.f);
    int w = 0; w = __builtin_amdgcn_cvt_pk_fp8_f32(a, b, w, false); w = __builtin_amdgcn_cvt_pk_fp8_f32(c, d, w, true); return (unsigned)w; }
__device__ __forceinline__ float bf_lo(unsigned u) { return __uint_as_float(u << 16); }
__device__ __forceinline__ float bf_hi(unsigned u) { return __uint_as_float(u & 0xffff0000u); }
__device__ __forceinline__ float sigm(float x) { return __builtin_amdgcn_rcpf(1.f + __builtin_amdgcn_exp2f(-1.44269504f * x)); }
__device__ __forceinline__ float wave_sum(float v) {
#pragma unroll
    for (int o = 1; o < 64; o <<= 1) v += __shfl_xor(v, o);
    return v;
}
#define LDS_WAIT() asm volatile("s_waitcnt lgkmcnt(0)" ::: "memory")

namespace pg8 {
constexpr int BM = 256, BK = 64, HALF = 128, HTB = HALF * BK * 2, STAGE_BYTES = 8 * HTB, NXCD = 8;
__host__ __device__ __forceinline__ int lds_byte(int r, int c) { const int st = (r >> 4) * 2 + (c >> 5), rr = r & 15, cc = c & 31, ob = rr * 64 + cc * 2; return st * 1024 + (ob ^ (((ob >> 9) & 1) << 5)); }
__host__ __device__ __forceinline__ void stage_rc(int b, int& R, int& C) { const int st = b / 1024, sb = b % 1024, swz = sb ^ (((sb >> 9) & 1) << 5); R = (st >> 1) * 16 + swz / 64; C = (st & 1) * 32 + (swz % 64) / 2; }
__host__ __device__ __forceinline__ int perm32(int rho) { const int n = rho >> 4, i = rho & 15; return 8 * (i >> 2) + 4 * n + (i & 3); }

struct Unit { int pm, pn, aux; const char* A; const char* B; };
struct Gemm { int Kb, lda, ldb; int sa, sb; };

__device__ __forceinline__ bool tile_of(int L, int nM, int nN, int& pm, int& pn, int WGM = 4) {
    const int nwg = nM * nN; if (L >= nwg) return false;
    int wgid = L; { const int q = nwg / NXCD, r = nwg % NXCD, xcd = wgid % NXCD, off = wgid / NXCD; wgid = (xcd < r ? xcd * (q + 1) : r * (q + 1) + (xcd - r) * q) + off; }
    const int nig = WGM * nN, gid = wgid / nig, fm = gid * WGM, gsz = (nM - fm) < WGM ? (nM - fm) : WGM;
    pm = fm + ((wgid % nig) % gsz); pn = (wgid % nig) / gsz; return true;
}
struct PlainSched {
    int nM, nN, G, c; const char* A0; const char* B0; size_t astep, bstep; int wgm;
    __device__ __forceinline__ bool next(int i, Unit& u) const { int pm, pn; if (!tile_of(i * G + c, nM, nN, pm, pn, wgm)) return false; u.pm = pm; u.pn = pn; u.aux = 0; u.A = A0 + (size_t)pm * astep; u.B = B0 + (size_t)pn * bstep; return true; }
};
struct PoolSched {
    int G, c; const char* A0; const char* B0;
    __device__ __forceinline__ bool next(int i, Unit& u) const { int pm, pn; if (!tile_of(i * G + c, M / 256, 4, pm, pn)) return false; u.pm = pm; u.pn = pn; u.aux = 0;
        u.A = A0 + (size_t)pm * (256 * 1024 * 2) + (size_t)pn * 512; u.B = B0 + (size_t)pn * (256 * 256 * 2); return true; }
};
struct MergeSched {
    int G, c; const char *A0, *B0, *B2; size_t astr, bstr;
    __device__ __forceinline__ bool next(int i, Unit& u) const { const int t = i / 3, b = i - 3 * t; int pm, pn; if (!tile_of(t * G + c, M / 256, 4, pm, pn)) return false; u.pm = pm; u.pn = pn; u.aux = b;
        const char* w = b == 2 ? B2 : B0 + (size_t)b * bstr;
        u.A = A0 + (size_t)b * astr + (size_t)pm * (256 * 1024 * 2); u.B = w + (size_t)pn * (256 * 1024 * 2); return true; }
};
struct FoldSched {
    int G, c; const char *A0, *B0;
    __device__ __forceinline__ bool next(int i, Unit& u) const { const int idx = i * G + c; if (idx >= 32) return false; const int L = idx >> 4, pm = (idx >> 2) & 3, g = idx & 3; u.pm = pm; u.pn = g; u.aux = L;
        u.A = A0 + (size_t)L * (6 * MiB) + (size_t)pm * (256 * 1024 * 2) + (size_t)g * 512; u.B = B0 + (size_t)L * (512 * 1024) + (size_t)g * (256 * 256 * 2); return true; }
};
struct GroupSched {
    int nM, nN, G, c; int o1, o2, o3, o4, o5, o6, o7; const char* A0; const char* B0; size_t astep, bstep, estep; int wgm;
    __device__ __forceinline__ bool next(int i, Unit& u) const { int pm, pn; if (!tile_of(i * G + c, nM, nN, pm, pn, wgm)) return false; u.pm = pm; u.pn = pn; u.aux = 0;
        const int e = (pm >= o1) + (pm >= o2) + (pm >= o3) + (pm >= o4) + (pm >= o5) + (pm >= o6) + (pm >= o7);
        u.A = A0 + (size_t)pm * astep; u.B = B0 + (size_t)e * estep + (size_t)pn * bstep; return true; }
};

typedef f32x4 Acc[2][2][4][2];
__device__ __forceinline__ u32x4 pack8(const f32x4 v0, const f32x4 v1) { u32x4 w; w.x = pk_bf16(v0[0], v0[1]); w.y = pk_bf16(v0[2], v0[3]); w.z = pk_bf16(v1[0], v1[1]); w.w = pk_bf16(v1[2], v1[3]); return w; }
__device__ __forceinline__ f32x4 sig4(const f32x4 v) { f32x4 r; r[0] = sigm(v[0]); r[1] = sigm(v[1]); r[2] = sigm(v[2]); r[3] = sigm(v[3]); return r; }
__device__ __forceinline__ void unpack8(const u32x4 g, f32x4& lo, f32x4& hi) { lo[0] = bf_lo(g.x); lo[1] = bf_hi(g.x); lo[2] = bf_lo(g.y); lo[3] = bf_hi(g.y); hi[0] = bf_lo(g.z); hi[1] = bf_hi(g.z); hi[2] = bf_lo(g.w); hi[3] = bf_hi(g.w); }

__device__ __forceinline__ size_t gate_frag(int pm, int q, int wid, int ai, int m, int bj, int lane) { return ((size_t)((((((pm * 12 + q) * 8 + wid) * 2 + ai) * 4 + m) * 2 + bj) * 64 + lane)) * 16; }
struct EpiProj {
    bf16_t *scb, *scx, *glu, *pu, *gates; const f32x4* ss; int pn_off;
    __device__ __forceinline__ bool operator()(Acc& acc, const Unit& u, int wr, int wc, int fr, int fq) const {
        const int row0 = u.pm * BM + wr * 64 + fr, pn = u.pn + pn_off;
        float rs[2][4];
#pragma unroll
        for (int ai = 0; ai < 2; ++ai)
#pragma unroll
            for (int m = 0; m < 4; ++m) { const f32x4 p = ss[row0 + ai * HALF + m * 16]; rs[ai][m] = __builtin_amdgcn_rsqf(((p[0] + p[1]) + (p[2] + p[3])) * (1.0f / D) + RMS_EPS); }
        if (pn >= 4 && pn < 20) {
            const bool isglu = pn >= 12; bf16_t* dst = isglu ? glu : scx; const int col0 = (isglu ? pn - 12 : pn - 4) * 128 + wc * 32 + 8 * fq;
#pragma unroll
            for (int ai = 0; ai < 2; ++ai)
#pragma unroll
                for (int m = 0; m < 4; ++m) { const float r = rs[ai][m];
                    f32x4 a0 = acc[ai][0][m][0] * r, a1 = acc[ai][0][m][1] * r, b0 = acc[ai][1][m][0] * r, b1 = acc[ai][1][m][1] * r;
                    if (isglu) { b0 = sig4(b0); b1 = sig4(b1); }
                    *(u32x4*)(dst + (size_t)(row0 + ai * HALF + m * 16) * D + col0) = pack8(a0 * b0, a1 * b1); }
        } else {
            if (pn >= 24) {
#pragma unroll
                for (int ai = 0; ai < 2; ++ai)
#pragma unroll
                    for (int m = 0; m < 4; ++m) { const float r = rs[ai][m];
#pragma unroll
                        for (int bj = 0; bj < 2; ++bj) { f32x4 e0 = acc[ai][bj][m][0] * r, e1 = acc[ai][bj][m][1] * r;
#pragma unroll
                            for (int j = 0; j < 4; ++j) { e0[j] = __builtin_amdgcn_exp2f(-1.44269504f * __builtin_amdgcn_fmed3f(e0[j], -30.f, 30.f)); e1[j] = __builtin_amdgcn_exp2f(-1.44269504f * __builtin_amdgcn_fmed3f(e1[j], -30.f, 30.f)); }
                            *(u32x4*)((unsigned char*)gates + gate_frag(u.pm, pn - 24, wr * 4 + wc, ai, m, bj, fr + 16 * fq)) = pack8(e0, e1); } }
            } else {
            bf16_t* dst = pn < 4 ? scb : pu; const int ldc = D, colb = (pn < 4 ? pn : pn - 20) * 256;
            const int col0 = colb + wc * 32 + 8 * fq;
#pragma unroll
            for (int ai = 0; ai < 2; ++ai)
#pragma unroll
                for (int m = 0; m < 4; ++m) { const float r = rs[ai][m]; bf16_t* rowp = dst + (size_t)(row0 + ai * HALF + m * 16) * ldc + col0;
#pragma unroll
                    for (int bj = 0; bj < 2; ++bj) *(u32x4*)(rowp + bj * HALF) = pack8(acc[ai][bj][m][0] * r, acc[ai][bj][m][1] * r); }
            }
        }
        return false;
    }
};
struct EpiPlain {
    bf16_t* Ob; int ldc; size_t aux_stride;
    __device__ __forceinline__ bool operator()(Acc& acc, const Unit& u, int wr, int wc, int fr, int fq) const {
        bf16_t* O = Ob + (size_t)u.aux * aux_stride;
        const int row0 = u.pm * BM + wr * 64 + fr, col0 = u.pn * BM + wc * 32 + 8 * fq;
#pragma unroll
        for (int ai = 0; ai < 2; ++ai)
#pragma unroll
            for (int m = 0; m < 4; ++m) { bf16_t* rowp = O + (size_t)(row0 + ai * HALF + m * 16) * ldc + col0;
#pragma unroll
                for (int bj = 0; bj < 2; ++bj) *(u32x4*)(rowp + bj * HALF) = pack8(acc[ai][bj][m][0], acc[ai][bj][m][1]); }
        return false;
    }
};
struct EpiMerge {
    const bf16_t* gates; bf16_t* O;
    __device__ __forceinline__ bool operator()(Acc& acc, const Unit& u, int wr, int wc, int fr, int fq) const {
        const int row0 = u.pm * BM + wr * 64 + fr, col0 = u.pn * BM + wc * 32 + 8 * fq, b = u.aux;
#pragma unroll
        for (int ai = 0; ai < 2; ++ai)
#pragma unroll
            for (int m = 0; m < 4; ++m) { const size_t row = (size_t)(row0 + ai * HALF + m * 16);
#pragma unroll
                for (int bj = 0; bj < 2; ++bj) { const unsigned char* gp = (const unsigned char*)gates + gate_frag(u.pm, 4 * b + u.pn, wr * 4 + wc, ai, m, bj, fr + 16 * fq);
                    f32x4 g0, g1; unpack8(*(const u32x4*)gp, g0, g1);
                    if (b < 2) { f32x4 h0, h1; unpack8(*(const u32x4*)(gp + gate_frag(0, 4, 0, 0, 0, 0, 0)), h0, h1);
#pragma unroll
                        for (int j = 0; j < 4; ++j) { acc[ai][bj][m][0][j] *= (1.f + h0[j]) * __builtin_amdgcn_rcpf(1.f + g0[j]); acc[ai][bj][m][1][j] *= (1.f + h1[j]) * __builtin_amdgcn_rcpf(1.f + g1[j]); }
                    } else {
#pragma unroll
                        for (int j = 0; j < 4; ++j) { g0[j] = __builtin_amdgcn_rcpf(1.f + g0[j]); g1[j] = __builtin_amdgcn_rcpf(1.f + g1[j]); }
                        *(u32x4*)(O + row * D + col0 + bj * HALF) = pack8(acc[ai][bj][m][0] * g0, acc[ai][bj][m][1] * g1); } } }
        return b < 2;
    }
};
struct EpiResid {
    const float* base32; bf16_t* xb; float* ssp; LAS float* red; unsigned char* x8;
    __device__ __forceinline__ bool operator()(Acc& acc, const Unit& u, int wr, int wc, int fr, int fq) const {
        const int row0 = u.pm * BM + wr * 64 + fr, col0 = u.pn * BM + wc * 32 + 8 * fq;
#pragma unroll
        for (int ai = 0; ai < 2; ++ai)
#pragma unroll
            for (int m = 0; m < 4; ++m) { const size_t row = (size_t)(row0 + ai * HALF + m * 16); float q = 0.f;
#pragma unroll
                for (int bj = 0; bj < 2; ++bj) { const size_t off = row * D + col0 + bj * HALF;
                    f32x4 b0, b1; if (base32) { b0 = *(const f32x4*)(base32 + off); b1 = *(const f32x4*)(base32 + off + 4); } else unpack8(*(const u32x4*)(xb + off), b0, b1);
                    const u32x4 pk = pack8(b0 + acc[ai][bj][m][0], b1 + acc[ai][bj][m][1]); *(u32x4*)(xb + off) = pk;
                    f32x4 o0, o1; unpack8(pk, o0, o1); if (x8) *(u32x2*)(x8 + off) = (u32x2){pk_fp8x4(o0), pk_fp8x4(o1)};
                    q += (o0[0] * o0[0] + o0[1] * o0[1]) + (o0[2] * o0[2] + o0[3] * o0[3]) + (o1[0] * o1[0] + o1[1] * o1[1]) + (o1[2] * o1[2] + o1[3] * o1[3]); }
                q += __shfl_xor(q, 16); q += __shfl_xor(q, 32);
                if (fq == 0) red[(ai * HALF + wr * 64 + m * 16 + fr) * 4 + wc] = q; }
        asm volatile("s_waitcnt lgkmcnt(0)" ::: "memory"); __builtin_amdgcn_s_barrier(); asm volatile("" ::: "memory");
        int tid = threadIdx.x; asm volatile("" : "+v"(tid));
        if (tid < 256) { const f32x4 v = *(const LAS f32x4*)(red + tid * 4); ssp[(size_t)(u.pm * BM + tid) * 4 + u.pn] = (v[0] + v[1]) + (v[2] + v[3]); }
        return false;
    }
};
template <bool PART4, bool OUT8> struct EpiSwiGLU {
    bf16_t* O; int ldc; const float* ss;
    __device__ __forceinline__ bool operator()(Acc& acc, const Unit& u, int wr, int wc, int fr, int fq) const {
        const int row0 = u.pm * BM + wr * 64 + fr, col0 = u.pn * 128 + wc * 32 + 8 * fq;
#pragma unroll
        for (int ai = 0; ai < 2; ++ai)
#pragma unroll
            for (int m = 0; m < 4; ++m) { const size_t row = (size_t)(row0 + ai * HALF + m * 16); float r = 1.f;
                if (PART4) { const f32x4 p = *(const f32x4*)(ss + row * 4); r = __builtin_amdgcn_rsqf(((p[0] + p[1]) + (p[2] + p[3])) * (1.0f / D) + RMS_EPS); }
                const f32x4 a0 = acc[ai][0][m][0] * r, a1 = acc[ai][0][m][1] * r, c0 = acc[ai][1][m][0] * r, c1 = acc[ai][1][m][1] * r;
                const f32x4 h0 = a0 * sig4(a0) * c0, h1 = a1 * sig4(a1) * c1;
                if (OUT8) { *(u32x2*)((unsigned char*)O + row * ldc + col0) = (u32x2){pk_fp8x4(h0 * F8_ACT_MUL), pk_fp8x4(h1 * F8_ACT_MUL)}; }
                else *(u32x4*)(O + row * ldc + col0) = pack8(h0, h1); }
        return false;
    }
};

typedef int i32x4 __attribute__((ext_vector_type(4)));
typedef int i32x8 __attribute__((ext_vector_type(8)));
__device__ __forceinline__ i32x8 join16(const bf16x8 lo, const bf16x8 hi) { return __builtin_shufflevector(__builtin_bit_cast(i32x4, lo), __builtin_bit_cast(i32x4, hi), 0, 1, 2, 3, 4, 5, 6, 7); }
template <class Epi, class Sched, bool F8 = false>
__device__ __forceinline__ void gemm_phase(LAS unsigned char* lds, const Gemm g, const Sched& S, const Epi& E) {
    int tid_ = threadIdx.x; asm volatile("" : "+v"(tid_));
    const int tid = tid_, wid = __builtin_amdgcn_readfirstlane(tid >> 6), lane = tid & 63, wr = wid >> 2, wc = wid & 3, fr = lane & 15, fq = lane >> 4;
    const int nt = g.Kb / 128;
    int vsa = g.sa, vsb = g.sb; asm volatile("" : "+v"(vsa), "+v"(vsb));
    unsigned voffA[2], voffB[2];
#pragma unroll
    for (int i = 0; i < 2; ++i) { int R, C; stage_rc(tid * 16 + i * 8192, R, C); const int Rb = (R & ~31) + perm32(R & 31);
        voffA[i] = (unsigned)(R * g.lda + C * 2); voffB[i] = (unsigned)(Rb * g.ldb + C * 2); }
    const size_t kstep = (size_t)(BK * 2);
    const size_t hstepA = (size_t)HALF * g.lda, hstepB = (size_t)HALF * g.ldb;
    const unsigned ldsw = (unsigned)wid * 1024u;
    const int aoff = lds_byte(wr * 64 + fr, fq * 8), boff = lds_byte(wc * 32 + fr, fq * 8);
#define PG8_SA(b, h) (((b) * 2 + (h)) * HTB)
#define PG8_SB(b, h) ((4 + (b) * 2 + (h)) * HTB)
#define PG8_STAGE(bufoff, gbase, voff) do { _Pragma("unroll") for (int _i = 0; _i < 2; ++_i) \
        __builtin_amdgcn_global_load_lds((const unsigned*)((const char*)(gbase) + (voff)[_i]), (LAS unsigned*)(lds + (bufoff) + ldsw + _i * 8192), 16, 0, 0); } while (0)
#define PG8_LDA(dst, b, h) do { _Pragma("unroll") for (int m = 0; m < 4; ++m) _Pragma("unroll") for (int k = 0; k < 2; ++k) dst[m][k] = *(const LAS bf16x8*)(lds + PG8_SA(b, h) + aoff + m * 2048 + k * 1024); } while (0)
#define PG8_LDB(dst, b, h) do { _Pragma("unroll") for (int n = 0; n < 2; ++n) _Pragma("unroll") for (int k = 0; k < 2; ++k) dst[n][k] = *(const LAS bf16x8*)(lds + PG8_SB(b, h) + boff + n * 2048 + k * 1024); } while (0)
#define PG8_MMA(ai, bj, At, Bt) do { __builtin_amdgcn_s_setprio(1); _Pragma("unroll") for (int m = 0; m < 4; ++m) _Pragma("unroll") for (int n = 0; n < 2; ++n) { \
        if constexpr (F8) { const i32x8 b8_ = join16(Bt[n][0], Bt[n][1]), a8_ = join16(At[m][0], At[m][1]); \
            asm volatile("v_mfma_scale_f32_16x16x128_f8f6f4 %0, %1, %2, %0, %3, %4 op_sel_hi:[0,0,0]" : "+v"(acc[ai][bj][m][n]) : "v"(b8_), "v"(a8_), "v"(vsb), "v"(vsa)); } \
        else { _Pragma("unroll") for (int k = 0; k < 2; ++k) acc[ai][bj][m][n] = __builtin_amdgcn_mfma_f32_16x16x32_bf16(Bt[n][k], At[m][k], acc[ai][bj][m][n], 0, 0, 0); } } __builtin_amdgcn_s_setprio(0); } while (0)
#define PG8_WAIT_V(n) asm volatile("s_waitcnt vmcnt(" #n ")" ::: "memory")
#define PG8_WAIT_L(n) asm volatile("s_waitcnt lgkmcnt(" #n ")" ::: "memory")
#define PG8_BAR __builtin_amdgcn_s_barrier()
#define PG8_SCHED __builtin_amdgcn_sched_barrier(0)
    Unit cur, nxt; int ui = 0;
    if (!S.next(0, cur)) return;
    Acc acc;
#pragma unroll
    for (int a = 0; a < 2; ++a)
#pragma unroll
        for (int b = 0; b < 2; ++b)
#pragma unroll
            for (int m = 0; m < 4; ++m)
#pragma unroll
                for (int n = 0; n < 2; ++n) acc[a][b][m][n] = (f32x4){0.f, 0.f, 0.f, 0.f};
    bf16x8 At[4][2], B0[2][2], B1[2][2];
    const char* cA = cur.A; const char* cB = cur.B;
    PG8_STAGE(PG8_SB(0, 0), cB, voffB); PG8_STAGE(PG8_SB(0, 1), cB + hstepB, voffB); PG8_STAGE(PG8_SA(0, 0), cA, voffA); PG8_STAGE(PG8_SA(0, 1), cA + hstepA, voffA);
    if (wr == 1) PG8_BAR;
    PG8_WAIT_V(2); PG8_BAR;
    PG8_STAGE(PG8_SB(1, 0), cB + kstep, voffB); PG8_STAGE(PG8_SA(1, 0), cA + kstep, voffA); PG8_STAGE(PG8_SB(1, 1), cB + hstepB + kstep, voffB);
    PG8_WAIT_V(6); PG8_BAR;
    for (;;) {
        const bool has_next = S.next(ui + 1, nxt);
        const char* nA = has_next ? nxt.A : cA; const char* nB = has_next ? nxt.B : cB;
#pragma nounroll
        for (int t = 0; t < nt; t += 2) {
            const bool last = (t == nt - 2);
            const char* a1 = cA + (size_t)(t + 1) * kstep;
            const char* a2 = last ? nA : cA + (size_t)(t + 2) * kstep; const char* b2 = last ? nB : cB + (size_t)(t + 2) * kstep;
            const char* a3 = a2 + kstep; const char* b3 = b2 + kstep;
            PG8_LDB(B0, 0, 0); PG8_LDB(B1, 0, 1); PG8_SCHED; PG8_LDA(At, 0, 0); PG8_STAGE(PG8_SA(1, 1), a1 + hstepA, voffA);
            PG8_WAIT_V(8); PG8_WAIT_L(0); PG8_BAR; PG8_MMA(0, 0, At, B0); PG8_MMA(0, 1, At, B1); PG8_BAR; PG8_SCHED;
            PG8_LDA(At, 0, 1); PG8_STAGE(PG8_SB(0, 0), b2, voffB); PG8_STAGE(PG8_SB(0, 1), b2 + hstepB, voffB); PG8_STAGE(PG8_SA(0, 0), a2, voffA);
            PG8_WAIT_V(8); PG8_WAIT_L(0); PG8_BAR; PG8_MMA(1, 0, At, B0); PG8_MMA(1, 1, At, B1); PG8_BAR; PG8_SCHED;
            PG8_LDB(B0, 1, 0); PG8_LDB(B1, 1, 1); PG8_SCHED; PG8_LDA(At, 1, 0); PG8_STAGE(PG8_SA(0, 1), a2 + hstepA, voffA);
            PG8_WAIT_V(8); PG8_WAIT_L(0); PG8_BAR; PG8_MMA(0, 0, At, B0); PG8_MMA(0, 1, At, B1); PG8_BAR; PG8_SCHED;
            PG8_LDA(At, 1, 1); PG8_STAGE(PG8_SB(1, 0), b3, voffB); PG8_STAGE(PG8_SB(1, 1), b3 + hstepB, voffB); PG8_STAGE(PG8_SA(1, 0), a3, voffA);
            PG8_WAIT_V(8); PG8_WAIT_L(0); PG8_BAR; PG8_MMA(1, 0, At, B0); PG8_MMA(1, 1, At, B1); PG8_BAR; PG8_SCHED;
        }
        if constexpr (F8) asm volatile("s_nop 15\n\ts_nop 15" ::: "memory");
        if (wr == 0) PG8_BAR;
        const bool keep = E(acc, cur, wr, wc, fr, fq);
        if (!has_next) break;
        if (!keep) {
#pragma unroll
            for (int a = 0; a < 2; ++a)
#pragma unroll
                for (int b = 0; b < 2; ++b)
#pragma unroll
                    for (int m = 0; m < 4; ++m)
#pragma unroll
                        for (int n = 0; n < 2; ++n) acc[a][b][m][n] = (f32x4){0.f, 0.f, 0.f, 0.f};
        }
        cur = nxt; cA = nA; cB = nB; ++ui;
        if (wr == 1) PG8_BAR;
    }
    PG8_WAIT_V(0);
    PG8_BAR;
#undef PG8_SA
#undef PG8_SB
#undef PG8_STAGE
#undef PG8_LDA
#undef PG8_LDB
#undef PG8_MMA
#undef PG8_WAIT_V
#undef PG8_WAIT_L
#undef PG8_BAR
#undef PG8_SCHED
}
}

constexpr int RING_BYTES = 131072, MISC_OFF = RING_BYTES, RED_OFF = RING_BYTES + 1024, LDS_BYTES = 147456;

#define XB_TMO      128
#define XB_XCNT(j)  (256  + 64 * (j))
#define XB_XSUB(j)  (1280 + 64 * (j))
#define XB_XGEN(j)  (2304 + 64 * (j))
#define XB_TOP      3328
#define XB_TOPGEN   3392
#define XCD_BAR_WORDS 3456
#define XB_SPIN_CAP (1u << 18)
__device__ __forceinline__ unsigned xb_ld(unsigned* p)              { return __hip_atomic_load(p, __ATOMIC_RELAXED, __HIP_MEMORY_SCOPE_AGENT); }
__device__ __forceinline__ unsigned xb_add(unsigned* p, unsigned v) { return __hip_atomic_fetch_add(p, v, __ATOMIC_RELAXED, __HIP_MEMORY_SCOPE_AGENT); }
__device__ __forceinline__ unsigned xb_xcc_id() { return (unsigned)__builtin_amdgcn_s_getreg((3 << 11) | 20) & 0xFu; }
#define XB_SPIN(cond, bar) do { unsigned _sp = 0; while (cond) { __builtin_amdgcn_s_sleep(1); \
    if ((++_sp & 255u) == 0u) { if (xb_ld(&(bar)[XB_TMO])) break; if (_sp > XB_SPIN_CAP) { atomicAdd(&(bar)[XB_TMO], 1u); break; } } } } while (0)
struct XcdBarrier { unsigned* bar; unsigned x; volatile LAS unsigned* st; };
__device__ __forceinline__ XcdBarrier xcd_barrier_post(unsigned* bar, volatile LAS unsigned* st) {
    XcdBarrier b; b.bar = bar; b.x = xb_xcc_id(); b.st = st;
    if (threadIdx.x == 0) (void)xb_add(&bar[XB_XCNT(b.x)], 1u);
    return b;
}
__device__ __forceinline__ void xcd_barrier_complete(unsigned* bar, unsigned x, unsigned& nloc, unsigned& nx) {
    const unsigned G = gridDim.x * gridDim.y * gridDim.z;
    unsigned sum, cnt, mine, sp = 0u;
    for (;;) {
        sum = 0u; cnt = 0u; mine = 0u;
#pragma nounroll
        for (unsigned j = 0; j < 16; ++j) { const unsigned c = xb_ld(&bar[XB_XCNT(j)]); sum += c; cnt += (c > 0u) ? 1u : 0u; mine = (j == x) ? c : mine; }
        if (sum == G) break;
        __builtin_amdgcn_s_sleep(1);
        if ((++sp & 255u) == 0u) { if (xb_ld(&bar[XB_TMO])) break; if (sp > XB_SPIN_CAP) { atomicAdd(&bar[XB_TMO], 1u); break; } }
    }
    nloc = mine > 0u ? mine : 1u; nx = cnt > 0u ? cnt : 1u;
}
__device__ __forceinline__ void xcd_barrier(const XcdBarrier& b) {
    asm volatile("s_waitcnt vmcnt(0)" ::: "memory");
    __syncthreads();
    if (threadIdx.x == 0) {
        unsigned* bar = b.bar;
        __builtin_amdgcn_s_waitcnt(0);
        unsigned nloc = b.st[0], nx = b.st[1];
        if (nloc == 0u) { xcd_barrier_complete(bar, b.x, nloc, nx); b.st[0] = nloc; b.st[1] = nx; }
        const unsigned old = xb_add(&bar[XB_XSUB(b.x)], 1u);
        const unsigned gen = old / nloc;
        if (old + 1u == (gen + 1u) * nloc) {
            __builtin_amdgcn_fence(__ATOMIC_RELEASE, "agent");
            asm volatile("s_waitcnt vmcnt(0)" ::: "memory");
            const unsigned og = xb_add(&bar[XB_TOP], 1u);
            const unsigned tg = og / nx;
            if (og + 1u == (tg + 1u) * nx) xb_add(&bar[XB_TOPGEN], 1u);
            else XB_SPIN(xb_ld(&bar[XB_TOPGEN]) == tg, bar);
            __builtin_amdgcn_fence(__ATOMIC_ACQUIRE, "agent");
            xb_add(&bar[XB_XGEN(b.x)], 1u);
            asm volatile("s_waitcnt vmcnt(0)" ::: "memory");
        } else {
            XB_SPIN(xb_ld(&bar[XB_XGEN(b.x)]) == gen, bar);
            __builtin_amdgcn_fence(__ATOMIC_ACQUIRE, "agent");
            asm volatile("s_waitcnt vmcnt(0)" ::: "memory");
        }
    }
    __syncthreads();
}

struct Args { const float* in[23]; float* out; unsigned char* ws; int ph_lo, ph_hi; };
static_assert(sizeof(Args) == 23 * 8 + 8 + 8 + 8, "Args has no padding");
typedef const __attribute__((address_space(4))) Args* KArgs;
__device__ __forceinline__ KArgs kargs() { KArgs p = (KArgs)__builtin_amdgcn_kernarg_segment_ptr(); asm volatile("" : "+s"(p)); return p; }

__device__ __forceinline__ void transpose_item(const float* src, int ldn, int k0, int n0, bf16_t* dst, int ldk, const float* kscale, const float* nscale, int lane) {
    const int r4 = lane >> 4, q = lane & 15;
    f32x4 v[16];
    const float* sp = src + (size_t)(k0 + 16 * r4) * ldn + n0 + 4 * q;
#pragma unroll
    for (int i = 0; i < 16; ++i) v[i] = __builtin_nontemporal_load((const f32x4*)(sp + (size_t)i * ldn));
    f32x4 ns = (f32x4){1.f, 1.f, 1.f, 1.f}; if (nscale) ns = *(const f32x4*)(nscale + n0 + 4 * q);
    if (kscale) {
        const f32x4* kp = (const f32x4*)(kscale + k0 + 16 * r4);
#pragma unroll
        for (int g = 0; g < 4; ++g) { const f32x4 ks = kp[g];
#pragma unroll
            for (int j = 0; j < 4; ++j) v[4 * g + j] = v[4 * g + j] * ks[j]; }
    }
#pragma unroll
    for (int e = 0; e < 4; ++e) { u32x4 lo, hi;
#pragma unroll
        for (int w = 0; w < 4; ++w) { lo[w] = pk_bf16(v[2 * w][e] * ns[e], v[2 * w + 1][e] * ns[e]); hi[w] = pk_bf16(v[8 + 2 * w][e] * ns[e], v[9 + 2 * w][e] * ns[e]); }
        bf16_t* o = dst + (size_t)(4 * q + e) * ldk + k0 + 16 * r4; *(u32x4*)o = lo; *(u32x4*)(o + 8) = hi; }
}
__device__ __forceinline__ void transpose_item_f8(const float* src, int ldn, int k0, int n0, unsigned char* dst, int ldk, const float* kscale, float mul, int lane) {
    const int r4 = lane >> 4, q = lane & 15;
    f32x4 v[16];
    const float* sp = src + (size_t)(k0 + 16 * r4) * ldn + n0 + 4 * q;
#pragma unroll
    for (int i = 0; i < 16; ++i) v[i] = __builtin_nontemporal_load((const f32x4*)(sp + (size_t)i * ldn));
    {
        const f32x4* kp = (const f32x4*)(kscale + k0 + 16 * r4);
#pragma unroll
        for (int g = 0; g < 4; ++g) { f32x4 ks = (f32x4){mul, mul, mul, mul}; if (kscale) ks = kp[g] * mul;
#pragma unroll
            for (int j = 0; j < 4; ++j) v[4 * g + j] = v[4 * g + j] * ks[j]; }
    }
#pragma unroll
    for (int e = 0; e < 4; ++e) { u32x4 o;
#pragma unroll
        for (int w = 0; w < 4; ++w) o[w] = pk_fp8x4((f32x4){v[4 * w][e], v[4 * w + 1][e], v[4 * w + 2][e], v[4 * w + 3][e]});
        *(u32x4*)(dst + (size_t)(4 * q + e) * ldk + k0 + 16 * r4) = o; }
}
__device__ __forceinline__ int win_row(int n0) {
    const int seg = n0 >> 10, c = n0 & 1023;
    if (seg == 1 || seg == 2) return 1024 + (c >> 7) * 256 + (seg == 2 ? 128 : 0) + (c & 127);
    if (seg == 3 || seg == 4) return 3072 + (c >> 7) * 256 + (seg == 4 ? 128 : 0) + (c & 127);
    return n0;
}
__device__ __forceinline__ int pair_row(int f, int second) { return (f >> 7) * 256 + (second ? 128 : 0) + (f & 127); }

__device__ __forceinline__ void prologue_phase(KArgs a, LAS unsigned char* lds, int wid, int lane) {
    asm volatile("" : "+v"(lane));
    const int gw = blockIdx.x * 8 + wid, NGW = gridDim.x * 8;
    unsigned char* ws = a->ws;
    constexpr int I_WIN = 16 * 144, I_SQ = 16 * 16, I_PW = 16, I_D1 = 16 * 56, I_D2 = 56 * 16;
    constexpr int NIT = 2 * I_WIN + 8 * I_SQ + 8 * I_PW + 2 * I_D1 + I_D2;
    for (int it = gw; it < NIT; it += NGW) {
        int r = it;
        if (r < 2 * I_WIN) { const int L = r / I_WIN; r -= L * I_WIN; const int kb = r / 144, nb = r % 144, n0 = 64 * nb;
            if (n0 >= 6144) transpose_item_f8(a->in[2] + (size_t)L * D * INC, INC, 64 * kb, n0, ws + WS_WG8 + (size_t)L * 3 * MiB + (size_t)(n0 - 6144) * D, D, a->in[1] + L * D, F8_W13_MUL, lane);
            else transpose_item(a->in[2] + (size_t)L * D * INC, INC, 64 * kb, n0, (bf16_t*)(ws + WS_W0 + W0_WIN + (size_t)L * 18 * MiB) + (size_t)win_row(n0) * D, D, a->in[1] + L * D, nullptr, lane);
            continue; }
        r -= 2 * I_WIN;
        if (r < 8 * I_SQ) { const int j = r / I_SQ; r -= j * I_SQ; const int L = j >> 2, w = j & 3, kb = r / 16, nb = r % 16, n0 = 64 * nb;
            bf16_t* dst = w < 3 ? (bf16_t*)(ws + WS_W0 + W0_WOUT + (size_t)(L * 3 + w) * 2 * MiB) : (bf16_t*)(ws + WS_W0 + W0_WO + (size_t)L * 2 * MiB);
            transpose_item(a->in[10 + w] + (size_t)L * D * D, D, 64 * kb, n0, dst + (size_t)n0 * D, D, nullptr, nullptr, lane); continue; }
        r -= 8 * I_SQ;
        if (r < 8 * I_PW) { const int j = r / I_PW; r -= j * I_PW; const int L = j >> 2, g = j & 3;
            const float* src = a->in[8] + (size_t)(L * 4 + g) * 65536 + (size_t)r * 16 * 256; const float* sc = a->in[9] + L * D + g * 256;
            bf16_t* dst = (bf16_t*)(ws + WS_W0 + W0_POOL + (size_t)L * 512 * 1024) + (size_t)g * 65536 + (size_t)r * 16 * 256; const f32x4 s4 = *(const f32x4*)(sc + 4 * lane);
#pragma unroll
            for (int i = 0; i < 16; ++i) { const f32x4 v = *(const f32x4*)(src + i * 256 + 4 * lane) * s4; u32x2 w; w.x = pk_bf16(v[0], v[1]); w.y = pk_bf16(v[2], v[3]); *(u32x2*)(dst + i * 256 + 4 * lane) = w; }
            continue; }
        r -= 8 * I_PW;
        if (r < 2 * I_D1) { const int w = r / I_D1; r -= w * I_D1; const int kb = r / 56, nb = r % 56, n0 = 64 * nb;
            transpose_item(a->in[15 + w], DFF, 64 * kb, n0, (bf16_t*)(ws + WS_W0 + W0_D13) + (size_t)pair_row(n0, w) * D, D, a->in[14], nullptr, lane); continue; }
        r -= 2 * I_D1;
        { const int kb = r / 16, nb = r % 16, n0 = 64 * nb;
            transpose_item(a->in[17], D, 64 * kb, n0, (bf16_t*)(ws + WS_W0 + W0_D2) + (size_t)n0 * DFF, DFF, nullptr, nullptr, lane); }
    }
    const float* x = a->in[0]; bf16_t* xb = (bf16_t*)(ws + WS_XB); f32x4* ss0 = (f32x4*)(ws + WS_SS); unsigned char* x8 = ws + WS_X8;
    for (int m = gw; m < M; m += NGW) {
        const f32x4* xr = (const f32x4*)(x + (size_t)m * D) + lane; u32x2* o = (u32x2*)(xb + (size_t)m * D) + lane; float s = 0.f;
#pragma unroll
        for (int j = 0; j < 4; ++j) { const f32x4 v = xr[64 * j]; s += (v[0] * v[0] + v[1] * v[1]) + (v[2] * v[2] + v[3] * v[3]); u32x2 w; w.x = pk_bf16(v[0], v[1]); w.y = pk_bf16(v[2], v[3]); o[64 * j] = w;
            *((unsigned*)(x8 + (size_t)m * D) + lane + 64 * j) = pk_fp8x4(v); }
        s = wave_sum(s); if (lane == 0) ss0[m] = (f32x4){s, 0.f, 0.f, 0.f};
    }
}

__device__ __forceinline__ void dma_block16(const bf16_t* src, LAS unsigned char* dst, int wid, int lane) {
#pragma unroll
    for (int k = 0; k < 4; ++k) { const int h = wid * 4 + k;
        __builtin_amdgcn_global_load_lds((const unsigned*)((const char*)src + h * 1024 + lane * 16), (LAS unsigned*)(dst + h * 1024), 16, 0, 0); }
}
__device__ __forceinline__ void zero_block16(LAS unsigned char* dst, int tid) {
#pragma unroll
    for (int k = 0; k < 4; ++k) *(LAS u32x4*)(dst + (size_t)(tid + 512 * k) * 16) = (u32x4){0u, 0u, 0u, 0u};
}
template <int I> __device__ __forceinline__ void conv31_pair(const LAS unsigned char* col, const unsigned (&wp)[31], f32x2 bias, f32x2 (&acc)[16]) {
    f32x2 x[46];
#pragma unroll
    for (int i = 0; i < 46; ++i) { const int r = i - 30, j = I + (r >> 4); const unsigned u = *(const LAS unsigned*)(col + ((j + 2) & 3) * 32768 + (r & 15) * 2048); x[i] = (f32x2){bf_lo(u), bf_hi(u)}; }
#pragma unroll
    for (int j = 0; j < 16; ++j) acc[j] = bias;
#pragma unroll
    for (int k = 0; k < 31; ++k) { const f32x2 wk = (f32x2){bf_lo(wp[k]), bf_hi(wp[k])};
#pragma unroll
        for (int j = 0; j < 16; ++j) acc[j] = __builtin_elementwise_fma(wk, x[j + k], acc[j]); }
}
template <int I, int CH> __device__ __forceinline__ void pool_ch(const LAS unsigned char* col, int g, int s0, float (&p)[16]) {
    float x[31], tv[16];
#pragma unroll
    for (int i = 0; i < 31; ++i) { const int r = i - 15, j = I + (r >> 4); const unsigned u = *(const LAS unsigned*)(col + ((j + 1) % 3) * 32768 + (r & 15) * 2048); x[i] = CH ? bf_hi(u) : bf_lo(u); }
#pragma unroll
    for (int j = 0; j < 16; ++j) tv[j] = x[15 + j];
#pragma unroll
    for (int i = 30; i >= 1; --i) x[i] += x[i - 1];
    if (g >= 1) {
#pragma unroll
        for (int i = 30; i >= 2; --i) x[i] += x[i - 2]; }
    if (g >= 2) {
#pragma unroll
        for (int i = 30; i >= 4; --i) x[i] += x[i - 4]; }
    if (g >= 3) {
#pragma unroll
        for (int i = 30; i >= 8; --i) x[i] += x[i - 8]; }
    const int w = 2 << g;
#pragma unroll
    for (int j = 0; j < 16; ++j) { const int cnt = min(s0 + j + 1, w); p[j] = x[15 + j] * (1.0f / (float)cnt) - tv[j]; }
}
struct ConvB { const bf16_t* GLU; __amdgpu_buffer_rsrc_t rVB; LAS unsigned char* lds; LAS float* red; LAS float* stat; f32x2 bb, gg, be; };
template <int I> __device__ __forceinline__ void convB_tile(const ConvB& c, unsigned (&wp)[31], int T0, int tid, int wid, int lane) {
    const int t0 = T0 + 16 * I; const LAS unsigned char* col = c.lds + 4 * tid;
#pragma unroll
    for (int k = 0; k < 31; ++k) asm volatile("" : "+v"(wp[k]));
    if (I < 3) dma_block16(c.GLU + (size_t)(t0 + 16) * D, c.lds + ((I + 3) & 3) * 32768, wid, lane);
    float a0[16], a1[16];
    { f32x2 ap[16]; conv31_pair<I>(col, wp, c.bb, ap);
#pragma unroll
      for (int j = 0; j < 16; ++j) { a0[j] = ap[j].x; a1[j] = ap[j].y; } }
    {
        float v[32];
#pragma unroll
        for (int j = 0; j < 16; ++j) { v[j] = a0[j] + a1[j]; v[16 + j] = a0[j] * a0[j] + a1[j] * a1[j]; }
#pragma unroll
        for (int i = 0; i < 16; ++i) { const bool b = lane & 32; const float send = b ? v[i] : v[i + 16], keep = b ? v[i + 16] : v[i]; v[i] = keep + __shfl_xor(send, 32); }
#pragma unroll
        for (int i = 0; i < 8; ++i) { const bool b = lane & 16; const float send = b ? v[i] : v[i + 8], keep = b ? v[i + 8] : v[i]; v[i] = keep + __shfl_xor(send, 16); }
#pragma unroll
        for (int i = 0; i < 4; ++i) { const bool b = lane & 8; const float send = b ? v[i] : v[i + 4], keep = b ? v[i + 4] : v[i]; v[i] = keep + __shfl_xor(send, 8); }
#pragma unroll
        for (int i = 0; i < 2; ++i) { const bool b = lane & 4; const float send = b ? v[i] : v[i + 2], keep = b ? v[i + 2] : v[i]; v[i] = keep + __shfl_xor(send, 4); }
        { const bool b = lane & 2; const float send = b ? v[0] : v[1], keep = b ? v[1] : v[0]; v[0] = keep + __shfl_xor(send, 2); }
        v[0] += __shfl_xor(v[0], 1);
        const int idx = ((lane >> 5) & 1) * 16 + ((lane >> 4) & 1) * 8 + ((lane >> 3) & 1) * 4 + ((lane >> 2) & 1) * 2 + ((lane >> 1) & 1);
        if (!(lane & 1)) c.red[wid * 32 + idx] = v[0];
    }
    __syncthreads();
    if (tid < 16) { float s = 0.f, q = 0.f;
#pragma unroll
        for (int w = 0; w < 8; ++w) { s += c.red[w * 32 + tid]; q += c.red[w * 32 + 16 + tid]; }
        const float mean = s * (1.0f / D), var = fmaxf(q * (1.0f / D) - mean * mean, 0.f);
        c.stat[2 * tid] = mean; c.stat[2 * tid + 1] = __builtin_amdgcn_rsqf(var + LN_EPS); }
    asm volatile("s_waitcnt vmcnt(0)" ::: "memory");
    __syncthreads();
#pragma unroll
    for (int j = 0; j < 16; ++j) { const float mean = c.stat[2 * j], rstd = c.stat[2 * j + 1];
        const float y0 = (a0[j] - mean) * rstd * c.gg.x + c.be.x, y1 = (a1[j] - mean) * rstd * c.gg.y + c.be.y;
        __builtin_amdgcn_raw_buffer_store_b32(pk_bf16(y0 * sigm(y0), y1 * sigm(y1)), c.rVB, 4 * tid, (t0 + j) * (D * 2), 0); }
}
struct ConvAC { const bf16_t* PU; __amdgpu_buffer_rsrc_t rSCB, rSCX, rYA, rPP; LAS unsigned char* lds; f32x2 s0w, s1w, s2w; };
__device__ __forceinline__ void convAC_load(const ConvAC& c, int t0, int tid, unsigned (&ub)[16], unsigned (&ux)[18]) {
#pragma unroll
    for (int j = 0; j < 16; ++j) ub[j] = __builtin_amdgcn_raw_buffer_load_b32(c.rSCB, 4 * tid, (t0 + j) * (D * 2), 0);
#pragma unroll
    for (int i = 0; i < 18; ++i) ux[i] = __builtin_amdgcn_raw_buffer_load_b32(c.rSCX, 4 * tid, (t0 + 62 + i) * (D * 2), 0);
}
template <int I> __device__ __forceinline__ void convAC_tile(const ConvAC& c, int T0, int tid, int wid, int lane, const unsigned (&ub)[16], const unsigned (&ux)[18], unsigned (&ubn)[16], unsigned (&uxn)[18]) {
    const int t0 = T0 + 16 * I, s0 = t0 & (SEQ - 1); const LAS unsigned char* col = c.lds + 4 * tid;
    if (I < 3) { convAC_load(c, t0 + 16, tid, ubn, uxn); dma_block16(c.PU + (size_t)(t0 + 16) * D, c.lds + ((I + 2) % 3) * 32768, wid, lane); }
    asm volatile("" ::: "memory");
    {
        float x0[18], x1[18];
#pragma unroll
        for (int i = 0; i < 18; ++i) { const unsigned u = (s0 - 2 + i) >= 0 ? ux[i] : 0u; x0[i] = bf_lo(u); x1[i] = bf_hi(u); }
#pragma unroll
        for (int j = 0; j < 16; ++j) {
            const float y0 = bf_lo(ub[j]) * (c.s0w.x * x0[j] + c.s1w.x * x0[j + 1] + c.s2w.x * x0[j + 2]), y1 = bf_hi(ub[j]) * (c.s0w.y * x1[j] + c.s1w.y * x1[j + 1] + c.s2w.y * x1[j + 2]);
            __builtin_amdgcn_raw_buffer_store_b32(pk_bf16(y0, y1), c.rYA, 4 * tid, (t0 + j) * (D * 2), 0); }
    }
    {
        float p0[16], p1[16];
        pool_ch<I, 0>(col, wid >> 1, s0, p0);
#pragma unroll
        for (int j = 0; j < 16; ++j) asm volatile("" : "+v"(p0[j]) :: "memory");
        pool_ch<I, 1>(col, wid >> 1, s0, p1);
#pragma unroll
        for (int j = 0; j < 16; ++j) __builtin_amdgcn_raw_buffer_store_b32(pk_bf16(p0[j], p1[j]), c.rPP, 4 * tid, (t0 + j) * (D * 2), 0);
    }
    if (I < 3) asm volatile("s_waitcnt vmcnt(32)" ::: "memory");
    __syncthreads();
}
__device__ __forceinline__ void conv_phase(KArgs a, int layer, LAS unsigned char* lds, int tid, int wid, int lane) {
    asm volatile("" : "+v"(tid), "+v"(lane));
    unsigned char* ws = a->ws;
    const int G = gridDim.x;
    const int vcu = (G % 8 == 0) ? (int)(blockIdx.x % 8) * (G / 8) + (int)(blockIdx.x / 8) : (int)blockIdx.x;
    const int c2 = 2 * tid;
    {
        const float* cfw = a->in[4] + layer * 31 * D; const float* cfb = a->in[5] + layer * D; const float* lng = a->in[6] + layer * D; const float* lnb = a->in[7] + layer * D;
        ConvB c; c.GLU = (const bf16_t*)(ws + A_GLU); c.rVB = __builtin_amdgcn_make_buffer_rsrc((void*)(ws + A_VB), 0, 0x7fffffff, 0x00020000);
        c.lds = lds; c.red = (LAS float*)(lds + RED_OFF); c.stat = c.red + 256;
        unsigned wp[31];
#pragma unroll
        for (int k = 0; k < 31; ++k) { const f32x2 w = *(const f32x2*)(cfw + k * D + c2); wp[k] = pk_bf16(w.x, w.y); }
        c.bb = *(const f32x2*)(cfb + c2); c.gg = *(const f32x2*)(lng + c2); c.be = *(const f32x2*)(lnb + c2);
        asm volatile("" :: "v"(c.bb.x), "v"(c.bb.y), "v"(c.gg.x), "v"(c.gg.y), "v"(c.be.x), "v"(c.be.y));
        for (int rp2 = 0; rp2 < REPS2(21); ++rp2)
        for (int sup = vcu; sup < M / 64; sup += G) {
            const int T0 = sup * 64; const bool seq0 = (T0 & (SEQ - 1)) == 0;
            if (seq0) { zero_block16(lds, tid); zero_block16(lds + 32768, tid); } else { dma_block16(c.GLU + (size_t)(T0 - 32) * D, lds, wid, lane); dma_block16(c.GLU + (size_t)(T0 - 16) * D, lds + 32768, wid, lane); }
            dma_block16(c.GLU + (size_t)T0 * D, lds + 65536, wid, lane);
            asm volatile("s_waitcnt vmcnt(0)" ::: "memory");
            __syncthreads();
            convB_tile<0>(c, wp, T0, tid, wid, lane); convB_tile<1>(c, wp, T0, tid, wid, lane); convB_tile<2>(c, wp, T0, tid, wid, lane); convB_tile<3>(c, wp, T0, tid, wid, lane);
            __syncthreads();
        }
    }
    __syncthreads();
    {
        const float* scw = a->in[3] + layer * 3 * D;
        ConvAC c; c.PU = (const bf16_t*)(ws + A_PU); c.lds = lds;
        c.rSCB = __builtin_amdgcn_make_buffer_rsrc((void*)(ws + A_SCB), 0, 0x7fffffff, 0x00020000); c.rSCX = __builtin_amdgcn_make_buffer_rsrc((void*)(ws + A_SCX - 64 * D * 2), 0, 0x7fffffff, 0x00020000);
        c.rYA = __builtin_amdgcn_make_buffer_rsrc((void*)(ws + A_YA), 0, 0x7fffffff, 0x00020000); c.rPP = __builtin_amdgcn_make_buffer_rsrc((void*)(ws + A_PP), 0, 0x7fffffff, 0x00020000);
        c.s0w = *(const f32x2*)(scw + c2); c.s1w = *(const f32x2*)(scw + D + c2); c.s2w = *(const f32x2*)(scw + 2 * D + c2);
        asm volatile("" :: "v"(c.s0w.x), "v"(c.s0w.y), "v"(c.s1w.x), "v"(c.s1w.y), "v"(c.s2w.x), "v"(c.s2w.y));
        for (int rp2 = 0; rp2 < REPS2(22); ++rp2)
        for (int sup = vcu; sup < M / 64; sup += G) {
            const int T0 = sup * 64; const bool seq0 = (T0 & (SEQ - 1)) == 0;
            if (seq0) zero_block16(lds, tid); else dma_block16(c.PU + (size_t)(T0 - 16) * D, lds, wid, lane);
            dma_block16(c.PU + (size_t)T0 * D, lds + 32768, wid, lane);
            unsigned ubA[16], uxA[18], ubB[16], uxB[18]; convAC_load(c, T0, tid, ubA, uxA);
            asm volatile("s_waitcnt vmcnt(0)" ::: "memory");
            __syncthreads();
            convAC_tile<0>(c, T0, tid, wid, lane, ubA, uxA, ubB, uxB); convAC_tile<1>(c, T0, tid, wid, lane, ubB, uxB, ubA, uxA); convAC_tile<2>(c, T0, tid, wid, lane, ubA, uxA, ubB, uxB); convAC_tile<3>(c, T0, tid, wid, lane, ubB, uxB, ubA, uxA);
        }
    }
}

__device__ __forceinline__ void route_phase(KArgs a, LAS unsigned char* lds, int tid, int wid, int lane) {
    asm volatile("" : "+v"(tid), "+v"(lane));
    unsigned char* ws = a->ws;
    const bf16_t* X = (const bf16_t*)(ws + WS_XB); const float* gn = a->in[14] + D; const float* R = a->in[18];
    const f32x4* ss3 = (const f32x4*)(ws + WS_SS) + 3 * M;
    int* tope = (int*)(ws + WS_SMALL + SM_TOPE); f32x2* topp = (f32x2*)(ws + WS_SMALL + SM_TOPP); int* cntb = (int*)(ws + WS_CTL + CTL_CNT);
    LAS int* lcnt = (LAS int*)(lds + 98304);
    float wgt[2][8][8];
#pragma unroll
    for (int h = 0; h < 2; ++h)
#pragma unroll
        for (int i = 0; i < 8; ++i) { const int k = 8 * lane + 512 * h + i; const float g = gn[k]; const f32x4 r0 = *(const f32x4*)(R + k * 8), r1 = *(const f32x4*)(R + k * 8 + 4);
#pragma unroll
            for (int e = 0; e < 4; ++e) { wgt[h][i][e] = g * r0[e]; wgt[h][i][4 + e] = g * r1[e]; } }
    for (int vb = blockIdx.x; vb < 256; vb += gridDim.x) {
        if (tid < 8) lcnt[tid] = 0;
        __syncthreads();
        for (int i8 = 0; i8 < 8; ++i8) {
            const int t = vb * 64 + wid * 8 + i8;
            float lg[8];
#pragma unroll
            for (int e = 0; e < 8; ++e) lg[e] = 0.f;
#pragma unroll
            for (int h = 0; h < 2; ++h) { f32x4 v0, v1; pg8::unpack8(*(const u32x4*)(X + (size_t)t * D + 512 * h + 8 * lane), v0, v1);
#pragma unroll
                for (int i = 0; i < 4; ++i)
#pragma unroll
                    for (int e = 0; e < 8; ++e) { lg[e] = fmaf(v0[i], wgt[h][i][e], lg[e]); lg[e] = fmaf(v1[i], wgt[h][4 + i][e], lg[e]); } }
#pragma unroll
            for (int e = 0; e < 8; ++e) lg[e] = wave_sum(lg[e]);
            const f32x4 sp = ss3[t]; const float rstd = __builtin_amdgcn_rsqf(((sp[0] + sp[1]) + (sp[2] + sp[3])) * (1.0f / D) + RMS_EPS);
            int e1 = 0; float v1 = lg[0];
#pragma unroll
            for (int e = 1; e < 8; ++e) if (lg[e] > v1) { v1 = lg[e]; e1 = e; }
            int e2 = e1 == 0 ? 1 : 0; float v2 = -__builtin_inff();
#pragma unroll
            for (int e = 0; e < 8; ++e) if (e != e1 && lg[e] > v2) { v2 = lg[e]; e2 = e; }
            const float ex = __expf((v2 - v1) * rstd), p1 = 1.0f / (1.0f + ex), p2 = ex * p1;
            if (lane == 0) { tope[t] = e1 | (e2 << 8); topp[t] = (f32x2){p1, p2}; atomicAdd((int*)&lcnt[e1], 1); atomicAdd((int*)&lcnt[e2], 1); }
        }
        __syncthreads();
        if (tid < 8) cntb[vb * 8 + tid] = lcnt[tid];
        __syncthreads();
    }
    const int gw = blockIdx.x * 8 + wid, NGW = gridDim.x * 8;
    constexpr int I_1 = 16 * 56, I_13 = 2 * I_1, I_2 = 56 * 16;
    unsigned char* w13 = ws + WS_WMOE; unsigned char* w2t = ws + WS_WMOE + WMOE_W2;
    for (int it = gw; it < NE * (I_13 + I_2); it += NGW) {
        int r = it;
        if (r < NE * I_13) { const int e = r / I_13; r -= e * I_13; const int w = r / I_1; r -= w * I_1; const int kb = r / 56, nb = r % 56, n0 = 64 * nb;
            transpose_item_f8(a->in[19 + w] + (size_t)e * D * DFF, DFF, 64 * kb, n0, w13 + (size_t)e * (2 * DFF) * D + (size_t)pair_row(n0, w) * D, D, gn, F8_W13_MUL, lane); continue; }
        r -= NE * I_13;
        { const int e = r / I_2; r -= e * I_2; const int kb = r / 16, nb = r % 16, n0 = 64 * nb;
            transpose_item_f8(a->in[21] + (size_t)e * DFF * D, D, 64 * kb, n0, w2t + (size_t)e * D * DFF + (size_t)n0 * DFF, DFF, nullptr, F8_W2_MUL, lane); }
    }
}

__device__ __forceinline__ void scatter_phase(KArgs a, LAS unsigned char* lds, int tid, int wid, int lane) {
    asm volatile("" : "+v"(tid), "+v"(lane));
    unsigned char* ws = a->ws;
    const int* tope = (const int*)(ws + WS_SMALL + SM_TOPE); int* tslot = (int*)(ws + WS_SMALL + SM_TSLOT); float* ssperm = (float*)(ws + WS_SMALL + SM_SSPERM); int* meta = (int*)(ws + WS_SMALL + SM_META);
    const int* cntb = (const int*)(ws + WS_CTL + CTL_CNT); const f32x4* ss3 = (const f32x4*)(ws + WS_SS) + 3 * M;
    const bf16_t* X = (const bf16_t*)(ws + WS_XB); unsigned char* AP = ws + WS_APERM;
    LAS int* lc = (LAS int*)lds;
    LAS int* lbase = lc + 2048;
    LAS int* lslot = lc + 2064;
    LAS int* ltot = lc + 2200;
    for (int i = tid; i < 2048; i += 512) lc[i] = __hip_atomic_load(cntb + i, __ATOMIC_RELAXED, __HIP_MEMORY_SCOPE_AGENT);
    __syncthreads();
    for (int vb = blockIdx.x; vb < 256; vb += gridDim.x) {
        if (tid < 8) { int tot = 0, pre = 0;
#pragma unroll 8
            for (int b = 0; b < 256; ++b) { const int v = lc[b * 8 + tid]; tot += v; pre += (b < vb) ? v : 0; }
            ltot[tid] = tot; lbase[tid] = pre; }
        __syncthreads();
        if (tid == 0) { int off = 0;
            for (int e = 0; e < 8; ++e) { lbase[e] += off; if (vb == 0) meta[e] = off >> 8; off += (ltot[e] + 255) & ~255; }
            if (vb == 0) meta[8] = off >> 8; }
        __syncthreads();
        if (wid == 0) {
            const int t = vb * 64 + lane; const int te = tope[t]; const int e1 = te & 0xff, e2 = (te >> 8) & 0xff;
            int s1 = 0, s2 = 0;
#pragma unroll
            for (int k = 0; k < 2; ++k) { const int ek = k ? e2 : e1; int sk = 0;
#pragma unroll
                for (int e = 0; e < 8; ++e) { const unsigned long long mask = __ballot(ek == e); const int base = lbase[e]; LDS_WAIT();
                    const int rank = __popcll(mask & ((1ull << lane) - 1ull)); if (ek == e) sk = base + rank;
                    if (lane == 0) lbase[e] = base + __popcll(mask); LDS_WAIT(); }
                if (k) s2 = sk; else s1 = sk; }
            *(int2*)(tslot + 2 * t) = make_int2(s1, s2); lslot[lane] = s1; lslot[64 + lane] = s2;
        }
        __syncthreads();
        for (int rb = 0; rb < 2; ++rb) {
            u32x4 xv[8][2]; f32x4 sp[8];
#pragma unroll
            for (int i = 0; i < 8; ++i) { const int r = wid + 8 * (rb * 8 + i), t = vb * 64 + (r & 63); const u32x4* src = (const u32x4*)(X + (size_t)t * D) + 2 * lane; xv[i][0] = src[0]; xv[i][1] = src[1]; sp[i] = ss3[t]; }
#pragma unroll
            for (int i = 0; i < 8; ++i) { const int r = wid + 8 * (rb * 8 + i), slot = lslot[r];
                const float rstd = __builtin_amdgcn_rsqf(((sp[i][0] + sp[i][1]) + (sp[i][2] + sp[i][3])) * (1.0f / D) + RMS_EPS);
                f32x4 v0, v1, v2, v3; pg8::unpack8(xv[i][0], v0, v1); pg8::unpack8(xv[i][1], v2, v3);
                *((u32x4*)(AP + (size_t)slot * D) + lane) = (u32x4){pk_fp8x4(v0 * rstd), pk_fp8x4(v1 * rstd), pk_fp8x4(v2 * rstd), pk_fp8x4(v3 * rstd)}; } }
        __syncthreads();
    }
}

__device__ __forceinline__ void combine_phase(KArgs a, int wid, int lane) {
    asm volatile("" : "+v"(lane));
    unsigned char* ws = a->ws;
    const bf16_t* X = (const bf16_t*)(ws + WS_XB); const bf16_t* Y = (const bf16_t*)(ws + WS_Y); const int* tslot = (const int*)(ws + WS_SMALL + SM_TSLOT); const f32x2* topp = (const f32x2*)(ws + WS_SMALL + SM_TOPP);
    const float* gf = a->in[22]; float* out = a->out;
    const int gw = blockIdx.x * 8 + wid, NGW = gridDim.x * 8;
    f32x4 gv[4];
#pragma unroll
    for (int h = 0; h < 2; ++h) { gv[2 * h] = *(const f32x4*)(gf + 512 * h + 8 * lane); gv[2 * h + 1] = *(const f32x4*)(gf + 512 * h + 8 * lane + 4); }
    for (int tb = gw; tb < M; tb += 4 * NGW) {
        int2 sl[4]; f32x2 p[4];
#pragma unroll
        for (int i = 0; i < 4; ++i) { const int t = min(tb + i * NGW, M - 1); sl[i] = *(const int2*)(tslot + 2 * t); p[i] = topp[t]; }
        u32x4 xr[4][2], ya[4][2], yb[4][2];
#pragma unroll
        for (int i = 0; i < 4; ++i) { const int t = min(tb + i * NGW, M - 1);
#pragma unroll
            for (int h = 0; h < 2; ++h) { const int col = 512 * h + 8 * lane;
                xr[i][h] = *(const u32x4*)(X + (size_t)t * D + col); ya[i][h] = *(const u32x4*)(Y + (size_t)sl[i].x * D + col); yb[i][h] = *(const u32x4*)(Y + (size_t)sl[i].y * D + col); } }
#pragma unroll
        for (int i = 0; i < 4; ++i) { const int t = tb + i * NGW; if (t < M) {
            f32x4 v[4]; float s = 0.f;
#pragma unroll
            for (int h = 0; h < 2; ++h) { f32x4 x0, x1, a0, a1, b0, b1; pg8::unpack8(xr[i][h], x0, x1); pg8::unpack8(ya[i][h], a0, a1); pg8::unpack8(yb[i][h], b0, b1);
                v[2 * h] = x0 + a0 * p[i].x + b0 * p[i].y; v[2 * h + 1] = x1 + a1 * p[i].x + b1 * p[i].y; }
#pragma unroll
            for (int k = 0; k < 4; ++k) s += (v[k][0] * v[k][0] + v[k][1] * v[k][1]) + (v[k][2] * v[k][2] + v[k][3] * v[k][3]);
            const float rstd = __builtin_amdgcn_rsqf(wave_sum(s) * (1.0f / D) + RMS_EPS);
#pragma unroll
            for (int h = 0; h < 2; ++h) { const int col = 512 * h + 8 * lane;
                *(f32x4*)(out + (size_t)t * D + col) = v[2 * h] * rstd * gv[2 * h]; *(f32x4*)(out + (size_t)t * D + col + 4) = v[2 * h + 1] * rstd * gv[2 * h + 1]; } } }
    }
}

#ifndef WGM_INPROJ
#define WGM_INPROJ 4
#endif
#ifndef WGM_FFN1
#define WGM_FFN1 4
#endif
#ifndef WGM_MOE1
#define WGM_MOE1 4
#endif
constexpr int NPH = 18;
#ifndef MK_PH_MASK
#define MK_PH_MASK 0xFFFFFFFFu
#endif
#define PHON(bit) ((((MK_PH_MASK) >> (bit)) & 1u) != 0u)


__device__ __forceinline__ void ph_inproj(KArgs a, int layer, LAS unsigned char* lds) {
    unsigned char* ws = a->ws;
    {
        pg8::Gemm g{2 * D, 2 * D, 2 * D, 0, 0}; pg8::PlainSched S{M / 256, 24, (int)gridDim.x, (int)blockIdx.x, (const char*)(ws + WS_XB), (const char*)(ws + WS_W0 + W0_WIN + (size_t)layer * 18 * MiB), (size_t)256 * D * 2, (size_t)256 * D * 2, WGM_INPROJ};
        pg8::EpiProj E{(bf16_t*)(ws + A_SCB), (bf16_t*)(ws + A_SCX), (bf16_t*)(ws + A_GLU), (bf16_t*)(ws + A_PU), (bf16_t*)(ws + A_GATES), (const f32x4*)(ws + WS_SS) + (size_t)(layer * 2) * M, 0};
        pg8::gemm_phase(lds, g, S, E);
    }
    __syncthreads();
    {
        pg8::Gemm g{D, D, D, F8_ONE, F8_W13_SC}; pg8::PlainSched S{M / 256, 12, (int)gridDim.x, (int)blockIdx.x, (const char*)(ws + WS_X8), (const char*)(ws + WS_WG8 + (size_t)layer * 3 * MiB), (size_t)256 * D, (size_t)256 * D, WGM_INPROJ};
        pg8::EpiProj E{(bf16_t*)(ws + A_SCB), (bf16_t*)(ws + A_SCX), (bf16_t*)(ws + A_GLU), (bf16_t*)(ws + A_PU), (bf16_t*)(ws + A_GATES), (const f32x4*)(ws + WS_SS) + (size_t)(layer * 2) * M, 24};
        pg8::gemm_phase<pg8::EpiProj, pg8::PlainSched, true>(lds, g, S, E);
    }
}
__device__ __forceinline__ void ph_fold(KArgs a, LAS unsigned char* lds) {
    unsigned char* ws = a->ws;
    pg8::Gemm g{512, 2 * D, 512, 0, 0}; pg8::FoldSched S{(int)gridDim.x, (int)blockIdx.x, (const char*)(ws + WS_W0 + W0_WOUT + 2 * 2 * MiB), (const char*)(ws + WS_W0 + W0_POOL)};
    pg8::EpiPlain E{(bf16_t*)(ws + WS_WC), D, (size_t)D * D};
    pg8::gemm_phase(lds, g, S, E);
}
__device__ __forceinline__ void ph_merge(KArgs a, int layer, LAS unsigned char* lds) {
    unsigned char* ws = a->ws;
    pg8::Gemm g{2 * D, 2 * D, 2 * D, 0, 0}; pg8::MergeSched S{(int)gridDim.x, (int)blockIdx.x, (const char*)(ws + A_YA), (const char*)(ws + WS_W0 + W0_WOUT + (size_t)(layer * 3) * 2 * MiB), (const char*)(ws + WS_WC + (size_t)layer * 2 * MiB), (size_t)32 * MiB, (size_t)2 * MiB};
    pg8::EpiMerge E{(const bf16_t*)(ws + A_GATES), (bf16_t*)(ws + A_MERGED)};
    pg8::gemm_phase(lds, g, S, E);
}
__device__ __forceinline__ void ph_wo(KArgs a, int layer, LAS unsigned char* lds) {
    unsigned char* ws = a->ws;
    pg8::Gemm g{2 * D, 2 * D, 2 * D, 0, 0}; pg8::PlainSched S{M / 256, D / 256, (int)gridDim.x, (int)blockIdx.x, (const char*)(ws + A_MERGED), (const char*)(ws + WS_W0 + W0_WO + (size_t)layer * 2 * MiB), (size_t)256 * D * 2, (size_t)256 * D * 2, 4};
    pg8::EpiResid E{layer == 0 ? a->in[0] : (const float*)nullptr, (bf16_t*)(ws + WS_XB), (float*)(ws + WS_SS) + (size_t)(layer * 2 + 1) * M * 4, (LAS float*)(lds + RED_OFF), nullptr};
    pg8::gemm_phase(lds, g, S, E);
}
__device__ __forceinline__ void ph_ffn1(KArgs a, LAS unsigned char* lds) {
    unsigned char* ws = a->ws;
    pg8::Gemm g{2 * D, 2 * D, 2 * D, 0, 0}; pg8::PlainSched S{M / 256, 2 * DFF / 256, (int)gridDim.x, (int)blockIdx.x, (const char*)(ws + WS_XB), (const char*)(ws + WS_W0 + W0_D13), (size_t)256 * D * 2, (size_t)256 * D * 2, WGM_FFN1};
    pg8::EpiSwiGLU<true, false> E{(bf16_t*)(ws + A_FFN), DFF, (const float*)(ws + WS_SS) + (size_t)1 * M * 4};
    pg8::gemm_phase(lds, g, S, E);
}
__device__ __forceinline__ void ph_ffn2(KArgs a, LAS unsigned char* lds) {
    unsigned char* ws = a->ws;
    pg8::Gemm g{2 * DFF, 2 * DFF, 2 * DFF, 0, 0}; pg8::PlainSched S{M / 256, D / 256, (int)gridDim.x, (int)blockIdx.x, (const char*)(ws + A_FFN), (const char*)(ws + WS_W0 + W0_D2), (size_t)256 * DFF * 2, (size_t)256 * DFF * 2, 4};
    pg8::EpiResid E{(const float*)nullptr, (bf16_t*)(ws + WS_XB), (float*)(ws + WS_SS) + (size_t)2 * M * 4, (LAS float*)(lds + RED_OFF), ws + WS_X8};
    pg8::gemm_phase(lds, g, S, E);
}
__device__ __forceinline__ void ph_moe(KArgs a, int which, LAS unsigned char* lds) {
    unsigned char* ws = a->ws;
    const int* meta = (const int*)(ws + WS_SMALL + SM_META); int o[9];
#pragma unroll
    for (int e = 0; e < 9; ++e) o[e] = __builtin_amdgcn_readfirstlane(__hip_atomic_load(meta + e, __ATOMIC_RELAXED, __HIP_MEMORY_SCOPE_AGENT));
    const int nM = o[8] > MAXSLOT / 256 ? MAXSLOT / 256 : o[8];
    if (which == 0) {
        pg8::Gemm g{D, D, D, F8_ONE, F8_W13_SC}; pg8::GroupSched S{nM, 2 * DFF / 256, (int)gridDim.x, (int)blockIdx.x, o[1], o[2], o[3], o[4], o[5], o[6], o[7], (const char*)(ws + WS_APERM), (const char*)(ws + WS_WMOE), (size_t)256 * D, (size_t)256 * D, (size_t)2 * DFF * D, WGM_MOE1};
        pg8::EpiSwiGLU<false, true> E{(bf16_t*)(ws + WS_ACTP), DFF, nullptr};
        pg8::gemm_phase<pg8::EpiSwiGLU<false, true>, pg8::GroupSched, true>(lds, g, S, E);
    } else {
        pg8::Gemm g{DFF, DFF, DFF, F8_ACT_SC, F8_W2_SC}; pg8::GroupSched S{nM, D / 256, (int)gridDim.x, (int)blockIdx.x, o[1], o[2], o[3], o[4], o[5], o[6], o[7], (const char*)(ws + WS_ACTP), (const char*)(ws + WS_WMOE + WMOE_W2), (size_t)256 * DFF, (size_t)256 * DFF, (size_t)D * DFF, 4};
        pg8::EpiPlain E{(bf16_t*)(ws + WS_Y), D, 0};
        pg8::gemm_phase<pg8::EpiPlain, pg8::GroupSched, true>(lds, g, S, E);
    }
}

__global__ void __launch_bounds__(512, 2) fwd(Args unused_args_read_through_kargs) {
    extern __shared__ __attribute__((aligned(16))) unsigned char lds_raw[];
    LAS unsigned char* lds = (LAS unsigned char*)lds_raw;
    volatile LAS unsigned* MISC = (volatile LAS unsigned*)(lds + MISC_OFF);
    const int tid = threadIdx.x, lane = tid & 63, wid = __builtin_amdgcn_readfirstlane(tid >> 6);
    if (tid < 64) MISC[tid] = 0u;
    __syncthreads();
    int lo, hi; XcdBarrier bar;
    { KArgs a = kargs(); lo = a->ph_lo; hi = a->ph_hi; unsigned* bw = (unsigned*)(a->ws + WS_CTL + CTL_BAR); bar.bar = bw; bar.x = 0; bar.st = nullptr; if (hi - lo > 1) bar = xcd_barrier_post(bw, MISC + 8); }
#define IN(k) (lo <= (k) && (k) < hi)
#define SEAM(k) do { if (IN(k) && IN((k) + 1)) xcd_barrier(bar); } while (0)

    if (PHON(0) && IN(0)) { for (int rp = 0; rp < REPS(0); ++rp) { prologue_phase(kargs(), lds, wid, lane); __syncthreads(); } } SEAM(0);
#pragma nounroll
    for (int layer = 0; layer < 2; ++layer) {
        const int pb = 1 + 7 * layer;
        if (PHON(1) && IN(pb + 0)) { for (int rp = 0; rp < REPS(1); ++rp) { if (layer == 0) { ph_fold(kargs(), lds); __syncthreads(); } ph_inproj(kargs(), layer, lds); __syncthreads(); } } SEAM(pb + 0);
        if (PHON(2) && IN(pb + 1)) { for (int rp = 0; rp < REPS(2); ++rp) { conv_phase(kargs(), layer, lds, tid, wid, lane); __syncthreads(); } } SEAM(pb + 1);
        if (PHON(4) && IN(pb + 3)) { for (int rp = 0; rp < REPS(4); ++rp) { ph_merge(kargs(), layer, lds); __syncthreads(); } } SEAM(pb + 3);
        if (PHON(5) && IN(pb + 4)) { for (int rp = 0; rp < (layer == 0 ? REPS(5) : 1); ++rp) { ph_wo(kargs(), layer, lds); __syncthreads(); } } SEAM(pb + 4);
        if (layer == 0) {
            if (PHON(6) && IN(6)) { for (int rp = 0; rp < REPS(6); ++rp) { ph_ffn1(kargs(), lds); __syncthreads(); } } SEAM(6);
            if (PHON(7) && IN(7)) { ph_ffn2(kargs(), lds); } SEAM(7);
        }
    }
    if (PHON(13) && IN(13)) { for (int rp = 0; rp < REPS(13); ++rp) { route_phase(kargs(), lds, tid, wid, lane); __syncthreads(); } } SEAM(13);
    if (PHON(14) && IN(14)) { for (int rp = 0; rp < REPS(14); ++rp) { scatter_phase(kargs(), lds, tid, wid, lane); __syncthreads(); } } SEAM(14);
    if (PHON(15) && IN(15)) { for (int rp = 0; rp < REPS(15); ++rp) { ph_moe(kargs(), 0, lds); __syncthreads(); } } SEAM(15);
    if (PHON(16) && IN(16)) { for (int rp = 0; rp < REPS(16); ++rp) { ph_moe(kargs(), 1, lds); __syncthreads(); } } SEAM(16);
    if (PHON(17) && IN(17)) { for (int rp = 0; rp < REPS(17); ++rp) { combine_phase(kargs(), wid, lane); __syncthreads(); } }
#undef IN
#undef SEAM
}

extern "C" void kernel_launch(void* const* d_in, const int* in_sizes, int n_in, void* d_out, int out_size, void* d_ws, size_t ws_size, hipStream_t stream) {
    static int grid = 0;
    if (grid == 0) {
        if (n_in != 23 || in_sizes[0] != M * D || out_size != M * D || ws_size < WS_END) { fprintf(stderr, "kernel_launch: unexpected shapes: n_in %d in0 %d out %d ws %zu (need %zu); nothing launched\n", n_in, n_in > 0 ? in_sizes[0] : -1, out_size, ws_size, (size_t)WS_END); grid = -1; return; }
        int dev = 0, cus = 0, per_cu = 0;
        if (hipGetDevice(&dev) != hipSuccess || hipDeviceGetAttribute(&cus, hipDeviceAttributeMultiprocessorCount, dev) != hipSuccess) { fprintf(stderr, "kernel_launch: device query failed\n"); grid = -1; return; }
        if (hipFuncSetAttribute((const void*)fwd, hipFuncAttributeMaxDynamicSharedMemorySize, LDS_BYTES) != hipSuccess) { fprintf(stderr, "kernel_launch: hipFuncSetAttribute failed\n"); grid = -1; return; }
        if (hipOccupancyMaxActiveBlocksPerMultiprocessor(&per_cu, (const void*)fwd, 512, LDS_BYTES) != hipSuccess || per_cu < 1) fprintf(stderr, "kernel_launch: note: occupancy query reports %d workgroups per CU\n", per_cu);
        (void)hipGetLastError();
        grid = cus;
    }
    if (grid < 0) return;
    if (hipMemsetAsync((char*)d_ws + WS_CTL, 0, CTL_BYTES, stream) != hipSuccess) { fprintf(stderr, "kernel_launch: memset failed\n"); return; }
    Args a{};
    for (int i = 0; i < 23; ++i) a.in[i] = (const float*)d_in[i];
    a.out = (float*)d_out; a.ws = (unsigned char*)d_ws;
#if MK_PER_PHASE
    for (int ph = 0; ph < NPH; ++ph) { a.ph_lo = ph; a.ph_hi = ph + 1; hipLaunchKernelGGL(fwd, dim3(grid), dim3(512), LDS_BYTES, stream, a); }
#else
    a.ph_lo = 0; a.ph_hi = NPH; hipLaunchKernelGGL(fwd, dim3(grid), dim3(512), LDS_BYTES, stream, a);
#endif
    const hipError_t le = hipPeekAtLastError();
    if (le != hipSuccess) fprintf(stderr, "kernel_launch: launch failed: %s\n", hipGetErrorName(le));
}
```

```cpp
#include <hip/hip_runtime.h>
#include <cstdio>
#include <cstdint>

#ifndef MK_PER_PHASE
#define MK_PER_PHASE 0
#endif

#ifndef MK_REP_MASK
#define MK_REP_MASK 0u
#endif
#define REPS(bit) (1 + (int)(((MK_REP_MASK) >> (bit)) & 1u))
#define REPS2(bit) REPS(bit)

#define LAS __attribute__((address_space(3)))
typedef unsigned short bf16_t;
typedef short bf16x8 __attribute__((ext_vector_type(8)));
typedef float f32x4 __attribute__((ext_vector_type(4)));
typedef float f32x2 __attribute__((ext_vector_type(2)));
typedef unsigned u32x4 __attribute__((ext_vector_type(4)));
typedef unsigned u32x2 __attribute__((ext_vector_type(2)));

constexpr int M = 16384, D = 1024, SEQ = 8192, INC = 9216, DFF = 3584, NE = 8;
constexpr float RMS_EPS = 1e-6f, LN_EPS = 1e-5f;
constexpr int MAXSLOT = 34816;
constexpr float F8_W13_MUL = 128.f, F8_ACT_MUL = 4.f, F8_W2_MUL = 256.f;
constexpr int F8_ONE = 0x7f7f7f7f, F8_W13_SC = 0x78787878  , F8_ACT_SC = 0x7d7d7d7d  , F8_W2_SC = 0x77777777  ;

constexpr size_t MiB = 1u << 20;
constexpr size_t WS_CTL = 0, CTL_BYTES = 64 * 1024;
constexpr size_t CTL_BAR = 16384;
constexpr size_t CTL_CNT = 32768;
constexpr size_t WS_SMALL = 1 * MiB;
constexpr size_t SM_TOPE = 0, SM_TOPP = 64 * 1024, SM_TSLOT = 192 * 1024, SM_SSPERM = 320 * 1024, SM_META = 512 * 1024;
constexpr size_t WS_X8 = 2 * MiB;
constexpr size_t WS_YP = 18 * MiB;
constexpr size_t WS_WG8 = 58 * MiB;
constexpr size_t WS_XB = 66 * MiB;
constexpr size_t WS_W0 = 98 * MiB;
constexpr size_t W0_WIN = 0;
constexpr size_t W0_WOUT = 36 * MiB;
constexpr size_t W0_WO = 48 * MiB;
constexpr size_t W0_POOL = 52 * MiB;
constexpr size_t W0_D13 = 53 * MiB;
constexpr size_t W0_D2 = 67 * MiB;
constexpr size_t WS_ACT = 172 * MiB;
constexpr size_t A_SCB = WS_ACT, A_SCX = WS_ACT + 32 * MiB, A_GLU = WS_ACT + 64 * MiB, A_PU = WS_ACT + 96 * MiB, A_GATES = WS_ACT + 128 * MiB,
                 A_YA = WS_ACT + 224 * MiB, A_VB = WS_ACT + 256 * MiB, A_PP = WS_ACT + 288 * MiB, A_MERGED = A_SCX, A_FFN = WS_ACT;
constexpr size_t WS_WC = 524 * MiB;
constexpr size_t WS_ACTP = 98 * MiB;
constexpr size_t WS_WMOE = 304 * MiB, WMOE_W2 = 56 * MiB;
constexpr size_t WS_Y = 400 * MiB;
constexpr size_t WS_APERM = 472 * MiB;
constexpr size_t WS_SS = 540 * MiB;
constexpr size_t WS_END = 541 * MiB;

typedef __bf16 bf16x2_t __attribute__((ext_vector_type(2)));
__device__ __forceinline__ unsigned pk_bf16(float lo, float hi) { const bf16x2_t v = {(__bf16)lo, (__bf16)hi}; return __builtin_bit_cast(unsigned, v); }
__device__ __forceinline__ unsigned pk_fp8x4(const f32x4 v) {
    const float a = __builtin_amdgcn_fmed3f(v[0], -448.f, 448.f), b = __builtin_amdgcn_fmed3f(v[1], -448.f, 448.f), c = __builtin_amdgcn_fmed3f(v[2], -448.f, 448.f), d = __builtin_amdgcn_fmed3f(v[3], -448.f, 448.f);
    int w = 0; w = __builtin_amdgcn_cvt_pk_fp8_f32(a, b, w, false); w = __builtin_amdgcn_cvt_pk_fp8_f32(c, d, w, true); return (unsigned)w; }
__device__ __forceinline__ float bf_lo(unsigned u) { return __uint_as_float(u << 16); }
__device__ __forceinline__ float bf_hi(unsigned u) { return __uint_as_float(u & 0xffff0000u); }
__device__ __forceinline__ float sigm(float x) { return __builtin_amdgcn_rcpf(1.f + __builtin_amdgcn_exp2f(-1.44269504f * x)); }
__device__ __forceinline__ float wave_sum(float v) {
#pragma unroll
    for (int o = 1; o < 64; o <<= 1) v += __shfl_xor(v, o);
    return v;
}
#define LDS_WAIT() asm volatile("s_waitcnt lgkmcnt(0)" ::: "memory")

namespace pg8 {
constexpr int BM = 256, BK = 64, HALF = 128, HTB = HALF * BK * 2, STAGE_BYTES = 8 * HTB, NXCD = 8;
__host__ __device__ __forceinline__ int lds_byte(int r, int c) { const int st = (r >> 4) * 2 + (c >> 5), rr = r & 15, cc = c & 31, ob = rr * 64 + cc * 2; return st * 1024 + (ob ^ (((ob >> 9) & 1) << 5)); }
__host__ __device__ __forceinline__ void stage_rc(int b, int& R, int& C) { const int st = b / 1024, sb = b % 1024, swz = sb ^ (((sb >> 9) & 1) << 5); R = (st >> 1) * 16 + swz / 64; C = (st & 1) * 32 + (swz % 64) / 2; }
__host__ __device__ __forceinline__ int perm32(int rho) { const int n = rho >> 4, i = rho & 15; return 8 * (i >> 2) + 4 * n + (i & 3); }

struct Unit { int pm, pn, aux, nt; const char* A; const char* B; };
struct Gemm { int Kb, lda, ldb; int sa, sb; };

__device__ __forceinline__ bool tile_of(int L, int nM, int nN, int& pm, int& pn, int WGM = 4) {
    const int nwg = nM * nN; if (L >= nwg) return false;
    int wgid = L; { const int q = nwg / NXCD, r = nwg % NXCD, xcd = wgid % NXCD, off = wgid / NXCD; wgid = (xcd < r ? xcd * (q + 1) : r * (q + 1) + (xcd - r) * q) + off; }
    const int nig = WGM * nN, gid = wgid / nig, fm = gid * WGM, gsz = (nM - fm) < WGM ? (nM - fm) : WGM;
    pm = fm + ((wgid % nig) % gsz); pn = (wgid % nig) / gsz; return true;
}
struct PlainSched {
    int nM, nN, G, c; const char* A0; const char* B0; size_t astep, bstep; int wgm;
    __device__ __forceinline__ bool next(int i, Unit& u) const { int pm, pn; if (!tile_of(i * G + c, nM, nN, pm, pn, wgm)) return false; u.pm = pm; u.pn = pn; u.aux = 0; u.nt = 0; u.A = A0 + (size_t)pm * astep; u.B = B0 + (size_t)pn * bstep; return true; }
};
struct PoolSched {
    int G, c; const char* A0; const char* B0;
    __device__ __forceinline__ bool next(int i, Unit& u) const { int pm, pn; if (!tile_of(i * G + c, M / 256, 4, pm, pn)) return false; u.pm = pm; u.pn = pn; u.aux = 0; u.nt = 0;
        u.A = A0 + (size_t)pm * (256 * 1024 * 2) + (size_t)pn * 512; u.B = B0 + (size_t)pn * (256 * 256 * 2); return true; }
};
struct MergeSched {
    int G, c; const char *A0, *B0, *B2; size_t astr, bstr;
    __device__ __forceinline__ bool next(int i, Unit& u) const { const int t = i / 3, b = i - 3 * t; int pm, pn; if (!tile_of(t * G + c, M / 256, 4, pm, pn)) return false; u.pm = pm; u.pn = pn; u.aux = b; u.nt = 0;
        const char* w = b == 2 ? B2 : B0 + (size_t)b * bstr;
        u.A = A0 + (size_t)b * astr + (size_t)pm * (256 * 1024 * 2); u.B = w + (size_t)pn * (256 * 1024 * 2); return true; }
};
struct FoldSched {
    int G, c; const char *A0, *B0;
    __device__ __forceinline__ bool next(int i, Unit& u) const { const int idx = i * G + c; if (idx >= 32) return false; const int L = idx >> 4, pm = (idx >> 2) & 3, g = idx & 3; u.pm = pm; u.pn = g; u.aux = L; u.nt = 0;
        u.A = A0 + (size_t)L * (6 * MiB) + (size_t)pm * (256 * 1024 * 2) + (size_t)g * 512; u.B = B0 + (size_t)L * (512 * 1024) + (size_t)g * (256 * 256 * 2); return true; }
};
struct GroupSched {
    int nM, nN, G, c; int o1, o2, o3, o4, o5, o6, o7; const char* A0; const char* B0; size_t astep, bstep, estep; int wgm;
    __device__ __forceinline__ bool next(int i, Unit& u) const { int pm, pn; if (!tile_of(i * G + c, nM, nN, pm, pn, wgm)) return false; u.pm = pm; u.pn = pn; u.aux = 0; u.nt = 0;
        const int e = (pm >= o1) + (pm >= o2) + (pm >= o3) + (pm >= o4) + (pm >= o5) + (pm >= o6) + (pm >= o7);
        u.A = A0 + (size_t)pm * astep; u.B = B0 + (size_t)e * estep + (size_t)pn * bstep; return true; }
};

constexpr int MOE2_SPL = 7, MOE2_SNT = 4;
struct Moe2Sched {
    int nM, G, c, R, tail, split; int o1, o2, o3, o4, o5, o6, o7; const char* A0; const char* B0; size_t astep, bstep, estep;
    __device__ __forceinline__ bool next(int i, Unit& u) const {
        int L = i * G + c, part = -1, sub = 0;
        if (split && i >= R) { if (i > R || c >= MOE2_SPL * tail) return false; sub = c; L = R * G + c / MOE2_SPL; part = c % MOE2_SPL; }
        int pm, pn; if (!tile_of(L, nM, 4, pm, pn, 4)) return false; u.pm = pm; u.pn = pn;
        const int e = (pm >= o1) + (pm >= o2) + (pm >= o3) + (pm >= o4) + (pm >= o5) + (pm >= o6) + (pm >= o7);
        u.A = A0 + (size_t)pm * astep; u.B = B0 + (size_t)e * estep + (size_t)pn * bstep; u.aux = 0; u.nt = 0;
        if (part >= 0) { u.A += part * (MOE2_SNT * 128); u.B += part * (MOE2_SNT * 128); u.aux = 1 + sub; u.nt = MOE2_SNT; }
        return true; }
};

typedef f32x4 Acc[2][2][4][2];
__device__ __forceinline__ u32x4 pack8(const f32x4 v0, const f32x4 v1) { u32x4 w; w.x = pk_bf16(v0[0], v0[1]); w.y = pk_bf16(v0[2], v0[3]); w.z = pk_bf16(v1[0], v1[1]); w.w = pk_bf16(v1[2], v1[3]); return w; }
__device__ __forceinline__ f32x4 sig4(const f32x4 v) { f32x4 r; r[0] = sigm(v[0]); r[1] = sigm(v[1]); r[2] = sigm(v[2]); r[3] = sigm(v[3]); return r; }
__device__ __forceinline__ void unpack8(const u32x4 g, f32x4& lo, f32x4& hi) { lo[0] = bf_lo(g.x); lo[1] = bf_hi(g.x); lo[2] = bf_lo(g.y); lo[3] = bf_hi(g.y); hi[0] = bf_lo(g.z); hi[1] = bf_hi(g.z); hi[2] = bf_lo(g.w); hi[3] = bf_hi(g.w); }

__device__ __forceinline__ size_t gate_frag(int pm, int q, int wid, int ai, int m, int bj, int lane) { return ((size_t)((((((pm * 12 + q) * 8 + wid) * 2 + ai) * 4 + m) * 2 + bj) * 64 + lane)) * 16; }
struct EpiProj {
    bf16_t *scb, *scx, *glu, *pu, *gates; const f32x4* ss; int pn_off;
    __device__ __forceinline__ bool operator()(Acc& acc, const Unit& u, int wr, int wc, int fr, int fq) const {
        const int row0 = u.pm * BM + wr * 64 + fr, pn = u.pn + pn_off;
        float rs[2][4];
#pragma unroll
        for (int ai = 0; ai < 2; ++ai)
#pragma unroll
            for (int m = 0; m < 4; ++m) { const f32x4 p = ss[row0 + ai * HALF + m * 16]; rs[ai][m] = __builtin_amdgcn_rsqf(((p[0] + p[1]) + (p[2] + p[3])) * (1.0f / D) + RMS_EPS); }
        if (pn >= 4 && pn < 20) {
            const bool isglu = pn >= 12; bf16_t* dst = isglu ? glu : scx; const int col0 = (isglu ? pn - 12 : pn - 4) * 128 + wc * 32 + 8 * fq;
#pragma unroll
            for (int ai = 0; ai < 2; ++ai)
#pragma unroll
                for (int m = 0; m < 4; ++m) { const float r = rs[ai][m];
                    f32x4 a0 = acc[ai][0][m][0] * r, a1 = acc[ai][0][m][1] * r, b0 = acc[ai][1][m][0] * r, b1 = acc[ai][1][m][1] * r;
                    if (isglu) { b0 = sig4(b0); b1 = sig4(b1); }
                    *(u32x4*)(dst + (size_t)(row0 + ai * HALF + m * 16) * D + col0) = pack8(a0 * b0, a1 * b1); }
        } else {
            if (pn >= 24) {
#pragma unroll
                for (int ai = 0; ai < 2; ++ai)
#pragma unroll
                    for (int m = 0; m < 4; ++m) { const float r = rs[ai][m];
#pragma unroll
                        for (int bj = 0; bj < 2; ++bj) { f32x4 e0 = acc[ai][bj][m][0] * r, e1 = acc[ai][bj][m][1] * r;
#pragma unroll
                            for (int j = 0; j < 4; ++j) { e0[j] = __builtin_amdgcn_exp2f(-1.44269504f * __builtin_amdgcn_fmed3f(e0[j], -30.f, 30.f)); e1[j] = __builtin_amdgcn_exp2f(-1.44269504f * __builtin_amdgcn_fmed3f(e1[j], -30.f, 30.f)); }
                            *(u32x4*)((unsigned char*)gates + gate_frag(u.pm, pn - 24, wr * 4 + wc, ai, m, bj, fr + 16 * fq)) = pack8(e0, e1); } }
            } else {
            bf16_t* dst = pn < 4 ? scb : pu; const int ldc = D, colb = (pn < 4 ? pn : pn - 20) * 256;
            const int col0 = colb + wc * 32 + 8 * fq;
#pragma unroll
            for (int ai = 0; ai < 2; ++ai)
#pragma unroll
                for (int m = 0; m < 4; ++m) { const float r = rs[ai][m]; bf16_t* rowp = dst + (size_t)(row0 + ai * HALF + m * 16) * ldc + col0;
#pragma unroll
                    for (int bj = 0; bj < 2; ++bj) *(u32x4*)(rowp + bj * HALF) = pack8(acc[ai][bj][m][0] * r, acc[ai][bj][m][1] * r); }
            }
        }
        return false;
    }
};
struct EpiPlain {
    bf16_t* Ob; int ldc; size_t aux_stride;
    __device__ __forceinline__ bool operator()(Acc& acc, const Unit& u, int wr, int wc, int fr, int fq) const {
        bf16_t* O = Ob + (size_t)u.aux * aux_stride;
        const int row0 = u.pm * BM + wr * 64 + fr, col0 = u.pn * BM + wc * 32 + 8 * fq;
#pragma unroll
        for (int ai = 0; ai < 2; ++ai)
#pragma unroll
            for (int m = 0; m < 4; ++m) { bf16_t* rowp = O + (size_t)(row0 + ai * HALF + m * 16) * ldc + col0;
#pragma unroll
                for (int bj = 0; bj < 2; ++bj) *(u32x4*)(rowp + bj * HALF) = pack8(acc[ai][bj][m][0], acc[ai][bj][m][1]); }
        return false;
    }
};
struct EpiMoe2 {
    bf16_t* Y; bf16_t* YP;
    __device__ __forceinline__ bool operator()(Acc& acc, const Unit& u, int wr, int wc, int fr, int fq) const {
        bf16_t* O; int ldc;
        if (u.aux) { O = YP + (size_t)(u.aux - 1) * 65536 + (size_t)(wr * 64 + fr) * 256 + wc * 32 + 8 * fq; ldc = 256; }
        else { O = Y + (size_t)(u.pm * BM + wr * 64 + fr) * D + u.pn * BM + wc * 32 + 8 * fq; ldc = D; }
#pragma unroll
        for (int ai = 0; ai < 2; ++ai)
#pragma unroll
            for (int m = 0; m < 4; ++m) { bf16_t* rowp = O + (size_t)(ai * HALF + m * 16) * ldc;
#pragma unroll
                for (int bj = 0; bj < 2; ++bj) *(u32x4*)(rowp + bj * HALF) = pack8(acc[ai][bj][m][0], acc[ai][bj][m][1]); }
        return false;
    }
};
struct EpiMerge {
    const bf16_t* gates; bf16_t* O;
    __device__ __forceinline__ bool operator()(Acc& acc, const Unit& u, int wr, int wc, int fr, int fq) const {
        const int row0 = u.pm * BM + wr * 64 + fr, col0 = u.pn * BM + wc * 32 + 8 * fq, b = u.aux;
#pragma unroll
        for (int ai = 0; ai < 2; ++ai)
#pragma unroll
            for (int m = 0; m < 4; ++m) { const size_t row = (size_t)(row0 + ai * HALF + m * 16);
#pragma unroll
                for (int bj = 0; bj < 2; ++bj) { const unsigned char* gp = (const unsigned char*)gates + gate_frag(u.pm, 4 * b + u.pn, wr * 4 + wc, ai, m, bj, fr + 16 * fq);
                    f32x4 g0, g1; unpack8(*(const u32x4*)gp, g0, g1);
                    if (b < 2) { f32x4 h0, h1; unpack8(*(const u32x4*)(gp + gate_frag(0, 4, 0, 0, 0, 0, 0)), h0, h1);
#pragma unroll
                        for (int j = 0; j < 4; ++j) { acc[ai][bj][m][0][j] *= (1.f + h0[j]) * __builtin_amdgcn_rcpf(1.f + g0[j]); acc[ai][bj][m][1][j] *= (1.f + h1[j]) * __builtin_amdgcn_rcpf(1.f + g1[j]); }
                    } else {
#pragma unroll
                        for (int j = 0; j < 4; ++j) { g0[j] = __builtin_amdgcn_rcpf(1.f + g0[j]); g1[j] = __builtin_amdgcn_rcpf(1.f + g1[j]); }
                        *(u32x4*)(O + row * D + col0 + bj * HALF) = pack8(acc[ai][bj][m][0] * g0, acc[ai][bj][m][1] * g1); } } }
        return b < 2;
    }
};
struct EpiResid {
    const float* base32; bf16_t* xb; float* ssp; LAS float* red; unsigned char* x8;
    __device__ __forceinline__ bool operator()(Acc& acc, const Unit& u, int wr, int wc, int fr, int fq) const {
        const int row0 = u.pm * BM + wr * 64 + fr, col0 = u.pn * BM + wc * 32 + 8 * fq;
#pragma unroll
        for (int ai = 0; ai < 2; ++ai)
#pragma unroll
            for (int m = 0; m < 4; ++m) { const size_t row = (size_t)(row0 + ai * HALF + m * 16); float q = 0.f;
#pragma unroll
                for (int bj = 0; bj < 2; ++bj) { const size_t off = row * D + col0 + bj * HALF;
                    f32x4 b0, b1; if (base32) { b0 = *(const f32x4*)(base32 + off); b1 = *(const f32x4*)(base32 + off + 4); } else unpack8(*(const u32x4*)(xb + off), b0, b1);
                    const u32x4 pk = pack8(b0 + acc[ai][bj][m][0], b1 + acc[ai][bj][m][1]); *(u32x4*)(xb + off) = pk;
                    f32x4 o0, o1; unpack8(pk, o0, o1); if (x8) *(u32x2*)(x8 + off) = (u32x2){pk_fp8x4(o0), pk_fp8x4(o1)};
                    q += (o0[0] * o0[0] + o0[1] * o0[1]) + (o0[2] * o0[2] + o0[3] * o0[3]) + (o1[0] * o1[0] + o1[1] * o1[1]) + (o1[2] * o1[2] + o1[3] * o1[3]); }
                q += __shfl_xor(q, 16); q += __shfl_xor(q, 32);
                if (fq == 0) red[(ai * HALF + wr * 64 + m * 16 + fr) * 4 + wc] = q; }
        asm volatile("s_waitcnt lgkmcnt(0)" ::: "memory"); __builtin_amdgcn_s_barrier(); asm volatile("" ::: "memory");
        int tid = threadIdx.x; asm volatile("" : "+v"(tid));
        if (tid < 256) { const f32x4 v = *(const LAS f32x4*)(red + tid * 4); ssp[(size_t)(u.pm * BM + tid) * 4 + u.pn] = (v[0] + v[1]) + (v[2] + v[3]); }
        return false;
    }
};
template <bool PART4, bool OUT8> struct EpiSwiGLU {
    bf16_t* O; int ldc; const float* ss;
    __device__ __forceinline__ bool operator()(Acc& acc, const Unit& u, int wr, int wc, int fr, int fq) const {
        const int row0 = u.pm * BM + wr * 64 + fr, col0 = u.pn * 128 + wc * 32 + 8 * fq;
#pragma unroll
        for (int ai = 0; ai < 2; ++ai)
#pragma unroll
            for (int m = 0; m < 4; ++m) { const size_t row = (size_t)(row0 + ai * HALF + m * 16); float r = 1.f;
                if (PART4) { const f32x4 p = *(const f32x4*)(ss + row * 4); r = __builtin_amdgcn_rsqf(((p[0] + p[1]) + (p[2] + p[3])) * (1.0f / D) + RMS_EPS); }
                const f32x4 a0 = acc[ai][0][m][0] * r, a1 = acc[ai][0][m][1] * r, c0 = acc[ai][1][m][0] * r, c1 = acc[ai][1][m][1] * r;
                const f32x4 h0 = a0 * sig4(a0) * c0, h1 = a1 * sig4(a1) * c1;
                if (OUT8) { *(u32x2*)((unsigned char*)O + row * ldc + col0) = (u32x2){pk_fp8x4(h0 * F8_ACT_MUL), pk_fp8x4(h1 * F8_ACT_MUL)}; }
                else *(u32x4*)(O + row * ldc + col0) = pack8(h0, h1); }
        return false;
    }
};

typedef int i32x4 __attribute__((ext_vector_type(4)));
typedef int i32x8 __attribute__((ext_vector_type(8)));
__device__ __forceinline__ i32x8 join16(const bf16x8 lo, const bf16x8 hi) { return __builtin_shufflevector(__builtin_bit_cast(i32x4, lo), __builtin_bit_cast(i32x4, hi), 0, 1, 2, 3, 4, 5, 6, 7); }
template <class Epi, class Sched, bool F8 = false>
__device__ __forceinline__ void gemm_phase(LAS unsigned char* lds, const Gemm g, const Sched& S, const Epi& E) {
    int tid_ = threadIdx.x; asm volatile("" : "+v"(tid_));
    const int tid = tid_, wid = __builtin_amdgcn_readfirstlane(tid >> 6), lane = tid & 63, wr = wid >> 2, wc = wid & 3, fr = lane & 15, fq = lane >> 4;
    const int nt = g.Kb / 128;
    int vsa = g.sa, vsb = g.sb; asm volatile("" : "+v"(vsa), "+v"(vsb));
    unsigned voffA[2], voffB[2];
#pragma unroll
    for (int i = 0; i < 2; ++i) { int R, C; stage_rc(tid * 16 + i * 8192, R, C); const int Rb = (R & ~31) + perm32(R & 31);
        voffA[i] = (unsigned)(R * g.lda + C * 2); voffB[i] = (unsigned)(Rb * g.ldb + C * 2); }
    const size_t kstep = (size_t)(BK * 2);
    const size_t hstepA = (size_t)HALF * g.lda, hstepB = (size_t)HALF * g.ldb;
    const unsigned ldsw = (unsigned)wid * 1024u;
    const int aoff = lds_byte(wr * 64 + fr, fq * 8), boff = lds_byte(wc * 32 + fr, fq * 8);
#define PG8_SA(b, h) (((b) * 2 + (h)) * HTB)
#define PG8_SB(b, h) ((4 + (b) * 2 + (h)) * HTB)
#define PG8_STAGE(bufoff, gbase, voff) do { _Pragma("unroll") for (int _i = 0; _i < 2; ++_i) \
        __builtin_amdgcn_global_load_lds((const unsigned*)((const char*)(gbase) + (voff)[_i]), (LAS unsigned*)(lds + (bufoff) + ldsw + _i * 8192), 16, 0, 0); } while (0)
#define PG8_LDA(dst, b, h) do { _Pragma("unroll") for (int m = 0; m < 4; ++m) _Pragma("unroll") for (int k = 0; k < 2; ++k) dst[m][k] = *(const LAS bf16x8*)(lds + PG8_SA(b, h) + aoff + m * 2048 + k * 1024); } while (0)
#define PG8_LDB(dst, b, h) do { _Pragma("unroll") for (int n = 0; n < 2; ++n) _Pragma("unroll") for (int k = 0; k < 2; ++k) dst[n][k] = *(const LAS bf16x8*)(lds + PG8_SB(b, h) + boff + n * 2048 + k * 1024); } while (0)
#define PG8_MMA(ai, bj, At, Bt) do { __builtin_amdgcn_s_setprio(1); _Pragma("unroll") for (int m = 0; m < 4; ++m) _Pragma("unroll") for (int n = 0; n < 2; ++n) { \
        if constexpr (F8) { const i32x8 b8_ = join16(Bt[n][0], Bt[n][1]), a8_ = join16(At[m][0], At[m][1]); \
            asm volatile("v_mfma_scale_f32_16x16x128_f8f6f4 %0, %1, %2, %0, %3, %4 op_sel_hi:[0,0,0]" : "+v"(acc[ai][bj][m][n]) : "v"(b8_), "v"(a8_), "v"(vsb), "v"(vsa)); } \
        else { _Pragma("unroll") for (int k = 0; k < 2; ++k) acc[ai][bj][m][n] = __builtin_amdgcn_mfma_f32_16x16x32_bf16(Bt[n][k], At[m][k], acc[ai][bj][m][n], 0, 0, 0); } } __builtin_amdgcn_s_setprio(0); } while (0)
#define PG8_WAIT_V(n) asm volatile("s_waitcnt vmcnt(" #n ")" ::: "memory")
#define PG8_WAIT_L(n) asm volatile("s_waitcnt lgkmcnt(" #n ")" ::: "memory")
#define PG8_BAR __builtin_amdgcn_s_barrier()
#define PG8_SCHED __builtin_amdgcn_sched_barrier(0)
    Unit cur, nxt; int ui = 0;
    if (!S.next(0, cur)) return;
    Acc acc;
#pragma unroll
    for (int a = 0; a < 2; ++a)
#pragma unroll
        for (int b = 0; b < 2; ++b)
#pragma unroll
            for (int m = 0; m < 4; ++m)
#pragma unroll
                for (int n = 0; n < 2; ++n) acc[a][b][m][n] = (f32x4){0.f, 0.f, 0.f, 0.f};
    bf16x8 At[4][2], B0[2][2], B1[2][2];
    const char* cA = cur.A; const char* cB = cur.B;
    PG8_STAGE(PG8_SB(0, 0), cB, voffB); PG8_STAGE(PG8_SB(0, 1), cB + hstepB, voffB); PG8_STAGE(PG8_SA(0, 0), cA, voffA); PG8_STAGE(PG8_SA(0, 1), cA + hstepA, voffA);
    if (wr == 1) PG8_BAR;
    PG8_WAIT_V(2); PG8_BAR;
    PG8_STAGE(PG8_SB(1, 0), cB + kstep, voffB); PG8_STAGE(PG8_SA(1, 0), cA + kstep, voffA); PG8_STAGE(PG8_SB(1, 1), cB + hstepB + kstep, voffB);
    PG8_WAIT_V(6); PG8_BAR;
    for (;;) {
        const bool has_next = S.next(ui + 1, nxt);
        const char* nA = has_next ? nxt.A : cA; const char* nB = has_next ? nxt.B : cB;
        const int unt = cur.nt ? cur.nt : nt;
#pragma nounroll
        for (int t = 0; t < unt; t += 2) {
            const bool last = (t == unt - 2);
            const char* a1 = cA + (size_t)(t + 1) * kstep;
            const char* a2 = last ? nA : cA + (size_t)(t + 2) * kstep; const char* b2 = last ? nB : cB + (size_t)(t + 2) * kstep;
            const char* a3 = a2 + kstep; const char* b3 = b2 + kstep;
            PG8_LDB(B0, 0, 0); PG8_LDB(B1, 0, 1); PG8_SCHED; PG8_LDA(At, 0, 0); PG8_STAGE(PG8_SA(1, 1), a1 + hstepA, voffA);
            PG8_WAIT_V(8); PG8_WAIT_L(0); PG8_BAR; PG8_MMA(0, 0, At, B0); PG8_MMA(0, 1, At, B1); PG8_BAR; PG8_SCHED;
            PG8_LDA(At, 0, 1); PG8_STAGE(PG8_SB(0, 0), b2, voffB); PG8_STAGE(PG8_SB(0, 1), b2 + hstepB, voffB); PG8_STAGE(PG8_SA(0, 0), a2, voffA);
            PG8_WAIT_V(8); PG8_WAIT_L(0); PG8_BAR; PG8_MMA(1, 0, At, B0); PG8_MMA(1, 1, At, B1); PG8_BAR; PG8_SCHED;
            PG8_LDB(B0, 1, 0); PG8_LDB(B1, 1, 1); PG8_SCHED; PG8_LDA(At, 1, 0); PG8_STAGE(PG8_SA(0, 1), a2 + hstepA, voffA);
            PG8_WAIT_V(8); PG8_WAIT_L(0); PG8_BAR; PG8_MMA(0, 0, At, B0); PG8_MMA(0, 1, At, B1); PG8_BAR; PG8_SCHED;
            PG8_LDA(At, 1, 1); PG8_STAGE(PG8_SB(1, 0), b3, voffB); PG8_STAGE(PG8_SB(1, 1), b3 + hstepB, voffB); PG8_STAGE(PG8_SA(1, 0), a3, voffA);
            PG8_WAIT_V(8); PG8_WAIT_L(0); PG8_BAR; PG8_MMA(1, 0, At, B0); PG8_MMA(1, 1, At, B1); PG8_BAR; PG8_SCHED;
        }
        if constexpr (F8) asm volatile("s_nop 15\n\ts_nop 15" ::: "memory");
        if (wr == 0) PG8_BAR;
        const bool keep = E(acc, cur, wr, wc, fr, fq);
        if (!has_next) break;
        if (!keep) {
#pragma unroll
            for (int a = 0; a < 2; ++a)
#pragma unroll
                for (int b = 0; b < 2; ++b)
#pragma unroll
                    for (int m = 0; m < 4; ++m)
#pragma unroll
                        for (int n = 0; n < 2; ++n) acc[a][b][m][n] = (f32x4){0.f, 0.f, 0.f, 0.f};
        }
        cur = nxt; cA = nA; cB = nB; ++ui;
        if (wr == 1) PG8_BAR;
    }
    PG8_WAIT_V(0);
    PG8_BAR;
#undef PG8_SA
#undef PG8_SB
#undef PG8_STAGE
#undef PG8_LDA
#undef PG8_LDB
#undef PG8_MMA
#undef PG8_WAIT_V
#undef PG8_WAIT_L
#undef PG8_BAR
#undef PG8_SCHED
}
}

constexpr int RING_BYTES = 131072, MISC_OFF = RING_BYTES, RED_OFF = RING_BYTES + 1024, LDS_BYTES = 147456;

#define XB_TMO      128
#define XB_XCNT(j)  (256  + 64 * (j))
#define XB_XSUB(j)  (1280 + 64 * (j))
#define XB_XGEN(j)  (2304 + 64 * (j))
#define XB_TOP      3328
#define XB_TOPGEN   3392
#define XCD_BAR_WORDS 3456
#define XB_SPIN_CAP (1u << 18)
__device__ __forceinline__ unsigned xb_ld(unsigned* p)              { return __hip_atomic_load(p, __ATOMIC_RELAXED, __HIP_MEMORY_SCOPE_AGENT); }
__device__ __forceinline__ unsigned xb_add(unsigned* p, unsigned v) { return __hip_atomic_fetch_add(p, v, __ATOMIC_RELAXED, __HIP_MEMORY_SCOPE_AGENT); }
__device__ __forceinline__ unsigned xb_xcc_id() { return (unsigned)__builtin_amdgcn_s_getreg((3 << 11) | 20) & 0xFu; }
#define XB_SPIN(cond, bar) do { unsigned _sp = 0; while (cond) { __builtin_amdgcn_s_sleep(1); \
    if ((++_sp & 255u) == 0u) { if (xb_ld(&(bar)[XB_TMO])) break; if (_sp > XB_SPIN_CAP) { atomicAdd(&(bar)[XB_TMO], 1u); break; } } } } while (0)
struct XcdBarrier { unsigned* bar; unsigned x; volatile LAS unsigned* st; };
__device__ __forceinline__ XcdBarrier xcd_barrier_post(unsigned* bar, volatile LAS unsigned* st) {
    XcdBarrier b; b.bar = bar; b.x = xb_xcc_id(); b.st = st;
    if (threadIdx.x == 0) (void)xb_add(&bar[XB_XCNT(b.x)], 1u);
    return b;
}
__device__ __forceinline__ void xcd_barrier_complete(unsigned* bar, unsigned x, unsigned& nloc, unsigned& nx) {
    const unsigned G = gridDim.x * gridDim.y * gridDim.z;
    unsigned sum, cnt, mine, sp = 0u;
    for (;;) {
        sum = 0u; cnt = 0u; mine = 0u;
#pragma nounroll
        for (unsigned j = 0; j < 16; ++j) { const unsigned c = xb_ld(&bar[XB_XCNT(j)]); sum += c; cnt += (c > 0u) ? 1u : 0u; mine = (j == x) ? c : mine; }
        if (sum == G) break;
        __builtin_amdgcn_s_sleep(1);
        if ((++sp & 255u) == 0u) { if (xb_ld(&bar[XB_TMO])) break; if (sp > XB_SPIN_CAP) { atomicAdd(&bar[XB_TMO], 1u); break; } }
    }
    nloc = mine > 0u ? mine : 1u; nx = cnt > 0u ? cnt : 1u;
}
__device__ __forceinline__ void xcd_barrier(const XcdBarrier& b) {
    asm volatile("s_waitcnt vmcnt(0)" ::: "memory");
    __syncthreads();
    if (threadIdx.x == 0) {
        unsigned* bar = b.bar;
        __builtin_amdgcn_s_waitcnt(0);
        unsigned nloc = b.st[0], nx = b.st[1];
        if (nloc == 0u) { xcd_barrier_complete(bar, b.x, nloc, nx); b.st[0] = nloc; b.st[1] = nx; }
        const unsigned old = xb_add(&bar[XB_XSUB(b.x)], 1u);
        const unsigned gen = old / nloc;
        if (old + 1u == (gen + 1u) * nloc) {
            __builtin_amdgcn_fence(__ATOMIC_RELEASE, "agent");
            asm volatile("s_waitcnt vmcnt(0)" ::: "memory");
            const unsigned og = xb_add(&bar[XB_TOP], 1u);
            const unsigned tg = og / nx;
            if (og + 1u == (tg + 1u) * nx) xb_add(&bar[XB_TOPGEN], 1u);
            else XB_SPIN(xb_ld(&bar[XB_TOPGEN]) == tg, bar);
            __builtin_amdgcn_fence(__ATOMIC_ACQUIRE, "agent");
            xb_add(&bar[XB_XGEN(b.x)], 1u);
            asm volatile("s_waitcnt vmcnt(0)" ::: "memory");
        } else {
            XB_SPIN(xb_ld(&bar[XB_XGEN(b.x)]) == gen, bar);
            __builtin_amdgcn_fence(__ATOMIC_ACQUIRE, "agent");
            asm volatile("s_waitcnt vmcnt(0)" ::: "memory");
        }
    }
    __syncthreads();
}

struct Args { const float* in[23]; float* out; unsigned char* ws; int ph_lo, ph_hi; };
static_assert(sizeof(Args) == 23 * 8 + 8 + 8 + 8, "Args has no padding");
typedef const __attribute__((address_space(4))) Args* KArgs;
__device__ __forceinline__ KArgs kargs() { KArgs p = (KArgs)__builtin_amdgcn_kernarg_segment_ptr(); asm volatile("" : "+s"(p)); return p; }

__device__ __forceinline__ void transpose_item(const float* src, int ldn, int k0, int n0, bf16_t* dst, int ldk, const float* kscale, const float* nscale, int lane) {
    const int r4 = lane >> 4, q = lane & 15;
    f32x4 v[16];
    const float* sp = src + (size_t)(k0 + 16 * r4) * ldn + n0 + 4 * q;
#pragma unroll
    for (int i = 0; i < 16; ++i) v[i] = __builtin_nontemporal_load((const f32x4*)(sp + (size_t)i * ldn));
    f32x4 ns = (f32x4){1.f, 1.f, 1.f, 1.f}; if (nscale) ns = *(const f32x4*)(nscale + n0 + 4 * q);
    if (kscale) {
        const f32x4* kp = (const f32x4*)(kscale + k0 + 16 * r4);
#pragma unroll
        for (int g = 0; g < 4; ++g) { const f32x4 ks = kp[g];
#pragma unroll
            for (int j = 0; j < 4; ++j) v[4 * g + j] = v[4 * g + j] * ks[j]; }
    }
#pragma unroll
    for (int e = 0; e < 4; ++e) { u32x4 lo, hi;
#pragma unroll
        for (int w = 0; w < 4; ++w) { lo[w] = pk_bf16(v[2 * w][e] * ns[e], v[2 * w + 1][e] * ns[e]); hi[w] = pk_bf16(v[8 + 2 * w][e] * ns[e], v[9 + 2 * w][e] * ns[e]); }
        bf16_t* o = dst + (size_t)(4 * q + e) * ldk + k0 + 16 * r4; *(u32x4*)o = lo; *(u32x4*)(o + 8) = hi; }
}
__device__ __forceinline__ void transpose_item_f8(const float* src, int ldn, int k0, int n0, unsigned char* dst, int ldk, const float* kscale, float mul, int lane) {
    const int r4 = lane >> 4, q = lane & 15;
    f32x4 v[16];
    const float* sp = src + (size_t)(k0 + 16 * r4) * ldn + n0 + 4 * q;
#pragma unroll
    for (int i = 0; i < 16; ++i) v[i] = __builtin_nontemporal_load((const f32x4*)(sp + (size_t)i * ldn));
    {
        const f32x4* kp = (const f32x4*)(kscale + k0 + 16 * r4);
#pragma unroll
        for (int g = 0; g < 4; ++g) { f32x4 ks = (f32x4){mul, mul, mul, mul}; if (kscale) ks = kp[g] * mul;
#pragma unroll
            for (int j = 0; j < 4; ++j) v[4 * g + j] = v[4 * g + j] * ks[j]; }
    }
#pragma unroll
    for (int e = 0; e < 4; ++e) { u32x4 o;
#pragma unroll
        for (int w = 0; w < 4; ++w) o[w] = pk_fp8x4((f32x4){v[4 * w][e], v[4 * w + 1][e], v[4 * w + 2][e], v[4 * w + 3][e]});
        *(u32x4*)(dst + (size_t)(4 * q + e) * ldk + k0 + 16 * r4) = o; }
}
__device__ __forceinline__ int win_row(int n0) {
    const int seg = n0 >> 10, c = n0 & 1023;
    if (seg == 1 || seg == 2) return 1024 + (c >> 7) * 256 + (seg == 2 ? 128 : 0) + (c & 127);
    if (seg == 3 || seg == 4) return 3072 + (c >> 7) * 256 + (seg == 4 ? 128 : 0) + (c & 127);
    return n0;
}
__device__ __forceinline__ int pair_row(int f, int second) { return (f >> 7) * 256 + (second ? 128 : 0) + (f & 127); }

__device__ __forceinline__ void prologue_phase(KArgs a, LAS unsigned char* lds, int wid, int lane) {
    asm volatile("" : "+v"(lane));
    const int gw = blockIdx.x * 8 + wid, NGW = gridDim.x * 8;
    unsigned char* ws = a->ws;
    constexpr int I_WIN = 16 * 144, I_SQ = 16 * 16, I_PW = 16, I_D1 = 16 * 56, I_D2 = 56 * 16;
    constexpr int NIT = 2 * I_WIN + 8 * I_SQ + 8 * I_PW + 2 * I_D1 + I_D2;
    for (int it = gw; it < NIT; it += NGW) {
        int r = it;
        if (r < 2 * I_WIN) { const int L = r / I_WIN; r -= L * I_WIN; const int kb = r / 144, nb = r % 144, n0 = 64 * nb;
            if (n0 >= 6144) transpose_item_f8(a->in[2] + (size_t)L * D * INC, INC, 64 * kb, n0, ws + WS_WG8 + (size_t)L * 3 * MiB + (size_t)(n0 - 6144) * D, D, a->in[1] + L * D, F8_W13_MUL, lane);
            else transpose_item(a->in[2] + (size_t)L * D * INC, INC, 64 * kb, n0, (bf16_t*)(ws + WS_W0 + W0_WIN + (size_t)L * 18 * MiB) + (size_t)win_row(n0) * D, D, a->in[1] + L * D, nullptr, lane);
            continue; }
        r -= 2 * I_WIN;
        if (r < 8 * I_SQ) { const int j = r / I_SQ; r -= j * I_SQ; const int L = j >> 2, w = j & 3, kb = r / 16, nb = r % 16, n0 = 64 * nb;
            bf16_t* dst = w < 3 ? (bf16_t*)(ws + WS_W0 + W0_WOUT + (size_t)(L * 3 + w) * 2 * MiB) : (bf16_t*)(ws + WS_W0 + W0_WO + (size_t)L * 2 * MiB);
            transpose_item(a->in[10 + w] + (size_t)L * D * D, D, 64 * kb, n0, dst + (size_t)n0 * D, D, nullptr, nullptr, lane); continue; }
        r -= 8 * I_SQ;
        if (r < 8 * I_PW) { const int j = r / I_PW; r -= j * I_PW; const int L = j >> 2, g = j & 3;
            const float* src = a->in[8] + (size_t)(L * 4 + g) * 65536 + (size_t)r * 16 * 256; const float* sc = a->in[9] + L * D + g * 256;
            bf16_t* dst = (bf16_t*)(ws + WS_W0 + W0_POOL + (size_t)L * 512 * 1024) + (size_t)g * 65536 + (size_t)r * 16 * 256; const f32x4 s4 = *(const f32x4*)(sc + 4 * lane);
#pragma unroll
            for (int i = 0; i < 16; ++i) { const f32x4 v = *(const f32x4*)(src + i * 256 + 4 * lane) * s4; u32x2 w; w.x = pk_bf16(v[0], v[1]); w.y = pk_bf16(v[2], v[3]); *(u32x2*)(dst + i * 256 + 4 * lane) = w; }
            continue; }
        r -= 8 * I_PW;
        if (r < 2 * I_D1) { const int w = r / I_D1; r -= w * I_D1; const int kb = r / 56, nb = r % 56, n0 = 64 * nb;
            transpose_item(a->in[15 + w], DFF, 64 * kb, n0, (bf16_t*)(ws + WS_W0 + W0_D13) + (size_t)pair_row(n0, w) * D, D, a->in[14], nullptr, lane); continue; }
        r -= 2 * I_D1;
        { const int kb = r / 16, nb = r % 16, n0 = 64 * nb;
            transpose_item(a->in[17], D, 64 * kb, n0, (bf16_t*)(ws + WS_W0 + W0_D2) + (size_t)n0 * DFF, DFF, nullptr, nullptr, lane); }
    }
    const float* x = a->in[0]; bf16_t* xb = (bf16_t*)(ws + WS_XB); f32x4* ss0 = (f32x4*)(ws + WS_SS); unsigned char* x8 = ws + WS_X8;
    for (int m = gw; m < M; m += NGW) {
        const f32x4* xr = (const f32x4*)(x + (size_t)m * D) + lane; u32x2* o = (u32x2*)(xb + (size_t)m * D) + lane; float s = 0.f;
#pragma unroll
        for (int j = 0; j < 4; ++j) { const f32x4 v = xr[64 * j]; s += (v[0] * v[0] + v[1] * v[1]) + (v[2] * v[2] + v[3] * v[3]); u32x2 w; w.x = pk_bf16(v[0], v[1]); w.y = pk_bf16(v[2], v[3]); o[64 * j] = w;
            *((unsigned*)(x8 + (size_t)m * D) + lane + 64 * j) = pk_fp8x4(v); }
        s = wave_sum(s); if (lane == 0) ss0[m] = (f32x4){s, 0.f, 0.f, 0.f};
    }
}

__device__ __forceinline__ void dma_block16(const bf16_t* src, LAS unsigned char* dst, int wid, int lane) {
#pragma unroll
    for (int k = 0; k < 4; ++k) { const int h = wid * 4 + k;
        __builtin_amdgcn_global_load_lds((const unsigned*)((const char*)src + h * 1024 + lane * 16), (LAS unsigned*)(dst + h * 1024), 16, 0, 0); }
}
__device__ __forceinline__ void zero_block16(LAS unsigned char* dst, int tid) {
#pragma unroll
    for (int k = 0; k < 4; ++k) *(LAS u32x4*)(dst + (size_t)(tid + 512 * k) * 16) = (u32x4){0u, 0u, 0u, 0u};
}
template <int I> __device__ __forceinline__ void conv31_pair(const LAS unsigned char* col, const unsigned (&wp)[31], f32x2 bias, f32x2 (&acc)[16]) {
    f32x2 x[46];
#pragma unroll
    for (int i = 0; i < 46; ++i) { const int r = i - 30, j = I + (r >> 4); const unsigned u = *(const LAS unsigned*)(col + ((j + 2) & 3) * 32768 + (r & 15) * 2048); x[i] = (f32x2){bf_lo(u), bf_hi(u)}; }
#pragma unroll
    for (int j = 0; j < 16; ++j) acc[j] = bias;
#pragma unroll
    for (int k = 0; k < 31; ++k) { const f32x2 wk = (f32x2){bf_lo(wp[k]), bf_hi(wp[k])};
#pragma unroll
        for (int j = 0; j < 16; ++j) acc[j] = __builtin_elementwise_fma(wk, x[j + k], acc[j]); }
}
template <int I, int CH> __device__ __forceinline__ void pool_ch(const LAS unsigned char* col, int g, int s0, float (&p)[16]) {
    float x[31], tv[16];
#pragma unroll
    for (int i = 0; i < 31; ++i) { const int r = i - 15, j = I + (r >> 4); const unsigned u = *(const LAS unsigned*)(col + ((j + 1) % 3) * 32768 + (r & 15) * 2048); x[i] = CH ? bf_hi(u) : bf_lo(u); }
#pragma unroll
    for (int j = 0; j < 16; ++j) tv[j] = x[15 + j];
#pragma unroll
    for (int i = 30; i >= 1; --i) x[i] += x[i - 1];
    if (g >= 1) {
#pragma unroll
        for (int i = 30; i >= 2; --i) x[i] += x[i - 2]; }
    if (g >= 2) {
#pragma unroll
        for (int i = 30; i >= 4; --i) x[i] += x[i - 4]; }
    if (g >= 3) {
#pragma unroll
        for (int i = 30; i >= 8; --i) x[i] += x[i - 8]; }
    const int w = 2 << g;
#pragma unroll
    for (int j = 0; j < 16; ++j) { const int cnt = min(s0 + j + 1, w); p[j] = x[15 + j] * (1.0f / (float)cnt) - tv[j]; }
}
struct ConvB { const bf16_t* GLU; __amdgpu_buffer_rsrc_t rVB; LAS unsigned char* lds; LAS float* red; LAS float* stat; f32x2 bb, gg, be; };
template <int I> __device__ __forceinline__ void convB_tile(const ConvB& c, unsigned (&wp)[31], int T0, int tid, int wid, int lane) {
    const int t0 = T0 + 16 * I; const LAS unsigned char* col = c.lds + 4 * tid;
#pragma unroll
    for (int k = 0; k < 31; ++k) asm volatile("" : "+v"(wp[k]));
    if (I < 3) dma_block16(c.GLU + (size_t)(t0 + 16) * D, c.lds + ((I + 3) & 3) * 32768, wid, lane);
    float a0[16], a1[16];
    { f32x2 ap[16]; conv31_pair<I>(col, wp, c.bb, ap);
#pragma unroll
      for (int j = 0; j < 16; ++j) { a0[j] = ap[j].x; a1[j] = ap[j].y; } }
    {
        float v[32];
#pragma unroll
        for (int j = 0; j < 16; ++j) { v[j] = a0[j] + a1[j]; v[16 + j] = a0[j] * a0[j] + a1[j] * a1[j]; }
#pragma unroll
        for (int i = 0; i < 16; ++i) { const bool b = lane & 32; const float send = b ? v[i] : v[i + 16], keep = b ? v[i + 16] : v[i]; v[i] = keep + __shfl_xor(send, 32); }
#pragma unroll
        for (int i = 0; i < 8; ++i) { const bool b = lane & 16; const float send = b ? v[i] : v[i + 8], keep = b ? v[i + 8] : v[i]; v[i] = keep + __shfl_xor(send, 16); }
#pragma unroll
        for (int i = 0; i < 4; ++i) { const bool b = lane & 8; const float send = b ? v[i] : v[i + 4], keep = b ? v[i + 4] : v[i]; v[i] = keep + __shfl_xor(send, 8); }
#pragma unroll
        for (int i = 0; i < 2; ++i) { const bool b = lane & 4; const float send = b ? v[i] : v[i + 2], keep = b ? v[i + 2] : v[i]; v[i] = keep + __shfl_xor(send, 4); }
        { const bool b = lane & 2; const float send = b ? v[0] : v[1], keep = b ? v[1] : v[0]; v[0] = keep + __shfl_xor(send, 2); }
        v[0] += __shfl_xor(v[0], 1);
        const int idx = ((lane >> 5) & 1) * 16 + ((lane >> 4) & 1) * 8 + ((lane >> 3) & 1) * 4 + ((lane >> 2) & 1) * 2 + ((lane >> 1) & 1);
        if (!(lane & 1)) c.red[wid * 32 + idx] = v[0];
    }
    __syncthreads();
    if (tid < 16) { float s = 0.f, q = 0.f;
#pragma unroll
        for (int w = 0; w < 8; ++w) { s += c.red[w * 32 + tid]; q += c.red[w * 32 + 16 + tid]; }
        const float mean = s * (1.0f / D), var = fmaxf(q * (1.0f / D) - mean * mean, 0.f);
        c.stat[2 * tid] = mean; c.stat[2 * tid + 1] = __builtin_amdgcn_rsqf(var + LN_EPS); }
    asm volatile("s_waitcnt vmcnt(0)" ::: "memory");
    __syncthreads();
#pragma unroll
    for (int j = 0; j < 16; ++j) { const float mean = c.stat[2 * j], rstd = c.stat[2 * j + 1];
        const float y0 = (a0[j] - mean) * rstd * c.gg.x + c.be.x, y1 = (a1[j] - mean) * rstd * c.gg.y + c.be.y;
        __builtin_amdgcn_raw_buffer_store_b32(pk_bf16(y0 * sigm(y0), y1 * sigm(y1)), c.rVB, 4 * tid, (t0 + j) * (D * 2), 0); }
}
struct ConvAC { const bf16_t* PU; __amdgpu_buffer_rsrc_t rSCB, rSCX, rYA, rPP; LAS unsigned char* lds; f32x2 s0w, s1w, s2w; };
__device__ __forceinline__ void convAC_load(const ConvAC& c, int t0, int tid, unsigned (&ub)[16], unsigned (&ux)[18]) {
#pragma unroll
    for (int j = 0; j < 16; ++j) ub[j] = __builtin_amdgcn_raw_buffer_load_b32(c.rSCB, 4 * tid, (t0 + j) * (D * 2), 0);
#pragma unroll
    for (int i = 0; i < 18; ++i) ux[i] = __builtin_amdgcn_raw_buffer_load_b32(c.rSCX, 4 * tid, (t0 + 62 + i) * (D * 2), 0);
}
template <int I> __device__ __forceinline__ void convAC_tile(const ConvAC& c, int T0, int tid, int wid, int lane, const unsigned (&ub)[16], const unsigned (&ux)[18], unsigned (&ubn)[16], unsigned (&uxn)[18]) {
    const int t0 = T0 + 16 * I, s0 = t0 & (SEQ - 1); const LAS unsigned char* col = c.lds + 4 * tid;
    if (I < 3) { convAC_load(c, t0 + 16, tid, ubn, uxn); dma_block16(c.PU + (size_t)(t0 + 16) * D, c.lds + ((I + 2) % 3) * 32768, wid, lane); }
    asm volatile("" ::: "memory");
    {
        float x0[18], x1[18];
#pragma unroll
        for (int i = 0; i < 18; ++i) { const unsigned u = (s0 - 2 + i) >= 0 ? ux[i] : 0u; x0[i] = bf_lo(u); x1[i] = bf_hi(u); }
#pragma unroll
        for (int j = 0; j < 16; ++j) {
            const float y0 = bf_lo(ub[j]) * (c.s0w.x * x0[j] + c.s1w.x * x0[j + 1] + c.s2w.x * x0[j + 2]), y1 = bf_hi(ub[j]) * (c.s0w.y * x1[j] + c.s1w.y * x1[j + 1] + c.s2w.y * x1[j + 2]);
            __builtin_amdgcn_raw_buffer_store_b32(pk_bf16(y0, y1), c.rYA, 4 * tid, (t0 + j) * (D * 2), 0); }
    }
    {
        float p0[16], p1[16];
        pool_ch<I, 0>(col, wid >> 1, s0, p0);
#pragma unroll
        for (int j = 0; j < 16; ++j) asm volatile("" : "+v"(p0[j]) :: "memory");
        pool_ch<I, 1>(col, wid >> 1, s0, p1);
#pragma unroll
        for (int j = 0; j < 16; ++j) __builtin_amdgcn_raw_buffer_store_b32(pk_bf16(p0[j], p1[j]), c.rPP, 4 * tid, (t0 + j) * (D * 2), 0);
    }
    if (I < 3) asm volatile("s_waitcnt vmcnt(32)" ::: "memory");
    __syncthreads();
}
__device__ __forceinline__ void conv_phase(KArgs a, int layer, LAS unsigned char* lds, int tid, int wid, int lane) {
    asm volatile("" : "+v"(tid), "+v"(lane));
    unsigned char* ws = a->ws;
    const int G = gridDim.x;
    const int vcu = (G % 8 == 0) ? (int)(blockIdx.x % 8) * (G / 8) + (int)(blockIdx.x / 8) : (int)blockIdx.x;
    const int c2 = 2 * tid;
    {
        const float* cfw = a->in[4] + layer * 31 * D; const float* cfb = a->in[5] + layer * D; const float* lng = a->in[6] + layer * D; const float* lnb = a->in[7] + layer * D;
        ConvB c; c.GLU = (const bf16_t*)(ws + A_GLU); c.rVB = __builtin_amdgcn_make_buffer_rsrc((void*)(ws + A_VB), 0, 0x7fffffff, 0x00020000);
        c.lds = lds; c.red = (LAS float*)(lds + RED_OFF); c.stat = c.red + 256;
        unsigned wp[31];
#pragma unroll
        for (int k = 0; k < 31; ++k) { const f32x2 w = *(const f32x2*)(cfw + k * D + c2); wp[k] = pk_bf16(w.x, w.y); }
        c.bb = *(const f32x2*)(cfb + c2); c.gg = *(const f32x2*)(lng + c2); c.be = *(const f32x2*)(lnb + c2);
        asm volatile("" :: "v"(c.bb.x), "v"(c.bb.y), "v"(c.gg.x), "v"(c.gg.y), "v"(c.be.x), "v"(c.be.y));
        for (int rp2 = 0; rp2 < REPS2(21); ++rp2)
        for (int sup = vcu; sup < M / 64; sup += G) {
            const int T0 = sup * 64; const bool seq0 = (T0 & (SEQ - 1)) == 0;
            if (seq0) { zero_block16(lds, tid); zero_block16(lds + 32768, tid); } else { dma_block16(c.GLU + (size_t)(T0 - 32) * D, lds, wid, lane); dma_block16(c.GLU + (size_t)(T0 - 16) * D, lds + 32768, wid, lane); }
            dma_block16(c.GLU + (size_t)T0 * D, lds + 65536, wid, lane);
            asm volatile("s_waitcnt vmcnt(0)" ::: "memory");
            __syncthreads();
            convB_tile<0>(c, wp, T0, tid, wid, lane); convB_tile<1>(c, wp, T0, tid, wid, lane); convB_tile<2>(c, wp, T0, tid, wid, lane); convB_tile<3>(c, wp, T0, tid, wid, lane);
            __syncthreads();
        }
    }
    __syncthreads();
    {
        const float* scw = a->in[3] + layer * 3 * D;
        ConvAC c; c.PU = (const bf16_t*)(ws + A_PU); c.lds = lds;
        c.rSCB = __builtin_amdgcn_make_buffer_rsrc((void*)(ws + A_SCB), 0, 0x7fffffff, 0x00020000); c.rSCX = __builtin_amdgcn_make_buffer_rsrc((void*)(ws + A_SCX - 64 * D * 2), 0, 0x7fffffff, 0x00020000);
        c.rYA = __builtin_amdgcn_make_buffer_rsrc((void*)(ws + A_YA), 0, 0x7fffffff, 0x00020000); c.rPP = __builtin_amdgcn_make_buffer_rsrc((void*)(ws + A_PP), 0, 0x7fffffff, 0x00020000);
        c.s0w = *(const f32x2*)(scw + c2); c.s1w = *(const f32x2*)(scw + D + c2); c.s2w = *(const f32x2*)(scw + 2 * D + c2);
        asm volatile("" :: "v"(c.s0w.x), "v"(c.s0w.y), "v"(c.s1w.x), "v"(c.s1w.y), "v"(c.s2w.x), "v"(c.s2w.y));
        for (int rp2 = 0; rp2 < REPS2(22); ++rp2)
        for (int sup = vcu; sup < M / 64; sup += G) {
            const int T0 = sup * 64; const bool seq0 = (T0 & (SEQ - 1)) == 0;
            if (seq0) zero_block16(lds, tid); else dma_block16(c.PU + (size_t)(T0 - 16) * D, lds, wid, lane);
            dma_block16(c.PU + (size_t)T0 * D, lds + 32768, wid, lane);
            unsigned ubA[16], uxA[18], ubB[16], uxB[18]; convAC_load(c, T0, tid, ubA, uxA);
            asm volatile("s_waitcnt vmcnt(0)" ::: "memory");
            __syncthreads();
            convAC_tile<0>(c, T0, tid, wid, lane, ubA, uxA, ubB, uxB); convAC_tile<1>(c, T0, tid, wid, lane, ubB, uxB, ubA, uxA); convAC_tile<2>(c, T0, tid, wid, lane, ubA, uxA, ubB, uxB); convAC_tile<3>(c, T0, tid, wid, lane, ubB, uxB, ubA, uxA);
        }
    }
}

__device__ __forceinline__ void route_phase(KArgs a, LAS unsigned char* lds, int tid, int wid, int lane) {
    asm volatile("" : "+v"(tid), "+v"(lane));
    unsigned char* ws = a->ws;
    const bf16_t* X = (const bf16_t*)(ws + WS_XB); const float* gn = a->in[14] + D; const float* R = a->in[18];
    const f32x4* ss3 = (const f32x4*)(ws + WS_SS) + 3 * M;
    int* tope = (int*)(ws + WS_SMALL + SM_TOPE); f32x2* topp = (f32x2*)(ws + WS_SMALL + SM_TOPP); int* cntb = (int*)(ws + WS_CTL + CTL_CNT);
    LAS int* lcnt = (LAS int*)(lds + 98304);
    float wgt[2][8][8];
#pragma unroll
    for (int h = 0; h < 2; ++h)
#pragma unroll
        for (int i = 0; i < 8; ++i) { const int k = 8 * lane + 512 * h + i; const float g = gn[k]; const f32x4 r0 = *(const f32x4*)(R + k * 8), r1 = *(const f32x4*)(R + k * 8 + 4);
#pragma unroll
            for (int e = 0; e < 4; ++e) { wgt[h][i][e] = g * r0[e]; wgt[h][i][4 + e] = g * r1[e]; } }
    for (int vb = blockIdx.x; vb < 256; vb += gridDim.x) {
        if (tid < 8) lcnt[tid] = 0;
        __syncthreads();
        for (int i8 = 0; i8 < 8; ++i8) {
            const int t = vb * 64 + wid * 8 + i8;
            float lg[8];
#pragma unroll
            for (int e = 0; e < 8; ++e) lg[e] = 0.f;
#pragma unroll
            for (int h = 0; h < 2; ++h) { f32x4 v0, v1; pg8::unpack8(*(const u32x4*)(X + (size_t)t * D + 512 * h + 8 * lane), v0, v1);
#pragma unroll
                for (int i = 0; i < 4; ++i)
#pragma unroll
                    for (int e = 0; e < 8; ++e) { lg[e] = fmaf(v0[i], wgt[h][i][e], lg[e]); lg[e] = fmaf(v1[i], wgt[h][4 + i][e], lg[e]); } }
#pragma unroll
            for (int e = 0; e < 8; ++e) lg[e] = wave_sum(lg[e]);
            const f32x4 sp = ss3[t]; const float rstd = __builtin_amdgcn_rsqf(((sp[0] + sp[1]) + (sp[2] + sp[3])) * (1.0f / D) + RMS_EPS);
            int e1 = 0; float v1 = lg[0];
#pragma unroll
            for (int e = 1; e < 8; ++e) if (lg[e] > v1) { v1 = lg[e]; e1 = e; }
            int e2 = e1 == 0 ? 1 : 0; float v2 = -__builtin_inff();
#pragma unroll
            for (int e = 0; e < 8; ++e) if (e != e1 && lg[e] > v2) { v2 = lg[e]; e2 = e; }
            const float ex = __expf((v2 - v1) * rstd), p1 = 1.0f / (1.0f + ex), p2 = ex * p1;
            if (lane == 0) { tope[t] = e1 | (e2 << 8); topp[t] = (f32x2){p1, p2}; atomicAdd((int*)&lcnt[e1], 1); atomicAdd((int*)&lcnt[e2], 1); }
        }
        __syncthreads();
        if (tid < 8) cntb[vb * 8 + tid] = lcnt[tid];
        __syncthreads();
    }
    const int gw = blockIdx.x * 8 + wid, NGW = gridDim.x * 8;
    constexpr int I_1 = 16 * 56, I_13 = 2 * I_1, I_2 = 56 * 16;
    unsigned char* w13 = ws + WS_WMOE; unsigned char* w2t = ws + WS_WMOE + WMOE_W2;
    for (int it = gw; it < NE * (I_13 + I_2); it += NGW) {
        int r = it;
        if (r < NE * I_13) { const int e = r / I_13; r -= e * I_13; const int w = r / I_1; r -= w * I_1; const int kb = r / 56, nb = r % 56, n0 = 64 * nb;
            transpose_item_f8(a->in[19 + w] + (size_t)e * D * DFF, DFF, 64 * kb, n0, w13 + (size_t)e * (2 * DFF) * D + (size_t)pair_row(n0, w) * D, D, gn, F8_W13_MUL, lane); continue; }
        r -= NE * I_13;
        { const int e = r / I_2; r -= e * I_2; const int kb = r / 16, nb = r % 16, n0 = 64 * nb;
            transpose_item_f8(a->in[21] + (size_t)e * DFF * D, D, 64 * kb, n0, w2t + (size_t)e * D * DFF + (size_t)n0 * DFF, DFF, nullptr, F8_W2_MUL, lane); }
    }
}

__device__ __forceinline__ void scatter_phase(KArgs a, LAS unsigned char* lds, int tid, int wid, int lane) {
    asm volatile("" : "+v"(tid), "+v"(lane));
    unsigned char* ws = a->ws;
    const int* tope = (const int*)(ws + WS_SMALL + SM_TOPE); int* tslot = (int*)(ws + WS_SMALL + SM_TSLOT); float* ssperm = (float*)(ws + WS_SMALL + SM_SSPERM); int* meta = (int*)(ws + WS_SMALL + SM_META);
    const int* cntb = (const int*)(ws + WS_CTL + CTL_CNT); const f32x4* ss3 = (const f32x4*)(ws + WS_SS) + 3 * M;
    const bf16_t* X = (const bf16_t*)(ws + WS_XB); unsigned char* AP = ws + WS_APERM;
    LAS int* lc = (LAS int*)lds;
    LAS int* lbase = lc + 2048;
    LAS int* lslot = lc + 2064;
    LAS int* ltot = lc + 2200;
    for (int i = tid; i < 2048; i += 512) lc[i] = __hip_atomic_load(cntb + i, __ATOMIC_RELAXED, __HIP_MEMORY_SCOPE_AGENT);
    __syncthreads();
    for (int vb = blockIdx.x; vb < 256; vb += gridDim.x) {
        if (tid < 8) { int tot = 0, pre = 0;
#pragma unroll 8
            for (int b = 0; b < 256; ++b) { const int v = lc[b * 8 + tid]; tot += v; pre += (b < vb) ? v : 0; }
            ltot[tid] = tot; lbase[tid] = pre; }
        __syncthreads();
        if (tid == 0) { int off = 0;
            for (int e = 0; e < 8; ++e) { lbase[e] += off; if (vb == 0) meta[e] = off >> 8; off += (ltot[e] + 255) & ~255; }
            if (vb == 0) meta[8] = off >> 8; }
        __syncthreads();
        if (wid == 0) {
            const int t = vb * 64 + lane; const int te = tope[t]; const int e1 = te & 0xff, e2 = (te >> 8) & 0xff;
            int s1 = 0, s2 = 0;
#pragma unroll
            for (int k = 0; k < 2; ++k) { const int ek = k ? e2 : e1; int sk = 0;
#pragma unroll
                for (int e = 0; e < 8; ++e) { const unsigned long long mask = __ballot(ek == e); const int base = lbase[e]; LDS_WAIT();
                    const int rank = __popcll(mask & ((1ull << lane) - 1ull)); if (ek == e) sk = base + rank;
                    if (lane == 0) lbase[e] = base + __popcll(mask); LDS_WAIT(); }
                if (k) s2 = sk; else s1 = sk; }
            *(int2*)(tslot + 2 * t) = make_int2(s1, s2); lslot[lane] = s1; lslot[64 + lane] = s2;
        }
        __syncthreads();
        for (int rb = 0; rb < 2; ++rb) {
            u32x4 xv[8][2]; f32x4 sp[8];
#pragma unroll
            for (int i = 0; i < 8; ++i) { const int r = wid + 8 * (rb * 8 + i), t = vb * 64 + (r & 63); const u32x4* src = (const u32x4*)(X + (size_t)t * D) + 2 * lane; xv[i][0] = src[0]; xv[i][1] = src[1]; sp[i] = ss3[t]; }
#pragma unroll
            for (int i = 0; i < 8; ++i) { const int r = wid + 8 * (rb * 8 + i), slot = lslot[r];
                const float rstd = __builtin_amdgcn_rsqf(((sp[i][0] + sp[i][1]) + (sp[i][2] + sp[i][3])) * (1.0f / D) + RMS_EPS);
                f32x4 v0, v1, v2, v3; pg8::unpack8(xv[i][0], v0, v1); pg8::unpack8(xv[i][1], v2, v3);
                *((u32x4*)(AP + (size_t)slot * D) + lane) = (u32x4){pk_fp8x4(v0 * rstd), pk_fp8x4(v1 * rstd), pk_fp8x4(v2 * rstd), pk_fp8x4(v3 * rstd)}; } }
        __syncthreads();
    }
}

__device__ __forceinline__ void combine_phase(KArgs a, LAS unsigned char* lds, int tid, int wid, int lane) {
    asm volatile("" : "+v"(lane), "+v"(tid));
    unsigned char* ws = a->ws;
    LAS int* tmap = (LAS int*)lds; const bf16_t* YP = (const bf16_t*)(ws + WS_YP);
    int split;
    { const int nMraw = __builtin_amdgcn_readfirstlane(__hip_atomic_load((const int*)(ws + WS_SMALL + SM_META) + 8, __ATOMIC_RELAXED, __HIP_MEMORY_SCOPE_AGENT)); const int nM = nMraw > MAXSLOT / 256 ? MAXSLOT / 256 : nMraw;
      const int G = (int)gridDim.x, nU = 4 * nM, R = nU / G, tail = nU - R * G; split = (tail > 0 && pg8::MOE2_SPL * tail <= G) ? 1 : 0;
      for (int i = tid; i < 4 * (MAXSLOT / 256); i += 512) tmap[i] = -1;
      __syncthreads();
      if (split && tid < tail) { int pm, pn; if (pg8::tile_of(R * G + tid, nM, 4, pm, pn, 4)) tmap[4 * pm + pn] = tid; }
      __syncthreads(); }
    const bf16_t* X = (const bf16_t*)(ws + WS_XB); const bf16_t* Y = (const bf16_t*)(ws + WS_Y); const int* tslot = (const int*)(ws + WS_SMALL + SM_TSLOT); const f32x2* topp = (const f32x2*)(ws + WS_SMALL + SM_TOPP);
    const float* gf = a->in[22]; float* out = a->out;
    const int gw = blockIdx.x * 8 + wid, NGW = gridDim.x * 8;
    f32x4 gv[4];
#pragma unroll
    for (int h = 0; h < 2; ++h) { gv[2 * h] = *(const f32x4*)(gf + 512 * h + 8 * lane); gv[2 * h + 1] = *(const f32x4*)(gf + 512 * h + 8 * lane + 4); }
    for (int tb = gw; tb < M; tb += 4 * NGW) {
        int2 sl[4]; f32x2 p[4];
#pragma unroll
        for (int i = 0; i < 4; ++i) { const int t = min(tb + i * NGW, M - 1); sl[i] = *(const int2*)(tslot + 2 * t); p[i] = topp[t]; }
        u32x4 xr[4][2], ya[4][2], yb[4][2];
#pragma unroll
        for (int i = 0; i < 4; ++i) { const int t = min(tb + i * NGW, M - 1);
#pragma unroll
            for (int h = 0; h < 2; ++h) { const int col = 512 * h + 8 * lane;
                xr[i][h] = *(const u32x4*)(X + (size_t)t * D + col); ya[i][h] = *(const u32x4*)(Y + (size_t)sl[i].x * D + col); yb[i][h] = *(const u32x4*)(Y + (size_t)sl[i].y * D + col); } }
#pragma unroll
        for (int i = 0; i < 4; ++i) { const int t = tb + i * NGW; if (t < M) {
            f32x4 v[4]; float s = 0.f;
#pragma unroll
            for (int h = 0; h < 2; ++h) { f32x4 x0, x1, a0, a1, b0, b1; pg8::unpack8(xr[i][h], x0, x1); pg8::unpack8(ya[i][h], a0, a1); pg8::unpack8(yb[i][h], b0, b1);
                if (split) { const int pn = 2 * h + (lane >> 5), cl = 8 * (lane & 31);
                    const int ka = tmap[4 * (sl[i].x >> 8) + pn], kb = tmap[4 * (sl[i].y >> 8) + pn];
                    if (ka >= 0) { a0 = (f32x4){0.f, 0.f, 0.f, 0.f}; a1 = a0;
                        for (int p = 0; p < pg8::MOE2_SPL; ++p) { f32x4 t0, t1; pg8::unpack8(*(const u32x4*)(YP + (size_t)(ka * pg8::MOE2_SPL + p) * 65536 + (size_t)(sl[i].x & 255) * 256 + cl), t0, t1); a0 += t0; a1 += t1; } }
                    if (kb >= 0) { b0 = (f32x4){0.f, 0.f, 0.f, 0.f}; b1 = b0;
                        for (int p = 0; p < pg8::MOE2_SPL; ++p) { f32x4 t0, t1; pg8::unpack8(*(const u32x4*)(YP + (size_t)(kb * pg8::MOE2_SPL + p) * 65536 + (size_t)(sl[i].y & 255) * 256 + cl), t0, t1); b0 += t0; b1 += t1; } } }
                v[2 * h] = x0 + a0 * p[i].x + b0 * p[i].y; v[2 * h + 1] = x1 + a1 * p[i].x + b1 * p[i].y; }
#pragma unroll
            for (int k = 0; k < 4; ++k) s += (v[k][0] * v[k][0] + v[k][1] * v[k][1]) + (v[k][2] * v[k][2] + v[k][3] * v[k][3]);
            const float rstd = __builtin_amdgcn_rsqf(wave_sum(s) * (1.0f / D) + RMS_EPS);
#pragma unroll
            for (int h = 0; h < 2; ++h) { const int col = 512 * h + 8 * lane;
                *(f32x4*)(out + (size_t)t * D + col) = v[2 * h] * rstd * gv[2 * h]; *(f32x4*)(out + (size_t)t * D + col + 4) = v[2 * h + 1] * rstd * gv[2 * h + 1]; } } }
    }
}

#ifndef WGM_INPROJ
#define WGM_INPROJ 4
#endif
#ifndef WGM_FFN1
#define WGM_FFN1 4
#endif
#ifndef WGM_MOE1
#define WGM_MOE1 4
#endif
constexpr int NPH = 18;
#ifndef MK_PH_MASK
#define MK_PH_MASK 0xFFFFFFFFu
#endif
#define PHON(bit) ((((MK_PH_MASK) >> (bit)) & 1u) != 0u)


__device__ __forceinline__ void ph_inproj(KArgs a, int layer, LAS unsigned char* lds) {
    unsigned char* ws = a->ws;
    {
        pg8::Gemm g{2 * D, 2 * D, 2 * D, 0, 0}; pg8::PlainSched S{M / 256, 24, (int)gridDim.x, (int)blockIdx.x, (const char*)(ws + WS_XB), (const char*)(ws + WS_W0 + W0_WIN + (size_t)layer * 18 * MiB), (size_t)256 * D * 2, (size_t)256 * D * 2, WGM_INPROJ};
        pg8::EpiProj E{(bf16_t*)(ws + A_SCB), (bf16_t*)(ws + A_SCX), (bf16_t*)(ws + A_GLU), (bf16_t*)(ws + A_PU), (bf16_t*)(ws + A_GATES), (const f32x4*)(ws + WS_SS) + (size_t)(layer * 2) * M, 0};
        pg8::gemm_phase(lds, g, S, E);
    }
    __syncthreads();
    {
        pg8::Gemm g{D, D, D, F8_ONE, F8_W13_SC}; pg8::PlainSched S{M / 256, 12, (int)gridDim.x, (int)blockIdx.x, (const char*)(ws + WS_X8), (const char*)(ws + WS_WG8 + (size_t)layer * 3 * MiB), (size_t)256 * D, (size_t)256 * D, WGM_INPROJ};
        pg8::EpiProj E{(bf16_t*)(ws + A_SCB), (bf16_t*)(ws + A_SCX), (bf16_t*)(ws + A_GLU), (bf16_t*)(ws + A_PU), (bf16_t*)(ws + A_GATES), (const f32x4*)(ws + WS_SS) + (size_t)(layer * 2) * M, 24};
        pg8::gemm_phase<pg8::EpiProj, pg8::PlainSched, true>(lds, g, S, E);
    }
}
__device__ __forceinline__ void ph_fold(KArgs a, LAS unsigned char* lds) {
    unsigned char* ws = a->ws;
    pg8::Gemm g{512, 2 * D, 512, 0, 0}; pg8::FoldSched S{(int)gridDim.x, (int)blockIdx.x, (const char*)(ws + WS_W0 + W0_WOUT + 2 * 2 * MiB), (const char*)(ws + WS_W0 + W0_POOL)};
    pg8::EpiPlain E{(bf16_t*)(ws + WS_WC), D, (size_t)D * D};
    pg8::gemm_phase(lds, g, S, E);
}
__device__ __forceinline__ void ph_merge(KArgs a, int layer, LAS unsigned char* lds) {
    unsigned char* ws = a->ws;
    pg8::Gemm g{2 * D, 2 * D, 2 * D, 0, 0}; pg8::MergeSched S{(int)gridDim.x, (int)blockIdx.x, (const char*)(ws + A_YA), (const char*)(ws + WS_W0 + W0_WOUT + (size_t)(layer * 3) * 2 * MiB), (const char*)(ws + WS_WC + (size_t)layer * 2 * MiB), (size_t)32 * MiB, (size_t)2 * MiB};
    pg8::EpiMerge E{(const bf16_t*)(ws + A_GATES), (bf16_t*)(ws + A_MERGED)};
    pg8::gemm_phase(lds, g, S, E);
}
__device__ __forceinline__ void ph_wo(KArgs a, int layer, LAS unsigned char* lds) {
    unsigned char* ws = a->ws;
    pg8::Gemm g{2 * D, 2 * D, 2 * D, 0, 0}; pg8::PlainSched S{M / 256, D / 256, (int)gridDim.x, (int)blockIdx.x, (const char*)(ws + A_MERGED), (const char*)(ws + WS_W0 + W0_WO + (size_t)layer * 2 * MiB), (size_t)256 * D * 2, (size_t)256 * D * 2, 4};
    pg8::EpiResid E{layer == 0 ? a->in[0] : (const float*)nullptr, (bf16_t*)(ws + WS_XB), (float*)(ws + WS_SS) + (size_t)(layer * 2 + 1) * M * 4, (LAS float*)(lds + RED_OFF), nullptr};
    pg8::gemm_phase(lds, g, S, E);
}
__device__ __forceinline__ void ph_ffn1(KArgs a, LAS unsigned char* lds) {
    unsigned char* ws = a->ws;
    pg8::Gemm g{2 * D, 2 * D, 2 * D, 0, 0}; pg8::PlainSched S{M / 256, 2 * DFF / 256, (int)gridDim.x, (int)blockIdx.x, (const char*)(ws + WS_XB), (const char*)(ws + WS_W0 + W0_D13), (size_t)256 * D * 2, (size_t)256 * D * 2, WGM_FFN1};
    pg8::EpiSwiGLU<true, false> E{(bf16_t*)(ws + A_FFN), DFF, (const float*)(ws + WS_SS) + (size_t)1 * M * 4};
    pg8::gemm_phase(lds, g, S, E);
}
__device__ __forceinline__ void ph_ffn2(KArgs a, LAS unsigned char* lds) {
    unsigned char* ws = a->ws;
    pg8::Gemm g{2 * DFF, 2 * DFF, 2 * DFF, 0, 0}; pg8::PlainSched S{M / 256, D / 256, (int)gridDim.x, (int)blockIdx.x, (const char*)(ws + A_FFN), (const char*)(ws + WS_W0 + W0_D2), (size_t)256 * DFF * 2, (size_t)256 * DFF * 2, 4};
    pg8::EpiResid E{(const float*)nullptr, (bf16_t*)(ws + WS_XB), (float*)(ws + WS_SS) + (size_t)2 * M * 4, (LAS float*)(lds + RED_OFF), ws + WS_X8};
    pg8::gemm_phase(lds, g, S, E);
}
__device__ __forceinline__ void ph_moe(KArgs a, int which, LAS unsigned char* lds) {
    unsigned char* ws = a->ws;
    const int* meta = (const int*)(ws + WS_SMALL + SM_META); int o[9];
#pragma unroll
    for (int e = 0; e < 9; ++e) o[e] = __builtin_amdgcn_readfirstlane(__hip_atomic_load(meta + e, __ATOMIC_RELAXED, __HIP_MEMORY_SCOPE_AGENT));
    const int nM = o[8] > MAXSLOT / 256 ? MAXSLOT / 256 : o[8];
    if (which == 0) {
        pg8::Gemm g{D, D, D, F8_ONE, F8_W13_SC}; pg8::GroupSched S{nM, 2 * DFF / 256, (int)gridDim.x, (int)blockIdx.x, o[1], o[2], o[3], o[4], o[5], o[6], o[7], (const char*)(ws + WS_APERM), (const char*)(ws + WS_WMOE), (size_t)256 * D, (size_t)256 * D, (size_t)2 * DFF * D, WGM_MOE1};
        pg8::EpiSwiGLU<false, true> E{(bf16_t*)(ws + WS_ACTP), DFF, nullptr};
        pg8::gemm_phase<pg8::EpiSwiGLU<false, true>, pg8::GroupSched, true>(lds, g, S, E);
    } else {
        const int G = (int)gridDim.x, nU = 4 * nM, R = nU / G, tail = nU - R * G, split = (tail > 0 && pg8::MOE2_SPL * tail <= G) ? 1 : 0;
        pg8::Gemm g{DFF, DFF, DFF, F8_ACT_SC, F8_W2_SC}; pg8::Moe2Sched S{nM, G, (int)blockIdx.x, R, tail, split, o[1], o[2], o[3], o[4], o[5], o[6], o[7], (const char*)(ws + WS_ACTP), (const char*)(ws + WS_WMOE + WMOE_W2), (size_t)256 * DFF, (size_t)256 * DFF, (size_t)D * DFF};
        pg8::EpiMoe2 E{(bf16_t*)(ws + WS_Y), (bf16_t*)(ws + WS_YP)};
        pg8::gemm_phase<pg8::EpiMoe2, pg8::Moe2Sched, true>(lds, g, S, E);
    }
}

__global__ void __launch_bounds__(512, 2) fwd(Args unused_args_read_through_kargs) {
    extern __shared__ __attribute__((aligned(16))) unsigned char lds_raw[];
    LAS unsigned char* lds = (LAS unsigned char*)lds_raw;
    volatile LAS unsigned* MISC = (volatile LAS unsigned*)(lds + MISC_OFF);
    const int tid = threadIdx.x, lane = tid & 63, wid = __builtin_amdgcn_readfirstlane(tid >> 6);
    if (tid < 64) MISC[tid] = 0u;
    __syncthreads();
    int lo, hi; XcdBarrier bar;
    { KArgs a = kargs(); lo = a->ph_lo; hi = a->ph_hi; unsigned* bw = (unsigned*)(a->ws + WS_CTL + CTL_BAR); bar.bar = bw; bar.x = 0; bar.st = nullptr; if (hi - lo > 1) bar = xcd_barrier_post(bw, MISC + 8); }
#define IN(k) (lo <= (k) && (k) < hi)
#define SEAM(k) do { if (IN(k) && IN((k) + 1)) xcd_barrier(bar); } while (0)

    if (PHON(0) && IN(0)) { for (int rp = 0; rp < REPS(0); ++rp) { prologue_phase(kargs(), lds, wid, lane); __syncthreads(); } } SEAM(0);
#pragma nounroll
    for (int layer = 0; layer < 2; ++layer) {
        const int pb = 1 + 7 * layer;
        if (PHON(1) && IN(pb + 0)) { for (int rp = 0; rp < REPS(1); ++rp) { if (layer == 0) { ph_fold(kargs(), lds); __syncthreads(); } ph_inproj(kargs(), layer, lds); __syncthreads(); } } SEAM(pb + 0);
        if (PHON(2) && IN(pb + 1)) { for (int rp = 0; rp < REPS(2); ++rp) { conv_phase(kargs(), layer, lds, tid, wid, lane); __syncthreads(); } } SEAM(pb + 1);
        if (PHON(4) && IN(pb + 3)) { for (int rp = 0; rp < REPS(4); ++rp) { ph_merge(kargs(), layer, lds); __syncthreads(); } } SEAM(pb + 3);
        if (PHON(5) && IN(pb + 4)) { for (int rp = 0; rp < (layer == 0 ? REPS(5) : 1); ++rp) { ph_wo(kargs(), layer, lds); __syncthreads(); } } SEAM(pb + 4);
        if (layer == 0) {
            if (PHON(6) && IN(6)) { for (int rp = 0; rp < REPS(6); ++rp) { ph_ffn1(kargs(), lds); __syncthreads(); } } SEAM(6);
            if (PHON(7) && IN(7)) { ph_ffn2(kargs(), lds); } SEAM(7);
        }
    }
    if (PHON(13) && IN(13)) { for (int rp = 0; rp < REPS(13); ++rp) { route_phase(kargs(), lds, tid, wid, lane); __syncthreads(); } } SEAM(13);
    if (PHON(14) && IN(14)) { for (int rp = 0; rp < REPS(14); ++rp) { scatter_phase(kargs(), lds, tid, wid, lane); __syncthreads(); } } SEAM(14);
    if (PHON(15) && IN(15)) { for (int rp = 0; rp < REPS(15); ++rp) { ph_moe(kargs(), 0, lds); __syncthreads(); } } SEAM(15);
    if (PHON(16) && IN(16)) { for (int rp = 0; rp < REPS(16); ++rp) { ph_moe(kargs(), 1, lds); __syncthreads(); } } SEAM(16);
    if (PHON(17) && IN(17)) { for (int rp = 0; rp < REPS(17); ++rp) { combine_phase(kargs(), lds, tid, wid, lane); __syncthreads(); } }
#undef IN
#undef SEAM
}

extern "C" void kernel_launch(void* const* d_in, const int* in_sizes, int n_in, void* d_out, int out_size, void* d_ws, size_t ws_size, hipStream_t stream) {
    static int grid = 0;
    if (grid == 0) {
        if (n_in != 23 || in_sizes[0] != M * D || out_size != M * D || ws_size < WS_END) { fprintf(stderr, "kernel_launch: unexpected shapes: n_in %d in0 %d out %d ws %zu (need %zu); nothing launched\n", n_in, n_in > 0 ? in_sizes[0] : -1, out_size, ws_size, (size_t)WS_END); grid = -1; return; }
        int dev = 0, cus = 0, per_cu = 0;
        if (hipGetDevice(&dev) != hipSuccess || hipDeviceGetAttribute(&cus, hipDeviceAttributeMultiprocessorCount, dev) != hipSuccess) { fprintf(stderr, "kernel_launch: device query failed\n"); grid = -1; return; }
        if (hipFuncSetAttribute((const void*)fwd, hipFuncAttributeMaxDynamicSharedMemorySize, LDS_BYTES) != hipSuccess) { fprintf(stderr, "kernel_launch: hipFuncSetAttribute failed\n"); grid = -1; return; }
        if (hipOccupancyMaxActiveBlocksPerMultiprocessor(&per_cu, (const void*)fwd, 512, LDS_BYTES) != hipSuccess || per_cu < 1) fprintf(stderr, "kernel_launch: note: occupancy query reports %d workgroups per CU\n", per_cu);
        (void)hipGetLastError();
        grid = cus;
    }
    if (grid < 0) return;
    if (hipMemsetAsync((char*)d_ws + WS_CTL, 0, CTL_BYTES, stream) != hipSuccess) { fprintf(stderr, "kernel_launch: memset failed\n"); return; }
    Args a{};
    for (int i = 0; i < 23; ++i) a.in[i] = (const float*)d_in[i];
    a.out = (float*)d_out; a.ws = (unsigned char*)d_ws;
#if MK_PER_PHASE
    for (int ph = 0; ph < NPH; ++ph) { a.ph_lo = ph; a.ph_hi = ph + 1; hipLaunchKernelGGL(fwd, dim3(grid), dim3(512), LDS_BYTES, stream, a); }
#else
    a.ph_lo = 0; a.ph_hi = NPH; hipLaunchKernelGGL(fwd, dim3(grid), dim3(512), LDS_BYTES, stream, a);
#endif
    const hipError_t le = hipPeekAtLastError();
    if (le != hipSuccess) fprintf(stderr, "kernel_launch: launch failed: %s\n", hipGetErrorName(le));
}
```

```cpp
#include <hip/hip_runtime.h>
#include <cstdio>
#include <cstdint>

#ifndef MK_PER_PHASE
#define MK_PER_PHASE 0
#endif

#ifndef MK_REP_MASK
#define MK_REP_MASK 0u
#endif
#define REPS(bit) (1 + (int)(((MK_REP_MASK) >> (bit)) & 1u))
#define REPS2(bit) REPS(bit)

#define LAS __attribute__((address_space(3)))
typedef unsigned short bf16_t;
typedef short bf16x8 __attribute__((ext_vector_type(8)));
typedef float f32x4 __attribute__((ext_vector_type(4)));
typedef float f32x2 __attribute__((ext_vector_type(2)));
typedef unsigned u32x4 __attribute__((ext_vector_type(4)));
typedef unsigned u32x2 __attribute__((ext_vector_type(2)));

constexpr int M = 16384, D = 1024, SEQ = 8192, INC = 9216, DFF = 3584, NE = 8;
constexpr float RMS_EPS = 1e-6f, LN_EPS = 1e-5f;
constexpr int MAXSLOT = 34816;
constexpr float F8_W13_MUL = 128.f, F8_ACT_MUL = 4.f, F8_W2_MUL = 256.f;
constexpr int F8_ONE = 0x7f7f7f7f, F8_W13_SC = 0x78787878  , F8_ACT_SC = 0x7d7d7d7d  , F8_W2_SC = 0x77777777  ;

constexpr size_t MiB = 1u << 20;
constexpr size_t WS_CTL = 0, CTL_BYTES = 64 * 1024;
constexpr size_t CTL_BAR = 16384;
constexpr size_t CTL_CNT = 32768;
constexpr size_t WS_SMALL = 1 * MiB;
constexpr size_t SM_TOPE = 0, SM_TOPP = 64 * 1024, SM_TSLOT = 192 * 1024, SM_SSPERM = 320 * 1024, SM_META = 512 * 1024;
constexpr size_t WS_X8 = 2 * MiB;
constexpr size_t WS_YP = 18 * MiB;
constexpr size_t WS_WG8 = 492 * MiB;
constexpr size_t WS_XB = 66 * MiB;
constexpr size_t WS_W0 = 98 * MiB;
constexpr size_t W0_WIN = 0;
constexpr size_t W0_WOUT = 36 * MiB;
constexpr size_t W0_WO = 48 * MiB;
constexpr size_t W0_POOL = 52 * MiB;
constexpr size_t W0_D13 = 53 * MiB;
constexpr size_t W0_D2 = 67 * MiB;
constexpr size_t WS_ACT = 172 * MiB;
constexpr size_t A_SCB = WS_ACT, A_SCX = WS_ACT + 32 * MiB, A_GLU = WS_ACT + 64 * MiB, A_PU = WS_ACT + 96 * MiB, A_GATES = WS_ACT + 128 * MiB,
                 A_YA = WS_ACT + 224 * MiB, A_VB = WS_ACT + 256 * MiB, A_PP = WS_ACT + 288 * MiB, A_MERGED = A_SCX, A_FFN = WS_ACT;
constexpr size_t WS_WC = 524 * MiB;
constexpr size_t WS_ACTP = 98 * MiB;
constexpr size_t WS_WMOE = 304 * MiB, WMOE_W2 = 56 * MiB;
constexpr size_t WS_Y = 400 * MiB;
constexpr size_t WS_APERM = 472 * MiB;
constexpr size_t WS_SS = 540 * MiB;
constexpr size_t WS_END = 541 * MiB;

typedef __bf16 bf16x2_t __attribute__((ext_vector_type(2)));
__device__ __forceinline__ unsigned pk_bf16(float lo, float hi) { const bf16x2_t v = {(__bf16)lo, (__bf16)hi}; return __builtin_bit_cast(unsigned, v); }
__device__ __forceinline__ unsigned pk_fp8x4(const f32x4 v) {
    const float a = __builtin_amdgcn_fmed3f(v[0], -448.f, 448.f), b = __builtin_amdgcn_fmed3f(v[1], -448.f, 448.f), c = __builtin_amdgcn_fmed3f(v[2], -448.f, 448.f), d = __builtin_amdgcn_fmed3f(v[3], -448.f, 448.f);
    int w = 0; w = __builtin_amdgcn_cvt_pk_fp8_f32(a, b, w, false); w = __builtin_amdgcn_cvt_pk_fp8_f32(c, d, w, true); return (unsigned)w; }
__device__ __forceinline__ float bf_lo(unsigned u) { return __uint_as_float(u << 16); }
__device__ __forceinline__ float bf_hi(unsigned u) { return __uint_as_float(u & 0xffff0000u); }
__device__ __forceinline__ float sigm(float x) { return __builtin_amdgcn_rcpf(1.f + __builtin_amdgcn_exp2f(-1.44269504f * x)); }
__device__ __forceinline__ float wave_sum(float v) {
#pragma unroll
    for (int o = 1; o < 64; o <<= 1) v += __shfl_xor(v, o);
    return v;
}
#define LDS_WAIT() asm volatile("s_waitcnt lgkmcnt(0)" ::: "memory")

namespace pg8 {
constexpr int BM = 256, BK = 64, HALF = 128, HTB = HALF * BK * 2, STAGE_BYTES = 8 * HTB, NXCD = 8;
__host__ __device__ __forceinline__ int lds_byte(int r, int c) { const int st = (r >> 4) * 2 + (c >> 5), rr = r & 15, cc = c & 31, ob = rr * 64 + cc * 2; return st * 1024 + (ob ^ (((ob >> 9) & 1) << 5)); }
__host__ __device__ __forceinline__ void stage_rc(int b, int& R, int& C) { const int st = b / 1024, sb = b % 1024, swz = sb ^ (((sb >> 9) & 1) << 5); R = (st >> 1) * 16 + swz / 64; C = (st & 1) * 32 + (swz % 64) / 2; }
__host__ __device__ __forceinline__ int perm32(int rho) { const int n = rho >> 4, i = rho & 15; return 8 * (i >> 2) + 4 * n + (i & 3); }

struct Unit { int pm, pn, aux, nt; const char* A; const char* B; };
struct Gemm { int Kb, lda, ldb; int sa, sb; };

__device__ __forceinline__ bool tile_of(int L, int nM, int nN, int& pm, int& pn, int WGM = 4) {
    const int nwg = nM * nN; if (L >= nwg) return false;
    int wgid = L; { const int q = nwg / NXCD, r = nwg % NXCD, xcd = wgid % NXCD, off = wgid / NXCD; wgid = (xcd < r ? xcd * (q + 1) : r * (q + 1) + (xcd - r) * q) + off; }
    const int nig = WGM * nN, gid = wgid / nig, fm = gid * WGM, gsz = (nM - fm) < WGM ? (nM - fm) : WGM;
    pm = fm + ((wgid % nig) % gsz); pn = (wgid % nig) / gsz; return true;
}
struct PlainSched {
    int nM, nN, G, c; const char* A0; const char* B0; size_t astep, bstep; int wgm; int bsplit, badd;
    __device__ __forceinline__ bool next(int i, Unit& u) const { int pm, pn; if (!tile_of(i * G + c, nM, nN, pm, pn, wgm)) return false; u.pm = pm; u.pn = pn; u.aux = 0; u.nt = 0; u.A = A0 + (size_t)pm * astep; u.B = B0 + (size_t)(pn + (pn >= bsplit ? badd : 0)) * bstep; return true; }
};
struct PoolSched {
    int G, c; const char* A0; const char* B0;
    __device__ __forceinline__ bool next(int i, Unit& u) const { int pm, pn; if (!tile_of(i * G + c, M / 256, 4, pm, pn)) return false; u.pm = pm; u.pn = pn; u.aux = 0; u.nt = 0;
        u.A = A0 + (size_t)pm * (256 * 1024 * 2) + (size_t)pn * 512; u.B = B0 + (size_t)pn * (256 * 256 * 2); return true; }
};
struct MergeSched {
    int G, c; const char *A0, *B0, *B2; size_t astr, bstr;
    __device__ __forceinline__ bool next(int i, Unit& u) const { const int t = i / 3, b = i - 3 * t; int pm, pn; if (!tile_of(t * G + c, M / 256, 4, pm, pn)) return false; u.pm = pm; u.pn = pn; u.aux = b; u.nt = 0;
        const char* w = b == 2 ? B2 : B0 + (size_t)b * bstr;
        u.A = A0 + (size_t)b * astr + (size_t)pm * (256 * 1024 * 2); u.B = w + (size_t)pn * (256 * 1024 * 2); return true; }
};
struct FoldSched {
    int G, c; const char *A0, *B0;
    __device__ __forceinline__ bool next(int i, Unit& u) const { const int idx = i * G + c; if (idx >= 32) return false; const int L = idx >> 4, pm = (idx >> 2) & 3, g = idx & 3; u.pm = pm; u.pn = g; u.aux = L; u.nt = 0;
        u.A = A0 + (size_t)L * (6 * MiB) + (size_t)pm * (256 * 1024 * 2) + (size_t)g * 512; u.B = B0 + (size_t)L * (512 * 1024) + (size_t)g * (256 * 256 * 2); return true; }
};
struct GroupSched {
    int nM, nN, G, c; int o1, o2, o3, o4, o5, o6, o7; const char* A0; const char* B0; size_t astep, bstep, estep; int wgm;
    __device__ __forceinline__ bool next(int i, Unit& u) const { int pm, pn; if (!tile_of(i * G + c, nM, nN, pm, pn, wgm)) return false; u.pm = pm; u.pn = pn; u.aux = 0; u.nt = 0;
        const int e = (pm >= o1) + (pm >= o2) + (pm >= o3) + (pm >= o4) + (pm >= o5) + (pm >= o6) + (pm >= o7);
        u.A = A0 + (size_t)pm * astep; u.B = B0 + (size_t)e * estep + (size_t)pn * bstep; return true; }
};

constexpr int MOE2_SPL = 7, MOE2_SNT = 4;
struct Moe2Sched {
    int nM, G, c, R, tail, split; int o1, o2, o3, o4, o5, o6, o7; const char* A0; const char* B0; size_t astep, bstep, estep;
    __device__ __forceinline__ bool next(int i, Unit& u) const {
        int L = i * G + c, part = -1, sub = 0;
        if (split && i >= R) { if (i > R || c >= MOE2_SPL * tail) return false; sub = c; L = R * G + c / MOE2_SPL; part = c % MOE2_SPL; }
        int pm, pn; if (!tile_of(L, nM, 4, pm, pn, 4)) return false; u.pm = pm; u.pn = pn;
        const int e = (pm >= o1) + (pm >= o2) + (pm >= o3) + (pm >= o4) + (pm >= o5) + (pm >= o6) + (pm >= o7);
        u.A = A0 + (size_t)pm * astep; u.B = B0 + (size_t)e * estep + (size_t)pn * bstep; u.aux = 0; u.nt = 0;
        if (part >= 0) { u.A += part * (MOE2_SNT * 128); u.B += part * (MOE2_SNT * 128); u.aux = 1 + sub; u.nt = MOE2_SNT; }
        return true; }
};

typedef f32x4 Acc[2][2][4][2];
__device__ __forceinline__ u32x4 pack8(const f32x4 v0, const f32x4 v1) { u32x4 w; w.x = pk_bf16(v0[0], v0[1]); w.y = pk_bf16(v0[2], v0[3]); w.z = pk_bf16(v1[0], v1[1]); w.w = pk_bf16(v1[2], v1[3]); return w; }
__device__ __forceinline__ f32x4 sig4(const f32x4 v) { f32x4 r; r[0] = sigm(v[0]); r[1] = sigm(v[1]); r[2] = sigm(v[2]); r[3] = sigm(v[3]); return r; }
__device__ __forceinline__ void unpack8(const u32x4 g, f32x4& lo, f32x4& hi) { lo[0] = bf_lo(g.x); lo[1] = bf_hi(g.x); lo[2] = bf_lo(g.y); lo[3] = bf_hi(g.y); hi[0] = bf_lo(g.z); hi[1] = bf_hi(g.z); hi[2] = bf_lo(g.w); hi[3] = bf_hi(g.w); }

__device__ __forceinline__ size_t gate_frag(int pm, int q, int wid, int ai, int m, int bj, int lane) { return ((size_t)((((((pm * 12 + q) * 8 + wid) * 2 + ai) * 4 + m) * 2 + bj) * 64 + lane)) * 16; }
struct EpiProj {
    bf16_t *scb, *scx, *glu, *pu, *gates; const f32x4* ss; int psplit, off_lo, off_hi;
    __device__ __forceinline__ bool operator()(Acc& acc, const Unit& u, int wr, int wc, int fr, int fq) const {
        const int row0 = u.pm * BM + wr * 64 + fr, pn = u.pn + (u.pn >= psplit ? off_hi : off_lo);
        float rs[2][4];
#pragma unroll
        for (int ai = 0; ai < 2; ++ai)
#pragma unroll
            for (int m = 0; m < 4; ++m) { const f32x4 p = ss[row0 + ai * HALF + m * 16]; rs[ai][m] = __builtin_amdgcn_rsqf(((p[0] + p[1]) + (p[2] + p[3])) * (1.0f / D) + RMS_EPS); }
        if (pn >= 4 && pn < 20) {
            const bool isglu = pn >= 12; bf16_t* dst = isglu ? glu : scx; const int col0 = (isglu ? pn - 12 : pn - 4) * 128 + wc * 32 + 8 * fq;
#pragma unroll
            for (int ai = 0; ai < 2; ++ai)
#pragma unroll
                for (int m = 0; m < 4; ++m) { const float r = rs[ai][m];
                    f32x4 a0 = acc[ai][0][m][0] * r, a1 = acc[ai][0][m][1] * r, b0 = acc[ai][1][m][0] * r, b1 = acc[ai][1][m][1] * r;
                    if (isglu) { b0 = sig4(b0); b1 = sig4(b1); }
                    *(u32x4*)(dst + (size_t)(row0 + ai * HALF + m * 16) * D + col0) = pack8(a0 * b0, a1 * b1); }
        } else {
            if (pn >= 24) {
#pragma unroll
                for (int ai = 0; ai < 2; ++ai)
#pragma unroll
                    for (int m = 0; m < 4; ++m) { const float r = rs[ai][m];
#pragma unroll
                        for (int bj = 0; bj < 2; ++bj) { f32x4 e0 = acc[ai][bj][m][0] * r, e1 = acc[ai][bj][m][1] * r;
#pragma unroll
                            for (int j = 0; j < 4; ++j) { e0[j] = __builtin_amdgcn_exp2f(-1.44269504f * __builtin_amdgcn_fmed3f(e0[j], -30.f, 30.f)); e1[j] = __builtin_amdgcn_exp2f(-1.44269504f * __builtin_amdgcn_fmed3f(e1[j], -30.f, 30.f)); }
                            *(u32x4*)((unsigned char*)gates + gate_frag(u.pm, pn - 24, wr * 4 + wc, ai, m, bj, fr + 16 * fq)) = pack8(e0, e1); } }
            } else {
            bf16_t* dst = pn < 4 ? scb : pu; const int ldc = D, colb = (pn < 4 ? pn : pn - 20) * 256;
            const int col0 = colb + wc * 32 + 8 * fq;
#pragma unroll
            for (int ai = 0; ai < 2; ++ai)
#pragma unroll
                for (int m = 0; m < 4; ++m) { const float r = rs[ai][m]; bf16_t* rowp = dst + (size_t)(row0 + ai * HALF + m * 16) * ldc + col0;
#pragma unroll
                    for (int bj = 0; bj < 2; ++bj) *(u32x4*)(rowp + bj * HALF) = pack8(acc[ai][bj][m][0] * r, acc[ai][bj][m][1] * r); }
            }
        }
        return false;
    }
};
struct EpiPlain {
    bf16_t* Ob; int ldc; size_t aux_stride;
    __device__ __forceinline__ bool operator()(Acc& acc, const Unit& u, int wr, int wc, int fr, int fq) const {
        bf16_t* O = Ob + (size_t)u.aux * aux_stride;
        const int row0 = u.pm * BM + wr * 64 + fr, col0 = u.pn * BM + wc * 32 + 8 * fq;
#pragma unroll
        for (int ai = 0; ai < 2; ++ai)
#pragma unroll
            for (int m = 0; m < 4; ++m) { bf16_t* rowp = O + (size_t)(row0 + ai * HALF + m * 16) * ldc + col0;
#pragma unroll
                for (int bj = 0; bj < 2; ++bj) *(u32x4*)(rowp + bj * HALF) = pack8(acc[ai][bj][m][0], acc[ai][bj][m][1]); }
        return false;
    }
};
struct EpiMoe2 {
    bf16_t* Y; bf16_t* YP;
    __device__ __forceinline__ bool operator()(Acc& acc, const Unit& u, int wr, int wc, int fr, int fq) const {
        bf16_t* O; int ldc;
        if (u.aux) { O = YP + (size_t)(u.aux - 1) * 65536 + (size_t)(wr * 64 + fr) * 256 + wc * 32 + 8 * fq; ldc = 256; }
        else { O = Y + (size_t)(u.pm * BM + wr * 64 + fr) * D + u.pn * BM + wc * 32 + 8 * fq; ldc = D; }
#pragma unroll
        for (int ai = 0; ai < 2; ++ai)
#pragma unroll
            for (int m = 0; m < 4; ++m) { bf16_t* rowp = O + (size_t)(ai * HALF + m * 16) * ldc;
#pragma unroll
                for (int bj = 0; bj < 2; ++bj) *(u32x4*)(rowp + bj * HALF) = pack8(acc[ai][bj][m][0], acc[ai][bj][m][1]); }
        return false;
    }
};
struct EpiMerge {
    const bf16_t* gates; bf16_t* O;
    __device__ __forceinline__ bool operator()(Acc& acc, const Unit& u, int wr, int wc, int fr, int fq) const {
        const int row0 = u.pm * BM + wr * 64 + fr, col0 = u.pn * BM + wc * 32 + 8 * fq, b = u.aux;
#pragma unroll
        for (int ai = 0; ai < 2; ++ai)
#pragma unroll
            for (int m = 0; m < 4; ++m) { const size_t row = (size_t)(row0 + ai * HALF + m * 16);
#pragma unroll
                for (int bj = 0; bj < 2; ++bj) { const unsigned char* gp = (const unsigned char*)gates + gate_frag(u.pm, 4 * b + u.pn, wr * 4 + wc, ai, m, bj, fr + 16 * fq);
                    f32x4 g0, g1; unpack8(*(const u32x4*)gp, g0, g1);
                    if (b < 2) { f32x4 h0, h1; unpack8(*(const u32x4*)(gp + gate_frag(0, 4, 0, 0, 0, 0, 0)), h0, h1);
#pragma unroll
                        for (int j = 0; j < 4; ++j) { acc[ai][bj][m][0][j] *= (1.f + h0[j]) * __builtin_amdgcn_rcpf(1.f + g0[j]); acc[ai][bj][m][1][j] *= (1.f + h1[j]) * __builtin_amdgcn_rcpf(1.f + g1[j]); }
                    } else {
#pragma unroll
                        for (int j = 0; j < 4; ++j) { g0[j] = __builtin_amdgcn_rcpf(1.f + g0[j]); g1[j] = __builtin_amdgcn_rcpf(1.f + g1[j]); }
                        *(u32x4*)(O + row * D + col0 + bj * HALF) = pack8(acc[ai][bj][m][0] * g0, acc[ai][bj][m][1] * g1); } } }
        return b < 2;
    }
};
struct EpiResid {
    const float* base32; bf16_t* xb; float* ssp; LAS float* red; unsigned char* x8;
    __device__ __forceinline__ bool operator()(Acc& acc, const Unit& u, int wr, int wc, int fr, int fq) const {
        const int row0 = u.pm * BM + wr * 64 + fr, col0 = u.pn * BM + wc * 32 + 8 * fq;
#pragma unroll
        for (int ai = 0; ai < 2; ++ai)
#pragma unroll
            for (int m = 0; m < 4; ++m) { const size_t row = (size_t)(row0 + ai * HALF + m * 16); float q = 0.f;
#pragma unroll
                for (int bj = 0; bj < 2; ++bj) { const size_t off = row * D + col0 + bj * HALF;
                    f32x4 b0, b1; if (base32) { b0 = *(const f32x4*)(base32 + off); b1 = *(const f32x4*)(base32 + off + 4); } else unpack8(*(const u32x4*)(xb + off), b0, b1);
                    const u32x4 pk = pack8(b0 + acc[ai][bj][m][0], b1 + acc[ai][bj][m][1]); *(u32x4*)(xb + off) = pk;
                    f32x4 o0, o1; unpack8(pk, o0, o1); if (x8) *(u32x2*)(x8 + off) = (u32x2){pk_fp8x4(o0), pk_fp8x4(o1)};
                    q += (o0[0] * o0[0] + o0[1] * o0[1]) + (o0[2] * o0[2] + o0[3] * o0[3]) + (o1[0] * o1[0] + o1[1] * o1[1]) + (o1[2] * o1[2] + o1[3] * o1[3]); }
                q += __shfl_xor(q, 16); q += __shfl_xor(q, 32);
                if (fq == 0) red[(ai * HALF + wr * 64 + m * 16 + fr) * 4 + wc] = q; }
        asm volatile("s_waitcnt lgkmcnt(0)" ::: "memory"); __builtin_amdgcn_s_barrier(); asm volatile("" ::: "memory");
        int tid = threadIdx.x; asm volatile("" : "+v"(tid));
        if (tid < 256) { const f32x4 v = *(const LAS f32x4*)(red + tid * 4); ssp[(size_t)(u.pm * BM + tid) * 4 + u.pn] = (v[0] + v[1]) + (v[2] + v[3]); }
        return false;
    }
};
template <bool PART4, bool OUT8> struct EpiSwiGLU {
    bf16_t* O; int ldc; const float* ss;
    __device__ __forceinline__ bool operator()(Acc& acc, const Unit& u, int wr, int wc, int fr, int fq) const {
        const int row0 = u.pm * BM + wr * 64 + fr, col0 = u.pn * 128 + wc * 32 + 8 * fq;
#pragma unroll
        for (int ai = 0; ai < 2; ++ai)
#pragma unroll
            for (int m = 0; m < 4; ++m) { const size_t row = (size_t)(row0 + ai * HALF + m * 16); float r = 1.f;
                if (PART4) { const f32x4 p = *(const f32x4*)(ss + row * 4); r = __builtin_amdgcn_rsqf(((p[0] + p[1]) + (p[2] + p[3])) * (1.0f / D) + RMS_EPS); }
                const f32x4 a0 = acc[ai][0][m][0] * r, a1 = acc[ai][0][m][1] * r, c0 = acc[ai][1][m][0] * r, c1 = acc[ai][1][m][1] * r;
                const f32x4 h0 = a0 * sig4(a0) * c0, h1 = a1 * sig4(a1) * c1;
                if (OUT8) { *(u32x2*)((unsigned char*)O + row * ldc + col0) = (u32x2){pk_fp8x4(h0 * F8_ACT_MUL), pk_fp8x4(h1 * F8_ACT_MUL)}; }
                else *(u32x4*)(O + row * ldc + col0) = pack8(h0, h1); }
        return false;
    }
};

typedef int i32x4 __attribute__((ext_vector_type(4)));
typedef int i32x8 __attribute__((ext_vector_type(8)));
__device__ __forceinline__ i32x8 join16(const bf16x8 lo, const bf16x8 hi) { return __builtin_shufflevector(__builtin_bit_cast(i32x4, lo), __builtin_bit_cast(i32x4, hi), 0, 1, 2, 3, 4, 5, 6, 7); }
template <class Epi, class Sched, bool F8 = false>
__device__ __forceinline__ void gemm_phase(LAS unsigned char* lds, const Gemm g, const Sched& S, const Epi& E) {
    int tid_ = threadIdx.x; asm volatile("" : "+v"(tid_));
    const int tid = tid_, wid = __builtin_amdgcn_readfirstlane(tid >> 6), lane = tid & 63, wr = wid >> 2, wc = wid & 3, fr = lane & 15, fq = lane >> 4;
    const int nt = g.Kb / 128;
    int vsa = g.sa, vsb = g.sb; asm volatile("" : "+v"(vsa), "+v"(vsb));
    unsigned voffA[2], voffB[2];
#pragma unroll
    for (int i = 0; i < 2; ++i) { int R, C; stage_rc(tid * 16 + i * 8192, R, C); const int Rb = (R & ~31) + perm32(R & 31);
        voffA[i] = (unsigned)(R * g.lda + C * 2); voffB[i] = (unsigned)(Rb * g.ldb + C * 2); }
    const size_t kstep = (size_t)(BK * 2);
    const size_t hstepA = (size_t)HALF * g.lda, hstepB = (size_t)HALF * g.ldb;
    const unsigned ldsw = (unsigned)wid * 1024u;
    const int aoff = lds_byte(wr * 64 + fr, fq * 8), boff = lds_byte(wc * 32 + fr, fq * 8);
#define PG8_SA(b, h) (((b) * 2 + (h)) * HTB)
#define PG8_SB(b, h) ((4 + (b) * 2 + (h)) * HTB)
#define PG8_STAGE(bufoff, gbase, voff) do { _Pragma("unroll") for (int _i = 0; _i < 2; ++_i) \
        __builtin_amdgcn_global_load_lds((const unsigned*)((const char*)(gbase) + (voff)[_i]), (LAS unsigned*)(lds + (bufoff) + ldsw + _i * 8192), 16, 0, 0); } while (0)
#define PG8_LDA(dst, b, h) do { _Pragma("unroll") for (int m = 0; m < 4; ++m) _Pragma("unroll") for (int k = 0; k < 2; ++k) dst[m][k] = *(const LAS bf16x8*)(lds + PG8_SA(b, h) + aoff + m * 2048 + k * 1024); } while (0)
#define PG8_LDB(dst, b, h) do { _Pragma("unroll") for (int n = 0; n < 2; ++n) _Pragma("unroll") for (int k = 0; k < 2; ++k) dst[n][k] = *(const LAS bf16x8*)(lds + PG8_SB(b, h) + boff + n * 2048 + k * 1024); } while (0)
#define PG8_MMA(ai, bj, At, Bt) do { __builtin_amdgcn_s_setprio(1); _Pragma("unroll") for (int m = 0; m < 4; ++m) _Pragma("unroll") for (int n = 0; n < 2; ++n) { \
        if constexpr (F8) { const i32x8 b8_ = join16(Bt[n][0], Bt[n][1]), a8_ = join16(At[m][0], At[m][1]); \
            asm volatile("v_mfma_scale_f32_16x16x128_f8f6f4 %0, %1, %2, %0, %3, %4 op_sel_hi:[0,0,0]" : "+v"(acc[ai][bj][m][n]) : "v"(b8_), "v"(a8_), "v"(vsb), "v"(vsa)); } \
        else { _Pragma("unroll") for (int k = 0; k < 2; ++k) acc[ai][bj][m][n] = __builtin_amdgcn_mfma_f32_16x16x32_bf16(Bt[n][k], At[m][k], acc[ai][bj][m][n], 0, 0, 0); } } __builtin_amdgcn_s_setprio(0); } while (0)
#define PG8_WAIT_V(n) asm volatile("s_waitcnt vmcnt(" #n ")" ::: "memory")
#define PG8_WAIT_L(n) asm volatile("s_waitcnt lgkmcnt(" #n ")" ::: "memory")
#define PG8_BAR __builtin_amdgcn_s_barrier()
#define PG8_SCHED __builtin_amdgcn_sched_barrier(0)
    Unit cur, nxt; int ui = 0;
    if (!S.next(0, cur)) return;
    Acc acc;
#pragma unroll
    for (int a = 0; a < 2; ++a)
#pragma unroll
        for (int b = 0; b < 2; ++b)
#pragma unroll
            for (int m = 0; m < 4; ++m)
#pragma unroll
                for (int n = 0; n < 2; ++n) acc[a][b][m][n] = (f32x4){0.f, 0.f, 0.f, 0.f};
    bf16x8 At[4][2], B0[2][2], B1[2][2];
    const char* cA = cur.A; const char* cB = cur.B;
    PG8_STAGE(PG8_SB(0, 0), cB, voffB); PG8_STAGE(PG8_SB(0, 1), cB + hstepB, voffB); PG8_STAGE(PG8_SA(0, 0), cA, voffA); PG8_STAGE(PG8_SA(0, 1), cA + hstepA, voffA);
    if (wr == 1) PG8_BAR;
    PG8_WAIT_V(2); PG8_BAR;
    PG8_STAGE(PG8_SB(1, 0), cB + kstep, voffB); PG8_STAGE(PG8_SA(1, 0), cA + kstep, voffA); PG8_STAGE(PG8_SB(1, 1), cB + hstepB + kstep, voffB);
    PG8_WAIT_V(6); PG8_BAR;
    for (;;) {
        const bool has_next = S.next(ui + 1, nxt);
        const char* nA = has_next ? nxt.A : cA; const char* nB = has_next ? nxt.B : cB;
        const int unt = cur.nt ? cur.nt : nt;
#pragma nounroll
        for (int t = 0; t < unt; t += 2) {
            const bool last = (t == unt - 2);
            const char* a1 = cA + (size_t)(t + 1) * kstep;
            const char* a2 = last ? nA : cA + (size_t)(t + 2) * kstep; const char* b2 = last ? nB : cB + (size_t)(t + 2) * kstep;
            const char* a3 = a2 + kstep; const char* b3 = b2 + kstep;
            PG8_LDB(B0, 0, 0); PG8_LDB(B1, 0, 1); PG8_SCHED; PG8_LDA(At, 0, 0); PG8_STAGE(PG8_SA(1, 1), a1 + hstepA, voffA);
            PG8_WAIT_V(8); PG8_WAIT_L(0); PG8_BAR; PG8_MMA(0, 0, At, B0); PG8_MMA(0, 1, At, B1); PG8_BAR; PG8_SCHED;
            PG8_LDA(At, 0, 1); PG8_STAGE(PG8_SB(0, 0), b2, voffB); PG8_STAGE(PG8_SB(0, 1), b2 + hstepB, voffB); PG8_STAGE(PG8_SA(0, 0), a2, voffA);
            PG8_WAIT_V(8); PG8_WAIT_L(0); PG8_BAR; PG8_MMA(1, 0, At, B0); PG8_MMA(1, 1, At, B1); PG8_BAR; PG8_SCHED;
            PG8_LDB(B0, 1, 0); PG8_LDB(B1, 1, 1); PG8_SCHED; PG8_LDA(At, 1, 0); PG8_STAGE(PG8_SA(0, 1), a2 + hstepA, voffA);
            PG8_WAIT_V(8); PG8_WAIT_L(0); PG8_BAR; PG8_MMA(0, 0, At, B0); PG8_MMA(0, 1, At, B1); PG8_BAR; PG8_SCHED;
            PG8_LDA(At, 1, 1); PG8_STAGE(PG8_SB(1, 0), b3, voffB); PG8_STAGE(PG8_SB(1, 1), b3 + hstepB, voffB); PG8_STAGE(PG8_SA(1, 0), a3, voffA);
            PG8_WAIT_V(8); PG8_WAIT_L(0); PG8_BAR; PG8_MMA(1, 0, At, B0); PG8_MMA(1, 1, At, B1); PG8_BAR; PG8_SCHED;
        }
        if constexpr (F8) asm volatile("s_nop 15\n\ts_nop 15" ::: "memory");
        if (wr == 0) PG8_BAR;
        const bool keep = E(acc, cur, wr, wc, fr, fq);
        if (!has_next) break;
        if (!keep) {
#pragma unroll
            for (int a = 0; a < 2; ++a)
#pragma unroll
                for (int b = 0; b < 2; ++b)
#pragma unroll
                    for (int m = 0; m < 4; ++m)
#pragma unroll
                        for (int n = 0; n < 2; ++n) acc[a][b][m][n] = (f32x4){0.f, 0.f, 0.f, 0.f};
        }
        cur = nxt; cA = nA; cB = nB; ++ui;
        if (wr == 1) PG8_BAR;
    }
    PG8_WAIT_V(0);
    PG8_BAR;
#undef PG8_SA
#undef PG8_SB
#undef PG8_STAGE
#undef PG8_LDA
#undef PG8_LDB
#undef PG8_MMA
#undef PG8_WAIT_V
#undef PG8_WAIT_L
#undef PG8_BAR
#undef PG8_SCHED
}
}

constexpr int RING_BYTES = 131072, MISC_OFF = RING_BYTES, RED_OFF = RING_BYTES + 1024, LDS_BYTES = 147456;

#define XB_TMO      128
#define XB_XCNT(j)  (256  + 64 * (j))
#define XB_XSUB(j)  (1280 + 64 * (j))
#define XB_XGEN(j)  (2304 + 64 * (j))
#define XB_TOP      3328
#define XB_TOPGEN   3392
#define XCD_BAR_WORDS 3456
#define XB_SPIN_CAP (1u << 18)
__device__ __forceinline__ unsigned xb_ld(unsigned* p)              { return __hip_atomic_load(p, __ATOMIC_RELAXED, __HIP_MEMORY_SCOPE_AGENT); }
__device__ __forceinline__ unsigned xb_add(unsigned* p, unsigned v) { return __hip_atomic_fetch_add(p, v, __ATOMIC_RELAXED, __HIP_MEMORY_SCOPE_AGENT); }
__device__ __forceinline__ unsigned xb_xcc_id() { return (unsigned)__builtin_amdgcn_s_getreg((3 << 11) | 20) & 0xFu; }
#define XB_SPIN(cond, bar) do { unsigned _sp = 0; while (cond) { __builtin_amdgcn_s_sleep(1); \
    if ((++_sp & 255u) == 0u) { if (xb_ld(&(bar)[XB_TMO])) break; if (_sp > XB_SPIN_CAP) { atomicAdd(&(bar)[XB_TMO], 1u); break; } } } } while (0)
struct XcdBarrier { unsigned* bar; unsigned x; volatile LAS unsigned* st; };
__device__ __forceinline__ XcdBarrier xcd_barrier_post(unsigned* bar, volatile LAS unsigned* st) {
    XcdBarrier b; b.bar = bar; b.x = xb_xcc_id(); b.st = st;
    if (threadIdx.x == 0) (void)xb_add(&bar[XB_XCNT(b.x)], 1u);
    return b;
}
__device__ __forceinline__ void xcd_barrier_complete(unsigned* bar, unsigned x, unsigned& nloc, unsigned& nx) {
    const unsigned G = gridDim.x * gridDim.y * gridDim.z;
    unsigned sum, cnt, mine, sp = 0u;
    for (;;) {
        sum = 0u; cnt = 0u; mine = 0u;
#pragma nounroll
        for (unsigned j = 0; j < 16; ++j) { const unsigned c = xb_ld(&bar[XB_XCNT(j)]); sum += c; cnt += (c > 0u) ? 1u : 0u; mine = (j == x) ? c : mine; }
        if (sum == G) break;
        __builtin_amdgcn_s_sleep(1);
        if ((++sp & 255u) == 0u) { if (xb_ld(&bar[XB_TMO])) break; if (sp > XB_SPIN_CAP) { atomicAdd(&bar[XB_TMO], 1u); break; } }
    }
    nloc = mine > 0u ? mine : 1u; nx = cnt > 0u ? cnt : 1u;
}
__device__ __forceinline__ void xcd_barrier(const XcdBarrier& b) {
    asm volatile("s_waitcnt vmcnt(0)" ::: "memory");
    __syncthreads();
    if (threadIdx.x == 0) {
        unsigned* bar = b.bar;
        __builtin_amdgcn_s_waitcnt(0);
        unsigned nloc = b.st[0], nx = b.st[1];
        if (nloc == 0u) { xcd_barrier_complete(bar, b.x, nloc, nx); b.st[0] = nloc; b.st[1] = nx; }
        const unsigned old = xb_add(&bar[XB_XSUB(b.x)], 1u);
        const unsigned gen = old / nloc;
        if (old + 1u == (gen + 1u) * nloc) {
            __builtin_amdgcn_fence(__ATOMIC_RELEASE, "agent");
            asm volatile("s_waitcnt vmcnt(0)" ::: "memory");
            const unsigned og = xb_add(&bar[XB_TOP], 1u);
            const unsigned tg = og / nx;
            if (og + 1u == (tg + 1u) * nx) xb_add(&bar[XB_TOPGEN], 1u);
            else XB_SPIN(xb_ld(&bar[XB_TOPGEN]) == tg, bar);
            __builtin_amdgcn_fence(__ATOMIC_ACQUIRE, "agent");
            xb_add(&bar[XB_XGEN(b.x)], 1u);
            asm volatile("s_waitcnt vmcnt(0)" ::: "memory");
        } else {
            XB_SPIN(xb_ld(&bar[XB_XGEN(b.x)]) == gen, bar);
            __builtin_amdgcn_fence(__ATOMIC_ACQUIRE, "agent");
            asm volatile("s_waitcnt vmcnt(0)" ::: "memory");
        }
    }
    __syncthreads();
}

struct Args { const float* in[23]; float* out; unsigned char* ws; int ph_lo, ph_hi; };
static_assert(sizeof(Args) == 23 * 8 + 8 + 8 + 8, "Args has no padding");
typedef const __attribute__((address_space(4))) Args* KArgs;
__device__ __forceinline__ KArgs kargs() { KArgs p = (KArgs)__builtin_amdgcn_kernarg_segment_ptr(); asm volatile("" : "+s"(p)); return p; }

__device__ __forceinline__ void transpose_item(const float* src, int ldn, int k0, int n0, bf16_t* dst, int ldk, const float* kscale, const float* nscale, int lane) {
    const int r4 = lane >> 4, q = lane & 15;
    f32x4 v[16];
    const float* sp = src + (size_t)(k0 + 16 * r4) * ldn + n0 + 4 * q;
#pragma unroll
    for (int i = 0; i < 16; ++i) v[i] = __builtin_nontemporal_load((const f32x4*)(sp + (size_t)i * ldn));
    f32x4 ns = (f32x4){1.f, 1.f, 1.f, 1.f}; if (nscale) ns = *(const f32x4*)(nscale + n0 + 4 * q);
    if (kscale) {
        const f32x4* kp = (const f32x4*)(kscale + k0 + 16 * r4);
#pragma unroll
        for (int g = 0; g < 4; ++g) { const f32x4 ks = kp[g];
#pragma unroll
            for (int j = 0; j < 4; ++j) v[4 * g + j] = v[4 * g + j] * ks[j]; }
    }
#pragma unroll
    for (int e = 0; e < 4; ++e) { u32x4 lo, hi;
#pragma unroll
        for (int w = 0; w < 4; ++w) { lo[w] = pk_bf16(v[2 * w][e] * ns[e], v[2 * w + 1][e] * ns[e]); hi[w] = pk_bf16(v[8 + 2 * w][e] * ns[e], v[9 + 2 * w][e] * ns[e]); }
        bf16_t* o = dst + (size_t)(4 * q + e) * ldk + k0 + 16 * r4; *(u32x4*)o = lo; *(u32x4*)(o + 8) = hi; }
}
__device__ __forceinline__ void transpose_item_f8(const float* src, int ldn, int k0, int n0, unsigned char* dst, int ldk, const float* kscale, float mul, int lane) {
    const int r4 = lane >> 4, q = lane & 15;
    f32x4 v[16];
    const float* sp = src + (size_t)(k0 + 16 * r4) * ldn + n0 + 4 * q;
#pragma unroll
    for (int i = 0; i < 16; ++i) v[i] = __builtin_nontemporal_load((const f32x4*)(sp + (size_t)i * ldn));
    {
        const f32x4* kp = (const f32x4*)(kscale + k0 + 16 * r4);
#pragma unroll
        for (int g = 0; g < 4; ++g) { f32x4 ks = (f32x4){mul, mul, mul, mul}; if (kscale) ks = kp[g] * mul;
#pragma unroll
            for (int j = 0; j < 4; ++j) v[4 * g + j] = v[4 * g + j] * ks[j]; }
    }
#pragma unroll
    for (int e = 0; e < 4; ++e) { u32x4 o;
#pragma unroll
        for (int w = 0; w < 4; ++w) o[w] = pk_fp8x4((f32x4){v[4 * w][e], v[4 * w + 1][e], v[4 * w + 2][e], v[4 * w + 3][e]});
        *(u32x4*)(dst + (size_t)(4 * q + e) * ldk + k0 + 16 * r4) = o; }
}
__device__ __forceinline__ int win_row(int n0) {
    const int seg = n0 >> 10, c = n0 & 1023;
    if (seg == 1 || seg == 2) return 1024 + (c >> 7) * 256 + (seg == 2 ? 128 : 0) + (c & 127);
    if (seg == 3 || seg == 4) return 3072 + (c >> 7) * 256 + (seg == 4 ? 128 : 0) + (c & 127);
    return n0;
}
__device__ __forceinline__ int pair_row(int f, int second) { return (f >> 7) * 256 + (second ? 128 : 0) + (f & 127); }

__device__ __forceinline__ void prologue_phase(KArgs a, LAS unsigned char* lds, int wid, int lane) {
    asm volatile("" : "+v"(lane));
    const int gw = blockIdx.x * 8 + wid, NGW = gridDim.x * 8;
    unsigned char* ws = a->ws;
    constexpr int I_WIN = 16 * 144, I_SQ = 16 * 16, I_PW = 16, I_D1 = 16 * 56, I_D2 = 56 * 16;
    constexpr int NIT = 2 * I_WIN + 8 * I_SQ + 8 * I_PW + 2 * I_D1 + I_D2;
    for (int it = gw; it < NIT; it += NGW) {
        int r = it;
        if (r < 2 * I_WIN) { const int L = r / I_WIN; r -= L * I_WIN; const int kb = r / 144, nb = r % 144, n0 = 64 * nb;
            if (n0 >= 6144 || (n0 >= 3072 && n0 < 5120)) transpose_item_f8(a->in[2] + (size_t)L * D * INC, INC, 64 * kb, n0, ws + WS_WG8 + (size_t)L * 5 * MiB + (size_t)(n0 >= 6144 ? 2048 + (n0 - 6144) : win_row(n0) - 3072) * D, D, a->in[1] + L * D, F8_W13_MUL, lane);
            else transpose_item(a->in[2] + (size_t)L * D * INC, INC, 64 * kb, n0, (bf16_t*)(ws + WS_W0 + W0_WIN + (size_t)L * 18 * MiB) + (size_t)win_row(n0) * D, D, a->in[1] + L * D, nullptr, lane);
            continue; }
        r -= 2 * I_WIN;
        if (r < 8 * I_SQ) { const int j = r / I_SQ; r -= j * I_SQ; const int L = j >> 2, w = j & 3, kb = r / 16, nb = r % 16, n0 = 64 * nb;
            bf16_t* dst = w < 3 ? (bf16_t*)(ws + WS_W0 + W0_WOUT + (size_t)(L * 3 + w) * 2 * MiB) : (bf16_t*)(ws + WS_W0 + W0_WO + (size_t)L * 2 * MiB);
            transpose_item(a->in[10 + w] + (size_t)L * D * D, D, 64 * kb, n0, dst + (size_t)n0 * D, D, nullptr, nullptr, lane); continue; }
        r -= 8 * I_SQ;
        if (r < 8 * I_PW) { const int j = r / I_PW; r -= j * I_PW; const int L = j >> 2, g = j & 3;
            const float* src = a->in[8] + (size_t)(L * 4 + g) * 65536 + (size_t)r * 16 * 256; const float* sc = a->in[9] + L * D + g * 256;
            bf16_t* dst = (bf16_t*)(ws + WS_W0 + W0_POOL + (size_t)L * 512 * 1024) + (size_t)g * 65536 + (size_t)r * 16 * 256; const f32x4 s4 = *(const f32x4*)(sc + 4 * lane);
#pragma unroll
            for (int i = 0; i < 16; ++i) { const f32x4 v = *(const f32x4*)(src + i * 256 + 4 * lane) * s4; u32x2 w; w.x = pk_bf16(v[0], v[1]); w.y = pk_bf16(v[2], v[3]); *(u32x2*)(dst + i * 256 + 4 * lane) = w; }
            continue; }
        r -= 8 * I_PW;
        if (r < 2 * I_D1) { const int w = r / I_D1; r -= w * I_D1; const int kb = r / 56, nb = r % 56, n0 = 64 * nb;
            transpose_item(a->in[15 + w], DFF, 64 * kb, n0, (bf16_t*)(ws + WS_W0 + W0_D13) + (size_t)pair_row(n0, w) * D, D, a->in[14], nullptr, lane); continue; }
        r -= 2 * I_D1;
        { const int kb = r / 16, nb = r % 16, n0 = 64 * nb;
            transpose_item(a->in[17], D, 64 * kb, n0, (bf16_t*)(ws + WS_W0 + W0_D2) + (size_t)n0 * DFF, DFF, nullptr, nullptr, lane); }
    }
    const float* x = a->in[0]; bf16_t* xb = (bf16_t*)(ws + WS_XB); f32x4* ss0 = (f32x4*)(ws + WS_SS); unsigned char* x8 = ws + WS_X8;
    for (int m = gw; m < M; m += NGW) {
        const f32x4* xr = (const f32x4*)(x + (size_t)m * D) + lane; u32x2* o = (u32x2*)(xb + (size_t)m * D) + lane; float s = 0.f;
#pragma unroll
        for (int j = 0; j < 4; ++j) { const f32x4 v = xr[64 * j]; s += (v[0] * v[0] + v[1] * v[1]) + (v[2] * v[2] + v[3] * v[3]); u32x2 w; w.x = pk_bf16(v[0], v[1]); w.y = pk_bf16(v[2], v[3]); o[64 * j] = w;
            *((unsigned*)(x8 + (size_t)m * D) + lane + 64 * j) = pk_fp8x4(v); }
        s = wave_sum(s); if (lane == 0) ss0[m] = (f32x4){s, 0.f, 0.f, 0.f};
    }
}

__device__ __forceinline__ void dma_block16(const bf16_t* src, LAS unsigned char* dst, int wid, int lane) {
#pragma unroll
    for (int k = 0; k < 4; ++k) { const int h = wid * 4 + k;
        __builtin_amdgcn_global_load_lds((const unsigned*)((const char*)src + h * 1024 + lane * 16), (LAS unsigned*)(dst + h * 1024), 16, 0, 0); }
}
__device__ __forceinline__ void zero_block16(LAS unsigned char* dst, int tid) {
#pragma unroll
    for (int k = 0; k < 4; ++k) *(LAS u32x4*)(dst + (size_t)(tid + 512 * k) * 16) = (u32x4){0u, 0u, 0u, 0u};
}
template <int I> __device__ __forceinline__ void conv31_pair(const LAS unsigned char* col, const unsigned (&wp)[31], f32x2 bias, f32x2 (&acc)[16]) {
    f32x2 x[46];
#pragma unroll
    for (int i = 0; i < 46; ++i) { const int r = i - 30, j = I + (r >> 4); const unsigned u = *(const LAS unsigned*)(col + ((j + 2) & 3) * 32768 + (r & 15) * 2048); x[i] = (f32x2){bf_lo(u), bf_hi(u)}; }
#pragma unroll
    for (int j = 0; j < 16; ++j) acc[j] = bias;
#pragma unroll
    for (int k = 0; k < 31; ++k) { const f32x2 wk = (f32x2){bf_lo(wp[k]), bf_hi(wp[k])};
#pragma unroll
        for (int j = 0; j < 16; ++j) acc[j] = __builtin_elementwise_fma(wk, x[j + k], acc[j]); }
}
template <int I, int CH> __device__ __forceinline__ void pool_ch(const LAS unsigned char* col, int g, int s0, float (&p)[16]) {
    float x[31], tv[16];
#pragma unroll
    for (int i = 0; i < 31; ++i) { const int r = i - 15, j = I + (r >> 4); const unsigned u = *(const LAS unsigned*)(col + ((j + 1) % 3) * 32768 + (r & 15) * 2048); x[i] = CH ? bf_hi(u) : bf_lo(u); }
#pragma unroll
    for (int j = 0; j < 16; ++j) tv[j] = x[15 + j];
#pragma unroll
    for (int i = 30; i >= 1; --i) x[i] += x[i - 1];
    if (g >= 1) {
#pragma unroll
        for (int i = 30; i >= 2; --i) x[i] += x[i - 2]; }
    if (g >= 2) {
#pragma unroll
        for (int i = 30; i >= 4; --i) x[i] += x[i - 4]; }
    if (g >= 3) {
#pragma unroll
        for (int i = 30; i >= 8; --i) x[i] += x[i - 8]; }
    const int w = 2 << g;
#pragma unroll
    for (int j = 0; j < 16; ++j) { const int cnt = min(s0 + j + 1, w); p[j] = x[15 + j] * (1.0f / (float)cnt) - tv[j]; }
}
struct ConvB { const bf16_t* GLU; __amdgpu_buffer_rsrc_t rVB; LAS unsigned char* lds; LAS float* red; LAS float* stat; f32x2 bb, gg, be; };
template <int I> __device__ __forceinline__ void convB_tile(const ConvB& c, unsigned (&wp)[31], int T0, int tid, int wid, int lane) {
    const int t0 = T0 + 16 * I; const LAS unsigned char* col = c.lds + 4 * tid;
#pragma unroll
    for (int k = 0; k < 31; ++k) asm volatile("" : "+v"(wp[k]));
    if (I < 3) dma_block16(c.GLU + (size_t)(t0 + 16) * D, c.lds + ((I + 3) & 3) * 32768, wid, lane);
    float a0[16], a1[16];
    { f32x2 ap[16]; conv31_pair<I>(col, wp, c.bb, ap);
#pragma unroll
      for (int j = 0; j < 16; ++j) { a0[j] = ap[j].x; a1[j] = ap[j].y; } }
    {
        float v[32];
#pragma unroll
        for (int j = 0; j < 16; ++j) { v[j] = a0[j] + a1[j]; v[16 + j] = a0[j] * a0[j] + a1[j] * a1[j]; }
#pragma unroll
        for (int i = 0; i < 16; ++i) { const bool b = lane & 32; const float send = b ? v[i] : v[i + 16], keep = b ? v[i + 16] : v[i]; v[i] = keep + __shfl_xor(send, 32); }
#pragma unroll
        for (int i = 0; i < 8; ++i) { const bool b = lane & 16; const float send = b ? v[i] : v[i + 8], keep = b ? v[i + 8] : v[i]; v[i] = keep + __shfl_xor(send, 16); }
#pragma unroll
        for (int i = 0; i < 4; ++i) { const bool b = lane & 8; const float send = b ? v[i] : v[i + 4], keep = b ? v[i + 4] : v[i]; v[i] = keep + __shfl_xor(send, 8); }
#pragma unroll
        for (int i = 0; i < 2; ++i) { const bool b = lane & 4; const float send = b ? v[i] : v[i + 2], keep = b ? v[i + 2] : v[i]; v[i] = keep + __shfl_xor(send, 4); }
        { const bool b = lane & 2; const float send = b ? v[0] : v[1], keep = b ? v[1] : v[0]; v[0] = keep + __shfl_xor(send, 2); }
        v[0] += __shfl_xor(v[0], 1);
        const int idx = ((lane >> 5) & 1) * 16 + ((lane >> 4) & 1) * 8 + ((lane >> 3) & 1) * 4 + ((lane >> 2) & 1) * 2 + ((lane >> 1) & 1);
        if (!(lane & 1)) c.red[wid * 32 + idx] = v[0];
    }
    __syncthreads();
    if (tid < 16) { float s = 0.f, q = 0.f;
#pragma unroll
        for (int w = 0; w < 8; ++w) { s += c.red[w * 32 + tid]; q += c.red[w * 32 + 16 + tid]; }
        const float mean = s * (1.0f / D), var = fmaxf(q * (1.0f / D) - mean * mean, 0.f);
        c.stat[2 * tid] = mean; c.stat[2 * tid + 1] = __builtin_amdgcn_rsqf(var + LN_EPS); }
    asm volatile("s_waitcnt vmcnt(0)" ::: "memory");
    __syncthreads();
#pragma unroll
    for (int j = 0; j < 16; ++j) { const float mean = c.stat[2 * j], rstd = c.stat[2 * j + 1];
        const float y0 = (a0[j] - mean) * rstd * c.gg.x + c.be.x, y1 = (a1[j] - mean) * rstd * c.gg.y + c.be.y;
        __builtin_amdgcn_raw_buffer_store_b32(pk_bf16(y0 * sigm(y0), y1 * sigm(y1)), c.rVB, 4 * tid, (t0 + j) * (D * 2), 0); }
}
struct ConvAC { const bf16_t* PU; __amdgpu_buffer_rsrc_t rSCB, rSCX, rYA, rPP; LAS unsigned char* lds; f32x2 s0w, s1w, s2w; };
__device__ __forceinline__ void convAC_load(const ConvAC& c, int t0, int tid, unsigned (&ub)[16], unsigned (&ux)[18]) {
#pragma unroll
    for (int j = 0; j < 16; ++j) ub[j] = __builtin_amdgcn_raw_buffer_load_b32(c.rSCB, 4 * tid, (t0 + j) * (D * 2), 0);
#pragma unroll
    for (int i = 0; i < 18; ++i) ux[i] = __builtin_amdgcn_raw_buffer_load_b32(c.rSCX, 4 * tid, (t0 + 62 + i) * (D * 2), 0);
}
template <int I> __device__ __forceinline__ void convAC_tile(const ConvAC& c, int T0, int tid, int wid, int lane, const unsigned (&ub)[16], const unsigned (&ux)[18], unsigned (&ubn)[16], unsigned (&uxn)[18]) {
    const int t0 = T0 + 16 * I, s0 = t0 & (SEQ - 1); const LAS unsigned char* col = c.lds + 4 * tid;
    if (I < 3) { convAC_load(c, t0 + 16, tid, ubn, uxn); dma_block16(c.PU + (size_t)(t0 + 16) * D, c.lds + ((I + 2) % 3) * 32768, wid, lane); }
    asm volatile("" ::: "memory");
    {
        float x0[18], x1[18];
#pragma unroll
        for (int i = 0; i < 18; ++i) { const unsigned u = (s0 - 2 + i) >= 0 ? ux[i] : 0u; x0[i] = bf_lo(u); x1[i] = bf_hi(u); }
#pragma unroll
        for (int j = 0; j < 16; ++j) {
            const float y0 = bf_lo(ub[j]) * (c.s0w.x * x0[j] + c.s1w.x * x0[j + 1] + c.s2w.x * x0[j + 2]), y1 = bf_hi(ub[j]) * (c.s0w.y * x1[j] + c.s1w.y * x1[j + 1] + c.s2w.y * x1[j + 2]);
            __builtin_amdgcn_raw_buffer_store_b32(pk_bf16(y0, y1), c.rYA, 4 * tid, (t0 + j) * (D * 2), 0); }
    }
    {
        float p0[16], p1[16];
        pool_ch<I, 0>(col, wid >> 1, s0, p0);
#pragma unroll
        for (int j = 0; j < 16; ++j) asm volatile("" : "+v"(p0[j]) :: "memory");
        pool_ch<I, 1>(col, wid >> 1, s0, p1);
#pragma unroll
        for (int j = 0; j < 16; ++j) __builtin_amdgcn_raw_buffer_store_b32(pk_bf16(p0[j], p1[j]), c.rPP, 4 * tid, (t0 + j) * (D * 2), 0);
    }
    if (I < 3) asm volatile("s_waitcnt vmcnt(32)" ::: "memory");
    __syncthreads();
}
__device__ __forceinline__ void conv_phase(KArgs a, int layer, LAS unsigned char* lds, int tid, int wid, int lane) {
    asm volatile("" : "+v"(tid), "+v"(lane));
    unsigned char* ws = a->ws;
    const int G = gridDim.x;
    const int vcu = (G % 8 == 0) ? (int)(blockIdx.x % 8) * (G / 8) + (int)(blockIdx.x / 8) : (int)blockIdx.x;
    const int c2 = 2 * tid;
    {
        const float* cfw = a->in[4] + layer * 31 * D; const float* cfb = a->in[5] + layer * D; const float* lng = a->in[6] + layer * D; const float* lnb = a->in[7] + layer * D;
        ConvB c; c.GLU = (const bf16_t*)(ws + A_GLU); c.rVB = __builtin_amdgcn_make_buffer_rsrc((void*)(ws + A_VB), 0, 0x7fffffff, 0x00020000);
        c.lds = lds; c.red = (LAS float*)(lds + RED_OFF); c.stat = c.red + 256;
        unsigned wp[31];
#pragma unroll
        for (int k = 0; k < 31; ++k) { const f32x2 w = *(const f32x2*)(cfw + k * D + c2); wp[k] = pk_bf16(w.x, w.y); }
        c.bb = *(const f32x2*)(cfb + c2); c.gg = *(const f32x2*)(lng + c2); c.be = *(const f32x2*)(lnb + c2);
        asm volatile("" :: "v"(c.bb.x), "v"(c.bb.y), "v"(c.gg.x), "v"(c.gg.y), "v"(c.be.x), "v"(c.be.y));
        for (int rp2 = 0; rp2 < REPS2(21); ++rp2)
        for (int sup = vcu; sup < M / 64; sup += G) {
            const int T0 = sup * 64; const bool seq0 = (T0 & (SEQ - 1)) == 0;
            if (seq0) { zero_block16(lds, tid); zero_block16(lds + 32768, tid); } else { dma_block16(c.GLU + (size_t)(T0 - 32) * D, lds, wid, lane); dma_block16(c.GLU + (size_t)(T0 - 16) * D, lds + 32768, wid, lane); }
            dma_block16(c.GLU + (size_t)T0 * D, lds + 65536, wid, lane);
            asm volatile("s_waitcnt vmcnt(0)" ::: "memory");
            __syncthreads();
            convB_tile<0>(c, wp, T0, tid, wid, lane); convB_tile<1>(c, wp, T0, tid, wid, lane); convB_tile<2>(c, wp, T0, tid, wid, lane); convB_tile<3>(c, wp, T0, tid, wid, lane);
            __syncthreads();
        }
    }
    __syncthreads();
    {
        const float* scw = a->in[3] + layer * 3 * D;
        ConvAC c; c.PU = (const bf16_t*)(ws + A_PU); c.lds = lds;
        c.rSCB = __builtin_amdgcn_make_buffer_rsrc((void*)(ws + A_SCB), 0, 0x7fffffff, 0x00020000); c.rSCX = __builtin_amdgcn_make_buffer_rsrc((void*)(ws + A_SCX - 64 * D * 2), 0, 0x7fffffff, 0x00020000);
        c.rYA = __builtin_amdgcn_make_buffer_rsrc((void*)(ws + A_YA), 0, 0x7fffffff, 0x00020000); c.rPP = __builtin_amdgcn_make_buffer_rsrc((void*)(ws + A_PP), 0, 0x7fffffff, 0x00020000);
        c.s0w = *(const f32x2*)(scw + c2); c.s1w = *(const f32x2*)(scw + D + c2); c.s2w = *(const f32x2*)(scw + 2 * D + c2);
        asm volatile("" :: "v"(c.s0w.x), "v"(c.s0w.y), "v"(c.s1w.x), "v"(c.s1w.y), "v"(c.s2w.x), "v"(c.s2w.y));
        for (int rp2 = 0; rp2 < REPS2(22); ++rp2)
        for (int sup = vcu; sup < M / 64; sup += G) {
            const int T0 = sup * 64; const bool seq0 = (T0 & (SEQ - 1)) == 0;
            if (seq0) zero_block16(lds, tid); else dma_block16(c.PU + (size_t)(T0 - 16) * D, lds, wid, lane);
            dma_block16(c.PU + (size_t)T0 * D, lds + 32768, wid, lane);
            unsigned ubA[16], uxA[18], ubB[16], uxB[18]; convAC_load(c, T0, tid, ubA, uxA);
            asm volatile("s_waitcnt vmcnt(0)" ::: "memory");
            __syncthreads();
            convAC_tile<0>(c, T0, tid, wid, lane, ubA, uxA, ubB, uxB); convAC_tile<1>(c, T0, tid, wid, lane, ubB, uxB, ubA, uxA); convAC_tile<2>(c, T0, tid, wid, lane, ubA, uxA, ubB, uxB); convAC_tile<3>(c, T0, tid, wid, lane, ubB, uxB, ubA, uxA);
        }
    }
}

__device__ __forceinline__ void route_phase(KArgs a, LAS unsigned char* lds, int tid, int wid, int lane) {
    asm volatile("" : "+v"(tid), "+v"(lane));
    unsigned char* ws = a->ws;
    const bf16_t* X = (const bf16_t*)(ws + WS_XB); const float* gn = a->in[14] + D; const float* R = a->in[18];
    const f32x4* ss3 = (const f32x4*)(ws + WS_SS) + 3 * M;
    int* tope = (int*)(ws + WS_SMALL + SM_TOPE); f32x2* topp = (f32x2*)(ws + WS_SMALL + SM_TOPP); int* cntb = (int*)(ws + WS_CTL + CTL_CNT);
    LAS int* lcnt = (LAS int*)(lds + 98304);
    float wgt[2][8][8];
#pragma unroll
    for (int h = 0; h < 2; ++h)
#pragma unroll
        for (int i = 0; i < 8; ++i) { const int k = 8 * lane + 512 * h + i; const float g = gn[k]; const f32x4 r0 = *(const f32x4*)(R + k * 8), r1 = *(const f32x4*)(R + k * 8 + 4);
#pragma unroll
            for (int e = 0; e < 4; ++e) { wgt[h][i][e] = g * r0[e]; wgt[h][i][4 + e] = g * r1[e]; } }
    for (int vb = blockIdx.x; vb < 256; vb += gridDim.x) {
        if (tid < 8) lcnt[tid] = 0;
        __syncthreads();
        for (int i8 = 0; i8 < 8; ++i8) {
            const int t = vb * 64 + wid * 8 + i8;
            float lg[8];
#pragma unroll
            for (int e = 0; e < 8; ++e) lg[e] = 0.f;
#pragma unroll
            for (int h = 0; h < 2; ++h) { f32x4 v0, v1; pg8::unpack8(*(const u32x4*)(X + (size_t)t * D + 512 * h + 8 * lane), v0, v1);
#pragma unroll
                for (int i = 0; i < 4; ++i)
#pragma unroll
                    for (int e = 0; e < 8; ++e) { lg[e] = fmaf(v0[i], wgt[h][i][e], lg[e]); lg[e] = fmaf(v1[i], wgt[h][4 + i][e], lg[e]); } }
#pragma unroll
            for (int e = 0; e < 8; ++e) lg[e] = wave_sum(lg[e]);
            const f32x4 sp = ss3[t]; const float rstd = __builtin_amdgcn_rsqf(((sp[0] + sp[1]) + (sp[2] + sp[3])) * (1.0f / D) + RMS_EPS);
            int e1 = 0; float v1 = lg[0];
#pragma unroll
            for (int e = 1; e < 8; ++e) if (lg[e] > v1) { v1 = lg[e]; e1 = e; }
            int e2 = e1 == 0 ? 1 : 0; float v2 = -__builtin_inff();
#pragma unroll
            for (int e = 0; e < 8; ++e) if (e != e1 && lg[e] > v2) { v2 = lg[e]; e2 = e; }
            const float ex = __expf((v2 - v1) * rstd), p1 = 1.0f / (1.0f + ex), p2 = ex * p1;
            if (lane == 0) { tope[t] = e1 | (e2 << 8); topp[t] = (f32x2){p1, p2}; atomicAdd((int*)&lcnt[e1], 1); atomicAdd((int*)&lcnt[e2], 1); }
        }
        __syncthreads();
        if (tid < 8) cntb[vb * 8 + tid] = lcnt[tid];
        __syncthreads();
    }
    const int gw = blockIdx.x * 8 + wid, NGW = gridDim.x * 8;
    constexpr int I_1 = 16 * 56, I_13 = 2 * I_1, I_2 = 56 * 16;
    unsigned char* w13 = ws + WS_WMOE; unsigned char* w2t = ws + WS_WMOE + WMOE_W2;
    for (int it = gw; it < NE * (I_13 + I_2); it += NGW) {
        int r = it;
        if (r < NE * I_13) { const int e = r / I_13; r -= e * I_13; const int w = r / I_1; r -= w * I_1; const int kb = r / 56, nb = r % 56, n0 = 64 * nb;
            transpose_item_f8(a->in[19 + w] + (size_t)e * D * DFF, DFF, 64 * kb, n0, w13 + (size_t)e * (2 * DFF) * D + (size_t)pair_row(n0, w) * D, D, gn, F8_W13_MUL, lane); continue; }
        r -= NE * I_13;
        { const int e = r / I_2; r -= e * I_2; const int kb = r / 16, nb = r % 16, n0 = 64 * nb;
            transpose_item_f8(a->in[21] + (size_t)e * DFF * D, D, 64 * kb, n0, w2t + (size_t)e * D * DFF + (size_t)n0 * DFF, DFF, nullptr, F8_W2_MUL, lane); }
    }
}

__device__ __forceinline__ void scatter_phase(KArgs a, LAS unsigned char* lds, int tid, int wid, int lane) {
    asm volatile("" : "+v"(tid), "+v"(lane));
    unsigned char* ws = a->ws;
    const int* tope = (const int*)(ws + WS_SMALL + SM_TOPE); int* tslot = (int*)(ws + WS_SMALL + SM_TSLOT); float* ssperm = (float*)(ws + WS_SMALL + SM_SSPERM); int* meta = (int*)(ws + WS_SMALL + SM_META);
    const int* cntb = (const int*)(ws + WS_CTL + CTL_CNT); const f32x4* ss3 = (const f32x4*)(ws + WS_SS) + 3 * M;
    const bf16_t* X = (const bf16_t*)(ws + WS_XB); unsigned char* AP = ws + WS_APERM;
    LAS int* lc = (LAS int*)lds;
    LAS int* lbase = lc + 2048;
    LAS int* lslot = lc + 2064;
    LAS int* ltot = lc + 2200;
    for (int i = tid; i < 2048; i += 512) lc[i] = __hip_atomic_load(cntb + i, __ATOMIC_RELAXED, __HIP_MEMORY_SCOPE_AGENT);
    __syncthreads();
    for (int vb = blockIdx.x; vb < 256; vb += gridDim.x) {
        if (tid < 8) { int tot = 0, pre = 0;
#pragma unroll 8
            for (int b = 0; b < 256; ++b) { const int v = lc[b * 8 + tid]; tot += v; pre += (b < vb) ? v : 0; }
            ltot[tid] = tot; lbase[tid] = pre; }
        __syncthreads();
        if (tid == 0) { int off = 0;
            for (int e = 0; e < 8; ++e) { lbase[e] += off; if (vb == 0) meta[e] = off >> 8; off += (ltot[e] + 255) & ~255; }
            if (vb == 0) meta[8] = off >> 8; }
        __syncthreads();
        if (wid == 0) {
            const int t = vb * 64 + lane; const int te = tope[t]; const int e1 = te & 0xff, e2 = (te >> 8) & 0xff;
            int s1 = 0, s2 = 0;
#pragma unroll
            for (int k = 0; k < 2; ++k) { const int ek = k ? e2 : e1; int sk = 0;
#pragma unroll
                for (int e = 0; e < 8; ++e) { const unsigned long long mask = __ballot(ek == e); const int base = lbase[e]; LDS_WAIT();
                    const int rank = __popcll(mask & ((1ull << lane) - 1ull)); if (ek == e) sk = base + rank;
                    if (lane == 0) lbase[e] = base + __popcll(mask); LDS_WAIT(); }
                if (k) s2 = sk; else s1 = sk; }
            *(int2*)(tslot + 2 * t) = make_int2(s1, s2); lslot[lane] = s1; lslot[64 + lane] = s2;
        }
        __syncthreads();
        {
            u32x4 xv[8][2]; f32x4 sp[8];
#pragma unroll
            for (int i = 0; i < 8; ++i) { const int t = vb * 64 + wid + 8 * i; const u32x4* src = (const u32x4*)(X + (size_t)t * D) + 2 * lane; xv[i][0] = src[0]; xv[i][1] = src[1]; sp[i] = ss3[t]; }
#pragma unroll
            for (int i = 0; i < 8; ++i) { const int r = wid + 8 * i, s1 = lslot[r], s2 = lslot[64 + r];
                const float rstd = __builtin_amdgcn_rsqf(((sp[i][0] + sp[i][1]) + (sp[i][2] + sp[i][3])) * (1.0f / D) + RMS_EPS);
                f32x4 v0, v1, v2, v3; pg8::unpack8(xv[i][0], v0, v1); pg8::unpack8(xv[i][1], v2, v3);
                const u32x4 q = (u32x4){pk_fp8x4(v0 * rstd), pk_fp8x4(v1 * rstd), pk_fp8x4(v2 * rstd), pk_fp8x4(v3 * rstd)};
                *((u32x4*)(AP + (size_t)s1 * D) + lane) = q; *((u32x4*)(AP + (size_t)s2 * D) + lane) = q; } }
        __syncthreads();
    }
}

__device__ __forceinline__ void combine_phase(KArgs a, LAS unsigned char* lds, int tid, int wid, int lane) {
    asm volatile("" : "+v"(lane), "+v"(tid));
    unsigned char* ws = a->ws;
    LAS int* tmap = (LAS int*)lds; const bf16_t* YP = (const bf16_t*)(ws + WS_YP);
    int split;
    { const int nMraw = __builtin_amdgcn_readfirstlane(__hip_atomic_load((const int*)(ws + WS_SMALL + SM_META) + 8, __ATOMIC_RELAXED, __HIP_MEMORY_SCOPE_AGENT)); const int nM = nMraw > MAXSLOT / 256 ? MAXSLOT / 256 : nMraw;
      const int G = (int)gridDim.x, nU = 4 * nM, R = nU / G, tail = nU - R * G; split = (tail > 0 && pg8::MOE2_SPL * tail <= G) ? 1 : 0;
      for (int i = tid; i < 4 * (MAXSLOT / 256); i += 512) tmap[i] = -1;
      __syncthreads();
      if (split && tid < tail) { int pm, pn; if (pg8::tile_of(R * G + tid, nM, 4, pm, pn, 4)) tmap[4 * pm + pn] = tid; }
      __syncthreads(); }
    const bf16_t* X = (const bf16_t*)(ws + WS_XB); const bf16_t* Y = (const bf16_t*)(ws + WS_Y); const int* tslot = (const int*)(ws + WS_SMALL + SM_TSLOT); const f32x2* topp = (const f32x2*)(ws + WS_SMALL + SM_TOPP);
    const float* gf = a->in[22]; float* out = a->out;
    const int gw = blockIdx.x * 8 + wid, NGW = gridDim.x * 8;
    f32x4 gv[4];
#pragma unroll
    for (int h = 0; h < 2; ++h) { gv[2 * h] = *(const f32x4*)(gf + 512 * h + 8 * lane); gv[2 * h + 1] = *(const f32x4*)(gf + 512 * h + 8 * lane + 4); }
    for (int tb = gw; tb < M; tb += 4 * NGW) {
        int2 sl[4]; f32x2 p[4];
#pragma unroll
        for (int i = 0; i < 4; ++i) { const int t = min(tb + i * NGW, M - 1); sl[i] = *(const int2*)(tslot + 2 * t); p[i] = topp[t]; }
        u32x4 xr[4][2], ya[4][2], yb[4][2];
#pragma unroll
        for (int i = 0; i < 4; ++i) { const int t = min(tb + i * NGW, M - 1);
#pragma unroll
            for (int h = 0; h < 2; ++h) { const int col = 512 * h + 8 * lane;
                xr[i][h] = *(const u32x4*)(X + (size_t)t * D + col); ya[i][h] = *(const u32x4*)(Y + (size_t)sl[i].x * D + col); yb[i][h] = *(const u32x4*)(Y + (size_t)sl[i].y * D + col); } }
#pragma unroll
        for (int i = 0; i < 4; ++i) { const int t = tb + i * NGW; if (t < M) {
            f32x4 v[4]; float s = 0.f;
#pragma unroll
            for (int h = 0; h < 2; ++h) { f32x4 x0, x1, a0, a1, b0, b1; pg8::unpack8(xr[i][h], x0, x1); pg8::unpack8(ya[i][h], a0, a1); pg8::unpack8(yb[i][h], b0, b1);
                if (split) { const int pn = 2 * h + (lane >> 5), cl = 8 * (lane & 31);
                    const int ka = tmap[4 * (sl[i].x >> 8) + pn], kb = tmap[4 * (sl[i].y >> 8) + pn];
                    if (ka >= 0) { a0 = (f32x4){0.f, 0.f, 0.f, 0.f}; a1 = a0;
                        for (int p = 0; p < pg8::MOE2_SPL; ++p) { f32x4 t0, t1; pg8::unpack8(*(const u32x4*)(YP + (size_t)(ka * pg8::MOE2_SPL + p) * 65536 + (size_t)(sl[i].x & 255) * 256 + cl), t0, t1); a0 += t0; a1 += t1; } }
                    if (kb >= 0) { b0 = (f32x4){0.f, 0.f, 0.f, 0.f}; b1 = b0;
                        for (int p = 0; p < pg8::MOE2_SPL; ++p) { f32x4 t0, t1; pg8::unpack8(*(const u32x4*)(YP + (size_t)(kb * pg8::MOE2_SPL + p) * 65536 + (size_t)(sl[i].y & 255) * 256 + cl), t0, t1); b0 += t0; b1 += t1; } } }
                v[2 * h] = x0 + a0 * p[i].x + b0 * p[i].y; v[2 * h + 1] = x1 + a1 * p[i].x + b1 * p[i].y; }
#pragma unroll
            for (int k = 0; k < 4; ++k) s += (v[k][0] * v[k][0] + v[k][1] * v[k][1]) + (v[k][2] * v[k][2] + v[k][3] * v[k][3]);
            const float rstd = __builtin_amdgcn_rsqf(wave_sum(s) * (1.0f / D) + RMS_EPS);
#pragma unroll
            for (int h = 0; h < 2; ++h) { const int col = 512 * h + 8 * lane;
                *(f32x4*)(out + (size_t)t * D + col) = v[2 * h] * rstd * gv[2 * h]; *(f32x4*)(out + (size_t)t * D + col + 4) = v[2 * h + 1] * rstd * gv[2 * h + 1]; } } }
    }
}

#ifndef WGM_INPROJ
#define WGM_INPROJ 4
#endif
#ifndef WGM_FFN1
#define WGM_FFN1 4
#endif
#ifndef WGM_MOE1
#define WGM_MOE1 4
#endif
constexpr int NPH = 18;
#ifndef MK_PH_MASK
#define MK_PH_MASK 0xFFFFFFFFu
#endif
#define PHON(bit) ((((MK_PH_MASK) >> (bit)) & 1u) != 0u)


__device__ __forceinline__ void ph_inproj(KArgs a, int layer, LAS unsigned char* lds) {
    unsigned char* ws = a->ws;
    {
        pg8::Gemm g{2 * D, 2 * D, 2 * D, 0, 0}; pg8::PlainSched S{M / 256, 16, (int)gridDim.x, (int)blockIdx.x, (const char*)(ws + WS_XB), (const char*)(ws + WS_W0 + W0_WIN + (size_t)layer * 18 * MiB), (size_t)256 * D * 2, (size_t)256 * D * 2, WGM_INPROJ, 12, 8};
        pg8::EpiProj E{(bf16_t*)(ws + A_SCB), (bf16_t*)(ws + A_SCX), (bf16_t*)(ws + A_GLU), (bf16_t*)(ws + A_PU), (bf16_t*)(ws + A_GATES), (const f32x4*)(ws + WS_SS) + (size_t)(layer * 2) * M, 12, 0, 8};
        pg8::gemm_phase(lds, g, S, E);
    }
    __syncthreads();
    {
        pg8::Gemm g{D, D, D, F8_ONE, F8_W13_SC}; pg8::PlainSched S{M / 256, 20, (int)gridDim.x, (int)blockIdx.x, (const char*)(ws + WS_X8), (const char*)(ws + WS_WG8 + (size_t)layer * 5 * MiB), (size_t)256 * D, (size_t)256 * D, WGM_INPROJ, 1 << 30, 0};
        pg8::EpiProj E{(bf16_t*)(ws + A_SCB), (bf16_t*)(ws + A_SCX), (bf16_t*)(ws + A_GLU), (bf16_t*)(ws + A_PU), (bf16_t*)(ws + A_GATES), (const f32x4*)(ws + WS_SS) + (size_t)(layer * 2) * M, 8, 12, 16};
        pg8::gemm_phase<pg8::EpiProj, pg8::PlainSched, true>(lds, g, S, E);
    }
}
__device__ __forceinline__ void ph_fold(KArgs a, LAS unsigned char* lds) {
    unsigned char* ws = a->ws;
    pg8::Gemm g{512, 2 * D, 512, 0, 0}; pg8::FoldSched S{(int)gridDim.x, (int)blockIdx.x, (const char*)(ws + WS_W0 + W0_WOUT + 2 * 2 * MiB), (const char*)(ws + WS_W0 + W0_POOL)};
    pg8::EpiPlain E{(bf16_t*)(ws + WS_WC), D, (size_t)D * D};
    pg8::gemm_phase(lds, g, S, E);
}
__device__ __forceinline__ void ph_merge(KArgs a, int layer, LAS unsigned char* lds) {
    unsigned char* ws = a->ws;
    pg8::Gemm g{2 * D, 2 * D, 2 * D, 0, 0}; pg8::MergeSched S{(int)gridDim.x, (int)blockIdx.x, (const char*)(ws + A_YA), (const char*)(ws + WS_W0 + W0_WOUT + (size_t)(layer * 3) * 2 * MiB), (const char*)(ws + WS_WC + (size_t)layer * 2 * MiB), (size_t)32 * MiB, (size_t)2 * MiB};
    pg8::EpiMerge E{(const bf16_t*)(ws + A_GATES), (bf16_t*)(ws + A_MERGED)};
    pg8::gemm_phase(lds, g, S, E);
}
__device__ __forceinline__ void ph_wo(KArgs a, int layer, LAS unsigned char* lds) {
    unsigned char* ws = a->ws;
    pg8::Gemm g{2 * D, 2 * D, 2 * D, 0, 0}; pg8::PlainSched S{M / 256, D / 256, (int)gridDim.x, (int)blockIdx.x, (const char*)(ws + A_MERGED), (const char*)(ws + WS_W0 + W0_WO + (size_t)layer * 2 * MiB), (size_t)256 * D * 2, (size_t)256 * D * 2, 4, 1 << 30, 0};
    pg8::EpiResid E{layer == 0 ? a->in[0] : (const float*)nullptr, (bf16_t*)(ws + WS_XB), (float*)(ws + WS_SS) + (size_t)(layer * 2 + 1) * M * 4, (LAS float*)(lds + RED_OFF), nullptr};
    pg8::gemm_phase(lds, g, S, E);
}
__device__ __forceinline__ void ph_ffn1(KArgs a, LAS unsigned char* lds) {
    unsigned char* ws = a->ws;
    pg8::Gemm g{2 * D, 2 * D, 2 * D, 0, 0}; pg8::PlainSched S{M / 256, 2 * DFF / 256, (int)gridDim.x, (int)blockIdx.x, (const char*)(ws + WS_XB), (const char*)(ws + WS_W0 + W0_D13), (size_t)256 * D * 2, (size_t)256 * D * 2, WGM_FFN1, 1 << 30, 0};
    pg8::EpiSwiGLU<true, false> E{(bf16_t*)(ws + A_FFN), DFF, (const float*)(ws + WS_SS) + (size_t)1 * M * 4};
    pg8::gemm_phase(lds, g, S, E);
}
__device__ __forceinline__ void ph_ffn2(KArgs a, LAS unsigned char* lds) {
    unsigned char* ws = a->ws;
    pg8::Gemm g{2 * DFF, 2 * DFF, 2 * DFF, 0, 0}; pg8::PlainSched S{M / 256, D / 256, (int)gridDim.x, (int)blockIdx.x, (const char*)(ws + A_FFN), (const char*)(ws + WS_W0 + W0_D2), (size_t)256 * DFF * 2, (size_t)256 * DFF * 2, 4, 1 << 30, 0};
    pg8::EpiResid E{(const float*)nullptr, (bf16_t*)(ws + WS_XB), (float*)(ws + WS_SS) + (size_t)2 * M * 4, (LAS float*)(lds + RED_OFF), ws + WS_X8};
    pg8::gemm_phase(lds, g, S, E);
}
__device__ __forceinline__ void ph_moe(KArgs a, int which, LAS unsigned char* lds) {
    unsigned char* ws = a->ws;
    const int* meta = (const int*)(ws + WS_SMALL + SM_META); int o[9];
#pragma unroll
    for (int e = 0; e < 9; ++e) o[e] = __builtin_amdgcn_readfirstlane(__hip_atomic_load(meta + e, __ATOMIC_RELAXED, __HIP_MEMORY_SCOPE_AGENT));
    const int nM = o[8] > MAXSLOT / 256 ? MAXSLOT / 256 : o[8];
    if (which == 0) {
        pg8::Gemm g{D, D, D, F8_ONE, F8_W13_SC}; pg8::GroupSched S{nM, 2 * DFF / 256, (int)gridDim.x, (int)blockIdx.x, o[1], o[2], o[3], o[4], o[5], o[6], o[7], (const char*)(ws + WS_APERM), (const char*)(ws + WS_WMOE), (size_t)256 * D, (size_t)256 * D, (size_t)2 * DFF * D, WGM_MOE1};
        pg8::EpiSwiGLU<false, true> E{(bf16_t*)(ws + WS_ACTP), DFF, nullptr};
        pg8::gemm_phase<pg8::EpiSwiGLU<false, true>, pg8::GroupSched, true>(lds, g, S, E);
    } else {
        const int G = (int)gridDim.x, nU = 4 * nM, R = nU / G, tail = nU - R * G, split = (tail > 0 && pg8::MOE2_SPL * tail <= G) ? 1 : 0;
        pg8::Gemm g{DFF, DFF, DFF, F8_ACT_SC, F8_W2_SC}; pg8::Moe2Sched S{nM, G, (int)blockIdx.x, R, tail, split, o[1], o[2], o[3], o[4], o[5], o[6], o[7], (const char*)(ws + WS_ACTP), (const char*)(ws + WS_WMOE + WMOE_W2), (size_t)256 * DFF, (size_t)256 * DFF, (size_t)D * DFF};
        pg8::EpiMoe2 E{(bf16_t*)(ws + WS_Y), (bf16_t*)(ws + WS_YP)};
        pg8::gemm_phase<pg8::EpiMoe2, pg8::Moe2Sched, true>(lds, g, S, E);
    }
}

__global__ void __launch_bounds__(512, 2) fwd(Args unused_args_read_through_kargs) {
    extern __shared__ __attribute__((aligned(16))) unsigned char lds_raw[];
    LAS unsigned char* lds = (LAS unsigned char*)lds_raw;
    volatile LAS unsigned* MISC = (volatile LAS unsigned*)(lds + MISC_OFF);
    const int tid = threadIdx.x, lane = tid & 63, wid = __builtin_amdgcn_readfirstlane(tid >> 6);
    if (tid < 64) MISC[tid] = 0u;
    __syncthreads();
    int lo, hi; XcdBarrier bar;
    { KArgs a = kargs(); lo = a->ph_lo; hi = a->ph_hi; unsigned* bw = (unsigned*)(a->ws + WS_CTL + CTL_BAR); bar.bar = bw; bar.x = 0; bar.st = nullptr; if (hi - lo > 1) bar = xcd_barrier_post(bw, MISC + 8); }
#define IN(k) (lo <= (k) && (k) < hi)
#define SEAM(k) do { if (IN(k) && IN((k) + 1)) xcd_barrier(bar); } while (0)

    if (PHON(0) && IN(0)) { for (int rp = 0; rp < REPS(0); ++rp) { prologue_phase(kargs(), lds, wid, lane); __syncthreads(); } } SEAM(0);
#pragma nounroll
    for (int layer = 0; layer < 2; ++layer) {
        const int pb = 1 + 7 * layer;
        if (PHON(1) && IN(pb + 0)) { for (int rp = 0; rp < REPS(1); ++rp) { if (layer == 0) { ph_fold(kargs(), lds); __syncthreads(); } ph_inproj(kargs(), layer, lds); __syncthreads(); } } SEAM(pb + 0);
        if (PHON(2) && IN(pb + 1)) { for (int rp = 0; rp < REPS(2); ++rp) { conv_phase(kargs(), layer, lds, tid, wid, lane); __syncthreads(); } } SEAM(pb + 1);
        if (PHON(4) && IN(pb + 3)) { for (int rp = 0; rp < REPS(4); ++rp) { ph_merge(kargs(), layer, lds); __syncthreads(); } } SEAM(pb + 3);
        if (PHON(5) && IN(pb + 4)) { for (int rp = 0; rp < (layer == 0 ? REPS(5) : 1); ++rp) { ph_wo(kargs(), layer, lds); __syncthreads(); } } SEAM(pb + 4);
        if (layer == 0) {
            if (PHON(6) && IN(6)) { for (int rp = 0; rp < REPS(6); ++rp) { ph_ffn1(kargs(), lds); __syncthreads(); } } SEAM(6);
            if (PHON(7) && IN(7)) { ph_ffn2(kargs(), lds); } SEAM(7);
        }
    }
    if (PHON(13) && IN(13)) { for (int rp = 0; rp < REPS(13); ++rp) { route_phase(kargs(), lds, tid, wid, lane); __syncthreads(); } } SEAM(13);
    if (PHON(14) && IN(14)) { for (int rp = 0; rp < REPS(14); ++rp) { scatter_phase(kargs(), lds, tid, wid, lane); __syncthreads(); } } SEAM(14);
    if (PHON(15) && IN(15)) { for (int rp = 0; rp < REPS(15); ++rp) { ph_moe(kargs(), 0, lds); __syncthreads(); } } SEAM(15);
    if (PHON(16) && IN(16)) { for (int rp = 0; rp < REPS(16); ++rp) { ph_moe(kargs(), 1, lds); __syncthreads(); } } SEAM(16);
    if (PHON(17) && IN(17)) { for (int rp = 0; rp < REPS(17); ++rp) { combine_phase(kargs(), lds, tid, wid, lane); __syncthreads(); } }
#undef IN
#undef SEAM
}

extern "C" void kernel_launch(void* const* d_in, const int* in_sizes, int n_in, void* d_out, int out_size, void* d_ws, size_t ws_size, hipStream_t stream) {
    static int grid = 0;
    if (grid == 0) {
        if (n_in != 23 || in_sizes[0] != M * D || out_size != M * D || ws_size < WS_END) { fprintf(stderr, "kernel_launch: unexpected shapes: n_in %d in0 %d out %d ws %zu (need %zu); nothing launched\n", n_in, n_in > 0 ? in_sizes[0] : -1, out_size, ws_size, (size_t)WS_END); grid = -1; return; }
        int dev = 0, cus = 0, per_cu = 0;
        if (hipGetDevice(&dev) != hipSuccess || hipDeviceGetAttribute(&cus, hipDeviceAttributeMultiprocessorCount, dev) != hipSuccess) { fprintf(stderr, "kernel_launch: device query failed\n"); grid = -1; return; }
        if (hipFuncSetAttribute((const void*)fwd, hipFuncAttributeMaxDynamicSharedMemorySize, LDS_BYTES) != hipSuccess) { fprintf(stderr, "kernel_launch: hipFuncSetAttribute failed\n"); grid = -1; return; }
        if (hipOccupancyMaxActiveBlocksPerMultiprocessor(&per_cu, (const void*)fwd, 512, LDS_BYTES) != hipSuccess || per_cu < 1) fprintf(stderr, "kernel_launch: note: occupancy query reports %d workgroups per CU\n", per_cu);
        (void)hipGetLastError();
        grid = cus;
    }
    if (grid < 0) return;
    if (hipMemsetAsync((char*)d_ws + WS_CTL, 0, CTL_BYTES, stream) != hipSuccess) { fprintf(stderr, "kernel_launch: memset failed\n"); return; }
    Args a{};
    for (int i = 0; i < 23; ++i) a.in[i] = (const float*)d_in[i];
    a.out = (float*)d_out; a.ws = (unsigned char*)d_ws;
#if MK_PER_PHASE
    for (int ph = 0; ph < NPH; ++ph) { a.ph_lo = ph; a.ph_hi = ph + 1; hipLaunchKernelGGL(fwd, dim3(grid), dim3(512), LDS_BYTES, stream, a); }
#else
    a.ph_lo = 0; a.ph_hi = NPH; hipLaunchKernelGGL(fwd, dim3(grid), dim3(512), LDS_BYTES, stream, a);
#endif
    const hipError_t le = hipPeekAtLastError();
    if (le != hipSuccess) fprintf(stderr, "kernel_launch: launch failed: %s\n", hipGetErrorName(le));
}
```

```cpp
#include <hip/hip_runtime.h>
#include <cstdio>
#include <cstdint>

#ifndef MK_PER_PHASE
#define MK_PER_PHASE 0
#endif

#ifndef MK_REP_MASK
#define MK_REP_MASK 0u
#endif
#define REPS(bit) (1 + (int)(((MK_REP_MASK) >> (bit)) & 1u))
#define REPS2(bit) REPS(bit)

#define LAS __attribute__((address_space(3)))
typedef unsigned short bf16_t;
typedef short bf16x8 __attribute__((ext_vector_type(8)));
typedef float f32x4 __attribute__((ext_vector_type(4)));
typedef float f32x2 __attribute__((ext_vector_type(2)));
typedef unsigned u32x4 __attribute__((ext_vector_type(4)));
typedef unsigned u32x2 __attribute__((ext_vector_type(2)));

constexpr int M = 16384, D = 1024, SEQ = 8192, INC = 9216, DFF = 3584, NE = 8;
constexpr float RMS_EPS = 1e-6f, LN_EPS = 1e-5f;
constexpr int MAXSLOT = 34816;
constexpr float F8_W13_MUL = 128.f, F8_ACT_MUL = 4.f, F8_W2_MUL = 256.f;
constexpr int F8_ONE = 0x7f7f7f7f, F8_W13_SC = 0x78787878  , F8_ACT_SC = 0x7d7d7d7d  , F8_W2_SC = 0x77777777  ;

constexpr size_t MiB = 1u << 20;
constexpr size_t WS_CTL = 0, CTL_BYTES = 64 * 1024;
constexpr size_t CTL_BAR = 16384;
constexpr size_t CTL_CNT = 32768;
constexpr size_t WS_SMALL = 1 * MiB;
constexpr size_t SM_TOPE = 0, SM_TOPP = 64 * 1024, SM_TSLOT = 192 * 1024, SM_SSPERM = 320 * 1024, SM_META = 512 * 1024;
constexpr size_t WS_X8 = 2 * MiB;
constexpr size_t WS_YP = 18 * MiB;
constexpr size_t WS_WG8 = 492 * MiB;
constexpr size_t WS_XB = 66 * MiB;
constexpr size_t WS_W0 = 98 * MiB;
constexpr size_t W0_WIN = 0;
constexpr size_t W0_WOUT = 36 * MiB;
constexpr size_t W0_WO = 48 * MiB;
constexpr size_t W0_POOL = 52 * MiB;
constexpr size_t W0_D13 = 53 * MiB;
constexpr size_t W0_D2 = 67 * MiB;
constexpr size_t WS_ACT = 172 * MiB;
constexpr size_t A_SCB = WS_ACT, A_SCX = WS_ACT + 32 * MiB, A_GLU = WS_ACT + 64 * MiB, A_PU = WS_ACT + 96 * MiB, A_GATES = WS_ACT + 128 * MiB,
                 A_YA = WS_ACT + 224 * MiB, A_VB = WS_ACT + 256 * MiB, A_PP = WS_ACT + 288 * MiB, A_MERGED = A_SCX, A_FFN = WS_ACT;
constexpr size_t WS_WC = 524 * MiB;
constexpr size_t WS_ACTP = 98 * MiB;
constexpr size_t WS_WMOE = 304 * MiB, WMOE_W2 = 56 * MiB;
constexpr size_t WS_Y = 400 * MiB;
constexpr size_t WS_APERM = 472 * MiB;
constexpr size_t WS_SS = 540 * MiB;
constexpr size_t WS_END = 541 * MiB;

typedef __bf16 bf16x2_t __attribute__((ext_vector_type(2)));
__device__ __forceinline__ unsigned pk_bf16(float lo, float hi) { const bf16x2_t v = {(__bf16)lo, (__bf16)hi}; return __builtin_bit_cast(unsigned, v); }
__device__ __forceinline__ unsigned pk_fp8x4(const f32x4 v) {
    const float a = __builtin_amdgcn_fmed3f(v[0], -448.f, 448.f), b = __builtin_amdgcn_fmed3f(v[1], -448.f, 448.f), c = __builtin_amdgcn_fmed3f(v[2], -448.f, 448.f), d = __builtin_amdgcn_fmed3f(v[3], -448.f, 448.f);
    int w = 0; w = __builtin_amdgcn_cvt_pk_fp8_f32(a, b, w, false); w = __builtin_amdgcn_cvt_pk_fp8_f32(c, d, w, true); return (unsigned)w; }
__device__ __forceinline__ float bf_lo(unsigned u) { return __uint_as_float(u << 16); }
__device__ __forceinline__ float bf_hi(unsigned u) { return __uint_as_float(u & 0xffff0000u); }
__device__ __forceinline__ float sigm(float x) { return __builtin_amdgcn_rcpf(1.f + __builtin_amdgcn_exp2f(-1.44269504f * x)); }
__device__ __forceinline__ float wave_sum(float v) {
#pragma unroll
    for (int o = 1; o < 64; o <<= 1) v += __shfl_xor(v, o);
    return v;
}
#define LDS_WAIT() asm volatile("s_waitcnt lgkmcnt(0)" ::: "memory")

namespace pg8 {
constexpr int BM = 256, BK = 64, HALF = 128, HTB = HALF * BK * 2, STAGE_BYTES = 8 * HTB, NXCD = 8;
__host__ __device__ __forceinline__ int lds_byte(int r, int c) { const int st = (r >> 4) * 2 + (c >> 5), rr = r & 15, cc = c & 31, ob = rr * 64 + cc * 2; return st * 1024 + (ob ^ (((ob >> 9) & 1) << 5)); }
__host__ __device__ __forceinline__ void stage_rc(int b, int& R, int& C) { const int st = b / 1024, sb = b % 1024, swz = sb ^ (((sb >> 9) & 1) << 5); R = (st >> 1) * 16 + swz / 64; C = (st & 1) * 32 + (swz % 64) / 2; }
__host__ __device__ __forceinline__ int perm32(int rho) { const int n = rho >> 4, i = rho & 15; return 8 * (i >> 2) + 4 * n + (i & 3); }

struct Unit { int pm, pn, aux, nt; const char* A; const char* B; };
struct Gemm { int Kb, lda, ldb; int sa, sb; };

__device__ __forceinline__ bool tile_of(int L, int nM, int nN, int& pm, int& pn, int WGM = 4) {
    const int nwg = nM * nN; if (L >= nwg) return false;
    int wgid = L; { const int q = nwg / NXCD, r = nwg % NXCD, xcd = wgid % NXCD, off = wgid / NXCD; wgid = (xcd < r ? xcd * (q + 1) : r * (q + 1) + (xcd - r) * q) + off; }
    const int nig = WGM * nN, gid = wgid / nig, fm = gid * WGM, gsz = (nM - fm) < WGM ? (nM - fm) : WGM;
    pm = fm + ((wgid % nig) % gsz); pn = (wgid % nig) / gsz; return true;
}
struct PlainSched {
    int nM, nN, G, c; const char* A0; const char* B0; size_t astep, bstep; int wgm; int bsplit, badd;
    __device__ __forceinline__ bool next(int i, Unit& u) const { int pm, pn; if (!tile_of(i * G + c, nM, nN, pm, pn, wgm)) return false; u.pm = pm; u.pn = pn; u.aux = 0; u.nt = 0; u.A = A0 + (size_t)pm * astep; u.B = B0 + (size_t)(pn + (pn >= bsplit ? badd : 0)) * bstep; return true; }
};
struct PoolSched {
    int G, c; const char* A0; const char* B0;
    __device__ __forceinline__ bool next(int i, Unit& u) const { int pm, pn; if (!tile_of(i * G + c, M / 256, 4, pm, pn)) return false; u.pm = pm; u.pn = pn; u.aux = 0; u.nt = 0;
        u.A = A0 + (size_t)pm * (256 * 1024 * 2) + (size_t)pn * 512; u.B = B0 + (size_t)pn * (256 * 256 * 2); return true; }
};
struct MergeSched {
    int G, c; const char *A0, *B0, *B2; size_t astr, bstr;
    __device__ __forceinline__ bool next(int i, Unit& u) const { const int t = i / 3, b = i - 3 * t; int pm, pn; if (!tile_of(t * G + c, M / 256, 4, pm, pn)) return false; u.pm = pm; u.pn = pn; u.aux = b; u.nt = 0;
        const char* w = b == 2 ? B2 : B0 + (size_t)b * bstr;
        u.A = A0 + (size_t)b * astr + (size_t)pm * (256 * 1024 * 2); u.B = w + (size_t)pn * (256 * 1024 * 2); return true; }
};
struct FoldSched {
    int G, c; const char *A0, *B0;
    __device__ __forceinline__ bool next(int i, Unit& u) const { const int idx = i * G + c; if (idx >= 32) return false; const int L = idx >> 4, pm = (idx >> 2) & 3, g = idx & 3; u.pm = pm; u.pn = g; u.aux = L; u.nt = 0;
        u.A = A0 + (size_t)L * (6 * MiB) + (size_t)pm * (256 * 1024 * 2) + (size_t)g * 512; u.B = B0 + (size_t)L * (512 * 1024) + (size_t)g * (256 * 256 * 2); return true; }
};
struct GroupSched {
    int nM, nN, G, c; int o1, o2, o3, o4, o5, o6, o7; const char* A0; const char* B0; size_t astep, bstep, estep; int wgm;
    __device__ __forceinline__ bool next(int i, Unit& u) const { int pm, pn; if (!tile_of(i * G + c, nM, nN, pm, pn, wgm)) return false; u.pm = pm; u.pn = pn; u.aux = 0; u.nt = 0;
        const int e = (pm >= o1) + (pm >= o2) + (pm >= o3) + (pm >= o4) + (pm >= o5) + (pm >= o6) + (pm >= o7);
        u.A = A0 + (size_t)pm * astep; u.B = B0 + (size_t)e * estep + (size_t)pn * bstep; return true; }
};

constexpr int MOE2_SPL = 7, MOE2_SNT = 4;
struct Moe2Sched {
    int nM, G, c, R, tail, split; int o1, o2, o3, o4, o5, o6, o7; const char* A0; const char* B0; size_t astep, bstep, estep;
    __device__ __forceinline__ bool next(int i, Unit& u) const {
        int L = i * G + c, part = -1, sub = 0;
        if (split && i >= R) { if (i > R || c >= MOE2_SPL * tail) return false; sub = c; L = R * G + c / MOE2_SPL; part = c % MOE2_SPL; }
        int pm, pn; if (!tile_of(L, nM, 4, pm, pn, 4)) return false; u.pm = pm; u.pn = pn;
        const int e = (pm >= o1) + (pm >= o2) + (pm >= o3) + (pm >= o4) + (pm >= o5) + (pm >= o6) + (pm >= o7);
        u.A = A0 + (size_t)pm * astep; u.B = B0 + (size_t)e * estep + (size_t)pn * bstep; u.aux = 0; u.nt = 0;
        if (part >= 0) { u.A += part * (MOE2_SNT * 128); u.B += part * (MOE2_SNT * 128); u.aux = 1 + sub; u.nt = MOE2_SNT; }
        return true; }
};

typedef f32x4 Acc[2][2][4][2];
__device__ __forceinline__ u32x4 pack8(const f32x4 v0, const f32x4 v1) { u32x4 w; w.x = pk_bf16(v0[0], v0[1]); w.y = pk_bf16(v0[2], v0[3]); w.z = pk_bf16(v1[0], v1[1]); w.w = pk_bf16(v1[2], v1[3]); return w; }
__device__ __forceinline__ f32x4 sig4(const f32x4 v) { f32x4 r; r[0] = sigm(v[0]); r[1] = sigm(v[1]); r[2] = sigm(v[2]); r[3] = sigm(v[3]); return r; }
__device__ __forceinline__ void unpack8(const u32x4 g, f32x4& lo, f32x4& hi) { lo[0] = bf_lo(g.x); lo[1] = bf_hi(g.x); lo[2] = bf_lo(g.y); lo[3] = bf_hi(g.y); hi[0] = bf_lo(g.z); hi[1] = bf_hi(g.z); hi[2] = bf_lo(g.w); hi[3] = bf_hi(g.w); }

__device__ __forceinline__ size_t gate_frag(int pm, int q, int wid, int ai, int m, int lane) { return ((size_t)(((((pm * 12 + q) * 8 + wid) * 2 + ai) * 4 + m) * 64 + lane)) * 16; }
__device__ __forceinline__ unsigned pk_fp8x4_raw(const f32x4 v) { int w = 0; w = __builtin_amdgcn_cvt_pk_fp8_f32(v[0], v[1], w, false); w = __builtin_amdgcn_cvt_pk_fp8_f32(v[2], v[3], w, true); return (unsigned)w; }
__device__ __forceinline__ f32x4 un_fp8x4(unsigned w) { const f32x2 lo = __builtin_amdgcn_cvt_pk_f32_fp8((int)w, false), hi = __builtin_amdgcn_cvt_pk_f32_fp8((int)w, true); return (f32x4){lo[0], lo[1], hi[0], hi[1]}; }
struct EpiProj {
    bf16_t *scb, *scx, *glu, *pu, *gates; const f32x4* ss; int psplit, off_lo, off_hi;
    __device__ __forceinline__ bool operator()(Acc& acc, const Unit& u, int wr, int wc, int fr, int fq) const {
        const int row0 = u.pm * BM + wr * 64 + fr, pn = u.pn + (u.pn >= psplit ? off_hi : off_lo);
        float rs[2][4];
#pragma unroll
        for (int ai = 0; ai < 2; ++ai)
#pragma unroll
            for (int m = 0; m < 4; ++m) { const f32x4 p = ss[row0 + ai * HALF + m * 16]; rs[ai][m] = __builtin_amdgcn_rsqf(((p[0] + p[1]) + (p[2] + p[3])) * (1.0f / D) + RMS_EPS); }
        if (pn >= 4 && pn < 20) {
            const bool isglu = pn >= 12; bf16_t* dst = isglu ? glu : scx; const int col0 = (isglu ? pn - 12 : pn - 4) * 128 + wc * 32 + 8 * fq;
#pragma unroll
            for (int ai = 0; ai < 2; ++ai)
#pragma unroll
                for (int m = 0; m < 4; ++m) { const float r = rs[ai][m];
                    f32x4 a0 = acc[ai][0][m][0] * r, a1 = acc[ai][0][m][1] * r, b0 = acc[ai][1][m][0] * r, b1 = acc[ai][1][m][1] * r;
                    if (isglu) { b0 = sig4(b0); b1 = sig4(b1); }
                    *(u32x4*)(dst + (size_t)(row0 + ai * HALF + m * 16) * D + col0) = pack8(a0 * b0, a1 * b1); }
        } else {
            if (pn >= 24) {
#pragma unroll
                for (int ai = 0; ai < 2; ++ai)
#pragma unroll
                    for (int m = 0; m < 4; ++m) { const float r = -1.44269504f * rs[ai][m]; u32x4 w;
#pragma unroll
                        for (int bj = 0; bj < 2; ++bj) { f32x4 e0 = acc[ai][bj][m][0] * r, e1 = acc[ai][bj][m][1] * r;
#pragma unroll
                            for (int j = 0; j < 4; ++j) { e0[j] = __builtin_amdgcn_exp2f(__builtin_amdgcn_fmed3f(e0[j], -8.65617f, 8.65617f)); e1[j] = __builtin_amdgcn_exp2f(__builtin_amdgcn_fmed3f(e1[j], -8.65617f, 8.65617f)); }
                            w[2 * bj] = pk_fp8x4_raw(e0); w[2 * bj + 1] = pk_fp8x4_raw(e1); }
                        *(u32x4*)((unsigned char*)gates + gate_frag(u.pm, pn - 24, wr * 4 + wc, ai, m, fr + 16 * fq)) = w; }
            } else {
            bf16_t* dst = pn < 4 ? scb : pu; const int ldc = D, colb = (pn < 4 ? pn : pn - 20) * 256;
            const int col0 = colb + wc * 32 + 8 * fq;
#pragma unroll
            for (int ai = 0; ai < 2; ++ai)
#pragma unroll
                for (int m = 0; m < 4; ++m) { const float r = rs[ai][m]; bf16_t* rowp = dst + (size_t)(row0 + ai * HALF + m * 16) * ldc + col0;
#pragma unroll
                    for (int bj = 0; bj < 2; ++bj) *(u32x4*)(rowp + bj * HALF) = pack8(acc[ai][bj][m][0] * r, acc[ai][bj][m][1] * r); }
            }
        }
        return false;
    }
};
struct EpiPlain {
    bf16_t* Ob; int ldc; size_t aux_stride;
    __device__ __forceinline__ bool operator()(Acc& acc, const Unit& u, int wr, int wc, int fr, int fq) const {
        bf16_t* O = Ob + (size_t)u.aux * aux_stride;
        const int row0 = u.pm * BM + wr * 64 + fr, col0 = u.pn * BM + wc * 32 + 8 * fq;
#pragma unroll
        for (int ai = 0; ai < 2; ++ai)
#pragma unroll
            for (int m = 0; m < 4; ++m) { bf16_t* rowp = O + (size_t)(row0 + ai * HALF + m * 16) * ldc + col0;
#pragma unroll
                for (int bj = 0; bj < 2; ++bj) *(u32x4*)(rowp + bj * HALF) = pack8(acc[ai][bj][m][0], acc[ai][bj][m][1]); }
        return false;
    }
};
struct EpiMoe2 {
    bf16_t* Y; bf16_t* YP;
    __device__ __forceinline__ bool operator()(Acc& acc, const Unit& u, int wr, int wc, int fr, int fq) const {
        bf16_t* O; int ldc;
        if (u.aux) { O = YP + (size_t)(u.aux - 1) * 65536 + (size_t)(wr * 64 + fr) * 256 + wc * 32 + 8 * fq; ldc = 256; }
        else { O = Y + (size_t)(u.pm * BM + wr * 64 + fr) * D + u.pn * BM + wc * 32 + 8 * fq; ldc = D; }
#pragma unroll
        for (int ai = 0; ai < 2; ++ai)
#pragma unroll
            for (int m = 0; m < 4; ++m) { bf16_t* rowp = O + (size_t)(ai * HALF + m * 16) * ldc;
#pragma unroll
                for (int bj = 0; bj < 2; ++bj) *(u32x4*)(rowp + bj * HALF) = pack8(acc[ai][bj][m][0], acc[ai][bj][m][1]); }
        return false;
    }
};
struct EpiMerge {
    const bf16_t* gates; bf16_t* O;
    __device__ __forceinline__ bool operator()(Acc& acc, const Unit& u, int wr, int wc, int fr, int fq) const {
        const int row0 = u.pm * BM + wr * 64 + fr, col0 = u.pn * BM + wc * 32 + 8 * fq, b = u.aux;
#pragma unroll
        for (int ai = 0; ai < 2; ++ai)
#pragma unroll
            for (int m = 0; m < 4; ++m) { const size_t row = (size_t)(row0 + ai * HALF + m * 16);
                const unsigned char* gp = (const unsigned char*)gates + gate_frag(u.pm, 4 * b + u.pn, wr * 4 + wc, ai, m, fr + 16 * fq);
                const u32x4 gw = *(const u32x4*)gp;
                if (b < 2) { const u32x4 hw = *(const u32x4*)(gp + gate_frag(0, 4, 0, 0, 0, 0));
#pragma unroll
                    for (int bj = 0; bj < 2; ++bj) { const f32x4 g0 = un_fp8x4(gw[2 * bj]), g1 = un_fp8x4(gw[2 * bj + 1]), h0 = un_fp8x4(hw[2 * bj]), h1 = un_fp8x4(hw[2 * bj + 1]);
#pragma unroll
                        for (int j = 0; j < 4; ++j) { acc[ai][bj][m][0][j] *= (1.f + h0[j]) * __builtin_amdgcn_rcpf(1.f + g0[j]); acc[ai][bj][m][1][j] *= (1.f + h1[j]) * __builtin_amdgcn_rcpf(1.f + g1[j]); } }
                } else {
#pragma unroll
                    for (int bj = 0; bj < 2; ++bj) { f32x4 g0 = un_fp8x4(gw[2 * bj]), g1 = un_fp8x4(gw[2 * bj + 1]);
#pragma unroll
                        for (int j = 0; j < 4; ++j) { g0[j] = __builtin_amdgcn_rcpf(1.f + g0[j]); g1[j] = __builtin_amdgcn_rcpf(1.f + g1[j]); }
                        *(u32x4*)(O + row * D + col0 + bj * HALF) = pack8(acc[ai][bj][m][0] * g0, acc[ai][bj][m][1] * g1); } } }
        return b < 2;
    }
};
struct EpiResid {
    const float* base32; bf16_t* xb; float* ssp; LAS float* red; unsigned char* x8;
    __device__ __forceinline__ bool operator()(Acc& acc, const Unit& u, int wr, int wc, int fr, int fq) const {
        const int row0 = u.pm * BM + wr * 64 + fr, col0 = u.pn * BM + wc * 32 + 8 * fq;
#pragma unroll
        for (int ai = 0; ai < 2; ++ai)
#pragma unroll
            for (int m = 0; m < 4; ++m) { const size_t row = (size_t)(row0 + ai * HALF + m * 16); float q = 0.f;
#pragma unroll
                for (int bj = 0; bj < 2; ++bj) { const size_t off = row * D + col0 + bj * HALF;
                    f32x4 b0, b1; if (base32) { b0 = *(const f32x4*)(base32 + off); b1 = *(const f32x4*)(base32 + off + 4); } else unpack8(*(const u32x4*)(xb + off), b0, b1);
                    const u32x4 pk = pack8(b0 + acc[ai][bj][m][0], b1 + acc[ai][bj][m][1]); *(u32x4*)(xb + off) = pk;
                    f32x4 o0, o1; unpack8(pk, o0, o1); if (x8) *(u32x2*)(x8 + off) = (u32x2){pk_fp8x4(o0), pk_fp8x4(o1)};
                    q += (o0[0] * o0[0] + o0[1] * o0[1]) + (o0[2] * o0[2] + o0[3] * o0[3]) + (o1[0] * o1[0] + o1[1] * o1[1]) + (o1[2] * o1[2] + o1[3] * o1[3]); }
                q += __shfl_xor(q, 16); q += __shfl_xor(q, 32);
                if (fq == 0) red[(ai * HALF + wr * 64 + m * 16 + fr) * 4 + wc] = q; }
        asm volatile("s_waitcnt lgkmcnt(0)" ::: "memory"); __builtin_amdgcn_s_barrier(); asm volatile("" ::: "memory");
        int tid = threadIdx.x; asm volatile("" : "+v"(tid));
        if (tid < 256) { const f32x4 v = *(const LAS f32x4*)(red + tid * 4); ssp[(size_t)(u.pm * BM + tid) * 4 + u.pn] = (v[0] + v[1]) + (v[2] + v[3]); }
        return false;
    }
};
template <bool PART4, bool OUT8> struct EpiSwiGLU {
    bf16_t* O; int ldc; const float* ss;
    __device__ __forceinline__ bool operator()(Acc& acc, const Unit& u, int wr, int wc, int fr, int fq) const {
        const int row0 = u.pm * BM + wr * 64 + fr, col0 = u.pn * 128 + wc * 32 + 8 * fq;
#pragma unroll
        for (int ai = 0; ai < 2; ++ai)
#pragma unroll
            for (int m = 0; m < 4; ++m) { const size_t row = (size_t)(row0 + ai * HALF + m * 16); float r = 1.f;
                if (PART4) { const f32x4 p = *(const f32x4*)(ss + row * 4); r = __builtin_amdgcn_rsqf(((p[0] + p[1]) + (p[2] + p[3])) * (1.0f / D) + RMS_EPS); }
                const f32x4 a0 = acc[ai][0][m][0] * r, a1 = acc[ai][0][m][1] * r, c0 = acc[ai][1][m][0] * r, c1 = acc[ai][1][m][1] * r;
                const f32x4 h0 = a0 * sig4(a0) * c0, h1 = a1 * sig4(a1) * c1;
                if (OUT8) { *(u32x2*)((unsigned char*)O + row * ldc + col0) = (u32x2){pk_fp8x4(h0 * F8_ACT_MUL), pk_fp8x4(h1 * F8_ACT_MUL)}; }
                else *(u32x4*)(O + row * ldc + col0) = pack8(h0, h1); }
        return false;
    }
};

typedef int i32x4 __attribute__((ext_vector_type(4)));
typedef int i32x8 __attribute__((ext_vector_type(8)));
__device__ __forceinline__ i32x8 join16(const bf16x8 lo, const bf16x8 hi) { return __builtin_shufflevector(__builtin_bit_cast(i32x4, lo), __builtin_bit_cast(i32x4, hi), 0, 1, 2, 3, 4, 5, 6, 7); }
template <class Epi, class Sched, bool F8 = false>
__device__ __forceinline__ void gemm_phase(LAS unsigned char* lds, const Gemm g, const Sched& S, const Epi& E) {
    int tid_ = threadIdx.x; asm volatile("" : "+v"(tid_));
    const int tid = tid_, wid = __builtin_amdgcn_readfirstlane(tid >> 6), lane = tid & 63, wr = wid >> 2, wc = wid & 3, fr = lane & 15, fq = lane >> 4;
    const int nt = g.Kb / 128;
    int vsa = g.sa, vsb = g.sb; asm volatile("" : "+v"(vsa), "+v"(vsb));
    unsigned voffA[2], voffB[2];
#pragma unroll
    for (int i = 0; i < 2; ++i) { int R, C; stage_rc(tid * 16 + i * 8192, R, C); const int Rb = (R & ~31) + perm32(R & 31);
        voffA[i] = (unsigned)(R * g.lda + C * 2); voffB[i] = (unsigned)(Rb * g.ldb + C * 2); }
    const size_t kstep = (size_t)(BK * 2);
    const size_t hstepA = (size_t)HALF * g.lda, hstepB = (size_t)HALF * g.ldb;
    const unsigned ldsw = (unsigned)wid * 1024u;
    const int aoff = lds_byte(wr * 64 + fr, fq * 8), boff = lds_byte(wc * 32 + fr, fq * 8);
#define PG8_SA(b, h) (((b) * 2 + (h)) * HTB)
#define PG8_SB(b, h) ((4 + (b) * 2 + (h)) * HTB)
#define PG8_STAGE(bufoff, gbase, voff) do { _Pragma("unroll") for (int _i = 0; _i < 2; ++_i) \
        __builtin_amdgcn_global_load_lds((const unsigned*)((const char*)(gbase) + (voff)[_i]), (LAS unsigned*)(lds + (bufoff) + ldsw + _i * 8192), 16, 0, 0); } while (0)
#define PG8_LDA(dst, b, h) do { _Pragma("unroll") for (int m = 0; m < 4; ++m) _Pragma("unroll") for (int k = 0; k < 2; ++k) dst[m][k] = *(const LAS bf16x8*)(lds + PG8_SA(b, h) + aoff + m * 2048 + k * 1024); } while (0)
#define PG8_LDB(dst, b, h) do { _Pragma("unroll") for (int n = 0; n < 2; ++n) _Pragma("unroll") for (int k = 0; k < 2; ++k) dst[n][k] = *(const LAS bf16x8*)(lds + PG8_SB(b, h) + boff + n * 2048 + k * 1024); } while (0)
#define PG8_MMA(ai, bj, At, Bt) do { __builtin_amdgcn_s_setprio(1); _Pragma("unroll") for (int m = 0; m < 4; ++m) _Pragma("unroll") for (int n = 0; n < 2; ++n) { \
        if constexpr (F8) { const i32x8 b8_ = join16(Bt[n][0], Bt[n][1]), a8_ = join16(At[m][0], At[m][1]); \
            asm volatile("v_mfma_scale_f32_16x16x128_f8f6f4 %0, %1, %2, %0, %3, %4 op_sel_hi:[0,0,0]" : "+v"(acc[ai][bj][m][n]) : "v"(b8_), "v"(a8_), "v"(vsb), "v"(vsa)); } \
        else { _Pragma("unroll") for (int k = 0; k < 2; ++k) acc[ai][bj][m][n] = __builtin_amdgcn_mfma_f32_16x16x32_bf16(Bt[n][k], At[m][k], acc[ai][bj][m][n], 0, 0, 0); } } __builtin_amdgcn_s_setprio(0); } while (0)
#define PG8_WAIT_V(n) asm volatile("s_waitcnt vmcnt(" #n ")" ::: "memory")
#define PG8_WAIT_L(n) asm volatile("s_waitcnt lgkmcnt(" #n ")" ::: "memory")
#define PG8_BAR __builtin_amdgcn_s_barrier()
#define PG8_SCHED __builtin_amdgcn_sched_barrier(0)
    Unit cur, nxt; int ui = 0;
    if (!S.next(0, cur)) return;
    Acc acc;
#pragma unroll
    for (int a = 0; a < 2; ++a)
#pragma unroll
        for (int b = 0; b < 2; ++b)
#pragma unroll
            for (int m = 0; m < 4; ++m)
#pragma unroll
                for (int n = 0; n < 2; ++n) acc[a][b][m][n] = (f32x4){0.f, 0.f, 0.f, 0.f};
    bf16x8 At[4][2], B0[2][2], B1[2][2];
    const char* cA = cur.A; const char* cB = cur.B;
    PG8_STAGE(PG8_SB(0, 0), cB, voffB); PG8_STAGE(PG8_SB(0, 1), cB + hstepB, voffB); PG8_STAGE(PG8_SA(0, 0), cA, voffA); PG8_STAGE(PG8_SA(0, 1), cA + hstepA, voffA);
    if (wr == 1) PG8_BAR;
    PG8_WAIT_V(2); PG8_BAR;
    PG8_STAGE(PG8_SB(1, 0), cB + kstep, voffB); PG8_STAGE(PG8_SA(1, 0), cA + kstep, voffA); PG8_STAGE(PG8_SB(1, 1), cB + hstepB + kstep, voffB);
    PG8_WAIT_V(6); PG8_BAR;
    for (;;) {
        const bool has_next = S.next(ui + 1, nxt);
        const char* nA = has_next ? nxt.A : cA; const char* nB = has_next ? nxt.B : cB;
        const int unt = cur.nt ? cur.nt : nt;
#pragma nounroll
        for (int t = 0; t < unt; t += 2) {
            const bool last = (t == unt - 2);
            const char* a1 = cA + (size_t)(t + 1) * kstep;
            const char* a2 = last ? nA : cA + (size_t)(t + 2) * kstep; const char* b2 = last ? nB : cB + (size_t)(t + 2) * kstep;
            const char* a3 = a2 + kstep; const char* b3 = b2 + kstep;
            PG8_LDB(B0, 0, 0); PG8_LDB(B1, 0, 1); PG8_SCHED; PG8_LDA(At, 0, 0); PG8_STAGE(PG8_SA(1, 1), a1 + hstepA, voffA);
            PG8_WAIT_V(8); PG8_WAIT_L(0); PG8_BAR; PG8_MMA(0, 0, At, B0); PG8_MMA(0, 1, At, B1); PG8_BAR; PG8_SCHED;
            PG8_LDA(At, 0, 1); PG8_STAGE(PG8_SB(0, 0), b2, voffB); PG8_STAGE(PG8_SB(0, 1), b2 + hstepB, voffB); PG8_STAGE(PG8_SA(0, 0), a2, voffA);
            PG8_WAIT_V(8); PG8_WAIT_L(0); PG8_BAR; PG8_MMA(1, 0, At, B0); PG8_MMA(1, 1, At, B1); PG8_BAR; PG8_SCHED;
            PG8_LDB(B0, 1, 0); PG8_LDB(B1, 1, 1); PG8_SCHED; PG8_LDA(At, 1, 0); PG8_STAGE(PG8_SA(0, 1), a2 + hstepA, voffA);
            PG8_WAIT_V(8); PG8_WAIT_L(0); PG8_BAR; PG8_MMA(0, 0, At, B0); PG8_MMA(0, 1, At, B1); PG8_BAR; PG8_SCHED;
            PG8_LDA(At, 1, 1); PG8_STAGE(PG8_SB(1, 0), b3, voffB); PG8_STAGE(PG8_SB(1, 1), b3 + hstepB, voffB); PG8_STAGE(PG8_SA(1, 0), a3, voffA);
            PG8_WAIT_V(8); PG8_WAIT_L(0); PG8_BAR; PG8_MMA(1, 0, At, B0); PG8_MMA(1, 1, At, B1); PG8_BAR; PG8_SCHED;
        }
        if constexpr (F8) asm volatile("s_nop 15\n\ts_nop 15" ::: "memory");
        if (wr == 0) PG8_BAR;
        const bool keep = E(acc, cur, wr, wc, fr, fq);
        if (!has_next) break;
        if (!keep) {
#pragma unroll
            for (int a = 0; a < 2; ++a)
#pragma unroll
                for (int b = 0; b < 2; ++b)
#pragma unroll
                    for (int m = 0; m < 4; ++m)
#pragma unroll
                        for (int n = 0; n < 2; ++n) acc[a][b][m][n] = (f32x4){0.f, 0.f, 0.f, 0.f};
        }
        cur = nxt; cA = nA; cB = nB; ++ui;
        if (wr == 1) PG8_BAR;
    }
    PG8_WAIT_V(0);
    PG8_BAR;
#undef PG8_SA
#undef PG8_SB
#undef PG8_STAGE
#undef PG8_LDA
#undef PG8_LDB
#undef PG8_MMA
#undef PG8_WAIT_V
#undef PG8_WAIT_L
#undef PG8_BAR
#undef PG8_SCHED
}
}

constexpr int RING_BYTES = 131072, MISC_OFF = RING_BYTES, RED_OFF = RING_BYTES + 1024, LDS_BYTES = 147456;

#define XB_TMO      128
#define XB_XCNT(j)  (256  + 64 * (j))
#define XB_XSUB(j)  (1280 + 64 * (j))
#define XB_XGEN(j)  (2304 + 64 * (j))
#define XB_TOP      3328
#define XB_TOPGEN   3392
#define XCD_BAR_WORDS 3456
#define XB_SPIN_CAP (1u << 18)
__device__ __forceinline__ unsigned xb_ld(unsigned* p)              { return __hip_atomic_load(p, __ATOMIC_RELAXED, __HIP_MEMORY_SCOPE_AGENT); }
__device__ __forceinline__ unsigned xb_add(unsigned* p, unsigned v) { return __hip_atomic_fetch_add(p, v, __ATOMIC_RELAXED, __HIP_MEMORY_SCOPE_AGENT); }
__device__ __forceinline__ unsigned xb_xcc_id() { return (unsigned)__builtin_amdgcn_s_getreg((3 << 11) | 20) & 0xFu; }
#define XB_SPIN(cond, bar) do { unsigned _sp = 0; while (cond) { __builtin_amdgcn_s_sleep(1); \
    if ((++_sp & 255u) == 0u) { if (xb_ld(&(bar)[XB_TMO])) break; if (_sp > XB_SPIN_CAP) { atomicAdd(&(bar)[XB_TMO], 1u); break; } } } } while (0)
struct XcdBarrier { unsigned* bar; unsigned x; volatile LAS unsigned* st; };
__device__ __forceinline__ XcdBarrier xcd_barrier_post(unsigned* bar, volatile LAS unsigned* st) {
    XcdBarrier b; b.bar = bar; b.x = xb_xcc_id(); b.st = st;
    if (threadIdx.x == 0) (void)xb_add(&bar[XB_XCNT(b.x)], 1u);
    return b;
}
__device__ __forceinline__ void xcd_barrier_complete(unsigned* bar, unsigned x, unsigned& nloc, unsigned& nx) {
    const unsigned G = gridDim.x * gridDim.y * gridDim.z;
    unsigned sum, cnt, mine, sp = 0u;
    for (;;) {
        sum = 0u; cnt = 0u; mine = 0u;
#pragma nounroll
        for (unsigned j = 0; j < 16; ++j) { const unsigned c = xb_ld(&bar[XB_XCNT(j)]); sum += c; cnt += (c > 0u) ? 1u : 0u; mine = (j == x) ? c : mine; }
        if (sum == G) break;
        __builtin_amdgcn_s_sleep(1);
        if ((++sp & 255u) == 0u) { if (xb_ld(&bar[XB_TMO])) break; if (sp > XB_SPIN_CAP) { atomicAdd(&bar[XB_TMO], 1u); break; } }
    }
    nloc = mine > 0u ? mine : 1u; nx = cnt > 0u ? cnt : 1u;
}
__device__ __forceinline__ void xcd_barrier(const XcdBarrier& b) {
    asm volatile("s_waitcnt vmcnt(0)" ::: "memory");
    __syncthreads();
    if (threadIdx.x == 0) {
        unsigned* bar = b.bar;
        __builtin_amdgcn_s_waitcnt(0);
        unsigned nloc = b.st[0], nx = b.st[1];
        if (nloc == 0u) { xcd_barrier_complete(bar, b.x, nloc, nx); b.st[0] = nloc; b.st[1] = nx; }
        const unsigned old = xb_add(&bar[XB_XSUB(b.x)], 1u);
        const unsigned gen = old / nloc;
        if (old + 1u == (gen + 1u) * nloc) {
            __builtin_amdgcn_fence(__ATOMIC_RELEASE, "agent");
            asm volatile("s_waitcnt vmcnt(0)" ::: "memory");
            const unsigned og = xb_add(&bar[XB_TOP], 1u);
            const unsigned tg = og / nx;
            if (og + 1u == (tg + 1u) * nx) xb_add(&bar[XB_TOPGEN], 1u);
            else XB_SPIN(xb_ld(&bar[XB_TOPGEN]) == tg, bar);
            __builtin_amdgcn_fence(__ATOMIC_ACQUIRE, "agent");
            xb_add(&bar[XB_XGEN(b.x)], 1u);
            asm volatile("s_waitcnt vmcnt(0)" ::: "memory");
        } else {
            XB_SPIN(xb_ld(&bar[XB_XGEN(b.x)]) == gen, bar);
            __builtin_amdgcn_fence(__ATOMIC_ACQUIRE, "agent");
            asm volatile("s_waitcnt vmcnt(0)" ::: "memory");
        }
    }
    __syncthreads();
}

struct Args { const float* in[23]; float* out; unsigned char* ws; int ph_lo, ph_hi; };
static_assert(sizeof(Args) == 23 * 8 + 8 + 8 + 8, "Args has no padding");
typedef const __attribute__((address_space(4))) Args* KArgs;
__device__ __forceinline__ KArgs kargs() { KArgs p = (KArgs)__builtin_amdgcn_kernarg_segment_ptr(); asm volatile("" : "+s"(p)); return p; }

__device__ __forceinline__ void transpose_item(const float* src, int ldn, int k0, int n0, bf16_t* dst, int ldk, const float* kscale, const float* nscale, int lane) {
    const int r4 = lane >> 4, q = lane & 15;
    f32x4 v[16];
    const float* sp = src + (size_t)(k0 + 16 * r4) * ldn + n0 + 4 * q;
#pragma unroll
    for (int i = 0; i < 16; ++i) v[i] = __builtin_nontemporal_load((const f32x4*)(sp + (size_t)i * ldn));
    f32x4 ns = (f32x4){1.f, 1.f, 1.f, 1.f}; if (nscale) ns = *(const f32x4*)(nscale + n0 + 4 * q);
    if (kscale) {
        const f32x4* kp = (const f32x4*)(kscale + k0 + 16 * r4);
#pragma unroll
        for (int g = 0; g < 4; ++g) { const f32x4 ks = kp[g];
#pragma unroll
            for (int j = 0; j < 4; ++j) v[4 * g + j] = v[4 * g + j] * ks[j]; }
    }
#pragma unroll
    for (int e = 0; e < 4; ++e) { u32x4 lo, hi;
#pragma unroll
        for (int w = 0; w < 4; ++w) { lo[w] = pk_bf16(v[2 * w][e] * ns[e], v[2 * w + 1][e] * ns[e]); hi[w] = pk_bf16(v[8 + 2 * w][e] * ns[e], v[9 + 2 * w][e] * ns[e]); }
        bf16_t* o = dst + (size_t)(4 * q + e) * ldk + k0 + 16 * r4; *(u32x4*)o = lo; *(u32x4*)(o + 8) = hi; }
}
__device__ __forceinline__ void transpose_item_f8(const float* src, int ldn, int k0, int n0, unsigned char* dst, int ldk, const float* kscale, float mul, int lane) {
    const int r4 = lane >> 4, q = lane & 15;
    f32x4 v[16];
    const float* sp = src + (size_t)(k0 + 16 * r4) * ldn + n0 + 4 * q;
#pragma unroll
    for (int i = 0; i < 16; ++i) v[i] = __builtin_nontemporal_load((const f32x4*)(sp + (size_t)i * ldn));
    {
        const f32x4* kp = (const f32x4*)(kscale + k0 + 16 * r4);
#pragma unroll
        for (int g = 0; g < 4; ++g) { f32x4 ks = (f32x4){mul, mul, mul, mul}; if (kscale) ks = kp[g] * mul;
#pragma unroll
            for (int j = 0; j < 4; ++j) v[4 * g + j] = v[4 * g + j] * ks[j]; }
    }
#pragma unroll
    for (int e = 0; e < 4; ++e) { u32x4 o;
#pragma unroll
        for (int w = 0; w < 4; ++w) o[w] = pk_fp8x4((f32x4){v[4 * w][e], v[4 * w + 1][e], v[4 * w + 2][e], v[4 * w + 3][e]});
        *(u32x4*)(dst + (size_t)(4 * q + e) * ldk + k0 + 16 * r4) = o; }
}
__device__ __forceinline__ int win_row(int n0) {
    const int seg = n0 >> 10, c = n0 & 1023;
    if (seg == 1 || seg == 2) return 1024 + (c >> 7) * 256 + (seg == 2 ? 128 : 0) + (c & 127);
    if (seg == 3 || seg == 4) return 3072 + (c >> 7) * 256 + (seg == 4 ? 128 : 0) + (c & 127);
    return n0;
}
__device__ __forceinline__ int pair_row(int f, int second) { return (f >> 7) * 256 + (second ? 128 : 0) + (f & 127); }

__device__ __forceinline__ void prologue_phase(KArgs a, LAS unsigned char* lds, int wid, int lane) {
    asm volatile("" : "+v"(lane));
    const int gw = blockIdx.x * 8 + wid, NGW = gridDim.x * 8;
    unsigned char* ws = a->ws;
    constexpr int I_WIN = 16 * 144, I_SQ = 16 * 16, I_PW = 16, I_D1 = 16 * 56, I_D2 = 56 * 16;
    constexpr int NIT = 2 * I_WIN + 8 * I_SQ + 8 * I_PW + 2 * I_D1 + I_D2;
    for (int it = gw; it < NIT; it += NGW) {
        int r = it;
        if (r < 2 * I_WIN) { const int L = r / I_WIN; r -= L * I_WIN; const int kb = r / 144, nb = r % 144, n0 = 64 * nb;
            if (n0 >= 6144 || (n0 >= 3072 && n0 < 5120)) transpose_item_f8(a->in[2] + (size_t)L * D * INC, INC, 64 * kb, n0, ws + WS_WG8 + (size_t)L * 5 * MiB + (size_t)(n0 >= 6144 ? 2048 + (n0 - 6144) : win_row(n0) - 3072) * D, D, a->in[1] + L * D, F8_W13_MUL, lane);
            else transpose_item(a->in[2] + (size_t)L * D * INC, INC, 64 * kb, n0, (bf16_t*)(ws + WS_W0 + W0_WIN + (size_t)L * 18 * MiB) + (size_t)win_row(n0) * D, D, a->in[1] + L * D, nullptr, lane);
            continue; }
        r -= 2 * I_WIN;
        if (r < 8 * I_SQ) { const int j = r / I_SQ; r -= j * I_SQ; const int L = j >> 2, w = j & 3, kb = r / 16, nb = r % 16, n0 = 64 * nb;
            bf16_t* dst = w < 3 ? (bf16_t*)(ws + WS_W0 + W0_WOUT + (size_t)(L * 3 + w) * 2 * MiB) : (bf16_t*)(ws + WS_W0 + W0_WO + (size_t)L * 2 * MiB);
            transpose_item(a->in[10 + w] + (size_t)L * D * D, D, 64 * kb, n0, dst + (size_t)n0 * D, D, nullptr, nullptr, lane); continue; }
        r -= 8 * I_SQ;
        if (r < 8 * I_PW) { const int j = r / I_PW; r -= j * I_PW; const int L = j >> 2, g = j & 3;
            const float* src = a->in[8] + (size_t)(L * 4 + g) * 65536 + (size_t)r * 16 * 256; const float* sc = a->in[9] + L * D + g * 256;
            bf16_t* dst = (bf16_t*)(ws + WS_W0 + W0_POOL + (size_t)L * 512 * 1024) + (size_t)g * 65536 + (size_t)r * 16 * 256; const f32x4 s4 = *(const f32x4*)(sc + 4 * lane);
#pragma unroll
            for (int i = 0; i < 16; ++i) { const f32x4 v = *(const f32x4*)(src + i * 256 + 4 * lane) * s4; u32x2 w; w.x = pk_bf16(v[0], v[1]); w.y = pk_bf16(v[2], v[3]); *(u32x2*)(dst + i * 256 + 4 * lane) = w; }
            continue; }
        r -= 8 * I_PW;
        if (r < 2 * I_D1) { const int w = r / I_D1; r -= w * I_D1; const int kb = r / 56, nb = r % 56, n0 = 64 * nb;
            transpose_item(a->in[15 + w], DFF, 64 * kb, n0, (bf16_t*)(ws + WS_W0 + W0_D13) + (size_t)pair_row(n0, w) * D, D, a->in[14], nullptr, lane); continue; }
        r -= 2 * I_D1;
        { const int kb = r / 16, nb = r % 16, n0 = 64 * nb;
            transpose_item(a->in[17], D, 64 * kb, n0, (bf16_t*)(ws + WS_W0 + W0_D2) + (size_t)n0 * DFF, DFF, nullptr, nullptr, lane); }
    }
    const float* x = a->in[0]; bf16_t* xb = (bf16_t*)(ws + WS_XB); f32x4* ss0 = (f32x4*)(ws + WS_SS); unsigned char* x8 = ws + WS_X8;
    for (int m = gw; m < M; m += NGW) {
        const f32x4* xr = (const f32x4*)(x + (size_t)m * D) + lane; u32x2* o = (u32x2*)(xb + (size_t)m * D) + lane; float s = 0.f;
#pragma unroll
        for (int j = 0; j < 4; ++j) { const f32x4 v = xr[64 * j]; s += (v[0] * v[0] + v[1] * v[1]) + (v[2] * v[2] + v[3] * v[3]); u32x2 w; w.x = pk_bf16(v[0], v[1]); w.y = pk_bf16(v[2], v[3]); o[64 * j] = w;
            *((unsigned*)(x8 + (size_t)m * D) + lane + 64 * j) = pk_fp8x4(v); }
        s = wave_sum(s); if (lane == 0) ss0[m] = (f32x4){s, 0.f, 0.f, 0.f};
    }
}

__device__ __forceinline__ void dma_block16(const bf16_t* src, LAS unsigned char* dst, int wid, int lane) {
#pragma unroll
    for (int k = 0; k < 4; ++k) { const int h = wid * 4 + k;
        __builtin_amdgcn_global_load_lds((const unsigned*)((const char*)src + h * 1024 + lane * 16), (LAS unsigned*)(dst + h * 1024), 16, 0, 0); }
}
__device__ __forceinline__ void zero_block16(LAS unsigned char* dst, int tid) {
#pragma unroll
    for (int k = 0; k < 4; ++k) *(LAS u32x4*)(dst + (size_t)(tid + 512 * k) * 16) = (u32x4){0u, 0u, 0u, 0u};
}
template <int I> __device__ __forceinline__ void conv31_pair(const LAS unsigned char* col, const unsigned (&wp)[31], f32x2 bias, f32x2 (&acc)[16]) {
    f32x2 x[46];
#pragma unroll
    for (int i = 0; i < 46; ++i) { const int r = i - 30, j = I + (r >> 4); const unsigned u = *(const LAS unsigned*)(col + ((j + 2) & 3) * 32768 + (r & 15) * 2048); x[i] = (f32x2){bf_lo(u), bf_hi(u)}; }
#pragma unroll
    for (int j = 0; j < 16; ++j) acc[j] = bias;
#pragma unroll
    for (int k = 0; k < 31; ++k) { const f32x2 wk = (f32x2){bf_lo(wp[k]), bf_hi(wp[k])};
#pragma unroll
        for (int j = 0; j < 16; ++j) acc[j] = __builtin_elementwise_fma(wk, x[j + k], acc[j]); }
}
template <int I, int CH> __device__ __forceinline__ void pool_ch(const LAS unsigned char* col, int g, int s0, float (&p)[16]) {
    float x[31], tv[16];
#pragma unroll
    for (int i = 0; i < 31; ++i) { const int r = i - 15, j = I + (r >> 4); const unsigned u = *(const LAS unsigned*)(col + ((j + 1) % 3) * 32768 + (r & 15) * 2048); x[i] = CH ? bf_hi(u) : bf_lo(u); }
#pragma unroll
    for (int j = 0; j < 16; ++j) tv[j] = x[15 + j];
#pragma unroll
    for (int i = 30; i >= 1; --i) x[i] += x[i - 1];
    if (g >= 1) {
#pragma unroll
        for (int i = 30; i >= 2; --i) x[i] += x[i - 2]; }
    if (g >= 2) {
#pragma unroll
        for (int i = 30; i >= 4; --i) x[i] += x[i - 4]; }
    if (g >= 3) {
#pragma unroll
        for (int i = 30; i >= 8; --i) x[i] += x[i - 8]; }
    const int w = 2 << g;
#pragma unroll
    for (int j = 0; j < 16; ++j) { const int cnt = min(s0 + j + 1, w); p[j] = x[15 + j] * (1.0f / (float)cnt) - tv[j]; }
}
struct ConvB { const bf16_t* GLU; __amdgpu_buffer_rsrc_t rVB; LAS unsigned char* lds; LAS float* red; LAS float* stat; f32x2 bb, gg, be; };
template <int I> __device__ __forceinline__ void convB_tile(const ConvB& c, unsigned (&wp)[31], int T0, int tid, int wid, int lane) {
    const int t0 = T0 + 16 * I; const LAS unsigned char* col = c.lds + 4 * tid;
#pragma unroll
    for (int k = 0; k < 31; ++k) asm volatile("" : "+v"(wp[k]));
    if (I < 3) dma_block16(c.GLU + (size_t)(t0 + 16) * D, c.lds + ((I + 3) & 3) * 32768, wid, lane);
    float a0[16], a1[16];
    { f32x2 ap[16]; conv31_pair<I>(col, wp, c.bb, ap);
#pragma unroll
      for (int j = 0; j < 16; ++j) { a0[j] = ap[j].x; a1[j] = ap[j].y; } }
    {
        float v[32];
#pragma unroll
        for (int j = 0; j < 16; ++j) { v[j] = a0[j] + a1[j]; v[16 + j] = a0[j] * a0[j] + a1[j] * a1[j]; }
#pragma unroll
        for (int i = 0; i < 16; ++i) { const bool b = lane & 32; const float send = b ? v[i] : v[i + 16], keep = b ? v[i + 16] : v[i]; v[i] = keep + __shfl_xor(send, 32); }
#pragma unroll
        for (int i = 0; i < 8; ++i) { const bool b = lane & 16; const float send = b ? v[i] : v[i + 8], keep = b ? v[i + 8] : v[i]; v[i] = keep + __shfl_xor(send, 16); }
#pragma unroll
        for (int i = 0; i < 4; ++i) { const bool b = lane & 8; const float send = b ? v[i] : v[i + 4], keep = b ? v[i + 4] : v[i]; v[i] = keep + __shfl_xor(send, 8); }
#pragma unroll
        for (int i = 0; i < 2; ++i) { const bool b = lane & 4; const float send = b ? v[i] : v[i + 2], keep = b ? v[i + 2] : v[i]; v[i] = keep + __shfl_xor(send, 4); }
        { const bool b = lane & 2; const float send = b ? v[0] : v[1], keep = b ? v[1] : v[0]; v[0] = keep + __shfl_xor(send, 2); }
        v[0] += __shfl_xor(v[0], 1);
        const int idx = ((lane >> 5) & 1) * 16 + ((lane >> 4) & 1) * 8 + ((lane >> 3) & 1) * 4 + ((lane >> 2) & 1) * 2 + ((lane >> 1) & 1);
        if (!(lane & 1)) c.red[wid * 32 + idx] = v[0];
    }
    __syncthreads();
    if (tid < 16) { float s = 0.f, q = 0.f;
#pragma unroll
        for (int w = 0; w < 8; ++w) { s += c.red[w * 32 + tid]; q += c.red[w * 32 + 16 + tid]; }
        const float mean = s * (1.0f / D), var = fmaxf(q * (1.0f / D) - mean * mean, 0.f);
        c.stat[2 * tid] = mean; c.stat[2 * tid + 1] = __builtin_amdgcn_rsqf(var + LN_EPS); }
    asm volatile("s_waitcnt vmcnt(0)" ::: "memory");
    __syncthreads();
#pragma unroll
    for (int j = 0; j < 16; ++j) { const float mean = c.stat[2 * j], rstd = c.stat[2 * j + 1];
        const float y0 = (a0[j] - mean) * rstd * c.gg.x + c.be.x, y1 = (a1[j] - mean) * rstd * c.gg.y + c.be.y;
        __builtin_amdgcn_raw_buffer_store_b32(pk_bf16(y0 * sigm(y0), y1 * sigm(y1)), c.rVB, 4 * tid, (t0 + j) * (D * 2), 0); }
}
struct ConvAC { const bf16_t* PU; __amdgpu_buffer_rsrc_t rSCB, rSCX, rYA, rPP; LAS unsigned char* lds; f32x2 s0w, s1w, s2w; };
__device__ __forceinline__ void convAC_load(const ConvAC& c, int t0, int tid, unsigned (&ub)[16], unsigned (&ux)[18]) {
#pragma unroll
    for (int j = 0; j < 16; ++j) ub[j] = __builtin_amdgcn_raw_buffer_load_b32(c.rSCB, 4 * tid, (t0 + j) * (D * 2), 0);
#pragma unroll
    for (int i = 0; i < 18; ++i) ux[i] = __builtin_amdgcn_raw_buffer_load_b32(c.rSCX, 4 * tid, (t0 + 62 + i) * (D * 2), 0);
}
template <int I> __device__ __forceinline__ void convAC_tile(const ConvAC& c, int T0, int tid, int wid, int lane, const unsigned (&ub)[16], const unsigned (&ux)[18], unsigned (&ubn)[16], unsigned (&uxn)[18]) {
    const int t0 = T0 + 16 * I, s0 = t0 & (SEQ - 1); const LAS unsigned char* col = c.lds + 4 * tid;
    if (I < 3) { convAC_load(c, t0 + 16, tid, ubn, uxn); dma_block16(c.PU + (size_t)(t0 + 16) * D, c.lds + ((I + 2) % 3) * 32768, wid, lane); }
    asm volatile("" ::: "memory");
    {
        float x0[18], x1[18];
#pragma unroll
        for (int i = 0; i < 18; ++i) { const unsigned u = (s0 - 2 + i) >= 0 ? ux[i] : 0u; x0[i] = bf_lo(u); x1[i] = bf_hi(u); }
#pragma unroll
        for (int j = 0; j < 16; ++j) {
            const float y0 = bf_lo(ub[j]) * (c.s0w.x * x0[j] + c.s1w.x * x0[j + 1] + c.s2w.x * x0[j + 2]), y1 = bf_hi(ub[j]) * (c.s0w.y * x1[j] + c.s1w.y * x1[j + 1] + c.s2w.y * x1[j + 2]);
            __builtin_amdgcn_raw_buffer_store_b32(pk_bf16(y0, y1), c.rYA, 4 * tid, (t0 + j) * (D * 2), 0); }
    }
    {
        float p0[16], p1[16];
        pool_ch<I, 0>(col, wid >> 1, s0, p0);
#pragma unroll
        for (int j = 0; j < 16; ++j) asm volatile("" : "+v"(p0[j]) :: "memory");
        pool_ch<I, 1>(col, wid >> 1, s0, p1);
#pragma unroll
        for (int j = 0; j < 16; ++j) __builtin_amdgcn_raw_buffer_store_b32(pk_bf16(p0[j], p1[j]), c.rPP, 4 * tid, (t0 + j) * (D * 2), 0);
    }
    if (I < 3) asm volatile("s_waitcnt vmcnt(32)" ::: "memory");
    __syncthreads();
}
__device__ __forceinline__ void conv_phase(KArgs a, int layer, LAS unsigned char* lds, int tid, int wid, int lane) {
    asm volatile("" : "+v"(tid), "+v"(lane));
    unsigned char* ws = a->ws;
    const int G = gridDim.x;
    const int vcu = (G % 8 == 0) ? (int)(blockIdx.x % 8) * (G / 8) + (int)(blockIdx.x / 8) : (int)blockIdx.x;
    const int c2 = 2 * tid;
    {
        const float* cfw = a->in[4] + layer * 31 * D; const float* cfb = a->in[5] + layer * D; const float* lng = a->in[6] + layer * D; const float* lnb = a->in[7] + layer * D;
        ConvB c; c.GLU = (const bf16_t*)(ws + A_GLU); c.rVB = __builtin_amdgcn_make_buffer_rsrc((void*)(ws + A_VB), 0, 0x7fffffff, 0x00020000);
        c.lds = lds; c.red = (LAS float*)(lds + RED_OFF); c.stat = c.red + 256;
        unsigned wp[31];
#pragma unroll
        for (int k = 0; k < 31; ++k) { const f32x2 w = *(const f32x2*)(cfw + k * D + c2); wp[k] = pk_bf16(w.x, w.y); }
        c.bb = *(const f32x2*)(cfb + c2); c.gg = *(const f32x2*)(lng + c2); c.be = *(const f32x2*)(lnb + c2);
        asm volatile("" :: "v"(c.bb.x), "v"(c.bb.y), "v"(c.gg.x), "v"(c.gg.y), "v"(c.be.x), "v"(c.be.y));
        for (int rp2 = 0; rp2 < REPS2(21); ++rp2)
        for (int sup = vcu; sup < M / 64; sup += G) {
            const int T0 = sup * 64; const bool seq0 = (T0 & (SEQ - 1)) == 0;
            if (seq0) { zero_block16(lds, tid); zero_block16(lds + 32768, tid); } else { dma_block16(c.GLU + (size_t)(T0 - 32) * D, lds, wid, lane); dma_block16(c.GLU + (size_t)(T0 - 16) * D, lds + 32768, wid, lane); }
            dma_block16(c.GLU + (size_t)T0 * D, lds + 65536, wid, lane);
            asm volatile("s_waitcnt vmcnt(0)" ::: "memory");
            __syncthreads();
            convB_tile<0>(c, wp, T0, tid, wid, lane); convB_tile<1>(c, wp, T0, tid, wid, lane); convB_tile<2>(c, wp, T0, tid, wid, lane); convB_tile<3>(c, wp, T0, tid, wid, lane);
            __syncthreads();
        }
    }
    __syncthreads();
    {
        const float* scw = a->in[3] + layer * 3 * D;
        ConvAC c; c.PU = (const bf16_t*)(ws + A_PU); c.lds = lds;
        c.rSCB = __builtin_amdgcn_make_buffer_rsrc((void*)(ws + A_SCB), 0, 0x7fffffff, 0x00020000); c.rSCX = __builtin_amdgcn_make_buffer_rsrc((void*)(ws + A_SCX - 64 * D * 2), 0, 0x7fffffff, 0x00020000);
        c.rYA = __builtin_amdgcn_make_buffer_rsrc((void*)(ws + A_YA), 0, 0x7fffffff, 0x00020000); c.rPP = __builtin_amdgcn_make_buffer_rsrc((void*)(ws + A_PP), 0, 0x7fffffff, 0x00020000);
        c.s0w = *(const f32x2*)(scw + c2); c.s1w = *(const f32x2*)(scw + D + c2); c.s2w = *(const f32x2*)(scw + 2 * D + c2);
        asm volatile("" :: "v"(c.s0w.x), "v"(c.s0w.y), "v"(c.s1w.x), "v"(c.s1w.y), "v"(c.s2w.x), "v"(c.s2w.y));
        for (int rp2 = 0; rp2 < REPS2(22); ++rp2)
        for (int sup = vcu; sup < M / 64; sup += G) {
            const int T0 = sup * 64; const bool seq0 = (T0 & (SEQ - 1)) == 0;
            if (seq0) zero_block16(lds, tid); else dma_block16(c.PU + (size_t)(T0 - 16) * D, lds, wid, lane);
            dma_block16(c.PU + (size_t)T0 * D, lds + 32768, wid, lane);
            unsigned ubA[16], uxA[18], ubB[16], uxB[18]; convAC_load(c, T0, tid, ubA, uxA);
            asm volatile("s_waitcnt vmcnt(0)" ::: "memory");
            __syncthreads();
            convAC_tile<0>(c, T0, tid, wid, lane, ubA, uxA, ubB, uxB); convAC_tile<1>(c, T0, tid, wid, lane, ubB, uxB, ubA, uxA); convAC_tile<2>(c, T0, tid, wid, lane, ubA, uxA, ubB, uxB); convAC_tile<3>(c, T0, tid, wid, lane, ubB, uxB, ubA, uxA);
        }
    }
}

__device__ __forceinline__ void route_phase(KArgs a, LAS unsigned char* lds, int tid, int wid, int lane) {
    asm volatile("" : "+v"(tid), "+v"(lane));
    unsigned char* ws = a->ws;
    const bf16_t* X = (const bf16_t*)(ws + WS_XB); const float* gn = a->in[14] + D; const float* R = a->in[18];
    const f32x4* ss3 = (const f32x4*)(ws + WS_SS) + 3 * M;
    int* tope = (int*)(ws + WS_SMALL + SM_TOPE); f32x2* topp = (f32x2*)(ws + WS_SMALL + SM_TOPP); int* cntb = (int*)(ws + WS_CTL + CTL_CNT);
    LAS int* lcnt = (LAS int*)(lds + 98304);
    float wgt[2][8][8];
#pragma unroll
    for (int h = 0; h < 2; ++h)
#pragma unroll
        for (int i = 0; i < 8; ++i) { const int k = 8 * lane + 512 * h + i; const float g = gn[k]; const f32x4 r0 = *(const f32x4*)(R + k * 8), r1 = *(const f32x4*)(R + k * 8 + 4);
#pragma unroll
            for (int e = 0; e < 4; ++e) { wgt[h][i][e] = g * r0[e]; wgt[h][i][4 + e] = g * r1[e]; } }
    for (int vb = blockIdx.x; vb < 256; vb += gridDim.x) {
        if (tid < 8) lcnt[tid] = 0;
        __syncthreads();
        for (int i8 = 0; i8 < 8; ++i8) {
            const int t = vb * 64 + wid * 8 + i8;
            float lg[8];
#pragma unroll
            for (int e = 0; e < 8; ++e) lg[e] = 0.f;
#pragma unroll
            for (int h = 0; h < 2; ++h) { f32x4 v0, v1; pg8::unpack8(*(const u32x4*)(X + (size_t)t * D + 512 * h + 8 * lane), v0, v1);
#pragma unroll
                for (int i = 0; i < 4; ++i)
#pragma unroll
                    for (int e = 0; e < 8; ++e) { lg[e] = fmaf(v0[i], wgt[h][i][e], lg[e]); lg[e] = fmaf(v1[i], wgt[h][4 + i][e], lg[e]); } }
#pragma unroll
            for (int e = 0; e < 8; ++e) lg[e] = wave_sum(lg[e]);
            const f32x4 sp = ss3[t]; const float rstd = __builtin_amdgcn_rsqf(((sp[0] + sp[1]) + (sp[2] + sp[3])) * (1.0f / D) + RMS_EPS);
            int e1 = 0; float v1 = lg[0];
#pragma unroll
            for (int e = 1; e < 8; ++e) if (lg[e] > v1) { v1 = lg[e]; e1 = e; }
            int e2 = e1 == 0 ? 1 : 0; float v2 = -__builtin_inff();
#pragma unroll
            for (int e = 0; e < 8; ++e) if (e != e1 && lg[e] > v2) { v2 = lg[e]; e2 = e; }
            const float ex = __expf((v2 - v1) * rstd), p1 = 1.0f / (1.0f + ex), p2 = ex * p1;
            if (lane == 0) { tope[t] = e1 | (e2 << 8); topp[t] = (f32x2){p1, p2}; atomicAdd((int*)&lcnt[e1], 1); atomicAdd((int*)&lcnt[e2], 1); }
        }
        __syncthreads();
        if (tid < 8) cntb[vb * 8 + tid] = lcnt[tid];
        __syncthreads();
    }
    const int gw = blockIdx.x * 8 + wid, NGW = gridDim.x * 8;
    constexpr int I_1 = 16 * 56, I_13 = 2 * I_1, I_2 = 56 * 16;
    unsigned char* w13 = ws + WS_WMOE; unsigned char* w2t = ws + WS_WMOE + WMOE_W2;
    for (int it = gw; it < NE * (I_13 + I_2); it += NGW) {
        int r = it;
        if (r < NE * I_13) { const int e = r / I_13; r -= e * I_13; const int w = r / I_1; r -= w * I_1; const int kb = r / 56, nb = r % 56, n0 = 64 * nb;
            transpose_item_f8(a->in[19 + w] + (size_t)e * D * DFF, DFF, 64 * kb, n0, w13 + (size_t)e * (2 * DFF) * D + (size_t)pair_row(n0, w) * D, D, gn, F8_W13_MUL, lane); continue; }
        r -= NE * I_13;
        { const int e = r / I_2; r -= e * I_2; const int kb = r / 16, nb = r % 16, n0 = 64 * nb;
            transpose_item_f8(a->in[21] + (size_t)e * DFF * D, D, 64 * kb, n0, w2t + (size_t)e * D * DFF + (size_t)n0 * DFF, DFF, nullptr, F8_W2_MUL, lane); }
    }
}

__device__ __forceinline__ void scatter_phase(KArgs a, LAS unsigned char* lds, int tid, int wid, int lane) {
    asm volatile("" : "+v"(tid), "+v"(lane));
    unsigned char* ws = a->ws;
    const int* tope = (const int*)(ws + WS_SMALL + SM_TOPE); int* tslot = (int*)(ws + WS_SMALL + SM_TSLOT); float* ssperm = (float*)(ws + WS_SMALL + SM_SSPERM); int* meta = (int*)(ws + WS_SMALL + SM_META);
    const int* cntb = (const int*)(ws + WS_CTL + CTL_CNT); const f32x4* ss3 = (const f32x4*)(ws + WS_SS) + 3 * M;
    const bf16_t* X = (const bf16_t*)(ws + WS_XB); unsigned char* AP = ws + WS_APERM;
    LAS int* lc = (LAS int*)lds;
    LAS int* lbase = lc + 2048;
    LAS int* lslot = lc + 2064;
    LAS int* ltot = lc + 2200;
    for (int i = tid; i < 2048; i += 512) lc[i] = __hip_atomic_load(cntb + i, __ATOMIC_RELAXED, __HIP_MEMORY_SCOPE_AGENT);
    __syncthreads();
    for (int vb = blockIdx.x; vb < 256; vb += gridDim.x) {
        if (tid < 8) { int tot = 0, pre = 0;
#pragma unroll 8
            for (int b = 0; b < 256; ++b) { const int v = lc[b * 8 + tid]; tot += v; pre += (b < vb) ? v : 0; }
            ltot[tid] = tot; lbase[tid] = pre; }
        __syncthreads();
        if (tid == 0) { int off = 0;
            for (int e = 0; e < 8; ++e) { lbase[e] += off; if (vb == 0) meta[e] = off >> 8; off += (ltot[e] + 255) & ~255; }
            if (vb == 0) meta[8] = off >> 8; }
        __syncthreads();
        if (wid == 0) {
            const int t = vb * 64 + lane; const int te = tope[t]; const int e1 = te & 0xff, e2 = (te >> 8) & 0xff;
            int s1 = 0, s2 = 0;
#pragma unroll
            for (int k = 0; k < 2; ++k) { const int ek = k ? e2 : e1; int sk = 0;
#pragma unroll
                for (int e = 0; e < 8; ++e) { const unsigned long long mask = __ballot(ek == e); const int base = lbase[e]; LDS_WAIT();
                    const int rank = __popcll(mask & ((1ull << lane) - 1ull)); if (ek == e) sk = base + rank;
                    if (lane == 0) lbase[e] = base + __popcll(mask); LDS_WAIT(); }
                if (k) s2 = sk; else s1 = sk; }
            *(int2*)(tslot + 2 * t) = make_int2(s1, s2); lslot[lane] = s1; lslot[64 + lane] = s2;
        }
        __syncthreads();
        {
            u32x4 xv[8][2]; f32x4 sp[8];
#pragma unroll
            for (int i = 0; i < 8; ++i) { const int t = vb * 64 + wid + 8 * i; const u32x4* src = (const u32x4*)(X + (size_t)t * D) + 2 * lane; xv[i][0] = src[0]; xv[i][1] = src[1]; sp[i] = ss3[t]; }
#pragma unroll
            for (int i = 0; i < 8; ++i) { const int r = wid + 8 * i, s1 = lslot[r], s2 = lslot[64 + r];
                const float rstd = __builtin_amdgcn_rsqf(((sp[i][0] + sp[i][1]) + (sp[i][2] + sp[i][3])) * (1.0f / D) + RMS_EPS);
                f32x4 v0, v1, v2, v3; pg8::unpack8(xv[i][0], v0, v1); pg8::unpack8(xv[i][1], v2, v3);
                const u32x4 q = (u32x4){pk_fp8x4(v0 * rstd), pk_fp8x4(v1 * rstd), pk_fp8x4(v2 * rstd), pk_fp8x4(v3 * rstd)};
                *((u32x4*)(AP + (size_t)s1 * D) + lane) = q; *((u32x4*)(AP + (size_t)s2 * D) + lane) = q; } }
        __syncthreads();
    }
}

__device__ __forceinline__ void combine_phase(KArgs a, LAS unsigned char* lds, int tid, int wid, int lane) {
    asm volatile("" : "+v"(lane), "+v"(tid));
    unsigned char* ws = a->ws;
    LAS int* tmap = (LAS int*)lds; const bf16_t* YP = (const bf16_t*)(ws + WS_YP);
    int split;
    { const int nMraw = __builtin_amdgcn_readfirstlane(__hip_atomic_load((const int*)(ws + WS_SMALL + SM_META) + 8, __ATOMIC_RELAXED, __HIP_MEMORY_SCOPE_AGENT)); const int nM = nMraw > MAXSLOT / 256 ? MAXSLOT / 256 : nMraw;
      const int G = (int)gridDim.x, nU = 4 * nM, R = nU / G, tail = nU - R * G; split = (tail > 0 && pg8::MOE2_SPL * tail <= G) ? 1 : 0;
      for (int i = tid; i < 4 * (MAXSLOT / 256); i += 512) tmap[i] = -1;
      __syncthreads();
      if (split && tid < tail) { int pm, pn; if (pg8::tile_of(R * G + tid, nM, 4, pm, pn, 4)) tmap[4 * pm + pn] = tid; }
      __syncthreads(); }
    const bf16_t* X = (const bf16_t*)(ws + WS_XB); const bf16_t* Y = (const bf16_t*)(ws + WS_Y); const int* tslot = (const int*)(ws + WS_SMALL + SM_TSLOT); const f32x2* topp = (const f32x2*)(ws + WS_SMALL + SM_TOPP);
    const float* gf = a->in[22]; float* out = a->out;
    const int gw = blockIdx.x * 8 + wid, NGW = gridDim.x * 8;
    f32x4 gv[4];
#pragma unroll
    for (int h = 0; h < 2; ++h) { gv[2 * h] = *(const f32x4*)(gf + 512 * h + 8 * lane); gv[2 * h + 1] = *(const f32x4*)(gf + 512 * h + 8 * lane + 4); }
    for (int tb = gw; tb < M; tb += 4 * NGW) {
        int2 sl[4]; f32x2 p[4];
#pragma unroll
        for (int i = 0; i < 4; ++i) { const int t = min(tb + i * NGW, M - 1); sl[i] = *(const int2*)(tslot + 2 * t); p[i] = topp[t]; }
        u32x4 xr[4][2], ya[4][2], yb[4][2];
#pragma unroll
        for (int i = 0; i < 4; ++i) { const int t = min(tb + i * NGW, M - 1);
#pragma unroll
            for (int h = 0; h < 2; ++h) { const int col = 512 * h + 8 * lane;
                xr[i][h] = *(const u32x4*)(X + (size_t)t * D + col); ya[i][h] = *(const u32x4*)(Y + (size_t)sl[i].x * D + col); yb[i][h] = *(const u32x4*)(Y + (size_t)sl[i].y * D + col); } }
#pragma unroll
        for (int i = 0; i < 4; ++i) { const int t = tb + i * NGW; if (t < M) {
            f32x4 v[4]; float s = 0.f;
#pragma unroll
            for (int h = 0; h < 2; ++h) { f32x4 x0, x1, a0, a1, b0, b1; pg8::unpack8(xr[i][h], x0, x1); pg8::unpack8(ya[i][h], a0, a1); pg8::unpack8(yb[i][h], b0, b1);
                if (split) { const int pn = 2 * h + (lane >> 5), cl = 8 * (lane & 31);
                    const int ka = tmap[4 * (sl[i].x >> 8) + pn], kb = tmap[4 * (sl[i].y >> 8) + pn];
                    if (ka >= 0) { a0 = (f32x4){0.f, 0.f, 0.f, 0.f}; a1 = a0;
                        for (int p = 0; p < pg8::MOE2_SPL; ++p) { f32x4 t0, t1; pg8::unpack8(*(const u32x4*)(YP + (size_t)(ka * pg8::MOE2_SPL + p) * 65536 + (size_t)(sl[i].x & 255) * 256 + cl), t0, t1); a0 += t0; a1 += t1; } }
                    if (kb >= 0) { b0 = (f32x4){0.f, 0.f, 0.f, 0.f}; b1 = b0;
                        for (int p = 0; p < pg8::MOE2_SPL; ++p) { f32x4 t0, t1; pg8::unpack8(*(const u32x4*)(YP + (size_t)(kb * pg8::MOE2_SPL + p) * 65536 + (size_t)(sl[i].y & 255) * 256 + cl), t0, t1); b0 += t0; b1 += t1; } } }
                v[2 * h] = x0 + a0 * p[i].x + b0 * p[i].y; v[2 * h + 1] = x1 + a1 * p[i].x + b1 * p[i].y; }
#pragma unroll
            for (int k = 0; k < 4; ++k) s += (v[k][0] * v[k][0] + v[k][1] * v[k][1]) + (v[k][2] * v[k][2] + v[k][3] * v[k][3]);
            const float rstd = __builtin_amdgcn_rsqf(wave_sum(s) * (1.0f / D) + RMS_EPS);
#pragma unroll
            for (int h = 0; h < 2; ++h) { const int col = 512 * h + 8 * lane;
                *(f32x4*)(out + (size_t)t * D + col) = v[2 * h] * rstd * gv[2 * h]; *(f32x4*)(out + (size_t)t * D + col + 4) = v[2 * h + 1] * rstd * gv[2 * h + 1]; } } }
    }
}

#ifndef WGM_INPROJ
#define WGM_INPROJ 4
#endif
#ifndef WGM_FFN1
#define WGM_FFN1 4
#endif
#ifndef WGM_MOE1
#define WGM_MOE1 4
#endif
constexpr int NPH = 18;
#ifndef MK_PH_MASK
#define MK_PH_MASK 0xFFFFFFFFu
#endif
#define PHON(bit) ((((MK_PH_MASK) >> (bit)) & 1u) != 0u)


__device__ __forceinline__ void ph_inproj(KArgs a, int layer, LAS unsigned char* lds) {
    unsigned char* ws = a->ws;
    {
        pg8::Gemm g{2 * D, 2 * D, 2 * D, 0, 0}; pg8::PlainSched S{M / 256, 16, (int)gridDim.x, (int)blockIdx.x, (const char*)(ws + WS_XB), (const char*)(ws + WS_W0 + W0_WIN + (size_t)layer * 18 * MiB), (size_t)256 * D * 2, (size_t)256 * D * 2, WGM_INPROJ, 12, 8};
        pg8::EpiProj E{(bf16_t*)(ws + A_SCB), (bf16_t*)(ws + A_SCX), (bf16_t*)(ws + A_GLU), (bf16_t*)(ws + A_PU), (bf16_t*)(ws + A_GATES), (const f32x4*)(ws + WS_SS) + (size_t)(layer * 2) * M, 12, 0, 8};
        pg8::gemm_phase(lds, g, S, E);
    }
    __syncthreads();
    {
        pg8::Gemm g{D, D, D, F8_ONE, F8_W13_SC}; pg8::PlainSched S{M / 256, 20, (int)gridDim.x, (int)blockIdx.x, (const char*)(ws + WS_X8), (const char*)(ws + WS_WG8 + (size_t)layer * 5 * MiB), (size_t)256 * D, (size_t)256 * D, WGM_INPROJ, 1 << 30, 0};
        pg8::EpiProj E{(bf16_t*)(ws + A_SCB), (bf16_t*)(ws + A_SCX), (bf16_t*)(ws + A_GLU), (bf16_t*)(ws + A_PU), (bf16_t*)(ws + A_GATES), (const f32x4*)(ws + WS_SS) + (size_t)(layer * 2) * M, 8, 12, 16};
        pg8::gemm_phase<pg8::EpiProj, pg8::PlainSched, true>(lds, g, S, E);
    }
}
__device__ __forceinline__ void ph_fold(KArgs a, LAS unsigned char* lds) {
    unsigned char* ws = a->ws;
    pg8::Gemm g{512, 2 * D, 512, 0, 0}; pg8::FoldSched S{(int)gridDim.x, (int)blockIdx.x, (const char*)(ws + WS_W0 + W0_WOUT + 2 * 2 * MiB), (const char*)(ws + WS_W0 + W0_POOL)};
    pg8::EpiPlain E{(bf16_t*)(ws + WS_WC), D, (size_t)D * D};
    pg8::gemm_phase(lds, g, S, E);
}
__device__ __forceinline__ void ph_merge(KArgs a, int layer, LAS unsigned char* lds) {
    unsigned char* ws = a->ws;
    pg8::Gemm g{2 * D, 2 * D, 2 * D, 0, 0}; pg8::MergeSched S{(int)gridDim.x, (int)blockIdx.x, (const char*)(ws + A_YA), (const char*)(ws + WS_W0 + W0_WOUT + (size_t)(layer * 3) * 2 * MiB), (const char*)(ws + WS_WC + (size_t)layer * 2 * MiB), (size_t)32 * MiB, (size_t)2 * MiB};
    pg8::EpiMerge E{(const bf16_t*)(ws + A_GATES), (bf16_t*)(ws + A_MERGED)};
    pg8::gemm_phase(lds, g, S, E);
}
__device__ __forceinline__ void ph_wo(KArgs a, int layer, LAS unsigned char* lds) {
    unsigned char* ws = a->ws;
    pg8::Gemm g{2 * D, 2 * D, 2 * D, 0, 0}; pg8::PlainSched S{M / 256, D / 256, (int)gridDim.x, (int)blockIdx.x, (const char*)(ws + A_MERGED), (const char*)(ws + WS_W0 + W0_WO + (size_t)layer * 2 * MiB), (size_t)256 * D * 2, (size_t)256 * D * 2, 4, 1 << 30, 0};
    pg8::EpiResid E{layer == 0 ? a->in[0] : (const float*)nullptr, (bf16_t*)(ws + WS_XB), (float*)(ws + WS_SS) + (size_t)(layer * 2 + 1) * M * 4, (LAS float*)(lds + RED_OFF), nullptr};
    pg8::gemm_phase(lds, g, S, E);
}
__device__ __forceinline__ void ph_ffn1(KArgs a, LAS unsigned char* lds) {
    unsigned char* ws = a->ws;
    pg8::Gemm g{2 * D, 2 * D, 2 * D, 0, 0}; pg8::PlainSched S{M / 256, 2 * DFF / 256, (int)gridDim.x, (int)blockIdx.x, (const char*)(ws + WS_XB), (const char*)(ws + WS_W0 + W0_D13), (size_t)256 * D * 2, (size_t)256 * D * 2, WGM_FFN1, 1 << 30, 0};
    pg8::EpiSwiGLU<true, false> E{(bf16_t*)(ws + A_FFN), DFF, (const float*)(ws + WS_SS) + (size_t)1 * M * 4};
    pg8::gemm_phase(lds, g, S, E);
}
__device__ __forceinline__ void ph_ffn2(KArgs a, LAS unsigned char* lds) {
    unsigned char* ws = a->ws;
    pg8::Gemm g{2 * DFF, 2 * DFF, 2 * DFF, 0, 0}; pg8::PlainSched S{M / 256, D / 256, (int)gridDim.x, (int)blockIdx.x, (const char*)(ws + A_FFN), (const char*)(ws + WS_W0 + W0_D2), (size_t)256 * DFF * 2, (size_t)256 * DFF * 2, 4, 1 << 30, 0};
    pg8::EpiResid E{(const float*)nullptr, (bf16_t*)(ws + WS_XB), (float*)(ws + WS_SS) + (size_t)2 * M * 4, (LAS float*)(lds + RED_OFF), ws + WS_X8};
    pg8::gemm_phase(lds, g, S, E);
}
__device__ __forceinline__ void ph_moe(KArgs a, int which, LAS unsigned char* lds) {
    unsigned char* ws = a->ws;
    const int* meta = (const int*)(ws + WS_SMALL + SM_META); int o[9];
#pragma unroll
    for (int e = 0; e < 9; ++e) o[e] = __builtin_amdgcn_readfirstlane(__hip_atomic_load(meta + e, __ATOMIC_RELAXED, __HIP_MEMORY_SCOPE_AGENT));
    const int nM = o[8] > MAXSLOT / 256 ? MAXSLOT / 256 : o[8];
    if (which == 0) {
        pg8::Gemm g{D, D, D, F8_ONE, F8_W13_SC}; pg8::GroupSched S{nM, 2 * DFF / 256, (int)gridDim.x, (int)blockIdx.x, o[1], o[2], o[3], o[4], o[5], o[6], o[7], (const char*)(ws + WS_APERM), (const char*)(ws + WS_WMOE), (size_t)256 * D, (size_t)256 * D, (size_t)2 * DFF * D, WGM_MOE1};
        pg8::EpiSwiGLU<false, true> E{(bf16_t*)(ws + WS_ACTP), DFF, nullptr};
        pg8::gemm_phase<pg8::EpiSwiGLU<false, true>, pg8::GroupSched, true>(lds, g, S, E);
    } else {
        const int G = (int)gridDim.x, nU = 4 * nM, R = nU / G, tail = nU - R * G, split = (tail > 0 && pg8::MOE2_SPL * tail <= G) ? 1 : 0;
        pg8::Gemm g{DFF, DFF, DFF, F8_ACT_SC, F8_W2_SC}; pg8::Moe2Sched S{nM, G, (int)blockIdx.x, R, tail, split, o[1], o[2], o[3], o[4], o[5], o[6], o[7], (const char*)(ws + WS_ACTP), (const char*)(ws + WS_WMOE + WMOE_W2), (size_t)256 * DFF, (size_t)256 * DFF, (size_t)D * DFF};
        pg8::EpiMoe2 E{(bf16_t*)(ws + WS_Y), (bf16_t*)(ws + WS_YP)};
        pg8::gemm_phase<pg8::EpiMoe2, pg8::Moe2Sched, true>(lds, g, S, E);
    }
}

__global__ void __launch_bounds__(512, 2) fwd(Args unused_args_read_through_kargs) {
    extern __shared__ __attribute__((aligned(16))) unsigned char lds_raw[];
    LAS unsigned char* lds = (LAS unsigned char*)lds_raw;
    volatile LAS unsigned* MISC = (volatile LAS unsigned*)(lds + MISC_OFF);
    const int tid = threadIdx.x, lane = tid & 63, wid = __builtin_amdgcn_readfirstlane(tid >> 6);
    if (tid < 64) MISC[tid] = 0u;
    __syncthreads();
    int lo, hi; XcdBarrier bar;
    { KArgs a = kargs(); lo = a->ph_lo; hi = a->ph_hi; unsigned* bw = (unsigned*)(a->ws + WS_CTL + CTL_BAR); bar.bar = bw; bar.x = 0; bar.st = nullptr; if (hi - lo > 1) bar = xcd_barrier_post(bw, MISC + 8); }
#define IN(k) (lo <= (k) && (k) < hi)
#define SEAM(k) do { if (IN(k) && IN((k) + 1)) xcd_barrier(bar); } while (0)

    if (PHON(0) && IN(0)) { for (int rp = 0; rp < REPS(0); ++rp) { prologue_phase(kargs(), lds, wid, lane); __syncthreads(); } } SEAM(0);
#pragma nounroll
    for (int layer = 0; layer < 2; ++layer) {
        const int pb = 1 + 7 * layer;
        if (PHON(1) && IN(pb + 0)) { for (int rp = 0; rp < REPS(1); ++rp) { if (layer == 0) { ph_fold(kargs(), lds); __syncthreads(); } ph_inproj(kargs(), layer, lds); __syncthreads(); } } SEAM(pb + 0);
        if (PHON(2) && IN(pb + 1)) { for (int rp = 0; rp < REPS(2); ++rp) { conv_phase(kargs(), layer, lds, tid, wid, lane); __syncthreads(); } } SEAM(pb + 1);
        if (PHON(4) && IN(pb + 3)) { for (int rp = 0; rp < REPS(4); ++rp) { ph_merge(kargs(), layer, lds); __syncthreads(); } } SEAM(pb + 3);
        if (PHON(5) && IN(pb + 4)) { for (int rp = 0; rp < (layer == 0 ? REPS(5) : 1); ++rp) { ph_wo(kargs(), layer, lds); __syncthreads(); } } SEAM(pb + 4);
        if (layer == 0) {
            if (PHON(6) && IN(6)) { for (int rp = 0; rp < REPS(6); ++rp) { ph_ffn1(kargs(), lds); __syncthreads(); } } SEAM(6);
            if (PHON(7) && IN(7)) { ph_ffn2(kargs(), lds); } SEAM(7);
        }
    }
    if (PHON(13) && IN(13)) { for (int rp = 0; rp < REPS(13); ++rp) { route_phase(kargs(), lds, tid, wid, lane); __syncthreads(); } } SEAM(13);
    if (PHON(14) && IN(14)) { for (int rp = 0; rp < REPS(14); ++rp) { scatter_phase(kargs(), lds, tid, wid, lane); __syncthreads(); } } SEAM(14);
    if (PHON(15) && IN(15)) { for (int rp = 0; rp < REPS(15); ++rp) { ph_moe(kargs(), 0, lds); __syncthreads(); } } SEAM(15);
    if (PHON(16) && IN(16)) { for (int rp = 0; rp < REPS(16); ++rp) { ph_moe(kargs(), 1, lds); __syncthreads(); } } SEAM(16);
    if (PHON(17) && IN(17)) { for (int rp = 0; rp < REPS(17); ++rp) { combine_phase(kargs(), lds, tid, wid, lane); __syncthreads(); } }
#undef IN
#undef SEAM
}

extern "C" void kernel_launch(void* const* d_in, const int* in_sizes, int n_in, void* d_out, int out_size, void* d_ws, size_t ws_size, hipStream_t stream) {
    static int grid = 0;
    if (grid == 0) {
        if (n_in != 23 || in_sizes[0] != M * D || out_size != M * D || ws_size < WS_END) { fprintf(stderr, "kernel_launch: unexpected shapes: n_in %d in0 %d out %d ws %zu (need %zu); nothing launched\n", n_in, n_in > 0 ? in_sizes[0] : -1, out_size, ws_size, (size_t)WS_END); grid = -1; return; }
        int dev = 0, cus = 0, per_cu = 0;
        if (hipGetDevice(&dev) != hipSuccess || hipDeviceGetAttribute(&cus, hipDeviceAttributeMultiprocessorCount, dev) != hipSuccess) { fprintf(stderr, "kernel_launch: device query failed\n"); grid = -1; return; }
        if (hipFuncSetAttribute((const void*)fwd, hipFuncAttributeMaxDynamicSharedMemorySize, LDS_BYTES) != hipSuccess) { fprintf(stderr, "kernel_launch: hipFuncSetAttribute failed\n"); grid = -1; return; }
        if (hipOccupancyMaxActiveBlocksPerMultiprocessor(&per_cu, (const void*)fwd, 512, LDS_BYTES) != hipSuccess || per_cu < 1) fprintf(stderr, "kernel_launch: note: occupancy query reports %d workgroups per CU\n", per_cu);
        (void)hipGetLastError();
        grid = cus;
    }
    if (grid < 0) return;
    if (hipMemsetAsync((char*)d_ws + WS_CTL, 0, CTL_BYTES, stream) != hipSuccess) { fprintf(stderr, "kernel_launch: memset failed\n"); return; }
    Args a{};
    for (int i = 0; i < 23; ++i) a.in[i] = (const float*)d_in[i];
    a.out = (float*)d_out; a.ws = (unsigned char*)d_ws;
#if MK_PER_PHASE
    for (int ph = 0; ph < NPH; ++ph) { a.ph_lo = ph; a.ph_hi = ph + 1; hipLaunchKernelGGL(fwd, dim3(grid), dim3(512), LDS_BYTES, stream, a); }
#else
    a.ph_lo = 0; a.ph_hi = NPH; hipLaunchKernelGGL(fwd, dim3(grid), dim3(512), LDS_BYTES, stream, a);
#endif
    const hipError_t le = hipPeekAtLastError();
    if (le != hipSuccess) fprintf(stderr, "kernel_launch: launch failed: %s\n", hipGetErrorName(le));
}
```

```cpp
#include <hip/hip_runtime.h>
#include <cstdio>
#include <cstdint>

#ifndef MK_PER_PHASE
#define MK_PER_PHASE 0
#endif

#ifndef MK_REP_MASK
#define MK_REP_MASK 0u
#endif
#define REPS(bit) (1 + (int)(((MK_REP_MASK) >> (bit)) & 1u))
#define REPS2(bit) REPS(bit)

#define LAS __attribute__((address_space(3)))
typedef unsigned short bf16_t;
typedef short bf16x8 __attribute__((ext_vector_type(8)));
typedef float f32x4 __attribute__((ext_vector_type(4)));
typedef float f32x2 __attribute__((ext_vector_type(2)));
typedef unsigned u32x4 __attribute__((ext_vector_type(4)));
typedef unsigned u32x2 __attribute__((ext_vector_type(2)));

constexpr int M = 16384, D = 1024, SEQ = 8192, INC = 9216, DFF = 3584, NE = 8;
constexpr float RMS_EPS = 1e-6f, LN_EPS = 1e-5f;
constexpr int MAXSLOT = 34816;
constexpr float F8_W13_MUL = 128.f, F8_ACT_MUL = 4.f, F8_W2_MUL = 256.f;
constexpr int F8_ONE = 0x7f7f7f7f, F8_W13_SC = 0x78787878  , F8_ACT_SC = 0x7d7d7d7d  , F8_W2_SC = 0x77777777  ;

constexpr size_t MiB = 1u << 20;
constexpr size_t WS_CTL = 0, CTL_BYTES = 64 * 1024;
constexpr size_t CTL_BAR = 16384;
constexpr size_t CTL_CNT = 32768;
constexpr size_t WS_SMALL = 1 * MiB;
constexpr size_t SM_TOPE = 0, SM_TOPP = 64 * 1024, SM_TSLOT = 192 * 1024, SM_SSPERM = 320 * 1024, SM_META = 512 * 1024;
constexpr size_t WS_X8 = 2 * MiB;
constexpr size_t WS_YP = 18 * MiB;
constexpr size_t WS_WG8 = 492 * MiB;
constexpr size_t WS_XB = 66 * MiB;
constexpr size_t WS_W0 = 98 * MiB;
constexpr size_t W0_WIN = 0;
constexpr size_t W0_WOUT = 36 * MiB;
constexpr size_t W0_WO = 48 * MiB;
constexpr size_t W0_POOL = 52 * MiB;
constexpr size_t W0_D13 = 53 * MiB;
constexpr size_t W0_D2 = 67 * MiB;
constexpr size_t WS_ACT = 172 * MiB;
constexpr size_t A_SCB = WS_ACT, A_SCX = WS_ACT + 32 * MiB, A_GLU = WS_ACT + 64 * MiB, A_PU = WS_ACT + 96 * MiB, A_GATES = WS_ACT + 128 * MiB,
                 A_YA = WS_ACT + 224 * MiB, A_VB = WS_ACT + 256 * MiB, A_PP = WS_ACT + 288 * MiB, A_MERGED = A_SCX, A_FFN = WS_ACT;
constexpr size_t WS_HALO = 528 * MiB;
constexpr size_t WS_WC = 524 * MiB;
constexpr size_t WS_ACTP = 98 * MiB;
constexpr size_t WS_WMOE = 304 * MiB, WMOE_W2 = 56 * MiB;
constexpr size_t WS_Y = 400 * MiB;
constexpr size_t WS_APERM = 472 * MiB;
constexpr size_t WS_SS = 540 * MiB;
constexpr size_t WS_END = 541 * MiB;

typedef __bf16 bf16x2_t __attribute__((ext_vector_type(2)));
__device__ __forceinline__ unsigned pk_bf16(float lo, float hi) { const bf16x2_t v = {(__bf16)lo, (__bf16)hi}; return __builtin_bit_cast(unsigned, v); }
__device__ __forceinline__ unsigned pk_fp8x4(const f32x4 v) {
    const float a = __builtin_amdgcn_fmed3f(v[0], -448.f, 448.f), b = __builtin_amdgcn_fmed3f(v[1], -448.f, 448.f), c = __builtin_amdgcn_fmed3f(v[2], -448.f, 448.f), d = __builtin_amdgcn_fmed3f(v[3], -448.f, 448.f);
    int w = 0; w = __builtin_amdgcn_cvt_pk_fp8_f32(a, b, w, false); w = __builtin_amdgcn_cvt_pk_fp8_f32(c, d, w, true); return (unsigned)w; }
__device__ __forceinline__ float bf_lo(unsigned u) { return __uint_as_float(u << 16); }
__device__ __forceinline__ float bf_hi(unsigned u) { return __uint_as_float(u & 0xffff0000u); }
__device__ __forceinline__ float sigm(float x) { return __builtin_amdgcn_rcpf(1.f + __builtin_amdgcn_exp2f(-1.44269504f * x)); }
__device__ __forceinline__ float wave_sum(float v) {
#pragma unroll
    for (int o = 1; o < 64; o <<= 1) v += __shfl_xor(v, o);
    return v;
}
#define LDS_WAIT() asm volatile("s_waitcnt lgkmcnt(0)" ::: "memory")

namespace pg8 {
constexpr int BM = 256, BK = 64, HALF = 128, HTB = HALF * BK * 2, STAGE_BYTES = 8 * HTB, NXCD = 8;
__host__ __device__ __forceinline__ int lds_byte(int r, int c) { const int st = (r >> 4) * 2 + (c >> 5), rr = r & 15, cc = c & 31, ob = rr * 64 + cc * 2; return st * 1024 + (ob ^ (((ob >> 9) & 1) << 5)); }
__host__ __device__ __forceinline__ void stage_rc(int b, int& R, int& C) { const int st = b / 1024, sb = b % 1024, swz = sb ^ (((sb >> 9) & 1) << 5); R = (st >> 1) * 16 + swz / 64; C = (st & 1) * 32 + (swz % 64) / 2; }
__host__ __device__ __forceinline__ int perm32(int rho) { const int n = rho >> 4, i = rho & 15; return 8 * (i >> 2) + 4 * n + (i & 3); }

struct Unit { int pm, pn, aux, nt; const char* A; const char* B; };
struct Gemm { int Kb, lda, ldb; int sa, sb; };

__device__ __forceinline__ bool tile_of(int L, int nM, int nN, int& pm, int& pn, int WGM = 4) {
    const int nwg = nM * nN; if (L >= nwg) return false;
    int wgid = L; { const int q = nwg / NXCD, r = nwg % NXCD, xcd = wgid % NXCD, off = wgid / NXCD; wgid = (xcd < r ? xcd * (q + 1) : r * (q + 1) + (xcd - r) * q) + off; }
    const int nig = WGM * nN, gid = wgid / nig, fm = gid * WGM, gsz = (nM - fm) < WGM ? (nM - fm) : WGM;
    pm = fm + ((wgid % nig) % gsz); pn = (wgid % nig) / gsz; return true;
}
struct PlainSched {
    int nM, nN, G, c; const char* A0; const char* B0; size_t astep, bstep; int wgm; int bsplit, badd;
    __device__ __forceinline__ bool next(int i, Unit& u) const { int pm, pn; if (!tile_of(i * G + c, nM, nN, pm, pn, wgm)) return false; u.pm = pm; u.pn = pn; u.aux = 0; u.nt = 0; u.A = A0 + (size_t)pm * astep; u.B = B0 + (size_t)(pn + (pn >= bsplit ? badd : 0)) * bstep; return true; }
};
struct PoolSched {
    int G, c; const char* A0; const char* B0;
    __device__ __forceinline__ bool next(int i, Unit& u) const { int pm, pn; if (!tile_of(i * G + c, M / 256, 4, pm, pn)) return false; u.pm = pm; u.pn = pn; u.aux = 0; u.nt = 0;
        u.A = A0 + (size_t)pm * (256 * 1024 * 2) + (size_t)pn * 512; u.B = B0 + (size_t)pn * (256 * 256 * 2); return true; }
};
struct MergeSched {
    int G, c; const char *A0, *B0, *B2; size_t astr, bstr;
    __device__ __forceinline__ bool next(int i, Unit& u) const { const int t = i / 3, b = i - 3 * t; int pm, pn; if (!tile_of(t * G + c, M / 256, 4, pm, pn)) return false; u.pm = pm; u.pn = pn; u.aux = b; u.nt = 0;
        const char* w = b == 2 ? B2 : B0 + (size_t)b * bstr;
        u.A = A0 + (size_t)b * astr + (size_t)pm * (256 * 1024 * 2); u.B = w + (size_t)pn * (256 * 1024 * 2); return true; }
};
struct FoldSched {
    int G, c; const char *A0, *B0;
    __device__ __forceinline__ bool next(int i, Unit& u) const { const int idx = i * G + c; if (idx >= 32) return false; const int L = idx >> 4, pm = (idx >> 2) & 3, g = idx & 3; u.pm = pm; u.pn = g; u.aux = L; u.nt = 0;
        u.A = A0 + (size_t)L * (6 * MiB) + (size_t)pm * (256 * 1024 * 2) + (size_t)g * 512; u.B = B0 + (size_t)L * (512 * 1024) + (size_t)g * (256 * 256 * 2); return true; }
};
struct GroupSched {
    int nM, nN, G, c; int o1, o2, o3, o4, o5, o6, o7; const char* A0; const char* B0; size_t astep, bstep, estep; int wgm;
    __device__ __forceinline__ bool next(int i, Unit& u) const { int pm, pn; if (!tile_of(i * G + c, nM, nN, pm, pn, wgm)) return false; u.pm = pm; u.pn = pn; u.aux = 0; u.nt = 0;
        const int e = (pm >= o1) + (pm >= o2) + (pm >= o3) + (pm >= o4) + (pm >= o5) + (pm >= o6) + (pm >= o7);
        u.A = A0 + (size_t)pm * astep; u.B = B0 + (size_t)e * estep + (size_t)pn * bstep; return true; }
};

constexpr int MOE2_SPL = 7, MOE2_SNT = 4;
struct Moe2Sched {
    int nM, G, c, R, tail, split; int o1, o2, o3, o4, o5, o6, o7; const char* A0; const char* B0; size_t astep, bstep, estep;
    __device__ __forceinline__ bool next(int i, Unit& u) const {
        int L = i * G + c, part = -1, sub = 0;
        if (split && i >= R) { if (i > R || c >= MOE2_SPL * tail) return false; sub = c; L = R * G + c / MOE2_SPL; part = c % MOE2_SPL; }
        int pm, pn; if (!tile_of(L, nM, 4, pm, pn, 4)) return false; u.pm = pm; u.pn = pn;
        const int e = (pm >= o1) + (pm >= o2) + (pm >= o3) + (pm >= o4) + (pm >= o5) + (pm >= o6) + (pm >= o7);
        u.A = A0 + (size_t)pm * astep; u.B = B0 + (size_t)e * estep + (size_t)pn * bstep; u.aux = 0; u.nt = 0;
        if (part >= 0) { u.A += part * (MOE2_SNT * 128); u.B += part * (MOE2_SNT * 128); u.aux = 1 + sub; u.nt = MOE2_SNT; }
        return true; }
};

typedef f32x4 Acc[2][2][4][2];
__device__ __forceinline__ u32x4 pack8(const f32x4 v0, const f32x4 v1) { u32x4 w; w.x = pk_bf16(v0[0], v0[1]); w.y = pk_bf16(v0[2], v0[3]); w.z = pk_bf16(v1[0], v1[1]); w.w = pk_bf16(v1[2], v1[3]); return w; }
__device__ __forceinline__ f32x4 sig4(const f32x4 v) { f32x4 r; r[0] = sigm(v[0]); r[1] = sigm(v[1]); r[2] = sigm(v[2]); r[3] = sigm(v[3]); return r; }
__device__ __forceinline__ void unpack8(const u32x4 g, f32x4& lo, f32x4& hi) { lo[0] = bf_lo(g.x); lo[1] = bf_hi(g.x); lo[2] = bf_lo(g.y); lo[3] = bf_hi(g.y); hi[0] = bf_lo(g.z); hi[1] = bf_hi(g.z); hi[2] = bf_lo(g.w); hi[3] = bf_hi(g.w); }

__device__ __forceinline__ size_t gate_frag(int pm, int q, int wid, int ai, int m, int lane) { return ((size_t)(((((pm * 12 + q) * 8 + wid) * 2 + ai) * 4 + m) * 64 + lane)) * 16; }
__device__ __forceinline__ unsigned pk_fp8x4_raw(const f32x4 v) { int w = 0; w = __builtin_amdgcn_cvt_pk_fp8_f32(v[0], v[1], w, false); w = __builtin_amdgcn_cvt_pk_fp8_f32(v[2], v[3], w, true); return (unsigned)w; }
__device__ __forceinline__ f32x4 un_fp8x4(unsigned w) { const f32x2 lo = __builtin_amdgcn_cvt_pk_f32_fp8((int)w, false), hi = __builtin_amdgcn_cvt_pk_f32_fp8((int)w, true); return (f32x4){lo[0], lo[1], hi[0], hi[1]}; }
struct EpiProj {
    bf16_t *glu, *gates; const f32x4* ss;
    __device__ __forceinline__ bool operator()(Acc& acc, const Unit& u, int wr, int wc, int fr, int fq) const {
        const int row0 = u.pm * BM + wr * 64 + fr, pn = u.pn;
        float rs[2][4];
#pragma unroll
        for (int ai = 0; ai < 2; ++ai)
#pragma unroll
            for (int m = 0; m < 4; ++m) { const f32x4 p = ss[row0 + ai * HALF + m * 16]; rs[ai][m] = __builtin_amdgcn_rsqf(((p[0] + p[1]) + (p[2] + p[3])) * (1.0f / D) + RMS_EPS); }
        if (pn < 8) {
            const int col0 = pn * 128 + wc * 32 + 8 * fq;
#pragma unroll
            for (int ai = 0; ai < 2; ++ai)
#pragma unroll
                for (int m = 0; m < 4; ++m) { const float r = rs[ai][m];
                    const f32x4 a0 = acc[ai][0][m][0] * r, a1 = acc[ai][0][m][1] * r, b0 = sig4(acc[ai][1][m][0] * r), b1 = sig4(acc[ai][1][m][1] * r);
                    *(u32x4*)(glu + (size_t)(row0 + ai * HALF + m * 16) * D + col0) = pack8(a0 * b0, a1 * b1); }
        } else {
#pragma unroll
            for (int ai = 0; ai < 2; ++ai)
#pragma unroll
                for (int m = 0; m < 4; ++m) { const float r = -1.44269504f * rs[ai][m]; u32x4 w;
#pragma unroll
                    for (int bj = 0; bj < 2; ++bj) { f32x4 e0 = acc[ai][bj][m][0] * r, e1 = acc[ai][bj][m][1] * r;
#pragma unroll
                        for (int j = 0; j < 4; ++j) { e0[j] = __builtin_amdgcn_exp2f(__builtin_amdgcn_fmed3f(e0[j], -8.65617f, 8.65617f)); e1[j] = __builtin_amdgcn_exp2f(__builtin_amdgcn_fmed3f(e1[j], -8.65617f, 8.65617f)); }
                        w[2 * bj] = pk_fp8x4_raw(e0); w[2 * bj + 1] = pk_fp8x4_raw(e1); }
                    *(u32x4*)((unsigned char*)gates + gate_frag(u.pm, pn - 8, wr * 4 + wc, ai, m, fr + 16 * fq)) = w; }
        }
        return false;
    }
};
template <int CTRL> __device__ __forceinline__ float dpp_f(float old, float src) { return __int_as_float(__builtin_amdgcn_update_dpp(__float_as_int(old), __float_as_int(src), CTRL, 0xf, 0xf, false)); }
struct EpiSc {
    bf16_t *ya, *pu; const f32x4* ss; const float* scw; float* halo; LAS float* ex;
    __device__ __forceinline__ bool operator()(Acc& acc, const Unit& u, int wr, int wc, int fr, int fq) const {
        const int row0 = u.pm * BM + wr * 64 + fr, ch0 = u.pn * 64 + wc * 16 + fq * 4;
#pragma unroll
        for (int ai = 0; ai < 2; ++ai)
#pragma unroll
            for (int m = 0; m < 4; ++m) { const f32x4 p = ss[row0 + ai * HALF + m * 16]; const float r = __builtin_amdgcn_rsqf(((p[0] + p[1]) + (p[2] + p[3])) * (1.0f / D) + RMS_EPS);
                acc[ai][0][m][0] = acc[ai][0][m][0] * r; acc[ai][0][m][1] = (acc[ai][0][m][1] * r) * (acc[ai][1][m][0] * r); acc[ai][1][m][1] = acc[ai][1][m][1] * r; }
        if (fr >= 14) {
#pragma unroll
            for (int ai = 0; ai < 2; ++ai) *(LAS f32x4*)(ex + ((((ai * 2 + wr) * 4 + wc) * 4 + fq) * 2 + (fr - 14)) * 4) = acc[ai][0][3][1];
            if (wr == 1) *(f32x4*)(halo + ((size_t)((2 * 64 + u.pm) * 2 + (fr - 14))) * D + ch0) = acc[1][0][3][1];
        }
        if (wr == 0 && fr < 2) { *(f32x4*)(halo + ((size_t)((0 * 64 + u.pm) * 2 + fr)) * D + ch0) = acc[0][0][0][0]; *(f32x4*)(halo + ((size_t)((1 * 64 + u.pm) * 2 + fr)) * D + ch0) = acc[0][0][0][1]; }
        const f32x4 w0 = *(const f32x4*)(scw + ch0), w1 = *(const f32x4*)(scw + D + ch0), w2 = *(const f32x4*)(scw + 2 * D + ch0);
        asm volatile("s_waitcnt lgkmcnt(0)" ::: "memory"); __builtin_amdgcn_s_barrier(); asm volatile("" ::: "memory");
#pragma unroll
        for (int ai = 0; ai < 2; ++ai) {
            f32x4 F1 = (f32x4){0.f, 0.f, 0.f, 0.f}, F2 = F1;
            if (ai + wr > 0) { const int pb = 2 * ai + wr - 1; const LAS float* e = ex + (((pb * 4 + wc) * 4 + fq) * 2) * 4; const f32x4 E0 = *(const LAS f32x4*)e, E1 = *(const LAS f32x4*)(e + 4); F1 = E1; F2 = fr == 0 ? E0 : E1; }
#pragma unroll
            for (int m = 0; m < 4; ++m) { const f32x4 pr = acc[ai][0][m][1]; f32x4 y;
                if (m > 0) { const f32x4 pv = acc[ai][0][m - 1][1];
#pragma unroll
                    for (int j = 0; j < 4; ++j) { F1[j] = dpp_f<0x121>(0.f, pv[j]); F2[j] = dpp_f<0x122>(0.f, pv[j]); } }
#pragma unroll
                for (int j = 0; j < 4; ++j) { const float p1 = dpp_f<0x111>(F1[j], pr[j]), p2 = dpp_f<0x112>(F2[j], pr[j]); y[j] = acc[ai][0][m][0][j] * (w0[j] * p2 + w1[j] * p1 + w2[j] * pr[j]); }
                const f32x4 pp = acc[ai][1][m][1];
                const auto s0 = __builtin_amdgcn_permlane16_swap(pk_bf16(y[0], y[1]), pk_bf16(pp[0], pp[1]), false, false), s1 = __builtin_amdgcn_permlane16_swap(pk_bf16(y[2], y[3]), pk_bf16(pp[2], pp[3]), false, false);
                *(u32x4*)(ya + (ptrdiff_t)(fq & 1) * (pu - ya) + (size_t)(row0 + ai * HALF + m * 16) * D + (ch0 & ~7)) = (u32x4){s0[0], s1[0], s0[1], s1[1]}; }
        }
        return false;
    }
};
struct EpiPlain {
    bf16_t* Ob; int ldc; size_t aux_stride;
    __device__ __forceinline__ bool operator()(Acc& acc, const Unit& u, int wr, int wc, int fr, int fq) const {
        bf16_t* O = Ob + (size_t)u.aux * aux_stride;
        const int row0 = u.pm * BM + wr * 64 + fr, col0 = u.pn * BM + wc * 32 + 8 * fq;
#pragma unroll
        for (int ai = 0; ai < 2; ++ai)
#pragma unroll
            for (int m = 0; m < 4; ++m) { bf16_t* rowp = O + (size_t)(row0 + ai * HALF + m * 16) * ldc + col0;
#pragma unroll
                for (int bj = 0; bj < 2; ++bj) *(u32x4*)(rowp + bj * HALF) = pack8(acc[ai][bj][m][0], acc[ai][bj][m][1]); }
        return false;
    }
};
struct EpiMoe2 {
    bf16_t* Y; bf16_t* YP;
    __device__ __forceinline__ bool operator()(Acc& acc, const Unit& u, int wr, int wc, int fr, int fq) const {
        bf16_t* O; int ldc;
        if (u.aux) { O = YP + (size_t)(u.aux - 1) * 65536 + (size_t)(wr * 64 + fr) * 256 + wc * 32 + 8 * fq; ldc = 256; }
        else { O = Y + (size_t)(u.pm * BM + wr * 64 + fr) * D + u.pn * BM + wc * 32 + 8 * fq; ldc = D; }
#pragma unroll
        for (int ai = 0; ai < 2; ++ai)
#pragma unroll
            for (int m = 0; m < 4; ++m) { bf16_t* rowp = O + (size_t)(ai * HALF + m * 16) * ldc;
#pragma unroll
                for (int bj = 0; bj < 2; ++bj) *(u32x4*)(rowp + bj * HALF) = pack8(acc[ai][bj][m][0], acc[ai][bj][m][1]); }
        return false;
    }
};
struct EpiMerge {
    const bf16_t* gates; bf16_t* O;
    __device__ __forceinline__ bool operator()(Acc& acc, const Unit& u, int wr, int wc, int fr, int fq) const {
        const int row0 = u.pm * BM + wr * 64 + fr, col0 = u.pn * BM + wc * 32 + 8 * fq, b = u.aux;
#pragma unroll
        for (int ai = 0; ai < 2; ++ai)
#pragma unroll
            for (int m = 0; m < 4; ++m) { const size_t row = (size_t)(row0 + ai * HALF + m * 16);
                const unsigned char* gp = (const unsigned char*)gates + gate_frag(u.pm, 4 * b + u.pn, wr * 4 + wc, ai, m, fr + 16 * fq);
                const u32x4 gw = *(const u32x4*)gp;
                if (b < 2) { const u32x4 hw = *(const u32x4*)(gp + gate_frag(0, 4, 0, 0, 0, 0));
#pragma unroll
                    for (int bj = 0; bj < 2; ++bj) { const f32x4 g0 = un_fp8x4(gw[2 * bj]), g1 = un_fp8x4(gw[2 * bj + 1]), h0 = un_fp8x4(hw[2 * bj]), h1 = un_fp8x4(hw[2 * bj + 1]);
#pragma unroll
                        for (int j = 0; j < 4; ++j) { acc[ai][bj][m][0][j] *= (1.f + h0[j]) * __builtin_amdgcn_rcpf(1.f + g0[j]); acc[ai][bj][m][1][j] *= (1.f + h1[j]) * __builtin_amdgcn_rcpf(1.f + g1[j]); } }
                } else {
#pragma unroll
                    for (int bj = 0; bj < 2; ++bj) { f32x4 g0 = un_fp8x4(gw[2 * bj]), g1 = un_fp8x4(gw[2 * bj + 1]);
#pragma unroll
                        for (int j = 0; j < 4; ++j) { g0[j] = __builtin_amdgcn_rcpf(1.f + g0[j]); g1[j] = __builtin_amdgcn_rcpf(1.f + g1[j]); }
                        *(u32x4*)(O + row * D + col0 + bj * HALF) = pack8(acc[ai][bj][m][0] * g0, acc[ai][bj][m][1] * g1); } } }
        return b < 2;
    }
};
struct EpiResid {
    const float* base32; bf16_t* xb; float* ssp; LAS float* red; unsigned char* x8;
    __device__ __forceinline__ bool operator()(Acc& acc, const Unit& u, int wr, int wc, int fr, int fq) const {
        const int row0 = u.pm * BM + wr * 64 + fr, col0 = u.pn * BM + wc * 32 + 8 * fq;
#pragma unroll
        for (int ai = 0; ai < 2; ++ai)
#pragma unroll
            for (int m = 0; m < 4; ++m) { const size_t row = (size_t)(row0 + ai * HALF + m * 16); float q = 0.f;
#pragma unroll
                for (int bj = 0; bj < 2; ++bj) { const size_t off = row * D + col0 + bj * HALF;
                    f32x4 b0, b1; if (base32) { b0 = *(const f32x4*)(base32 + off); b1 = *(const f32x4*)(base32 + off + 4); } else unpack8(*(const u32x4*)(xb + off), b0, b1);
                    const u32x4 pk = pack8(b0 + acc[ai][bj][m][0], b1 + acc[ai][bj][m][1]); *(u32x4*)(xb + off) = pk;
                    f32x4 o0, o1; unpack8(pk, o0, o1); if (x8) *(u32x2*)(x8 + off) = (u32x2){pk_fp8x4(o0), pk_fp8x4(o1)};
                    q += (o0[0] * o0[0] + o0[1] * o0[1]) + (o0[2] * o0[2] + o0[3] * o0[3]) + (o1[0] * o1[0] + o1[1] * o1[1]) + (o1[2] * o1[2] + o1[3] * o1[3]); }
                q += __shfl_xor(q, 16); q += __shfl_xor(q, 32);
                if (fq == 0) red[(ai * HALF + wr * 64 + m * 16 + fr) * 4 + wc] = q; }
        asm volatile("s_waitcnt lgkmcnt(0)" ::: "memory"); __builtin_amdgcn_s_barrier(); asm volatile("" ::: "memory");
        int tid = threadIdx.x; asm volatile("" : "+v"(tid));
        if (tid < 256) { const f32x4 v = *(const LAS f32x4*)(red + tid * 4); ssp[(size_t)(u.pm * BM + tid) * 4 + u.pn] = (v[0] + v[1]) + (v[2] + v[3]); }
        return false;
    }
};
template <bool PART4, bool OUT8> struct EpiSwiGLU {
    bf16_t* O; int ldc; const float* ss;
    __device__ __forceinline__ bool operator()(Acc& acc, const Unit& u, int wr, int wc, int fr, int fq) const {
        const int row0 = u.pm * BM + wr * 64 + fr, col0 = u.pn * 128 + wc * 32 + 8 * fq;
#pragma unroll
        for (int ai = 0; ai < 2; ++ai)
#pragma unroll
            for (int m = 0; m < 4; ++m) { const size_t row = (size_t)(row0 + ai * HALF + m * 16); float r = 1.f;
                if (PART4) { const f32x4 p = *(const f32x4*)(ss + row * 4); r = __builtin_amdgcn_rsqf(((p[0] + p[1]) + (p[2] + p[3])) * (1.0f / D) + RMS_EPS); }
                const f32x4 a0 = acc[ai][0][m][0] * r, a1 = acc[ai][0][m][1] * r, c0 = acc[ai][1][m][0] * r, c1 = acc[ai][1][m][1] * r;
                const f32x4 h0 = a0 * sig4(a0) * c0, h1 = a1 * sig4(a1) * c1;
                if (OUT8) { *(u32x2*)((unsigned char*)O + row * ldc + col0) = (u32x2){pk_fp8x4(h0 * F8_ACT_MUL), pk_fp8x4(h1 * F8_ACT_MUL)}; }
                else *(u32x4*)(O + row * ldc + col0) = pack8(h0, h1); }
        return false;
    }
};

typedef int i32x4 __attribute__((ext_vector_type(4)));
typedef int i32x8 __attribute__((ext_vector_type(8)));
__device__ __forceinline__ i32x8 join16(const bf16x8 lo, const bf16x8 hi) { return __builtin_shufflevector(__builtin_bit_cast(i32x4, lo), __builtin_bit_cast(i32x4, hi), 0, 1, 2, 3, 4, 5, 6, 7); }
template <class Epi, class Sched, bool F8 = false>
__device__ __forceinline__ void gemm_phase(LAS unsigned char* lds, const Gemm g, const Sched& S, const Epi& E) {
    int tid_ = threadIdx.x; asm volatile("" : "+v"(tid_));
    const int tid = tid_, wid = __builtin_amdgcn_readfirstlane(tid >> 6), lane = tid & 63, wr = wid >> 2, wc = wid & 3, fr = lane & 15, fq = lane >> 4;
    const int nt = g.Kb / 128;
    int vsa = g.sa, vsb = g.sb; asm volatile("" : "+v"(vsa), "+v"(vsb));
    unsigned voffA[2], voffB[2];
#pragma unroll
    for (int i = 0; i < 2; ++i) { int R, C; stage_rc(tid * 16 + i * 8192, R, C); const int Rb = (R & ~31) + perm32(R & 31);
        voffA[i] = (unsigned)(R * g.lda + C * 2); voffB[i] = (unsigned)(Rb * g.ldb + C * 2); }
    const size_t kstep = (size_t)(BK * 2);
    const size_t hstepA = (size_t)HALF * g.lda, hstepB = (size_t)HALF * g.ldb;
    const unsigned ldsw = (unsigned)wid * 1024u;
    const int aoff = lds_byte(wr * 64 + fr, fq * 8), boff = lds_byte(wc * 32 + fr, fq * 8);
#define PG8_SA(b, h) (((b) * 2 + (h)) * HTB)
#define PG8_SB(b, h) ((4 + (b) * 2 + (h)) * HTB)
#define PG8_STAGE(bufoff, gbase, voff) do { _Pragma("unroll") for (int _i = 0; _i < 2; ++_i) \
        __builtin_amdgcn_global_load_lds((const unsigned*)((const char*)(gbase) + (voff)[_i]), (LAS unsigned*)(lds + (bufoff) + ldsw + _i * 8192), 16, 0, 0); } while (0)
#define PG8_LDA(dst, b, h) do { _Pragma("unroll") for (int m = 0; m < 4; ++m) _Pragma("unroll") for (int k = 0; k < 2; ++k) dst[m][k] = *(const LAS bf16x8*)(lds + PG8_SA(b, h) + aoff + m * 2048 + k * 1024); } while (0)
#define PG8_LDB(dst, b, h) do { _Pragma("unroll") for (int n = 0; n < 2; ++n) _Pragma("unroll") for (int k = 0; k < 2; ++k) dst[n][k] = *(const LAS bf16x8*)(lds + PG8_SB(b, h) + boff + n * 2048 + k * 1024); } while (0)
#define PG8_MMA(ai, bj, At, Bt) do { __builtin_amdgcn_s_setprio(1); _Pragma("unroll") for (int m = 0; m < 4; ++m) _Pragma("unroll") for (int n = 0; n < 2; ++n) { \
        if constexpr (F8) { const i32x8 b8_ = join16(Bt[n][0], Bt[n][1]), a8_ = join16(At[m][0], At[m][1]); \
            asm volatile("v_mfma_scale_f32_16x16x128_f8f6f4 %0, %1, %2, %0, %3, %4 op_sel_hi:[0,0,0]" : "+v"(acc[ai][bj][m][n]) : "v"(b8_), "v"(a8_), "v"(vsb), "v"(vsa)); } \
        else { _Pragma("unroll") for (int k = 0; k < 2; ++k) acc[ai][bj][m][n] = __builtin_amdgcn_mfma_f32_16x16x32_bf16(Bt[n][k], At[m][k], acc[ai][bj][m][n], 0, 0, 0); } } __builtin_amdgcn_s_setprio(0); } while (0)
#define PG8_WAIT_V(n) asm volatile("s_waitcnt vmcnt(" #n ")" ::: "memory")
#define PG8_WAIT_L(n) asm volatile("s_waitcnt lgkmcnt(" #n ")" ::: "memory")
#define PG8_BAR __builtin_amdgcn_s_barrier()
#define PG8_SCHED __builtin_amdgcn_sched_barrier(0)
    Unit cur, nxt; int ui = 0;
    if (!S.next(0, cur)) return;
    Acc acc;
#pragma unroll
    for (int a = 0; a < 2; ++a)
#pragma unroll
        for (int b = 0; b < 2; ++b)
#pragma unroll
            for (int m = 0; m < 4; ++m)
#pragma unroll
                for (int n = 0; n < 2; ++n) acc[a][b][m][n] = (f32x4){0.f, 0.f, 0.f, 0.f};
    bf16x8 At[4][2], B0[2][2], B1[2][2];
    const char* cA = cur.A; const char* cB = cur.B;
    PG8_STAGE(PG8_SB(0, 0), cB, voffB); PG8_STAGE(PG8_SB(0, 1), cB + hstepB, voffB); PG8_STAGE(PG8_SA(0, 0), cA, voffA); PG8_STAGE(PG8_SA(0, 1), cA + hstepA, voffA);
    if (wr == 1) PG8_BAR;
    PG8_WAIT_V(2); PG8_BAR;
    PG8_STAGE(PG8_SB(1, 0), cB + kstep, voffB); PG8_STAGE(PG8_SA(1, 0), cA + kstep, voffA); PG8_STAGE(PG8_SB(1, 1), cB + hstepB + kstep, voffB);
    PG8_WAIT_V(6); PG8_BAR;
    for (;;) {
        const bool has_next = S.next(ui + 1, nxt);
        const char* nA = has_next ? nxt.A : cA; const char* nB = has_next ? nxt.B : cB;
        const int unt = cur.nt ? cur.nt : nt;
#pragma nounroll
        for (int t = 0; t < unt; t += 2) {
            const bool last = (t == unt - 2);
            const char* a1 = cA + (size_t)(t + 1) * kstep;
            const char* a2 = last ? nA : cA + (size_t)(t + 2) * kstep; const char* b2 = last ? nB : cB + (size_t)(t + 2) * kstep;
            const char* a3 = a2 + kstep; const char* b3 = b2 + kstep;
            PG8_LDB(B0, 0, 0); PG8_LDB(B1, 0, 1); PG8_SCHED; PG8_LDA(At, 0, 0); PG8_STAGE(PG8_SA(1, 1), a1 + hstepA, voffA);
            PG8_WAIT_V(8); PG8_WAIT_L(0); PG8_BAR; PG8_MMA(0, 0, At, B0); PG8_MMA(0, 1, At, B1); PG8_BAR; PG8_SCHED;
            PG8_LDA(At, 0, 1); PG8_STAGE(PG8_SB(0, 0), b2, voffB); PG8_STAGE(PG8_SB(0, 1), b2 + hstepB, voffB); PG8_STAGE(PG8_SA(0, 0), a2, voffA);
            PG8_WAIT_V(8); PG8_WAIT_L(0); PG8_BAR; PG8_MMA(1, 0, At, B0); PG8_MMA(1, 1, At, B1); PG8_BAR; PG8_SCHED;
            PG8_LDB(B0, 1, 0); PG8_LDB(B1, 1, 1); PG8_SCHED; PG8_LDA(At, 1, 0); PG8_STAGE(PG8_SA(0, 1), a2 + hstepA, voffA);
            PG8_WAIT_V(8); PG8_WAIT_L(0); PG8_BAR; PG8_MMA(0, 0, At, B0); PG8_MMA(0, 1, At, B1); PG8_BAR; PG8_SCHED;
            PG8_LDA(At, 1, 1); PG8_STAGE(PG8_SB(1, 0), b3, voffB); PG8_STAGE(PG8_SB(1, 1), b3 + hstepB, voffB); PG8_STAGE(PG8_SA(1, 0), a3, voffA);
            PG8_WAIT_V(8); PG8_WAIT_L(0); PG8_BAR; PG8_MMA(1, 0, At, B0); PG8_MMA(1, 1, At, B1); PG8_BAR; PG8_SCHED;
        }
        if constexpr (F8) asm volatile("s_nop 15\n\ts_nop 15" ::: "memory");
        if (wr == 0) PG8_BAR;
        const bool keep = E(acc, cur, wr, wc, fr, fq);
        if (!has_next) break;
        if (!keep) {
#pragma unroll
            for (int a = 0; a < 2; ++a)
#pragma unroll
                for (int b = 0; b < 2; ++b)
#pragma unroll
                    for (int m = 0; m < 4; ++m)
#pragma unroll
                        for (int n = 0; n < 2; ++n) acc[a][b][m][n] = (f32x4){0.f, 0.f, 0.f, 0.f};
        }
        cur = nxt; cA = nA; cB = nB; ++ui;
        if (wr == 1) PG8_BAR;
    }
    PG8_WAIT_V(0);
    PG8_BAR;
#undef PG8_SA
#undef PG8_SB
#undef PG8_STAGE
#undef PG8_LDA
#undef PG8_LDB
#undef PG8_MMA
#undef PG8_WAIT_V
#undef PG8_WAIT_L
#undef PG8_BAR
#undef PG8_SCHED
}
}

constexpr int RING_BYTES = 131072, MISC_OFF = RING_BYTES, RED_OFF = RING_BYTES + 1024, LDS_BYTES = 147456;

#define XB_TMO      128
#define XB_XCNT(j)  (256  + 64 * (j))
#define XB_XSUB(j)  (1280 + 64 * (j))
#define XB_XGEN(j)  (2304 + 64 * (j))
#define XB_TOP      3328
#define XB_TOPGEN   3392
#define XCD_BAR_WORDS 3456
#define XB_SPIN_CAP (1u << 18)
__device__ __forceinline__ unsigned xb_ld(unsigned* p)              { return __hip_atomic_load(p, __ATOMIC_RELAXED, __HIP_MEMORY_SCOPE_AGENT); }
__device__ __forceinline__ unsigned xb_add(unsigned* p, unsigned v) { return __hip_atomic_fetch_add(p, v, __ATOMIC_RELAXED, __HIP_MEMORY_SCOPE_AGENT); }
__device__ __forceinline__ unsigned xb_xcc_id() { return (unsigned)__builtin_amdgcn_s_getreg((3 << 11) | 20) & 0xFu; }
#define XB_SPIN(cond, bar) do { unsigned _sp = 0; while (cond) { __builtin_amdgcn_s_sleep(1); \
    if ((++_sp & 255u) == 0u) { if (xb_ld(&(bar)[XB_TMO])) break; if (_sp > XB_SPIN_CAP) { atomicAdd(&(bar)[XB_TMO], 1u); break; } } } } while (0)
struct XcdBarrier { unsigned* bar; unsigned x; volatile LAS unsigned* st; };
__device__ __forceinline__ XcdBarrier xcd_barrier_post(unsigned* bar, volatile LAS unsigned* st) {
    XcdBarrier b; b.bar = bar; b.x = xb_xcc_id(); b.st = st;
    if (threadIdx.x == 0) (void)xb_add(&bar[XB_XCNT(b.x)], 1u);
    return b;
}
__device__ __forceinline__ void xcd_barrier_complete(unsigned* bar, unsigned x, unsigned& nloc, unsigned& nx) {
    const unsigned G = gridDim.x * gridDim.y * gridDim.z;
    unsigned sum, cnt, mine, sp = 0u;
    for (;;) {
        sum = 0u; cnt = 0u; mine = 0u;
#pragma nounroll
        for (unsigned j = 0; j < 16; ++j) { const unsigned c = xb_ld(&bar[XB_XCNT(j)]); sum += c; cnt += (c > 0u) ? 1u : 0u; mine = (j == x) ? c : mine; }
        if (sum == G) break;
        __builtin_amdgcn_s_sleep(1);
        if ((++sp & 255u) == 0u) { if (xb_ld(&bar[XB_TMO])) break; if (sp > XB_SPIN_CAP) { atomicAdd(&bar[XB_TMO], 1u); break; } }
    }
    nloc = mine > 0u ? mine : 1u; nx = cnt > 0u ? cnt : 1u;
}
__device__ __forceinline__ void xcd_barrier(const XcdBarrier& b) {
    asm volatile("s_waitcnt vmcnt(0)" ::: "memory");
    __syncthreads();
    if (threadIdx.x == 0) {
        unsigned* bar = b.bar;
        __builtin_amdgcn_s_waitcnt(0);
        unsigned nloc = b.st[0], nx = b.st[1];
        if (nloc == 0u) { xcd_barrier_complete(bar, b.x, nloc, nx); b.st[0] = nloc; b.st[1] = nx; }
        const unsigned old = xb_add(&bar[XB_XSUB(b.x)], 1u);
        const unsigned gen = old / nloc;
        if (old + 1u == (gen + 1u) * nloc) {
            __builtin_amdgcn_fence(__ATOMIC_RELEASE, "agent");
            asm volatile("s_waitcnt vmcnt(0)" ::: "memory");
            const unsigned og = xb_add(&bar[XB_TOP], 1u);
            const unsigned tg = og / nx;
            if (og + 1u == (tg + 1u) * nx) xb_add(&bar[XB_TOPGEN], 1u);
            else XB_SPIN(xb_ld(&bar[XB_TOPGEN]) == tg, bar);
            __builtin_amdgcn_fence(__ATOMIC_ACQUIRE, "agent");
            xb_add(&bar[XB_XGEN(b.x)], 1u);
            asm volatile("s_waitcnt vmcnt(0)" ::: "memory");
        } else {
            XB_SPIN(xb_ld(&bar[XB_XGEN(b.x)]) == gen, bar);
            __builtin_amdgcn_fence(__ATOMIC_ACQUIRE, "agent");
            asm volatile("s_waitcnt vmcnt(0)" ::: "memory");
        }
    }
    __syncthreads();
}

struct Args { const float* in[23]; float* out; unsigned char* ws; int ph_lo, ph_hi; };
static_assert(sizeof(Args) == 23 * 8 + 8 + 8 + 8, "Args has no padding");
typedef const __attribute__((address_space(4))) Args* KArgs;
__device__ __forceinline__ KArgs kargs() { KArgs p = (KArgs)__builtin_amdgcn_kernarg_segment_ptr(); asm volatile("" : "+s"(p)); return p; }

__device__ __forceinline__ void transpose_item(const float* src, int ldn, int k0, int n0, bf16_t* dst, int ldk, const float* kscale, const float* nscale, int lane, bool perm = false) {
    const int r4 = lane >> 4, q = lane & 15, rq = perm ? 32 * (q >> 2) + 8 * (q & 3) : 4 * q;
    f32x4 v[16];
    const float* sp = src + (size_t)(k0 + 16 * r4) * ldn + n0 + 4 * q;
#pragma unroll
    for (int i = 0; i < 16; ++i) v[i] = __builtin_nontemporal_load((const f32x4*)(sp + (size_t)i * ldn));
    f32x4 ns = (f32x4){1.f, 1.f, 1.f, 1.f}; if (nscale) ns = *(const f32x4*)(nscale + n0 + 4 * q);
    if (kscale) {
        const f32x4* kp = (const f32x4*)(kscale + k0 + 16 * r4);
#pragma unroll
        for (int g = 0; g < 4; ++g) { const f32x4 ks = kp[g];
#pragma unroll
            for (int j = 0; j < 4; ++j) v[4 * g + j] = v[4 * g + j] * ks[j]; }
    }
#pragma unroll
    for (int e = 0; e < 4; ++e) { u32x4 lo, hi;
#pragma unroll
        for (int w = 0; w < 4; ++w) { lo[w] = pk_bf16(v[2 * w][e] * ns[e], v[2 * w + 1][e] * ns[e]); hi[w] = pk_bf16(v[8 + 2 * w][e] * ns[e], v[9 + 2 * w][e] * ns[e]); }
        bf16_t* o = dst + (size_t)(rq + e) * ldk + k0 + 16 * r4; *(u32x4*)o = lo; *(u32x4*)(o + 8) = hi; }
}
__device__ __forceinline__ void transpose_item_f8(const float* src, int ldn, int k0, int n0, unsigned char* dst, int ldk, const float* kscale, float mul, int lane) {
    const int r4 = lane >> 4, q = lane & 15;
    f32x4 v[16];
    const float* sp = src + (size_t)(k0 + 16 * r4) * ldn + n0 + 4 * q;
#pragma unroll
    for (int i = 0; i < 16; ++i) v[i] = __builtin_nontemporal_load((const f32x4*)(sp + (size_t)i * ldn));
    {
        const f32x4* kp = (const f32x4*)(kscale + k0 + 16 * r4);
#pragma unroll
        for (int g = 0; g < 4; ++g) { f32x4 ks = (f32x4){mul, mul, mul, mul}; if (kscale) ks = kp[g] * mul;
#pragma unroll
            for (int j = 0; j < 4; ++j) v[4 * g + j] = v[4 * g + j] * ks[j]; }
    }
#pragma unroll
    for (int e = 0; e < 4; ++e) { u32x4 o;
#pragma unroll
        for (int w = 0; w < 4; ++w) o[w] = pk_fp8x4((f32x4){v[4 * w][e], v[4 * w + 1][e], v[4 * w + 2][e], v[4 * w + 3][e]});
        *(u32x4*)(dst + (size_t)(4 * q + e) * ldk + k0 + 16 * r4) = o; }
}
__device__ __forceinline__ int win_row(int n0) {
    const int seg = n0 >> 10, c = n0 & 1023;
    if (seg == 1 || seg == 2) return 1024 + (c >> 7) * 256 + (seg == 2 ? 128 : 0) + (c & 127);
    if (seg == 3 || seg == 4) return 3072 + (c >> 7) * 256 + (seg == 4 ? 128 : 0) + (c & 127);
    return n0;
}
__device__ __forceinline__ int pair_row(int f, int second) { return (f >> 7) * 256 + (second ? 128 : 0) + (f & 127); }

__device__ __forceinline__ void prologue_phase(KArgs a, LAS unsigned char* lds, int wid, int lane) {
    asm volatile("" : "+v"(lane));
    const int gw = blockIdx.x * 8 + wid, NGW = gridDim.x * 8;
    unsigned char* ws = a->ws;
    constexpr int I_WIN = 16 * 144, I_SQ = 16 * 16, I_PW = 16, I_D1 = 16 * 56, I_D2 = 56 * 16;
    constexpr int NIT = 2 * I_WIN + 8 * I_SQ + 8 * I_PW + 2 * I_D1 + I_D2;
    for (int it = gw; it < NIT; it += NGW) {
        int r = it;
        if (r < 2 * I_WIN) { const int L = r / I_WIN; r -= L * I_WIN; const int kb = r / 144, nb = r % 144, n0 = 64 * nb;
            if (n0 >= 6144 || (n0 >= 3072 && n0 < 5120)) transpose_item_f8(a->in[2] + (size_t)L * D * INC, INC, 64 * kb, n0, ws + WS_WG8 + (size_t)L * 5 * MiB + (size_t)(n0 >= 6144 ? 2048 + (n0 - 6144) : win_row(n0) - 3072) * D, D, a->in[1] + L * D, F8_W13_MUL, lane);
            else { const int ty = n0 < 3072 ? n0 >> 10 : 3, T = (n0 & 1023) >> 6;
                transpose_item(a->in[2] + (size_t)L * D * INC, INC, 64 * kb, n0, (bf16_t*)(ws + WS_W0 + W0_WIN + (size_t)L * 18 * MiB) + (size_t)(256 * T + 128 * (ty >> 1) + 4 * (ty & 1)) * D, D, a->in[1] + L * D, nullptr, lane, true); }
            continue; }
        r -= 2 * I_WIN;
        if (r < 8 * I_SQ) { const int j = r / I_SQ; r -= j * I_SQ; const int L = j >> 2, w = j & 3, kb = r / 16, nb = r % 16, n0 = 64 * nb;
            bf16_t* dst = w < 3 ? (bf16_t*)(ws + WS_W0 + W0_WOUT + (size_t)(L * 3 + w) * 2 * MiB) : (bf16_t*)(ws + WS_W0 + W0_WO + (size_t)L * 2 * MiB);
            transpose_item(a->in[10 + w] + (size_t)L * D * D, D, 64 * kb, n0, dst + (size_t)n0 * D, D, nullptr, nullptr, lane); continue; }
        r -= 8 * I_SQ;
        if (r < 8 * I_PW) { const int j = r / I_PW; r -= j * I_PW; const int L = j >> 2, g = j & 3;
            const float* src = a->in[8] + (size_t)(L * 4 + g) * 65536 + (size_t)r * 16 * 256; const float* sc = a->in[9] + L * D + g * 256;
            bf16_t* dst = (bf16_t*)(ws + WS_W0 + W0_POOL + (size_t)L * 512 * 1024) + (size_t)g * 65536 + (size_t)r * 16 * 256; const f32x4 s4 = *(const f32x4*)(sc + 4 * lane);
#pragma unroll
            for (int i = 0; i < 16; ++i) { const f32x4 v = *(const f32x4*)(src + i * 256 + 4 * lane) * s4; u32x2 w; w.x = pk_bf16(v[0], v[1]); w.y = pk_bf16(v[2], v[3]); *(u32x2*)(dst + i * 256 + 4 * lane) = w; }
            continue; }
        r -= 8 * I_PW;
        if (r < 2 * I_D1) { const int w = r / I_D1; r -= w * I_D1; const int kb = r / 56, nb = r % 56, n0 = 64 * nb;
            transpose_item(a->in[15 + w], DFF, 64 * kb, n0, (bf16_t*)(ws + WS_W0 + W0_D13) + (size_t)pair_row(n0, w) * D, D, a->in[14], nullptr, lane); continue; }
        r -= 2 * I_D1;
        { const int kb = r / 16, nb = r % 16, n0 = 64 * nb;
            transpose_item(a->in[17], D, 64 * kb, n0, (bf16_t*)(ws + WS_W0 + W0_D2) + (size_t)n0 * DFF, DFF, nullptr, nullptr, lane); }
    }
    const float* x = a->in[0]; bf16_t* xb = (bf16_t*)(ws + WS_XB); f32x4* ss0 = (f32x4*)(ws + WS_SS); unsigned char* x8 = ws + WS_X8;
    for (int m = gw; m < M; m += NGW) {
        const f32x4* xr = (const f32x4*)(x + (size_t)m * D) + lane; u32x2* o = (u32x2*)(xb + (size_t)m * D) + lane; float s = 0.f;
#pragma unroll
        for (int j = 0; j < 4; ++j) { const f32x4 v = xr[64 * j]; s += (v[0] * v[0] + v[1] * v[1]) + (v[2] * v[2] + v[3] * v[3]); u32x2 w; w.x = pk_bf16(v[0], v[1]); w.y = pk_bf16(v[2], v[3]); o[64 * j] = w;
            *((unsigned*)(x8 + (size_t)m * D) + lane + 64 * j) = pk_fp8x4(v); }
        s = wave_sum(s); if (lane == 0) ss0[m] = (f32x4){s, 0.f, 0.f, 0.f};
    }
}

__device__ __forceinline__ void dma_block16(const bf16_t* src, LAS unsigned char* dst, int wid, int lane) {
#pragma unroll
    for (int k = 0; k < 4; ++k) { const int h = wid * 4 + k;
        __builtin_amdgcn_global_load_lds((const unsigned*)((const char*)src + h * 1024 + lane * 16), (LAS unsigned*)(dst + h * 1024), 16, 0, 0); }
}
__device__ __forceinline__ void zero_block16(LAS unsigned char* dst, int tid) {
#pragma unroll
    for (int k = 0; k < 4; ++k) *(LAS u32x4*)(dst + (size_t)(tid + 512 * k) * 16) = (u32x4){0u, 0u, 0u, 0u};
}
template <int I> __device__ __forceinline__ void conv31_pair(const LAS unsigned char* col, const unsigned (&wp)[31], f32x2 bias, f32x2 (&acc)[16]) {
    f32x2 x[46];
#pragma unroll
    for (int i = 0; i < 46; ++i) { const int r = i - 30, j = I + (r >> 4); const unsigned u = *(const LAS unsigned*)(col + ((j + 2) & 3) * 32768 + (r & 15) * 2048); x[i] = (f32x2){bf_lo(u), bf_hi(u)}; }
#pragma unroll
    for (int j = 0; j < 16; ++j) acc[j] = bias;
#pragma unroll
    for (int k = 0; k < 31; ++k) { const f32x2 wk = (f32x2){bf_lo(wp[k]), bf_hi(wp[k])};
#pragma unroll
        for (int j = 0; j < 16; ++j) acc[j] = __builtin_elementwise_fma(wk, x[j + k], acc[j]); }
}
template <int I, int CH> __device__ __forceinline__ void pool_ch(const LAS unsigned char* col, int g, int s0, float (&p)[16]) {
    float x[31], tv[16];
#pragma unroll
    for (int i = 0; i < 31; ++i) { const int r = i - 15, j = I + (r >> 4); const unsigned u = *(const LAS unsigned*)(col + ((j + 1) % 3) * 32768 + (r & 15) * 2048); x[i] = CH ? bf_hi(u) : bf_lo(u); }
#pragma unroll
    for (int j = 0; j < 16; ++j) tv[j] = x[15 + j];
#pragma unroll
    for (int i = 30; i >= 1; --i) x[i] += x[i - 1];
    if (g >= 1) {
#pragma unroll
        for (int i = 30; i >= 2; --i) x[i] += x[i - 2]; }
    if (g >= 2) {
#pragma unroll
        for (int i = 30; i >= 4; --i) x[i] += x[i - 4]; }
    if (g >= 3) {
#pragma unroll
        for (int i = 30; i >= 8; --i) x[i] += x[i - 8]; }
    const int w = 2 << g;
#pragma unroll
    for (int j = 0; j < 16; ++j) { const int cnt = min(s0 + j + 1, w); p[j] = x[15 + j] * (1.0f / (float)cnt) - tv[j]; }
}
struct ConvB { const bf16_t* GLU; __amdgpu_buffer_rsrc_t rVB; LAS unsigned char* lds; LAS float* red; LAS float* stat; f32x2 bb, gg, be; };
template <int I> __device__ __forceinline__ void convB_tile(const ConvB& c, unsigned (&wp)[31], int T0, int tid, int wid, int lane) {
    const int t0 = T0 + 16 * I; const LAS unsigned char* col = c.lds + 4 * tid;
#pragma unroll
    for (int k = 0; k < 31; ++k) asm volatile("" : "+v"(wp[k]));
    if (I < 3) dma_block16(c.GLU + (size_t)(t0 + 16) * D, c.lds + ((I + 3) & 3) * 32768, wid, lane);
    float a0[16], a1[16];
    { f32x2 ap[16]; conv31_pair<I>(col, wp, c.bb, ap);
#pragma unroll
      for (int j = 0; j < 16; ++j) { a0[j] = ap[j].x; a1[j] = ap[j].y; } }
    {
        float v[32];
#pragma unroll
        for (int j = 0; j < 16; ++j) { v[j] = a0[j] + a1[j]; v[16 + j] = a0[j] * a0[j] + a1[j] * a1[j]; }
#pragma unroll
        for (int i = 0; i < 16; ++i) { const bool b = lane & 32; const float send = b ? v[i] : v[i + 16], keep = b ? v[i + 16] : v[i]; v[i] = keep + __shfl_xor(send, 32); }
#pragma unroll
        for (int i = 0; i < 8; ++i) { const bool b = lane & 16; const float send = b ? v[i] : v[i + 8], keep = b ? v[i + 8] : v[i]; v[i] = keep + __shfl_xor(send, 16); }
#pragma unroll
        for (int i = 0; i < 4; ++i) { const bool b = lane & 8; const float send = b ? v[i] : v[i + 4], keep = b ? v[i + 4] : v[i]; v[i] = keep + __shfl_xor(send, 8); }
#pragma unroll
        for (int i = 0; i < 2; ++i) { const bool b = lane & 4; const float send = b ? v[i] : v[i + 2], keep = b ? v[i + 2] : v[i]; v[i] = keep + __shfl_xor(send, 4); }
        { const bool b = lane & 2; const float send = b ? v[0] : v[1], keep = b ? v[1] : v[0]; v[0] = keep + __shfl_xor(send, 2); }
        v[0] += __shfl_xor(v[0], 1);
        const int idx = ((lane >> 5) & 1) * 16 + ((lane >> 4) & 1) * 8 + ((lane >> 3) & 1) * 4 + ((lane >> 2) & 1) * 2 + ((lane >> 1) & 1);
        if (!(lane & 1)) c.red[wid * 32 + idx] = v[0];
    }
    __syncthreads();
    if (tid < 16) { float s = 0.f, q = 0.f;
#pragma unroll
        for (int w = 0; w < 8; ++w) { s += c.red[w * 32 + tid]; q += c.red[w * 32 + 16 + tid]; }
        const float mean = s * (1.0f / D), var = fmaxf(q * (1.0f / D) - mean * mean, 0.f);
        c.stat[2 * tid] = mean; c.stat[2 * tid + 1] = __builtin_amdgcn_rsqf(var + LN_EPS); }
    asm volatile("s_waitcnt vmcnt(0)" ::: "memory");
    __syncthreads();
#pragma unroll
    for (int j = 0; j < 16; ++j) { const float mean = c.stat[2 * j], rstd = c.stat[2 * j + 1];
        const float y0 = (a0[j] - mean) * rstd * c.gg.x + c.be.x, y1 = (a1[j] - mean) * rstd * c.gg.y + c.be.y;
        __builtin_amdgcn_raw_buffer_store_b32(pk_bf16(y0 * sigm(y0), y1 * sigm(y1)), c.rVB, 4 * tid, (t0 + j) * (D * 2), 0); }
}
struct ConvAC { const bf16_t* PU; __amdgpu_buffer_rsrc_t rPP; LAS unsigned char* lds; };
template <int I> __device__ __forceinline__ void convAC_tile(const ConvAC& c, int T0, int tid, int wid, int lane) {
    const int t0 = T0 + 16 * I, s0 = t0 & (SEQ - 1); const LAS unsigned char* col = c.lds + 4 * tid;
    if (I < 3) dma_block16(c.PU + (size_t)(t0 + 16) * D, c.lds + ((I + 2) % 3) * 32768, wid, lane);
    asm volatile("" ::: "memory");
    {
        float p0[16], p1[16];
        pool_ch<I, 0>(col, wid >> 1, s0, p0);
#pragma unroll
        for (int j = 0; j < 16; ++j) asm volatile("" : "+v"(p0[j]) :: "memory");
        pool_ch<I, 1>(col, wid >> 1, s0, p1);
#pragma unroll
        for (int j = 0; j < 16; ++j) __builtin_amdgcn_raw_buffer_store_b32(pk_bf16(p0[j], p1[j]), c.rPP, 4 * tid, (t0 + j) * (D * 2), 0);
    }
    if (I < 3) asm volatile("s_waitcnt vmcnt(16)" ::: "memory");
    __syncthreads();
}
__device__ __forceinline__ void conv_phase(KArgs a, int layer, LAS unsigned char* lds, int tid, int wid, int lane) {
    asm volatile("" : "+v"(tid), "+v"(lane));
    unsigned char* ws = a->ws;
    const int G = gridDim.x;
    const int vcu = (G % 8 == 0) ? (int)(blockIdx.x % 8) * (G / 8) + (int)(blockIdx.x / 8) : (int)blockIdx.x;
    const int c2 = 2 * tid;
    {
        const float* cfw = a->in[4] + layer * 31 * D; const float* cfb = a->in[5] + layer * D; const float* lng = a->in[6] + layer * D; const float* lnb = a->in[7] + layer * D;
        ConvB c; c.GLU = (const bf16_t*)(ws + A_GLU); c.rVB = __builtin_amdgcn_make_buffer_rsrc((void*)(ws + A_VB), 0, 0x7fffffff, 0x00020000);
        c.lds = lds; c.red = (LAS float*)(lds + RED_OFF); c.stat = c.red + 256;
        unsigned wp[31];
#pragma unroll
        for (int k = 0; k < 31; ++k) { const f32x2 w = *(const f32x2*)(cfw + k * D + c2); wp[k] = pk_bf16(w.x, w.y); }
        c.bb = *(const f32x2*)(cfb + c2); c.gg = *(const f32x2*)(lng + c2); c.be = *(const f32x2*)(lnb + c2);
        asm volatile("" :: "v"(c.bb.x), "v"(c.bb.y), "v"(c.gg.x), "v"(c.gg.y), "v"(c.be.x), "v"(c.be.y));
        for (int rp2 = 0; rp2 < REPS2(21); ++rp2)
        for (int sup = vcu; sup < M / 64; sup += G) {
            const int T0 = sup * 64; const bool seq0 = (T0 & (SEQ - 1)) == 0;
            if (seq0) { zero_block16(lds, tid); zero_block16(lds + 32768, tid); } else { dma_block16(c.GLU + (size_t)(T0 - 32) * D, lds, wid, lane); dma_block16(c.GLU + (size_t)(T0 - 16) * D, lds + 32768, wid, lane); }
            dma_block16(c.GLU + (size_t)T0 * D, lds + 65536, wid, lane);
            asm volatile("s_waitcnt vmcnt(0)" ::: "memory");
            __syncthreads();
            convB_tile<0>(c, wp, T0, tid, wid, lane); convB_tile<1>(c, wp, T0, tid, wid, lane); convB_tile<2>(c, wp, T0, tid, wid, lane); convB_tile<3>(c, wp, T0, tid, wid, lane);
            __syncthreads();
        }
    }
    __syncthreads();
    {
        const float* scw = a->in[3] + layer * 3 * D; const float* halo = (const float*)(ws + WS_HALO); bf16_t* YA = (bf16_t*)(ws + A_YA);
        ConvAC c; c.PU = (const bf16_t*)(ws + A_PU); c.lds = lds;
        c.rPP = __builtin_amdgcn_make_buffer_rsrc((void*)(ws + A_PP), 0, 0x7fffffff, 0x00020000);
        for (int rp2 = 0; rp2 < REPS2(22); ++rp2)
        for (int sup = vcu; sup < M / 64; sup += G) {
            const int T0 = sup * 64; const bool seq0 = (T0 & (SEQ - 1)) == 0;
            if (seq0) zero_block16(lds, tid); else dma_block16(c.PU + (size_t)(T0 - 16) * D, lds, wid, lane);
            dma_block16(c.PU + (size_t)T0 * D, lds + 32768, wid, lane);
            if ((sup & 3) == 0) { const int pm = sup >> 2;
                const f32x2 s0w = *(const f32x2*)(scw + c2), s1w = *(const f32x2*)(scw + D + c2), s2w = *(const f32x2*)(scw + 2 * D + c2);
                const f32x2 b0 = *(const f32x2*)(halo + (size_t)((0 * 64 + pm) * 2 + 0) * D + c2), b1 = *(const f32x2*)(halo + (size_t)((0 * 64 + pm) * 2 + 1) * D + c2);
                const f32x2 q0 = *(const f32x2*)(halo + (size_t)((1 * 64 + pm) * 2 + 0) * D + c2), q1 = *(const f32x2*)(halo + (size_t)((1 * 64 + pm) * 2 + 1) * D + c2);
                f32x2 pa = (f32x2){0.f, 0.f}, pb = pa;
                if (!seq0) { pa = *(const f32x2*)(halo + (size_t)((2 * 64 + pm - 1) * 2 + 0) * D + c2); pb = *(const f32x2*)(halo + (size_t)((2 * 64 + pm - 1) * 2 + 1) * D + c2); }
                const f32x2 y0 = b0 * (s0w * pa + s1w * pb + s2w * q0), y1 = b1 * (s0w * pb + s1w * q0 + s2w * q1);
                *(unsigned*)(YA + (size_t)T0 * D + c2) = pk_bf16(y0.x, y0.y); *(unsigned*)(YA + (size_t)(T0 + 1) * D + c2) = pk_bf16(y1.x, y1.y); }
            asm volatile("s_waitcnt vmcnt(0)" ::: "memory");
            __syncthreads();
            convAC_tile<0>(c, T0, tid, wid, lane); convAC_tile<1>(c, T0, tid, wid, lane); convAC_tile<2>(c, T0, tid, wid, lane); convAC_tile<3>(c, T0, tid, wid, lane);
        }
    }
}

__device__ __forceinline__ void route_phase(KArgs a, LAS unsigned char* lds, int tid, int wid, int lane) {
    asm volatile("" : "+v"(tid), "+v"(lane));
    unsigned char* ws = a->ws;
    const bf16_t* X = (const bf16_t*)(ws + WS_XB); const float* gn = a->in[14] + D; const float* R = a->in[18];
    const f32x4* ss3 = (const f32x4*)(ws + WS_SS) + 3 * M;
    int* tope = (int*)(ws + WS_SMALL + SM_TOPE); f32x2* topp = (f32x2*)(ws + WS_SMALL + SM_TOPP); int* cntb = (int*)(ws + WS_CTL + CTL_CNT);
    LAS int* lcnt = (LAS int*)(lds + 98304);
    float wgt[2][8][8];
#pragma unroll
    for (int h = 0; h < 2; ++h)
#pragma unroll
        for (int i = 0; i < 8; ++i) { const int k = 8 * lane + 512 * h + i; const float g = gn[k]; const f32x4 r0 = *(const f32x4*)(R + k * 8), r1 = *(const f32x4*)(R + k * 8 + 4);
#pragma unroll
            for (int e = 0; e < 4; ++e) { wgt[h][i][e] = g * r0[e]; wgt[h][i][4 + e] = g * r1[e]; } }
    for (int vb = blockIdx.x; vb < 256; vb += gridDim.x) {
        if (tid < 8) lcnt[tid] = 0;
        __syncthreads();
        for (int i8 = 0; i8 < 8; ++i8) {
            const int t = vb * 64 + wid * 8 + i8;
            float lg[8];
#pragma unroll
            for (int e = 0; e < 8; ++e) lg[e] = 0.f;
#pragma unroll
            for (int h = 0; h < 2; ++h) { f32x4 v0, v1; pg8::unpack8(*(const u32x4*)(X + (size_t)t * D + 512 * h + 8 * lane), v0, v1);
#pragma unroll
                for (int i = 0; i < 4; ++i)
#pragma unroll
                    for (int e = 0; e < 8; ++e) { lg[e] = fmaf(v0[i], wgt[h][i][e], lg[e]); lg[e] = fmaf(v1[i], wgt[h][4 + i][e], lg[e]); } }
#pragma unroll
            for (int e = 0; e < 8; ++e) lg[e] = wave_sum(lg[e]);
            const f32x4 sp = ss3[t]; const float rstd = __builtin_amdgcn_rsqf(((sp[0] + sp[1]) + (sp[2] + sp[3])) * (1.0f / D) + RMS_EPS);
            int e1 = 0; float v1 = lg[0];
#pragma unroll
            for (int e = 1; e < 8; ++e) if (lg[e] > v1) { v1 = lg[e]; e1 = e; }
            int e2 = e1 == 0 ? 1 : 0; float v2 = -__builtin_inff();
#pragma unroll
            for (int e = 0; e < 8; ++e) if (e != e1 && lg[e] > v2) { v2 = lg[e]; e2 = e; }
            const float ex = __expf((v2 - v1) * rstd), p1 = 1.0f / (1.0f + ex), p2 = ex * p1;
            if (lane == 0) { tope[t] = e1 | (e2 << 8); topp[t] = (f32x2){p1, p2}; atomicAdd((int*)&lcnt[e1], 1); atomicAdd((int*)&lcnt[e2], 1); }
        }
        __syncthreads();
        if (tid < 8) cntb[vb * 8 + tid] = lcnt[tid];
        __syncthreads();
    }
    const int gw = blockIdx.x * 8 + wid, NGW = gridDim.x * 8;
    constexpr int I_1 = 16 * 56, I_13 = 2 * I_1, I_2 = 56 * 16;
    unsigned char* w13 = ws + WS_WMOE; unsigned char* w2t = ws + WS_WMOE + WMOE_W2;
    for (int it = gw; it < NE * (I_13 + I_2); it += NGW) {
        int r = it;
        if (r < NE * I_13) { const int e = r / I_13; r -= e * I_13; const int w = r / I_1; r -= w * I_1; const int kb = r / 56, nb = r % 56, n0 = 64 * nb;
            transpose_item_f8(a->in[19 + w] + (size_t)e * D * DFF, DFF, 64 * kb, n0, w13 + (size_t)e * (2 * DFF) * D + (size_t)pair_row(n0, w) * D, D, gn, F8_W13_MUL, lane); continue; }
        r -= NE * I_13;
        { const int e = r / I_2; r -= e * I_2; const int kb = r / 16, nb = r % 16, n0 = 64 * nb;
            transpose_item_f8(a->in[21] + (size_t)e * DFF * D, D, 64 * kb, n0, w2t + (size_t)e * D * DFF + (size_t)n0 * DFF, DFF, nullptr, F8_W2_MUL, lane); }
    }
}

__device__ __forceinline__ void scatter_phase(KArgs a, LAS unsigned char* lds, int tid, int wid, int lane) {
    asm volatile("" : "+v"(tid), "+v"(lane));
    unsigned char* ws = a->ws;
    const int* tope = (const int*)(ws + WS_SMALL + SM_TOPE); int* tslot = (int*)(ws + WS_SMALL + SM_TSLOT); float* ssperm = (float*)(ws + WS_SMALL + SM_SSPERM); int* meta = (int*)(ws + WS_SMALL + SM_META);
    const int* cntb = (const int*)(ws + WS_CTL + CTL_CNT); const f32x4* ss3 = (const f32x4*)(ws + WS_SS) + 3 * M;
    const bf16_t* X = (const bf16_t*)(ws + WS_XB); unsigned char* AP = ws + WS_APERM;
    LAS int* lc = (LAS int*)lds;
    LAS int* lbase = lc + 2048;
    LAS int* lslot = lc + 2064;
    LAS int* ltot = lc + 2200;
    for (int i = tid; i < 2048; i += 512) lc[i] = __hip_atomic_load(cntb + i, __ATOMIC_RELAXED, __HIP_MEMORY_SCOPE_AGENT);
    __syncthreads();
    for (int vb = blockIdx.x; vb < 256; vb += gridDim.x) {
        if (tid < 8) { int tot = 0, pre = 0;
#pragma unroll 8
            for (int b = 0; b < 256; ++b) { const int v = lc[b * 8 + tid]; tot += v; pre += (b < vb) ? v : 0; }
            ltot[tid] = tot; lbase[tid] = pre; }
        __syncthreads();
        if (tid == 0) { int off = 0;
            for (int e = 0; e < 8; ++e) { lbase[e] += off; if (vb == 0) meta[e] = off >> 8; off += (ltot[e] + 255) & ~255; }
            if (vb == 0) meta[8] = off >> 8; }
        __syncthreads();
        if (wid == 0) {
            const int t = vb * 64 + lane; const int te = tope[t]; const int e1 = te & 0xff, e2 = (te >> 8) & 0xff;
            int s1 = 0, s2 = 0;
#pragma unroll
            for (int k = 0; k < 2; ++k) { const int ek = k ? e2 : e1; int sk = 0;
#pragma unroll
                for (int e = 0; e < 8; ++e) { const unsigned long long mask = __ballot(ek == e); const int base = lbase[e]; LDS_WAIT();
                    const int rank = __popcll(mask & ((1ull << lane) - 1ull)); if (ek == e) sk = base + rank;
                    if (lane == 0) lbase[e] = base + __popcll(mask); LDS_WAIT(); }
                if (k) s2 = sk; else s1 = sk; }
            *(int2*)(tslot + 2 * t) = make_int2(s1, s2); lslot[lane] = s1; lslot[64 + lane] = s2;
        }
        __syncthreads();
        {
            u32x4 xv[8][2]; f32x4 sp[8];
#pragma unroll
            for (int i = 0; i < 8; ++i) { const int t = vb * 64 + wid + 8 * i; const u32x4* src = (const u32x4*)(X + (size_t)t * D) + 2 * lane; xv[i][0] = src[0]; xv[i][1] = src[1]; sp[i] = ss3[t]; }
#pragma unroll
            for (int i = 0; i < 8; ++i) { const int r = wid + 8 * i, s1 = lslot[r], s2 = lslot[64 + r];
                const float rstd = __builtin_amdgcn_rsqf(((sp[i][0] + sp[i][1]) + (sp[i][2] + sp[i][3])) * (1.0f / D) + RMS_EPS);
                f32x4 v0, v1, v2, v3; pg8::unpack8(xv[i][0], v0, v1); pg8::unpack8(xv[i][1], v2, v3);
                const u32x4 q = (u32x4){pk_fp8x4(v0 * rstd), pk_fp8x4(v1 * rstd), pk_fp8x4(v2 * rstd), pk_fp8x4(v3 * rstd)};
                *((u32x4*)(AP + (size_t)s1 * D) + lane) = q; *((u32x4*)(AP + (size_t)s2 * D) + lane) = q; } }
        __syncthreads();
    }
}

__device__ __forceinline__ void combine_phase(KArgs a, LAS unsigned char* lds, int tid, int wid, int lane) {
    asm volatile("" : "+v"(lane), "+v"(tid));
    unsigned char* ws = a->ws;
    LAS int* tmap = (LAS int*)lds; const bf16_t* YP = (const bf16_t*)(ws + WS_YP);
    int split;
    { const int nMraw = __builtin_amdgcn_readfirstlane(__hip_atomic_load((const int*)(ws + WS_SMALL + SM_META) + 8, __ATOMIC_RELAXED, __HIP_MEMORY_SCOPE_AGENT)); const int nM = nMraw > MAXSLOT / 256 ? MAXSLOT / 256 : nMraw;
      const int G = (int)gridDim.x, nU = 4 * nM, R = nU / G, tail = nU - R * G; split = (tail > 0 && pg8::MOE2_SPL * tail <= G) ? 1 : 0;
      for (int i = tid; i < 4 * (MAXSLOT / 256); i += 512) tmap[i] = -1;
      __syncthreads();
      if (split && tid < tail) { int pm, pn; if (pg8::tile_of(R * G + tid, nM, 4, pm, pn, 4)) tmap[4 * pm + pn] = tid; }
      __syncthreads(); }
    const bf16_t* X = (const bf16_t*)(ws + WS_XB); const bf16_t* Y = (const bf16_t*)(ws + WS_Y); const int* tslot = (const int*)(ws + WS_SMALL + SM_TSLOT); const f32x2* topp = (const f32x2*)(ws + WS_SMALL + SM_TOPP);
    const float* gf = a->in[22]; float* out = a->out;
    const int gw = blockIdx.x * 8 + wid, NGW = gridDim.x * 8;
    f32x4 gv[4];
#pragma unroll
    for (int h = 0; h < 2; ++h) { gv[2 * h] = *(const f32x4*)(gf + 512 * h + 8 * lane); gv[2 * h + 1] = *(const f32x4*)(gf + 512 * h + 8 * lane + 4); }
    for (int tb = gw; tb < M; tb += 4 * NGW) {
        int2 sl[4]; f32x2 p[4];
#pragma unroll
        for (int i = 0; i < 4; ++i) { const int t = min(tb + i * NGW, M - 1); sl[i] = *(const int2*)(tslot + 2 * t); p[i] = topp[t]; }
        u32x4 xr[4][2], ya[4][2], yb[4][2];
#pragma unroll
        for (int i = 0; i < 4; ++i) { const int t = min(tb + i * NGW, M - 1);
#pragma unroll
            for (int h = 0; h < 2; ++h) { const int col = 512 * h + 8 * lane;
                xr[i][h] = *(const u32x4*)(X + (size_t)t * D + col); ya[i][h] = *(const u32x4*)(Y + (size_t)sl[i].x * D + col); yb[i][h] = *(const u32x4*)(Y + (size_t)sl[i].y * D + col); } }
#pragma unroll
        for (int i = 0; i < 4; ++i) { const int t = tb + i * NGW; if (t < M) {
            f32x4 v[4]; float s = 0.f;
#pragma unroll
            for (int h = 0; h < 2; ++h) { f32x4 x0, x1, a0, a1, b0, b1; pg8::unpack8(xr[i][h], x0, x1); pg8::unpack8(ya[i][h], a0, a1); pg8::unpack8(yb[i][h], b0, b1);
                if (split) { const int pn = 2 * h + (lane >> 5), cl = 8 * (lane & 31);
                    const int ka = tmap[4 * (sl[i].x >> 8) + pn], kb = tmap[4 * (sl[i].y >> 8) + pn];
                    if (ka >= 0) { a0 = (f32x4){0.f, 0.f, 0.f, 0.f}; a1 = a0;
                        for (int p = 0; p < pg8::MOE2_SPL; ++p) { f32x4 t0, t1; pg8::unpack8(*(const u32x4*)(YP + (size_t)(ka * pg8::MOE2_SPL + p) * 65536 + (size_t)(sl[i].x & 255) * 256 + cl), t0, t1); a0 += t0; a1 += t1; } }
                    if (kb >= 0) { b0 = (f32x4){0.f, 0.f, 0.f, 0.f}; b1 = b0;
                        for (int p = 0; p < pg8::MOE2_SPL; ++p) { f32x4 t0, t1; pg8::unpack8(*(const u32x4*)(YP + (size_t)(kb * pg8::MOE2_SPL + p) * 65536 + (size_t)(sl[i].y & 255) * 256 + cl), t0, t1); b0 += t0; b1 += t1; } } }
                v[2 * h] = x0 + a0 * p[i].x + b0 * p[i].y; v[2 * h + 1] = x1 + a1 * p[i].x + b1 * p[i].y; }
#pragma unroll
            for (int k = 0; k < 4; ++k) s += (v[k][0] * v[k][0] + v[k][1] * v[k][1]) + (v[k][2] * v[k][2] + v[k][3] * v[k][3]);
            const float rstd = __builtin_amdgcn_rsqf(wave_sum(s) * (1.0f / D) + RMS_EPS);
#pragma unroll
            for (int h = 0; h < 2; ++h) { const int col = 512 * h + 8 * lane;
                *(f32x4*)(out + (size_t)t * D + col) = v[2 * h] * rstd * gv[2 * h]; *(f32x4*)(out + (size_t)t * D + col + 4) = v[2 * h + 1] * rstd * gv[2 * h + 1]; } } }
    }
}

#ifndef WGM_INPROJ
#define WGM_INPROJ 4
#endif
#ifndef WGM_FFN1
#define WGM_FFN1 4
#endif
#ifndef WGM_MOE1
#define WGM_MOE1 4
#endif
constexpr int NPH = 18;
#ifndef MK_PH_MASK
#define MK_PH_MASK 0xFFFFFFFFu
#endif
#define PHON(bit) ((((MK_PH_MASK) >> (bit)) & 1u) != 0u)


__device__ __forceinline__ void ph_inproj(KArgs a, int layer, LAS unsigned char* lds) {
    unsigned char* ws = a->ws;
    {
        pg8::Gemm g{2 * D, 2 * D, 2 * D, 0, 0}; pg8::PlainSched S{M / 256, 16, (int)gridDim.x, (int)blockIdx.x, (const char*)(ws + WS_XB), (const char*)(ws + WS_W0 + W0_WIN + (size_t)layer * 18 * MiB), (size_t)256 * D * 2, (size_t)256 * D * 2, WGM_INPROJ, 1 << 30, 0};
        pg8::EpiSc E{(bf16_t*)(ws + A_YA), (bf16_t*)(ws + A_PU), (const f32x4*)(ws + WS_SS) + (size_t)(layer * 2) * M, a->in[3] + layer * 3 * D, (float*)(ws + WS_HALO), (LAS float*)(lds + RED_OFF)};
        pg8::gemm_phase(lds, g, S, E);
    }
    __syncthreads();
    {
        pg8::Gemm g{D, D, D, F8_ONE, F8_W13_SC}; pg8::PlainSched S{M / 256, 20, (int)gridDim.x, (int)blockIdx.x, (const char*)(ws + WS_X8), (const char*)(ws + WS_WG8 + (size_t)layer * 5 * MiB), (size_t)256 * D, (size_t)256 * D, WGM_INPROJ, 1 << 30, 0};
        pg8::EpiProj E{(bf16_t*)(ws + A_GLU), (bf16_t*)(ws + A_GATES), (const f32x4*)(ws + WS_SS) + (size_t)(layer * 2) * M};
        pg8::gemm_phase<pg8::EpiProj, pg8::PlainSched, true>(lds, g, S, E);
    }
}
__device__ __forceinline__ void ph_fold(KArgs a, LAS unsigned char* lds) {
    unsigned char* ws = a->ws;
    pg8::Gemm g{512, 2 * D, 512, 0, 0}; pg8::FoldSched S{(int)gridDim.x, (int)blockIdx.x, (const char*)(ws + WS_W0 + W0_WOUT + 2 * 2 * MiB), (const char*)(ws + WS_W0 + W0_POOL)};
    pg8::EpiPlain E{(bf16_t*)(ws + WS_WC), D, (size_t)D * D};
    pg8::gemm_phase(lds, g, S, E);
}
__device__ __forceinline__ void ph_merge(KArgs a, int layer, LAS unsigned char* lds) {
    unsigned char* ws = a->ws;
    pg8::Gemm g{2 * D, 2 * D, 2 * D, 0, 0}; pg8::MergeSched S{(int)gridDim.x, (int)blockIdx.x, (const char*)(ws + A_YA), (const char*)(ws + WS_W0 + W0_WOUT + (size_t)(layer * 3) * 2 * MiB), (const char*)(ws + WS_WC + (size_t)layer * 2 * MiB), (size_t)32 * MiB, (size_t)2 * MiB};
    pg8::EpiMerge E{(const bf16_t*)(ws + A_GATES), (bf16_t*)(ws + A_MERGED)};
    pg8::gemm_phase(lds, g, S, E);
}
__device__ __forceinline__ void ph_wo(KArgs a, int layer, LAS unsigned char* lds) {
    unsigned char* ws = a->ws;
    pg8::Gemm g{2 * D, 2 * D, 2 * D, 0, 0}; pg8::PlainSched S{M / 256, D / 256, (int)gridDim.x, (int)blockIdx.x, (const char*)(ws + A_MERGED), (const char*)(ws + WS_W0 + W0_WO + (size_t)layer * 2 * MiB), (size_t)256 * D * 2, (size_t)256 * D * 2, 4, 1 << 30, 0};
    pg8::EpiResid E{layer == 0 ? a->in[0] : (const float*)nullptr, (bf16_t*)(ws + WS_XB), (float*)(ws + WS_SS) + (size_t)(layer * 2 + 1) * M * 4, (LAS float*)(lds + RED_OFF), nullptr};
    pg8::gemm_phase(lds, g, S, E);
}
__device__ __forceinline__ void ph_ffn1(KArgs a, LAS unsigned char* lds) {
    unsigned char* ws = a->ws;
    pg8::Gemm g{2 * D, 2 * D, 2 * D, 0, 0}; pg8::PlainSched S{M / 256, 2 * DFF / 256, (int)gridDim.x, (int)blockIdx.x, (const char*)(ws + WS_XB), (const char*)(ws + WS_W0 + W0_D13), (size_t)256 * D * 2, (size_t)256 * D * 2, WGM_FFN1, 1 << 30, 0};
    pg8::EpiSwiGLU<true, false> E{(bf16_t*)(ws + A_FFN), DFF, (const float*)(ws + WS_SS) + (size_t)1 * M * 4};
    pg8::gemm_phase(lds, g, S, E);
}
__device__ __forceinline__ void ph_ffn2(KArgs a, LAS unsigned char* lds) {
    unsigned char* ws = a->ws;
    pg8::Gemm g{2 * DFF, 2 * DFF, 2 * DFF, 0, 0}; pg8::PlainSched S{M / 256, D / 256, (int)gridDim.x, (int)blockIdx.x, (const char*)(ws + A_FFN), (const char*)(ws + WS_W0 + W0_D2), (size_t)256 * DFF * 2, (size_t)256 * DFF * 2, 4, 1 << 30, 0};
    pg8::EpiResid E{(const float*)nullptr, (bf16_t*)(ws + WS_XB), (float*)(ws + WS_SS) + (size_t)2 * M * 4, (LAS float*)(lds + RED_OFF), ws + WS_X8};
    pg8::gemm_phase(lds, g, S, E);
}
__device__ __forceinline__ void ph_moe(KArgs a, int which, LAS unsigned char* lds) {
    unsigned char* ws = a->ws;
    const int* meta = (const int*)(ws + WS_SMALL + SM_META); int o[9];
#pragma unroll
    for (int e = 0; e < 9; ++e) o[e] = __builtin_amdgcn_readfirstlane(__hip_atomic_load(meta + e, __ATOMIC_RELAXED, __HIP_MEMORY_SCOPE_AGENT));
    const int nM = o[8] > MAXSLOT / 256 ? MAXSLOT / 256 : o[8];
    if (which == 0) {
        pg8::Gemm g{D, D, D, F8_ONE, F8_W13_SC}; pg8::GroupSched S{nM, 2 * DFF / 256, (int)gridDim.x, (int)blockIdx.x, o[1], o[2], o[3], o[4], o[5], o[6], o[7], (const char*)(ws + WS_APERM), (const char*)(ws + WS_WMOE), (size_t)256 * D, (size_t)256 * D, (size_t)2 * DFF * D, WGM_MOE1};
        pg8::EpiSwiGLU<false, true> E{(bf16_t*)(ws + WS_ACTP), DFF, nullptr};
        pg8::gemm_phase<pg8::EpiSwiGLU<false, true>, pg8::GroupSched, true>(lds, g, S, E);
    } else {
        const int G = (int)gridDim.x, nU = 4 * nM, R = nU / G, tail = nU - R * G, split = (tail > 0 && pg8::MOE2_SPL * tail <= G) ? 1 : 0;
        pg8::Gemm g{DFF, DFF, DFF, F8_ACT_SC, F8_W2_SC}; pg8::Moe2Sched S{nM, G, (int)blockIdx.x, R, tail, split, o[1], o[2], o[3], o[4], o[5], o[6], o[7], (const char*)(ws + WS_ACTP), (const char*)(ws + WS_WMOE + WMOE_W2), (size_t)256 * DFF, (size_t)256 * DFF, (size_t)D * DFF};
        pg8::EpiMoe2 E{(bf16_t*)(ws + WS_Y), (bf16_t*)(ws + WS_YP)};
        pg8::gemm_phase<pg8::EpiMoe2, pg8::Moe2Sched, true>(lds, g, S, E);
    }
}

__global__ void __launch_bounds__(512, 2) fwd(Args unused_args_read_through_kargs) {
    extern __shared__ __attribute__((aligned(16))) unsigned char lds_raw[];
    LAS unsigned char* lds = (LAS unsigned char*)lds_raw;
    volatile LAS unsigned* MISC = (volatile LAS unsigned*)(lds + MISC_OFF);
    const int tid = threadIdx.x, lane = tid & 63, wid = __builtin_amdgcn_readfirstlane(tid >> 6);
    if (tid < 64) MISC[tid] = 0u;
    __syncthreads();
    int lo, hi; XcdBarrier bar;
    { KArgs a = kargs(); lo = a->ph_lo; hi = a->ph_hi; unsigned* bw = (unsigned*)(a->ws + WS_CTL + CTL_BAR); bar.bar = bw; bar.x = 0; bar.st = nullptr; if (hi - lo > 1) bar = xcd_barrier_post(bw, MISC + 8); }
#define IN(k) (lo <= (k) && (k) < hi)
#define SEAM(k) do { if (IN(k) && IN((k) + 1)) xcd_barrier(bar); } while (0)

    if (PHON(0) && IN(0)) { for (int rp = 0; rp < REPS(0); ++rp) { prologue_phase(kargs(), lds, wid, lane); __syncthreads(); } } SEAM(0);
#pragma nounroll
    for (int layer = 0; layer < 2; ++layer) {
        const int pb = 1 + 7 * layer;
        if (PHON(1) && IN(pb + 0)) { for (int rp = 0; rp < REPS(1); ++rp) { if (layer == 0) { ph_fold(kargs(), lds); __syncthreads(); } ph_inproj(kargs(), layer, lds); __syncthreads(); } } SEAM(pb + 0);
        if (PHON(2) && IN(pb + 1)) { for (int rp = 0; rp < REPS(2); ++rp) { conv_phase(kargs(), layer, lds, tid, wid, lane); __syncthreads(); } } SEAM(pb + 1);
        if (PHON(4) && IN(pb + 3)) { for (int rp = 0; rp < REPS(4); ++rp) { ph_merge(kargs(), layer, lds); __syncthreads(); } } SEAM(pb + 3);
        if (PHON(5) && IN(pb + 4)) { for (int rp = 0; rp < (layer == 0 ? REPS(5) : 1); ++rp) { ph_wo(kargs(), layer, lds); __syncthreads(); } } SEAM(pb + 4);
        if (layer == 0) {
            if (PHON(6) && IN(6)) { for (int rp = 0; rp < REPS(6); ++rp) { ph_ffn1(kargs(), lds); __syncthreads(); } } SEAM(6);
            if (PHON(7) && IN(7)) { ph_ffn2(kargs(), lds); } SEAM(7);
        }
    }
    if (PHON(13) && IN(13)) { for (int rp = 0; rp < REPS(13); ++rp) { route_phase(kargs(), lds, tid, wid, lane); __syncthreads(); } } SEAM(13);
    if (PHON(14) && IN(14)) { for (int rp = 0; rp < REPS(14); ++rp) { scatter_phase(kargs(), lds, tid, wid, lane); __syncthreads(); } } SEAM(14);
    if (PHON(15) && IN(15)) { for (int rp = 0; rp < REPS(15); ++rp) { ph_moe(kargs(), 0, lds); __syncthreads(); } } SEAM(15);
    if (PHON(16) && IN(16)) { for (int rp = 0; rp < REPS(16); ++rp) { ph_moe(kargs(), 1, lds); __syncthreads(); } } SEAM(16);
    if (PHON(17) && IN(17)) { for (int rp = 0; rp < REPS(17); ++rp) { combine_phase(kargs(), lds, tid, wid, lane); __syncthreads(); } }
#undef IN
#undef SEAM
}

extern "C" void kernel_launch(void* const* d_in, const int* in_sizes, int n_in, void* d_out, int out_size, void* d_ws, size_t ws_size, hipStream_t stream) {
    static int grid = 0;
    if (grid == 0) {
        if (n_in != 23 || in_sizes[0] != M * D || out_size != M * D || ws_size < WS_END) { fprintf(stderr, "kernel_launch: unexpected shapes: n_in %d in0 %d out %d ws %zu (need %zu); nothing launched\n", n_in, n_in > 0 ? in_sizes[0] : -1, out_size, ws_size, (size_t)WS_END); grid = -1; return; }
        int dev = 0, cus = 0, per_cu = 0;
        if (hipGetDevice(&dev) != hipSuccess || hipDeviceGetAttribute(&cus, hipDeviceAttributeMultiprocessorCount, dev) != hipSuccess) { fprintf(stderr, "kernel_launch: device query failed\n"); grid = -1; return; }
        if (hipFuncSetAttribute((const void*)fwd, hipFuncAttributeMaxDynamicSharedMemorySize, LDS_BYTES) != hipSuccess) { fprintf(stderr, "kernel_launch: hipFuncSetAttribute failed\n"); grid = -1; return; }
        if (hipOccupancyMaxActiveBlocksPerMultiprocessor(&per_cu, (const void*)fwd, 512, LDS_BYTES) != hipSuccess || per_cu < 1) fprintf(stderr, "kernel_launch: note: occupancy query reports %d workgroups per CU\n", per_cu);
        (void)hipGetLastError();
        grid = cus;
    }
    if (grid < 0) return;
    if (hipMemsetAsync((char*)d_ws + WS_CTL, 0, CTL_BYTES, stream) != hipSuccess) { fprintf(stderr, "kernel_launch: memset failed\n"); return; }
    Args a{};
    for (int i = 0; i < 23; ++i) a.in[i] = (const float*)d_in[i];
    a.out = (float*)d_out; a.ws = (unsigned char*)d_ws;
#if MK_PER_PHASE
    for (int ph = 0; ph < NPH; ++ph) { a.ph_lo = ph; a.ph_hi = ph + 1; hipLaunchKernelGGL(fwd, dim3(grid), dim3(512), LDS_BYTES, stream, a); }
#else
    a.ph_lo = 0; a.ph_hi = NPH; hipLaunchKernelGGL(fwd, dim3(grid), dim3(512), LDS_BYTES, stream, a);
#endif
    const hipError_t le = hipPeekAtLastError();
    if (le != hipSuccess) fprintf(stderr, "kernel_launch: launch failed: %s\n", hipGetErrorName(le));
}
```

```cpp
#include <hip/hip_runtime.h>
#include <cstdio>
#include <cstdint>

#ifndef MK_PER_PHASE
#define MK_PER_PHASE 0
#endif

#ifndef MK_REP_MASK
#define MK_REP_MASK 0u
#endif
#define REPS(bit) (1 + (int)(((MK_REP_MASK) >> (bit)) & 1u))
#define REPS2(bit) REPS(bit)

#define LAS __attribute__((address_space(3)))
typedef unsigned short bf16_t;
typedef short bf16x8 __attribute__((ext_vector_type(8)));
typedef float f32x4 __attribute__((ext_vector_type(4)));
typedef float f32x2 __attribute__((ext_vector_type(2)));
typedef unsigned u32x4 __attribute__((ext_vector_type(4)));
typedef unsigned u32x2 __attribute__((ext_vector_type(2)));

constexpr int M = 16384, D = 1024, SEQ = 8192, INC = 9216, DFF = 3584, NE = 8;
constexpr float RMS_EPS = 1e-6f, LN_EPS = 1e-5f;
constexpr int MAXSLOT = 34816;
constexpr float F8_W13_MUL = 128.f, F8_ACT_MUL = 4.f, F8_W2_MUL = 256.f, F8_Y_MUL = 32.f;
constexpr int F8_ONE = 0x7f7f7f7f, F8_W13_SC = 0x78787878  , F8_ACT_SC = 0x7d7d7d7d  , F8_W2_SC = 0x77777777  ;

constexpr size_t MiB = 1u << 20;
constexpr size_t WS_CTL = 0, CTL_BYTES = 64 * 1024;
constexpr size_t CTL_BAR = 16384;
constexpr size_t CTL_CNT = 32768;
constexpr size_t WS_SMALL = 1 * MiB;
constexpr size_t SM_TOPE = 0, SM_TOPP = 64 * 1024, SM_TSLOT = 192 * 1024, SM_SSPERM = 320 * 1024, SM_META = 512 * 1024;
constexpr size_t WS_X8 = 2 * MiB;
constexpr size_t WS_YP = 18 * MiB;
constexpr size_t WS_WG8 = 492 * MiB;
constexpr size_t WS_XB = 66 * MiB;
constexpr size_t WS_W0 = 98 * MiB;
constexpr size_t W0_WIN = 0;
constexpr size_t W0_WOUT = 36 * MiB;
constexpr size_t W0_WO = 48 * MiB;
constexpr size_t W0_POOL = 52 * MiB;
constexpr size_t W0_D13 = 53 * MiB;
constexpr size_t W0_D2 = 67 * MiB;
constexpr size_t WS_ACT = 172 * MiB;
constexpr size_t A_SCB = WS_ACT, A_SCX = WS_ACT + 32 * MiB, A_GLU = WS_ACT + 64 * MiB, A_PU = WS_ACT + 96 * MiB, A_GATES = WS_ACT + 128 * MiB,
                 A_YA = WS_ACT + 224 * MiB, A_VB = WS_ACT + 256 * MiB, A_PP = WS_ACT + 288 * MiB, A_MERGED = A_SCX, A_FFN = WS_ACT;
constexpr size_t WS_HALO = 528 * MiB;
constexpr size_t WS_WC = 524 * MiB;
constexpr size_t WS_ACTP = 98 * MiB;
constexpr size_t WS_WMOE = 304 * MiB, WMOE_W2 = 56 * MiB;
constexpr size_t WS_Y = 400 * MiB;
constexpr size_t WS_APERM = 472 * MiB;
constexpr size_t WS_SS = 540 * MiB;
constexpr size_t WS_END = 541 * MiB;

typedef __bf16 bf16x2_t __attribute__((ext_vector_type(2)));
__device__ __forceinline__ unsigned pk_bf16(float lo, float hi) { const bf16x2_t v = {(__bf16)lo, (__bf16)hi}; return __builtin_bit_cast(unsigned, v); }
__device__ __forceinline__ unsigned pk_fp8x4(const f32x4 v) {
    const float a = __builtin_amdgcn_fmed3f(v[0], -448.f, 448.f), b = __builtin_amdgcn_fmed3f(v[1], -448.f, 448.f), c = __builtin_amdgcn_fmed3f(v[2], -448.f, 448.f), d = __builtin_amdgcn_fmed3f(v[3], -448.f, 448.f);
    int w = 0; w = __builtin_amdgcn_cvt_pk_fp8_f32(a, b, w, false); w = __builtin_amdgcn_cvt_pk_fp8_f32(c, d, w, true); return (unsigned)w; }
__device__ __forceinline__ float bf_lo(unsigned u) { return __uint_as_float(u << 16); }
__device__ __forceinline__ float bf_hi(unsigned u) { return __uint_as_float(u & 0xffff0000u); }
__device__ __forceinline__ float sigm(float x) { return __builtin_amdgcn_rcpf(1.f + __builtin_amdgcn_exp2f(-1.44269504f * x)); }
__device__ __forceinline__ float wave_sum(float v) {
#pragma unroll
    for (int o = 1; o < 64; o <<= 1) v += __shfl_xor(v, o);
    return v;
}
#define LDS_WAIT() asm volatile("s_waitcnt lgkmcnt(0)" ::: "memory")

namespace pg8 {
constexpr int BM = 256, BK = 64, HALF = 128, HTB = HALF * BK * 2, STAGE_BYTES = 8 * HTB, NXCD = 8;
__host__ __device__ __forceinline__ int lds_byte(int r, int c) { const int st = (r >> 4) * 2 + (c >> 5), rr = r & 15, cc = c & 31, ob = rr * 64 + cc * 2; return st * 1024 + (ob ^ (((ob >> 9) & 1) << 5)); }
__host__ __device__ __forceinline__ void stage_rc(int b, int& R, int& C) { const int st = b / 1024, sb = b % 1024, swz = sb ^ (((sb >> 9) & 1) << 5); R = (st >> 1) * 16 + swz / 64; C = (st & 1) * 32 + (swz % 64) / 2; }
__host__ __device__ __forceinline__ int perm32(int rho) { const int n = rho >> 4, i = rho & 15; return 8 * (i >> 2) + 4 * n + (i & 3); }

struct Unit { int pm, pn, aux, nt; const char* A; const char* B; };
struct Gemm { int Kb, lda, ldb; int sa, sb; };

__device__ __forceinline__ bool tile_of(int L, int nM, int nN, int& pm, int& pn, int WGM = 4) {
    const int nwg = nM * nN; if (L >= nwg) return false;
    int wgid = L; { const int q = nwg / NXCD, r = nwg % NXCD, xcd = wgid % NXCD, off = wgid / NXCD; wgid = (xcd < r ? xcd * (q + 1) : r * (q + 1) + (xcd - r) * q) + off; }
    const int nig = WGM * nN, gid = wgid / nig, fm = gid * WGM, gsz = (nM - fm) < WGM ? (nM - fm) : WGM;
    pm = fm + ((wgid % nig) % gsz); pn = (wgid % nig) / gsz; return true;
}
struct PlainSched {
    int nM, nN, G, c; const char* A0; const char* B0; size_t astep, bstep; int wgm; int bsplit, badd;
    __device__ __forceinline__ bool next(int i, Unit& u) const { int pm, pn; if (!tile_of(i * G + c, nM, nN, pm, pn, wgm)) return false; u.pm = pm; u.pn = pn; u.aux = 0; u.nt = 0; u.A = A0 + (size_t)pm * astep; u.B = B0 + (size_t)(pn + (pn >= bsplit ? badd : 0)) * bstep; return true; }
};
struct PoolSched {
    int G, c; const char* A0; const char* B0;
    __device__ __forceinline__ bool next(int i, Unit& u) const { int pm, pn; if (!tile_of(i * G + c, M / 256, 4, pm, pn)) return false; u.pm = pm; u.pn = pn; u.aux = 0; u.nt = 0;
        u.A = A0 + (size_t)pm * (256 * 1024 * 2) + (size_t)pn * 512; u.B = B0 + (size_t)pn * (256 * 256 * 2); return true; }
};
struct MergeSched {
    int G, c; const char *A0, *B0, *B2; size_t astr, bstr;
    __device__ __forceinline__ bool next(int i, Unit& u) const { const int t = i / 3, b = i - 3 * t; int pm, pn; if (!tile_of(t * G + c, M / 256, 4, pm, pn)) return false; u.pm = pm; u.pn = pn; u.aux = b; u.nt = 0;
        const char* w = b == 2 ? B2 : B0 + (size_t)b * bstr;
        u.A = A0 + (size_t)b * astr + (size_t)pm * (256 * 1024 * 2); u.B = w + (size_t)pn * (256 * 1024 * 2); return true; }
};
struct FoldSched {
    int G, c; const char *A0, *B0;
    __device__ __forceinline__ bool next(int i, Unit& u) const { const int idx = i * G + c; if (idx >= 32) return false; const int L = idx >> 4, pm = (idx >> 2) & 3, g = idx & 3; u.pm = pm; u.pn = g; u.aux = L; u.nt = 0;
        u.A = A0 + (size_t)L * (6 * MiB) + (size_t)pm * (256 * 1024 * 2) + (size_t)g * 512; u.B = B0 + (size_t)L * (512 * 1024) + (size_t)g * (256 * 256 * 2); return true; }
};
struct GroupSched {
    int nM, nN, G, c; int o1, o2, o3, o4, o5, o6, o7; const char* A0; const char* B0; size_t astep, bstep, estep; int wgm;
    __device__ __forceinline__ bool next(int i, Unit& u) const { int pm, pn; if (!tile_of(i * G + c, nM, nN, pm, pn, wgm)) return false; u.pm = pm; u.pn = pn; u.aux = 0; u.nt = 0;
        const int e = (pm >= o1) + (pm >= o2) + (pm >= o3) + (pm >= o4) + (pm >= o5) + (pm >= o6) + (pm >= o7);
        u.A = A0 + (size_t)pm * astep; u.B = B0 + (size_t)e * estep + (size_t)pn * bstep; return true; }
};

constexpr int MOE2_SPL = 7, MOE2_SNT = 4;
struct Moe2Sched {
    int nM, G, c, R, tail, split; int o1, o2, o3, o4, o5, o6, o7; const char* A0; const char* B0; size_t astep, bstep, estep;
    __device__ __forceinline__ bool next(int i, Unit& u) const {
        int L = i * G + c, part = -1, sub = 0;
        if (split && i >= R) { if (i > R || c >= MOE2_SPL * tail) return false; sub = c; L = R * G + c / MOE2_SPL; part = c % MOE2_SPL; }
        int pm, pn; if (!tile_of(L, nM, 4, pm, pn, 4)) return false; u.pm = pm; u.pn = pn;
        const int e = (pm >= o1) + (pm >= o2) + (pm >= o3) + (pm >= o4) + (pm >= o5) + (pm >= o6) + (pm >= o7);
        u.A = A0 + (size_t)pm * astep; u.B = B0 + (size_t)e * estep + (size_t)pn * bstep; u.aux = 0; u.nt = 0;
        if (part >= 0) { u.A += part * (MOE2_SNT * 128); u.B += part * (MOE2_SNT * 128); u.aux = 1 + sub; u.nt = MOE2_SNT; }
        return true; }
};

typedef f32x4 Acc[2][2][4][2];
__device__ __forceinline__ u32x4 pack8(const f32x4 v0, const f32x4 v1) { u32x4 w; w.x = pk_bf16(v0[0], v0[1]); w.y = pk_bf16(v0[2], v0[3]); w.z = pk_bf16(v1[0], v1[1]); w.w = pk_bf16(v1[2], v1[3]); return w; }
__device__ __forceinline__ f32x4 sig4(const f32x4 v) { f32x4 r; r[0] = sigm(v[0]); r[1] = sigm(v[1]); r[2] = sigm(v[2]); r[3] = sigm(v[3]); return r; }
__device__ __forceinline__ void unpack8(const u32x4 g, f32x4& lo, f32x4& hi) { lo[0] = bf_lo(g.x); lo[1] = bf_hi(g.x); lo[2] = bf_lo(g.y); lo[3] = bf_hi(g.y); hi[0] = bf_lo(g.z); hi[1] = bf_hi(g.z); hi[2] = bf_lo(g.w); hi[3] = bf_hi(g.w); }

__device__ __forceinline__ size_t gate_frag(int pm, int q, int wid, int ai, int m, int lane) { return ((size_t)(((((pm * 12 + q) * 8 + wid) * 2 + ai) * 4 + m) * 64 + lane)) * 16; }
__device__ __forceinline__ unsigned pk_fp8x4_raw(const f32x4 v) { int w = 0; w = __builtin_amdgcn_cvt_pk_fp8_f32(v[0], v[1], w, false); w = __builtin_amdgcn_cvt_pk_fp8_f32(v[2], v[3], w, true); return (unsigned)w; }
__device__ __forceinline__ f32x4 un_fp8x4(unsigned w) { const f32x2 lo = __builtin_amdgcn_cvt_pk_f32_fp8((int)w, false), hi = __builtin_amdgcn_cvt_pk_f32_fp8((int)w, true); return (f32x4){lo[0], lo[1], hi[0], hi[1]}; }
struct EpiProj {
    bf16_t *glu, *gates; const f32x4* ss;
    __device__ __forceinline__ bool operator()(Acc& acc, const Unit& u, int wr, int wc, int fr, int fq) const {
        const int row0 = u.pm * BM + wr * 64 + fr, pn = u.pn;
        float rs[2][4];
#pragma unroll
        for (int ai = 0; ai < 2; ++ai)
#pragma unroll
            for (int m = 0; m < 4; ++m) { const f32x4 p = ss[row0 + ai * HALF + m * 16]; rs[ai][m] = __builtin_amdgcn_rsqf(((p[0] + p[1]) + (p[2] + p[3])) * (1.0f / D) + RMS_EPS); }
        if (pn < 8) {
            const int col0 = pn * 128 + wc * 32 + 8 * fq;
#pragma unroll
            for (int ai = 0; ai < 2; ++ai)
#pragma unroll
                for (int m = 0; m < 4; ++m) { const float r = rs[ai][m];
                    const f32x4 a0 = acc[ai][0][m][0] * r, a1 = acc[ai][0][m][1] * r, b0 = sig4(acc[ai][1][m][0] * r), b1 = sig4(acc[ai][1][m][1] * r);
                    *(u32x4*)(glu + (size_t)(row0 + ai * HALF + m * 16) * D + col0) = pack8(a0 * b0, a1 * b1); }
        } else {
#pragma unroll
            for (int ai = 0; ai < 2; ++ai)
#pragma unroll
                for (int m = 0; m < 4; ++m) { const float r = -1.44269504f * rs[ai][m]; u32x4 w;
#pragma unroll
                    for (int bj = 0; bj < 2; ++bj) { f32x4 e0 = acc[ai][bj][m][0] * r, e1 = acc[ai][bj][m][1] * r;
#pragma unroll
                        for (int j = 0; j < 4; ++j) { e0[j] = __builtin_amdgcn_exp2f(__builtin_amdgcn_fmed3f(e0[j], -8.65617f, 8.65617f)); e1[j] = __builtin_amdgcn_exp2f(__builtin_amdgcn_fmed3f(e1[j], -8.65617f, 8.65617f)); }
                        w[2 * bj] = pk_fp8x4_raw(e0); w[2 * bj + 1] = pk_fp8x4_raw(e1); }
                    *(u32x4*)((unsigned char*)gates + gate_frag(u.pm, pn - 8, wr * 4 + wc, ai, m, fr + 16 * fq)) = w; }
        }
        return false;
    }
};
template <int CTRL> __device__ __forceinline__ float dpp_f(float old, float src) { return __int_as_float(__builtin_amdgcn_update_dpp(__float_as_int(old), __float_as_int(src), CTRL, 0xf, 0xf, false)); }
struct EpiSc {
    bf16_t *ya, *pu; const f32x4* ss; const float* scw; float* halo; LAS float* ex;
    __device__ __forceinline__ bool operator()(Acc& acc, const Unit& u, int wr, int wc, int fr, int fq) const {
        const int row0 = u.pm * BM + wr * 64 + fr, ch0 = u.pn * 64 + wc * 16 + fq * 4;
#pragma unroll
        for (int ai = 0; ai < 2; ++ai)
#pragma unroll
            for (int m = 0; m < 4; ++m) { const f32x4 p = ss[row0 + ai * HALF + m * 16]; const float r = __builtin_amdgcn_rsqf(((p[0] + p[1]) + (p[2] + p[3])) * (1.0f / D) + RMS_EPS);
                acc[ai][0][m][0] = acc[ai][0][m][0] * r; acc[ai][0][m][1] = (acc[ai][0][m][1] * r) * (acc[ai][1][m][0] * r); acc[ai][1][m][1] = acc[ai][1][m][1] * r; }
        if (fr >= 14) {
#pragma unroll
            for (int ai = 0; ai < 2; ++ai) *(LAS f32x4*)(ex + ((((ai * 2 + wr) * 4 + wc) * 4 + fq) * 2 + (fr - 14)) * 4) = acc[ai][0][3][1];
            if (wr == 1) *(f32x4*)(halo + ((size_t)((2 * 64 + u.pm) * 2 + (fr - 14))) * D + ch0) = acc[1][0][3][1];
        }
        if (wr == 0 && fr < 2) { *(f32x4*)(halo + ((size_t)((0 * 64 + u.pm) * 2 + fr)) * D + ch0) = acc[0][0][0][0]; *(f32x4*)(halo + ((size_t)((1 * 64 + u.pm) * 2 + fr)) * D + ch0) = acc[0][0][0][1]; }
        const f32x4 w0 = *(const f32x4*)(scw + ch0), w1 = *(const f32x4*)(scw + D + ch0), w2 = *(const f32x4*)(scw + 2 * D + ch0);
        asm volatile("s_waitcnt lgkmcnt(0)" ::: "memory"); __builtin_amdgcn_s_barrier(); asm volatile("" ::: "memory");
#pragma unroll
        for (int ai = 0; ai < 2; ++ai) {
            f32x4 F1 = (f32x4){0.f, 0.f, 0.f, 0.f}, F2 = F1;
            if (ai + wr > 0) { const int pb = 2 * ai + wr - 1; const LAS float* e = ex + (((pb * 4 + wc) * 4 + fq) * 2) * 4; const f32x4 E0 = *(const LAS f32x4*)e, E1 = *(const LAS f32x4*)(e + 4); F1 = E1; F2 = fr == 0 ? E0 : E1; }
#pragma unroll
            for (int m = 0; m < 4; ++m) { const f32x4 pr = acc[ai][0][m][1]; f32x4 y;
                if (m > 0) { const f32x4 pv = acc[ai][0][m - 1][1];
#pragma unroll
                    for (int j = 0; j < 4; ++j) { F1[j] = dpp_f<0x121>(0.f, pv[j]); F2[j] = dpp_f<0x122>(0.f, pv[j]); } }
#pragma unroll
                for (int j = 0; j < 4; ++j) { const float p1 = dpp_f<0x111>(F1[j], pr[j]), p2 = dpp_f<0x112>(F2[j], pr[j]); y[j] = acc[ai][0][m][0][j] * (w0[j] * p2 + w1[j] * p1 + w2[j] * pr[j]); }
                const f32x4 pp = acc[ai][1][m][1];
                const auto s0 = __builtin_amdgcn_permlane16_swap(pk_bf16(y[0], y[1]), pk_bf16(pp[0], pp[1]), false, false), s1 = __builtin_amdgcn_permlane16_swap(pk_bf16(y[2], y[3]), pk_bf16(pp[2], pp[3]), false, false);
                *(u32x4*)(ya + (ptrdiff_t)(fq & 1) * (pu - ya) + (size_t)(row0 + ai * HALF + m * 16) * D + (ch0 & ~7)) = (u32x4){s0[0], s1[0], s0[1], s1[1]}; }
        }
        return false;
    }
};
struct EpiPlain {
    bf16_t* Ob; int ldc; size_t aux_stride;
    __device__ __forceinline__ bool operator()(Acc& acc, const Unit& u, int wr, int wc, int fr, int fq) const {
        bf16_t* O = Ob + (size_t)u.aux * aux_stride;
        const int row0 = u.pm * BM + wr * 64 + fr, col0 = u.pn * BM + wc * 32 + 8 * fq;
#pragma unroll
        for (int ai = 0; ai < 2; ++ai)
#pragma unroll
            for (int m = 0; m < 4; ++m) { bf16_t* rowp = O + (size_t)(row0 + ai * HALF + m * 16) * ldc + col0;
#pragma unroll
                for (int bj = 0; bj < 2; ++bj) *(u32x4*)(rowp + bj * HALF) = pack8(acc[ai][bj][m][0], acc[ai][bj][m][1]); }
        return false;
    }
};
struct EpiMoe2 {
    unsigned char* Y; bf16_t* YP;
    __device__ __forceinline__ bool operator()(Acc& acc, const Unit& u, int wr, int wc, int fr, int fq) const {
        if (u.aux) { bf16_t* O = YP + (size_t)(u.aux - 1) * 65536 + (size_t)(wr * 64 + fr) * 256 + wc * 32 + 8 * fq;
#pragma unroll
            for (int ai = 0; ai < 2; ++ai)
#pragma unroll
                for (int m = 0; m < 4; ++m) { bf16_t* rowp = O + (size_t)(ai * HALF + m * 16) * 256;
#pragma unroll
                    for (int bj = 0; bj < 2; ++bj) *(u32x4*)(rowp + bj * HALF) = pack8(acc[ai][bj][m][0], acc[ai][bj][m][1]); }
        } else {
            unsigned char* O = Y + (size_t)(u.pm * BM + wr * 64 + fr) * D + u.pn * BM + wc * 32 + 8 * (fq & ~1) + (fq & 1) * HALF;
#pragma unroll
            for (int ai = 0; ai < 2; ++ai)
#pragma unroll
                for (int m = 0; m < 4; ++m) {
                    const auto s0 = __builtin_amdgcn_permlane16_swap(pk_fp8x4(acc[ai][0][m][0] * F8_Y_MUL), pk_fp8x4(acc[ai][1][m][0] * F8_Y_MUL), false, false),
                               s1 = __builtin_amdgcn_permlane16_swap(pk_fp8x4(acc[ai][0][m][1] * F8_Y_MUL), pk_fp8x4(acc[ai][1][m][1] * F8_Y_MUL), false, false);
                    *(u32x4*)(O + (size_t)(ai * HALF + m * 16) * D) = (u32x4){s0[0], s1[0], s0[1], s1[1]}; }
        }
        return false;
    }
};
struct EpiMerge {
    const bf16_t* gates; bf16_t* O;
    __device__ __forceinline__ bool operator()(Acc& acc, const Unit& u, int wr, int wc, int fr, int fq) const {
        const int row0 = u.pm * BM + wr * 64 + fr, col0 = u.pn * BM + wc * 32 + 8 * fq, b = u.aux;
#pragma unroll
        for (int ai = 0; ai < 2; ++ai)
#pragma unroll
            for (int m = 0; m < 4; ++m) { const size_t row = (size_t)(row0 + ai * HALF + m * 16);
                const unsigned char* gp = (const unsigned char*)gates + gate_frag(u.pm, 4 * b + u.pn, wr * 4 + wc, ai, m, fr + 16 * fq);
                const u32x4 gw = *(const u32x4*)gp;
                if (b < 2) { const u32x4 hw = *(const u32x4*)(gp + gate_frag(0, 4, 0, 0, 0, 0));
#pragma unroll
                    for (int bj = 0; bj < 2; ++bj) { const f32x4 g0 = un_fp8x4(gw[2 * bj]), g1 = un_fp8x4(gw[2 * bj + 1]), h0 = un_fp8x4(hw[2 * bj]), h1 = un_fp8x4(hw[2 * bj + 1]);
#pragma unroll
                        for (int j = 0; j < 4; ++j) { acc[ai][bj][m][0][j] *= (1.f + h0[j]) * __builtin_amdgcn_rcpf(1.f + g0[j]); acc[ai][bj][m][1][j] *= (1.f + h1[j]) * __builtin_amdgcn_rcpf(1.f + g1[j]); } }
                } else {
#pragma unroll
                    for (int bj = 0; bj < 2; ++bj) { f32x4 g0 = un_fp8x4(gw[2 * bj]), g1 = un_fp8x4(gw[2 * bj + 1]);
#pragma unroll
                        for (int j = 0; j < 4; ++j) { g0[j] = __builtin_amdgcn_rcpf(1.f + g0[j]); g1[j] = __builtin_amdgcn_rcpf(1.f + g1[j]); }
                        *(u32x4*)(O + row * D + col0 + bj * HALF) = pack8(acc[ai][bj][m][0] * g0, acc[ai][bj][m][1] * g1); } } }
        return b < 2;
    }
};
struct EpiResid {
    const float* base32; bf16_t* xb; float* ssp; LAS float* red; unsigned char* x8;
    __device__ __forceinline__ bool operator()(Acc& acc, const Unit& u, int wr, int wc, int fr, int fq) const {
        const int row0 = u.pm * BM + wr * 64 + fr, col0 = u.pn * BM + wc * 32 + 8 * fq;
#pragma unroll
        for (int ai = 0; ai < 2; ++ai)
#pragma unroll
            for (int m = 0; m < 4; ++m) { const size_t row = (size_t)(row0 + ai * HALF + m * 16); float q = 0.f;
#pragma unroll
                for (int bj = 0; bj < 2; ++bj) { const size_t off = row * D + col0 + bj * HALF;
                    f32x4 b0, b1; if (base32) { b0 = *(const f32x4*)(base32 + off); b1 = *(const f32x4*)(base32 + off + 4); } else unpack8(*(const u32x4*)(xb + off), b0, b1);
                    const u32x4 pk = pack8(b0 + acc[ai][bj][m][0], b1 + acc[ai][bj][m][1]); *(u32x4*)(xb + off) = pk;
                    f32x4 o0, o1; unpack8(pk, o0, o1); if (x8) *(u32x2*)(x8 + off) = (u32x2){pk_fp8x4(o0), pk_fp8x4(o1)};
                    q += (o0[0] * o0[0] + o0[1] * o0[1]) + (o0[2] * o0[2] + o0[3] * o0[3]) + (o1[0] * o1[0] + o1[1] * o1[1]) + (o1[2] * o1[2] + o1[3] * o1[3]); }
                q += __shfl_xor(q, 16); q += __shfl_xor(q, 32);
                if (fq == 0) red[(ai * HALF + wr * 64 + m * 16 + fr) * 4 + wc] = q; }
        asm volatile("s_waitcnt lgkmcnt(0)" ::: "memory"); __builtin_amdgcn_s_barrier(); asm volatile("" ::: "memory");
        int tid = threadIdx.x; asm volatile("" : "+v"(tid));
        if (tid < 256) { const f32x4 v = *(const LAS f32x4*)(red + tid * 4); ssp[(size_t)(u.pm * BM + tid) * 4 + u.pn] = (v[0] + v[1]) + (v[2] + v[3]); }
        return false;
    }
};
template <bool PART4, bool OUT8> struct EpiSwiGLU {
    bf16_t* O; int ldc; const float* ss;
    __device__ __forceinline__ bool operator()(Acc& acc, const Unit& u, int wr, int wc, int fr, int fq) const {
        const int row0 = u.pm * BM + wr * 64 + fr, col0 = u.pn * 128 + wc * 32 + 8 * fq;
#pragma unroll
        for (int ai = 0; ai < 2; ++ai)
#pragma unroll
            for (int m = 0; m < 4; ++m) { const size_t row = (size_t)(row0 + ai * HALF + m * 16); float r = 1.f;
                if (PART4) { const f32x4 p = *(const f32x4*)(ss + row * 4); r = __builtin_amdgcn_rsqf(((p[0] + p[1]) + (p[2] + p[3])) * (1.0f / D) + RMS_EPS); }
                const f32x4 a0 = acc[ai][0][m][0] * r, a1 = acc[ai][0][m][1] * r, c0 = acc[ai][1][m][0] * r, c1 = acc[ai][1][m][1] * r;
                const f32x4 h0 = a0 * sig4(a0) * c0, h1 = a1 * sig4(a1) * c1;
                if (OUT8) { *(u32x2*)((unsigned char*)O + row * ldc + col0) = (u32x2){pk_fp8x4(h0 * F8_ACT_MUL), pk_fp8x4(h1 * F8_ACT_MUL)}; }
                else *(u32x4*)(O + row * ldc + col0) = pack8(h0, h1); }
        return false;
    }
};

typedef int i32x4 __attribute__((ext_vector_type(4)));
typedef int i32x8 __attribute__((ext_vector_type(8)));
__device__ __forceinline__ i32x8 join16(const bf16x8 lo, const bf16x8 hi) { return __builtin_shufflevector(__builtin_bit_cast(i32x4, lo), __builtin_bit_cast(i32x4, hi), 0, 1, 2, 3, 4, 5, 6, 7); }
template <class Epi, class Sched, bool F8 = false>
__device__ __forceinline__ void gemm_phase(LAS unsigned char* lds, const Gemm g, const Sched& S, const Epi& E) {
    int tid_ = threadIdx.x; asm volatile("" : "+v"(tid_));
    const int tid = tid_, wid = __builtin_amdgcn_readfirstlane(tid >> 6), lane = tid & 63, wr = wid >> 2, wc = wid & 3, fr = lane & 15, fq = lane >> 4;
    const int nt = g.Kb / 128;
    int vsa = g.sa, vsb = g.sb; asm volatile("" : "+v"(vsa), "+v"(vsb));
    unsigned voffA[2], voffB[2];
#pragma unroll
    for (int i = 0; i < 2; ++i) { int R, C; stage_rc(tid * 16 + i * 8192, R, C); const int Rb = (R & ~31) + perm32(R & 31);
        voffA[i] = (unsigned)(R * g.lda + C * 2); voffB[i] = (unsigned)(Rb * g.ldb + C * 2); }
    const size_t kstep = (size_t)(BK * 2);
    const size_t hstepA = (size_t)HALF * g.lda, hstepB = (size_t)HALF * g.ldb;
    const unsigned ldsw = (unsigned)wid * 1024u;
    const int aoff = lds_byte(wr * 64 + fr, fq * 8), boff = lds_byte(wc * 32 + fr, fq * 8);
#define PG8_SA(b, h) (((b) * 2 + (h)) * HTB)
#define PG8_SB(b, h) ((4 + (b) * 2 + (h)) * HTB)
#define PG8_STAGE(bufoff, gbase, voff) do { _Pragma("unroll") for (int _i = 0; _i < 2; ++_i) \
        __builtin_amdgcn_global_load_lds((const unsigned*)((const char*)(gbase) + (voff)[_i]), (LAS unsigned*)(lds + (bufoff) + ldsw + _i * 8192), 16, 0, 0); } while (0)
#define PG8_LDA(dst, b, h) do { _Pragma("unroll") for (int m = 0; m < 4; ++m) _Pragma("unroll") for (int k = 0; k < 2; ++k) dst[m][k] = *(const LAS bf16x8*)(lds + PG8_SA(b, h) + aoff + m * 2048 + k * 1024); } while (0)
#define PG8_LDB(dst, b, h) do { _Pragma("unroll") for (int n = 0; n < 2; ++n) _Pragma("unroll") for (int k = 0; k < 2; ++k) dst[n][k] = *(const LAS bf16x8*)(lds + PG8_SB(b, h) + boff + n * 2048 + k * 1024); } while (0)
#define PG8_MMA(ai, bj, At, Bt) do { __builtin_amdgcn_s_setprio(1); _Pragma("unroll") for (int m = 0; m < 4; ++m) _Pragma("unroll") for (int n = 0; n < 2; ++n) { \
        if constexpr (F8) { const i32x8 b8_ = join16(Bt[n][0], Bt[n][1]), a8_ = join16(At[m][0], At[m][1]); \
            asm volatile("v_mfma_scale_f32_16x16x128_f8f6f4 %0, %1, %2, %0, %3, %4 op_sel_hi:[0,0,0]" : "+v"(acc[ai][bj][m][n]) : "v"(b8_), "v"(a8_), "v"(vsb), "v"(vsa)); } \
        else { _Pragma("unroll") for (int k = 0; k < 2; ++k) acc[ai][bj][m][n] = __builtin_amdgcn_mfma_f32_16x16x32_bf16(Bt[n][k], At[m][k], acc[ai][bj][m][n], 0, 0, 0); } } __builtin_amdgcn_s_setprio(0); } while (0)
#define PG8_WAIT_V(n) asm volatile("s_waitcnt vmcnt(" #n ")" ::: "memory")
#define PG8_WAIT_L(n) asm volatile("s_waitcnt lgkmcnt(" #n ")" ::: "memory")
#define PG8_BAR __builtin_amdgcn_s_barrier()
#define PG8_SCHED __builtin_amdgcn_sched_barrier(0)
    Unit cur, nxt; int ui = 0;
    if (!S.next(0, cur)) return;
    Acc acc;
#pragma unroll
    for (int a = 0; a < 2; ++a)
#pragma unroll
        for (int b = 0; b < 2; ++b)
#pragma unroll
            for (int m = 0; m < 4; ++m)
#pragma unroll
                for (int n = 0; n < 2; ++n) acc[a][b][m][n] = (f32x4){0.f, 0.f, 0.f, 0.f};
    bf16x8 At[4][2], B0[2][2], B1[2][2];
    const char* cA = cur.A; const char* cB = cur.B;
    PG8_STAGE(PG8_SB(0, 0), cB, voffB); PG8_STAGE(PG8_SB(0, 1), cB + hstepB, voffB); PG8_STAGE(PG8_SA(0, 0), cA, voffA); PG8_STAGE(PG8_SA(0, 1), cA + hstepA, voffA);
    if (wr == 1) PG8_BAR;
    PG8_WAIT_V(2); PG8_BAR;
    PG8_STAGE(PG8_SB(1, 0), cB + kstep, voffB); PG8_STAGE(PG8_SA(1, 0), cA + kstep, voffA); PG8_STAGE(PG8_SB(1, 1), cB + hstepB + kstep, voffB);
    PG8_WAIT_V(6); PG8_BAR;
    for (;;) {
        const bool has_next = S.next(ui + 1, nxt);
        const char* nA = has_next ? nxt.A : cA; const char* nB = has_next ? nxt.B : cB;
        const int unt = cur.nt ? cur.nt : nt;
#pragma nounroll
        for (int t = 0; t < unt; t += 2) {
            const bool last = (t == unt - 2);
            const char* a1 = cA + (size_t)(t + 1) * kstep;
            const char* a2 = last ? nA : cA + (size_t)(t + 2) * kstep; const char* b2 = last ? nB : cB + (size_t)(t + 2) * kstep;
            const char* a3 = a2 + kstep; const char* b3 = b2 + kstep;
            PG8_LDB(B0, 0, 0); PG8_LDB(B1, 0, 1); PG8_SCHED; PG8_LDA(At, 0, 0); PG8_STAGE(PG8_SA(1, 1), a1 + hstepA, voffA);
            PG8_WAIT_V(8); PG8_WAIT_L(0); PG8_BAR; PG8_MMA(0, 0, At, B0); PG8_MMA(0, 1, At, B1); PG8_BAR; PG8_SCHED;
            PG8_LDA(At, 0, 1); PG8_STAGE(PG8_SB(0, 0), b2, voffB); PG8_STAGE(PG8_SB(0, 1), b2 + hstepB, voffB); PG8_STAGE(PG8_SA(0, 0), a2, voffA);
            PG8_WAIT_V(8); PG8_WAIT_L(0); PG8_BAR; PG8_MMA(1, 0, At, B0); PG8_MMA(1, 1, At, B1); PG8_BAR; PG8_SCHED;
            PG8_LDB(B0, 1, 0); PG8_LDB(B1, 1, 1); PG8_SCHED; PG8_LDA(At, 1, 0); PG8_STAGE(PG8_SA(0, 1), a2 + hstepA, voffA);
            PG8_WAIT_V(8); PG8_WAIT_L(0); PG8_BAR; PG8_MMA(0, 0, At, B0); PG8_MMA(0, 1, At, B1); PG8_BAR; PG8_SCHED;
            PG8_LDA(At, 1, 1); PG8_STAGE(PG8_SB(1, 0), b3, voffB); PG8_STAGE(PG8_SB(1, 1), b3 + hstepB, voffB); PG8_STAGE(PG8_SA(1, 0), a3, voffA);
            PG8_WAIT_V(8); PG8_WAIT_L(0); PG8_BAR; PG8_MMA(1, 0, At, B0); PG8_MMA(1, 1, At, B1); PG8_BAR; PG8_SCHED;
        }
        if constexpr (F8) asm volatile("s_nop 15\n\ts_nop 15" ::: "memory");
        if (wr == 0) PG8_BAR;
        const bool keep = E(acc, cur, wr, wc, fr, fq);
        if (!has_next) break;
        if (!keep) {
#pragma unroll
            for (int a = 0; a < 2; ++a)
#pragma unroll
                for (int b = 0; b < 2; ++b)
#pragma unroll
                    for (int m = 0; m < 4; ++m)
#pragma unroll
                        for (int n = 0; n < 2; ++n) acc[a][b][m][n] = (f32x4){0.f, 0.f, 0.f, 0.f};
        }
        cur = nxt; cA = nA; cB = nB; ++ui;
        if (wr == 1) PG8_BAR;
    }
    PG8_WAIT_V(0);
    PG8_BAR;
#undef PG8_SA
#undef PG8_SB
#undef PG8_STAGE
#undef PG8_LDA
#undef PG8_LDB
#undef PG8_MMA
#undef PG8_WAIT_V
#undef PG8_WAIT_L
#undef PG8_BAR
#undef PG8_SCHED
}
}

constexpr int RING_BYTES = 131072, MISC_OFF = RING_BYTES, RED_OFF = RING_BYTES + 1024, LDS_BYTES = 147456;

#define XB_TMO      128
#define XB_XCNT(j)  (256  + 64 * (j))
#define XB_XSUB(j)  (1280 + 64 * (j))
#define XB_XGEN(j)  (2304 + 64 * (j))
#define XB_TOP      3328
#define XB_TOPGEN   3392
#define XCD_BAR_WORDS 3456
#define XB_SPIN_CAP (1u << 18)
__device__ __forceinline__ unsigned xb_ld(unsigned* p)              { return __hip_atomic_load(p, __ATOMIC_RELAXED, __HIP_MEMORY_SCOPE_AGENT); }
__device__ __forceinline__ unsigned xb_add(unsigned* p, unsigned v) { return __hip_atomic_fetch_add(p, v, __ATOMIC_RELAXED, __HIP_MEMORY_SCOPE_AGENT); }
__device__ __forceinline__ unsigned xb_xcc_id() { return (unsigned)__builtin_amdgcn_s_getreg((3 << 11) | 20) & 0xFu; }
#define XB_SPIN(cond, bar) do { unsigned _sp = 0; while (cond) { __builtin_amdgcn_s_sleep(1); \
    if ((++_sp & 255u) == 0u) { if (xb_ld(&(bar)[XB_TMO])) break; if (_sp > XB_SPIN_CAP) { atomicAdd(&(bar)[XB_TMO], 1u); break; } } } } while (0)
struct XcdBarrier { unsigned* bar; unsigned x; volatile LAS unsigned* st; };
__device__ __forceinline__ XcdBarrier xcd_barrier_post(unsigned* bar, volatile LAS unsigned* st) {
    XcdBarrier b; b.bar = bar; b.x = xb_xcc_id(); b.st = st;
    if (threadIdx.x == 0) (void)xb_add(&bar[XB_XCNT(b.x)], 1u);
    return b;
}
__device__ __forceinline__ void xcd_barrier_complete(unsigned* bar, unsigned x, unsigned& nloc, unsigned& nx) {
    const unsigned G = gridDim.x * gridDim.y * gridDim.z;
    unsigned sum, cnt, mine, sp = 0u;
    for (;;) {
        sum = 0u; cnt = 0u; mine = 0u;
#pragma nounroll
        for (unsigned j = 0; j < 16; ++j) { const unsigned c = xb_ld(&bar[XB_XCNT(j)]); sum += c; cnt += (c > 0u) ? 1u : 0u; mine = (j == x) ? c : mine; }
        if (sum == G) break;
        __builtin_amdgcn_s_sleep(1);
        if ((++sp & 255u) == 0u) { if (xb_ld(&bar[XB_TMO])) break; if (sp > XB_SPIN_CAP) { atomicAdd(&bar[XB_TMO], 1u); break; } }
    }
    nloc = mine > 0u ? mine : 1u; nx = cnt > 0u ? cnt : 1u;
}
__device__ __forceinline__ void xcd_barrier(const XcdBarrier& b) {
    asm volatile("s_waitcnt vmcnt(0)" ::: "memory");
    __syncthreads();
    if (threadIdx.x == 0) {
        unsigned* bar = b.bar;
        __builtin_amdgcn_s_waitcnt(0);
        unsigned nloc = b.st[0], nx = b.st[1];
        if (nloc == 0u) { xcd_barrier_complete(bar, b.x, nloc, nx); b.st[0] = nloc; b.st[1] = nx; }
        const unsigned old = xb_add(&bar[XB_XSUB(b.x)], 1u);
        const unsigned gen = old / nloc;
        if (old + 1u == (gen + 1u) * nloc) {
            __builtin_amdgcn_fence(__ATOMIC_RELEASE, "agent");
            asm volatile("s_waitcnt vmcnt(0)" ::: "memory");
            const unsigned og = xb_add(&bar[XB_TOP], 1u);
            const unsigned tg = og / nx;
            if (og + 1u == (tg + 1u) * nx) xb_add(&bar[XB_TOPGEN], 1u);
            else XB_SPIN(xb_ld(&bar[XB_TOPGEN]) == tg, bar);
            __builtin_amdgcn_fence(__ATOMIC_ACQUIRE, "agent");
            xb_add(&bar[XB_XGEN(b.x)], 1u);
            asm volatile("s_waitcnt vmcnt(0)" ::: "memory");
        } else {
            XB_SPIN(xb_ld(&bar[XB_XGEN(b.x)]) == gen, bar);
            __builtin_amdgcn_fence(__ATOMIC_ACQUIRE, "agent");
            asm volatile("s_waitcnt vmcnt(0)" ::: "memory");
        }
    }
    __syncthreads();
}

struct Args { const float* in[23]; float* out; unsigned char* ws; int ph_lo, ph_hi; };
static_assert(sizeof(Args) == 23 * 8 + 8 + 8 + 8, "Args has no padding");
typedef const __attribute__((address_space(4))) Args* KArgs;
__device__ __forceinline__ KArgs kargs() { KArgs p = (KArgs)__builtin_amdgcn_kernarg_segment_ptr(); asm volatile("" : "+s"(p)); return p; }

__device__ __forceinline__ void transpose_item(const float* src, int ldn, int k0, int n0, bf16_t* dst, int ldk, const float* kscale, const float* nscale, int lane, bool perm = false) {
    const int r4 = lane >> 4, q = lane & 15, rq = perm ? 32 * (q >> 2) + 8 * (q & 3) : 4 * q;
    f32x4 v[16];
    const float* sp = src + (size_t)(k0 + 16 * r4) * ldn + n0 + 4 * q;
#pragma unroll
    for (int i = 0; i < 16; ++i) v[i] = __builtin_nontemporal_load((const f32x4*)(sp + (size_t)i * ldn));
    f32x4 ns = (f32x4){1.f, 1.f, 1.f, 1.f}; if (nscale) ns = *(const f32x4*)(nscale + n0 + 4 * q);
    if (kscale) {
        const f32x4* kp = (const f32x4*)(kscale + k0 + 16 * r4);
#pragma unroll
        for (int g = 0; g < 4; ++g) { const f32x4 ks = kp[g];
#pragma unroll
            for (int j = 0; j < 4; ++j) v[4 * g + j] = v[4 * g + j] * ks[j]; }
    }
#pragma unroll
    for (int e = 0; e < 4; ++e) { u32x4 lo, hi;
#pragma unroll
        for (int w = 0; w < 4; ++w) { lo[w] = pk_bf16(v[2 * w][e] * ns[e], v[2 * w + 1][e] * ns[e]); hi[w] = pk_bf16(v[8 + 2 * w][e] * ns[e], v[9 + 2 * w][e] * ns[e]); }
        bf16_t* o = dst + (size_t)(rq + e) * ldk + k0 + 16 * r4; *(u32x4*)o = lo; *(u32x4*)(o + 8) = hi; }
}
__device__ __forceinline__ void transpose_item_f8(const float* src, int ldn, int k0, int n0, unsigned char* dst, int ldk, const float* kscale, float mul, int lane) {
    const int r4 = lane >> 4, q = lane & 15;
    f32x4 v[16];
    const float* sp = src + (size_t)(k0 + 16 * r4) * ldn + n0 + 4 * q;
#pragma unroll
    for (int i = 0; i < 16; ++i) v[i] = __builtin_nontemporal_load((const f32x4*)(sp + (size_t)i * ldn));
    {
        const f32x4* kp = (const f32x4*)(kscale + k0 + 16 * r4);
#pragma unroll
        for (int g = 0; g < 4; ++g) { f32x4 ks = (f32x4){mul, mul, mul, mul}; if (kscale) ks = kp[g] * mul;
#pragma unroll
            for (int j = 0; j < 4; ++j) v[4 * g + j] = v[4 * g + j] * ks[j]; }
    }
#pragma unroll
    for (int e = 0; e < 4; ++e) { u32x4 o;
#pragma unroll
        for (int w = 0; w < 4; ++w) o[w] = pk_fp8x4((f32x4){v[4 * w][e], v[4 * w + 1][e], v[4 * w + 2][e], v[4 * w + 3][e]});
        *(u32x4*)(dst + (size_t)(4 * q + e) * ldk + k0 + 16 * r4) = o; }
}
__device__ __forceinline__ int win_row(int n0) {
    const int seg = n0 >> 10, c = n0 & 1023;
    if (seg == 1 || seg == 2) return 1024 + (c >> 7) * 256 + (seg == 2 ? 128 : 0) + (c & 127);
    if (seg == 3 || seg == 4) return 3072 + (c >> 7) * 256 + (seg == 4 ? 128 : 0) + (c & 127);
    return n0;
}
__device__ __forceinline__ int pair_row(int f, int second) { return (f >> 7) * 256 + (second ? 128 : 0) + (f & 127); }

__device__ __forceinline__ void prologue_phase(KArgs a, LAS unsigned char* lds, int wid, int lane) {
    asm volatile("" : "+v"(lane));
    const int gw = blockIdx.x * 8 + wid, NGW = gridDim.x * 8;
    unsigned char* ws = a->ws;
    constexpr int I_WIN = 16 * 144, I_SQ = 16 * 16, I_PW = 16, I_D1 = 16 * 56, I_D2 = 56 * 16;
    constexpr int NIT = 2 * I_WIN + 8 * I_SQ + 8 * I_PW + 2 * I_D1 + I_D2;
    for (int it = gw; it < NIT; it += NGW) {
        int r = it;
        if (r < 2 * I_WIN) { const int L = r / I_WIN; r -= L * I_WIN; const int kb = r / 144, nb = r % 144, n0 = 64 * nb;
            if (n0 >= 6144 || (n0 >= 3072 && n0 < 5120)) transpose_item_f8(a->in[2] + (size_t)L * D * INC, INC, 64 * kb, n0, ws + WS_WG8 + (size_t)L * 5 * MiB + (size_t)(n0 >= 6144 ? 2048 + (n0 - 6144) : win_row(n0) - 3072) * D, D, a->in[1] + L * D, F8_W13_MUL, lane);
            else { const int ty = n0 < 3072 ? n0 >> 10 : 3, T = (n0 & 1023) >> 6;
                transpose_item(a->in[2] + (size_t)L * D * INC, INC, 64 * kb, n0, (bf16_t*)(ws + WS_W0 + W0_WIN + (size_t)L * 18 * MiB) + (size_t)(256 * T + 128 * (ty >> 1) + 4 * (ty & 1)) * D, D, a->in[1] + L * D, nullptr, lane, true); }
            continue; }
        r -= 2 * I_WIN;
        if (r < 8 * I_SQ) { const int j = r / I_SQ; r -= j * I_SQ; const int L = j >> 2, w = j & 3, kb = r / 16, nb = r % 16, n0 = 64 * nb;
            bf16_t* dst = w < 3 ? (bf16_t*)(ws + WS_W0 + W0_WOUT + (size_t)(L * 3 + w) * 2 * MiB) : (bf16_t*)(ws + WS_W0 + W0_WO + (size_t)L * 2 * MiB);
            transpose_item(a->in[10 + w] + (size_t)L * D * D, D, 64 * kb, n0, dst + (size_t)n0 * D, D, nullptr, nullptr, lane); continue; }
        r -= 8 * I_SQ;
        if (r < 8 * I_PW) { const int j = r / I_PW; r -= j * I_PW; const int L = j >> 2, g = j & 3;
            const float* src = a->in[8] + (size_t)(L * 4 + g) * 65536 + (size_t)r * 16 * 256; const float* sc = a->in[9] + L * D + g * 256;
            bf16_t* dst = (bf16_t*)(ws + WS_W0 + W0_POOL + (size_t)L * 512 * 1024) + (size_t)g * 65536 + (size_t)r * 16 * 256; const f32x4 s4 = *(const f32x4*)(sc + 4 * lane);
#pragma unroll
            for (int i = 0; i < 16; ++i) { const f32x4 v = *(const f32x4*)(src + i * 256 + 4 * lane) * s4; u32x2 w; w.x = pk_bf16(v[0], v[1]); w.y = pk_bf16(v[2], v[3]); *(u32x2*)(dst + i * 256 + 4 * lane) = w; }
            continue; }
        r -= 8 * I_PW;
        if (r < 2 * I_D1) { const int w = r / I_D1; r -= w * I_D1; const int kb = r / 56, nb = r % 56, n0 = 64 * nb;
            transpose_item(a->in[15 + w], DFF, 64 * kb, n0, (bf16_t*)(ws + WS_W0 + W0_D13) + (size_t)pair_row(n0, w) * D, D, a->in[14], nullptr, lane); continue; }
        r -= 2 * I_D1;
        { const int kb = r / 16, nb = r % 16, n0 = 64 * nb;
            transpose_item(a->in[17], D, 64 * kb, n0, (bf16_t*)(ws + WS_W0 + W0_D2) + (size_t)n0 * DFF, DFF, nullptr, nullptr, lane); }
    }
    const float* x = a->in[0]; bf16_t* xb = (bf16_t*)(ws + WS_XB); f32x4* ss0 = (f32x4*)(ws + WS_SS); unsigned char* x8 = ws + WS_X8;
    for (int m = gw; m < M; m += NGW) {
        const f32x4* xr = (const f32x4*)(x + (size_t)m * D) + lane; u32x2* o = (u32x2*)(xb + (size_t)m * D) + lane; float s = 0.f;
#pragma unroll
        for (int j = 0; j < 4; ++j) { const f32x4 v = xr[64 * j]; s += (v[0] * v[0] + v[1] * v[1]) + (v[2] * v[2] + v[3] * v[3]); u32x2 w; w.x = pk_bf16(v[0], v[1]); w.y = pk_bf16(v[2], v[3]); o[64 * j] = w;
            *((unsigned*)(x8 + (size_t)m * D) + lane + 64 * j) = pk_fp8x4(v); }
        s = wave_sum(s); if (lane == 0) ss0[m] = (f32x4){s, 0.f, 0.f, 0.f};
    }
}

__device__ __forceinline__ void dma_block16(const bf16_t* src, LAS unsigned char* dst, int wid, int lane) {
#pragma unroll
    for (int k = 0; k < 4; ++k) { const int h = wid * 4 + k;
        __builtin_amdgcn_global_load_lds((const unsigned*)((const char*)src + h * 1024 + lane * 16), (LAS unsigned*)(dst + h * 1024), 16, 0, 0); }
}
__device__ __forceinline__ void zero_block16(LAS unsigned char* dst, int tid) {
#pragma unroll
    for (int k = 0; k < 4; ++k) *(LAS u32x4*)(dst + (size_t)(tid + 512 * k) * 16) = (u32x4){0u, 0u, 0u, 0u};
}
template <int I> __device__ __forceinline__ void conv31_pair(const LAS unsigned char* col, const unsigned (&wp)[31], f32x2 bias, f32x2 (&acc)[16]) {
    f32x2 x[46];
#pragma unroll
    for (int i = 0; i < 46; ++i) { const int r = i - 30, j = I + (r >> 4); const unsigned u = *(const LAS unsigned*)(col + ((j + 2) & 3) * 32768 + (r & 15) * 2048); x[i] = (f32x2){bf_lo(u), bf_hi(u)}; }
#pragma unroll
    for (int j = 0; j < 16; ++j) acc[j] = bias;
#pragma unroll
    for (int k = 0; k < 31; ++k) { const f32x2 wk = (f32x2){bf_lo(wp[k]), bf_hi(wp[k])};
#pragma unroll
        for (int j = 0; j < 16; ++j) acc[j] = __builtin_elementwise_fma(wk, x[j + k], acc[j]); }
}
template <int I, int CH> __device__ __forceinline__ void pool_ch(const LAS unsigned char* col, int g, int s0, float (&p)[16]) {
    float x[31], tv[16];
#pragma unroll
    for (int i = 0; i < 31; ++i) { const int r = i - 15, j = I + (r >> 4); const unsigned u = *(const LAS unsigned*)(col + ((j + 1) % 3) * 32768 + (r & 15) * 2048); x[i] = CH ? bf_hi(u) : bf_lo(u); }
#pragma unroll
    for (int j = 0; j < 16; ++j) tv[j] = x[15 + j];
#pragma unroll
    for (int i = 30; i >= 1; --i) x[i] += x[i - 1];
    if (g >= 1) {
#pragma unroll
        for (int i = 30; i >= 2; --i) x[i] += x[i - 2]; }
    if (g >= 2) {
#pragma unroll
        for (int i = 30; i >= 4; --i) x[i] += x[i - 4]; }
    if (g >= 3) {
#pragma unroll
        for (int i = 30; i >= 8; --i) x[i] += x[i - 8]; }
    const int w = 2 << g;
#pragma unroll
    for (int j = 0; j < 16; ++j) { const int cnt = min(s0 + j + 1, w); p[j] = x[15 + j] * (1.0f / (float)cnt) - tv[j]; }
}
struct ConvB { const bf16_t* GLU; __amdgpu_buffer_rsrc_t rVB; LAS unsigned char* lds; LAS float* red; LAS float* stat; f32x2 bb, gg, be; };
template <int I> __device__ __forceinline__ void convB_tile(const ConvB& c, unsigned (&wp)[31], int T0, int tid, int wid, int lane) {
    const int t0 = T0 + 16 * I; const LAS unsigned char* col = c.lds + 4 * tid;
#pragma unroll
    for (int k = 0; k < 31; ++k) asm volatile("" : "+v"(wp[k]));
    if (I < 3) dma_block16(c.GLU + (size_t)(t0 + 16) * D, c.lds + ((I + 3) & 3) * 32768, wid, lane);
    float a0[16], a1[16];
    { f32x2 ap[16]; conv31_pair<I>(col, wp, c.bb, ap);
#pragma unroll
      for (int j = 0; j < 16; ++j) { a0[j] = ap[j].x; a1[j] = ap[j].y; } }
    {
        float v[32];
#pragma unroll
        for (int j = 0; j < 16; ++j) { v[j] = a0[j] + a1[j]; v[16 + j] = a0[j] * a0[j] + a1[j] * a1[j]; }
#pragma unroll
        for (int i = 0; i < 16; ++i) { const bool b = lane & 32; const float send = b ? v[i] : v[i + 16], keep = b ? v[i + 16] : v[i]; v[i] = keep + __shfl_xor(send, 32); }
#pragma unroll
        for (int i = 0; i < 8; ++i) { const bool b = lane & 16; const float send = b ? v[i] : v[i + 8], keep = b ? v[i + 8] : v[i]; v[i] = keep + __shfl_xor(send, 16); }
#pragma unroll
        for (int i = 0; i < 4; ++i) { const bool b = lane & 8; const float send = b ? v[i] : v[i + 4], keep = b ? v[i + 4] : v[i]; v[i] = keep + __shfl_xor(send, 8); }
#pragma unroll
        for (int i = 0; i < 2; ++i) { const bool b = lane & 4; const float send = b ? v[i] : v[i + 2], keep = b ? v[i + 2] : v[i]; v[i] = keep + __shfl_xor(send, 4); }
        { const bool b = lane & 2; const float send = b ? v[0] : v[1], keep = b ? v[1] : v[0]; v[0] = keep + __shfl_xor(send, 2); }
        v[0] += __shfl_xor(v[0], 1);
        const int idx = ((lane >> 5) & 1) * 16 + ((lane >> 4) & 1) * 8 + ((lane >> 3) & 1) * 4 + ((lane >> 2) & 1) * 2 + ((lane >> 1) & 1);
        if (!(lane & 1)) c.red[wid * 32 + idx] = v[0];
    }
    __syncthreads();
    if (tid < 16) { float s = 0.f, q = 0.f;
#pragma unroll
        for (int w = 0; w < 8; ++w) { s += c.red[w * 32 + tid]; q += c.red[w * 32 + 16 + tid]; }
        const float mean = s * (1.0f / D), var = fmaxf(q * (1.0f / D) - mean * mean, 0.f);
        c.stat[2 * tid] = mean; c.stat[2 * tid + 1] = __builtin_amdgcn_rsqf(var + LN_EPS); }
    asm volatile("s_waitcnt vmcnt(0)" ::: "memory");
    __syncthreads();
#pragma unroll
    for (int j = 0; j < 16; ++j) { const float mean = c.stat[2 * j], rstd = c.stat[2 * j + 1];
        const float y0 = (a0[j] - mean) * rstd * c.gg.x + c.be.x, y1 = (a1[j] - mean) * rstd * c.gg.y + c.be.y;
        __builtin_amdgcn_raw_buffer_store_b32(pk_bf16(y0 * sigm(y0), y1 * sigm(y1)), c.rVB, 4 * tid, (t0 + j) * (D * 2), 0); }
}
struct ConvAC { const bf16_t* PU; __amdgpu_buffer_rsrc_t rPP; LAS unsigned char* lds; };
template <int I> __device__ __forceinline__ void convAC_tile(const ConvAC& c, int T0, int tid, int wid, int lane) {
    const int t0 = T0 + 16 * I, s0 = t0 & (SEQ - 1); const LAS unsigned char* col = c.lds + 4 * tid;
    if (I < 3) dma_block16(c.PU + (size_t)(t0 + 16) * D, c.lds + ((I + 2) % 3) * 32768, wid, lane);
    asm volatile("" ::: "memory");
    {
        float p0[16], p1[16];
        pool_ch<I, 0>(col, wid >> 1, s0, p0);
#pragma unroll
        for (int j = 0; j < 16; ++j) asm volatile("" : "+v"(p0[j]) :: "memory");
        pool_ch<I, 1>(col, wid >> 1, s0, p1);
#pragma unroll
        for (int j = 0; j < 16; ++j) __builtin_amdgcn_raw_buffer_store_b32(pk_bf16(p0[j], p1[j]), c.rPP, 4 * tid, (t0 + j) * (D * 2), 0);
    }
    if (I < 3) asm volatile("s_waitcnt vmcnt(16)" ::: "memory");
    __syncthreads();
}
__device__ __forceinline__ void conv_phase(KArgs a, int layer, LAS unsigned char* lds, int tid, int wid, int lane) {
    asm volatile("" : "+v"(tid), "+v"(lane));
    unsigned char* ws = a->ws;
    const int G = gridDim.x;
    const int vcu = (G % 8 == 0) ? (int)(blockIdx.x % 8) * (G / 8) + (int)(blockIdx.x / 8) : (int)blockIdx.x;
    const int c2 = 2 * tid;
    {
        const float* cfw = a->in[4] + layer * 31 * D; const float* cfb = a->in[5] + layer * D; const float* lng = a->in[6] + layer * D; const float* lnb = a->in[7] + layer * D;
        ConvB c; c.GLU = (const bf16_t*)(ws + A_GLU); c.rVB = __builtin_amdgcn_make_buffer_rsrc((void*)(ws + A_VB), 0, 0x7fffffff, 0x00020000);
        c.lds = lds; c.red = (LAS float*)(lds + RED_OFF); c.stat = c.red + 256;
        unsigned wp[31];
#pragma unroll
        for (int k = 0; k < 31; ++k) { const f32x2 w = *(const f32x2*)(cfw + k * D + c2); wp[k] = pk_bf16(w.x, w.y); }
        c.bb = *(const f32x2*)(cfb + c2); c.gg = *(const f32x2*)(lng + c2); c.be = *(const f32x2*)(lnb + c2);
        asm volatile("" :: "v"(c.bb.x), "v"(c.bb.y), "v"(c.gg.x), "v"(c.gg.y), "v"(c.be.x), "v"(c.be.y));
        for (int rp2 = 0; rp2 < REPS2(21); ++rp2)
        for (int sup = vcu; sup < M / 64; sup += G) {
            const int T0 = sup * 64; const bool seq0 = (T0 & (SEQ - 1)) == 0;
            if (seq0) { zero_block16(lds, tid); zero_block16(lds + 32768, tid); } else { dma_block16(c.GLU + (size_t)(T0 - 32) * D, lds, wid, lane); dma_block16(c.GLU + (size_t)(T0 - 16) * D, lds + 32768, wid, lane); }
            dma_block16(c.GLU + (size_t)T0 * D, lds + 65536, wid, lane);
            asm volatile("s_waitcnt vmcnt(0)" ::: "memory");
            __syncthreads();
            convB_tile<0>(c, wp, T0, tid, wid, lane); convB_tile<1>(c, wp, T0, tid, wid, lane); convB_tile<2>(c, wp, T0, tid, wid, lane); convB_tile<3>(c, wp, T0, tid, wid, lane);
            __syncthreads();
        }
    }
    __syncthreads();
    {
        const float* scw = a->in[3] + layer * 3 * D; const float* halo = (const float*)(ws + WS_HALO); bf16_t* YA = (bf16_t*)(ws + A_YA);
        ConvAC c; c.PU = (const bf16_t*)(ws + A_PU); c.lds = lds;
        c.rPP = __builtin_amdgcn_make_buffer_rsrc((void*)(ws + A_PP), 0, 0x7fffffff, 0x00020000);
        for (int rp2 = 0; rp2 < REPS2(22); ++rp2)
        for (int sup = vcu; sup < M / 64; sup += G) {
            const int T0 = sup * 64; const bool seq0 = (T0 & (SEQ - 1)) == 0;
            if (seq0) zero_block16(lds, tid); else dma_block16(c.PU + (size_t)(T0 - 16) * D, lds, wid, lane);
            dma_block16(c.PU + (size_t)T0 * D, lds + 32768, wid, lane);
            if ((sup & 3) == 0) { const int pm = sup >> 2;
                const f32x2 s0w = *(const f32x2*)(scw + c2), s1w = *(const f32x2*)(scw + D + c2), s2w = *(const f32x2*)(scw + 2 * D + c2);
                const f32x2 b0 = *(const f32x2*)(halo + (size_t)((0 * 64 + pm) * 2 + 0) * D + c2), b1 = *(const f32x2*)(halo + (size_t)((0 * 64 + pm) * 2 + 1) * D + c2);
                const f32x2 q0 = *(const f32x2*)(halo + (size_t)((1 * 64 + pm) * 2 + 0) * D + c2), q1 = *(const f32x2*)(halo + (size_t)((1 * 64 + pm) * 2 + 1) * D + c2);
                f32x2 pa = (f32x2){0.f, 0.f}, pb = pa;
                if (!seq0) { pa = *(const f32x2*)(halo + (size_t)((2 * 64 + pm - 1) * 2 + 0) * D + c2); pb = *(const f32x2*)(halo + (size_t)((2 * 64 + pm - 1) * 2 + 1) * D + c2); }
                const f32x2 y0 = b0 * (s0w * pa + s1w * pb + s2w * q0), y1 = b1 * (s0w * pb + s1w * q0 + s2w * q1);
                *(unsigned*)(YA + (size_t)T0 * D + c2) = pk_bf16(y0.x, y0.y); *(unsigned*)(YA + (size_t)(T0 + 1) * D + c2) = pk_bf16(y1.x, y1.y); }
            asm volatile("s_waitcnt vmcnt(0)" ::: "memory");
            __syncthreads();
            convAC_tile<0>(c, T0, tid, wid, lane); convAC_tile<1>(c, T0, tid, wid, lane); convAC_tile<2>(c, T0, tid, wid, lane); convAC_tile<3>(c, T0, tid, wid, lane);
        }
    }
}

__device__ __forceinline__ void route_phase(KArgs a, LAS unsigned char* lds, int tid, int wid, int lane) {
    asm volatile("" : "+v"(tid), "+v"(lane));
    unsigned char* ws = a->ws;
    const bf16_t* X = (const bf16_t*)(ws + WS_XB); const float* gn = a->in[14] + D; const float* R = a->in[18];
    const f32x4* ss3 = (const f32x4*)(ws + WS_SS) + 3 * M;
    int* tope = (int*)(ws + WS_SMALL + SM_TOPE); f32x2* topp = (f32x2*)(ws + WS_SMALL + SM_TOPP); int* cntb = (int*)(ws + WS_CTL + CTL_CNT);
    LAS int* lcnt = (LAS int*)(lds + 98304);
    float wgt[2][8][8];
#pragma unroll
    for (int h = 0; h < 2; ++h)
#pragma unroll
        for (int i = 0; i < 8; ++i) { const int k = 8 * lane + 512 * h + i; const float g = gn[k]; const f32x4 r0 = *(const f32x4*)(R + k * 8), r1 = *(const f32x4*)(R + k * 8 + 4);
#pragma unroll
            for (int e = 0; e < 4; ++e) { wgt[h][i][e] = g * r0[e]; wgt[h][i][4 + e] = g * r1[e]; } }
    for (int vb = blockIdx.x; vb < 256; vb += gridDim.x) {
        if (tid < 8) lcnt[tid] = 0;
        __syncthreads();
        for (int i8 = 0; i8 < 8; ++i8) {
            const int t = vb * 64 + wid * 8 + i8;
            float lg[8];
#pragma unroll
            for (int e = 0; e < 8; ++e) lg[e] = 0.f;
#pragma unroll
            for (int h = 0; h < 2; ++h) { f32x4 v0, v1; pg8::unpack8(*(const u32x4*)(X + (size_t)t * D + 512 * h + 8 * lane), v0, v1);
#pragma unroll
                for (int i = 0; i < 4; ++i)
#pragma unroll
                    for (int e = 0; e < 8; ++e) { lg[e] = fmaf(v0[i], wgt[h][i][e], lg[e]); lg[e] = fmaf(v1[i], wgt[h][4 + i][e], lg[e]); } }
#pragma unroll
            for (int e = 0; e < 8; ++e) lg[e] = wave_sum(lg[e]);
            const f32x4 sp = ss3[t]; const float rstd = __builtin_amdgcn_rsqf(((sp[0] + sp[1]) + (sp[2] + sp[3])) * (1.0f / D) + RMS_EPS);
            int e1 = 0; float v1 = lg[0];
#pragma unroll
            for (int e = 1; e < 8; ++e) if (lg[e] > v1) { v1 = lg[e]; e1 = e; }
            int e2 = e1 == 0 ? 1 : 0; float v2 = -__builtin_inff();
#pragma unroll
            for (int e = 0; e < 8; ++e) if (e != e1 && lg[e] > v2) { v2 = lg[e]; e2 = e; }
            const float ex = __expf((v2 - v1) * rstd), p1 = 1.0f / (1.0f + ex), p2 = ex * p1;
            if (lane == 0) { tope[t] = e1 | (e2 << 8); topp[t] = (f32x2){p1, p2}; atomicAdd((int*)&lcnt[e1], 1); atomicAdd((int*)&lcnt[e2], 1); }
        }
        __syncthreads();
        if (tid < 8) cntb[vb * 8 + tid] = lcnt[tid];
        __syncthreads();
    }
    const int gw = blockIdx.x * 8 + wid, NGW = gridDim.x * 8;
    constexpr int I_1 = 16 * 56, I_13 = 2 * I_1, I_2 = 56 * 16;
    unsigned char* w13 = ws + WS_WMOE; unsigned char* w2t = ws + WS_WMOE + WMOE_W2;
    for (int it = gw; it < NE * (I_13 + I_2); it += NGW) {
        int r = it;
        if (r < NE * I_13) { const int e = r / I_13; r -= e * I_13; const int w = r / I_1; r -= w * I_1; const int kb = r / 56, nb = r % 56, n0 = 64 * nb;
            transpose_item_f8(a->in[19 + w] + (size_t)e * D * DFF, DFF, 64 * kb, n0, w13 + (size_t)e * (2 * DFF) * D + (size_t)pair_row(n0, w) * D, D, gn, F8_W13_MUL, lane); continue; }
        r -= NE * I_13;
        { const int e = r / I_2; r -= e * I_2; const int kb = r / 16, nb = r % 16, n0 = 64 * nb;
            transpose_item_f8(a->in[21] + (size_t)e * DFF * D, D, 64 * kb, n0, w2t + (size_t)e * D * DFF + (size_t)n0 * DFF, DFF, nullptr, F8_W2_MUL, lane); }
    }
}

__device__ __forceinline__ void scatter_phase(KArgs a, LAS unsigned char* lds, int tid, int wid, int lane) {
    asm volatile("" : "+v"(tid), "+v"(lane));
    unsigned char* ws = a->ws;
    const int* tope = (const int*)(ws + WS_SMALL + SM_TOPE); int* tslot = (int*)(ws + WS_SMALL + SM_TSLOT); float* ssperm = (float*)(ws + WS_SMALL + SM_SSPERM); int* meta = (int*)(ws + WS_SMALL + SM_META);
    const int* cntb = (const int*)(ws + WS_CTL + CTL_CNT); const f32x4* ss3 = (const f32x4*)(ws + WS_SS) + 3 * M;
    const bf16_t* X = (const bf16_t*)(ws + WS_XB); unsigned char* AP = ws + WS_APERM;
    LAS int* lc = (LAS int*)lds;
    LAS int* lbase = lc + 2048;
    LAS int* lslot = lc + 2064;
    LAS int* ltot = lc + 2200;
    for (int i = tid; i < 2048; i += 512) lc[i] = __hip_atomic_load(cntb + i, __ATOMIC_RELAXED, __HIP_MEMORY_SCOPE_AGENT);
    __syncthreads();
    for (int vb = blockIdx.x; vb < 256; vb += gridDim.x) {
        if (tid < 8) { int tot = 0, pre = 0;
#pragma unroll 8
            for (int b = 0; b < 256; ++b) { const int v = lc[b * 8 + tid]; tot += v; pre += (b < vb) ? v : 0; }
            ltot[tid] = tot; lbase[tid] = pre; }
        __syncthreads();
        if (tid == 0) { int off = 0;
            for (int e = 0; e < 8; ++e) { lbase[e] += off; if (vb == 0) meta[e] = off >> 8; off += (ltot[e] + 255) & ~255; }
            if (vb == 0) meta[8] = off >> 8; }
        __syncthreads();
        if (wid == 0) {
            const int t = vb * 64 + lane; const int te = tope[t]; const int e1 = te & 0xff, e2 = (te >> 8) & 0xff;
            int s1 = 0, s2 = 0;
#pragma unroll
            for (int k = 0; k < 2; ++k) { const int ek = k ? e2 : e1; int sk = 0;
#pragma unroll
                for (int e = 0; e < 8; ++e) { const unsigned long long mask = __ballot(ek == e); const int base = lbase[e]; LDS_WAIT();
                    const int rank = __popcll(mask & ((1ull << lane) - 1ull)); if (ek == e) sk = base + rank;
                    if (lane == 0) lbase[e] = base + __popcll(mask); LDS_WAIT(); }
                if (k) s2 = sk; else s1 = sk; }
            *(int2*)(tslot + 2 * t) = make_int2(s1, s2); lslot[lane] = s1; lslot[64 + lane] = s2;
        }
        __syncthreads();
        {
            u32x4 xv[8][2]; f32x4 sp[8];
#pragma unroll
            for (int i = 0; i < 8; ++i) { const int t = vb * 64 + wid + 8 * i; const u32x4* src = (const u32x4*)(X + (size_t)t * D) + 2 * lane; xv[i][0] = src[0]; xv[i][1] = src[1]; sp[i] = ss3[t]; }
#pragma unroll
            for (int i = 0; i < 8; ++i) { const int r = wid + 8 * i, s1 = lslot[r], s2 = lslot[64 + r];
                const float rstd = __builtin_amdgcn_rsqf(((sp[i][0] + sp[i][1]) + (sp[i][2] + sp[i][3])) * (1.0f / D) + RMS_EPS);
                f32x4 v0, v1, v2, v3; pg8::unpack8(xv[i][0], v0, v1); pg8::unpack8(xv[i][1], v2, v3);
                const u32x4 q = (u32x4){pk_fp8x4(v0 * rstd), pk_fp8x4(v1 * rstd), pk_fp8x4(v2 * rstd), pk_fp8x4(v3 * rstd)};
                *((u32x4*)(AP + (size_t)s1 * D) + lane) = q; *((u32x4*)(AP + (size_t)s2 * D) + lane) = q; } }
        __syncthreads();
    }
}

__device__ __forceinline__ void combine_phase(KArgs a, LAS unsigned char* lds, int tid, int wid, int lane) {
    asm volatile("" : "+v"(lane), "+v"(tid));
    unsigned char* ws = a->ws;
    LAS int* tmap = (LAS int*)lds; const bf16_t* YP = (const bf16_t*)(ws + WS_YP);
    int split;
    { const int nMraw = __builtin_amdgcn_readfirstlane(__hip_atomic_load((const int*)(ws + WS_SMALL + SM_META) + 8, __ATOMIC_RELAXED, __HIP_MEMORY_SCOPE_AGENT)); const int nM = nMraw > MAXSLOT / 256 ? MAXSLOT / 256 : nMraw;
      const int G = (int)gridDim.x, nU = 4 * nM, R = nU / G, tail = nU - R * G; split = (tail > 0 && pg8::MOE2_SPL * tail <= G) ? 1 : 0;
      for (int i = tid; i < 4 * (MAXSLOT / 256); i += 512) tmap[i] = -1;
      __syncthreads();
      if (split && tid < tail) { int pm, pn; if (pg8::tile_of(R * G + tid, nM, 4, pm, pn, 4)) tmap[4 * pm + pn] = tid; }
      __syncthreads(); }
    const bf16_t* X = (const bf16_t*)(ws + WS_XB); const unsigned char* Y = ws + WS_Y; const int* tslot = (const int*)(ws + WS_SMALL + SM_TSLOT); const f32x2* topp = (const f32x2*)(ws + WS_SMALL + SM_TOPP);
    const float* gf = a->in[22]; float* out = a->out;
    const int gw = blockIdx.x * 8 + wid, NGW = gridDim.x * 8;
    f32x4 gv[4];
#pragma unroll
    for (int h = 0; h < 2; ++h) { gv[2 * h] = *(const f32x4*)(gf + 512 * h + 8 * lane); gv[2 * h + 1] = *(const f32x4*)(gf + 512 * h + 8 * lane + 4); }
    for (int tb = gw; tb < M; tb += 4 * NGW) {
        int2 sl[4]; f32x2 p[4];
#pragma unroll
        for (int i = 0; i < 4; ++i) { const int t = min(tb + i * NGW, M - 1); sl[i] = *(const int2*)(tslot + 2 * t); p[i] = topp[t]; }
        u32x4 xr[4][2]; u32x2 ya[4][2], yb[4][2];
#pragma unroll
        for (int i = 0; i < 4; ++i) { const int t = min(tb + i * NGW, M - 1);
#pragma unroll
            for (int h = 0; h < 2; ++h) { const int col = 512 * h + 8 * lane;
                xr[i][h] = *(const u32x4*)(X + (size_t)t * D + col); ya[i][h] = *(const u32x2*)(Y + (size_t)sl[i].x * D + col); yb[i][h] = *(const u32x2*)(Y + (size_t)sl[i].y * D + col); } }
#pragma unroll
        for (int i = 0; i < 4; ++i) { const int t = tb + i * NGW; if (t < M) {
            f32x4 v[4]; float s = 0.f;
#pragma unroll
            for (int h = 0; h < 2; ++h) { f32x4 x0, x1; pg8::unpack8(xr[i][h], x0, x1); f32x4 a0 = pg8::un_fp8x4(ya[i][h].x) * (1.0f / F8_Y_MUL), a1 = pg8::un_fp8x4(ya[i][h].y) * (1.0f / F8_Y_MUL), b0 = pg8::un_fp8x4(yb[i][h].x) * (1.0f / F8_Y_MUL), b1 = pg8::un_fp8x4(yb[i][h].y) * (1.0f / F8_Y_MUL);
                if (split) { const int pn = 2 * h + (lane >> 5), cl = 8 * (lane & 31);
                    const int ka = tmap[4 * (sl[i].x >> 8) + pn], kb = tmap[4 * (sl[i].y >> 8) + pn];
                    if (ka >= 0) { a0 = (f32x4){0.f, 0.f, 0.f, 0.f}; a1 = a0;
                        for (int p = 0; p < pg8::MOE2_SPL; ++p) { f32x4 t0, t1; pg8::unpack8(*(const u32x4*)(YP + (size_t)(ka * pg8::MOE2_SPL + p) * 65536 + (size_t)(sl[i].x & 255) * 256 + cl), t0, t1); a0 += t0; a1 += t1; } }
                    if (kb >= 0) { b0 = (f32x4){0.f, 0.f, 0.f, 0.f}; b1 = b0;
                        for (int p = 0; p < pg8::MOE2_SPL; ++p) { f32x4 t0, t1; pg8::unpack8(*(const u32x4*)(YP + (size_t)(kb * pg8::MOE2_SPL + p) * 65536 + (size_t)(sl[i].y & 255) * 256 + cl), t0, t1); b0 += t0; b1 += t1; } } }
                v[2 * h] = x0 + a0 * p[i].x + b0 * p[i].y; v[2 * h + 1] = x1 + a1 * p[i].x + b1 * p[i].y; }
#pragma unroll
            for (int k = 0; k < 4; ++k) s += (v[k][0] * v[k][0] + v[k][1] * v[k][1]) + (v[k][2] * v[k][2] + v[k][3] * v[k][3]);
            const float rstd = __builtin_amdgcn_rsqf(wave_sum(s) * (1.0f / D) + RMS_EPS);
#pragma unroll
            for (int h = 0; h < 2; ++h) { const int col = 512 * h + 8 * lane;
                *(f32x4*)(out + (size_t)t * D + col) = v[2 * h] * rstd * gv[2 * h]; *(f32x4*)(out + (size_t)t * D + col + 4) = v[2 * h + 1] * rstd * gv[2 * h + 1]; } } }
    }
}

#ifndef WGM_INPROJ
#define WGM_INPROJ 4
#endif
#ifndef WGM_FFN1
#define WGM_FFN1 4
#endif
#ifndef WGM_MOE1
#define WGM_MOE1 4
#endif
constexpr int NPH = 18;
#ifndef MK_PH_MASK
#define MK_PH_MASK 0xFFFFFFFFu
#endif
#define PHON(bit) ((((MK_PH_MASK) >> (bit)) & 1u) != 0u)


__device__ __forceinline__ void ph_inproj(KArgs a, int layer, LAS unsigned char* lds) {
    unsigned char* ws = a->ws;
    {
        pg8::Gemm g{2 * D, 2 * D, 2 * D, 0, 0}; pg8::PlainSched S{M / 256, 16, (int)gridDim.x, (int)blockIdx.x, (const char*)(ws + WS_XB), (const char*)(ws + WS_W0 + W0_WIN + (size_t)layer * 18 * MiB), (size_t)256 * D * 2, (size_t)256 * D * 2, WGM_INPROJ, 1 << 30, 0};
        pg8::EpiSc E{(bf16_t*)(ws + A_YA), (bf16_t*)(ws + A_PU), (const f32x4*)(ws + WS_SS) + (size_t)(layer * 2) * M, a->in[3] + layer * 3 * D, (float*)(ws + WS_HALO), (LAS float*)(lds + RED_OFF)};
        pg8::gemm_phase(lds, g, S, E);
    }
    __syncthreads();
    {
        pg8::Gemm g{D, D, D, F8_ONE, F8_W13_SC}; pg8::PlainSched S{M / 256, 20, (int)gridDim.x, (int)blockIdx.x, (const char*)(ws + WS_X8), (const char*)(ws + WS_WG8 + (size_t)layer * 5 * MiB), (size_t)256 * D, (size_t)256 * D, WGM_INPROJ, 1 << 30, 0};
        pg8::EpiProj E{(bf16_t*)(ws + A_GLU), (bf16_t*)(ws + A_GATES), (const f32x4*)(ws + WS_SS) + (size_t)(layer * 2) * M};
        pg8::gemm_phase<pg8::EpiProj, pg8::PlainSched, true>(lds, g, S, E);
    }
}
__device__ __forceinline__ void ph_fold(KArgs a, LAS unsigned char* lds) {
    unsigned char* ws = a->ws;
    pg8::Gemm g{512, 2 * D, 512, 0, 0}; pg8::FoldSched S{(int)gridDim.x, (int)blockIdx.x, (const char*)(ws + WS_W0 + W0_WOUT + 2 * 2 * MiB), (const char*)(ws + WS_W0 + W0_POOL)};
    pg8::EpiPlain E{(bf16_t*)(ws + WS_WC), D, (size_t)D * D};
    pg8::gemm_phase(lds, g, S, E);
}
__device__ __forceinline__ void ph_merge(KArgs a, int layer, LAS unsigned char* lds) {
    unsigned char* ws = a->ws;
    pg8::Gemm g{2 * D, 2 * D, 2 * D, 0, 0}; pg8::MergeSched S{(int)gridDim.x, (int)blockIdx.x, (const char*)(ws + A_YA), (const char*)(ws + WS_W0 + W0_WOUT + (size_t)(layer * 3) * 2 * MiB), (const char*)(ws + WS_WC + (size_t)layer * 2 * MiB), (size_t)32 * MiB, (size_t)2 * MiB};
    pg8::EpiMerge E{(const bf16_t*)(ws + A_GATES), (bf16_t*)(ws + A_MERGED)};
    pg8::gemm_phase(lds, g, S, E);
}
__device__ __forceinline__ void ph_wo(KArgs a, int layer, LAS unsigned char* lds) {
    unsigned char* ws = a->ws;
    pg8::Gemm g{2 * D, 2 * D, 2 * D, 0, 0}; pg8::PlainSched S{M / 256, D / 256, (int)gridDim.x, (int)blockIdx.x, (const char*)(ws + A_MERGED), (const char*)(ws + WS_W0 + W0_WO + (size_t)layer * 2 * MiB), (size_t)256 * D * 2, (size_t)256 * D * 2, 4, 1 << 30, 0};
    pg8::EpiResid E{layer == 0 ? a->in[0] : (const float*)nullptr, (bf16_t*)(ws + WS_XB), (float*)(ws + WS_SS) + (size_t)(layer * 2 + 1) * M * 4, (LAS float*)(lds + RED_OFF), nullptr};
    pg8::gemm_phase(lds, g, S, E);
}
__device__ __forceinline__ void ph_ffn1(KArgs a, LAS unsigned char* lds) {
    unsigned char* ws = a->ws;
    pg8::Gemm g{2 * D, 2 * D, 2 * D, 0, 0}; pg8::PlainSched S{M / 256, 2 * DFF / 256, (int)gridDim.x, (int)blockIdx.x, (const char*)(ws + WS_XB), (const char*)(ws + WS_W0 + W0_D13), (size_t)256 * D * 2, (size_t)256 * D * 2, WGM_FFN1, 1 << 30, 0};
    pg8::EpiSwiGLU<true, false> E{(bf16_t*)(ws + A_FFN), DFF, (const float*)(ws + WS_SS) + (size_t)1 * M * 4};
    pg8::gemm_phase(lds, g, S, E);
}
__device__ __forceinline__ void ph_ffn2(KArgs a, LAS unsigned char* lds) {
    unsigned char* ws = a->ws;
    pg8::Gemm g{2 * DFF, 2 * DFF, 2 * DFF, 0, 0}; pg8::PlainSched S{M / 256, D / 256, (int)gridDim.x, (int)blockIdx.x, (const char*)(ws + A_FFN), (const char*)(ws + WS_W0 + W0_D2), (size_t)256 * DFF * 2, (size_t)256 * DFF * 2, 4, 1 << 30, 0};
    pg8::EpiResid E{(const float*)nullptr, (bf16_t*)(ws + WS_XB), (float*)(ws + WS_SS) + (size_t)2 * M * 4, (LAS float*)(lds + RED_OFF), ws + WS_X8};
    pg8::gemm_phase(lds, g, S, E);
}
__device__ __forceinline__ void ph_moe(KArgs a, int which, LAS unsigned char* lds) {
    unsigned char* ws = a->ws;
    const int* meta = (const int*)(ws + WS_SMALL + SM_META); int o[9];
#pragma unroll
    for (int e = 0; e < 9; ++e) o[e] = __builtin_amdgcn_readfirstlane(__hip_atomic_load(meta + e, __ATOMIC_RELAXED, __HIP_MEMORY_SCOPE_AGENT));
    const int nM = o[8] > MAXSLOT / 256 ? MAXSLOT / 256 : o[8];
    if (which == 0) {
        pg8::Gemm g{D, D, D, F8_ONE, F8_W13_SC}; pg8::GroupSched S{nM, 2 * DFF / 256, (int)gridDim.x, (int)blockIdx.x, o[1], o[2], o[3], o[4], o[5], o[6], o[7], (const char*)(ws + WS_APERM), (const char*)(ws + WS_WMOE), (size_t)256 * D, (size_t)256 * D, (size_t)2 * DFF * D, WGM_MOE1};
        pg8::EpiSwiGLU<false, true> E{(bf16_t*)(ws + WS_ACTP), DFF, nullptr};
        pg8::gemm_phase<pg8::EpiSwiGLU<false, true>, pg8::GroupSched, true>(lds, g, S, E);
    } else {
        const int G = (int)gridDim.x, nU = 4 * nM, R = nU / G, tail = nU - R * G, split = (tail > 0 && pg8::MOE2_SPL * tail <= G) ? 1 : 0;
        pg8::Gemm g{DFF, DFF, DFF, F8_ACT_SC, F8_W2_SC}; pg8::Moe2Sched S{nM, G, (int)blockIdx.x, R, tail, split, o[1], o[2], o[3], o[4], o[5], o[6], o[7], (const char*)(ws + WS_ACTP), (const char*)(ws + WS_WMOE + WMOE_W2), (size_t)256 * DFF, (size_t)256 * DFF, (size_t)D * DFF};
        pg8::EpiMoe2 E{ws + WS_Y, (bf16_t*)(ws + WS_YP)};
        pg8::gemm_phase<pg8::EpiMoe2, pg8::Moe2Sched, true>(lds, g, S, E);
    }
}

__global__ void __launch_bounds__(512, 2) fwd(Args unused_args_read_through_kargs) {
    extern __shared__ __attribute__((aligned(16))) unsigned char lds_raw[];
    LAS unsigned char* lds = (LAS unsigned char*)lds_raw;
    volatile LAS unsigned* MISC = (volatile LAS unsigned*)(lds + MISC_OFF);
    const int tid = threadIdx.x, lane = tid & 63, wid = __builtin_amdgcn_readfirstlane(tid >> 6);
    if (tid < 64) MISC[tid] = 0u;
    __syncthreads();
    int lo, hi; XcdBarrier bar;
    { KArgs a = kargs(); lo = a->ph_lo; hi = a->ph_hi; unsigned* bw = (unsigned*)(a->ws + WS_CTL + CTL_BAR); bar.bar = bw; bar.x = 0; bar.st = nullptr; if (hi - lo > 1) bar = xcd_barrier_post(bw, MISC + 8); }
#define IN(k) (lo <= (k) && (k) < hi)
#define SEAM(k) do { if (IN(k) && IN((k) + 1)) xcd_barrier(bar); } while (0)

    if (PHON(0) && IN(0)) { for (int rp = 0; rp < REPS(0); ++rp) { prologue_phase(kargs(), lds, wid, lane); __syncthreads(); } } SEAM(0);
#pragma nounroll
    for (int layer = 0; layer < 2; ++layer) {
        const int pb = 1 + 7 * layer;
        if (PHON(1) && IN(pb + 0)) { for (int rp = 0; rp < REPS(1); ++rp) { if (layer == 0) { ph_fold(kargs(), lds); __syncthreads(); } ph_inproj(kargs(), layer, lds); __syncthreads(); } } SEAM(pb + 0);
        if (PHON(2) && IN(pb + 1)) { for (int rp = 0; rp < REPS(2); ++rp) { conv_phase(kargs(), layer, lds, tid, wid, lane); __syncthreads(); } } SEAM(pb + 1);
        if (PHON(4) && IN(pb + 3)) { for (int rp = 0; rp < REPS(4); ++rp) { ph_merge(kargs(), layer, lds); __syncthreads(); } } SEAM(pb + 3);
        if (PHON(5) && IN(pb + 4)) { for (int rp = 0; rp < (layer == 0 ? REPS(5) : 1); ++rp) { ph_wo(kargs(), layer, lds); __syncthreads(); } } SEAM(pb + 4);
        if (layer == 0) {
            if (PHON(6) && IN(6)) { for (int rp = 0; rp < REPS(6); ++rp) { ph_ffn1(kargs(), lds); __syncthreads(); } } SEAM(6);
            if (PHON(7) && IN(7)) { ph_ffn2(kargs(), lds); } SEAM(7);
        }
    }
    if (PHON(13) && IN(13)) { for (int rp = 0; rp < REPS(13); ++rp) { route_phase(kargs(), lds, tid, wid, lane); __syncthreads(); } } SEAM(13);
    if (PHON(14) && IN(14)) { for (int rp = 0; rp < REPS(14); ++rp) { scatter_phase(kargs(), lds, tid, wid, lane); __syncthreads(); } } SEAM(14);
    if (PHON(15) && IN(15)) { for (int rp = 0; rp < REPS(15); ++rp) { ph_moe(kargs(), 0, lds); __syncthreads(); } } SEAM(15);
    if (PHON(16) && IN(16)) { for (int rp = 0; rp < REPS(16); ++rp) { ph_moe(kargs(), 1, lds); __syncthreads(); } } SEAM(16);
    if (PHON(17) && IN(17)) { for (int rp = 0; rp < REPS(17); ++rp) { combine_phase(kargs(), lds, tid, wid, lane); __syncthreads(); } }
#undef IN
#undef SEAM
}

extern "C" void kernel_launch(void* const* d_in, const int* in_sizes, int n_in, void* d_out, int out_size, void* d_ws, size_t ws_size, hipStream_t stream) {
    static int grid = 0;
    if (grid == 0) {
        if (n_in != 23 || in_sizes[0] != M * D || out_size != M * D || ws_size < WS_END) { fprintf(stderr, "kernel_launch: unexpected shapes: n_in %d in0 %d out %d ws %zu (need %zu); nothing launched\n", n_in, n_in > 0 ? in_sizes[0] : -1, out_size, ws_size, (size_t)WS_END); grid = -1; return; }
        int dev = 0, cus = 0, per_cu = 0;
        if (hipGetDevice(&dev) != hipSuccess || hipDeviceGetAttribute(&cus, hipDeviceAttributeMultiprocessorCount, dev) != hipSuccess) { fprintf(stderr, "kernel_launch: device query failed\n"); grid = -1; return; }
        if (hipFuncSetAttribute((const void*)fwd, hipFuncAttributeMaxDynamicSharedMemorySize, LDS_BYTES) != hipSuccess) { fprintf(stderr, "kernel_launch: hipFuncSetAttribute failed\n"); grid = -1; return; }
        if (hipOccupancyMaxActiveBlocksPerMultiprocessor(&per_cu, (const void*)fwd, 512, LDS_BYTES) != hipSuccess || per_cu < 1) fprintf(stderr, "kernel_launch: note: occupancy query reports %d workgroups per CU\n", per_cu);
        (void)hipGetLastError();
        grid = cus;
    }
    if (grid < 0) return;
    if (hipMemsetAsync((char*)d_ws + WS_CTL, 0, CTL_BYTES, stream) != hipSuccess) { fprintf(stderr, "kernel_launch: memset failed\n"); return; }
    Args a{};
    for (int i = 0; i < 23; ++i) a.in[i] = (const float*)d_in[i];
    a.out = (float*)d_out; a.ws = (unsigned char*)d_ws;
#if MK_PER_PHASE
    for (int ph = 0; ph < NPH; ++ph) { a.ph_lo = ph; a.ph_hi = ph + 1; hipLaunchKernelGGL(fwd, dim3(grid), dim3(512), LDS_BYTES, stream, a); }
#else
    a.ph_lo = 0; a.ph_hi = NPH; hipLaunchKernelGGL(fwd, dim3(grid), dim3(512), LDS_BYTES, stream, a);
#endif
    const hipError_t le = hipPeekAtLastError();
    if (le != hipSuccess) fprintf(stderr, "kernel_launch: launch failed: %s\n", hipGetErrorName(le));
}
```

```cpp
#include <hip/hip_runtime.h>
#include <cstdio>
#include <cstdint>

#ifndef MK_PER_PHASE
#define MK_PER_PHASE 0
#endif

#ifndef MK_REP_MASK
#define MK_REP_MASK 0u
#endif
#define REPS(bit) (1 + (int)(((MK_REP_MASK) >> (bit)) & 1u))
#define REPS2(bit) REPS(bit)

#define LAS __attribute__((address_space(3)))
typedef unsigned short bf16_t;
typedef short bf16x8 __attribute__((ext_vector_type(8)));
typedef float f32x4 __attribute__((ext_vector_type(4)));
typedef float f32x2 __attribute__((ext_vector_type(2)));
typedef unsigned u32x4 __attribute__((ext_vector_type(4)));
typedef unsigned u32x2 __attribute__((ext_vector_type(2)));

constexpr int M = 16384, D = 1024, SEQ = 8192, INC = 9216, DFF = 3584, NE = 8;
constexpr float RMS_EPS = 1e-6f, LN_EPS = 1e-5f;
constexpr int MAXSLOT = 34816;
constexpr float F8_W13_MUL = 128.f, F8_ACT_MUL = 4.f, F8_W2_MUL = 256.f, F8_Y_MUL = 32.f;
constexpr int F8_ONE = 0x7f7f7f7f, F8_W13_SC = 0x78787878  , F8_ACT_SC = 0x7d7d7d7d  , F8_W2_SC = 0x77777777  ;

constexpr size_t MiB = 1u << 20;
constexpr size_t WS_CTL = 0, CTL_BYTES = 64 * 1024;
constexpr size_t CTL_BAR = 16384;
constexpr size_t CTL_CNT = 32768;
constexpr size_t WS_SMALL = 1 * MiB;
constexpr size_t SM_TOPE = 0, SM_TOPP = 64 * 1024, SM_TSLOT = 192 * 1024, SM_SSPERM = 320 * 1024, SM_META = 512 * 1024;
constexpr size_t WS_X8 = 2 * MiB;
constexpr size_t WS_YP = 18 * MiB;
constexpr size_t WS_WG8 = 492 * MiB;
constexpr size_t WS_XB = 66 * MiB;
constexpr size_t WS_W0 = 98 * MiB;
constexpr size_t W0_WIN = 0;
constexpr size_t W0_WOUT = 36 * MiB;
constexpr size_t W0_WO = 48 * MiB;
constexpr size_t W0_POOL = 52 * MiB;
constexpr size_t W0_D13 = 53 * MiB;
constexpr size_t W0_D2 = 67 * MiB;
constexpr size_t WS_ACT = 172 * MiB;
constexpr size_t A_SCB = WS_ACT, A_SCX = WS_ACT + 32 * MiB, A_GLU = WS_ACT + 64 * MiB, A_PU = WS_ACT + 96 * MiB, A_GATES = WS_ACT + 128 * MiB,
                 A_YA = WS_ACT + 224 * MiB, A_VB = WS_ACT + 256 * MiB, A_PP = WS_ACT + 288 * MiB, A_MERGED = A_SCX, A_FFN = WS_ACT;
constexpr size_t WS_HALO = 528 * MiB;
constexpr size_t WS_WC = 524 * MiB;
constexpr size_t WS_ACTP = 98 * MiB;
constexpr size_t WS_WMOE = 304 * MiB, WMOE_W2 = 56 * MiB;
constexpr size_t WS_Y = 400 * MiB;
constexpr size_t WS_APERM = 472 * MiB;
constexpr size_t WS_SS = 540 * MiB;
constexpr size_t WS_END = 541 * MiB;

typedef __bf16 bf16x2_t __attribute__((ext_vector_type(2)));
__device__ __forceinline__ unsigned pk_bf16(float lo, float hi) { const bf16x2_t v = {(__bf16)lo, (__bf16)hi}; return __builtin_bit_cast(unsigned, v); }
__device__ __forceinline__ unsigned pk_fp8x4(const f32x4 v) {
    const float a = __builtin_amdgcn_fmed3f(v[0], -448.f, 448.f), b = __builtin_amdgcn_fmed3f(v[1], -448.f, 448.f), c = __builtin_amdgcn_fmed3f(v[2], -448.f, 448.f), d = __builtin_amdgcn_fmed3f(v[3], -448.f, 448.f);
    int w = 0; w = __builtin_amdgcn_cvt_pk_fp8_f32(a, b, w, false); w = __builtin_amdgcn_cvt_pk_fp8_f32(c, d, w, true); return (unsigned)w; }
__device__ __forceinline__ float bf_lo(unsigned u) { return __uint_as_float(u << 16); }
__device__ __forceinline__ float bf_hi(unsigned u) { return __uint_as_float(u & 0xffff0000u); }
__device__ __forceinline__ float sigm(float x) { return __builtin_amdgcn_rcpf(1.f + __builtin_amdgcn_exp2f(-1.44269504f * x)); }
__device__ __forceinline__ float wave_sum(float v) {
#pragma unroll
    for (int o = 1; o < 64; o <<= 1) v += __shfl_xor(v, o);
    return v;
}
#define LDS_WAIT() asm volatile("s_waitcnt lgkmcnt(0)" ::: "memory")

namespace pg8 {
constexpr int BM = 256, BK = 64, HALF = 128, HTB = HALF * BK * 2, STAGE_BYTES = 8 * HTB, NXCD = 8;
__host__ __device__ __forceinline__ int lds_byte(int r, int c) { const int st = (r >> 4) * 2 + (c >> 5), rr = r & 15, cc = c & 31, ob = rr * 64 + cc * 2; return st * 1024 + (ob ^ (((ob >> 9) & 1) << 5)); }
__host__ __device__ __forceinline__ void stage_rc(int b, int& R, int& C) { const int st = b / 1024, sb = b % 1024, swz = sb ^ (((sb >> 9) & 1) << 5); R = (st >> 1) * 16 + swz / 64; C = (st & 1) * 32 + (swz % 64) / 2; }
__host__ __device__ __forceinline__ int perm32(int rho) { const int n = rho >> 4, i = rho & 15; return 8 * (i >> 2) + 4 * n + (i & 3); }

struct Unit { int pm, pn, aux, nt; const char* A; const char* B; };
struct Gemm { int Kb, lda, ldb; int sa, sb; };

__device__ __forceinline__ bool tile_of(int L, int nM, int nN, int& pm, int& pn, int WGM = 4) {
    const int nwg = nM * nN; if (L >= nwg) return false;
    int wgid = L; { const int q = nwg / NXCD, r = nwg % NXCD, xcd = wgid % NXCD, off = wgid / NXCD; wgid = (xcd < r ? xcd * (q + 1) : r * (q + 1) + (xcd - r) * q) + off; }
    const int nig = WGM * nN, gid = wgid / nig, fm = gid * WGM, gsz = (nM - fm) < WGM ? (nM - fm) : WGM;
    pm = fm + ((wgid % nig) % gsz); pn = (wgid % nig) / gsz; return true;
}
struct PlainSched {
    int nM, nN, G, c; const char* A0; const char* B0; size_t astep, bstep; int wgm; int bsplit, badd;
    __device__ __forceinline__ bool next(int i, Unit& u) const { int pm, pn; if (!tile_of(i * G + c, nM, nN, pm, pn, wgm)) return false; u.pm = pm; u.pn = pn; u.aux = 0; u.nt = 0; u.A = A0 + (size_t)pm * astep; u.B = B0 + (size_t)(pn + (pn >= bsplit ? badd : 0)) * bstep; return true; }
};
struct PoolSched {
    int G, c; const char* A0; const char* B0;
    __device__ __forceinline__ bool next(int i, Unit& u) const { int pm, pn; if (!tile_of(i * G + c, M / 256, 4, pm, pn)) return false; u.pm = pm; u.pn = pn; u.aux = 0; u.nt = 0;
        u.A = A0 + (size_t)pm * (256 * 1024 * 2) + (size_t)pn * 512; u.B = B0 + (size_t)pn * (256 * 256 * 2); return true; }
};
struct MergeSched {
    int G, c; const char *A0, *B0, *B2; size_t astr, bstr;
    __device__ __forceinline__ bool next(int i, Unit& u) const { const int t = i / 3, b = i - 3 * t; int pm, pn; if (!tile_of(t * G + c, M / 256, 4, pm, pn)) return false; u.pm = pm; u.pn = pn; u.aux = b; u.nt = 0;
        const char* w = b == 2 ? B2 : B0 + (size_t)b * bstr;
        u.A = A0 + (size_t)b * astr + (size_t)pm * (256 * 1024 * 2); u.B = w + (size_t)pn * (256 * 1024 * 2); return true; }
};
struct FoldSched {
    int G, c; const char *A0, *B0;
    __device__ __forceinline__ bool next(int i, Unit& u) const { const int idx = i * G + c; if (idx >= 32) return false; const int L = idx >> 4, pm = (idx >> 2) & 3, g = idx & 3; u.pm = pm; u.pn = g; u.aux = L; u.nt = 0;
        u.A = A0 + (size_t)L * (6 * MiB) + (size_t)pm * (256 * 1024 * 2) + (size_t)g * 512; u.B = B0 + (size_t)L * (512 * 1024) + (size_t)g * (256 * 256 * 2); return true; }
};
struct GroupSched {
    int nM, nN, G, c; int o1, o2, o3, o4, o5, o6, o7; const char* A0; const char* B0; size_t astep, bstep, estep; int wgm;
    __device__ __forceinline__ bool next(int i, Unit& u) const { int pm, pn; if (!tile_of(i * G + c, nM, nN, pm, pn, wgm)) return false; u.pm = pm; u.pn = pn; u.aux = 0; u.nt = 0;
        const int e = (pm >= o1) + (pm >= o2) + (pm >= o3) + (pm >= o4) + (pm >= o5) + (pm >= o6) + (pm >= o7);
        u.A = A0 + (size_t)pm * astep; u.B = B0 + (size_t)e * estep + (size_t)pn * bstep; return true; }
};

constexpr int MOE2_SPL = 7, MOE2_SNT = 4;
struct Moe2Sched {
    int nM, G, c, R, tail, split; int o1, o2, o3, o4, o5, o6, o7; const char* A0; const char* B0; size_t astep, bstep, estep;
    __device__ __forceinline__ bool next(int i, Unit& u) const {
        int L = i * G + c, part = -1, sub = 0;
        if (split && i >= R) { if (i > R || c >= MOE2_SPL * tail) return false; sub = c; L = R * G + c / MOE2_SPL; part = c % MOE2_SPL; }
        int pm, pn; if (!tile_of(L, nM, 4, pm, pn, 4)) return false; u.pm = pm; u.pn = pn;
        const int e = (pm >= o1) + (pm >= o2) + (pm >= o3) + (pm >= o4) + (pm >= o5) + (pm >= o6) + (pm >= o7);
        u.A = A0 + (size_t)pm * astep; u.B = B0 + (size_t)e * estep + (size_t)pn * bstep; u.aux = 0; u.nt = 0;
        if (part >= 0) { u.A += part * (MOE2_SNT * 128); u.B += part * (MOE2_SNT * 128); u.aux = 1 + sub; u.nt = MOE2_SNT; }
        return true; }
};

typedef f32x4 Acc[2][2][4][2];
__device__ __forceinline__ u32x4 pack8(const f32x4 v0, const f32x4 v1) { u32x4 w; w.x = pk_bf16(v0[0], v0[1]); w.y = pk_bf16(v0[2], v0[3]); w.z = pk_bf16(v1[0], v1[1]); w.w = pk_bf16(v1[2], v1[3]); return w; }
__device__ __forceinline__ f32x4 sig4(const f32x4 v) { f32x4 r; r[0] = sigm(v[0]); r[1] = sigm(v[1]); r[2] = sigm(v[2]); r[3] = sigm(v[3]); return r; }
__device__ __forceinline__ void unpack8(const u32x4 g, f32x4& lo, f32x4& hi) { lo[0] = bf_lo(g.x); lo[1] = bf_hi(g.x); lo[2] = bf_lo(g.y); lo[3] = bf_hi(g.y); hi[0] = bf_lo(g.z); hi[1] = bf_hi(g.z); hi[2] = bf_lo(g.w); hi[3] = bf_hi(g.w); }

__device__ __forceinline__ size_t gate_frag(int pm, int q, int wid, int ai, int m, int lane) { return ((size_t)(((((pm * 12 + q) * 8 + wid) * 2 + ai) * 4 + m) * 64 + lane)) * 16; }
__device__ __forceinline__ unsigned pk_fp8x4_raw(const f32x4 v) { int w = 0; w = __builtin_amdgcn_cvt_pk_fp8_f32(v[0], v[1], w, false); w = __builtin_amdgcn_cvt_pk_fp8_f32(v[2], v[3], w, true); return (unsigned)w; }
__device__ __forceinline__ f32x4 un_fp8x4(unsigned w) { const f32x2 lo = __builtin_amdgcn_cvt_pk_f32_fp8((int)w, false), hi = __builtin_amdgcn_cvt_pk_f32_fp8((int)w, true); return (f32x4){lo[0], lo[1], hi[0], hi[1]}; }
struct EpiProj {
    bf16_t *glu, *gates; const f32x4* ss;
    __device__ __forceinline__ bool operator()(Acc& acc, const Unit& u, int wr, int wc, int fr, int fq) const {
        const int row0 = u.pm * BM + wr * 64 + fr, pn = u.pn;
        float rs[2][4];
#pragma unroll
        for (int ai = 0; ai < 2; ++ai)
#pragma unroll
            for (int m = 0; m < 4; ++m) { const f32x4 p = ss[row0 + ai * HALF + m * 16]; rs[ai][m] = __builtin_amdgcn_rsqf(((p[0] + p[1]) + (p[2] + p[3])) * (1.0f / D) + RMS_EPS); }
        if (pn < 8) {
            const int col0 = pn * 128 + wc * 32 + 8 * fq;
#pragma unroll
            for (int ai = 0; ai < 2; ++ai)
#pragma unroll
                for (int m = 0; m < 4; ++m) { const float r = rs[ai][m];
                    const f32x4 a0 = acc[ai][0][m][0] * r, a1 = acc[ai][0][m][1] * r, b0 = sig4(acc[ai][1][m][0] * r), b1 = sig4(acc[ai][1][m][1] * r);
                    *(u32x4*)(glu + (size_t)(row0 + ai * HALF + m * 16) * D + col0) = pack8(a0 * b0, a1 * b1); }
        } else {
#pragma unroll
            for (int ai = 0; ai < 2; ++ai)
#pragma unroll
                for (int m = 0; m < 4; ++m) { const float r = -1.44269504f * rs[ai][m]; u32x4 w;
#pragma unroll
                    for (int bj = 0; bj < 2; ++bj) { f32x4 e0 = acc[ai][bj][m][0] * r, e1 = acc[ai][bj][m][1] * r;
#pragma unroll
                        for (int j = 0; j < 4; ++j) { e0[j] = __builtin_amdgcn_exp2f(__builtin_amdgcn_fmed3f(e0[j], -8.65617f, 8.65617f)); e1[j] = __builtin_amdgcn_exp2f(__builtin_amdgcn_fmed3f(e1[j], -8.65617f, 8.65617f)); }
                        w[2 * bj] = pk_fp8x4_raw(e0); w[2 * bj + 1] = pk_fp8x4_raw(e1); }
                    *(u32x4*)((unsigned char*)gates + gate_frag(u.pm, pn - 8, wr * 4 + wc, ai, m, fr + 16 * fq)) = w; }
        }
        return false;
    }
};
template <int CTRL> __device__ __forceinline__ float dpp_f(float old, float src) { return __int_as_float(__builtin_amdgcn_update_dpp(__float_as_int(old), __float_as_int(src), CTRL, 0xf, 0xf, false)); }
struct EpiSc {
    bf16_t *ya, *pp, *pu; const f32x4* ss; const float* scw; float* halo; LAS float* ex; LAS float* px;
    __device__ __forceinline__ bool operator()(Acc& acc, const Unit& u, int wr, int wc, int fr, int fq) const {
        const int row0 = u.pm * BM + wr * 64 + fr, ch0 = u.pn * 64 + wc * 16 + fq * 4;
        const int g = __builtin_amdgcn_readfirstlane(u.pn >> 2);
#pragma unroll
        for (int ai = 0; ai < 2; ++ai)
#pragma unroll
            for (int m = 0; m < 4; ++m) { const f32x4 p = ss[row0 + ai * HALF + m * 16]; const float r = __builtin_amdgcn_rsqf(((p[0] + p[1]) + (p[2] + p[3])) * (1.0f / D) + RMS_EPS);
                acc[ai][0][m][0] = acc[ai][0][m][0] * r; acc[ai][0][m][1] = (acc[ai][0][m][1] * r) * (acc[ai][1][m][0] * r); acc[ai][1][m][1] = acc[ai][1][m][1] * r; acc[ai][1][m][0] = acc[ai][1][m][1]; }
        if (fr >= 14) {
#pragma unroll
            for (int ai = 0; ai < 2; ++ai) *(LAS f32x4*)(ex + ((((ai * 2 + wr) * 4 + wc) * 4 + fq) * 2 + (fr - 14)) * 4) = acc[ai][0][3][1];
            if (wr == 1) *(f32x4*)(halo + ((size_t)((2 * 64 + u.pm) * 2 + (fr - 14))) * D + ch0) = acc[1][0][3][1];
        }
        if (wr == 0 && fr < 2) { *(f32x4*)(halo + ((size_t)((0 * 64 + u.pm) * 2 + fr)) * D + ch0) = acc[0][0][0][0]; *(f32x4*)(halo + ((size_t)((1 * 64 + u.pm) * 2 + fr)) * D + ch0) = acc[0][0][0][1]; }
        if (wr == 0) { const f32x4 v = acc[0][1][0][1]; *(u32x2*)(pu + (size_t)row0 * D + ch0) = (u32x2){pk_bf16(v[0], v[1]), pk_bf16(v[2], v[3])}; }
        else { const f32x4 v = acc[1][1][3][1]; *(u32x2*)(pu + (size_t)(row0 + HALF + 48) * D + ch0) = (u32x2){pk_bf16(v[0], v[1]), pk_bf16(v[2], v[3])}; }
#pragma unroll
        for (int ai = 0; ai < 2; ++ai) { LAS float* eb = px + ((((ai * 2 + wr) * 4 + wc) * 4 + fq) * 15) * 4;
#define POOL_STEP(DSH, ROR, SHR) do { if (fr >= 16 - DSH) *(LAS f32x4*)(eb + (DSH - 1 + fr - (16 - DSH)) * 4) = acc[ai][1][3][0]; \
            _Pragma("unroll") for (int m = 3; m >= 0; --m) { _Pragma("unroll") for (int j = 0; j < 4; ++j) { float f = 0.f; if (m > 0) f = dpp_f<ROR>(0.f, acc[ai][1][m - 1][0][j]); acc[ai][1][m][0][j] += dpp_f<SHR>(f, acc[ai][1][m][0][j]); } } } while (0)
            POOL_STEP(1, 0x121, 0x111);
            if (g >= 1) POOL_STEP(2, 0x122, 0x112);
            if (g >= 2) POOL_STEP(4, 0x124, 0x114);
            if (g >= 3) POOL_STEP(8, 0x128, 0x118);
#undef POOL_STEP
        }
        const f32x4 w0 = *(const f32x4*)(scw + ch0), w1 = *(const f32x4*)(scw + D + ch0), w2 = *(const f32x4*)(scw + 2 * D + ch0);
        asm volatile("s_waitcnt lgkmcnt(0)" ::: "memory"); __builtin_amdgcn_s_barrier(); asm volatile("" ::: "memory");
        const float invw = 0.5f / (float)(1 << g);
#pragma unroll
        for (int ai = 0; ai < 2; ++ai) {
            f32x4 F1 = (f32x4){0.f, 0.f, 0.f, 0.f}, F2 = F1;
            if (ai + wr > 0) { const int pb = 2 * ai + wr - 1; const LAS float* e = ex + (((pb * 4 + wc) * 4 + fq) * 2) * 4; const f32x4 E0 = *(const LAS f32x4*)e, E1 = *(const LAS f32x4*)(e + 4); F1 = E1; F2 = fr == 0 ? E0 : E1;
                const LAS float* pe = px + (((pb * 4 + wc) * 4 + fq) * 15) * 4; f32x4 t = acc[ai][1][0][1];
#define POOL_REDO(DSH, SHR) do { const f32x4 f = *(const LAS f32x4*)(pe + (DSH - 1 + (fr & (DSH - 1))) * 4); _Pragma("unroll") for (int j = 0; j < 4; ++j) t[j] += dpp_f<SHR>(f[j], t[j]); } while (0)
                POOL_REDO(1, 0x111);
                if (g >= 1) POOL_REDO(2, 0x112);
                if (g >= 2) POOL_REDO(4, 0x114);
                if (g >= 3) POOL_REDO(8, 0x118);
#undef POOL_REDO
                acc[ai][1][0][0] = t; }
#pragma unroll
            for (int m = 0; m < 4; ++m) { const f32x4 pr = acc[ai][0][m][1]; f32x4 y;
                if (m > 0) { const f32x4 pv = acc[ai][0][m - 1][1];
#pragma unroll
                    for (int j = 0; j < 4; ++j) { F1[j] = dpp_f<0x121>(0.f, pv[j]); F2[j] = dpp_f<0x122>(0.f, pv[j]); } }
#pragma unroll
                for (int j = 0; j < 4; ++j) { const float p1 = dpp_f<0x111>(F1[j], pr[j]), p2 = dpp_f<0x112>(F2[j], pr[j]); y[j] = acc[ai][0][m][0][j] * (w0[j] * p2 + w1[j] * p1 + w2[j] * pr[j]); }
                const f32x4 q = acc[ai][1][m][0] * invw - acc[ai][1][m][1];
                const auto s0 = __builtin_amdgcn_permlane16_swap(pk_bf16(y[0], y[1]), pk_bf16(q[0], q[1]), false, false), s1 = __builtin_amdgcn_permlane16_swap(pk_bf16(y[2], y[3]), pk_bf16(q[2], q[3]), false, false);
                *(u32x4*)(ya + (ptrdiff_t)(fq & 1) * (pp - ya) + (size_t)(row0 + ai * HALF + m * 16) * D + (ch0 & ~7)) = (u32x4){s0[0], s1[0], s0[1], s1[1]}; }
        }
        return false;
    }
};
struct EpiPlain {
    bf16_t* Ob; int ldc; size_t aux_stride;
    __device__ __forceinline__ bool operator()(Acc& acc, const Unit& u, int wr, int wc, int fr, int fq) const {
        bf16_t* O = Ob + (size_t)u.aux * aux_stride;
        const int row0 = u.pm * BM + wr * 64 + fr, col0 = u.pn * BM + wc * 32 + 8 * fq;
#pragma unroll
        for (int ai = 0; ai < 2; ++ai)
#pragma unroll
            for (int m = 0; m < 4; ++m) { bf16_t* rowp = O + (size_t)(row0 + ai * HALF + m * 16) * ldc + col0;
#pragma unroll
                for (int bj = 0; bj < 2; ++bj) *(u32x4*)(rowp + bj * HALF) = pack8(acc[ai][bj][m][0], acc[ai][bj][m][1]); }
        return false;
    }
};
struct EpiMoe2 {
    unsigned char* Y; bf16_t* YP;
    __device__ __forceinline__ bool operator()(Acc& acc, const Unit& u, int wr, int wc, int fr, int fq) const {
        if (u.aux) { bf16_t* O = YP + (size_t)(u.aux - 1) * 65536 + (size_t)(wr * 64 + fr) * 256 + wc * 32 + 8 * fq;
#pragma unroll
            for (int ai = 0; ai < 2; ++ai)
#pragma unroll
                for (int m = 0; m < 4; ++m) { bf16_t* rowp = O + (size_t)(ai * HALF + m * 16) * 256;
#pragma unroll
                    for (int bj = 0; bj < 2; ++bj) *(u32x4*)(rowp + bj * HALF) = pack8(acc[ai][bj][m][0], acc[ai][bj][m][1]); }
        } else {
            unsigned char* O = Y + (size_t)(u.pm * BM + wr * 64 + fr) * D + u.pn * BM + wc * 32 + 8 * (fq & ~1) + (fq & 1) * HALF;
#pragma unroll
            for (int ai = 0; ai < 2; ++ai)
#pragma unroll
                for (int m = 0; m < 4; ++m) {
                    const auto s0 = __builtin_amdgcn_permlane16_swap(pk_fp8x4(acc[ai][0][m][0] * F8_Y_MUL), pk_fp8x4(acc[ai][1][m][0] * F8_Y_MUL), false, false),
                               s1 = __builtin_amdgcn_permlane16_swap(pk_fp8x4(acc[ai][0][m][1] * F8_Y_MUL), pk_fp8x4(acc[ai][1][m][1] * F8_Y_MUL), false, false);
                    *(u32x4*)(O + (size_t)(ai * HALF + m * 16) * D) = (u32x4){s0[0], s1[0], s0[1], s1[1]}; }
        }
        return false;
    }
};
struct EpiMerge {
    const bf16_t* gates; bf16_t* O;
    __device__ __forceinline__ bool operator()(Acc& acc, const Unit& u, int wr, int wc, int fr, int fq) const {
        const int row0 = u.pm * BM + wr * 64 + fr, col0 = u.pn * BM + wc * 32 + 8 * fq, b = u.aux;
#pragma unroll
        for (int ai = 0; ai < 2; ++ai)
#pragma unroll
            for (int m = 0; m < 4; ++m) { const size_t row = (size_t)(row0 + ai * HALF + m * 16);
                const unsigned char* gp = (const unsigned char*)gates + gate_frag(u.pm, 4 * b + u.pn, wr * 4 + wc, ai, m, fr + 16 * fq);
                const u32x4 gw = *(const u32x4*)gp;
                if (b < 2) { const u32x4 hw = *(const u32x4*)(gp + gate_frag(0, 4, 0, 0, 0, 0));
#pragma unroll
                    for (int bj = 0; bj < 2; ++bj) { const f32x4 g0 = un_fp8x4(gw[2 * bj]), g1 = un_fp8x4(gw[2 * bj + 1]), h0 = un_fp8x4(hw[2 * bj]), h1 = un_fp8x4(hw[2 * bj + 1]);
#pragma unroll
                        for (int j = 0; j < 4; ++j) { acc[ai][bj][m][0][j] *= (1.f + h0[j]) * __builtin_amdgcn_rcpf(1.f + g0[j]); acc[ai][bj][m][1][j] *= (1.f + h1[j]) * __builtin_amdgcn_rcpf(1.f + g1[j]); } }
                } else {
#pragma unroll
                    for (int bj = 0; bj < 2; ++bj) { f32x4 g0 = un_fp8x4(gw[2 * bj]), g1 = un_fp8x4(gw[2 * bj + 1]);
#pragma unroll
                        for (int j = 0; j < 4; ++j) { g0[j] = __builtin_amdgcn_rcpf(1.f + g0[j]); g1[j] = __builtin_amdgcn_rcpf(1.f + g1[j]); }
                        *(u32x4*)(O + row * D + col0 + bj * HALF) = pack8(acc[ai][bj][m][0] * g0, acc[ai][bj][m][1] * g1); } } }
        return b < 2;
    }
};
struct EpiResid {
    const float* base32; bf16_t* xb; float* ssp; LAS float* red; unsigned char* x8;
    __device__ __forceinline__ bool operator()(Acc& acc, const Unit& u, int wr, int wc, int fr, int fq) const {
        const int row0 = u.pm * BM + wr * 64 + fr, col0 = u.pn * BM + wc * 32 + 8 * fq;
#pragma unroll
        for (int ai = 0; ai < 2; ++ai)
#pragma unroll
            for (int m = 0; m < 4; ++m) { const size_t row = (size_t)(row0 + ai * HALF + m * 16); float q = 0.f;
#pragma unroll
                for (int bj = 0; bj < 2; ++bj) { const size_t off = row * D + col0 + bj * HALF;
                    f32x4 b0, b1; if (base32) { b0 = *(const f32x4*)(base32 + off); b1 = *(const f32x4*)(base32 + off + 4); } else unpack8(*(const u32x4*)(xb + off), b0, b1);
                    const u32x4 pk = pack8(b0 + acc[ai][bj][m][0], b1 + acc[ai][bj][m][1]); *(u32x4*)(xb + off) = pk;
                    f32x4 o0, o1; unpack8(pk, o0, o1); if (x8) *(u32x2*)(x8 + off) = (u32x2){pk_fp8x4(o0), pk_fp8x4(o1)};
                    q += (o0[0] * o0[0] + o0[1] * o0[1]) + (o0[2] * o0[2] + o0[3] * o0[3]) + (o1[0] * o1[0] + o1[1] * o1[1]) + (o1[2] * o1[2] + o1[3] * o1[3]); }
                q += __shfl_xor(q, 16); q += __shfl_xor(q, 32);
                if (fq == 0) red[(ai * HALF + wr * 64 + m * 16 + fr) * 4 + wc] = q; }
        asm volatile("s_waitcnt lgkmcnt(0)" ::: "memory"); __builtin_amdgcn_s_barrier(); asm volatile("" ::: "memory");
        int tid = threadIdx.x; asm volatile("" : "+v"(tid));
        if (tid < 256) { const f32x4 v = *(const LAS f32x4*)(red + tid * 4); ssp[(size_t)(u.pm * BM + tid) * 4 + u.pn] = (v[0] + v[1]) + (v[2] + v[3]); }
        return false;
    }
};
template <bool PART4, bool OUT8> struct EpiSwiGLU {
    bf16_t* O; int ldc; const float* ss;
    __device__ __forceinline__ bool operator()(Acc& acc, const Unit& u, int wr, int wc, int fr, int fq) const {
        const int row0 = u.pm * BM + wr * 64 + fr, col0 = u.pn * 128 + wc * 32 + 8 * fq;
#pragma unroll
        for (int ai = 0; ai < 2; ++ai)
#pragma unroll
            for (int m = 0; m < 4; ++m) { const size_t row = (size_t)(row0 + ai * HALF + m * 16); float r = 1.f;
                if (PART4) { const f32x4 p = *(const f32x4*)(ss + row * 4); r = __builtin_amdgcn_rsqf(((p[0] + p[1]) + (p[2] + p[3])) * (1.0f / D) + RMS_EPS); }
                const f32x4 a0 = acc[ai][0][m][0] * r, a1 = acc[ai][0][m][1] * r, c0 = acc[ai][1][m][0] * r, c1 = acc[ai][1][m][1] * r;
                const f32x4 h0 = a0 * sig4(a0) * c0, h1 = a1 * sig4(a1) * c1;
                if (OUT8) { *(u32x2*)((unsigned char*)O + row * ldc + col0) = (u32x2){pk_fp8x4(h0 * F8_ACT_MUL), pk_fp8x4(h1 * F8_ACT_MUL)}; }
                else *(u32x4*)(O + row * ldc + col0) = pack8(h0, h1); }
        return false;
    }
};

typedef int i32x4 __attribute__((ext_vector_type(4)));
typedef int i32x8 __attribute__((ext_vector_type(8)));
__device__ __forceinline__ i32x8 join16(const bf16x8 lo, const bf16x8 hi) { return __builtin_shufflevector(__builtin_bit_cast(i32x4, lo), __builtin_bit_cast(i32x4, hi), 0, 1, 2, 3, 4, 5, 6, 7); }
template <class Epi, class Sched, bool F8 = false>
__device__ __forceinline__ void gemm_phase(LAS unsigned char* lds, const Gemm g, const Sched& S, const Epi& E) {
    int tid_ = threadIdx.x; asm volatile("" : "+v"(tid_));
    const int tid = tid_, wid = __builtin_amdgcn_readfirstlane(tid >> 6), lane = tid & 63, wr = wid >> 2, wc = wid & 3, fr = lane & 15, fq = lane >> 4;
    const int nt = g.Kb / 128;
    int vsa = g.sa, vsb = g.sb; asm volatile("" : "+v"(vsa), "+v"(vsb));
    unsigned voffA[2], voffB[2];
#pragma unroll
    for (int i = 0; i < 2; ++i) { int R, C; stage_rc(tid * 16 + i * 8192, R, C); const int Rb = (R & ~31) + perm32(R & 31);
        voffA[i] = (unsigned)(R * g.lda + C * 2); voffB[i] = (unsigned)(Rb * g.ldb + C * 2); }
    const size_t kstep = (size_t)(BK * 2);
    const size_t hstepA = (size_t)HALF * g.lda, hstepB = (size_t)HALF * g.ldb;
    const unsigned ldsw = (unsigned)wid * 1024u;
    const int aoff = lds_byte(wr * 64 + fr, fq * 8), boff = lds_byte(wc * 32 + fr, fq * 8);
#define PG8_SA(b, h) (((b) * 2 + (h)) * HTB)
#define PG8_SB(b, h) ((4 + (b) * 2 + (h)) * HTB)
#define PG8_STAGE(bufoff, gbase, voff) do { _Pragma("unroll") for (int _i = 0; _i < 2; ++_i) \
        __builtin_amdgcn_global_load_lds((const unsigned*)((const char*)(gbase) + (voff)[_i]), (LAS unsigned*)(lds + (bufoff) + ldsw + _i * 8192), 16, 0, 0); } while (0)
#define PG8_LDA(dst, b, h) do { _Pragma("unroll") for (int m = 0; m < 4; ++m) _Pragma("unroll") for (int k = 0; k < 2; ++k) dst[m][k] = *(const LAS bf16x8*)(lds + PG8_SA(b, h) + aoff + m * 2048 + k * 1024); } while (0)
#define PG8_LDB(dst, b, h) do { _Pragma("unroll") for (int n = 0; n < 2; ++n) _Pragma("unroll") for (int k = 0; k < 2; ++k) dst[n][k] = *(const LAS bf16x8*)(lds + PG8_SB(b, h) + boff + n * 2048 + k * 1024); } while (0)
#define PG8_MMA(ai, bj, At, Bt) do { __builtin_amdgcn_s_setprio(1); _Pragma("unroll") for (int m = 0; m < 4; ++m) _Pragma("unroll") for (int n = 0; n < 2; ++n) { \
        if constexpr (F8) { const i32x8 b8_ = join16(Bt[n][0], Bt[n][1]), a8_ = join16(At[m][0], At[m][1]); \
            asm volatile("v_mfma_scale_f32_16x16x128_f8f6f4 %0, %1, %2, %0, %3, %4 op_sel_hi:[0,0,0]" : "+v"(acc[ai][bj][m][n]) : "v"(b8_), "v"(a8_), "v"(vsb), "v"(vsa)); } \
        else { _Pragma("unroll") for (int k = 0; k < 2; ++k) acc[ai][bj][m][n] = __builtin_amdgcn_mfma_f32_16x16x32_bf16(Bt[n][k], At[m][k], acc[ai][bj][m][n], 0, 0, 0); } } __builtin_amdgcn_s_setprio(0); } while (0)
#define PG8_WAIT_V(n) asm volatile("s_waitcnt vmcnt(" #n ")" ::: "memory")
#define PG8_WAIT_L(n) asm volatile("s_waitcnt lgkmcnt(" #n ")" ::: "memory")
#define PG8_BAR __builtin_amdgcn_s_barrier()
#define PG8_SCHED __builtin_amdgcn_sched_barrier(0)
    Unit cur, nxt; int ui = 0;
    if (!S.next(0, cur)) return;
    Acc acc;
#pragma unroll
    for (int a = 0; a < 2; ++a)
#pragma unroll
        for (int b = 0; b < 2; ++b)
#pragma unroll
            for (int m = 0; m < 4; ++m)
#pragma unroll
                for (int n = 0; n < 2; ++n) acc[a][b][m][n] = (f32x4){0.f, 0.f, 0.f, 0.f};
    bf16x8 At[4][2], B0[2][2], B1[2][2];
    const char* cA = cur.A; const char* cB = cur.B;
    PG8_STAGE(PG8_SB(0, 0), cB, voffB); PG8_STAGE(PG8_SB(0, 1), cB + hstepB, voffB); PG8_STAGE(PG8_SA(0, 0), cA, voffA); PG8_STAGE(PG8_SA(0, 1), cA + hstepA, voffA);
    if (wr == 1) PG8_BAR;
    PG8_WAIT_V(2); PG8_BAR;
    PG8_STAGE(PG8_SB(1, 0), cB + kstep, voffB); PG8_STAGE(PG8_SA(1, 0), cA + kstep, voffA); PG8_STAGE(PG8_SB(1, 1), cB + hstepB + kstep, voffB);
    PG8_WAIT_V(6); PG8_BAR;
    for (;;) {
        const bool has_next = S.next(ui + 1, nxt);
        const char* nA = has_next ? nxt.A : cA; const char* nB = has_next ? nxt.B : cB;
        const int unt = cur.nt ? cur.nt : nt;
#pragma nounroll
        for (int t = 0; t < unt; t += 2) {
            const bool last = (t == unt - 2);
            const char* a1 = cA + (size_t)(t + 1) * kstep;
            const char* a2 = last ? nA : cA + (size_t)(t + 2) * kstep; const char* b2 = last ? nB : cB + (size_t)(t + 2) * kstep;
            const char* a3 = a2 + kstep; const char* b3 = b2 + kstep;
            PG8_LDB(B0, 0, 0); PG8_LDB(B1, 0, 1); PG8_SCHED; PG8_LDA(At, 0, 0); PG8_STAGE(PG8_SA(1, 1), a1 + hstepA, voffA);
            PG8_WAIT_V(8); PG8_WAIT_L(0); PG8_BAR; PG8_MMA(0, 0, At, B0); PG8_MMA(0, 1, At, B1); PG8_BAR; PG8_SCHED;
            PG8_LDA(At, 0, 1); PG8_STAGE(PG8_SB(0, 0), b2, voffB); PG8_STAGE(PG8_SB(0, 1), b2 + hstepB, voffB); PG8_STAGE(PG8_SA(0, 0), a2, voffA);
            PG8_WAIT_V(8); PG8_WAIT_L(0); PG8_BAR; PG8_MMA(1, 0, At, B0); PG8_MMA(1, 1, At, B1); PG8_BAR; PG8_SCHED;
            PG8_LDB(B0, 1, 0); PG8_LDB(B1, 1, 1); PG8_SCHED; PG8_LDA(At, 1, 0); PG8_STAGE(PG8_SA(0, 1), a2 + hstepA, voffA);
            PG8_WAIT_V(8); PG8_WAIT_L(0); PG8_BAR; PG8_MMA(0, 0, At, B0); PG8_MMA(0, 1, At, B1); PG8_BAR; PG8_SCHED;
            PG8_LDA(At, 1, 1); PG8_STAGE(PG8_SB(1, 0), b3, voffB); PG8_STAGE(PG8_SB(1, 1), b3 + hstepB, voffB); PG8_STAGE(PG8_SA(1, 0), a3, voffA);
            PG8_WAIT_V(8); PG8_WAIT_L(0); PG8_BAR; PG8_MMA(1, 0, At, B0); PG8_MMA(1, 1, At, B1); PG8_BAR; PG8_SCHED;
        }
        if constexpr (F8) asm volatile("s_nop 15\n\ts_nop 15" ::: "memory");
        if (wr == 0) PG8_BAR;
        const bool keep = E(acc, cur, wr, wc, fr, fq);
        if (!has_next) break;
        if (!keep) {
#pragma unroll
            for (int a = 0; a < 2; ++a)
#pragma unroll
                for (int b = 0; b < 2; ++b)
#pragma unroll
                    for (int m = 0; m < 4; ++m)
#pragma unroll
                        for (int n = 0; n < 2; ++n) acc[a][b][m][n] = (f32x4){0.f, 0.f, 0.f, 0.f};
        }
        cur = nxt; cA = nA; cB = nB; ++ui;
        if (wr == 1) PG8_BAR;
    }
    PG8_WAIT_V(0);
    PG8_BAR;
#undef PG8_SA
#undef PG8_SB
#undef PG8_STAGE
#undef PG8_LDA
#undef PG8_LDB
#undef PG8_MMA
#undef PG8_WAIT_V
#undef PG8_WAIT_L
#undef PG8_BAR
#undef PG8_SCHED
}
}

constexpr int RING_BYTES = 131072, MISC_OFF = RING_BYTES, RED_OFF = RING_BYTES + 1024, POOLX_OFF = RED_OFF + 4096, LDS_BYTES = 163840;

#define XB_TMO      128
#define XB_XCNT(j)  (256  + 64 * (j))
#define XB_XSUB(j)  (1280 + 64 * (j))
#define XB_XGEN(j)  (2304 + 64 * (j))
#define XB_TOP      3328
#define XB_TOPGEN   3392
#define XCD_BAR_WORDS 3456
#define XB_SPIN_CAP (1u << 18)
__device__ __forceinline__ unsigned xb_ld(unsigned* p)              { return __hip_atomic_load(p, __ATOMIC_RELAXED, __HIP_MEMORY_SCOPE_AGENT); }
__device__ __forceinline__ unsigned xb_add(unsigned* p, unsigned v) { return __hip_atomic_fetch_add(p, v, __ATOMIC_RELAXED, __HIP_MEMORY_SCOPE_AGENT); }
__device__ __forceinline__ unsigned xb_xcc_id() { return (unsigned)__builtin_amdgcn_s_getreg((3 << 11) | 20) & 0xFu; }
#define XB_SPIN(cond, bar) do { unsigned _sp = 0; while (cond) { __builtin_amdgcn_s_sleep(1); \
    if ((++_sp & 255u) == 0u) { if (xb_ld(&(bar)[XB_TMO])) break; if (_sp > XB_SPIN_CAP) { atomicAdd(&(bar)[XB_TMO], 1u); break; } } } } while (0)
struct XcdBarrier { unsigned* bar; unsigned x; volatile LAS unsigned* st; };
__device__ __forceinline__ XcdBarrier xcd_barrier_post(unsigned* bar, volatile LAS unsigned* st) {
    XcdBarrier b; b.bar = bar; b.x = xb_xcc_id(); b.st = st;
    if (threadIdx.x == 0) (void)xb_add(&bar[XB_XCNT(b.x)], 1u);
    return b;
}
__device__ __forceinline__ void xcd_barrier_complete(unsigned* bar, unsigned x, unsigned& nloc, unsigned& nx) {
    const unsigned G = gridDim.x * gridDim.y * gridDim.z;
    unsigned sum, cnt, mine, sp = 0u;
    for (;;) {
        sum = 0u; cnt = 0u; mine = 0u;
#pragma nounroll
        for (unsigned j = 0; j < 16; ++j) { const unsigned c = xb_ld(&bar[XB_XCNT(j)]); sum += c; cnt += (c > 0u) ? 1u : 0u; mine = (j == x) ? c : mine; }
        if (sum == G) break;
        __builtin_amdgcn_s_sleep(1);
        if ((++sp & 255u) == 0u) { if (xb_ld(&bar[XB_TMO])) break; if (sp > XB_SPIN_CAP) { atomicAdd(&bar[XB_TMO], 1u); break; } }
    }
    nloc = mine > 0u ? mine : 1u; nx = cnt > 0u ? cnt : 1u;
}
__device__ __forceinline__ void xcd_barrier(const XcdBarrier& b) {
    asm volatile("s_waitcnt vmcnt(0)" ::: "memory");
    __syncthreads();
    if (threadIdx.x == 0) {
        unsigned* bar = b.bar;
        __builtin_amdgcn_s_waitcnt(0);
        unsigned nloc = b.st[0], nx = b.st[1];
        if (nloc == 0u) { xcd_barrier_complete(bar, b.x, nloc, nx); b.st[0] = nloc; b.st[1] = nx; }
        const unsigned old = xb_add(&bar[XB_XSUB(b.x)], 1u);
        const unsigned gen = old / nloc;
        if (old + 1u == (gen + 1u) * nloc) {
            __builtin_amdgcn_fence(__ATOMIC_RELEASE, "agent");
            asm volatile("s_waitcnt vmcnt(0)" ::: "memory");
            const unsigned og = xb_add(&bar[XB_TOP], 1u);
            const unsigned tg = og / nx;
            if (og + 1u == (tg + 1u) * nx) xb_add(&bar[XB_TOPGEN], 1u);
            else XB_SPIN(xb_ld(&bar[XB_TOPGEN]) == tg, bar);
            __builtin_amdgcn_fence(__ATOMIC_ACQUIRE, "agent");
            xb_add(&bar[XB_XGEN(b.x)], 1u);
            asm volatile("s_waitcnt vmcnt(0)" ::: "memory");
        } else {
            XB_SPIN(xb_ld(&bar[XB_XGEN(b.x)]) == gen, bar);
            __builtin_amdgcn_fence(__ATOMIC_ACQUIRE, "agent");
            asm volatile("s_waitcnt vmcnt(0)" ::: "memory");
        }
    }
    __syncthreads();
}

struct Args { const float* in[23]; float* out; unsigned char* ws; int ph_lo, ph_hi; };
static_assert(sizeof(Args) == 23 * 8 + 8 + 8 + 8, "Args has no padding");
typedef const __attribute__((address_space(4))) Args* KArgs;
__device__ __forceinline__ KArgs kargs() { KArgs p = (KArgs)__builtin_amdgcn_kernarg_segment_ptr(); asm volatile("" : "+s"(p)); return p; }

__device__ __forceinline__ void transpose_item(const float* src, int ldn, int k0, int n0, bf16_t* dst, int ldk, const float* kscale, const float* nscale, int lane, bool perm = false) {
    const int r4 = lane >> 4, q = lane & 15, rq = perm ? 32 * (q >> 2) + 8 * (q & 3) : 4 * q;
    f32x4 v[16];
    const float* sp = src + (size_t)(k0 + 16 * r4) * ldn + n0 + 4 * q;
#pragma unroll
    for (int i = 0; i < 16; ++i) v[i] = __builtin_nontemporal_load((const f32x4*)(sp + (size_t)i * ldn));
    f32x4 ns = (f32x4){1.f, 1.f, 1.f, 1.f}; if (nscale) ns = *(const f32x4*)(nscale + n0 + 4 * q);
    if (kscale) {
        const f32x4* kp = (const f32x4*)(kscale + k0 + 16 * r4);
#pragma unroll
        for (int g = 0; g < 4; ++g) { const f32x4 ks = kp[g];
#pragma unroll
            for (int j = 0; j < 4; ++j) v[4 * g + j] = v[4 * g + j] * ks[j]; }
    }
#pragma unroll
    for (int e = 0; e < 4; ++e) { u32x4 lo, hi;
#pragma unroll
        for (int w = 0; w < 4; ++w) { lo[w] = pk_bf16(v[2 * w][e] * ns[e], v[2 * w + 1][e] * ns[e]); hi[w] = pk_bf16(v[8 + 2 * w][e] * ns[e], v[9 + 2 * w][e] * ns[e]); }
        bf16_t* o = dst + (size_t)(rq + e) * ldk + k0 + 16 * r4; *(u32x4*)o = lo; *(u32x4*)(o + 8) = hi; }
}
__device__ __forceinline__ void transpose_item_f8(const float* src, int ldn, int k0, int n0, unsigned char* dst, int ldk, const float* kscale, float mul, int lane) {
    const int r4 = lane >> 4, q = lane & 15;
    f32x4 v[16];
    const float* sp = src + (size_t)(k0 + 16 * r4) * ldn + n0 + 4 * q;
#pragma unroll
    for (int i = 0; i < 16; ++i) v[i] = __builtin_nontemporal_load((const f32x4*)(sp + (size_t)i * ldn));
    {
        const f32x4* kp = (const f32x4*)(kscale + k0 + 16 * r4);
#pragma unroll
        for (int g = 0; g < 4; ++g) { f32x4 ks = (f32x4){mul, mul, mul, mul}; if (kscale) ks = kp[g] * mul;
#pragma unroll
            for (int j = 0; j < 4; ++j) v[4 * g + j] = v[4 * g + j] * ks[j]; }
    }
#pragma unroll
    for (int e = 0; e < 4; ++e) { u32x4 o;
#pragma unroll
        for (int w = 0; w < 4; ++w) o[w] = pk_fp8x4((f32x4){v[4 * w][e], v[4 * w + 1][e], v[4 * w + 2][e], v[4 * w + 3][e]});
        *(u32x4*)(dst + (size_t)(4 * q + e) * ldk + k0 + 16 * r4) = o; }
}
__device__ __forceinline__ int win_row(int n0) {
    const int seg = n0 >> 10, c = n0 & 1023;
    if (seg == 1 || seg == 2) return 1024 + (c >> 7) * 256 + (seg == 2 ? 128 : 0) + (c & 127);
    if (seg == 3 || seg == 4) return 3072 + (c >> 7) * 256 + (seg == 4 ? 128 : 0) + (c & 127);
    return n0;
}
__device__ __forceinline__ int pair_row(int f, int second) { return (f >> 7) * 256 + (second ? 128 : 0) + (f & 127); }

__device__ __forceinline__ void prologue_phase(KArgs a, LAS unsigned char* lds, int wid, int lane) {
    asm volatile("" : "+v"(lane));
    const int gw = blockIdx.x * 8 + wid, NGW = gridDim.x * 8;
    unsigned char* ws = a->ws;
    constexpr int I_WIN = 16 * 144, I_SQ = 16 * 16, I_PW = 16, I_D1 = 16 * 56, I_D2 = 56 * 16;
    constexpr int NIT = 2 * I_WIN + 8 * I_SQ + 8 * I_PW + 2 * I_D1 + I_D2;
    for (int it = gw; it < NIT; it += NGW) {
        int r = it;
        if (r < 2 * I_WIN) { const int L = r / I_WIN; r -= L * I_WIN; const int kb = r / 144, nb = r % 144, n0 = 64 * nb;
            if (n0 >= 6144 || (n0 >= 3072 && n0 < 5120)) transpose_item_f8(a->in[2] + (size_t)L * D * INC, INC, 64 * kb, n0, ws + WS_WG8 + (size_t)L * 5 * MiB + (size_t)(n0 >= 6144 ? 2048 + (n0 - 6144) : win_row(n0) - 3072) * D, D, a->in[1] + L * D, F8_W13_MUL, lane);
            else { const int ty = n0 < 3072 ? n0 >> 10 : 3, T = (n0 & 1023) >> 6;
                transpose_item(a->in[2] + (size_t)L * D * INC, INC, 64 * kb, n0, (bf16_t*)(ws + WS_W0 + W0_WIN + (size_t)L * 18 * MiB) + (size_t)(256 * T + 128 * (ty >> 1) + 4 * (ty & 1)) * D, D, a->in[1] + L * D, nullptr, lane, true); }
            continue; }
        r -= 2 * I_WIN;
        if (r < 8 * I_SQ) { const int j = r / I_SQ; r -= j * I_SQ; const int L = j >> 2, w = j & 3, kb = r / 16, nb = r % 16, n0 = 64 * nb;
            bf16_t* dst = w < 3 ? (bf16_t*)(ws + WS_W0 + W0_WOUT + (size_t)(L * 3 + w) * 2 * MiB) : (bf16_t*)(ws + WS_W0 + W0_WO + (size_t)L * 2 * MiB);
            transpose_item(a->in[10 + w] + (size_t)L * D * D, D, 64 * kb, n0, dst + (size_t)n0 * D, D, nullptr, nullptr, lane); continue; }
        r -= 8 * I_SQ;
        if (r < 8 * I_PW) { const int j = r / I_PW; r -= j * I_PW; const int L = j >> 2, g = j & 3;
            const float* src = a->in[8] + (size_t)(L * 4 + g) * 65536 + (size_t)r * 16 * 256; const float* sc = a->in[9] + L * D + g * 256;
            bf16_t* dst = (bf16_t*)(ws + WS_W0 + W0_POOL + (size_t)L * 512 * 1024) + (size_t)g * 65536 + (size_t)r * 16 * 256; const f32x4 s4 = *(const f32x4*)(sc + 4 * lane);
#pragma unroll
            for (int i = 0; i < 16; ++i) { const f32x4 v = *(const f32x4*)(src + i * 256 + 4 * lane) * s4; u32x2 w; w.x = pk_bf16(v[0], v[1]); w.y = pk_bf16(v[2], v[3]); *(u32x2*)(dst + i * 256 + 4 * lane) = w; }
            continue; }
        r -= 8 * I_PW;
        if (r < 2 * I_D1) { const int w = r / I_D1; r -= w * I_D1; const int kb = r / 56, nb = r % 56, n0 = 64 * nb;
            transpose_item(a->in[15 + w], DFF, 64 * kb, n0, (bf16_t*)(ws + WS_W0 + W0_D13) + (size_t)pair_row(n0, w) * D, D, a->in[14], nullptr, lane); continue; }
        r -= 2 * I_D1;
        { const int kb = r / 16, nb = r % 16, n0 = 64 * nb;
            transpose_item(a->in[17], D, 64 * kb, n0, (bf16_t*)(ws + WS_W0 + W0_D2) + (size_t)n0 * DFF, DFF, nullptr, nullptr, lane); }
    }
    const float* x = a->in[0]; bf16_t* xb = (bf16_t*)(ws + WS_XB); f32x4* ss0 = (f32x4*)(ws + WS_SS); unsigned char* x8 = ws + WS_X8;
    for (int m = gw; m < M; m += NGW) {
        const f32x4* xr = (const f32x4*)(x + (size_t)m * D) + lane; u32x2* o = (u32x2*)(xb + (size_t)m * D) + lane; float s = 0.f;
#pragma unroll
        for (int j = 0; j < 4; ++j) { const f32x4 v = xr[64 * j]; s += (v[0] * v[0] + v[1] * v[1]) + (v[2] * v[2] + v[3] * v[3]); u32x2 w; w.x = pk_bf16(v[0], v[1]); w.y = pk_bf16(v[2], v[3]); o[64 * j] = w;
            *((unsigned*)(x8 + (size_t)m * D) + lane + 64 * j) = pk_fp8x4(v); }
        s = wave_sum(s); if (lane == 0) ss0[m] = (f32x4){s, 0.f, 0.f, 0.f};
    }
}

__device__ __forceinline__ void dma_block16(const bf16_t* src, LAS unsigned char* dst, int wid, int lane) {
#pragma unroll
    for (int k = 0; k < 4; ++k) { const int h = wid * 4 + k;
        __builtin_amdgcn_global_load_lds((const unsigned*)((const char*)src + h * 1024 + lane * 16), (LAS unsigned*)(dst + h * 1024), 16, 0, 0); }
}
__device__ __forceinline__ void zero_block16(LAS unsigned char* dst, int tid) {
#pragma unroll
    for (int k = 0; k < 4; ++k) *(LAS u32x4*)(dst + (size_t)(tid + 512 * k) * 16) = (u32x4){0u, 0u, 0u, 0u};
}
template <int I> __device__ __forceinline__ void conv31_pair(const LAS unsigned char* col, const unsigned (&wp)[31], f32x2 bias, f32x2 (&acc)[16]) {
    f32x2 x[46];
#pragma unroll
    for (int i = 0; i < 46; ++i) { const int r = i - 30, j = I + (r >> 4); const unsigned u = *(const LAS unsigned*)(col + ((j + 2) & 3) * 32768 + (r & 15) * 2048); x[i] = (f32x2){bf_lo(u), bf_hi(u)}; }
#pragma unroll
    for (int j = 0; j < 16; ++j) acc[j] = bias;
#pragma unroll
    for (int k = 0; k < 31; ++k) { const f32x2 wk = (f32x2){bf_lo(wp[k]), bf_hi(wp[k])};
#pragma unroll
        for (int j = 0; j < 16; ++j) acc[j] = __builtin_elementwise_fma(wk, x[j + k], acc[j]); }
}
template <int I, int CH> __device__ __forceinline__ void pool_ch(const LAS unsigned char* col, int g, int s0, float (&p)[16]) {
    float x[31], tv[16];
#pragma unroll
    for (int i = 0; i < 31; ++i) { const int r = i - 15, j = I + (r >> 4); const unsigned u = *(const LAS unsigned*)(col + ((j + 1) % 3) * 32768 + (r & 15) * 2048); x[i] = CH ? bf_hi(u) : bf_lo(u); }
#pragma unroll
    for (int j = 0; j < 16; ++j) tv[j] = x[15 + j];
#pragma unroll
    for (int i = 30; i >= 1; --i) x[i] += x[i - 1];
    if (g >= 1) {
#pragma unroll
        for (int i = 30; i >= 2; --i) x[i] += x[i - 2]; }
    if (g >= 2) {
#pragma unroll
        for (int i = 30; i >= 4; --i) x[i] += x[i - 4]; }
    if (g >= 3) {
#pragma unroll
        for (int i = 30; i >= 8; --i) x[i] += x[i - 8]; }
    const int w = 2 << g;
#pragma unroll
    for (int j = 0; j < 16; ++j) { const int cnt = min(s0 + j + 1, w); p[j] = x[15 + j] * (1.0f / (float)cnt) - tv[j]; }
}
struct ConvB { const bf16_t* GLU; __amdgpu_buffer_rsrc_t rVB; LAS unsigned char* lds; LAS float* red; LAS float* stat; f32x2 bb, gg, be; };
template <int I> __device__ __forceinline__ void convB_tile(const ConvB& c, unsigned (&wp)[31], int T0, int tid, int wid, int lane) {
    const int t0 = T0 + 16 * I; const LAS unsigned char* col = c.lds + 4 * tid;
#pragma unroll
    for (int k = 0; k < 31; ++k) asm volatile("" : "+v"(wp[k]));
    if (I < 3) dma_block16(c.GLU + (size_t)(t0 + 16) * D, c.lds + ((I + 3) & 3) * 32768, wid, lane);
    float a0[16], a1[16];
    { f32x2 ap[16]; conv31_pair<I>(col, wp, c.bb, ap);
#pragma unroll
      for (int j = 0; j < 16; ++j) { a0[j] = ap[j].x; a1[j] = ap[j].y; } }
    {
        float v[32];
#pragma unroll
        for (int j = 0; j < 16; ++j) { v[j] = a0[j] + a1[j]; v[16 + j] = a0[j] * a0[j] + a1[j] * a1[j]; }
#pragma unroll
        for (int i = 0; i < 16; ++i) { const bool b = lane & 32; const float send = b ? v[i] : v[i + 16], keep = b ? v[i + 16] : v[i]; v[i] = keep + __shfl_xor(send, 32); }
#pragma unroll
        for (int i = 0; i < 8; ++i) { const bool b = lane & 16; const float send = b ? v[i] : v[i + 8], keep = b ? v[i + 8] : v[i]; v[i] = keep + __shfl_xor(send, 16); }
#pragma unroll
        for (int i = 0; i < 4; ++i) { const bool b = lane & 8; const float send = b ? v[i] : v[i + 4], keep = b ? v[i + 4] : v[i]; v[i] = keep + __shfl_xor(send, 8); }
#pragma unroll
        for (int i = 0; i < 2; ++i) { const bool b = lane & 4; const float send = b ? v[i] : v[i + 2], keep = b ? v[i + 2] : v[i]; v[i] = keep + __shfl_xor(send, 4); }
        { const bool b = lane & 2; const float send = b ? v[0] : v[1], keep = b ? v[1] : v[0]; v[0] = keep + __shfl_xor(send, 2); }
        v[0] += __shfl_xor(v[0], 1);
        const int idx = ((lane >> 5) & 1) * 16 + ((lane >> 4) & 1) * 8 + ((lane >> 3) & 1) * 4 + ((lane >> 2) & 1) * 2 + ((lane >> 1) & 1);
        if (!(lane & 1)) c.red[wid * 32 + idx] = v[0];
    }
    __syncthreads();
    if (tid < 16) { float s = 0.f, q = 0.f;
#pragma unroll
        for (int w = 0; w < 8; ++w) { s += c.red[w * 32 + tid]; q += c.red[w * 32 + 16 + tid]; }
        const float mean = s * (1.0f / D), var = fmaxf(q * (1.0f / D) - mean * mean, 0.f);
        c.stat[2 * tid] = mean; c.stat[2 * tid + 1] = __builtin_amdgcn_rsqf(var + LN_EPS); }
    asm volatile("s_waitcnt vmcnt(0)" ::: "memory");
    __syncthreads();
#pragma unroll
    for (int j = 0; j < 16; ++j) { const float mean = c.stat[2 * j], rstd = c.stat[2 * j + 1];
        const float y0 = (a0[j] - mean) * rstd * c.gg.x + c.be.x, y1 = (a1[j] - mean) * rstd * c.gg.y + c.be.y;
        __builtin_amdgcn_raw_buffer_store_b32(pk_bf16(y0 * sigm(y0), y1 * sigm(y1)), c.rVB, 4 * tid, (t0 + j) * (D * 2), 0); }
}
struct ConvAC { const bf16_t* PU; __amdgpu_buffer_rsrc_t rPP; LAS unsigned char* lds; };
__device__ __forceinline__ void conv_phase(KArgs a, int layer, LAS unsigned char* lds, int tid, int wid, int lane) {
    asm volatile("" : "+v"(tid), "+v"(lane));
    unsigned char* ws = a->ws;
    const int G = gridDim.x;
    const int vcu = (G % 8 == 0) ? (int)(blockIdx.x % 8) * (G / 8) + (int)(blockIdx.x / 8) : (int)blockIdx.x;
    const int c2 = 2 * tid;
    {
        const float* cfw = a->in[4] + layer * 31 * D; const float* cfb = a->in[5] + layer * D; const float* lng = a->in[6] + layer * D; const float* lnb = a->in[7] + layer * D;
        ConvB c; c.GLU = (const bf16_t*)(ws + A_GLU); c.rVB = __builtin_amdgcn_make_buffer_rsrc((void*)(ws + A_VB), 0, 0x7fffffff, 0x00020000);
        c.lds = lds; c.red = (LAS float*)(lds + RED_OFF); c.stat = c.red + 256;
        unsigned wp[31];
#pragma unroll
        for (int k = 0; k < 31; ++k) { const f32x2 w = *(const f32x2*)(cfw + k * D + c2); wp[k] = pk_bf16(w.x, w.y); }
        c.bb = *(const f32x2*)(cfb + c2); c.gg = *(const f32x2*)(lng + c2); c.be = *(const f32x2*)(lnb + c2);
        asm volatile("" :: "v"(c.bb.x), "v"(c.bb.y), "v"(c.gg.x), "v"(c.gg.y), "v"(c.be.x), "v"(c.be.y));
        for (int rp2 = 0; rp2 < REPS2(21); ++rp2)
        for (int sup = vcu; sup < M / 64; sup += G) {
            const int T0 = sup * 64; const bool seq0 = (T0 & (SEQ - 1)) == 0;
            if (seq0) { zero_block16(lds, tid); zero_block16(lds + 32768, tid); } else { dma_block16(c.GLU + (size_t)(T0 - 32) * D, lds, wid, lane); dma_block16(c.GLU + (size_t)(T0 - 16) * D, lds + 32768, wid, lane); }
            dma_block16(c.GLU + (size_t)T0 * D, lds + 65536, wid, lane);
            asm volatile("s_waitcnt vmcnt(0)" ::: "memory");
            __syncthreads();
            convB_tile<0>(c, wp, T0, tid, wid, lane); convB_tile<1>(c, wp, T0, tid, wid, lane); convB_tile<2>(c, wp, T0, tid, wid, lane); convB_tile<3>(c, wp, T0, tid, wid, lane);
            __syncthreads();
        }
    }
    __syncthreads();
    if (blockIdx.x < M / 256) {
        int pm_ = blockIdx.x; asm volatile("" : "+s"(pm_));
        const int pm = pm_, T0 = pm * 256, s0 = T0 & (SEQ - 1); const bool seq0 = s0 == 0;
        const float* scw = a->in[3] + layer * 3 * D; const float* halo = (const float*)(ws + WS_HALO); bf16_t* YA = (bf16_t*)(ws + A_YA);
        ConvAC c; c.PU = (const bf16_t*)(ws + A_PU); c.lds = lds;
        c.rPP = __builtin_amdgcn_make_buffer_rsrc((void*)(ws + A_PP), 0, 0x7fffffff, 0x00020000);
        if (seq0) zero_block16(lds, tid); else dma_block16(c.PU + (size_t)(T0 - 16) * D, lds, wid, lane);
        dma_block16(c.PU + (size_t)T0 * D, lds + 32768, wid, lane);
        {   const f32x2 s0w = *(const f32x2*)(scw + c2), s1w = *(const f32x2*)(scw + D + c2), s2w = *(const f32x2*)(scw + 2 * D + c2);
            const f32x2 b0 = *(const f32x2*)(halo + (size_t)((0 * 64 + pm) * 2 + 0) * D + c2), b1 = *(const f32x2*)(halo + (size_t)((0 * 64 + pm) * 2 + 1) * D + c2);
            const f32x2 q0 = *(const f32x2*)(halo + (size_t)((1 * 64 + pm) * 2 + 0) * D + c2), q1 = *(const f32x2*)(halo + (size_t)((1 * 64 + pm) * 2 + 1) * D + c2);
            f32x2 pa = (f32x2){0.f, 0.f}, pb = pa;
            if (!seq0) { pa = *(const f32x2*)(halo + (size_t)((2 * 64 + pm - 1) * 2 + 0) * D + c2); pb = *(const f32x2*)(halo + (size_t)((2 * 64 + pm - 1) * 2 + 1) * D + c2); }
            const f32x2 y0 = b0 * (s0w * pa + s1w * pb + s2w * q0), y1 = b1 * (s0w * pb + s1w * q0 + s2w * q1);
            *(unsigned*)(YA + (size_t)T0 * D + c2) = pk_bf16(y0.x, y0.y); *(unsigned*)(YA + (size_t)(T0 + 1) * D + c2) = pk_bf16(y1.x, y1.y); }
        asm volatile("s_waitcnt vmcnt(0)" ::: "memory");
        __syncthreads();
        {
            const LAS unsigned char* col = lds + 4 * tid;
            float p0[16], p1[16];
            pool_ch<0, 0>(col, wid >> 1, s0, p0);
#pragma unroll
            for (int j = 0; j < 16; ++j) asm volatile("" : "+v"(p0[j]) :: "memory");
            pool_ch<0, 1>(col, wid >> 1, s0, p1);
#pragma unroll
            for (int j = 0; j < 16; ++j) __builtin_amdgcn_raw_buffer_store_b32(pk_bf16(p0[j], p1[j]), c.rPP, 4 * tid, (T0 + j) * (D * 2), 0);
        }
        __syncthreads();
    }
}

__device__ __forceinline__ void route_phase(KArgs a, LAS unsigned char* lds, int tid, int wid, int lane) {
    asm volatile("" : "+v"(tid), "+v"(lane));
    unsigned char* ws = a->ws;
    const bf16_t* X = (const bf16_t*)(ws + WS_XB); const float* gn = a->in[14] + D; const float* R = a->in[18];
    const f32x4* ss3 = (const f32x4*)(ws + WS_SS) + 3 * M;
    int* tope = (int*)(ws + WS_SMALL + SM_TOPE); f32x2* topp = (f32x2*)(ws + WS_SMALL + SM_TOPP); int* cntb = (int*)(ws + WS_CTL + CTL_CNT);
    LAS int* lcnt = (LAS int*)(lds + 98304);
    float wgt[2][8][8];
#pragma unroll
    for (int h = 0; h < 2; ++h)
#pragma unroll
        for (int i = 0; i < 8; ++i) { const int k = 8 * lane + 512 * h + i; const float g = gn[k]; const f32x4 r0 = *(const f32x4*)(R + k * 8), r1 = *(const f32x4*)(R + k * 8 + 4);
#pragma unroll
            for (int e = 0; e < 4; ++e) { wgt[h][i][e] = g * r0[e]; wgt[h][i][4 + e] = g * r1[e]; } }
    for (int vb = blockIdx.x; vb < 256; vb += gridDim.x) {
        if (tid < 8) lcnt[tid] = 0;
        __syncthreads();
        for (int i8 = 0; i8 < 8; ++i8) {
            const int t = vb * 64 + wid * 8 + i8;
            float lg[8];
#pragma unroll
            for (int e = 0; e < 8; ++e) lg[e] = 0.f;
#pragma unroll
            for (int h = 0; h < 2; ++h) { f32x4 v0, v1; pg8::unpack8(*(const u32x4*)(X + (size_t)t * D + 512 * h + 8 * lane), v0, v1);
#pragma unroll
                for (int i = 0; i < 4; ++i)
#pragma unroll
                    for (int e = 0; e < 8; ++e) { lg[e] = fmaf(v0[i], wgt[h][i][e], lg[e]); lg[e] = fmaf(v1[i], wgt[h][4 + i][e], lg[e]); } }
#pragma unroll
            for (int e = 0; e < 8; ++e) lg[e] = wave_sum(lg[e]);
            const f32x4 sp = ss3[t]; const float rstd = __builtin_amdgcn_rsqf(((sp[0] + sp[1]) + (sp[2] + sp[3])) * (1.0f / D) + RMS_EPS);
            int e1 = 0; float v1 = lg[0];
#pragma unroll
            for (int e = 1; e < 8; ++e) if (lg[e] > v1) { v1 = lg[e]; e1 = e; }
            int e2 = e1 == 0 ? 1 : 0; float v2 = -__builtin_inff();
#pragma unroll
            for (int e = 0; e < 8; ++e) if (e != e1 && lg[e] > v2) { v2 = lg[e]; e2 = e; }
            const float ex = __expf((v2 - v1) * rstd), p1 = 1.0f / (1.0f + ex), p2 = ex * p1;
            if (lane == 0) { tope[t] = e1 | (e2 << 8); topp[t] = (f32x2){p1, p2}; atomicAdd((int*)&lcnt[e1], 1); atomicAdd((int*)&lcnt[e2], 1); }
        }
        __syncthreads();
        if (tid < 8) cntb[vb * 8 + tid] = lcnt[tid];
        __syncthreads();
    }
    const int gw = blockIdx.x * 8 + wid, NGW = gridDim.x * 8;
    constexpr int I_1 = 16 * 56, I_13 = 2 * I_1, I_2 = 56 * 16;
    unsigned char* w13 = ws + WS_WMOE; unsigned char* w2t = ws + WS_WMOE + WMOE_W2;
    for (int it = gw; it < NE * (I_13 + I_2); it += NGW) {
        int r = it;
        if (r < NE * I_13) { const int e = r / I_13; r -= e * I_13; const int w = r / I_1; r -= w * I_1; const int kb = r / 56, nb = r % 56, n0 = 64 * nb;
            transpose_item_f8(a->in[19 + w] + (size_t)e * D * DFF, DFF, 64 * kb, n0, w13 + (size_t)e * (2 * DFF) * D + (size_t)pair_row(n0, w) * D, D, gn, F8_W13_MUL, lane); continue; }
        r -= NE * I_13;
        { const int e = r / I_2; r -= e * I_2; const int kb = r / 16, nb = r % 16, n0 = 64 * nb;
            transpose_item_f8(a->in[21] + (size_t)e * DFF * D, D, 64 * kb, n0, w2t + (size_t)e * D * DFF + (size_t)n0 * DFF, DFF, nullptr, F8_W2_MUL, lane); }
    }
}

__device__ __forceinline__ void scatter_phase(KArgs a, LAS unsigned char* lds, int tid, int wid, int lane) {
    asm volatile("" : "+v"(tid), "+v"(lane));
    unsigned char* ws = a->ws;
    const int* tope = (const int*)(ws + WS_SMALL + SM_TOPE); int* tslot = (int*)(ws + WS_SMALL + SM_TSLOT); float* ssperm = (float*)(ws + WS_SMALL + SM_SSPERM); int* meta = (int*)(ws + WS_SMALL + SM_META);
    const int* cntb = (const int*)(ws + WS_CTL + CTL_CNT); const f32x4* ss3 = (const f32x4*)(ws + WS_SS) + 3 * M;
    const bf16_t* X = (const bf16_t*)(ws + WS_XB); unsigned char* AP = ws + WS_APERM;
    LAS int* lc = (LAS int*)lds;
    LAS int* lbase = lc + 2048;
    LAS int* lslot = lc + 2064;
    LAS int* ltot = lc + 2200;
    for (int i = tid; i < 2048; i += 512) lc[i] = __hip_atomic_load(cntb + i, __ATOMIC_RELAXED, __HIP_MEMORY_SCOPE_AGENT);
    __syncthreads();
    for (int vb = blockIdx.x; vb < 256; vb += gridDim.x) {
        if (tid < 8) { int tot = 0, pre = 0;
#pragma unroll 8
            for (int b = 0; b < 256; ++b) { const int v = lc[b * 8 + tid]; tot += v; pre += (b < vb) ? v : 0; }
            ltot[tid] = tot; lbase[tid] = pre; }
        __syncthreads();
        if (tid == 0) { int off = 0;
            for (int e = 0; e < 8; ++e) { lbase[e] += off; if (vb == 0) meta[e] = off >> 8; off += (ltot[e] + 255) & ~255; }
            if (vb == 0) meta[8] = off >> 8; }
        __syncthreads();
        if (wid == 0) {
            const int t = vb * 64 + lane; const int te = tope[t]; const int e1 = te & 0xff, e2 = (te >> 8) & 0xff;
            int s1 = 0, s2 = 0;
#pragma unroll
            for (int k = 0; k < 2; ++k) { const int ek = k ? e2 : e1; int sk = 0;
#pragma unroll
                for (int e = 0; e < 8; ++e) { const unsigned long long mask = __ballot(ek == e); const int base = lbase[e]; LDS_WAIT();
                    const int rank = __popcll(mask & ((1ull << lane) - 1ull)); if (ek == e) sk = base + rank;
                    if (lane == 0) lbase[e] = base + __popcll(mask); LDS_WAIT(); }
                if (k) s2 = sk; else s1 = sk; }
            *(int2*)(tslot + 2 * t) = make_int2(s1, s2); lslot[lane] = s1; lslot[64 + lane] = s2;
        }
        __syncthreads();
        {
            u32x4 xv[8][2]; f32x4 sp[8];
#pragma unroll
            for (int i = 0; i < 8; ++i) { const int t = vb * 64 + wid + 8 * i; const u32x4* src = (const u32x4*)(X + (size_t)t * D) + 2 * lane; xv[i][0] = src[0]; xv[i][1] = src[1]; sp[i] = ss3[t]; }
#pragma unroll
            for (int i = 0; i < 8; ++i) { const int r = wid + 8 * i, s1 = lslot[r], s2 = lslot[64 + r];
                const float rstd = __builtin_amdgcn_rsqf(((sp[i][0] + sp[i][1]) + (sp[i][2] + sp[i][3])) * (1.0f / D) + RMS_EPS);
                f32x4 v0, v1, v2, v3; pg8::unpack8(xv[i][0], v0, v1); pg8::unpack8(xv[i][1], v2, v3);
                const u32x4 q = (u32x4){pk_fp8x4(v0 * rstd), pk_fp8x4(v1 * rstd), pk_fp8x4(v2 * rstd), pk_fp8x4(v3 * rstd)};
                *((u32x4*)(AP + (size_t)s1 * D) + lane) = q; *((u32x4*)(AP + (size_t)s2 * D) + lane) = q; } }
        __syncthreads();
    }
}

__device__ __forceinline__ void combine_phase(KArgs a, LAS unsigned char* lds, int tid, int wid, int lane) {
    asm volatile("" : "+v"(lane), "+v"(tid));
    unsigned char* ws = a->ws;
    LAS int* tmap = (LAS int*)lds; const bf16_t* YP = (const bf16_t*)(ws + WS_YP);
    int split;
    { const int nMraw = __builtin_amdgcn_readfirstlane(__hip_atomic_load((const int*)(ws + WS_SMALL + SM_META) + 8, __ATOMIC_RELAXED, __HIP_MEMORY_SCOPE_AGENT)); const int nM = nMraw > MAXSLOT / 256 ? MAXSLOT / 256 : nMraw;
      const int G = (int)gridDim.x, nU = 4 * nM, R = nU / G, tail = nU - R * G; split = (tail > 0 && pg8::MOE2_SPL * tail <= G) ? 1 : 0;
      for (int i = tid; i < 4 * (MAXSLOT / 256); i += 512) tmap[i] = -1;
      __syncthreads();
      if (split && tid < tail) { int pm, pn; if (pg8::tile_of(R * G + tid, nM, 4, pm, pn, 4)) tmap[4 * pm + pn] = tid; }
      __syncthreads(); }
    const bf16_t* X = (const bf16_t*)(ws + WS_XB); const unsigned char* Y = ws + WS_Y; const int* tslot = (const int*)(ws + WS_SMALL + SM_TSLOT); const f32x2* topp = (const f32x2*)(ws + WS_SMALL + SM_TOPP);
    const float* gf = a->in[22]; float* out = a->out;
    const int gw = blockIdx.x * 8 + wid, NGW = gridDim.x * 8;
    f32x4 gv[4];
#pragma unroll
    for (int h = 0; h < 2; ++h) { gv[2 * h] = *(const f32x4*)(gf + 512 * h + 8 * lane); gv[2 * h + 1] = *(const f32x4*)(gf + 512 * h + 8 * lane + 4); }
    for (int tb = gw; tb < M; tb += 4 * NGW) {
        int2 sl[4]; f32x2 p[4];
#pragma unroll
        for (int i = 0; i < 4; ++i) { const int t = min(tb + i * NGW, M - 1); sl[i] = *(const int2*)(tslot + 2 * t); p[i] = topp[t]; }
        u32x4 xr[4][2]; u32x2 ya[4][2], yb[4][2];
#pragma unroll
        for (int i = 0; i < 4; ++i) { const int t = min(tb + i * NGW, M - 1);
#pragma unroll
            for (int h = 0; h < 2; ++h) { const int col = 512 * h + 8 * lane;
                xr[i][h] = *(const u32x4*)(X + (size_t)t * D + col); ya[i][h] = *(const u32x2*)(Y + (size_t)sl[i].x * D + col); yb[i][h] = *(const u32x2*)(Y + (size_t)sl[i].y * D + col); } }
#pragma unroll
        for (int i = 0; i < 4; ++i) { const int t = tb + i * NGW; if (t < M) {
            f32x4 v[4]; float s = 0.f;
#pragma unroll
            for (int h = 0; h < 2; ++h) { f32x4 x0, x1; pg8::unpack8(xr[i][h], x0, x1); f32x4 a0 = pg8::un_fp8x4(ya[i][h].x) * (1.0f / F8_Y_MUL), a1 = pg8::un_fp8x4(ya[i][h].y) * (1.0f / F8_Y_MUL), b0 = pg8::un_fp8x4(yb[i][h].x) * (1.0f / F8_Y_MUL), b1 = pg8::un_fp8x4(yb[i][h].y) * (1.0f / F8_Y_MUL);
                if (split) { const int pn = 2 * h + (lane >> 5), cl = 8 * (lane & 31);
                    const int ka = tmap[4 * (sl[i].x >> 8) + pn], kb = tmap[4 * (sl[i].y >> 8) + pn];
                    if (ka >= 0) { a0 = (f32x4){0.f, 0.f, 0.f, 0.f}; a1 = a0;
                        for (int p = 0; p < pg8::MOE2_SPL; ++p) { f32x4 t0, t1; pg8::unpack8(*(const u32x4*)(YP + (size_t)(ka * pg8::MOE2_SPL + p) * 65536 + (size_t)(sl[i].x & 255) * 256 + cl), t0, t1); a0 += t0; a1 += t1; } }
                    if (kb >= 0) { b0 = (f32x4){0.f, 0.f, 0.f, 0.f}; b1 = b0;
                        for (int p = 0; p < pg8::MOE2_SPL; ++p) { f32x4 t0, t1; pg8::unpack8(*(const u32x4*)(YP + (size_t)(kb * pg8::MOE2_SPL + p) * 65536 + (size_t)(sl[i].y & 255) * 256 + cl), t0, t1); b0 += t0; b1 += t1; } } }
                v[2 * h] = x0 + a0 * p[i].x + b0 * p[i].y; v[2 * h + 1] = x1 + a1 * p[i].x + b1 * p[i].y; }
#pragma unroll
            for (int k = 0; k < 4; ++k) s += (v[k][0] * v[k][0] + v[k][1] * v[k][1]) + (v[k][2] * v[k][2] + v[k][3] * v[k][3]);
            const float rstd = __builtin_amdgcn_rsqf(wave_sum(s) * (1.0f / D) + RMS_EPS);
#pragma unroll
            for (int h = 0; h < 2; ++h) { const int col = 512 * h + 8 * lane;
                *(f32x4*)(out + (size_t)t * D + col) = v[2 * h] * rstd * gv[2 * h]; *(f32x4*)(out + (size_t)t * D + col + 4) = v[2 * h + 1] * rstd * gv[2 * h + 1]; } } }
    }
}

#ifndef WGM_INPROJ
#define WGM_INPROJ 4
#endif
#ifndef WGM_FFN1
#define WGM_FFN1 4
#endif
#ifndef WGM_MOE1
#define WGM_MOE1 4
#endif
constexpr int NPH = 18;
#ifndef MK_PH_MASK
#define MK_PH_MASK 0xFFFFFFFFu
#endif
#define PHON(bit) ((((MK_PH_MASK) >> (bit)) & 1u) != 0u)


__device__ __forceinline__ void ph_inproj(KArgs a, int layer, LAS unsigned char* lds) {
    unsigned char* ws = a->ws;
    {
        pg8::Gemm g{2 * D, 2 * D, 2 * D, 0, 0}; pg8::PlainSched S{M / 256, 16, (int)gridDim.x, (int)blockIdx.x, (const char*)(ws + WS_XB), (const char*)(ws + WS_W0 + W0_WIN + (size_t)layer * 18 * MiB), (size_t)256 * D * 2, (size_t)256 * D * 2, WGM_INPROJ, 1 << 30, 0};
        pg8::EpiSc E{(bf16_t*)(ws + A_YA), (bf16_t*)(ws + A_PP), (bf16_t*)(ws + A_PU), (const f32x4*)(ws + WS_SS) + (size_t)(layer * 2) * M, a->in[3] + layer * 3 * D, (float*)(ws + WS_HALO), (LAS float*)(lds + RED_OFF), (LAS float*)(lds + POOLX_OFF)};
        pg8::gemm_phase(lds, g, S, E);
    }
    __syncthreads();
    {
        pg8::Gemm g{D, D, D, F8_ONE, F8_W13_SC}; pg8::PlainSched S{M / 256, 20, (int)gridDim.x, (int)blockIdx.x, (const char*)(ws + WS_X8), (const char*)(ws + WS_WG8 + (size_t)layer * 5 * MiB), (size_t)256 * D, (size_t)256 * D, WGM_INPROJ, 1 << 30, 0};
        pg8::EpiProj E{(bf16_t*)(ws + A_GLU), (bf16_t*)(ws + A_GATES), (const f32x4*)(ws + WS_SS) + (size_t)(layer * 2) * M};
        pg8::gemm_phase<pg8::EpiProj, pg8::PlainSched, true>(lds, g, S, E);
    }
}
__device__ __forceinline__ void ph_fold(KArgs a, LAS unsigned char* lds) {
    unsigned char* ws = a->ws;
    pg8::Gemm g{512, 2 * D, 512, 0, 0}; pg8::FoldSched S{(int)gridDim.x, (int)blockIdx.x, (const char*)(ws + WS_W0 + W0_WOUT + 2 * 2 * MiB), (const char*)(ws + WS_W0 + W0_POOL)};
    pg8::EpiPlain E{(bf16_t*)(ws + WS_WC), D, (size_t)D * D};
    pg8::gemm_phase(lds, g, S, E);
}
__device__ __forceinline__ void ph_merge(KArgs a, int layer, LAS unsigned char* lds) {
    unsigned char* ws = a->ws;
    pg8::Gemm g{2 * D, 2 * D, 2 * D, 0, 0}; pg8::MergeSched S{(int)gridDim.x, (int)blockIdx.x, (const char*)(ws + A_YA), (const char*)(ws + WS_W0 + W0_WOUT + (size_t)(layer * 3) * 2 * MiB), (const char*)(ws + WS_WC + (size_t)layer * 2 * MiB), (size_t)32 * MiB, (size_t)2 * MiB};
    pg8::EpiMerge E{(const bf16_t*)(ws + A_GATES), (bf16_t*)(ws + A_MERGED)};
    pg8::gemm_phase(lds, g, S, E);
}
__device__ __forceinline__ void ph_wo(KArgs a, int layer, LAS unsigned char* lds) {
    unsigned char* ws = a->ws;
    pg8::Gemm g{2 * D, 2 * D, 2 * D, 0, 0}; pg8::PlainSched S{M / 256, D / 256, (int)gridDim.x, (int)blockIdx.x, (const char*)(ws + A_MERGED), (const char*)(ws + WS_W0 + W0_WO + (size_t)layer * 2 * MiB), (size_t)256 * D * 2, (size_t)256 * D * 2, 4, 1 << 30, 0};
    pg8::EpiResid E{layer == 0 ? a->in[0] : (const float*)nullptr, (bf16_t*)(ws + WS_XB), (float*)(ws + WS_SS) + (size_t)(layer * 2 + 1) * M * 4, (LAS float*)(lds + RED_OFF), nullptr};
    pg8::gemm_phase(lds, g, S, E);
}
__device__ __forceinline__ void ph_ffn1(KArgs a, LAS unsigned char* lds) {
    unsigned char* ws = a->ws;
    pg8::Gemm g{2 * D, 2 * D, 2 * D, 0, 0}; pg8::PlainSched S{M / 256, 2 * DFF / 256, (int)gridDim.x, (int)blockIdx.x, (const char*)(ws + WS_XB), (const char*)(ws + WS_W0 + W0_D13), (size_t)256 * D * 2, (size_t)256 * D * 2, WGM_FFN1, 1 << 30, 0};
    pg8::EpiSwiGLU<true, false> E{(bf16_t*)(ws + A_FFN), DFF, (const float*)(ws + WS_SS) + (size_t)1 * M * 4};
    pg8::gemm_phase(lds, g, S, E);
}
__device__ __forceinline__ void ph_ffn2(KArgs a, LAS unsigned char* lds) {
    unsigned char* ws = a->ws;
    pg8::Gemm g{2 * DFF, 2 * DFF, 2 * DFF, 0, 0}; pg8::PlainSched S{M / 256, D / 256, (int)gridDim.x, (int)blockIdx.x, (const char*)(ws + A_FFN), (const char*)(ws + WS_W0 + W0_D2), (size_t)256 * DFF * 2, (size_t)256 * DFF * 2, 4, 1 << 30, 0};
    pg8::EpiResid E{(const float*)nullptr, (bf16_t*)(ws + WS_XB), (float*)(ws + WS_SS) + (size_t)2 * M * 4, (LAS float*)(lds + RED_OFF), ws + WS_X8};
    pg8::gemm_phase(lds, g, S, E);
}
__device__ __forceinline__ void ph_moe(KArgs a, int which, LAS unsigned char* lds) {
    unsigned char* ws = a->ws;
    const int* meta = (const int*)(ws + WS_SMALL + SM_META); int o[9];
#pragma unroll
    for (int e = 0; e < 9; ++e) o[e] = __builtin_amdgcn_readfirstlane(__hip_atomic_load(meta + e, __ATOMIC_RELAXED, __HIP_MEMORY_SCOPE_AGENT));
    const int nM = o[8] > MAXSLOT / 256 ? MAXSLOT / 256 : o[8];
    if (which == 0) {
        pg8::Gemm g{D, D, D, F8_ONE, F8_W13_SC}; pg8::GroupSched S{nM, 2 * DFF / 256, (int)gridDim.x, (int)blockIdx.x, o[1], o[2], o[3], o[4], o[5], o[6], o[7], (const char*)(ws + WS_APERM), (const char*)(ws + WS_WMOE), (size_t)256 * D, (size_t)256 * D, (size_t)2 * DFF * D, WGM_MOE1};
        pg8::EpiSwiGLU<false, true> E{(bf16_t*)(ws + WS_ACTP), DFF, nullptr};
        pg8::gemm_phase<pg8::EpiSwiGLU<false, true>, pg8::GroupSched, true>(lds, g, S, E);
    } else {
        const int G = (int)gridDim.x, nU = 4 * nM, R = nU / G, tail = nU - R * G, split = (tail > 0 && pg8::MOE2_SPL * tail <= G) ? 1 : 0;
        pg8::Gemm g{DFF, DFF, DFF, F8_ACT_SC, F8_W2_SC}; pg8::Moe2Sched S{nM, G, (int)blockIdx.x, R, tail, split, o[1], o[2], o[3], o[4], o[5], o[6], o[7], (const char*)(ws + WS_ACTP), (const char*)(ws + WS_WMOE + WMOE_W2), (size_t)256 * DFF, (size_t)256 * DFF, (size_t)D * DFF};
        pg8::EpiMoe2 E{ws + WS_Y, (bf16_t*)(ws + WS_YP)};
        pg8::gemm_phase<pg8::EpiMoe2, pg8::Moe2Sched, true>(lds, g, S, E);
    }
}

__global__ void __launch_bounds__(512, 2) fwd(Args unused_args_read_through_kargs) {
    extern __shared__ __attribute__((aligned(16))) unsigned char lds_raw[];
    LAS unsigned char* lds = (LAS unsigned char*)lds_raw;
    volatile LAS unsigned* MISC = (volatile LAS unsigned*)(lds + MISC_OFF);
    const int tid = threadIdx.x, lane = tid & 63, wid = __builtin_amdgcn_readfirstlane(tid >> 6);
    if (tid < 64) MISC[tid] = 0u;
    __syncthreads();
    int lo, hi; XcdBarrier bar;
    { KArgs a = kargs(); lo = a->ph_lo; hi = a->ph_hi; unsigned* bw = (unsigned*)(a->ws + WS_CTL + CTL_BAR); bar.bar = bw; bar.x = 0; bar.st = nullptr; if (hi - lo > 1) bar = xcd_barrier_post(bw, MISC + 8); }
#define IN(k) (lo <= (k) && (k) < hi)
#define SEAM(k) do { if (IN(k) && IN((k) + 1)) xcd_barrier(bar); } while (0)

    if (PHON(0) && IN(0)) { for (int rp = 0; rp < REPS(0); ++rp) { prologue_phase(kargs(), lds, wid, lane); __syncthreads(); } } SEAM(0);
#pragma nounroll
    for (int layer = 0; layer < 2; ++layer) {
        const int pb = 1 + 7 * layer;
        if (PHON(1) && IN(pb + 0)) { for (int rp = 0; rp < REPS(1); ++rp) { if (layer == 0) { ph_fold(kargs(), lds); __syncthreads(); } ph_inproj(kargs(), layer, lds); __syncthreads(); } } SEAM(pb + 0);
        if (PHON(2) && IN(pb + 1)) { for (int rp = 0; rp < REPS(2); ++rp) { conv_phase(kargs(), layer, lds, tid, wid, lane); __syncthreads(); } } SEAM(pb + 1);
        if (PHON(4) && IN(pb + 3)) { for (int rp = 0; rp < REPS(4); ++rp) { ph_merge(kargs(), layer, lds); __syncthreads(); } } SEAM(pb + 3);
        if (PHON(5) && IN(pb + 4)) { for (int rp = 0; rp < (layer == 0 ? REPS(5) : 1); ++rp) { ph_wo(kargs(), layer, lds); __syncthreads(); } } SEAM(pb + 4);
        if (layer == 0) {
            if (PHON(6) && IN(6)) { for (int rp = 0; rp < REPS(6); ++rp) { ph_ffn1(kargs(), lds); __syncthreads(); } } SEAM(6);
            if (PHON(7) && IN(7)) { ph_ffn2(kargs(), lds); } SEAM(7);
        }
    }
    if (PHON(13) && IN(13)) { for (int rp = 0; rp < REPS(13); ++rp) { route_phase(kargs(), lds, tid, wid, lane); __syncthreads(); } } SEAM(13);
    if (PHON(14) && IN(14)) { for (int rp = 0; rp < REPS(14); ++rp) { scatter_phase(kargs(), lds, tid, wid, lane); __syncthreads(); } } SEAM(14);
    if (PHON(15) && IN(15)) { for (int rp = 0; rp < REPS(15); ++rp) { ph_moe(kargs(), 0, lds); __syncthreads(); } } SEAM(15);
    if (PHON(16) && IN(16)) { for (int rp = 0; rp < REPS(16); ++rp) { ph_moe(kargs(), 1, lds); __syncthreads(); } } SEAM(16);
    if (PHON(17) && IN(17)) { for (int rp = 0; rp < REPS(17); ++rp) { combine_phase(kargs(), lds, tid, wid, lane); __syncthreads(); } }
#undef IN
#undef SEAM
}

extern "C" void kernel_launch(void* const* d_in, const int* in_sizes, int n_in, void* d_out, int out_size, void* d_ws, size_t ws_size, hipStream_t stream) {
    static int grid = 0;
    if (grid == 0) {
        if (n_in != 23 || in_sizes[0] != M * D || out_size != M * D || ws_size < WS_END) { fprintf(stderr, "kernel_launch: unexpected shapes: n_in %d in0 %d out %d ws %zu (need %zu); nothing launched\n", n_in, n_in > 0 ? in_sizes[0] : -1, out_size, ws_size, (size_t)WS_END); grid = -1; return; }
        int dev = 0, cus = 0, per_cu = 0;
        if (hipGetDevice(&dev) != hipSuccess || hipDeviceGetAttribute(&cus, hipDeviceAttributeMultiprocessorCount, dev) != hipSuccess) { fprintf(stderr, "kernel_launch: device query failed\n"); grid = -1; return; }
        if (hipFuncSetAttribute((const void*)fwd, hipFuncAttributeMaxDynamicSharedMemorySize, LDS_BYTES) != hipSuccess) { fprintf(stderr, "kernel_launch: hipFuncSetAttribute failed\n"); grid = -1; return; }
        if (hipOccupancyMaxActiveBlocksPerMultiprocessor(&per_cu, (const void*)fwd, 512, LDS_BYTES) != hipSuccess || per_cu < 1) fprintf(stderr, "kernel_launch: note: occupancy query reports %d workgroups per CU\n", per_cu);
        (void)hipGetLastError();
        grid = cus;
    }
    if (grid < 0) return;
    if (hipMemsetAsync((char*)d_ws + WS_CTL, 0, CTL_BYTES, stream) != hipSuccess) { fprintf(stderr, "kernel_launch: memset failed\n"); return; }
    Args a{};
    for (int i = 0; i < 23; ++i) a.in[i] = (const float*)d_in[i];
    a.out = (float*)d_out; a.ws = (unsigned char*)d_ws;
#if MK_PER_PHASE
    for (int ph = 0; ph < NPH; ++ph) { a.ph_lo = ph; a.ph_hi = ph + 1; hipLaunchKernelGGL(fwd, dim3(grid), dim3(512), LDS_BYTES, stream, a); }
#else
    a.ph_lo = 0; a.ph_hi = NPH; hipLaunchKernelGGL(fwd, dim3(grid), dim3(512), LDS_BYTES, stream, a);
#endif
    const hipError_t le = hipPeekAtLastError();
    if (le != hipSuccess) fprintf(stderr, "kernel_launch: launch failed: %s\n", hipGetErrorName(le));
}
```

```cpp
#include <hip/hip_runtime.h>
#include <cstdio>
#include <cstdint>

#ifndef MK_PER_PHASE
#define MK_PER_PHASE 0
#endif

#ifndef MK_REP_MASK
#define MK_REP_MASK 0u
#endif
#define REPS(bit) (1 + (int)(((MK_REP_MASK) >> (bit)) & 1u))
#define REPS2(bit) REPS(bit)

#define LAS __attribute__((address_space(3)))
typedef unsigned short bf16_t;
typedef short bf16x8 __attribute__((ext_vector_type(8)));
typedef float f32x4 __attribute__((ext_vector_type(4)));
typedef float f32x2 __attribute__((ext_vector_type(2)));
typedef unsigned u32x4 __attribute__((ext_vector_type(4)));
typedef unsigned u32x2 __attribute__((ext_vector_type(2)));

constexpr int M = 16384, D = 1024, SEQ = 8192, INC = 9216, DFF = 3584, NE = 8;
constexpr float RMS_EPS = 1e-6f, LN_EPS = 1e-5f;
constexpr int MAXSLOT = 34816;
constexpr float F8_W13_MUL = 128.f, F8_ACT_MUL = 4.f, F8_W2_MUL = 256.f, F8_Y_MUL = 32.f;
constexpr int F8_ONE = 0x7f7f7f7f, F8_W13_SC = 0x78787878  , F8_ACT_SC = 0x7d7d7d7d  , F8_W2_SC = 0x77777777  ;

constexpr size_t MiB = 1u << 20;
constexpr size_t WS_CTL = 0, CTL_BYTES = 64 * 1024;
constexpr size_t CTL_BAR = 16384;
constexpr size_t CTL_CNT = 32768;
constexpr size_t WS_SMALL = 1 * MiB;
constexpr size_t SM_TOPE = 0, SM_TOPP = 64 * 1024, SM_TSLOT = 192 * 1024, SM_SSPERM = 320 * 1024, SM_META = 512 * 1024;
constexpr size_t WS_X8 = 2 * MiB;
constexpr size_t WS_YP = 18 * MiB;
constexpr size_t WS_WG8 = 492 * MiB;
constexpr size_t WS_XB = 66 * MiB;
constexpr size_t WS_W0 = 98 * MiB;
constexpr size_t W0_WIN = 0;
constexpr size_t W0_WOUT = 36 * MiB;
constexpr size_t W0_WO = 48 * MiB;
constexpr size_t W0_POOL = 52 * MiB;
constexpr size_t W0_D13 = 53 * MiB;
constexpr size_t W0_D2 = 67 * MiB;
constexpr size_t WS_ACT = 172 * MiB;
constexpr size_t A_SCB = WS_ACT, A_SCX = WS_ACT + 32 * MiB, A_GLU = WS_ACT + 64 * MiB, A_PU = WS_ACT + 96 * MiB, A_GATES = WS_ACT + 128 * MiB,
                 A_YA = WS_ACT + 224 * MiB, A_VB = WS_ACT + 256 * MiB, A_PP = WS_ACT + 288 * MiB, A_MERGED = A_SCX, A_FFN = WS_ACT;
constexpr size_t WS_HALO = 528 * MiB;
constexpr size_t WS_WC = 524 * MiB;
constexpr size_t WS_ACTP = 98 * MiB;
constexpr size_t WS_WMOE = 304 * MiB, WMOE_W2 = 56 * MiB;
constexpr size_t WS_Y = 400 * MiB;
constexpr size_t WS_APERM = 472 * MiB;
constexpr size_t WS_SS = 540 * MiB;
constexpr size_t WS_END = 541 * MiB;

typedef __bf16 bf16x2_t __attribute__((ext_vector_type(2)));
__device__ __forceinline__ unsigned pk_bf16(float lo, float hi) { const bf16x2_t v = {(__bf16)lo, (__bf16)hi}; return __builtin_bit_cast(unsigned, v); }
__device__ __forceinline__ unsigned pk_fp8x4(const f32x4 v) {
    const float a = __builtin_amdgcn_fmed3f(v[0], -448.f, 448.f), b = __builtin_amdgcn_fmed3f(v[1], -448.f, 448.f), c = __builtin_amdgcn_fmed3f(v[2], -448.f, 448.f), d = __builtin_amdgcn_fmed3f(v[3], -448.f, 448.f);
    int w = 0; w = __builtin_amdgcn_cvt_pk_fp8_f32(a, b, w, false); w = __builtin_amdgcn_cvt_pk_fp8_f32(c, d, w, true); return (unsigned)w; }
__device__ __forceinline__ float bf_lo(unsigned u) { return __uint_as_float(u << 16); }
__device__ __forceinline__ float bf_hi(unsigned u) { return __uint_as_float(u & 0xffff0000u); }
__device__ __forceinline__ float sigm(float x) { return __builtin_amdgcn_rcpf(1.f + __builtin_amdgcn_exp2f(-1.44269504f * x)); }
__device__ __forceinline__ float wave_sum(float v) {
#pragma unroll
    for (int o = 1; o < 64; o <<= 1) v += __shfl_xor(v, o);
    return v;
}
#define LDS_WAIT() asm volatile("s_waitcnt lgkmcnt(0)" ::: "memory")

namespace pg8 {
constexpr int BM = 256, BK = 64, HALF = 128, HTB = HALF * BK * 2, STAGE_BYTES = 8 * HTB, NXCD = 8;
__host__ __device__ __forceinline__ int lds_byte(int r, int c) { const int st = (r >> 4) * 2 + (c >> 5), rr = r & 15, cc = c & 31, ob = rr * 64 + cc * 2; return st * 1024 + (ob ^ (((ob >> 9) & 1) << 5)); }
__host__ __device__ __forceinline__ void stage_rc(int b, int& R, int& C) { const int st = b / 1024, sb = b % 1024, swz = sb ^ (((sb >> 9) & 1) << 5); R = (st >> 1) * 16 + swz / 64; C = (st & 1) * 32 + (swz % 64) / 2; }
__host__ __device__ __forceinline__ int perm32(int rho) { const int n = rho >> 4, i = rho & 15; return 8 * (i >> 2) + 4 * n + (i & 3); }

struct Unit { int pm, pn, aux, nt; const char* A; const char* B; };
struct Gemm { int Kb, lda, ldb; int sa, sb; };

__device__ __forceinline__ bool tile_of(int L, int nM, int nN, int& pm, int& pn, int WGM = 4) {
    const int nwg = nM * nN; if (L >= nwg) return false;
    int wgid = L; { const int q = nwg / NXCD, r = nwg % NXCD, xcd = wgid % NXCD, off = wgid / NXCD; wgid = (xcd < r ? xcd * (q + 1) : r * (q + 1) + (xcd - r) * q) + off; }
    const int nig = WGM * nN, gid = wgid / nig, fm = gid * WGM, gsz = (nM - fm) < WGM ? (nM - fm) : WGM;
    pm = fm + ((wgid % nig) % gsz); pn = (wgid % nig) / gsz; return true;
}
struct PlainSched {
    int nM, nN, G, c; const char* A0; const char* B0; size_t astep, bstep; int wgm; int bsplit, badd;
    __device__ __forceinline__ bool next(int i, Unit& u) const { int pm, pn; if (!tile_of(i * G + c, nM, nN, pm, pn, wgm)) return false; u.pm = pm; u.pn = pn; u.aux = 0; u.nt = 0; u.A = A0 + (size_t)pm * astep; u.B = B0 + (size_t)(pn + (pn >= bsplit ? badd : 0)) * bstep; return true; }
};
struct PoolSched {
    int G, c; const char* A0; const char* B0;
    __device__ __forceinline__ bool next(int i, Unit& u) const { int pm, pn; if (!tile_of(i * G + c, M / 256, 4, pm, pn)) return false; u.pm = pm; u.pn = pn; u.aux = 0; u.nt = 0;
        u.A = A0 + (size_t)pm * (256 * 1024 * 2) + (size_t)pn * 512; u.B = B0 + (size_t)pn * (256 * 256 * 2); return true; }
};
struct MergeSched {
    int G, c; const char *A0, *B0, *B2; size_t astr, bstr;
    __device__ __forceinline__ bool next(int i, Unit& u) const { const int t = i / 3, b = i - 3 * t; int pm, pn; if (!tile_of(t * G + c, M / 256, 4, pm, pn)) return false; u.pm = pm; u.pn = pn; u.aux = b; u.nt = 0;
        const char* w = b == 2 ? B2 : B0 + (size_t)b * bstr;
        u.A = A0 + (size_t)b * astr + (size_t)pm * (256 * 1024 * 2); u.B = w + (size_t)pn * (256 * 1024 * 2); return true; }
};
struct FoldSched {
    int G, c; const char *A0, *B0;
    __device__ __forceinline__ bool next(int i, Unit& u) const { const int idx = i * G + c; if (idx >= 32) return false; const int L = idx >> 4, pm = (idx >> 2) & 3, g = idx & 3; u.pm = pm; u.pn = g; u.aux = L; u.nt = 0;
        u.A = A0 + (size_t)L * (6 * MiB) + (size_t)pm * (256 * 1024 * 2) + (size_t)g * 512; u.B = B0 + (size_t)L * (512 * 1024) + (size_t)g * (256 * 256 * 2); return true; }
};
struct GroupSched {
    int nM, nN, G, c; int o1, o2, o3, o4, o5, o6, o7; const char* A0; const char* B0; size_t astep, bstep, estep; int wgm;
    __device__ __forceinline__ bool next(int i, Unit& u) const { int pm, pn; if (!tile_of(i * G + c, nM, nN, pm, pn, wgm)) return false; u.pm = pm; u.pn = pn; u.aux = 0; u.nt = 0;
        const int e = (pm >= o1) + (pm >= o2) + (pm >= o3) + (pm >= o4) + (pm >= o5) + (pm >= o6) + (pm >= o7);
        u.A = A0 + (size_t)pm * astep; u.B = B0 + (size_t)e * estep + (size_t)pn * bstep; return true; }
};

constexpr int MOE2_SPL = 7, MOE2_SNT = 4;
struct Moe2Sched {
    int nM, G, c, R, tail, split; int o1, o2, o3, o4, o5, o6, o7; const char* A0; const char* B0; size_t astep, bstep, estep;
    __device__ __forceinline__ bool next(int i, Unit& u) const {
        int L = i * G + c, part = -1, sub = 0;
        if (split && i >= R) { if (i > R || c >= MOE2_SPL * tail) return false; sub = c; L = R * G + c / MOE2_SPL; part = c % MOE2_SPL; }
        int pm, pn; if (!tile_of(L, nM, 4, pm, pn, 4)) return false; u.pm = pm; u.pn = pn;
        const int e = (pm >= o1) + (pm >= o2) + (pm >= o3) + (pm >= o4) + (pm >= o5) + (pm >= o6) + (pm >= o7);
        u.A = A0 + (size_t)pm * astep; u.B = B0 + (size_t)e * estep + (size_t)pn * bstep; u.aux = 0; u.nt = 0;
        if (part >= 0) { u.A += part * (MOE2_SNT * 128); u.B += part * (MOE2_SNT * 128); u.aux = 1 + sub; u.nt = MOE2_SNT; }
        return true; }
};

typedef f32x4 Acc[2][2][4][2];
__device__ __forceinline__ u32x4 pack8(const f32x4 v0, const f32x4 v1) { u32x4 w; w.x = pk_bf16(v0[0], v0[1]); w.y = pk_bf16(v0[2], v0[3]); w.z = pk_bf16(v1[0], v1[1]); w.w = pk_bf16(v1[2], v1[3]); return w; }
__device__ __forceinline__ f32x4 sig4(const f32x4 v) { f32x4 r; r[0] = sigm(v[0]); r[1] = sigm(v[1]); r[2] = sigm(v[2]); r[3] = sigm(v[3]); return r; }
__device__ __forceinline__ void unpack8(const u32x4 g, f32x4& lo, f32x4& hi) { lo[0] = bf_lo(g.x); lo[1] = bf_hi(g.x); lo[2] = bf_lo(g.y); lo[3] = bf_hi(g.y); hi[0] = bf_lo(g.z); hi[1] = bf_hi(g.z); hi[2] = bf_lo(g.w); hi[3] = bf_hi(g.w); }

__device__ __forceinline__ size_t gate_frag(int pm, int q, int wid, int ai, int m, int lane) { return ((size_t)(((((pm * 12 + q) * 8 + wid) * 2 + ai) * 4 + m) * 64 + lane)) * 16; }
__device__ __forceinline__ unsigned pk_fp8x4_raw(const f32x4 v) { int w = 0; w = __builtin_amdgcn_cvt_pk_fp8_f32(v[0], v[1], w, false); w = __builtin_amdgcn_cvt_pk_fp8_f32(v[2], v[3], w, true); return (unsigned)w; }
__device__ __forceinline__ f32x4 un_fp8x4(unsigned w) { const f32x2 lo = __builtin_amdgcn_cvt_pk_f32_fp8((int)w, false), hi = __builtin_amdgcn_cvt_pk_f32_fp8((int)w, true); return (f32x4){lo[0], lo[1], hi[0], hi[1]}; }
struct EpiProj {
    static constexpr bool INIT = false;
    bf16_t *glu, *gates; const f32x4* ss;
    __device__ __forceinline__ bool operator()(Acc& acc, const Unit& u, int wr, int wc, int fr, int fq) const {
        const int row0 = u.pm * BM + wr * 64 + fr, pn = u.pn;
        float rs[2][4];
#pragma unroll
        for (int ai = 0; ai < 2; ++ai)
#pragma unroll
            for (int m = 0; m < 4; ++m) { const f32x4 p = ss[row0 + ai * HALF + m * 16]; rs[ai][m] = __builtin_amdgcn_rsqf(((p[0] + p[1]) + (p[2] + p[3])) * (1.0f / D) + RMS_EPS); }
        if (pn < 8) {
            const int col0 = pn * 128 + wc * 32 + 8 * fq;
#pragma unroll
            for (int ai = 0; ai < 2; ++ai)
#pragma unroll
                for (int m = 0; m < 4; ++m) { const float r = rs[ai][m];
                    const f32x4 a0 = acc[ai][0][m][0] * r, a1 = acc[ai][0][m][1] * r, b0 = sig4(acc[ai][1][m][0] * r), b1 = sig4(acc[ai][1][m][1] * r);
                    *(u32x4*)(glu + (size_t)(row0 + ai * HALF + m * 16) * D + col0) = pack8(a0 * b0, a1 * b1); }
        } else {
#pragma unroll
            for (int ai = 0; ai < 2; ++ai)
#pragma unroll
                for (int m = 0; m < 4; ++m) { const float r = -1.44269504f * rs[ai][m]; u32x4 w;
#pragma unroll
                    for (int bj = 0; bj < 2; ++bj) { f32x4 e0 = acc[ai][bj][m][0] * r, e1 = acc[ai][bj][m][1] * r;
#pragma unroll
                        for (int j = 0; j < 4; ++j) { e0[j] = __builtin_amdgcn_exp2f(__builtin_amdgcn_fmed3f(e0[j], -8.65617f, 8.65617f)); e1[j] = __builtin_amdgcn_exp2f(__builtin_amdgcn_fmed3f(e1[j], -8.65617f, 8.65617f)); }
                        w[2 * bj] = pk_fp8x4_raw(e0); w[2 * bj + 1] = pk_fp8x4_raw(e1); }
                    *(u32x4*)((unsigned char*)gates + gate_frag(u.pm, pn - 8, wr * 4 + wc, ai, m, fr + 16 * fq)) = w; }
        }
        return false;
    }
};
template <int CTRL> __device__ __forceinline__ float dpp_f(float old, float src) { return __int_as_float(__builtin_amdgcn_update_dpp(__float_as_int(old), __float_as_int(src), CTRL, 0xf, 0xf, false)); }
struct EpiSc {
    static constexpr bool INIT = false;
    bf16_t *ya, *pp, *pu; const f32x4* ss; const float* scw; float* halo; LAS float* ex; LAS float* px;
    __device__ __forceinline__ bool operator()(Acc& acc, const Unit& u, int wr, int wc, int fr, int fq) const {
        const int row0 = u.pm * BM + wr * 64 + fr, ch0 = u.pn * 64 + wc * 16 + fq * 4;
        const int g = __builtin_amdgcn_readfirstlane(u.pn >> 2);
#pragma unroll
        for (int ai = 0; ai < 2; ++ai)
#pragma unroll
            for (int m = 0; m < 4; ++m) { const f32x4 p = ss[row0 + ai * HALF + m * 16]; const float r = __builtin_amdgcn_rsqf(((p[0] + p[1]) + (p[2] + p[3])) * (1.0f / D) + RMS_EPS);
                acc[ai][0][m][0] = acc[ai][0][m][0] * r; acc[ai][0][m][1] = (acc[ai][0][m][1] * r) * (acc[ai][1][m][0] * r); acc[ai][1][m][1] = acc[ai][1][m][1] * r; acc[ai][1][m][0] = acc[ai][1][m][1]; }
        if (fr >= 14) {
#pragma unroll
            for (int ai = 0; ai < 2; ++ai) *(LAS f32x4*)(ex + ((((ai * 2 + wr) * 4 + wc) * 4 + fq) * 2 + (fr - 14)) * 4) = acc[ai][0][3][1];
            if (wr == 1) *(f32x4*)(halo + ((size_t)((2 * 64 + u.pm) * 2 + (fr - 14))) * D + ch0) = acc[1][0][3][1];
        }
        if (wr == 0 && fr < 2) { *(f32x4*)(halo + ((size_t)((0 * 64 + u.pm) * 2 + fr)) * D + ch0) = acc[0][0][0][0]; *(f32x4*)(halo + ((size_t)((1 * 64 + u.pm) * 2 + fr)) * D + ch0) = acc[0][0][0][1]; }
        if (wr == 0) { const f32x4 v = acc[0][1][0][1]; *(u32x2*)(pu + (size_t)row0 * D + ch0) = (u32x2){pk_bf16(v[0], v[1]), pk_bf16(v[2], v[3])}; }
        else { const f32x4 v = acc[1][1][3][1]; *(u32x2*)(pu + (size_t)(row0 + HALF + 48) * D + ch0) = (u32x2){pk_bf16(v[0], v[1]), pk_bf16(v[2], v[3])}; }
#pragma unroll
        for (int ai = 0; ai < 2; ++ai) { LAS float* eb = px + ((((ai * 2 + wr) * 4 + wc) * 4 + fq) * 15) * 4;
#define POOL_STEP(DSH, ROR, SHR) do { if (fr >= 16 - DSH) *(LAS f32x4*)(eb + (DSH - 1 + fr - (16 - DSH)) * 4) = acc[ai][1][3][0]; \
            _Pragma("unroll") for (int m = 3; m >= 0; --m) { _Pragma("unroll") for (int j = 0; j < 4; ++j) { float f = 0.f; if (m > 0) f = dpp_f<ROR>(0.f, acc[ai][1][m - 1][0][j]); acc[ai][1][m][0][j] += dpp_f<SHR>(f, acc[ai][1][m][0][j]); } } } while (0)
            POOL_STEP(1, 0x121, 0x111);
            if (g >= 1) POOL_STEP(2, 0x122, 0x112);
            if (g >= 2) POOL_STEP(4, 0x124, 0x114);
            if (g >= 3) POOL_STEP(8, 0x128, 0x118);
#undef POOL_STEP
        }
        const f32x4 w0 = *(const f32x4*)(scw + ch0), w1 = *(const f32x4*)(scw + D + ch0), w2 = *(const f32x4*)(scw + 2 * D + ch0);
        asm volatile("s_waitcnt lgkmcnt(0)" ::: "memory"); __builtin_amdgcn_s_barrier(); asm volatile("" ::: "memory");
        const float invw = 0.5f / (float)(1 << g);
#pragma unroll
        for (int ai = 0; ai < 2; ++ai) {
            f32x4 F1 = (f32x4){0.f, 0.f, 0.f, 0.f}, F2 = F1;
            if (ai + wr > 0) { const int pb = 2 * ai + wr - 1; const LAS float* e = ex + (((pb * 4 + wc) * 4 + fq) * 2) * 4; const f32x4 E0 = *(const LAS f32x4*)e, E1 = *(const LAS f32x4*)(e + 4); F1 = E1; F2 = fr == 0 ? E0 : E1;
                const LAS float* pe = px + (((pb * 4 + wc) * 4 + fq) * 15) * 4; f32x4 t = acc[ai][1][0][1];
#define POOL_REDO(DSH, SHR) do { const f32x4 f = *(const LAS f32x4*)(pe + (DSH - 1 + (fr & (DSH - 1))) * 4); _Pragma("unroll") for (int j = 0; j < 4; ++j) t[j] += dpp_f<SHR>(f[j], t[j]); } while (0)
                POOL_REDO(1, 0x111);
                if (g >= 1) POOL_REDO(2, 0x112);
                if (g >= 2) POOL_REDO(4, 0x114);
                if (g >= 3) POOL_REDO(8, 0x118);
#undef POOL_REDO
                acc[ai][1][0][0] = t; }
#pragma unroll
            for (int m = 0; m < 4; ++m) { const f32x4 pr = acc[ai][0][m][1]; f32x4 y;
                if (m > 0) { const f32x4 pv = acc[ai][0][m - 1][1];
#pragma unroll
                    for (int j = 0; j < 4; ++j) { F1[j] = dpp_f<0x121>(0.f, pv[j]); F2[j] = dpp_f<0x122>(0.f, pv[j]); } }
#pragma unroll
                for (int j = 0; j < 4; ++j) { const float p1 = dpp_f<0x111>(F1[j], pr[j]), p2 = dpp_f<0x112>(F2[j], pr[j]); y[j] = acc[ai][0][m][0][j] * (w0[j] * p2 + w1[j] * p1 + w2[j] * pr[j]); }
                const f32x4 q = acc[ai][1][m][0] * invw - acc[ai][1][m][1];
                const auto s0 = __builtin_amdgcn_permlane16_swap(pk_bf16(y[0], y[1]), pk_bf16(q[0], q[1]), false, false), s1 = __builtin_amdgcn_permlane16_swap(pk_bf16(y[2], y[3]), pk_bf16(q[2], q[3]), false, false);
                *(u32x4*)(ya + (ptrdiff_t)(fq & 1) * (pp - ya) + (size_t)(row0 + ai * HALF + m * 16) * D + (ch0 & ~7)) = (u32x4){s0[0], s1[0], s0[1], s1[1]}; }
        }
        return false;
    }
};
struct EpiPlain {
    static constexpr bool INIT = false;
    bf16_t* Ob; int ldc; size_t aux_stride;
    __device__ __forceinline__ bool operator()(Acc& acc, const Unit& u, int wr, int wc, int fr, int fq) const {
        bf16_t* O = Ob + (size_t)u.aux * aux_stride;
        const int row0 = u.pm * BM + wr * 64 + fr, col0 = u.pn * BM + wc * 32 + 8 * fq;
#pragma unroll
        for (int ai = 0; ai < 2; ++ai)
#pragma unroll
            for (int m = 0; m < 4; ++m) { bf16_t* rowp = O + (size_t)(row0 + ai * HALF + m * 16) * ldc + col0;
#pragma unroll
                for (int bj = 0; bj < 2; ++bj) *(u32x4*)(rowp + bj * HALF) = pack8(acc[ai][bj][m][0], acc[ai][bj][m][1]); }
        return false;
    }
};
struct EpiMoe2 {
    static constexpr bool INIT = false;
    unsigned char* Y; bf16_t* YP;
    __device__ __forceinline__ bool operator()(Acc& acc, const Unit& u, int wr, int wc, int fr, int fq) const {
        if (u.aux) { bf16_t* O = YP + (size_t)(u.aux - 1) * 65536 + (size_t)(wr * 64 + fr) * 256 + wc * 32 + 8 * fq;
#pragma unroll
            for (int ai = 0; ai < 2; ++ai)
#pragma unroll
                for (int m = 0; m < 4; ++m) { bf16_t* rowp = O + (size_t)(ai * HALF + m * 16) * 256;
#pragma unroll
                    for (int bj = 0; bj < 2; ++bj) *(u32x4*)(rowp + bj * HALF) = pack8(acc[ai][bj][m][0], acc[ai][bj][m][1]); }
        } else {
            unsigned char* O = Y + (size_t)(u.pm * BM + wr * 64 + fr) * D + u.pn * BM + wc * 32 + 8 * (fq & ~1) + (fq & 1) * HALF;
#pragma unroll
            for (int ai = 0; ai < 2; ++ai)
#pragma unroll
                for (int m = 0; m < 4; ++m) {
                    const auto s0 = __builtin_amdgcn_permlane16_swap(pk_fp8x4(acc[ai][0][m][0] * F8_Y_MUL), pk_fp8x4(acc[ai][1][m][0] * F8_Y_MUL), false, false),
                               s1 = __builtin_amdgcn_permlane16_swap(pk_fp8x4(acc[ai][0][m][1] * F8_Y_MUL), pk_fp8x4(acc[ai][1][m][1] * F8_Y_MUL), false, false);
                    *(u32x4*)(O + (size_t)(ai * HALF + m * 16) * D) = (u32x4){s0[0], s1[0], s0[1], s1[1]}; }
        }
        return false;
    }
};
struct EpiMerge {
    static constexpr bool INIT = false;
    const bf16_t* gates; bf16_t* O;
    __device__ __forceinline__ bool operator()(Acc& acc, const Unit& u, int wr, int wc, int fr, int fq) const {
        const int row0 = u.pm * BM + wr * 64 + fr, col0 = u.pn * BM + wc * 32 + 8 * fq, b = u.aux;
#pragma unroll
        for (int ai = 0; ai < 2; ++ai)
#pragma unroll
            for (int m = 0; m < 4; ++m) { const size_t row = (size_t)(row0 + ai * HALF + m * 16);
                const unsigned char* gp = (const unsigned char*)gates + gate_frag(u.pm, 4 * b + u.pn, wr * 4 + wc, ai, m, fr + 16 * fq);
                const u32x4 gw = *(const u32x4*)gp;
                if (b < 2) { const u32x4 hw = *(const u32x4*)(gp + gate_frag(0, 4, 0, 0, 0, 0));
#pragma unroll
                    for (int bj = 0; bj < 2; ++bj) { const f32x4 g0 = un_fp8x4(gw[2 * bj]), g1 = un_fp8x4(gw[2 * bj + 1]), h0 = un_fp8x4(hw[2 * bj]), h1 = un_fp8x4(hw[2 * bj + 1]);
#pragma unroll
                        for (int j = 0; j < 4; ++j) { acc[ai][bj][m][0][j] *= (1.f + h0[j]) * __builtin_amdgcn_rcpf(1.f + g0[j]); acc[ai][bj][m][1][j] *= (1.f + h1[j]) * __builtin_amdgcn_rcpf(1.f + g1[j]); } }
                } else {
#pragma unroll
                    for (int bj = 0; bj < 2; ++bj) { f32x4 g0 = un_fp8x4(gw[2 * bj]), g1 = un_fp8x4(gw[2 * bj + 1]);
#pragma unroll
                        for (int j = 0; j < 4; ++j) { g0[j] = __builtin_amdgcn_rcpf(1.f + g0[j]); g1[j] = __builtin_amdgcn_rcpf(1.f + g1[j]); }
                        *(u32x4*)(O + row * D + col0 + bj * HALF) = pack8(acc[ai][bj][m][0] * g0, acc[ai][bj][m][1] * g1); } } }
        return b < 2;
    }
};
struct EpiResid {
    static constexpr bool INIT = true;
    bf16_t* xb; float* ssp; LAS float* red; unsigned char* x8;
    __device__ __forceinline__ void init_load(Acc& acc, u32x4 (&raw)[16], const Unit& u, int wr, int wc, int fr, int fq) const {
        const int row0 = u.pm * BM + wr * 64 + fr, col0 = u.pn * BM + wc * 32 + 8 * fq;
#pragma unroll
        for (int ai = 0; ai < 2; ++ai)
#pragma unroll
            for (int m = 0; m < 4; ++m)
#pragma unroll
                for (int bj = 0; bj < 2; ++bj) { const size_t off = (size_t)(row0 + ai * HALF + m * 16) * D + col0 + bj * HALF;
                    raw[(ai * 4 + m) * 2 + bj] = *(const u32x4*)(xb + off); }
    }
    __device__ __forceinline__ void init_finish(Acc& acc, const u32x4 (&raw)[16]) const {
        {
#pragma unroll
            for (int ai = 0; ai < 2; ++ai)
#pragma unroll
                for (int m = 0; m < 4; ++m)
#pragma unroll
                    for (int bj = 0; bj < 2; ++bj) unpack8(raw[(ai * 4 + m) * 2 + bj], acc[ai][bj][m][0], acc[ai][bj][m][1]); }
    }
    __device__ __forceinline__ bool operator()(Acc& acc, const Unit& u, int wr, int wc, int fr, int fq) const {
        const int row0 = u.pm * BM + wr * 64 + fr, col0 = u.pn * BM + wc * 32 + 8 * fq;
#pragma unroll
        for (int ai = 0; ai < 2; ++ai)
#pragma unroll
            for (int m = 0; m < 4; ++m) { const size_t row = (size_t)(row0 + ai * HALF + m * 16); float q = 0.f;
#pragma unroll
                for (int bj = 0; bj < 2; ++bj) { const size_t off = row * D + col0 + bj * HALF;
                    const u32x4 pk = pack8(acc[ai][bj][m][0], acc[ai][bj][m][1]); *(u32x4*)(xb + off) = pk;
                    f32x4 o0, o1; unpack8(pk, o0, o1); if (x8) *(u32x2*)(x8 + off) = (u32x2){pk_fp8x4(o0), pk_fp8x4(o1)};
                    q += (o0[0] * o0[0] + o0[1] * o0[1]) + (o0[2] * o0[2] + o0[3] * o0[3]) + (o1[0] * o1[0] + o1[1] * o1[1]) + (o1[2] * o1[2] + o1[3] * o1[3]); }
                q += __shfl_xor(q, 16); q += __shfl_xor(q, 32);
                if (fq == 0) red[(ai * HALF + wr * 64 + m * 16 + fr) * 4 + wc] = q; }
        asm volatile("s_waitcnt lgkmcnt(0)" ::: "memory"); __builtin_amdgcn_s_barrier(); asm volatile("" ::: "memory");
        int tid = threadIdx.x; asm volatile("" : "+v"(tid));
        if (tid < 256) { const f32x4 v = *(const LAS f32x4*)(red + tid * 4); ssp[(size_t)(u.pm * BM + tid) * 4 + u.pn] = (v[0] + v[1]) + (v[2] + v[3]); }
        return false;
    }
};
template <bool PART4, bool OUT8> struct EpiSwiGLU {
    static constexpr bool INIT = false;
    bf16_t* O; int ldc; const float* ss;
    __device__ __forceinline__ bool operator()(Acc& acc, const Unit& u, int wr, int wc, int fr, int fq) const {
        const int row0 = u.pm * BM + wr * 64 + fr, col0 = u.pn * 128 + wc * 32 + 8 * fq;
#pragma unroll
        for (int ai = 0; ai < 2; ++ai)
#pragma unroll
            for (int m = 0; m < 4; ++m) { const size_t row = (size_t)(row0 + ai * HALF + m * 16); float r = 1.f;
                if (PART4) { const f32x4 p = *(const f32x4*)(ss + row * 4); r = __builtin_amdgcn_rsqf(((p[0] + p[1]) + (p[2] + p[3])) * (1.0f / D) + RMS_EPS); }
                const f32x4 a0 = acc[ai][0][m][0] * r, a1 = acc[ai][0][m][1] * r, c0 = acc[ai][1][m][0] * r, c1 = acc[ai][1][m][1] * r;
                const f32x4 h0 = a0 * sig4(a0) * c0, h1 = a1 * sig4(a1) * c1;
                if (OUT8) { *(u32x2*)((unsigned char*)O + row * ldc + col0) = (u32x2){pk_fp8x4(h0 * F8_ACT_MUL), pk_fp8x4(h1 * F8_ACT_MUL)}; }
                else *(u32x4*)(O + row * ldc + col0) = pack8(h0, h1); }
        return false;
    }
};

typedef int i32x4 __attribute__((ext_vector_type(4)));
typedef int i32x8 __attribute__((ext_vector_type(8)));
__device__ __forceinline__ i32x8 join16(const bf16x8 lo, const bf16x8 hi) { return __builtin_shufflevector(__builtin_bit_cast(i32x4, lo), __builtin_bit_cast(i32x4, hi), 0, 1, 2, 3, 4, 5, 6, 7); }
template <class Epi, class Sched, bool F8 = false>
__device__ __forceinline__ void gemm_phase(LAS unsigned char* lds, const Gemm g, const Sched& S, const Epi& E) {
    int tid_ = threadIdx.x; asm volatile("" : "+v"(tid_));
    const int tid = tid_, wid = __builtin_amdgcn_readfirstlane(tid >> 6), lane = tid & 63, wr = wid >> 2, wc = wid & 3, fr = lane & 15, fq = lane >> 4;
    const int nt = g.Kb / 128;
    int vsa = g.sa, vsb = g.sb; asm volatile("" : "+v"(vsa), "+v"(vsb));
    unsigned voffA[2], voffB[2];
#pragma unroll
    for (int i = 0; i < 2; ++i) { int R, C; stage_rc(tid * 16 + i * 8192, R, C); const int Rb = (R & ~31) + perm32(R & 31);
        voffA[i] = (unsigned)(R * g.lda + C * 2); voffB[i] = (unsigned)(Rb * g.ldb + C * 2); }
    const size_t kstep = (size_t)(BK * 2);
    const size_t hstepA = (size_t)HALF * g.lda, hstepB = (size_t)HALF * g.ldb;
    const unsigned ldsw = (unsigned)wid * 1024u;
    const int aoff = lds_byte(wr * 64 + fr, fq * 8), boff = lds_byte(wc * 32 + fr, fq * 8);
#define PG8_SA(b, h) (((b) * 2 + (h)) * HTB)
#define PG8_SB(b, h) ((4 + (b) * 2 + (h)) * HTB)
#define PG8_STAGE(bufoff, gbase, voff) do { _Pragma("unroll") for (int _i = 0; _i < 2; ++_i) \
        __builtin_amdgcn_global_load_lds((const unsigned*)((const char*)(gbase) + (voff)[_i]), (LAS unsigned*)(lds + (bufoff) + ldsw + _i * 8192), 16, 0, 0); } while (0)
#define PG8_LDA(dst, b, h) do { _Pragma("unroll") for (int m = 0; m < 4; ++m) _Pragma("unroll") for (int k = 0; k < 2; ++k) dst[m][k] = *(const LAS bf16x8*)(lds + PG8_SA(b, h) + aoff + m * 2048 + k * 1024); } while (0)
#define PG8_LDB(dst, b, h) do { _Pragma("unroll") for (int n = 0; n < 2; ++n) _Pragma("unroll") for (int k = 0; k < 2; ++k) dst[n][k] = *(const LAS bf16x8*)(lds + PG8_SB(b, h) + boff + n * 2048 + k * 1024); } while (0)
#define PG8_MMA(ai, bj, At, Bt) do { __builtin_amdgcn_s_setprio(1); _Pragma("unroll") for (int m = 0; m < 4; ++m) _Pragma("unroll") for (int n = 0; n < 2; ++n) { \
        if constexpr (F8) { const i32x8 b8_ = join16(Bt[n][0], Bt[n][1]), a8_ = join16(At[m][0], At[m][1]); \
            asm volatile("v_mfma_scale_f32_16x16x128_f8f6f4 %0, %1, %2, %0, %3, %4 op_sel_hi:[0,0,0]" : "+v"(acc[ai][bj][m][n]) : "v"(b8_), "v"(a8_), "v"(vsb), "v"(vsa)); } \
        else { _Pragma("unroll") for (int k = 0; k < 2; ++k) acc[ai][bj][m][n] = __builtin_amdgcn_mfma_f32_16x16x32_bf16(Bt[n][k], At[m][k], acc[ai][bj][m][n], 0, 0, 0); } } __builtin_amdgcn_s_setprio(0); } while (0)
#define PG8_WAIT_V(n) asm volatile("s_waitcnt vmcnt(" #n ")" ::: "memory")
#define PG8_WAIT_L(n) asm volatile("s_waitcnt lgkmcnt(" #n ")" ::: "memory")
#define PG8_BAR __builtin_amdgcn_s_barrier()
#define PG8_SCHED __builtin_amdgcn_sched_barrier(0)
    Unit cur, nxt; int ui = 0;
    if (!S.next(0, cur)) return;
    Acc acc;
    u32x4 iraw[16];
    if constexpr (Epi::INIT) E.init_load(acc, iraw, cur, wr, wc, fr, fq);
    else {
#pragma unroll
    for (int a = 0; a < 2; ++a)
#pragma unroll
        for (int b = 0; b < 2; ++b)
#pragma unroll
            for (int m = 0; m < 4; ++m)
#pragma unroll
                for (int n = 0; n < 2; ++n) acc[a][b][m][n] = (f32x4){0.f, 0.f, 0.f, 0.f};
    }
    bf16x8 At[4][2], B0[2][2], B1[2][2];
    const char* cA = cur.A; const char* cB = cur.B;
    PG8_STAGE(PG8_SB(0, 0), cB, voffB); PG8_STAGE(PG8_SB(0, 1), cB + hstepB, voffB); PG8_STAGE(PG8_SA(0, 0), cA, voffA); PG8_STAGE(PG8_SA(0, 1), cA + hstepA, voffA);
    if constexpr (Epi::INIT) { PG8_SCHED; E.init_finish(acc, iraw); PG8_SCHED; }
    if (wr == 1) PG8_BAR;
    PG8_WAIT_V(2); PG8_BAR;
    PG8_STAGE(PG8_SB(1, 0), cB + kstep, voffB); PG8_STAGE(PG8_SA(1, 0), cA + kstep, voffA); PG8_STAGE(PG8_SB(1, 1), cB + hstepB + kstep, voffB);
    PG8_WAIT_V(6); PG8_BAR;
    for (;;) {
        const bool has_next = S.next(ui + 1, nxt);
        const char* nA = has_next ? nxt.A : cA; const char* nB = has_next ? nxt.B : cB;
        const int unt = cur.nt ? cur.nt : nt;
#pragma nounroll
        for (int t = 0; t < unt; t += 2) {
            const bool last = (t == unt - 2);
            const char* a1 = cA + (size_t)(t + 1) * kstep;
            const char* a2 = last ? nA : cA + (size_t)(t + 2) * kstep; const char* b2 = last ? nB : cB + (size_t)(t + 2) * kstep;
            const char* a3 = a2 + kstep; const char* b3 = b2 + kstep;
            PG8_LDB(B0, 0, 0); PG8_LDB(B1, 0, 1); PG8_SCHED; PG8_LDA(At, 0, 0); PG8_STAGE(PG8_SA(1, 1), a1 + hstepA, voffA);
            PG8_WAIT_V(8); PG8_WAIT_L(0); PG8_BAR; PG8_MMA(0, 0, At, B0); PG8_MMA(0, 1, At, B1); PG8_BAR; PG8_SCHED;
            PG8_LDA(At, 0, 1); PG8_STAGE(PG8_SB(0, 0), b2, voffB); PG8_STAGE(PG8_SB(0, 1), b2 + hstepB, voffB); PG8_STAGE(PG8_SA(0, 0), a2, voffA);
            PG8_WAIT_V(8); PG8_WAIT_L(0); PG8_BAR; PG8_MMA(1, 0, At, B0); PG8_MMA(1, 1, At, B1); PG8_BAR; PG8_SCHED;
            PG8_LDB(B0, 1, 0); PG8_LDB(B1, 1, 1); PG8_SCHED; PG8_LDA(At, 1, 0); PG8_STAGE(PG8_SA(0, 1), a2 + hstepA, voffA);
            PG8_WAIT_V(8); PG8_WAIT_L(0); PG8_BAR; PG8_MMA(0, 0, At, B0); PG8_MMA(0, 1, At, B1); PG8_BAR; PG8_SCHED;
            PG8_LDA(At, 1, 1); PG8_STAGE(PG8_SB(1, 0), b3, voffB); PG8_STAGE(PG8_SB(1, 1), b3 + hstepB, voffB); PG8_STAGE(PG8_SA(1, 0), a3, voffA);
            PG8_WAIT_V(8); PG8_WAIT_L(0); PG8_BAR; PG8_MMA(1, 0, At, B0); PG8_MMA(1, 1, At, B1); PG8_BAR; PG8_SCHED;
        }
        if constexpr (F8) asm volatile("s_nop 15\n\ts_nop 15" ::: "memory");
        if (wr == 0) PG8_BAR;
        const bool keep = E(acc, cur, wr, wc, fr, fq);
        if (!has_next) break;
        if constexpr (Epi::INIT) { E.init_load(acc, iraw, nxt, wr, wc, fr, fq); E.init_finish(acc, iraw); }
        else if (!keep) {
#pragma unroll
            for (int a = 0; a < 2; ++a)
#pragma unroll
                for (int b = 0; b < 2; ++b)
#pragma unroll
                    for (int m = 0; m < 4; ++m)
#pragma unroll
                        for (int n = 0; n < 2; ++n) acc[a][b][m][n] = (f32x4){0.f, 0.f, 0.f, 0.f};
        }
        cur = nxt; cA = nA; cB = nB; ++ui;
        if (wr == 1) PG8_BAR;
    }
    PG8_WAIT_V(0);
    PG8_BAR;
#undef PG8_SA
#undef PG8_SB
#undef PG8_STAGE
#undef PG8_LDA
#undef PG8_LDB
#undef PG8_MMA
#undef PG8_WAIT_V
#undef PG8_WAIT_L
#undef PG8_BAR
#undef PG8_SCHED
}
}

constexpr int RING_BYTES = 131072, MISC_OFF = RING_BYTES, RED_OFF = RING_BYTES + 1024, POOLX_OFF = RED_OFF + 4096, LDS_BYTES = 163840;

#define XB_TMO      128
#define XB_XCNT(j)  (256  + 64 * (j))
#define XB_XSUB(j)  (1280 + 64 * (j))
#define XB_XGEN(j)  (2304 + 64 * (j))
#define XB_TOP      3328
#define XB_TOPGEN   3392
#define XCD_BAR_WORDS 3456
#define XB_SPIN_CAP (1u << 18)
__device__ __forceinline__ unsigned xb_ld(unsigned* p)              { return __hip_atomic_load(p, __ATOMIC_RELAXED, __HIP_MEMORY_SCOPE_AGENT); }
__device__ __forceinline__ unsigned xb_add(unsigned* p, unsigned v) { return __hip_atomic_fetch_add(p, v, __ATOMIC_RELAXED, __HIP_MEMORY_SCOPE_AGENT); }
__device__ __forceinline__ unsigned xb_xcc_id() { return (unsigned)__builtin_amdgcn_s_getreg((3 << 11) | 20) & 0xFu; }
#define XB_SPIN(cond, bar) do { unsigned _sp = 0; while (cond) { __builtin_amdgcn_s_sleep(1); \
    if ((++_sp & 255u) == 0u) { if (xb_ld(&(bar)[XB_TMO])) break; if (_sp > XB_SPIN_CAP) { atomicAdd(&(bar)[XB_TMO], 1u); break; } } } } while (0)
struct XcdBarrier { unsigned* bar; unsigned x; volatile LAS unsigned* st; };
__device__ __forceinline__ XcdBarrier xcd_barrier_post(unsigned* bar, volatile LAS unsigned* st) {
    XcdBarrier b; b.bar = bar; b.x = xb_xcc_id(); b.st = st;
    if (threadIdx.x == 0) (void)xb_add(&bar[XB_XCNT(b.x)], 1u);
    return b;
}
__device__ __forceinline__ void xcd_barrier_complete(unsigned* bar, unsigned x, unsigned& nloc, unsigned& nx) {
    const unsigned G = gridDim.x * gridDim.y * gridDim.z;
    unsigned sum, cnt, mine, sp = 0u;
    for (;;) {
        sum = 0u; cnt = 0u; mine = 0u;
#pragma nounroll
        for (unsigned j = 0; j < 16; ++j) { const unsigned c = xb_ld(&bar[XB_XCNT(j)]); sum += c; cnt += (c > 0u) ? 1u : 0u; mine = (j == x) ? c : mine; }
        if (sum == G) break;
        __builtin_amdgcn_s_sleep(1);
        if ((++sp & 255u) == 0u) { if (xb_ld(&bar[XB_TMO])) break; if (sp > XB_SPIN_CAP) { atomicAdd(&bar[XB_TMO], 1u); break; } }
    }
    nloc = mine > 0u ? mine : 1u; nx = cnt > 0u ? cnt : 1u;
}
__device__ __forceinline__ void xcd_barrier(const XcdBarrier& b) {
    asm volatile("s_waitcnt vmcnt(0)" ::: "memory");
    __syncthreads();
    if (threadIdx.x == 0) {
        unsigned* bar = b.bar;
        __builtin_amdgcn_s_waitcnt(0);
        unsigned nloc = b.st[0], nx = b.st[1];
        if (nloc == 0u) { xcd_barrier_complete(bar, b.x, nloc, nx); b.st[0] = nloc; b.st[1] = nx; }
        const unsigned old = xb_add(&bar[XB_XSUB(b.x)], 1u);
        const unsigned gen = old / nloc;
        if (old + 1u == (gen + 1u) * nloc) {
            __builtin_amdgcn_fence(__ATOMIC_RELEASE, "agent");
            asm volatile("s_waitcnt vmcnt(0)" ::: "memory");
            const unsigned og = xb_add(&bar[XB_TOP], 1u);
            const unsigned tg = og / nx;
            if (og + 1u == (tg + 1u) * nx) xb_add(&bar[XB_TOPGEN], 1u);
            else XB_SPIN(xb_ld(&bar[XB_TOPGEN]) == tg, bar);
            __builtin_amdgcn_fence(__ATOMIC_ACQUIRE, "agent");
            xb_add(&bar[XB_XGEN(b.x)], 1u);
            asm volatile("s_waitcnt vmcnt(0)" ::: "memory");
        } else {
            XB_SPIN(xb_ld(&bar[XB_XGEN(b.x)]) == gen, bar);
            __builtin_amdgcn_fence(__ATOMIC_ACQUIRE, "agent");
            asm volatile("s_waitcnt vmcnt(0)" ::: "memory");
        }
    }
    __syncthreads();
}

struct Args { const float* in[23]; float* out; unsigned char* ws; int ph_lo, ph_hi; };
static_assert(sizeof(Args) == 23 * 8 + 8 + 8 + 8, "Args has no padding");
typedef const __attribute__((address_space(4))) Args* KArgs;
__device__ __forceinline__ KArgs kargs() { KArgs p = (KArgs)__builtin_amdgcn_kernarg_segment_ptr(); asm volatile("" : "+s"(p)); return p; }

__device__ __forceinline__ void transpose_item(const float* src, int ldn, int k0, int n0, bf16_t* dst, int ldk, const float* kscale, const float* nscale, int lane, bool perm = false) {
    const int r4 = lane >> 4, q = lane & 15, rq = perm ? 32 * (q >> 2) + 8 * (q & 3) : 4 * q;
    f32x4 v[16];
    const float* sp = src + (size_t)(k0 + 16 * r4) * ldn + n0 + 4 * q;
#pragma unroll
    for (int i = 0; i < 16; ++i) v[i] = __builtin_nontemporal_load((const f32x4*)(sp + (size_t)i * ldn));
    f32x4 ns = (f32x4){1.f, 1.f, 1.f, 1.f}; if (nscale) ns = *(const f32x4*)(nscale + n0 + 4 * q);
    if (kscale) {
        const f32x4* kp = (const f32x4*)(kscale + k0 + 16 * r4);
#pragma unroll
        for (int g = 0; g < 4; ++g) { const f32x4 ks = kp[g];
#pragma unroll
            for (int j = 0; j < 4; ++j) v[4 * g + j] = v[4 * g + j] * ks[j]; }
    }
#pragma unroll
    for (int e = 0; e < 4; ++e) { u32x4 lo, hi;
#pragma unroll
        for (int w = 0; w < 4; ++w) { lo[w] = pk_bf16(v[2 * w][e] * ns[e], v[2 * w + 1][e] * ns[e]); hi[w] = pk_bf16(v[8 + 2 * w][e] * ns[e], v[9 + 2 * w][e] * ns[e]); }
        bf16_t* o = dst + (size_t)(rq + e) * ldk + k0 + 16 * r4; *(u32x4*)o = lo; *(u32x4*)(o + 8) = hi; }
}
__device__ __forceinline__ void transpose_item_f8(const float* src, int ldn, int k0, int n0, unsigned char* dst, int ldk, const float* kscale, float mul, int lane) {
    const int r4 = lane >> 4, q = lane & 15;
    f32x4 v[16];
    const float* sp = src + (size_t)(k0 + 16 * r4) * ldn + n0 + 4 * q;
#pragma unroll
    for (int i = 0; i < 16; ++i) v[i] = __builtin_nontemporal_load((const f32x4*)(sp + (size_t)i * ldn));
    {
        const f32x4* kp = (const f32x4*)(kscale + k0 + 16 * r4);
#pragma unroll
        for (int g = 0; g < 4; ++g) { f32x4 ks = (f32x4){mul, mul, mul, mul}; if (kscale) ks = kp[g] * mul;
#pragma unroll
            for (int j = 0; j < 4; ++j) v[4 * g + j] = v[4 * g + j] * ks[j]; }
    }
#pragma unroll
    for (int e = 0; e < 4; ++e) { u32x4 o;
#pragma unroll
        for (int w = 0; w < 4; ++w) o[w] = pk_fp8x4((f32x4){v[4 * w][e], v[4 * w + 1][e], v[4 * w + 2][e], v[4 * w + 3][e]});
        *(u32x4*)(dst + (size_t)(4 * q + e) * ldk + k0 + 16 * r4) = o; }
}
__device__ __forceinline__ int win_row(int n0) {
    const int seg = n0 >> 10, c = n0 & 1023;
    if (seg == 1 || seg == 2) return 1024 + (c >> 7) * 256 + (seg == 2 ? 128 : 0) + (c & 127);
    if (seg == 3 || seg == 4) return 3072 + (c >> 7) * 256 + (seg == 4 ? 128 : 0) + (c & 127);
    return n0;
}
__device__ __forceinline__ int pair_row(int f, int second) { return (f >> 7) * 256 + (second ? 128 : 0) + (f & 127); }

__device__ __forceinline__ void prologue_phase(KArgs a, LAS unsigned char* lds, int wid, int lane) {
    asm volatile("" : "+v"(lane));
    const int gw = blockIdx.x * 8 + wid, NGW = gridDim.x * 8;
    unsigned char* ws = a->ws;
    constexpr int I_WIN = 16 * 144, I_SQ = 16 * 16, I_PW = 16, I_D1 = 16 * 56, I_D2 = 56 * 16;
    constexpr int NIT = 2 * I_WIN + 8 * I_SQ + 8 * I_PW + 2 * I_D1 + I_D2;
    for (int it = gw; it < NIT; it += NGW) {
        int r = it;
        if (r < 2 * I_WIN) { const int L = r / I_WIN; r -= L * I_WIN; const int kb = r / 144, nb = r % 144, n0 = 64 * nb;
            if (n0 >= 6144 || (n0 >= 3072 && n0 < 5120)) transpose_item_f8(a->in[2] + (size_t)L * D * INC, INC, 64 * kb, n0, ws + WS_WG8 + (size_t)L * 5 * MiB + (size_t)(n0 >= 6144 ? 2048 + (n0 - 6144) : win_row(n0) - 3072) * D, D, a->in[1] + L * D, F8_W13_MUL, lane);
            else { const int ty = n0 < 3072 ? n0 >> 10 : 3, T = (n0 & 1023) >> 6;
                transpose_item(a->in[2] + (size_t)L * D * INC, INC, 64 * kb, n0, (bf16_t*)(ws + WS_W0 + W0_WIN + (size_t)L * 18 * MiB) + (size_t)(256 * T + 128 * (ty >> 1) + 4 * (ty & 1)) * D, D, a->in[1] + L * D, nullptr, lane, true); }
            continue; }
        r -= 2 * I_WIN;
        if (r < 8 * I_SQ) { const int j = r / I_SQ; r -= j * I_SQ; const int L = j >> 2, w = j & 3, kb = r / 16, nb = r % 16, n0 = 64 * nb;
            bf16_t* dst = w < 3 ? (bf16_t*)(ws + WS_W0 + W0_WOUT + (size_t)(L * 3 + w) * 2 * MiB) : (bf16_t*)(ws + WS_W0 + W0_WO + (size_t)L * 2 * MiB);
            transpose_item(a->in[10 + w] + (size_t)L * D * D, D, 64 * kb, n0, dst + (size_t)n0 * D, D, nullptr, nullptr, lane); continue; }
        r -= 8 * I_SQ;
        if (r < 8 * I_PW) { const int j = r / I_PW; r -= j * I_PW; const int L = j >> 2, g = j & 3;
            const float* src = a->in[8] + (size_t)(L * 4 + g) * 65536 + (size_t)r * 16 * 256; const float* sc = a->in[9] + L * D + g * 256;
            bf16_t* dst = (bf16_t*)(ws + WS_W0 + W0_POOL + (size_t)L * 512 * 1024) + (size_t)g * 65536 + (size_t)r * 16 * 256; const f32x4 s4 = *(const f32x4*)(sc + 4 * lane);
#pragma unroll
            for (int i = 0; i < 16; ++i) { const f32x4 v = *(const f32x4*)(src + i * 256 + 4 * lane) * s4; u32x2 w; w.x = pk_bf16(v[0], v[1]); w.y = pk_bf16(v[2], v[3]); *(u32x2*)(dst + i * 256 + 4 * lane) = w; }
            continue; }
        r -= 8 * I_PW;
        if (r < 2 * I_D1) { const int w = r / I_D1; r -= w * I_D1; const int kb = r / 56, nb = r % 56, n0 = 64 * nb;
            transpose_item(a->in[15 + w], DFF, 64 * kb, n0, (bf16_t*)(ws + WS_W0 + W0_D13) + (size_t)pair_row(n0, w) * D, D, a->in[14], nullptr, lane); continue; }
        r -= 2 * I_D1;
        { const int kb = r / 16, nb = r % 16, n0 = 64 * nb;
            transpose_item(a->in[17], D, 64 * kb, n0, (bf16_t*)(ws + WS_W0 + W0_D2) + (size_t)n0 * DFF, DFF, nullptr, nullptr, lane); }
    }
    const float* x = a->in[0]; bf16_t* xb = (bf16_t*)(ws + WS_XB); f32x4* ss0 = (f32x4*)(ws + WS_SS); unsigned char* x8 = ws + WS_X8;
    for (int m = gw; m < M; m += NGW) {
        const f32x4* xr = (const f32x4*)(x + (size_t)m * D) + lane; u32x2* o = (u32x2*)(xb + (size_t)m * D) + lane; float s = 0.f;
#pragma unroll
        for (int j = 0; j < 4; ++j) { const f32x4 v = xr[64 * j]; s += (v[0] * v[0] + v[1] * v[1]) + (v[2] * v[2] + v[3] * v[3]); u32x2 w; w.x = pk_bf16(v[0], v[1]); w.y = pk_bf16(v[2], v[3]); o[64 * j] = w;
            *((unsigned*)(x8 + (size_t)m * D) + lane + 64 * j) = pk_fp8x4(v); }
        s = wave_sum(s); if (lane == 0) ss0[m] = (f32x4){s, 0.f, 0.f, 0.f};
    }
}

__device__ __forceinline__ void dma_block16(const bf16_t* src, LAS unsigned char* dst, int wid, int lane) {
#pragma unroll
    for (int k = 0; k < 4; ++k) { const int h = wid * 4 + k;
        __builtin_amdgcn_global_load_lds((const unsigned*)((const char*)src + h * 1024 + lane * 16), (LAS unsigned*)(dst + h * 1024), 16, 0, 0); }
}
__device__ __forceinline__ void zero_block16(LAS unsigned char* dst, int tid) {
#pragma unroll
    for (int k = 0; k < 4; ++k) *(LAS u32x4*)(dst + (size_t)(tid + 512 * k) * 16) = (u32x4){0u, 0u, 0u, 0u};
}
template <int I> __device__ __forceinline__ void conv31_pair(const LAS unsigned char* col, const unsigned (&wp)[31], f32x2 bias, f32x2 (&acc)[16]) {
    f32x2 x[46];
#pragma unroll
    for (int i = 0; i < 46; ++i) { const int r = i - 30, j = I + (r >> 4); const unsigned u = *(const LAS unsigned*)(col + ((j + 2) & 3) * 32768 + (r & 15) * 2048); x[i] = (f32x2){bf_lo(u), bf_hi(u)}; }
#pragma unroll
    for (int j = 0; j < 16; ++j) acc[j] = bias;
#pragma unroll
    for (int k = 0; k < 31; ++k) { const f32x2 wk = (f32x2){bf_lo(wp[k]), bf_hi(wp[k])};
#pragma unroll
        for (int j = 0; j < 16; ++j) acc[j] = __builtin_elementwise_fma(wk, x[j + k], acc[j]); }
}
template <int I, int CH> __device__ __forceinline__ void pool_ch(const LAS unsigned char* col, int g, int s0, float (&p)[16]) {
    float x[31], tv[16];
#pragma unroll
    for (int i = 0; i < 31; ++i) { const int r = i - 15, j = I + (r >> 4); const unsigned u = *(const LAS unsigned*)(col + ((j + 1) % 3) * 32768 + (r & 15) * 2048); x[i] = CH ? bf_hi(u) : bf_lo(u); }
#pragma unroll
    for (int j = 0; j < 16; ++j) tv[j] = x[15 + j];
#pragma unroll
    for (int i = 30; i >= 1; --i) x[i] += x[i - 1];
    if (g >= 1) {
#pragma unroll
        for (int i = 30; i >= 2; --i) x[i] += x[i - 2]; }
    if (g >= 2) {
#pragma unroll
        for (int i = 30; i >= 4; --i) x[i] += x[i - 4]; }
    if (g >= 3) {
#pragma unroll
        for (int i = 30; i >= 8; --i) x[i] += x[i - 8]; }
    const int w = 2 << g;
#pragma unroll
    for (int j = 0; j < 16; ++j) { const int cnt = min(s0 + j + 1, w); p[j] = x[15 + j] * (1.0f / (float)cnt) - tv[j]; }
}
struct ConvB { const bf16_t* GLU; __amdgpu_buffer_rsrc_t rVB; LAS unsigned char* lds; LAS float* red; LAS float* stat; f32x2 bb, gg, be; };
template <int I> __device__ __forceinline__ void convB_tile(const ConvB& c, unsigned (&wp)[31], int T0, int tid, int wid, int lane) {
    const int t0 = T0 + 16 * I; const LAS unsigned char* col = c.lds + 4 * tid;
#pragma unroll
    for (int k = 0; k < 31; ++k) asm volatile("" : "+v"(wp[k]));
    if (I < 3) dma_block16(c.GLU + (size_t)(t0 + 16) * D, c.lds + ((I + 3) & 3) * 32768, wid, lane);
    float a0[16], a1[16];
    { f32x2 ap[16]; conv31_pair<I>(col, wp, c.bb, ap);
#pragma unroll
      for (int j = 0; j < 16; ++j) { a0[j] = ap[j].x; a1[j] = ap[j].y; } }
    {
        float v[32];
#pragma unroll
        for (int j = 0; j < 16; ++j) { v[j] = a0[j] + a1[j]; v[16 + j] = a0[j] * a0[j] + a1[j] * a1[j]; }
#pragma unroll
        for (int i = 0; i < 16; ++i) { const bool b = lane & 32; const float send = b ? v[i] : v[i + 16], keep = b ? v[i + 16] : v[i]; v[i] = keep + __shfl_xor(send, 32); }
#pragma unroll
        for (int i = 0; i < 8; ++i) { const bool b = lane & 16; const float send = b ? v[i] : v[i + 8], keep = b ? v[i + 8] : v[i]; v[i] = keep + __shfl_xor(send, 16); }
#pragma unroll
        for (int i = 0; i < 4; ++i) { const bool b = lane & 8; const float send = b ? v[i] : v[i + 4], keep = b ? v[i + 4] : v[i]; v[i] = keep + __shfl_xor(send, 8); }
#pragma unroll
        for (int i = 0; i < 2; ++i) { const bool b = lane & 4; const float send = b ? v[i] : v[i + 2], keep = b ? v[i + 2] : v[i]; v[i] = keep + __shfl_xor(send, 4); }
        { const bool b = lane & 2; const float send = b ? v[0] : v[1], keep = b ? v[1] : v[0]; v[0] = keep + __shfl_xor(send, 2); }
        v[0] += __shfl_xor(v[0], 1);
        const int idx = ((lane >> 5) & 1) * 16 + ((lane >> 4) & 1) * 8 + ((lane >> 3) & 1) * 4 + ((lane >> 2) & 1) * 2 + ((lane >> 1) & 1);
        if (!(lane & 1)) c.red[wid * 32 + idx] = v[0];
    }
    __syncthreads();
    if (tid < 16) { float s = 0.f, q = 0.f;
#pragma unroll
        for (int w = 0; w < 8; ++w) { s += c.red[w * 32 + tid]; q += c.red[w * 32 + 16 + tid]; }
        const float mean = s * (1.0f / D), var = fmaxf(q * (1.0f / D) - mean * mean, 0.f);
        c.stat[2 * tid] = mean; c.stat[2 * tid + 1] = __builtin_amdgcn_rsqf(var + LN_EPS); }
    asm volatile("s_waitcnt vmcnt(0)" ::: "memory");
    __syncthreads();
#pragma unroll
    for (int j = 0; j < 16; ++j) { const float mean = c.stat[2 * j], rstd = c.stat[2 * j + 1];
        const float y0 = (a0[j] - mean) * rstd * c.gg.x + c.be.x, y1 = (a1[j] - mean) * rstd * c.gg.y + c.be.y;
        __builtin_amdgcn_raw_buffer_store_b32(pk_bf16(y0 * sigm(y0), y1 * sigm(y1)), c.rVB, 4 * tid, (t0 + j) * (D * 2), 0); }
}
struct ConvAC { const bf16_t* PU; __amdgpu_buffer_rsrc_t rPP; LAS unsigned char* lds; };
__device__ __forceinline__ void conv_phase(KArgs a, int layer, LAS unsigned char* lds, int tid, int wid, int lane) {
    asm volatile("" : "+v"(tid), "+v"(lane));
    unsigned char* ws = a->ws;
    const int G = gridDim.x;
    const int vcu = (G % 8 == 0) ? (int)(blockIdx.x % 8) * (G / 8) + (int)(blockIdx.x / 8) : (int)blockIdx.x;
    const int c2 = 2 * tid;
    {
        const float* cfw = a->in[4] + layer * 31 * D; const float* cfb = a->in[5] + layer * D; const float* lng = a->in[6] + layer * D; const float* lnb = a->in[7] + layer * D;
        ConvB c; c.GLU = (const bf16_t*)(ws + A_GLU); c.rVB = __builtin_amdgcn_make_buffer_rsrc((void*)(ws + A_VB), 0, 0x7fffffff, 0x00020000);
        c.lds = lds; c.red = (LAS float*)(lds + RED_OFF); c.stat = c.red + 256;
        unsigned wp[31];
#pragma unroll
        for (int k = 0; k < 31; ++k) { const f32x2 w = *(const f32x2*)(cfw + k * D + c2); wp[k] = pk_bf16(w.x, w.y); }
        c.bb = *(const f32x2*)(cfb + c2); c.gg = *(const f32x2*)(lng + c2); c.be = *(const f32x2*)(lnb + c2);
        asm volatile("" :: "v"(c.bb.x), "v"(c.bb.y), "v"(c.gg.x), "v"(c.gg.y), "v"(c.be.x), "v"(c.be.y));
        for (int rp2 = 0; rp2 < REPS2(21); ++rp2)
        for (int sup = vcu; sup < M / 64; sup += G) {
            const int T0 = sup * 64; const bool seq0 = (T0 & (SEQ - 1)) == 0;
            if (seq0) { zero_block16(lds, tid); zero_block16(lds + 32768, tid); } else { dma_block16(c.GLU + (size_t)(T0 - 32) * D, lds, wid, lane); dma_block16(c.GLU + (size_t)(T0 - 16) * D, lds + 32768, wid, lane); }
            dma_block16(c.GLU + (size_t)T0 * D, lds + 65536, wid, lane);
            asm volatile("s_waitcnt vmcnt(0)" ::: "memory");
            __syncthreads();
            convB_tile<0>(c, wp, T0, tid, wid, lane); convB_tile<1>(c, wp, T0, tid, wid, lane); convB_tile<2>(c, wp, T0, tid, wid, lane); convB_tile<3>(c, wp, T0, tid, wid, lane);
            __syncthreads();
        }
    }
    __syncthreads();
    if (blockIdx.x < M / 256) {
        int pm_ = blockIdx.x; asm volatile("" : "+s"(pm_));
        const int pm = pm_, T0 = pm * 256, s0 = T0 & (SEQ - 1); const bool seq0 = s0 == 0;
        const float* scw = a->in[3] + layer * 3 * D; const float* halo = (const float*)(ws + WS_HALO); bf16_t* YA = (bf16_t*)(ws + A_YA);
        ConvAC c; c.PU = (const bf16_t*)(ws + A_PU); c.lds = lds;
        c.rPP = __builtin_amdgcn_make_buffer_rsrc((void*)(ws + A_PP), 0, 0x7fffffff, 0x00020000);
        if (seq0) zero_block16(lds, tid); else dma_block16(c.PU + (size_t)(T0 - 16) * D, lds, wid, lane);
        dma_block16(c.PU + (size_t)T0 * D, lds + 32768, wid, lane);
        {   const f32x2 s0w = *(const f32x2*)(scw + c2), s1w = *(const f32x2*)(scw + D + c2), s2w = *(const f32x2*)(scw + 2 * D + c2);
            const f32x2 b0 = *(const f32x2*)(halo + (size_t)((0 * 64 + pm) * 2 + 0) * D + c2), b1 = *(const f32x2*)(halo + (size_t)((0 * 64 + pm) * 2 + 1) * D + c2);
            const f32x2 q0 = *(const f32x2*)(halo + (size_t)((1 * 64 + pm) * 2 + 0) * D + c2), q1 = *(const f32x2*)(halo + (size_t)((1 * 64 + pm) * 2 + 1) * D + c2);
            f32x2 pa = (f32x2){0.f, 0.f}, pb = pa;
            if (!seq0) { pa = *(const f32x2*)(halo + (size_t)((2 * 64 + pm - 1) * 2 + 0) * D + c2); pb = *(const f32x2*)(halo + (size_t)((2 * 64 + pm - 1) * 2 + 1) * D + c2); }
            const f32x2 y0 = b0 * (s0w * pa + s1w * pb + s2w * q0), y1 = b1 * (s0w * pb + s1w * q0 + s2w * q1);
            *(unsigned*)(YA + (size_t)T0 * D + c2) = pk_bf16(y0.x, y0.y); *(unsigned*)(YA + (size_t)(T0 + 1) * D + c2) = pk_bf16(y1.x, y1.y); }
        asm volatile("s_waitcnt vmcnt(0)" ::: "memory");
        __syncthreads();
        {
            const LAS unsigned char* col = lds + 4 * tid;
            float p0[16], p1[16];
            pool_ch<0, 0>(col, wid >> 1, s0, p0);
#pragma unroll
            for (int j = 0; j < 16; ++j) asm volatile("" : "+v"(p0[j]) :: "memory");
            pool_ch<0, 1>(col, wid >> 1, s0, p1);
#pragma unroll
            for (int j = 0; j < 16; ++j) __builtin_amdgcn_raw_buffer_store_b32(pk_bf16(p0[j], p1[j]), c.rPP, 4 * tid, (T0 + j) * (D * 2), 0);
        }
        __syncthreads();
    }
}

__device__ __forceinline__ void route_phase(KArgs a, LAS unsigned char* lds, int tid, int wid, int lane) {
    asm volatile("" : "+v"(tid), "+v"(lane));
    unsigned char* ws = a->ws;
    const bf16_t* X = (const bf16_t*)(ws + WS_XB); const float* gn = a->in[14] + D; const float* R = a->in[18];
    const f32x4* ss3 = (const f32x4*)(ws + WS_SS) + 3 * M;
    int* tope = (int*)(ws + WS_SMALL + SM_TOPE); f32x2* topp = (f32x2*)(ws + WS_SMALL + SM_TOPP); int* cntb = (int*)(ws + WS_CTL + CTL_CNT);
    LAS int* lcnt = (LAS int*)(lds + 98304);
    float wgt[2][8][8];
#pragma unroll
    for (int h = 0; h < 2; ++h)
#pragma unroll
        for (int i = 0; i < 8; ++i) { const int k = 8 * lane + 512 * h + i; const float g = gn[k]; const f32x4 r0 = *(const f32x4*)(R + k * 8), r1 = *(const f32x4*)(R + k * 8 + 4);
#pragma unroll
            for (int e = 0; e < 4; ++e) { wgt[h][i][e] = g * r0[e]; wgt[h][i][4 + e] = g * r1[e]; } }
    for (int vb = blockIdx.x; vb < 256; vb += gridDim.x) {
        if (tid < 8) lcnt[tid] = 0;
        __syncthreads();
        for (int i8 = 0; i8 < 8; ++i8) {
            const int t = vb * 64 + wid * 8 + i8;
            float lg[8];
#pragma unroll
            for (int e = 0; e < 8; ++e) lg[e] = 0.f;
#pragma unroll
            for (int h = 0; h < 2; ++h) { f32x4 v0, v1; pg8::unpack8(*(const u32x4*)(X + (size_t)t * D + 512 * h + 8 * lane), v0, v1);
#pragma unroll
                for (int i = 0; i < 4; ++i)
#pragma unroll
                    for (int e = 0; e < 8; ++e) { lg[e] = fmaf(v0[i], wgt[h][i][e], lg[e]); lg[e] = fmaf(v1[i], wgt[h][4 + i][e], lg[e]); } }
#pragma unroll
            for (int e = 0; e < 8; ++e) lg[e] = wave_sum(lg[e]);
            const f32x4 sp = ss3[t]; const float rstd = __builtin_amdgcn_rsqf(((sp[0] + sp[1]) + (sp[2] + sp[3])) * (1.0f / D) + RMS_EPS);
            int e1 = 0; float v1 = lg[0];
#pragma unroll
            for (int e = 1; e < 8; ++e) if (lg[e] > v1) { v1 = lg[e]; e1 = e; }
            int e2 = e1 == 0 ? 1 : 0; float v2 = -__builtin_inff();
#pragma unroll
            for (int e = 0; e < 8; ++e) if (e != e1 && lg[e] > v2) { v2 = lg[e]; e2 = e; }
            const float ex = __expf((v2 - v1) * rstd), p1 = 1.0f / (1.0f + ex), p2 = ex * p1;
            if (lane == 0) { tope[t] = e1 | (e2 << 8); topp[t] = (f32x2){p1, p2}; atomicAdd((int*)&lcnt[e1], 1); atomicAdd((int*)&lcnt[e2], 1); }
        }
        __syncthreads();
        if (tid < 8) cntb[vb * 8 + tid] = lcnt[tid];
        __syncthreads();
    }
    const int gw = blockIdx.x * 8 + wid, NGW = gridDim.x * 8;
    constexpr int I_1 = 16 * 56, I_13 = 2 * I_1, I_2 = 56 * 16;
    unsigned char* w13 = ws + WS_WMOE; unsigned char* w2t = ws + WS_WMOE + WMOE_W2;
    for (int it = gw; it < NE * (I_13 + I_2); it += NGW) {
        int r = it;
        if (r < NE * I_13) { const int e = r / I_13; r -= e * I_13; const int w = r / I_1; r -= w * I_1; const int kb = r / 56, nb = r % 56, n0 = 64 * nb;
            transpose_item_f8(a->in[19 + w] + (size_t)e * D * DFF, DFF, 64 * kb, n0, w13 + (size_t)e * (2 * DFF) * D + (size_t)pair_row(n0, w) * D, D, gn, F8_W13_MUL, lane); continue; }
        r -= NE * I_13;
        { const int e = r / I_2; r -= e * I_2; const int kb = r / 16, nb = r % 16, n0 = 64 * nb;
            transpose_item_f8(a->in[21] + (size_t)e * DFF * D, D, 64 * kb, n0, w2t + (size_t)e * D * DFF + (size_t)n0 * DFF, DFF, nullptr, F8_W2_MUL, lane); }
    }
}

__device__ __forceinline__ void scatter_phase(KArgs a, LAS unsigned char* lds, int tid, int wid, int lane) {
    asm volatile("" : "+v"(tid), "+v"(lane));
    unsigned char* ws = a->ws;
    const int* tope = (const int*)(ws + WS_SMALL + SM_TOPE); int* tslot = (int*)(ws + WS_SMALL + SM_TSLOT); float* ssperm = (float*)(ws + WS_SMALL + SM_SSPERM); int* meta = (int*)(ws + WS_SMALL + SM_META);
    const int* cntb = (const int*)(ws + WS_CTL + CTL_CNT); const f32x4* ss3 = (const f32x4*)(ws + WS_SS) + 3 * M;
    const bf16_t* X = (const bf16_t*)(ws + WS_XB); unsigned char* AP = ws + WS_APERM;
    LAS int* lc = (LAS int*)lds;
    LAS int* lbase = lc + 2048;
    LAS int* lslot = lc + 2064;
    LAS int* ltot = lc + 2200;
    for (int i = tid; i < 2048; i += 512) lc[i] = __hip_atomic_load(cntb + i, __ATOMIC_RELAXED, __HIP_MEMORY_SCOPE_AGENT);
    __syncthreads();
    for (int vb = blockIdx.x; vb < 256; vb += gridDim.x) {
        if (tid < 8) { int tot = 0, pre = 0;
#pragma unroll 8
            for (int b = 0; b < 256; ++b) { const int v = lc[b * 8 + tid]; tot += v; pre += (b < vb) ? v : 0; }
            ltot[tid] = tot; lbase[tid] = pre; }
        __syncthreads();
        if (tid == 0) { int off = 0;
            for (int e = 0; e < 8; ++e) { lbase[e] += off; if (vb == 0) meta[e] = off >> 8; off += (ltot[e] + 255) & ~255; }
            if (vb == 0) meta[8] = off >> 8; }
        __syncthreads();
        if (wid == 0) {
            const int t = vb * 64 + lane; const int te = tope[t]; const int e1 = te & 0xff, e2 = (te >> 8) & 0xff;
            int s1 = 0, s2 = 0;
#pragma unroll
            for (int k = 0; k < 2; ++k) { const int ek = k ? e2 : e1; int sk = 0;
#pragma unroll
                for (int e = 0; e < 8; ++e) { const unsigned long long mask = __ballot(ek == e); const int base = lbase[e]; LDS_WAIT();
                    const int rank = __popcll(mask & ((1ull << lane) - 1ull)); if (ek == e) sk = base + rank;
                    if (lane == 0) lbase[e] = base + __popcll(mask); LDS_WAIT(); }
                if (k) s2 = sk; else s1 = sk; }
            *(int2*)(tslot + 2 * t) = make_int2(s1, s2); lslot[lane] = s1; lslot[64 + lane] = s2;
        }
        __syncthreads();
        {
            u32x4 xv[8][2]; f32x4 sp[8];
#pragma unroll
            for (int i = 0; i < 8; ++i) { const int t = vb * 64 + wid + 8 * i; const u32x4* src = (const u32x4*)(X + (size_t)t * D) + 2 * lane; xv[i][0] = src[0]; xv[i][1] = src[1]; sp[i] = ss3[t]; }
#pragma unroll
            for (int i = 0; i < 8; ++i) { const int r = wid + 8 * i, s1 = lslot[r], s2 = lslot[64 + r];
                const float rstd = __builtin_amdgcn_rsqf(((sp[i][0] + sp[i][1]) + (sp[i][2] + sp[i][3])) * (1.0f / D) + RMS_EPS);
                f32x4 v0, v1, v2, v3; pg8::unpack8(xv[i][0], v0, v1); pg8::unpack8(xv[i][1], v2, v3);
                const u32x4 q = (u32x4){pk_fp8x4(v0 * rstd), pk_fp8x4(v1 * rstd), pk_fp8x4(v2 * rstd), pk_fp8x4(v3 * rstd)};
                *((u32x4*)(AP + (size_t)s1 * D) + lane) = q; *((u32x4*)(AP + (size_t)s2 * D) + lane) = q; } }
        __syncthreads();
    }
}

__device__ __forceinline__ void combine_phase(KArgs a, LAS unsigned char* lds, int tid, int wid, int lane) {
    asm volatile("" : "+v"(lane), "+v"(tid));
    unsigned char* ws = a->ws;
    LAS int* tmap = (LAS int*)lds; const bf16_t* YP = (const bf16_t*)(ws + WS_YP);
    int split;
    { const int nMraw = __builtin_amdgcn_readfirstlane(__hip_atomic_load((const int*)(ws + WS_SMALL + SM_META) + 8, __ATOMIC_RELAXED, __HIP_MEMORY_SCOPE_AGENT)); const int nM = nMraw > MAXSLOT / 256 ? MAXSLOT / 256 : nMraw;
      const int G = (int)gridDim.x, nU = 4 * nM, R = nU / G, tail = nU - R * G; split = (tail > 0 && pg8::MOE2_SPL * tail <= G) ? 1 : 0;
      for (int i = tid; i < 4 * (MAXSLOT / 256); i += 512) tmap[i] = -1;
      __syncthreads();
      if (split && tid < tail) { int pm, pn; if (pg8::tile_of(R * G + tid, nM, 4, pm, pn, 4)) tmap[4 * pm + pn] = tid; }
      __syncthreads(); }
    const bf16_t* X = (const bf16_t*)(ws + WS_XB); const unsigned char* Y = ws + WS_Y; const int* tslot = (const int*)(ws + WS_SMALL + SM_TSLOT); const f32x2* topp = (const f32x2*)(ws + WS_SMALL + SM_TOPP);
    const float* gf = a->in[22]; float* out = a->out;
    const int gw = blockIdx.x * 8 + wid, NGW = gridDim.x * 8;
    f32x4 gv[4];
#pragma unroll
    for (int h = 0; h < 2; ++h) { gv[2 * h] = *(const f32x4*)(gf + 512 * h + 8 * lane); gv[2 * h + 1] = *(const f32x4*)(gf + 512 * h + 8 * lane + 4); }
    for (int tb = gw; tb < M; tb += 4 * NGW) {
        int2 sl[4]; f32x2 p[4];
#pragma unroll
        for (int i = 0; i < 4; ++i) { const int t = min(tb + i * NGW, M - 1); sl[i] = *(const int2*)(tslot + 2 * t); p[i] = topp[t]; }
        u32x4 xr[4][2]; u32x2 ya[4][2], yb[4][2];
#pragma unroll
        for (int i = 0; i < 4; ++i) { const int t = min(tb + i * NGW, M - 1);
#pragma unroll
            for (int h = 0; h < 2; ++h) { const int col = 512 * h + 8 * lane;
                xr[i][h] = *(const u32x4*)(X + (size_t)t * D + col); ya[i][h] = *(const u32x2*)(Y + (size_t)sl[i].x * D + col); yb[i][h] = *(const u32x2*)(Y + (size_t)sl[i].y * D + col); } }
#pragma unroll
        for (int i = 0; i < 4; ++i) { const int t = tb + i * NGW; if (t < M) {
            f32x4 v[4]; float s = 0.f;
#pragma unroll
            for (int h = 0; h < 2; ++h) { f32x4 x0, x1; pg8::unpack8(xr[i][h], x0, x1); f32x4 a0 = pg8::un_fp8x4(ya[i][h].x) * (1.0f / F8_Y_MUL), a1 = pg8::un_fp8x4(ya[i][h].y) * (1.0f / F8_Y_MUL), b0 = pg8::un_fp8x4(yb[i][h].x) * (1.0f / F8_Y_MUL), b1 = pg8::un_fp8x4(yb[i][h].y) * (1.0f / F8_Y_MUL);
                if (split) { const int pn = 2 * h + (lane >> 5), cl = 8 * (lane & 31);
                    const int ka = tmap[4 * (sl[i].x >> 8) + pn], kb = tmap[4 * (sl[i].y >> 8) + pn];
                    if (ka >= 0) { a0 = (f32x4){0.f, 0.f, 0.f, 0.f}; a1 = a0;
                        for (int p = 0; p < pg8::MOE2_SPL; ++p) { f32x4 t0, t1; pg8::unpack8(*(const u32x4*)(YP + (size_t)(ka * pg8::MOE2_SPL + p) * 65536 + (size_t)(sl[i].x & 255) * 256 + cl), t0, t1); a0 += t0; a1 += t1; } }
                    if (kb >= 0) { b0 = (f32x4){0.f, 0.f, 0.f, 0.f}; b1 = b0;
                        for (int p = 0; p < pg8::MOE2_SPL; ++p) { f32x4 t0, t1; pg8::unpack8(*(const u32x4*)(YP + (size_t)(kb * pg8::MOE2_SPL + p) * 65536 + (size_t)(sl[i].y & 255) * 256 + cl), t0, t1); b0 += t0; b1 += t1; } } }
                v[2 * h] = x0 + a0 * p[i].x + b0 * p[i].y; v[2 * h + 1] = x1 + a1 * p[i].x + b1 * p[i].y; }
#pragma unroll
            for (int k = 0; k < 4; ++k) s += (v[k][0] * v[k][0] + v[k][1] * v[k][1]) + (v[k][2] * v[k][2] + v[k][3] * v[k][3]);
            const float rstd = __builtin_amdgcn_rsqf(wave_sum(s) * (1.0f / D) + RMS_EPS);
#pragma unroll
            for (int h = 0; h < 2; ++h) { const int col = 512 * h + 8 * lane;
                *(f32x4*)(out + (size_t)t * D + col) = v[2 * h] * rstd * gv[2 * h]; *(f32x4*)(out + (size_t)t * D + col + 4) = v[2 * h + 1] * rstd * gv[2 * h + 1]; } } }
    }
}

#ifndef WGM_INPROJ
#define WGM_INPROJ 4
#endif
#ifndef WGM_FFN1
#define WGM_FFN1 4
#endif
#ifndef WGM_MOE1
#define WGM_MOE1 4
#endif
constexpr int NPH = 18;
#ifndef MK_PH_MASK
#define MK_PH_MASK 0xFFFFFFFFu
#endif
#define PHON(bit) ((((MK_PH_MASK) >> (bit)) & 1u) != 0u)


__device__ __forceinline__ void ph_inproj(KArgs a, int layer, LAS unsigned char* lds) {
    unsigned char* ws = a->ws;
    {
        pg8::Gemm g{2 * D, 2 * D, 2 * D, 0, 0}; pg8::PlainSched S{M / 256, 16, (int)gridDim.x, (int)blockIdx.x, (const char*)(ws + WS_XB), (const char*)(ws + WS_W0 + W0_WIN + (size_t)layer * 18 * MiB), (size_t)256 * D * 2, (size_t)256 * D * 2, WGM_INPROJ, 1 << 30, 0};
        pg8::EpiSc E{(bf16_t*)(ws + A_YA), (bf16_t*)(ws + A_PP), (bf16_t*)(ws + A_PU), (const f32x4*)(ws + WS_SS) + (size_t)(layer * 2) * M, a->in[3] + layer * 3 * D, (float*)(ws + WS_HALO), (LAS float*)(lds + RED_OFF), (LAS float*)(lds + POOLX_OFF)};
        pg8::gemm_phase(lds, g, S, E);
    }
    __syncthreads();
    {
        pg8::Gemm g{D, D, D, F8_ONE, F8_W13_SC}; pg8::PlainSched S{M / 256, 20, (int)gridDim.x, (int)blockIdx.x, (const char*)(ws + WS_X8), (const char*)(ws + WS_WG8 + (size_t)layer * 5 * MiB), (size_t)256 * D, (size_t)256 * D, WGM_INPROJ, 1 << 30, 0};
        pg8::EpiProj E{(bf16_t*)(ws + A_GLU), (bf16_t*)(ws + A_GATES), (const f32x4*)(ws + WS_SS) + (size_t)(layer * 2) * M};
        pg8::gemm_phase<pg8::EpiProj, pg8::PlainSched, true>(lds, g, S, E);
    }
}
__device__ __forceinline__ void ph_fold(KArgs a, LAS unsigned char* lds) {
    unsigned char* ws = a->ws;
    pg8::Gemm g{512, 2 * D, 512, 0, 0}; pg8::FoldSched S{(int)gridDim.x, (int)blockIdx.x, (const char*)(ws + WS_W0 + W0_WOUT + 2 * 2 * MiB), (const char*)(ws + WS_W0 + W0_POOL)};
    pg8::EpiPlain E{(bf16_t*)(ws + WS_WC), D, (size_t)D * D};
    pg8::gemm_phase(lds, g, S, E);
}
__device__ __forceinline__ void ph_merge(KArgs a, int layer, LAS unsigned char* lds) {
    unsigned char* ws = a->ws;
    pg8::Gemm g{2 * D, 2 * D, 2 * D, 0, 0}; pg8::MergeSched S{(int)gridDim.x, (int)blockIdx.x, (const char*)(ws + A_YA), (const char*)(ws + WS_W0 + W0_WOUT + (size_t)(layer * 3) * 2 * MiB), (const char*)(ws + WS_WC + (size_t)layer * 2 * MiB), (size_t)32 * MiB, (size_t)2 * MiB};
    pg8::EpiMerge E{(const bf16_t*)(ws + A_GATES), (bf16_t*)(ws + A_MERGED)};
    pg8::gemm_phase(lds, g, S, E);
}
__device__ __forceinline__ void ph_wo(KArgs a, int layer, LAS unsigned char* lds) {
    unsigned char* ws = a->ws;
    pg8::Gemm g{2 * D, 2 * D, 2 * D, 0, 0}; pg8::PlainSched S{M / 256, D / 256, (int)gridDim.x, (int)blockIdx.x, (const char*)(ws + A_MERGED), (const char*)(ws + WS_W0 + W0_WO + (size_t)layer * 2 * MiB), (size_t)256 * D * 2, (size_t)256 * D * 2, 4, 1 << 30, 0};
    pg8::EpiResid E{(bf16_t*)(ws + WS_XB), (float*)(ws + WS_SS) + (size_t)(layer * 2 + 1) * M * 4, (LAS float*)(lds + RED_OFF), nullptr};
    pg8::gemm_phase(lds, g, S, E);
}
__device__ __forceinline__ void ph_ffn1(KArgs a, LAS unsigned char* lds) {
    unsigned char* ws = a->ws;
    pg8::Gemm g{2 * D, 2 * D, 2 * D, 0, 0}; pg8::PlainSched S{M / 256, 2 * DFF / 256, (int)gridDim.x, (int)blockIdx.x, (const char*)(ws + WS_XB), (const char*)(ws + WS_W0 + W0_D13), (size_t)256 * D * 2, (size_t)256 * D * 2, WGM_FFN1, 1 << 30, 0};
    pg8::EpiSwiGLU<true, false> E{(bf16_t*)(ws + A_FFN), DFF, (const float*)(ws + WS_SS) + (size_t)1 * M * 4};
    pg8::gemm_phase(lds, g, S, E);
}
__device__ __forceinline__ void ph_ffn2(KArgs a, LAS unsigned char* lds) {
    unsigned char* ws = a->ws;
    pg8::Gemm g{2 * DFF, 2 * DFF, 2 * DFF, 0, 0}; pg8::PlainSched S{M / 256, D / 256, (int)gridDim.x, (int)blockIdx.x, (const char*)(ws + A_FFN), (const char*)(ws + WS_W0 + W0_D2), (size_t)256 * DFF * 2, (size_t)256 * DFF * 2, 4, 1 << 30, 0};
    pg8::EpiResid E{(bf16_t*)(ws + WS_XB), (float*)(ws + WS_SS) + (size_t)2 * M * 4, (LAS float*)(lds + RED_OFF), ws + WS_X8};
    pg8::gemm_phase(lds, g, S, E);
}
__device__ __forceinline__ void ph_moe(KArgs a, int which, LAS unsigned char* lds) {
    unsigned char* ws = a->ws;
    const int* meta = (const int*)(ws + WS_SMALL + SM_META); int o[9];
#pragma unroll
    for (int e = 0; e < 9; ++e) o[e] = __builtin_amdgcn_readfirstlane(__hip_atomic_load(meta + e, __ATOMIC_RELAXED, __HIP_MEMORY_SCOPE_AGENT));
    const int nM = o[8] > MAXSLOT / 256 ? MAXSLOT / 256 : o[8];
    if (which == 0) {
        pg8::Gemm g{D, D, D, F8_ONE, F8_W13_SC}; pg8::GroupSched S{nM, 2 * DFF / 256, (int)gridDim.x, (int)blockIdx.x, o[1], o[2], o[3], o[4], o[5], o[6], o[7], (const char*)(ws + WS_APERM), (const char*)(ws + WS_WMOE), (size_t)256 * D, (size_t)256 * D, (size_t)2 * DFF * D, WGM_MOE1};
        pg8::EpiSwiGLU<false, true> E{(bf16_t*)(ws + WS_ACTP), DFF, nullptr};
        pg8::gemm_phase<pg8::EpiSwiGLU<false, true>, pg8::GroupSched, true>(lds, g, S, E);
    } else {
        const int G = (int)gridDim.x, nU = 4 * nM, R = nU / G, tail = nU - R * G, split = (tail > 0 && pg8::MOE2_SPL * tail <= G) ? 1 : 0;
        pg8::Gemm g{DFF, DFF, DFF, F8_ACT_SC, F8_W2_SC}; pg8::Moe2Sched S{nM, G, (int)blockIdx.x, R, tail, split, o[1], o[2], o[3], o[4], o[5], o[6], o[7], (const char*)(ws + WS_ACTP), (const char*)(ws + WS_WMOE + WMOE_W2), (size_t)256 * DFF, (size_t)256 * DFF, (size_t)D * DFF};
        pg8::EpiMoe2 E{ws + WS_Y, (bf16_t*)(ws + WS_YP)};
        pg8::gemm_phase<pg8::EpiMoe2, pg8::Moe2Sched, true>(lds, g, S, E);
    }
}

__global__ void __launch_bounds__(512, 2) fwd(Args unused_args_read_through_kargs) {
    extern __shared__ __attribute__((aligned(16))) unsigned char lds_raw[];
    LAS unsigned char* lds = (LAS unsigned char*)lds_raw;
    volatile LAS unsigned* MISC = (volatile LAS unsigned*)(lds + MISC_OFF);
    const int tid = threadIdx.x, lane = tid & 63, wid = __builtin_amdgcn_readfirstlane(tid >> 6);
    if (tid < 64) MISC[tid] = 0u;
    __syncthreads();
    int lo, hi; XcdBarrier bar;
    { KArgs a = kargs(); lo = a->ph_lo; hi = a->ph_hi; unsigned* bw = (unsigned*)(a->ws + WS_CTL + CTL_BAR); bar.bar = bw; bar.x = 0; bar.st = nullptr; if (hi - lo > 1) bar = xcd_barrier_post(bw, MISC + 8); }
#define IN(k) (lo <= (k) && (k) < hi)
#define SEAM(k) do { if (IN(k) && IN((k) + 1)) xcd_barrier(bar); } while (0)

    if (PHON(0) && IN(0)) { for (int rp = 0; rp < REPS(0); ++rp) { prologue_phase(kargs(), lds, wid, lane); __syncthreads(); } } SEAM(0);
#pragma nounroll
    for (int layer = 0; layer < 2; ++layer) {
        const int pb = 1 + 7 * layer;
        if (PHON(1) && IN(pb + 0)) { for (int rp = 0; rp < REPS(1); ++rp) { if (layer == 0) { ph_fold(kargs(), lds); __syncthreads(); } ph_inproj(kargs(), layer, lds); __syncthreads(); } } SEAM(pb + 0);
        if (PHON(2) && IN(pb + 1)) { for (int rp = 0; rp < REPS(2); ++rp) { conv_phase(kargs(), layer, lds, tid, wid, lane); __syncthreads(); } } SEAM(pb + 1);
        if (PHON(4) && IN(pb + 3)) { for (int rp = 0; rp < REPS(4); ++rp) { ph_merge(kargs(), layer, lds); __syncthreads(); } } SEAM(pb + 3);
        if (PHON(5) && IN(pb + 4)) { for (int rp = 0; rp < (layer == 0 ? REPS(5) : 1); ++rp) { ph_wo(kargs(), layer, lds); __syncthreads(); } } SEAM(pb + 4);
        if (layer == 0) {
            if (PHON(6) && IN(6)) { for (int rp = 0; rp < REPS(6); ++rp) { ph_ffn1(kargs(), lds); __syncthreads(); } } SEAM(6);
            if (PHON(7) && IN(7)) { ph_ffn2(kargs(), lds); } SEAM(7);
        }
    }
    if (PHON(13) && IN(13)) { for (int rp = 0; rp < REPS(13); ++rp) { route_phase(kargs(), lds, tid, wid, lane); __syncthreads(); } } SEAM(13);
    if (PHON(14) && IN(14)) { for (int rp = 0; rp < REPS(14); ++rp) { scatter_phase(kargs(), lds, tid, wid, lane); __syncthreads(); } } SEAM(14);
    if (PHON(15) && IN(15)) { for (int rp = 0; rp < REPS(15); ++rp) { ph_moe(kargs(), 0, lds); __syncthreads(); } } SEAM(15);
    if (PHON(16) && IN(16)) { for (int rp = 0; rp < REPS(16); ++rp) { ph_moe(kargs(), 1, lds); __syncthreads(); } } SEAM(16);
    if (PHON(17) && IN(17)) { for (int rp = 0; rp < REPS(17); ++rp) { combine_phase(kargs(), lds, tid, wid, lane); __syncthreads(); } }
#undef IN
#undef SEAM
}

extern "C" void kernel_launch(void* const* d_in, const int* in_sizes, int n_in, void* d_out, int out_size, void* d_ws, size_t ws_size, hipStream_t stream) {
    static int grid = 0;
    if (grid == 0) {
        if (n_in != 23 || in_sizes[0] != M * D || out_size != M * D || ws_size < WS_END) { fprintf(stderr, "kernel_launch: unexpected shapes: n_in %d in0 %d out %d ws %zu (need %zu); nothing launched\n", n_in, n_in > 0 ? in_sizes[0] : -1, out_size, ws_size, (size_t)WS_END); grid = -1; return; }
        int dev = 0, cus = 0, per_cu = 0;
        if (hipGetDevice(&dev) != hipSuccess || hipDeviceGetAttribute(&cus, hipDeviceAttributeMultiprocessorCount, dev) != hipSuccess) { fprintf(stderr, "kernel_launch: device query failed\n"); grid = -1; return; }
        if (hipFuncSetAttribute((const void*)fwd, hipFuncAttributeMaxDynamicSharedMemorySize, LDS_BYTES) != hipSuccess) { fprintf(stderr, "kernel_launch: hipFuncSetAttribute failed\n"); grid = -1; return; }
        if (hipOccupancyMaxActiveBlocksPerMultiprocessor(&per_cu, (const void*)fwd, 512, LDS_BYTES) != hipSuccess || per_cu < 1) fprintf(stderr, "kernel_launch: note: occupancy query reports %d workgroups per CU\n", per_cu);
        (void)hipGetLastError();
        grid = cus;
    }
    if (grid < 0) return;
    if (hipMemsetAsync((char*)d_ws + WS_CTL, 0, CTL_BYTES, stream) != hipSuccess) { fprintf(stderr, "kernel_launch: memset failed\n"); return; }
    Args a{};
    for (int i = 0; i < 23; ++i) a.in[i] = (const float*)d_in[i];
    a.out = (float*)d_out; a.ws = (unsigned char*)d_ws;
#if MK_PER_PHASE
    for (int ph = 0; ph < NPH; ++ph) { a.ph_lo = ph; a.ph_hi = ph + 1; hipLaunchKernelGGL(fwd, dim3(grid), dim3(512), LDS_BYTES, stream, a); }
#else
    a.ph_lo = 0; a.ph_hi = NPH; hipLaunchKernelGGL(fwd, dim3(grid), dim3(512), LDS_BYTES, stream, a);
#endif
    const hipError_t le = hipPeekAtLastError();
    if (le != hipSuccess) fprintf(stderr, "kernel_launch: launch failed: %s\n", hipGetErrorName(le));
}
```

```cpp
#include <hip/hip_runtime.h>
#include <cstdio>
#include <cstdint>

#ifndef MK_PER_PHASE
#define MK_PER_PHASE 0
#endif

#ifndef MK_REP_MASK
#define MK_REP_MASK 0u
#endif
#define REPS(bit) (1 + (int)(((MK_REP_MASK) >> (bit)) & 1u))
#define REPS2(bit) REPS(bit)

#define LAS __attribute__((address_space(3)))
typedef unsigned short bf16_t;
typedef short bf16x8 __attribute__((ext_vector_type(8)));
typedef float f32x4 __attribute__((ext_vector_type(4)));
typedef float f32x2 __attribute__((ext_vector_type(2)));
typedef unsigned u32x4 __attribute__((ext_vector_type(4)));
typedef unsigned u32x2 __attribute__((ext_vector_type(2)));

constexpr int M = 16384, D = 1024, SEQ = 8192, INC = 9216, DFF = 3584, NE = 8;
constexpr float RMS_EPS = 1e-6f, LN_EPS = 1e-5f;
constexpr int MAXSLOT = 34816;
constexpr float F8_W13_MUL = 128.f, F8_ACT_MUL = 4.f, F8_W2_MUL = 256.f, F8_Y_MUL = 32.f;
constexpr int F8_ONE = 0x7f7f7f7f, F8_W13_SC = 0x78787878  , F8_ACT_SC = 0x7d7d7d7d  , F8_W2_SC = 0x77777777  ;

constexpr size_t MiB = 1u << 20;
constexpr size_t WS_CTL = 0, CTL_BYTES = 64 * 1024;
constexpr size_t CTL_BAR = 16384;
constexpr size_t CTL_CNT = 32768;
constexpr size_t WS_SMALL = 1 * MiB;
constexpr size_t SM_TOPE = 0, SM_TOPP = 64 * 1024, SM_TSLOT = 192 * 1024, SM_SSPERM = 320 * 1024, SM_META = 512 * 1024;
constexpr size_t WS_X8 = 2 * MiB;
constexpr size_t WS_YP = 18 * MiB;
constexpr size_t WS_WG8 = 492 * MiB;
constexpr size_t WS_XB = 66 * MiB;
constexpr size_t WS_W0 = 98 * MiB;
constexpr size_t W0_WIN = 0;
constexpr size_t W0_WOUT = 36 * MiB;
constexpr size_t W0_WO = 48 * MiB;
constexpr size_t W0_POOL = 52 * MiB;
constexpr size_t W0_D13 = 53 * MiB;
constexpr size_t W0_D2 = 67 * MiB;
constexpr size_t WS_ACT = 172 * MiB;
constexpr size_t A_SCB = WS_ACT, A_SCX = WS_ACT + 32 * MiB, A_GLU = WS_ACT + 64 * MiB, A_PU = WS_ACT + 96 * MiB, A_GATES = WS_ACT + 128 * MiB,
                 A_YA = WS_ACT + 224 * MiB, A_VB = WS_ACT + 256 * MiB, A_PP = WS_ACT + 288 * MiB, A_MERGED = A_SCX, A_FFN = WS_ACT;
constexpr size_t WS_HALO = 528 * MiB;
constexpr size_t WS_WC = 524 * MiB;
constexpr size_t WS_ACTP = 98 * MiB;
constexpr size_t WS_WMOE = 304 * MiB, WMOE_W2 = 56 * MiB;
constexpr size_t WS_Y = 400 * MiB;
constexpr size_t WS_APERM = 472 * MiB;
constexpr size_t WS_SS = 540 * MiB;
constexpr size_t WS_END = 541 * MiB;

typedef __bf16 bf16x2_t __attribute__((ext_vector_type(2)));
__device__ __forceinline__ unsigned pk_bf16(float lo, float hi) { const bf16x2_t v = {(__bf16)lo, (__bf16)hi}; return __builtin_bit_cast(unsigned, v); }
__device__ __forceinline__ unsigned pk_fp8x4(const f32x4 v) {
    const float a = __builtin_amdgcn_fmed3f(v[0], -448.f, 448.f), b = __builtin_amdgcn_fmed3f(v[1], -448.f, 448.f), c = __builtin_amdgcn_fmed3f(v[2], -448.f, 448.f), d = __builtin_amdgcn_fmed3f(v[3], -448.f, 448.f);
    int w = 0; w = __builtin_amdgcn_cvt_pk_fp8_f32(a, b, w, false); w = __builtin_amdgcn_cvt_pk_fp8_f32(c, d, w, true); return (unsigned)w; }
__device__ __forceinline__ float bf_lo(unsigned u) { return __uint_as_float(u << 16); }
__device__ __forceinline__ float bf_hi(unsigned u) { return __uint_as_float(u & 0xffff0000u); }
__device__ __forceinline__ float sigm(float x) { return __builtin_amdgcn_rcpf(1.f + __builtin_amdgcn_exp2f(-1.44269504f * x)); }
constexpr float LOG2E = 1.44269504f;
__device__ __forceinline__ float sigm2(float xl) { return __builtin_amdgcn_rcpf(1.f + __builtin_amdgcn_exp2f(-xl)); }
__device__ __forceinline__ float wave_sum(float v) {
#pragma unroll
    for (int o = 1; o < 64; o <<= 1) v += __shfl_xor(v, o);
    return v;
}
#define LDS_WAIT() asm volatile("s_waitcnt lgkmcnt(0)" ::: "memory")

namespace pg8 {
constexpr int BM = 256, BK = 64, HALF = 128, HTB = HALF * BK * 2, STAGE_BYTES = 8 * HTB, NXCD = 8;
__host__ __device__ __forceinline__ int lds_byte(int r, int c) { const int st = (r >> 4) * 2 + (c >> 5), rr = r & 15, cc = c & 31, ob = rr * 64 + cc * 2; return st * 1024 + (ob ^ (((ob >> 9) & 1) << 5)); }
__host__ __device__ __forceinline__ void stage_rc(int b, int& R, int& C) { const int st = b / 1024, sb = b % 1024, swz = sb ^ (((sb >> 9) & 1) << 5); R = (st >> 1) * 16 + swz / 64; C = (st & 1) * 32 + (swz % 64) / 2; }
__host__ __device__ __forceinline__ int perm32(int rho) { const int n = rho >> 4, i = rho & 15; return 8 * (i >> 2) + 4 * n + (i & 3); }

struct Unit { int pm, pn, aux, nt; const char* A; const char* B; };
struct Gemm { int Kb, lda, ldb; int sa, sb; };

__device__ __forceinline__ bool tile_of(int L, int nM, int nN, int& pm, int& pn, int WGM = 4) {
    const int nwg = nM * nN; if (L >= nwg) return false;
    int wgid = L; { const int q = nwg / NXCD, r = nwg % NXCD, xcd = wgid % NXCD, off = wgid / NXCD; wgid = (xcd < r ? xcd * (q + 1) : r * (q + 1) + (xcd - r) * q) + off; }
    const int nig = WGM * nN, gid = wgid / nig, fm = gid * WGM, gsz = (nM - fm) < WGM ? (nM - fm) : WGM;
    pm = fm + ((wgid % nig) % gsz); pn = (wgid % nig) / gsz; return true;
}
struct PlainSched {
    int nM, nN, G, c; const char* A0; const char* B0; size_t astep, bstep; int wgm; int bsplit, badd;
    __device__ __forceinline__ bool next(int i, Unit& u) const { int pm, pn; if (!tile_of(i * G + c, nM, nN, pm, pn, wgm)) return false; u.pm = pm; u.pn = pn; u.aux = 0; u.nt = 0; u.A = A0 + (size_t)pm * astep; u.B = B0 + (size_t)(pn + (pn >= bsplit ? badd : 0)) * bstep; return true; }
};
struct PoolSched {
    int G, c; const char* A0; const char* B0;
    __device__ __forceinline__ bool next(int i, Unit& u) const { int pm, pn; if (!tile_of(i * G + c, M / 256, 4, pm, pn)) return false; u.pm = pm; u.pn = pn; u.aux = 0; u.nt = 0;
        u.A = A0 + (size_t)pm * (256 * 1024 * 2) + (size_t)pn * 512; u.B = B0 + (size_t)pn * (256 * 256 * 2); return true; }
};
struct MergeSched {
    int G, c; const char *A0, *B0, *B2; size_t astr, bstr;
    __device__ __forceinline__ bool next(int i, Unit& u) const { const int t = i / 3, b = i - 3 * t; int pm, pn; if (!tile_of(t * G + c, M / 256, 4, pm, pn)) return false; u.pm = pm; u.pn = pn; u.aux = b; u.nt = 0;
        const char* w = b == 2 ? B2 : B0 + (size_t)b * bstr;
        u.A = A0 + (size_t)b * astr + (size_t)pm * (256 * 1024 * 2); u.B = w + (size_t)pn * (256 * 1024 * 2); return true; }
};
struct FoldSched {
    int G, c; const char *A0, *B0;
    __device__ __forceinline__ bool next(int i, Unit& u) const { const int idx = i * G + c; if (idx >= 32) return false; const int L = idx >> 4, pm = (idx >> 2) & 3, g = idx & 3; u.pm = pm; u.pn = g; u.aux = L; u.nt = 0;
        u.A = A0 + (size_t)L * (6 * MiB) + (size_t)pm * (256 * 1024 * 2) + (size_t)g * 512; u.B = B0 + (size_t)L * (512 * 1024) + (size_t)g * (256 * 256 * 2); return true; }
};
struct GroupSched {
    int nM, nN, G, c; int o1, o2, o3, o4, o5, o6, o7; const char* A0; const char* B0; size_t astep, bstep, estep; int wgm;
    __device__ __forceinline__ bool next(int i, Unit& u) const { int pm, pn; if (!tile_of(i * G + c, nM, nN, pm, pn, wgm)) return false; u.pm = pm; u.pn = pn; u.aux = 0; u.nt = 0;
        const int e = (pm >= o1) + (pm >= o2) + (pm >= o3) + (pm >= o4) + (pm >= o5) + (pm >= o6) + (pm >= o7);
        u.A = A0 + (size_t)pm * astep; u.B = B0 + (size_t)e * estep + (size_t)pn * bstep; return true; }
};

constexpr int MOE2_SPL = 7, MOE2_SNT = 4;
struct Moe2Sched {
    int nM, G, c, R, tail, split; int o1, o2, o3, o4, o5, o6, o7; const char* A0; const char* B0; size_t astep, bstep, estep;
    __device__ __forceinline__ bool next(int i, Unit& u) const {
        int L = i * G + c, part = -1, sub = 0;
        if (split && i >= R) { if (i > R || c >= MOE2_SPL * tail) return false; sub = c; L = R * G + c / MOE2_SPL; part = c % MOE2_SPL; }
        int pm, pn; if (!tile_of(L, nM, 4, pm, pn, 4)) return false; u.pm = pm; u.pn = pn;
        const int e = (pm >= o1) + (pm >= o2) + (pm >= o3) + (pm >= o4) + (pm >= o5) + (pm >= o6) + (pm >= o7);
        u.A = A0 + (size_t)pm * astep; u.B = B0 + (size_t)e * estep + (size_t)pn * bstep; u.aux = 0; u.nt = 0;
        if (part >= 0) { u.A += part * (MOE2_SNT * 128); u.B += part * (MOE2_SNT * 128); u.aux = 1 + sub; u.nt = MOE2_SNT; }
        return true; }
};

typedef f32x4 Acc[2][2][4][2];
__device__ __forceinline__ u32x4 pack8(const f32x4 v0, const f32x4 v1) { u32x4 w; w.x = pk_bf16(v0[0], v0[1]); w.y = pk_bf16(v0[2], v0[3]); w.z = pk_bf16(v1[0], v1[1]); w.w = pk_bf16(v1[2], v1[3]); return w; }
__device__ __forceinline__ f32x4 sig4l(const f32x4 v) { f32x4 r; r[0] = sigm2(v[0]); r[1] = sigm2(v[1]); r[2] = sigm2(v[2]); r[3] = sigm2(v[3]); return r; }
__device__ __forceinline__ void unpack8(const u32x4 g, f32x4& lo, f32x4& hi) { lo[0] = bf_lo(g.x); lo[1] = bf_hi(g.x); lo[2] = bf_lo(g.y); lo[3] = bf_hi(g.y); hi[0] = bf_lo(g.z); hi[1] = bf_hi(g.z); hi[2] = bf_lo(g.w); hi[3] = bf_hi(g.w); }

__device__ __forceinline__ size_t gate_frag(int pm, int q, int wid, int ai, int m, int lane) { return ((size_t)(((((pm * 12 + q) * 8 + wid) * 2 + ai) * 4 + m) * 64 + lane)) * 16; }
__device__ __forceinline__ unsigned pk_fp8x4_raw(const f32x4 v) { int w = 0; w = __builtin_amdgcn_cvt_pk_fp8_f32(v[0], v[1], w, false); w = __builtin_amdgcn_cvt_pk_fp8_f32(v[2], v[3], w, true); return (unsigned)w; }
__device__ __forceinline__ f32x4 un_fp8x4(unsigned w) { const f32x2 lo = __builtin_amdgcn_cvt_pk_f32_fp8((int)w, false), hi = __builtin_amdgcn_cvt_pk_f32_fp8((int)w, true); return (f32x4){lo[0], lo[1], hi[0], hi[1]}; }
struct EpiProj {
    static constexpr bool INIT = false;
    bf16_t *glu, *gates; const f32x4* ss;
    __device__ __forceinline__ bool operator()(Acc& acc, const Unit& u, int wr, int wc, int fr, int fq) const {
        const int row0 = u.pm * BM + wr * 64 + fr, pn = u.pn;
        float rs[2][4];
#pragma unroll
        for (int ai = 0; ai < 2; ++ai)
#pragma unroll
            for (int m = 0; m < 4; ++m) { const f32x4 p = ss[row0 + ai * HALF + m * 16]; rs[ai][m] = __builtin_amdgcn_rsqf(((p[0] + p[1]) + (p[2] + p[3])) * (1.0f / D) + RMS_EPS); }
        if (pn < 8) {
            const int col0 = pn * 128 + wc * 32 + 8 * fq;
#pragma unroll
            for (int ai = 0; ai < 2; ++ai)
#pragma unroll
                for (int m = 0; m < 4; ++m) { const float r = rs[ai][m];
                    const f32x4 a0 = acc[ai][0][m][0] * r, a1 = acc[ai][0][m][1] * r, b0 = sig4l(acc[ai][1][m][0] * r), b1 = sig4l(acc[ai][1][m][1] * r);
                    *(u32x4*)(glu + (size_t)(row0 + ai * HALF + m * 16) * D + col0) = pack8(a0 * b0, a1 * b1); }
        } else {
#pragma unroll
            for (int ai = 0; ai < 2; ++ai)
#pragma unroll
                for (int m = 0; m < 4; ++m) { const float r = -1.44269504f * rs[ai][m]; u32x4 w;
#pragma unroll
                    for (int bj = 0; bj < 2; ++bj) { f32x4 e0 = acc[ai][bj][m][0] * r, e1 = acc[ai][bj][m][1] * r;
#pragma unroll
                        for (int j = 0; j < 4; ++j) { e0[j] = __builtin_amdgcn_exp2f(__builtin_amdgcn_fmed3f(e0[j], -8.65617f, 8.65617f)); e1[j] = __builtin_amdgcn_exp2f(__builtin_amdgcn_fmed3f(e1[j], -8.65617f, 8.65617f)); }
                        w[2 * bj] = pk_fp8x4_raw(e0); w[2 * bj + 1] = pk_fp8x4_raw(e1); }
                    *(u32x4*)((unsigned char*)gates + gate_frag(u.pm, pn - 8, wr * 4 + wc, ai, m, fr + 16 * fq)) = w; }
        }
        return false;
    }
};
template <int CTRL> __device__ __forceinline__ float dpp_f(float old, float src) { return __int_as_float(__builtin_amdgcn_update_dpp(__float_as_int(old), __float_as_int(src), CTRL, 0xf, 0xf, false)); }
struct EpiSc {
    static constexpr bool INIT = false;
    bf16_t *ya, *pp, *pu; const f32x4* ss; const float* scw; float* halo; LAS float* ex; LAS float* px;
    __device__ __forceinline__ bool operator()(Acc& acc, const Unit& u, int wr, int wc, int fr, int fq) const {
        const int row0 = u.pm * BM + wr * 64 + fr, ch0 = u.pn * 64 + wc * 16 + fq * 4;
        const int g = __builtin_amdgcn_readfirstlane(u.pn >> 2);
#pragma unroll
        for (int ai = 0; ai < 2; ++ai)
#pragma unroll
            for (int m = 0; m < 4; ++m) { const f32x4 p = ss[row0 + ai * HALF + m * 16]; const float r = __builtin_amdgcn_rsqf(((p[0] + p[1]) + (p[2] + p[3])) * (1.0f / D) + RMS_EPS);
                acc[ai][0][m][0] = acc[ai][0][m][0] * r; acc[ai][0][m][1] = (acc[ai][0][m][1] * r) * (acc[ai][1][m][0] * r); acc[ai][1][m][1] = acc[ai][1][m][1] * r; acc[ai][1][m][0] = acc[ai][1][m][1]; }
        if (fr >= 14) {
#pragma unroll
            for (int ai = 0; ai < 2; ++ai) *(LAS f32x4*)(ex + ((((ai * 2 + wr) * 4 + wc) * 4 + fq) * 2 + (fr - 14)) * 4) = acc[ai][0][3][1];
            if (wr == 1) *(f32x4*)(halo + ((size_t)((2 * 64 + u.pm) * 2 + (fr - 14))) * D + ch0) = acc[1][0][3][1];
        }
        if (wr == 0 && fr < 2) { *(f32x4*)(halo + ((size_t)((0 * 64 + u.pm) * 2 + fr)) * D + ch0) = acc[0][0][0][0]; *(f32x4*)(halo + ((size_t)((1 * 64 + u.pm) * 2 + fr)) * D + ch0) = acc[0][0][0][1]; }
        if (wr == 0) { const f32x4 v = acc[0][1][0][1]; *(u32x2*)(pu + (size_t)row0 * D + ch0) = (u32x2){pk_bf16(v[0], v[1]), pk_bf16(v[2], v[3])}; }
        else { const f32x4 v = acc[1][1][3][1]; *(u32x2*)(pu + (size_t)(row0 + HALF + 48) * D + ch0) = (u32x2){pk_bf16(v[0], v[1]), pk_bf16(v[2], v[3])}; }
#pragma unroll
        for (int ai = 0; ai < 2; ++ai) { LAS float* eb = px + ((((ai * 2 + wr) * 4 + wc) * 4 + fq) * 15) * 4;
#define POOL_STEP(DSH, ROR, SHR) do { if (fr >= 16 - DSH) *(LAS f32x4*)(eb + (DSH - 1 + fr - (16 - DSH)) * 4) = acc[ai][1][3][0]; \
            _Pragma("unroll") for (int m = 3; m >= 0; --m) { _Pragma("unroll") for (int j = 0; j < 4; ++j) { float f = 0.f; if (m > 0) f = dpp_f<ROR>(0.f, acc[ai][1][m - 1][0][j]); acc[ai][1][m][0][j] += dpp_f<SHR>(f, acc[ai][1][m][0][j]); } } } while (0)
            POOL_STEP(1, 0x121, 0x111);
            if (g >= 1) POOL_STEP(2, 0x122, 0x112);
            if (g >= 2) POOL_STEP(4, 0x124, 0x114);
            if (g >= 3) POOL_STEP(8, 0x128, 0x118);
#undef POOL_STEP
        }
        const f32x4 w0 = *(const f32x4*)(scw + ch0), w1 = *(const f32x4*)(scw + D + ch0), w2 = *(const f32x4*)(scw + 2 * D + ch0);
        asm volatile("s_waitcnt lgkmcnt(0)" ::: "memory"); __builtin_amdgcn_s_barrier(); asm volatile("" ::: "memory");
        const float invw = 0.5f / (float)(1 << g);
#pragma unroll
        for (int ai = 0; ai < 2; ++ai) {
            f32x4 F1 = (f32x4){0.f, 0.f, 0.f, 0.f}, F2 = F1;
            if (ai + wr > 0) { const int pb = 2 * ai + wr - 1; const LAS float* e = ex + (((pb * 4 + wc) * 4 + fq) * 2) * 4; const f32x4 E0 = *(const LAS f32x4*)e, E1 = *(const LAS f32x4*)(e + 4); F1 = E1; F2 = fr == 0 ? E0 : E1;
                const LAS float* pe = px + (((pb * 4 + wc) * 4 + fq) * 15) * 4; f32x4 t = acc[ai][1][0][1];
#define POOL_REDO(DSH, SHR) do { const f32x4 f = *(const LAS f32x4*)(pe + (DSH - 1 + (fr & (DSH - 1))) * 4); _Pragma("unroll") for (int j = 0; j < 4; ++j) t[j] += dpp_f<SHR>(f[j], t[j]); } while (0)
                POOL_REDO(1, 0x111);
                if (g >= 1) POOL_REDO(2, 0x112);
                if (g >= 2) POOL_REDO(4, 0x114);
                if (g >= 3) POOL_REDO(8, 0x118);
#undef POOL_REDO
                acc[ai][1][0][0] = t; }
#pragma unroll
            for (int m = 0; m < 4; ++m) { const f32x4 pr = acc[ai][0][m][1]; f32x4 y;
                if (m > 0) { const f32x4 pv = acc[ai][0][m - 1][1];
#pragma unroll
                    for (int j = 0; j < 4; ++j) { F1[j] = dpp_f<0x121>(0.f, pv[j]); F2[j] = dpp_f<0x122>(0.f, pv[j]); } }
#pragma unroll
                for (int j = 0; j < 4; ++j) { const float p1 = dpp_f<0x111>(F1[j], pr[j]), p2 = dpp_f<0x112>(F2[j], pr[j]); y[j] = acc[ai][0][m][0][j] * (w0[j] * p2 + w1[j] * p1 + w2[j] * pr[j]); }
                const f32x4 q = acc[ai][1][m][0] * invw - acc[ai][1][m][1];
                const auto s0 = __builtin_amdgcn_permlane16_swap(pk_bf16(y[0], y[1]), pk_bf16(q[0], q[1]), false, false), s1 = __builtin_amdgcn_permlane16_swap(pk_bf16(y[2], y[3]), pk_bf16(q[2], q[3]), false, false);
                *(u32x4*)(ya + (ptrdiff_t)(fq & 1) * (pp - ya) + (size_t)(row0 + ai * HALF + m * 16) * D + (ch0 & ~7)) = (u32x4){s0[0], s1[0], s0[1], s1[1]}; }
        }
        return false;
    }
};
struct EpiPlain {
    static constexpr bool INIT = false;
    bf16_t* Ob; int ldc; size_t aux_stride;
    __device__ __forceinline__ bool operator()(Acc& acc, const Unit& u, int wr, int wc, int fr, int fq) const {
        bf16_t* O = Ob + (size_t)u.aux * aux_stride;
        const int row0 = u.pm * BM + wr * 64 + fr, col0 = u.pn * BM + wc * 32 + 8 * fq;
#pragma unroll
        for (int ai = 0; ai < 2; ++ai)
#pragma unroll
            for (int m = 0; m < 4; ++m) { bf16_t* rowp = O + (size_t)(row0 + ai * HALF + m * 16) * ldc + col0;
#pragma unroll
                for (int bj = 0; bj < 2; ++bj) *(u32x4*)(rowp + bj * HALF) = pack8(acc[ai][bj][m][0], acc[ai][bj][m][1]); }
        return false;
    }
};
struct EpiMoe2 {
    static constexpr bool INIT = false;
    unsigned char* Y; bf16_t* YP;
    __device__ __forceinline__ bool operator()(Acc& acc, const Unit& u, int wr, int wc, int fr, int fq) const {
        if (u.aux) { bf16_t* O = YP + (size_t)(u.aux - 1) * 65536 + (size_t)(wr * 64 + fr) * 256 + wc * 32 + 8 * fq;
#pragma unroll
            for (int ai = 0; ai < 2; ++ai)
#pragma unroll
                for (int m = 0; m < 4; ++m) { bf16_t* rowp = O + (size_t)(ai * HALF + m * 16) * 256;
#pragma unroll
                    for (int bj = 0; bj < 2; ++bj) *(u32x4*)(rowp + bj * HALF) = pack8(acc[ai][bj][m][0], acc[ai][bj][m][1]); }
        } else {
            unsigned char* O = Y + (size_t)(u.pm * BM + wr * 64 + fr) * D + u.pn * BM + wc * 32 + 8 * (fq & ~1) + (fq & 1) * HALF;
#pragma unroll
            for (int ai = 0; ai < 2; ++ai)
#pragma unroll
                for (int m = 0; m < 4; ++m) {
                    const auto s0 = __builtin_amdgcn_permlane16_swap(pk_fp8x4(acc[ai][0][m][0] * F8_Y_MUL), pk_fp8x4(acc[ai][1][m][0] * F8_Y_MUL), false, false),
                               s1 = __builtin_amdgcn_permlane16_swap(pk_fp8x4(acc[ai][0][m][1] * F8_Y_MUL), pk_fp8x4(acc[ai][1][m][1] * F8_Y_MUL), false, false);
                    *(u32x4*)(O + (size_t)(ai * HALF + m * 16) * D) = (u32x4){s0[0], s1[0], s0[1], s1[1]}; }
        }
        return false;
    }
};
struct EpiMerge {
    static constexpr bool INIT = false;
    const bf16_t* gates; bf16_t* O;
    __device__ __forceinline__ bool operator()(Acc& acc, const Unit& u, int wr, int wc, int fr, int fq) const {
        const int row0 = u.pm * BM + wr * 64 + fr, col0 = u.pn * BM + wc * 32 + 8 * fq, b = u.aux;
#pragma unroll
        for (int ai = 0; ai < 2; ++ai)
#pragma unroll
            for (int m = 0; m < 4; ++m) { const size_t row = (size_t)(row0 + ai * HALF + m * 16);
                const unsigned char* gp = (const unsigned char*)gates + gate_frag(u.pm, 4 * b + u.pn, wr * 4 + wc, ai, m, fr + 16 * fq);
                const u32x4 gw = *(const u32x4*)gp;
                if (b < 2) { const u32x4 hw = *(const u32x4*)(gp + gate_frag(0, 4, 0, 0, 0, 0));
#pragma unroll
                    for (int bj = 0; bj < 2; ++bj) { const f32x4 g0 = un_fp8x4(gw[2 * bj]), g1 = un_fp8x4(gw[2 * bj + 1]), h0 = un_fp8x4(hw[2 * bj]), h1 = un_fp8x4(hw[2 * bj + 1]);
#pragma unroll
                        for (int j = 0; j < 4; ++j) { acc[ai][bj][m][0][j] *= (1.f + h0[j]) * __builtin_amdgcn_rcpf(1.f + g0[j]); acc[ai][bj][m][1][j] *= (1.f + h1[j]) * __builtin_amdgcn_rcpf(1.f + g1[j]); } }
                } else {
#pragma unroll
                    for (int bj = 0; bj < 2; ++bj) { f32x4 g0 = un_fp8x4(gw[2 * bj]), g1 = un_fp8x4(gw[2 * bj + 1]);
#pragma unroll
                        for (int j = 0; j < 4; ++j) { g0[j] = __builtin_amdgcn_rcpf(1.f + g0[j]); g1[j] = __builtin_amdgcn_rcpf(1.f + g1[j]); }
                        *(u32x4*)(O + row * D + col0 + bj * HALF) = pack8(acc[ai][bj][m][0] * g0, acc[ai][bj][m][1] * g1); } } }
        return b < 2;
    }
};
struct EpiResid {
    static constexpr bool INIT = true;
    bf16_t* xb; float* ssp; LAS float* red; unsigned char* x8;
    __device__ __forceinline__ void init_load(Acc& acc, u32x4 (&raw)[16], const Unit& u, int wr, int wc, int fr, int fq) const {
        const int row0 = u.pm * BM + wr * 64 + fr, col0 = u.pn * BM + wc * 32 + 8 * fq;
#pragma unroll
        for (int ai = 0; ai < 2; ++ai)
#pragma unroll
            for (int m = 0; m < 4; ++m)
#pragma unroll
                for (int bj = 0; bj < 2; ++bj) { const size_t off = (size_t)(row0 + ai * HALF + m * 16) * D + col0 + bj * HALF;
                    raw[(ai * 4 + m) * 2 + bj] = *(const u32x4*)(xb + off); }
    }
    __device__ __forceinline__ void init_finish(Acc& acc, const u32x4 (&raw)[16]) const {
        {
#pragma unroll
            for (int ai = 0; ai < 2; ++ai)
#pragma unroll
                for (int m = 0; m < 4; ++m)
#pragma unroll
                    for (int bj = 0; bj < 2; ++bj) unpack8(raw[(ai * 4 + m) * 2 + bj], acc[ai][bj][m][0], acc[ai][bj][m][1]); }
    }
    __device__ __forceinline__ bool operator()(Acc& acc, const Unit& u, int wr, int wc, int fr, int fq) const {
        const int row0 = u.pm * BM + wr * 64 + fr, col0 = u.pn * BM + wc * 32 + 8 * fq;
#pragma unroll
        for (int ai = 0; ai < 2; ++ai)
#pragma unroll
            for (int m = 0; m < 4; ++m) { const size_t row = (size_t)(row0 + ai * HALF + m * 16); float q = 0.f;
#pragma unroll
                for (int bj = 0; bj < 2; ++bj) { const size_t off = row * D + col0 + bj * HALF;
                    const u32x4 pk = pack8(acc[ai][bj][m][0], acc[ai][bj][m][1]); *(u32x4*)(xb + off) = pk;
                    f32x4 o0, o1; unpack8(pk, o0, o1); if (x8) *(u32x2*)(x8 + off) = (u32x2){pk_fp8x4(o0), pk_fp8x4(o1)};
                    q += (o0[0] * o0[0] + o0[1] * o0[1]) + (o0[2] * o0[2] + o0[3] * o0[3]) + (o1[0] * o1[0] + o1[1] * o1[1]) + (o1[2] * o1[2] + o1[3] * o1[3]); }
                q += __shfl_xor(q, 16); q += __shfl_xor(q, 32);
                if (fq == 0) red[(ai * HALF + wr * 64 + m * 16 + fr) * 4 + wc] = q; }
        asm volatile("s_waitcnt lgkmcnt(0)" ::: "memory"); __builtin_amdgcn_s_barrier(); asm volatile("" ::: "memory");
        int tid = threadIdx.x; asm volatile("" : "+v"(tid));
        if (tid < 256) { const f32x4 v = *(const LAS f32x4*)(red + tid * 4); ssp[(size_t)(u.pm * BM + tid) * 4 + u.pn] = (v[0] + v[1]) + (v[2] + v[3]); }
        return false;
    }
};
template <bool PART4, bool OUT8> struct EpiSwiGLU {
    static constexpr bool INIT = false;
    bf16_t* O; int ldc; const float* ss;
    __device__ __forceinline__ bool operator()(Acc& acc, const Unit& u, int wr, int wc, int fr, int fq) const {
        const int row0 = u.pm * BM + wr * 64 + fr, col0 = u.pn * 128 + wc * 32 + 8 * fq;
#pragma unroll
        for (int ai = 0; ai < 2; ++ai)
#pragma unroll
            for (int m = 0; m < 4; ++m) { const size_t row = (size_t)(row0 + ai * HALF + m * 16); float r = 1.f;
                if (PART4) { const f32x4 p = *(const f32x4*)(ss + row * 4); r = __builtin_amdgcn_rsqf(((p[0] + p[1]) + (p[2] + p[3])) * (1.0f / D) + RMS_EPS); }
                f32x4 a0 = acc[ai][0][m][0], a1 = acc[ai][0][m][1], c0 = acc[ai][1][m][0], c1 = acc[ai][1][m][1];
                if (PART4) { a0 = a0 * r; a1 = a1 * r; c0 = c0 * r; c1 = c1 * r; }
                const f32x4 h0 = a0 * sig4l(a0) * c0, h1 = a1 * sig4l(a1) * c1;
                if (OUT8) { *(u32x2*)((unsigned char*)O + row * ldc + col0) = (u32x2){pk_fp8x4(h0), pk_fp8x4(h1)}; }
                else *(u32x4*)(O + row * ldc + col0) = pack8(h0, h1); }
        return false;
    }
};

typedef int i32x4 __attribute__((ext_vector_type(4)));
typedef int i32x8 __attribute__((ext_vector_type(8)));
__device__ __forceinline__ i32x8 join16(const bf16x8 lo, const bf16x8 hi) { return __builtin_shufflevector(__builtin_bit_cast(i32x4, lo), __builtin_bit_cast(i32x4, hi), 0, 1, 2, 3, 4, 5, 6, 7); }
template <class Epi, class Sched, bool F8 = false>
__device__ __forceinline__ void gemm_phase(LAS unsigned char* lds, const Gemm g, const Sched& S, const Epi& E) {
    int tid_ = threadIdx.x; asm volatile("" : "+v"(tid_));
    const int tid = tid_, wid = __builtin_amdgcn_readfirstlane(tid >> 6), lane = tid & 63, wr = wid >> 2, wc = wid & 3, fr = lane & 15, fq = lane >> 4;
    const int nt = g.Kb / 128;
    int vsa = g.sa, vsb = g.sb; asm volatile("" : "+v"(vsa), "+v"(vsb));
    unsigned voffA[2], voffB[2];
#pragma unroll
    for (int i = 0; i < 2; ++i) { int R, C; stage_rc(tid * 16 + i * 8192, R, C); const int Rb = (R & ~31) + perm32(R & 31);
        voffA[i] = (unsigned)(R * g.lda + C * 2); voffB[i] = (unsigned)(Rb * g.ldb + C * 2); }
    const size_t kstep = (size_t)(BK * 2);
    const size_t hstepA = (size_t)HALF * g.lda, hstepB = (size_t)HALF * g.ldb;
    const unsigned ldsw = (unsigned)wid * 1024u;
    const int aoff = lds_byte(wr * 64 + fr, fq * 8), boff = lds_byte(wc * 32 + fr, fq * 8);
#define PG8_SA(b, h) (((b) * 2 + (h)) * HTB)
#define PG8_SB(b, h) ((4 + (b) * 2 + (h)) * HTB)
#define PG8_STAGE(bufoff, gbase, voff) do { _Pragma("unroll") for (int _i = 0; _i < 2; ++_i) \
        __builtin_amdgcn_global_load_lds((const unsigned*)((const char*)(gbase) + (voff)[_i]), (LAS unsigned*)(lds + (bufoff) + ldsw + _i * 8192), 16, 0, 0); } while (0)
#define PG8_LDA(dst, b, h) do { _Pragma("unroll") for (int m = 0; m < 4; ++m) _Pragma("unroll") for (int k = 0; k < 2; ++k) dst[m][k] = *(const LAS bf16x8*)(lds + PG8_SA(b, h) + aoff + m * 2048 + k * 1024); } while (0)
#define PG8_LDB(dst, b, h) do { _Pragma("unroll") for (int n = 0; n < 2; ++n) _Pragma("unroll") for (int k = 0; k < 2; ++k) dst[n][k] = *(const LAS bf16x8*)(lds + PG8_SB(b, h) + boff + n * 2048 + k * 1024); } while (0)
#define PG8_MMA(ai, bj, At, Bt) do { __builtin_amdgcn_s_setprio(1); _Pragma("unroll") for (int m = 0; m < 4; ++m) _Pragma("unroll") for (int n = 0; n < 2; ++n) { \
        if constexpr (F8) { const i32x8 b8_ = join16(Bt[n][0], Bt[n][1]), a8_ = join16(At[m][0], At[m][1]); \
            asm volatile("v_mfma_scale_f32_16x16x128_f8f6f4 %0, %1, %2, %0, %3, %4 op_sel_hi:[0,0,0]" : "+v"(acc[ai][bj][m][n]) : "v"(b8_), "v"(a8_), "v"(vsb), "v"(vsa)); } \
        else { _Pragma("unroll") for (int k = 0; k < 2; ++k) acc[ai][bj][m][n] = __builtin_amdgcn_mfma_f32_16x16x32_bf16(Bt[n][k], At[m][k], acc[ai][bj][m][n], 0, 0, 0); } } __builtin_amdgcn_s_setprio(0); } while (0)
#define PG8_WAIT_V(n) asm volatile("s_waitcnt vmcnt(" #n ")" ::: "memory")
#define PG8_WAIT_L(n) asm volatile("s_waitcnt lgkmcnt(" #n ")" ::: "memory")
#define PG8_BAR __builtin_amdgcn_s_barrier()
#define PG8_SCHED __builtin_amdgcn_sched_barrier(0)
    Unit cur, nxt; int ui = 0;
    if (!S.next(0, cur)) return;
    Acc acc;
    u32x4 iraw[16];
    if constexpr (Epi::INIT) E.init_load(acc, iraw, cur, wr, wc, fr, fq);
    else {
#pragma unroll
    for (int a = 0; a < 2; ++a)
#pragma unroll
        for (int b = 0; b < 2; ++b)
#pragma unroll
            for (int m = 0; m < 4; ++m)
#pragma unroll
                for (int n = 0; n < 2; ++n) acc[a][b][m][n] = (f32x4){0.f, 0.f, 0.f, 0.f};
    }
    bf16x8 At[4][2], B0[2][2], B1[2][2];
    const char* cA = cur.A; const char* cB = cur.B;
    PG8_STAGE(PG8_SB(0, 0), cB, voffB); PG8_STAGE(PG8_SB(0, 1), cB + hstepB, voffB); PG8_STAGE(PG8_SA(0, 0), cA, voffA); PG8_STAGE(PG8_SA(0, 1), cA + hstepA, voffA);
    if constexpr (Epi::INIT) { PG8_SCHED; E.init_finish(acc, iraw); PG8_SCHED; }
    if (wr == 1) PG8_BAR;
    PG8_WAIT_V(2); PG8_BAR;
    PG8_STAGE(PG8_SB(1, 0), cB + kstep, voffB); PG8_STAGE(PG8_SA(1, 0), cA + kstep, voffA); PG8_STAGE(PG8_SB(1, 1), cB + hstepB + kstep, voffB);
    PG8_WAIT_V(6); PG8_BAR;
    for (;;) {
        const bool has_next = S.next(ui + 1, nxt);
        const char* nA = has_next ? nxt.A : cA; const char* nB = has_next ? nxt.B : cB;
        const int unt = cur.nt ? cur.nt : nt;
#pragma nounroll
        for (int t = 0; t < unt; t += 2) {
            const bool last = (t == unt - 2);
            const char* a1 = cA + (size_t)(t + 1) * kstep;
            const char* a2 = last ? nA : cA + (size_t)(t + 2) * kstep; const char* b2 = last ? nB : cB + (size_t)(t + 2) * kstep;
            const char* a3 = a2 + kstep; const char* b3 = b2 + kstep;
            PG8_LDB(B0, 0, 0); PG8_LDB(B1, 0, 1); PG8_SCHED; PG8_LDA(At, 0, 0); PG8_STAGE(PG8_SA(1, 1), a1 + hstepA, voffA);
            PG8_WAIT_V(8); PG8_WAIT_L(0); PG8_BAR; PG8_MMA(0, 0, At, B0); PG8_MMA(0, 1, At, B1); PG8_BAR; PG8_SCHED;
            PG8_LDA(At, 0, 1); PG8_STAGE(PG8_SB(0, 0), b2, voffB); PG8_STAGE(PG8_SB(0, 1), b2 + hstepB, voffB); PG8_STAGE(PG8_SA(0, 0), a2, voffA);
            PG8_WAIT_V(8); PG8_WAIT_L(0); PG8_BAR; PG8_MMA(1, 0, At, B0); PG8_MMA(1, 1, At, B1); PG8_BAR; PG8_SCHED;
            PG8_LDB(B0, 1, 0); PG8_LDB(B1, 1, 1); PG8_SCHED; PG8_LDA(At, 1, 0); PG8_STAGE(PG8_SA(0, 1), a2 + hstepA, voffA);
            PG8_WAIT_V(8); PG8_WAIT_L(0); PG8_BAR; PG8_MMA(0, 0, At, B0); PG8_MMA(0, 1, At, B1); PG8_BAR; PG8_SCHED;
            PG8_LDA(At, 1, 1); PG8_STAGE(PG8_SB(1, 0), b3, voffB); PG8_STAGE(PG8_SB(1, 1), b3 + hstepB, voffB); PG8_STAGE(PG8_SA(1, 0), a3, voffA);
            PG8_WAIT_V(8); PG8_WAIT_L(0); PG8_BAR; PG8_MMA(1, 0, At, B0); PG8_MMA(1, 1, At, B1); PG8_BAR; PG8_SCHED;
        }
        if constexpr (F8) asm volatile("s_nop 15\n\ts_nop 15" ::: "memory");
        if (wr == 0) PG8_BAR;
        const bool keep = E(acc, cur, wr, wc, fr, fq);
        if (!has_next) break;
        if constexpr (Epi::INIT) { E.init_load(acc, iraw, nxt, wr, wc, fr, fq); E.init_finish(acc, iraw); }
        else if (!keep) {
#pragma unroll
            for (int a = 0; a < 2; ++a)
#pragma unroll
                for (int b = 0; b < 2; ++b)
#pragma unroll
                    for (int m = 0; m < 4; ++m)
#pragma unroll
                        for (int n = 0; n < 2; ++n) acc[a][b][m][n] = (f32x4){0.f, 0.f, 0.f, 0.f};
        }
        cur = nxt; cA = nA; cB = nB; ++ui;
        if (wr == 1) PG8_BAR;
    }
    PG8_WAIT_V(0);
    PG8_BAR;
#undef PG8_SA
#undef PG8_SB
#undef PG8_STAGE
#undef PG8_LDA
#undef PG8_LDB
#undef PG8_MMA
#undef PG8_WAIT_V
#undef PG8_WAIT_L
#undef PG8_BAR
#undef PG8_SCHED
}
}

constexpr int RING_BYTES = 131072, MISC_OFF = RING_BYTES, RED_OFF = RING_BYTES + 1024, POOLX_OFF = RED_OFF + 4096, LDS_BYTES = 163840;

#define XB_TMO      128
#define XB_XCNT(j)  (256  + 64 * (j))
#define XB_XSUB(j)  (1280 + 64 * (j))
#define XB_XGEN(j)  (2304 + 64 * (j))
#define XB_TOP      3328
#define XB_TOPGEN   3392
#define XCD_BAR_WORDS 3456
#define XB_SPIN_CAP (1u << 18)
__device__ __forceinline__ unsigned xb_ld(unsigned* p)              { return __hip_atomic_load(p, __ATOMIC_RELAXED, __HIP_MEMORY_SCOPE_AGENT); }
__device__ __forceinline__ unsigned xb_add(unsigned* p, unsigned v) { return __hip_atomic_fetch_add(p, v, __ATOMIC_RELAXED, __HIP_MEMORY_SCOPE_AGENT); }
__device__ __forceinline__ unsigned xb_xcc_id() { return (unsigned)__builtin_amdgcn_s_getreg((3 << 11) | 20) & 0xFu; }
#define XB_SPIN(cond, bar) do { unsigned _sp = 0; while (cond) { __builtin_amdgcn_s_sleep(1); \
    if ((++_sp & 255u) == 0u) { if (xb_ld(&(bar)[XB_TMO])) break; if (_sp > XB_SPIN_CAP) { atomicAdd(&(bar)[XB_TMO], 1u); break; } } } } while (0)
struct XcdBarrier { unsigned* bar; unsigned x; volatile LAS unsigned* st; };
__device__ __forceinline__ XcdBarrier xcd_barrier_post(unsigned* bar, volatile LAS unsigned* st) {
    XcdBarrier b; b.bar = bar; b.x = xb_xcc_id(); b.st = st;
    if (threadIdx.x == 0) (void)xb_add(&bar[XB_XCNT(b.x)], 1u);
    return b;
}
__device__ __forceinline__ void xcd_barrier_complete(unsigned* bar, unsigned x, unsigned& nloc, unsigned& nx) {
    const unsigned G = gridDim.x * gridDim.y * gridDim.z;
    unsigned sum, cnt, mine, sp = 0u;
    for (;;) {
        sum = 0u; cnt = 0u; mine = 0u;
#pragma nounroll
        for (unsigned j = 0; j < 16; ++j) { const unsigned c = xb_ld(&bar[XB_XCNT(j)]); sum += c; cnt += (c > 0u) ? 1u : 0u; mine = (j == x) ? c : mine; }
        if (sum == G) break;
        __builtin_amdgcn_s_sleep(1);
        if ((++sp & 255u) == 0u) { if (xb_ld(&bar[XB_TMO])) break; if (sp > XB_SPIN_CAP) { atomicAdd(&bar[XB_TMO], 1u); break; } }
    }
    nloc = mine > 0u ? mine : 1u; nx = cnt > 0u ? cnt : 1u;
}
__device__ __forceinline__ void xcd_barrier(const XcdBarrier& b) {
    asm volatile("s_waitcnt vmcnt(0)" ::: "memory");
    __syncthreads();
    if (threadIdx.x == 0) {
        unsigned* bar = b.bar;
        __builtin_amdgcn_s_waitcnt(0);
        unsigned nloc = b.st[0], nx = b.st[1];
        if (nloc == 0u) { xcd_barrier_complete(bar, b.x, nloc, nx); b.st[0] = nloc; b.st[1] = nx; }
        const unsigned old = xb_add(&bar[XB_XSUB(b.x)], 1u);
        const unsigned gen = old / nloc;
        if (old + 1u == (gen + 1u) * nloc) {
            __builtin_amdgcn_fence(__ATOMIC_RELEASE, "agent");
            asm volatile("s_waitcnt vmcnt(0)" ::: "memory");
            const unsigned og = xb_add(&bar[XB_TOP], 1u);
            const unsigned tg = og / nx;
            if (og + 1u == (tg + 1u) * nx) xb_add(&bar[XB_TOPGEN], 1u);
            else XB_SPIN(xb_ld(&bar[XB_TOPGEN]) == tg, bar);
            __builtin_amdgcn_fence(__ATOMIC_ACQUIRE, "agent");
            xb_add(&bar[XB_XGEN(b.x)], 1u);
            asm volatile("s_waitcnt vmcnt(0)" ::: "memory");
        } else {
            XB_SPIN(xb_ld(&bar[XB_XGEN(b.x)]) == gen, bar);
            __builtin_amdgcn_fence(__ATOMIC_ACQUIRE, "agent");
            asm volatile("s_waitcnt vmcnt(0)" ::: "memory");
        }
    }
    __syncthreads();
}

struct Args { const float* in[23]; float* out; unsigned char* ws; int ph_lo, ph_hi; };
static_assert(sizeof(Args) == 23 * 8 + 8 + 8 + 8, "Args has no padding");
typedef const __attribute__((address_space(4))) Args* KArgs;
__device__ __forceinline__ KArgs kargs() { KArgs p = (KArgs)__builtin_amdgcn_kernarg_segment_ptr(); asm volatile("" : "+s"(p)); return p; }

__device__ __forceinline__ void transpose_item(const float* src, int ldn, int k0, int n0, bf16_t* dst, int ldk, const float* kscale, const float* nscale, int lane, bool perm = false, float mul = 1.f) {
    const int r4 = lane >> 4, q = lane & 15, rq = perm ? 32 * (q >> 2) + 8 * (q & 3) : 4 * q;
    f32x4 v[16];
    const float* sp = src + (size_t)(k0 + 16 * r4) * ldn + n0 + 4 * q;
#pragma unroll
    for (int i = 0; i < 16; ++i) v[i] = __builtin_nontemporal_load((const f32x4*)(sp + (size_t)i * ldn));
    f32x4 ns = (f32x4){mul, mul, mul, mul}; if (nscale) ns = *(const f32x4*)(nscale + n0 + 4 * q) * mul;
    if (kscale) {
        const f32x4* kp = (const f32x4*)(kscale + k0 + 16 * r4);
#pragma unroll
        for (int g = 0; g < 4; ++g) { const f32x4 ks = kp[g];
#pragma unroll
            for (int j = 0; j < 4; ++j) v[4 * g + j] = v[4 * g + j] * ks[j]; }
    }
#pragma unroll
    for (int e = 0; e < 4; ++e) { u32x4 lo, hi;
#pragma unroll
        for (int w = 0; w < 4; ++w) { lo[w] = pk_bf16(v[2 * w][e] * ns[e], v[2 * w + 1][e] * ns[e]); hi[w] = pk_bf16(v[8 + 2 * w][e] * ns[e], v[9 + 2 * w][e] * ns[e]); }
        bf16_t* o = dst + (size_t)(rq + e) * ldk + k0 + 16 * r4; *(u32x4*)o = lo; *(u32x4*)(o + 8) = hi; }
}
__device__ __forceinline__ void transpose_item_f8(const float* src, int ldn, int k0, int n0, unsigned char* dst, int ldk, const float* kscale, float mul, int lane) {
    const int r4 = lane >> 4, q = lane & 15;
    f32x4 v[16];
    const float* sp = src + (size_t)(k0 + 16 * r4) * ldn + n0 + 4 * q;
#pragma unroll
    for (int i = 0; i < 16; ++i) v[i] = __builtin_nontemporal_load((const f32x4*)(sp + (size_t)i * ldn));
    {
        const f32x4* kp = (const f32x4*)(kscale + k0 + 16 * r4);
#pragma unroll
        for (int g = 0; g < 4; ++g) { f32x4 ks = (f32x4){mul, mul, mul, mul}; if (kscale) ks = kp[g] * mul;
#pragma unroll
            for (int j = 0; j < 4; ++j) v[4 * g + j] = v[4 * g + j] * ks[j]; }
    }
#pragma unroll
    for (int e = 0; e < 4; ++e) { u32x4 o;
#pragma unroll
        for (int w = 0; w < 4; ++w) o[w] = pk_fp8x4((f32x4){v[4 * w][e], v[4 * w + 1][e], v[4 * w + 2][e], v[4 * w + 3][e]});
        *(u32x4*)(dst + (size_t)(4 * q + e) * ldk + k0 + 16 * r4) = o; }
}
__device__ __forceinline__ int win_row(int n0) {
    const int seg = n0 >> 10, c = n0 & 1023;
    if (seg == 1 || seg == 2) return 1024 + (c >> 7) * 256 + (seg == 2 ? 128 : 0) + (c & 127);
    if (seg == 3 || seg == 4) return 3072 + (c >> 7) * 256 + (seg == 4 ? 128 : 0) + (c & 127);
    return n0;
}
__device__ __forceinline__ int pair_row(int f, int second) { return (f >> 7) * 256 + (second ? 128 : 0) + (f & 127); }

__device__ __forceinline__ void prologue_phase(KArgs a, LAS unsigned char* lds, int wid, int lane) {
    asm volatile("" : "+v"(lane));
    const int gw = blockIdx.x * 8 + wid, NGW = gridDim.x * 8;
    unsigned char* ws = a->ws;
    constexpr int I_WIN = 16 * 144, I_SQ = 16 * 16, I_PW = 16, I_D1 = 16 * 56, I_D2 = 56 * 16;
    constexpr int NIT = 2 * I_WIN + 8 * I_SQ + 8 * I_PW + 2 * I_D1 + I_D2;
    for (int it = gw; it < NIT; it += NGW) {
        int r = it;
        if (r < 2 * I_WIN) { const int L = r / I_WIN; r -= L * I_WIN; const int kb = r / 144, nb = r % 144, n0 = 64 * nb;
            if (n0 >= 6144 || (n0 >= 3072 && n0 < 5120)) transpose_item_f8(a->in[2] + (size_t)L * D * INC, INC, 64 * kb, n0, ws + WS_WG8 + (size_t)L * 5 * MiB + (size_t)(n0 >= 6144 ? 2048 + (n0 - 6144) : win_row(n0) - 3072) * D, D, a->in[1] + L * D, (n0 >= 4096 && n0 < 5120) ? F8_W13_MUL * LOG2E : F8_W13_MUL, lane);
            else { const int ty = n0 < 3072 ? n0 >> 10 : 3, T = (n0 & 1023) >> 6;
                transpose_item(a->in[2] + (size_t)L * D * INC, INC, 64 * kb, n0, (bf16_t*)(ws + WS_W0 + W0_WIN + (size_t)L * 18 * MiB) + (size_t)(256 * T + 128 * (ty >> 1) + 4 * (ty & 1)) * D, D, a->in[1] + L * D, nullptr, lane, true); }
            continue; }
        r -= 2 * I_WIN;
        if (r < 8 * I_SQ) { const int j = r / I_SQ; r -= j * I_SQ; const int L = j >> 2, w = j & 3, kb = r / 16, nb = r % 16, n0 = 64 * nb;
            bf16_t* dst = w < 3 ? (bf16_t*)(ws + WS_W0 + W0_WOUT + (size_t)(L * 3 + w) * 2 * MiB) : (bf16_t*)(ws + WS_W0 + W0_WO + (size_t)L * 2 * MiB);
            transpose_item(a->in[10 + w] + (size_t)L * D * D, D, 64 * kb, n0, dst + (size_t)n0 * D, D, nullptr, nullptr, lane); continue; }
        r -= 8 * I_SQ;
        if (r < 8 * I_PW) { const int j = r / I_PW; r -= j * I_PW; const int L = j >> 2, g = j & 3;
            const float* src = a->in[8] + (size_t)(L * 4 + g) * 65536 + (size_t)r * 16 * 256; const float* sc = a->in[9] + L * D + g * 256;
            bf16_t* dst = (bf16_t*)(ws + WS_W0 + W0_POOL + (size_t)L * 512 * 1024) + (size_t)g * 65536 + (size_t)r * 16 * 256; const f32x4 s4 = *(const f32x4*)(sc + 4 * lane);
#pragma unroll
            for (int i = 0; i < 16; ++i) { const f32x4 v = *(const f32x4*)(src + i * 256 + 4 * lane) * s4; u32x2 w; w.x = pk_bf16(v[0], v[1]); w.y = pk_bf16(v[2], v[3]); *(u32x2*)(dst + i * 256 + 4 * lane) = w; }
            continue; }
        r -= 8 * I_PW;
        if (r < 2 * I_D1) { const int w = r / I_D1; r -= w * I_D1; const int kb = r / 56, nb = r % 56, n0 = 64 * nb;
            transpose_item(a->in[15 + w], DFF, 64 * kb, n0, (bf16_t*)(ws + WS_W0 + W0_D13) + (size_t)pair_row(n0, w) * D, D, a->in[14], nullptr, lane, false, w ? 1.0f / LOG2E : LOG2E); continue; }
        r -= 2 * I_D1;
        { const int kb = r / 16, nb = r % 16, n0 = 64 * nb;
            transpose_item(a->in[17], D, 64 * kb, n0, (bf16_t*)(ws + WS_W0 + W0_D2) + (size_t)n0 * DFF, DFF, nullptr, nullptr, lane); }
    }
    const float* x = a->in[0]; bf16_t* xb = (bf16_t*)(ws + WS_XB); f32x4* ss0 = (f32x4*)(ws + WS_SS); unsigned char* x8 = ws + WS_X8;
    for (int m = gw; m < M; m += NGW) {
        const f32x4* xr = (const f32x4*)(x + (size_t)m * D) + lane; u32x2* o = (u32x2*)(xb + (size_t)m * D) + lane; float s = 0.f;
#pragma unroll
        for (int j = 0; j < 4; ++j) { const f32x4 v = xr[64 * j]; s += (v[0] * v[0] + v[1] * v[1]) + (v[2] * v[2] + v[3] * v[3]); u32x2 w; w.x = pk_bf16(v[0], v[1]); w.y = pk_bf16(v[2], v[3]); o[64 * j] = w;
            *((unsigned*)(x8 + (size_t)m * D) + lane + 64 * j) = pk_fp8x4(v); }
        s = wave_sum(s); if (lane == 0) ss0[m] = (f32x4){s, 0.f, 0.f, 0.f};
    }
}

__device__ __forceinline__ void dma_block16(const bf16_t* src, LAS unsigned char* dst, int wid, int lane) {
#pragma unroll
    for (int k = 0; k < 4; ++k) { const int h = wid * 4 + k;
        __builtin_amdgcn_global_load_lds((const unsigned*)((const char*)src + h * 1024 + lane * 16), (LAS unsigned*)(dst + h * 1024), 16, 0, 0); }
}
__device__ __forceinline__ void zero_block16(LAS unsigned char* dst, int tid) {
#pragma unroll
    for (int k = 0; k < 4; ++k) *(LAS u32x4*)(dst + (size_t)(tid + 512 * k) * 16) = (u32x4){0u, 0u, 0u, 0u};
}
template <int I> __device__ __forceinline__ void conv31_pair(const LAS unsigned char* col, const unsigned (&wp)[31], f32x2 bias, f32x2 (&acc)[16]) {
    f32x2 x[46];
#pragma unroll
    for (int i = 0; i < 46; ++i) { const int r = i - 30, j = I + (r >> 4); const unsigned u = *(const LAS unsigned*)(col + ((j + 2) & 3) * 32768 + (r & 15) * 2048); x[i] = (f32x2){bf_lo(u), bf_hi(u)}; }
#pragma unroll
    for (int j = 0; j < 16; ++j) acc[j] = bias;
#pragma unroll
    for (int k = 0; k < 31; ++k) { const f32x2 wk = (f32x2){bf_lo(wp[k]), bf_hi(wp[k])};
#pragma unroll
        for (int j = 0; j < 16; ++j) acc[j] = __builtin_elementwise_fma(wk, x[j + k], acc[j]); }
}
template <int I, int CH> __device__ __forceinline__ void pool_ch(const LAS unsigned char* col, int g, int s0, float (&p)[16]) {
    float x[31], tv[16];
#pragma unroll
    for (int i = 0; i < 31; ++i) { const int r = i - 15, j = I + (r >> 4); const unsigned u = *(const LAS unsigned*)(col + ((j + 1) % 3) * 32768 + (r & 15) * 2048); x[i] = CH ? bf_hi(u) : bf_lo(u); }
#pragma unroll
    for (int j = 0; j < 16; ++j) tv[j] = x[15 + j];
#pragma unroll
    for (int i = 30; i >= 1; --i) x[i] += x[i - 1];
    if (g >= 1) {
#pragma unroll
        for (int i = 30; i >= 2; --i) x[i] += x[i - 2]; }
    if (g >= 2) {
#pragma unroll
        for (int i = 30; i >= 4; --i) x[i] += x[i - 4]; }
    if (g >= 3) {
#pragma unroll
        for (int i = 30; i >= 8; --i) x[i] += x[i - 8]; }
    const int w = 2 << g;
#pragma unroll
    for (int j = 0; j < 16; ++j) { const int cnt = min(s0 + j + 1, w); p[j] = x[15 + j] * (1.0f / (float)cnt) - tv[j]; }
}
struct ConvB { const bf16_t* GLU; __amdgpu_buffer_rsrc_t rVB; LAS unsigned char* lds; LAS float* red; LAS float* stat; f32x2 bb, gg, be; };
template <int I> __device__ __forceinline__ void convB_tile(const ConvB& c, unsigned (&wp)[31], int T0, int tid, int wid, int lane) {
    const int t0 = T0 + 16 * I; const LAS unsigned char* col = c.lds + 4 * tid;
#pragma unroll
    for (int k = 0; k < 31; ++k) asm volatile("" : "+v"(wp[k]));
    if (I < 3) dma_block16(c.GLU + (size_t)(t0 + 16) * D, c.lds + ((I + 3) & 3) * 32768, wid, lane);
    float a0[16], a1[16];
    { f32x2 ap[16]; conv31_pair<I>(col, wp, c.bb, ap);
#pragma unroll
      for (int j = 0; j < 16; ++j) { a0[j] = ap[j].x; a1[j] = ap[j].y; } }
    {
        float v[32];
#pragma unroll
        for (int j = 0; j < 16; ++j) { v[j] = a0[j] + a1[j]; v[16 + j] = a0[j] * a0[j] + a1[j] * a1[j]; }
#pragma unroll
        for (int i = 0; i < 16; ++i) { const bool b = lane & 32; const float send = b ? v[i] : v[i + 16], keep = b ? v[i + 16] : v[i]; v[i] = keep + __shfl_xor(send, 32); }
#pragma unroll
        for (int i = 0; i < 8; ++i) { const bool b = lane & 16; const float send = b ? v[i] : v[i + 8], keep = b ? v[i + 8] : v[i]; v[i] = keep + __shfl_xor(send, 16); }
#pragma unroll
        for (int i = 0; i < 4; ++i) { const bool b = lane & 8; const float send = b ? v[i] : v[i + 4], keep = b ? v[i + 4] : v[i]; v[i] = keep + __shfl_xor(send, 8); }
#pragma unroll
        for (int i = 0; i < 2; ++i) { const bool b = lane & 4; const float send = b ? v[i] : v[i + 2], keep = b ? v[i + 2] : v[i]; v[i] = keep + __shfl_xor(send, 4); }
        { const bool b = lane & 2; const float send = b ? v[0] : v[1], keep = b ? v[1] : v[0]; v[0] = keep + __shfl_xor(send, 2); }
        v[0] += __shfl_xor(v[0], 1);
        const int idx = ((lane >> 5) & 1) * 16 + ((lane >> 4) & 1) * 8 + ((lane >> 3) & 1) * 4 + ((lane >> 2) & 1) * 2 + ((lane >> 1) & 1);
        if (!(lane & 1)) c.red[wid * 32 + idx] = v[0];
    }
    __syncthreads();
    if (tid < 16) { float s = 0.f, q = 0.f;
#pragma unroll
        for (int w = 0; w < 8; ++w) { s += c.red[w * 32 + tid]; q += c.red[w * 32 + 16 + tid]; }
        const float mean = s * (1.0f / D), var = fmaxf(q * (1.0f / D) - mean * mean, 0.f);
        c.stat[2 * tid] = mean; c.stat[2 * tid + 1] = __builtin_amdgcn_rsqf(var + LN_EPS); }
    asm volatile("s_waitcnt vmcnt(0)" ::: "memory");
    __syncthreads();
#pragma unroll
    for (int j = 0; j < 16; ++j) { const float mean = c.stat[2 * j], rstd = c.stat[2 * j + 1];
        const float y0 = (a0[j] - mean) * rstd * c.gg.x + c.be.x, y1 = (a1[j] - mean) * rstd * c.gg.y + c.be.y;
        __builtin_amdgcn_raw_buffer_store_b32(pk_bf16(y0 * sigm(y0), y1 * sigm(y1)), c.rVB, 4 * tid, (t0 + j) * (D * 2), 0); }
}
struct ConvAC { const bf16_t* PU; __amdgpu_buffer_rsrc_t rPP; LAS unsigned char* lds; };
__device__ __forceinline__ void conv_phase(KArgs a, int layer, LAS unsigned char* lds, int tid, int wid, int lane) {
    asm volatile("" : "+v"(tid), "+v"(lane));
    unsigned char* ws = a->ws;
    const int G = gridDim.x;
    const int vcu = (G % 8 == 0) ? (int)(blockIdx.x % 8) * (G / 8) + (int)(blockIdx.x / 8) : (int)blockIdx.x;
    const int c2 = 2 * tid;
    {
        const float* cfw = a->in[4] + layer * 31 * D; const float* cfb = a->in[5] + layer * D; const float* lng = a->in[6] + layer * D; const float* lnb = a->in[7] + layer * D;
        ConvB c; c.GLU = (const bf16_t*)(ws + A_GLU); c.rVB = __builtin_amdgcn_make_buffer_rsrc((void*)(ws + A_VB), 0, 0x7fffffff, 0x00020000);
        c.lds = lds; c.red = (LAS float*)(lds + RED_OFF); c.stat = c.red + 256;
        unsigned wp[31];
#pragma unroll
        for (int k = 0; k < 31; ++k) { const f32x2 w = *(const f32x2*)(cfw + k * D + c2); wp[k] = pk_bf16(w.x, w.y); }
        c.bb = *(const f32x2*)(cfb + c2); c.gg = *(const f32x2*)(lng + c2); c.be = *(const f32x2*)(lnb + c2);
        asm volatile("" :: "v"(c.bb.x), "v"(c.bb.y), "v"(c.gg.x), "v"(c.gg.y), "v"(c.be.x), "v"(c.be.y));
        for (int rp2 = 0; rp2 < REPS2(21); ++rp2)
        for (int sup = vcu; sup < M / 64; sup += G) {
            const int T0 = sup * 64; const bool seq0 = (T0 & (SEQ - 1)) == 0;
            if (seq0) { zero_block16(lds, tid); zero_block16(lds + 32768, tid); } else { dma_block16(c.GLU + (size_t)(T0 - 32) * D, lds, wid, lane); dma_block16(c.GLU + (size_t)(T0 - 16) * D, lds + 32768, wid, lane); }
            dma_block16(c.GLU + (size_t)T0 * D, lds + 65536, wid, lane);
            asm volatile("s_waitcnt vmcnt(0)" ::: "memory");
            __syncthreads();
            convB_tile<0>(c, wp, T0, tid, wid, lane); convB_tile<1>(c, wp, T0, tid, wid, lane); convB_tile<2>(c, wp, T0, tid, wid, lane); convB_tile<3>(c, wp, T0, tid, wid, lane);
            __syncthreads();
        }
    }
    __syncthreads();
    if (blockIdx.x < M / 256) {
        int pm_ = blockIdx.x; asm volatile("" : "+s"(pm_));
        const int pm = pm_, T0 = pm * 256, s0 = T0 & (SEQ - 1); const bool seq0 = s0 == 0;
        const float* scw = a->in[3] + layer * 3 * D; const float* halo = (const float*)(ws + WS_HALO); bf16_t* YA = (bf16_t*)(ws + A_YA);
        ConvAC c; c.PU = (const bf16_t*)(ws + A_PU); c.lds = lds;
        c.rPP = __builtin_amdgcn_make_buffer_rsrc((void*)(ws + A_PP), 0, 0x7fffffff, 0x00020000);
        if (seq0) zero_block16(lds, tid); else dma_block16(c.PU + (size_t)(T0 - 16) * D, lds, wid, lane);
        dma_block16(c.PU + (size_t)T0 * D, lds + 32768, wid, lane);
        {   const f32x2 s0w = *(const f32x2*)(scw + c2), s1w = *(const f32x2*)(scw + D + c2), s2w = *(const f32x2*)(scw + 2 * D + c2);
            const f32x2 b0 = *(const f32x2*)(halo + (size_t)((0 * 64 + pm) * 2 + 0) * D + c2), b1 = *(const f32x2*)(halo + (size_t)((0 * 64 + pm) * 2 + 1) * D + c2);
            const f32x2 q0 = *(const f32x2*)(halo + (size_t)((1 * 64 + pm) * 2 + 0) * D + c2), q1 = *(const f32x2*)(halo + (size_t)((1 * 64 + pm) * 2 + 1) * D + c2);
            f32x2 pa = (f32x2){0.f, 0.f}, pb = pa;
            if (!seq0) { pa = *(const f32x2*)(halo + (size_t)((2 * 64 + pm - 1) * 2 + 0) * D + c2); pb = *(const f32x2*)(halo + (size_t)((2 * 64 + pm - 1) * 2 + 1) * D + c2); }
            const f32x2 y0 = b0 * (s0w * pa + s1w * pb + s2w * q0), y1 = b1 * (s0w * pb + s1w * q0 + s2w * q1);
            *(unsigned*)(YA + (size_t)T0 * D + c2) = pk_bf16(y0.x, y0.y); *(unsigned*)(YA + (size_t)(T0 + 1) * D + c2) = pk_bf16(y1.x, y1.y); }
        asm volatile("s_waitcnt vmcnt(0)" ::: "memory");
        __syncthreads();
        {
            const LAS unsigned char* col = lds + 4 * tid;
            float p0[16], p1[16];
            pool_ch<0, 0>(col, wid >> 1, s0, p0);
#pragma unroll
            for (int j = 0; j < 16; ++j) asm volatile("" : "+v"(p0[j]) :: "memory");
            pool_ch<0, 1>(col, wid >> 1, s0, p1);
#pragma unroll
            for (int j = 0; j < 16; ++j) __builtin_amdgcn_raw_buffer_store_b32(pk_bf16(p0[j], p1[j]), c.rPP, 4 * tid, (T0 + j) * (D * 2), 0);
        }
        __syncthreads();
    }
}

__device__ __forceinline__ void route_phase(KArgs a, LAS unsigned char* lds, int tid, int wid, int lane) {
    asm volatile("" : "+v"(tid), "+v"(lane));
    unsigned char* ws = a->ws;
    const bf16_t* X = (const bf16_t*)(ws + WS_XB); const float* gn = a->in[14] + D; const float* R = a->in[18];
    const f32x4* ss3 = (const f32x4*)(ws + WS_SS) + 3 * M;
    int* tope = (int*)(ws + WS_SMALL + SM_TOPE); f32x2* topp = (f32x2*)(ws + WS_SMALL + SM_TOPP); int* cntb = (int*)(ws + WS_CTL + CTL_CNT);
    LAS int* lcnt = (LAS int*)(lds + 98304);
    float wgt[2][8][8];
#pragma unroll
    for (int h = 0; h < 2; ++h)
#pragma unroll
        for (int i = 0; i < 8; ++i) { const int k = 8 * lane + 512 * h + i; const float g = gn[k]; const f32x4 r0 = *(const f32x4*)(R + k * 8), r1 = *(const f32x4*)(R + k * 8 + 4);
#pragma unroll
            for (int e = 0; e < 4; ++e) { wgt[h][i][e] = g * r0[e]; wgt[h][i][4 + e] = g * r1[e]; } }
    for (int vb = blockIdx.x; vb < 256; vb += gridDim.x) {
        if (tid < 8) lcnt[tid] = 0;
        __syncthreads();
        for (int i8 = 0; i8 < 8; ++i8) {
            const int t = vb * 64 + wid * 8 + i8;
            float lg[8];
#pragma unroll
            for (int e = 0; e < 8; ++e) lg[e] = 0.f;
#pragma unroll
            for (int h = 0; h < 2; ++h) { f32x4 v0, v1; pg8::unpack8(*(const u32x4*)(X + (size_t)t * D + 512 * h + 8 * lane), v0, v1);
#pragma unroll
                for (int i = 0; i < 4; ++i)
#pragma unroll
                    for (int e = 0; e < 8; ++e) { lg[e] = fmaf(v0[i], wgt[h][i][e], lg[e]); lg[e] = fmaf(v1[i], wgt[h][4 + i][e], lg[e]); } }
#pragma unroll
            for (int e = 0; e < 8; ++e) lg[e] = wave_sum(lg[e]);
            const f32x4 sp = ss3[t]; const float rstd = __builtin_amdgcn_rsqf(((sp[0] + sp[1]) + (sp[2] + sp[3])) * (1.0f / D) + RMS_EPS);
            int e1 = 0; float v1 = lg[0];
#pragma unroll
            for (int e = 1; e < 8; ++e) if (lg[e] > v1) { v1 = lg[e]; e1 = e; }
            int e2 = e1 == 0 ? 1 : 0; float v2 = -__builtin_inff();
#pragma unroll
            for (int e = 0; e < 8; ++e) if (e != e1 && lg[e] > v2) { v2 = lg[e]; e2 = e; }
            const float ex = __expf((v2 - v1) * rstd), p1 = 1.0f / (1.0f + ex), p2 = ex * p1;
            if (lane == 0) { tope[t] = e1 | (e2 << 8); topp[t] = (f32x2){p1, p2}; atomicAdd((int*)&lcnt[e1], 1); atomicAdd((int*)&lcnt[e2], 1); }
        }
        __syncthreads();
        if (tid < 8) cntb[vb * 8 + tid] = lcnt[tid];
        __syncthreads();
    }
    const int gw = blockIdx.x * 8 + wid, NGW = gridDim.x * 8;
    constexpr int I_1 = 16 * 56, I_13 = 2 * I_1, I_2 = 56 * 16;
    unsigned char* w13 = ws + WS_WMOE; unsigned char* w2t = ws + WS_WMOE + WMOE_W2;
    for (int it = gw; it < NE * (I_13 + I_2); it += NGW) {
        int r = it;
        if (r < NE * I_13) { const int e = r / I_13; r -= e * I_13; const int w = r / I_1; r -= w * I_1; const int kb = r / 56, nb = r % 56, n0 = 64 * nb;
            transpose_item_f8(a->in[19 + w] + (size_t)e * D * DFF, DFF, 64 * kb, n0, w13 + (size_t)e * (2 * DFF) * D + (size_t)pair_row(n0, w) * D, D, gn, w ? F8_W13_MUL * F8_ACT_MUL / LOG2E : F8_W13_MUL * LOG2E, lane); continue; }
        r -= NE * I_13;
        { const int e = r / I_2; r -= e * I_2; const int kb = r / 16, nb = r % 16, n0 = 64 * nb;
            transpose_item_f8(a->in[21] + (size_t)e * DFF * D, D, 64 * kb, n0, w2t + (size_t)e * D * DFF + (size_t)n0 * DFF, DFF, nullptr, F8_W2_MUL, lane); }
    }
}

__device__ __forceinline__ void scatter_phase(KArgs a, LAS unsigned char* lds, int tid, int wid, int lane) {
    asm volatile("" : "+v"(tid), "+v"(lane));
    unsigned char* ws = a->ws;
    const int* tope = (const int*)(ws + WS_SMALL + SM_TOPE); int* tslot = (int*)(ws + WS_SMALL + SM_TSLOT); float* ssperm = (float*)(ws + WS_SMALL + SM_SSPERM); int* meta = (int*)(ws + WS_SMALL + SM_META);
    const int* cntb = (const int*)(ws + WS_CTL + CTL_CNT); const f32x4* ss3 = (const f32x4*)(ws + WS_SS) + 3 * M;
    const bf16_t* X = (const bf16_t*)(ws + WS_XB); unsigned char* AP = ws + WS_APERM;
    LAS int* lc = (LAS int*)lds;
    LAS int* lbase = lc + 2048;
    LAS int* lslot = lc + 2064;
    LAS int* ltot = lc + 2200;
    for (int i = tid; i < 2048; i += 512) lc[i] = __hip_atomic_load(cntb + i, __ATOMIC_RELAXED, __HIP_MEMORY_SCOPE_AGENT);
    __syncthreads();
    for (int vb = blockIdx.x; vb < 256; vb += gridDim.x) {
        if (tid < 8) { int tot = 0, pre = 0;
#pragma unroll 8
            for (int b = 0; b < 256; ++b) { const int v = lc[b * 8 + tid]; tot += v; pre += (b < vb) ? v : 0; }
            ltot[tid] = tot; lbase[tid] = pre; }
        __syncthreads();
        if (tid == 0) { int off = 0;
            for (int e = 0; e < 8; ++e) { lbase[e] += off; if (vb == 0) meta[e] = off >> 8; off += (ltot[e] + 255) & ~255; }
            if (vb == 0) meta[8] = off >> 8; }
        __syncthreads();
        if (wid == 0) {
            const int t = vb * 64 + lane; const int te = tope[t]; const int e1 = te & 0xff, e2 = (te >> 8) & 0xff;
            int s1 = 0, s2 = 0;
#pragma unroll
            for (int k = 0; k < 2; ++k) { const int ek = k ? e2 : e1; int sk = 0;
#pragma unroll
                for (int e = 0; e < 8; ++e) { const unsigned long long mask = __ballot(ek == e); const int base = lbase[e]; LDS_WAIT();
                    const int rank = __popcll(mask & ((1ull << lane) - 1ull)); if (ek == e) sk = base + rank;
                    if (lane == 0) lbase[e] = base + __popcll(mask); LDS_WAIT(); }
                if (k) s2 = sk; else s1 = sk; }
            *(int2*)(tslot + 2 * t) = make_int2(s1, s2); lslot[lane] = s1; lslot[64 + lane] = s2;
        }
        __syncthreads();
        {
            u32x4 xv[8][2]; f32x4 sp[8];
#pragma unroll
            for (int i = 0; i < 8; ++i) { const int t = vb * 64 + wid + 8 * i; const u32x4* src = (const u32x4*)(X + (size_t)t * D) + 2 * lane; xv[i][0] = src[0]; xv[i][1] = src[1]; sp[i] = ss3[t]; }
#pragma unroll
            for (int i = 0; i < 8; ++i) { const int r = wid + 8 * i, s1 = lslot[r], s2 = lslot[64 + r];
                const float rstd = __builtin_amdgcn_rsqf(((sp[i][0] + sp[i][1]) + (sp[i][2] + sp[i][3])) * (1.0f / D) + RMS_EPS);
                f32x4 v0, v1, v2, v3; pg8::unpack8(xv[i][0], v0, v1); pg8::unpack8(xv[i][1], v2, v3);
                const u32x4 q = (u32x4){pk_fp8x4(v0 * rstd), pk_fp8x4(v1 * rstd), pk_fp8x4(v2 * rstd), pk_fp8x4(v3 * rstd)};
                *((u32x4*)(AP + (size_t)s1 * D) + lane) = q; *((u32x4*)(AP + (size_t)s2 * D) + lane) = q; } }
        __syncthreads();
    }
}

__device__ __forceinline__ void combine_phase(KArgs a, LAS unsigned char* lds, int tid, int wid, int lane) {
    asm volatile("" : "+v"(lane), "+v"(tid));
    unsigned char* ws = a->ws;
    LAS int* tmap = (LAS int*)lds; const bf16_t* YP = (const bf16_t*)(ws + WS_YP);
    int split;
    { const int nMraw = __builtin_amdgcn_readfirstlane(__hip_atomic_load((const int*)(ws + WS_SMALL + SM_META) + 8, __ATOMIC_RELAXED, __HIP_MEMORY_SCOPE_AGENT)); const int nM = nMraw > MAXSLOT / 256 ? MAXSLOT / 256 : nMraw;
      const int G = (int)gridDim.x, nU = 4 * nM, R = nU / G, tail = nU - R * G; split = (tail > 0 && pg8::MOE2_SPL * tail <= G) ? 1 : 0;
      for (int i = tid; i < 4 * (MAXSLOT / 256); i += 512) tmap[i] = -1;
      __syncthreads();
      if (split && tid < tail) { int pm, pn; if (pg8::tile_of(R * G + tid, nM, 4, pm, pn, 4)) tmap[4 * pm + pn] = tid; }
      __syncthreads(); }
    const bf16_t* X = (const bf16_t*)(ws + WS_XB); const unsigned char* Y = ws + WS_Y; const int* tslot = (const int*)(ws + WS_SMALL + SM_TSLOT); const f32x2* topp = (const f32x2*)(ws + WS_SMALL + SM_TOPP);
    const float* gf = a->in[22]; float* out = a->out;
    const int gw = blockIdx.x * 8 + wid, NGW = gridDim.x * 8;
    f32x4 gv[4];
#pragma unroll
    for (int h = 0; h < 2; ++h) { gv[2 * h] = *(const f32x4*)(gf + 512 * h + 8 * lane); gv[2 * h + 1] = *(const f32x4*)(gf + 512 * h + 8 * lane + 4); }
    for (int tb = gw; tb < M; tb += 4 * NGW) {
        int2 sl[4]; f32x2 p[4];
#pragma unroll
        for (int i = 0; i < 4; ++i) { const int t = min(tb + i * NGW, M - 1); sl[i] = *(const int2*)(tslot + 2 * t); p[i] = topp[t]; }
        u32x4 xr[4][2]; u32x2 ya[4][2], yb[4][2];
#pragma unroll
        for (int i = 0; i < 4; ++i) { const int t = min(tb + i * NGW, M - 1);
#pragma unroll
            for (int h = 0; h < 2; ++h) { const int col = 512 * h + 8 * lane;
                xr[i][h] = *(const u32x4*)(X + (size_t)t * D + col); ya[i][h] = *(const u32x2*)(Y + (size_t)sl[i].x * D + col); yb[i][h] = *(const u32x2*)(Y + (size_t)sl[i].y * D + col); } }
#pragma unroll
        for (int i = 0; i < 4; ++i) { const int t = tb + i * NGW; if (t < M) {
            f32x4 v[4]; float s = 0.f;
#pragma unroll
            for (int h = 0; h < 2; ++h) { f32x4 x0, x1; pg8::unpack8(xr[i][h], x0, x1); f32x4 a0 = pg8::un_fp8x4(ya[i][h].x) * (1.0f / F8_Y_MUL), a1 = pg8::un_fp8x4(ya[i][h].y) * (1.0f / F8_Y_MUL), b0 = pg8::un_fp8x4(yb[i][h].x) * (1.0f / F8_Y_MUL), b1 = pg8::un_fp8x4(yb[i][h].y) * (1.0f / F8_Y_MUL);
                if (split) { const int pn = 2 * h + (lane >> 5), cl = 8 * (lane & 31);
                    const int ka = tmap[4 * (sl[i].x >> 8) + pn], kb = tmap[4 * (sl[i].y >> 8) + pn];
                    if (ka >= 0) { a0 = (f32x4){0.f, 0.f, 0.f, 0.f}; a1 = a0;
                        for (int p = 0; p < pg8::MOE2_SPL; ++p) { f32x4 t0, t1; pg8::unpack8(*(const u32x4*)(YP + (size_t)(ka * pg8::MOE2_SPL + p) * 65536 + (size_t)(sl[i].x & 255) * 256 + cl), t0, t1); a0 += t0; a1 += t1; } }
                    if (kb >= 0) { b0 = (f32x4){0.f, 0.f, 0.f, 0.f}; b1 = b0;
                        for (int p = 0; p < pg8::MOE2_SPL; ++p) { f32x4 t0, t1; pg8::unpack8(*(const u32x4*)(YP + (size_t)(kb * pg8::MOE2_SPL + p) * 65536 + (size_t)(sl[i].y & 255) * 256 + cl), t0, t1); b0 += t0; b1 += t1; } } }
                v[2 * h] = x0 + a0 * p[i].x + b0 * p[i].y; v[2 * h + 1] = x1 + a1 * p[i].x + b1 * p[i].y; }
#pragma unroll
            for (int k = 0; k < 4; ++k) s += (v[k][0] * v[k][0] + v[k][1] * v[k][1]) + (v[k][2] * v[k][2] + v[k][3] * v[k][3]);
            const float rstd = __builtin_amdgcn_rsqf(wave_sum(s) * (1.0f / D) + RMS_EPS);
#pragma unroll
            for (int h = 0; h < 2; ++h) { const int col = 512 * h + 8 * lane;
                *(f32x4*)(out + (size_t)t * D + col) = v[2 * h] * rstd * gv[2 * h]; *(f32x4*)(out + (size_t)t * D + col + 4) = v[2 * h + 1] * rstd * gv[2 * h + 1]; } } }
    }
}

#ifndef WGM_INPROJ
#define WGM_INPROJ 4
#endif
#ifndef WGM_FFN1
#define WGM_FFN1 4
#endif
#ifndef WGM_MOE1
#define WGM_MOE1 4
#endif
constexpr int NPH = 18;
#ifndef MK_PH_MASK
#define MK_PH_MASK 0xFFFFFFFFu
#endif
#define PHON(bit) ((((MK_PH_MASK) >> (bit)) & 1u) != 0u)


__device__ __forceinline__ void ph_inproj(KArgs a, int layer, LAS unsigned char* lds) {
    unsigned char* ws = a->ws;
    {
        pg8::Gemm g{2 * D, 2 * D, 2 * D, 0, 0}; pg8::PlainSched S{M / 256, 16, (int)gridDim.x, (int)blockIdx.x, (const char*)(ws + WS_XB), (const char*)(ws + WS_W0 + W0_WIN + (size_t)layer * 18 * MiB), (size_t)256 * D * 2, (size_t)256 * D * 2, WGM_INPROJ, 1 << 30, 0};
        pg8::EpiSc E{(bf16_t*)(ws + A_YA), (bf16_t*)(ws + A_PP), (bf16_t*)(ws + A_PU), (const f32x4*)(ws + WS_SS) + (size_t)(layer * 2) * M, a->in[3] + layer * 3 * D, (float*)(ws + WS_HALO), (LAS float*)(lds + RED_OFF), (LAS float*)(lds + POOLX_OFF)};
        pg8::gemm_phase(lds, g, S, E);
    }
    __syncthreads();
    {
        pg8::Gemm g{D, D, D, F8_ONE, F8_W13_SC}; pg8::PlainSched S{M / 256, 20, (int)gridDim.x, (int)blockIdx.x, (const char*)(ws + WS_X8), (const char*)(ws + WS_WG8 + (size_t)layer * 5 * MiB), (size_t)256 * D, (size_t)256 * D, WGM_INPROJ, 1 << 30, 0};
        pg8::EpiProj E{(bf16_t*)(ws + A_GLU), (bf16_t*)(ws + A_GATES), (const f32x4*)(ws + WS_SS) + (size_t)(layer * 2) * M};
        pg8::gemm_phase<pg8::EpiProj, pg8::PlainSched, true>(lds, g, S, E);
    }
}
__device__ __forceinline__ void ph_fold(KArgs a, LAS unsigned char* lds) {
    unsigned char* ws = a->ws;
    pg8::Gemm g{512, 2 * D, 512, 0, 0}; pg8::FoldSched S{(int)gridDim.x, (int)blockIdx.x, (const char*)(ws + WS_W0 + W0_WOUT + 2 * 2 * MiB), (const char*)(ws + WS_W0 + W0_POOL)};
    pg8::EpiPlain E{(bf16_t*)(ws + WS_WC), D, (size_t)D * D};
    pg8::gemm_phase(lds, g, S, E);
}
__device__ __forceinline__ void ph_merge(KArgs a, int layer, LAS unsigned char* lds) {
    unsigned char* ws = a->ws;
    pg8::Gemm g{2 * D, 2 * D, 2 * D, 0, 0}; pg8::MergeSched S{(int)gridDim.x, (int)blockIdx.x, (const char*)(ws + A_YA), (const char*)(ws + WS_W0 + W0_WOUT + (size_t)(layer * 3) * 2 * MiB), (const char*)(ws + WS_WC + (size_t)layer * 2 * MiB), (size_t)32 * MiB, (size_t)2 * MiB};
    pg8::EpiMerge E{(const bf16_t*)(ws + A_GATES), (bf16_t*)(ws + A_MERGED)};
    pg8::gemm_phase(lds, g, S, E);
}
__device__ __forceinline__ void ph_wo(KArgs a, int layer, LAS unsigned char* lds) {
    unsigned char* ws = a->ws;
    pg8::Gemm g{2 * D, 2 * D, 2 * D, 0, 0}; pg8::PlainSched S{M / 256, D / 256, (int)gridDim.x, (int)blockIdx.x, (const char*)(ws + A_MERGED), (const char*)(ws + WS_W0 + W0_WO + (size_t)layer * 2 * MiB), (size_t)256 * D * 2, (size_t)256 * D * 2, 4, 1 << 30, 0};
    pg8::EpiResid E{(bf16_t*)(ws + WS_XB), (float*)(ws + WS_SS) + (size_t)(layer * 2 + 1) * M * 4, (LAS float*)(lds + RED_OFF), nullptr};
    pg8::gemm_phase(lds, g, S, E);
}
__device__ __forceinline__ void ph_ffn1(KArgs a, LAS unsigned char* lds) {
    unsigned char* ws = a->ws;
    pg8::Gemm g{2 * D, 2 * D, 2 * D, 0, 0}; pg8::PlainSched S{M / 256, 2 * DFF / 256, (int)gridDim.x, (int)blockIdx.x, (const char*)(ws + WS_XB), (const char*)(ws + WS_W0 + W0_D13), (size_t)256 * D * 2, (size_t)256 * D * 2, WGM_FFN1, 1 << 30, 0};
    pg8::EpiSwiGLU<true, false> E{(bf16_t*)(ws + A_FFN), DFF, (const float*)(ws + WS_SS) + (size_t)1 * M * 4};
    pg8::gemm_phase(lds, g, S, E);
}
__device__ __forceinline__ void ph_ffn2(KArgs a, LAS unsigned char* lds) {
    unsigned char* ws = a->ws;
    pg8::Gemm g{2 * DFF, 2 * DFF, 2 * DFF, 0, 0}; pg8::PlainSched S{M / 256, D / 256, (int)gridDim.x, (int)blockIdx.x, (const char*)(ws + A_FFN), (const char*)(ws + WS_W0 + W0_D2), (size_t)256 * DFF * 2, (size_t)256 * DFF * 2, 4, 1 << 30, 0};
    pg8::EpiResid E{(bf16_t*)(ws + WS_XB), (float*)(ws + WS_SS) + (size_t)2 * M * 4, (LAS float*)(lds + RED_OFF), ws + WS_X8};
    pg8::gemm_phase(lds, g, S, E);
}
__device__ __forceinline__ void ph_moe(KArgs a, int which, LAS unsigned char* lds) {
    unsigned char* ws = a->ws;
    const int* meta = (const int*)(ws + WS_SMALL + SM_META); int o[9];
#pragma unroll
    for (int e = 0; e < 9; ++e) o[e] = __builtin_amdgcn_readfirstlane(__hip_atomic_load(meta + e, __ATOMIC_RELAXED, __HIP_MEMORY_SCOPE_AGENT));
    const int nM = o[8] > MAXSLOT / 256 ? MAXSLOT / 256 : o[8];
    if (which == 0) {
        pg8::Gemm g{D, D, D, F8_ONE, F8_W13_SC}; pg8::GroupSched S{nM, 2 * DFF / 256, (int)gridDim.x, (int)blockIdx.x, o[1], o[2], o[3], o[4], o[5], o[6], o[7], (const char*)(ws + WS_APERM), (const char*)(ws + WS_WMOE), (size_t)256 * D, (size_t)256 * D, (size_t)2 * DFF * D, WGM_MOE1};
        pg8::EpiSwiGLU<false, true> E{(bf16_t*)(ws + WS_ACTP), DFF, nullptr};
        pg8::gemm_phase<pg8::EpiSwiGLU<false, true>, pg8::GroupSched, true>(lds, g, S, E);
    } else {
        const int G = (int)gridDim.x, nU = 4 * nM, R = nU / G, tail = nU - R * G, split = (tail > 0 && pg8::MOE2_SPL * tail <= G) ? 1 : 0;
        pg8::Gemm g{DFF, DFF, DFF, F8_ACT_SC, F8_W2_SC}; pg8::Moe2Sched S{nM, G, (int)blockIdx.x, R, tail, split, o[1], o[2], o[3], o[4], o[5], o[6], o[7], (const char*)(ws + WS_ACTP), (const char*)(ws + WS_WMOE + WMOE_W2), (size_t)256 * DFF, (size_t)256 * DFF, (size_t)D * DFF};
        pg8::EpiMoe2 E{ws + WS_Y, (bf16_t*)(ws + WS_YP)};
        pg8::gemm_phase<pg8::EpiMoe2, pg8::Moe2Sched, true>(lds, g, S, E);
    }
}

__global__ void __launch_bounds__(512, 2) fwd(Args unused_args_read_through_kargs) {
    extern __shared__ __attribute__((aligned(16))) unsigned char lds_raw[];
    LAS unsigned char* lds = (LAS unsigned char*)lds_raw;
    volatile LAS unsigned* MISC = (volatile LAS unsigned*)(lds + MISC_OFF);
    const int tid = threadIdx.x, lane = tid & 63, wid = __builtin_amdgcn_readfirstlane(tid >> 6);
    if (tid < 64) MISC[tid] = 0u;
    __syncthreads();
    int lo, hi; XcdBarrier bar;
    { KArgs a = kargs(); lo = a->ph_lo; hi = a->ph_hi; unsigned* bw = (unsigned*)(a->ws + WS_CTL + CTL_BAR); bar.bar = bw; bar.x = 0; bar.st = nullptr; if (hi - lo > 1) bar = xcd_barrier_post(bw, MISC + 8); }
#define IN(k) (lo <= (k) && (k) < hi)
#define SEAM(k) do { if (IN(k) && IN((k) + 1)) xcd_barrier(bar); } while (0)

    if (PHON(0) && IN(0)) { for (int rp = 0; rp < REPS(0); ++rp) { prologue_phase(kargs(), lds, wid, lane); __syncthreads(); } } SEAM(0);
#pragma nounroll
    for (int layer = 0; layer < 2; ++layer) {
        const int pb = 1 + 7 * layer;
        if (PHON(1) && IN(pb + 0)) { for (int rp = 0; rp < REPS(1); ++rp) { if (layer == 0) { ph_fold(kargs(), lds); __syncthreads(); } ph_inproj(kargs(), layer, lds); __syncthreads(); } } SEAM(pb + 0);
        if (PHON(2) && IN(pb + 1)) { for (int rp = 0; rp < REPS(2); ++rp) { conv_phase(kargs(), layer, lds, tid, wid, lane); __syncthreads(); } } SEAM(pb + 1);
        if (PHON(4) && IN(pb + 3)) { for (int rp = 0; rp < REPS(4); ++rp) { ph_merge(kargs(), layer, lds); __syncthreads(); } } SEAM(pb + 3);
        if (PHON(5) && IN(pb + 4)) { for (int rp = 0; rp < (layer == 0 ? REPS(5) : 1); ++rp) { ph_wo(kargs(), layer, lds); __syncthreads(); } } SEAM(pb + 4);
        if (layer == 0) {
            if (PHON(6) && IN(6)) { for (int rp = 0; rp < REPS(6); ++rp) { ph_ffn1(kargs(), lds); __syncthreads(); } } SEAM(6);
            if (PHON(7) && IN(7)) { ph_ffn2(kargs(), lds); } SEAM(7);
        }
    }
    if (PHON(13) && IN(13)) { for (int rp = 0; rp < REPS(13); ++rp) { route_phase(kargs(), lds, tid, wid, lane); __syncthreads(); } } SEAM(13);
    if (PHON(14) && IN(14)) { for (int rp = 0; rp < REPS(14); ++rp) { scatter_phase(kargs(), lds, tid, wid, lane); __syncthreads(); } } SEAM(14);
    if (PHON(15) && IN(15)) { for (int rp = 0; rp < REPS(15); ++rp) { ph_moe(kargs(), 0, lds); __syncthreads(); } } SEAM(15);
    if (PHON(16) && IN(16)) { for (int rp = 0; rp < REPS(16); ++rp) { ph_moe(kargs(), 1, lds); __syncthreads(); } } SEAM(16);
    if (PHON(17) && IN(17)) { for (int rp = 0; rp < REPS(17); ++rp) { combine_phase(kargs(), lds, tid, wid, lane); __syncthreads(); } }
#undef IN
#undef SEAM
}

extern "C" void kernel_launch(void* const* d_in, const int* in_sizes, int n_in, void* d_out, int out_size, void* d_ws, size_t ws_size, hipStream_t stream) {
    static int grid = 0;
    if (grid == 0) {
        if (n_in != 23 || in_sizes[0] != M * D || out_size != M * D || ws_size < WS_END) { fprintf(stderr, "kernel_launch: unexpected shapes: n_in %d in0 %d out %d ws %zu (need %zu); nothing launched\n", n_in, n_in > 0 ? in_sizes[0] : -1, out_size, ws_size, (size_t)WS_END); grid = -1; return; }
        int dev = 0, cus = 0, per_cu = 0;
        if (hipGetDevice(&dev) != hipSuccess || hipDeviceGetAttribute(&cus, hipDeviceAttributeMultiprocessorCount, dev) != hipSuccess) { fprintf(stderr, "kernel_launch: device query failed\n"); grid = -1; return; }
        if (hipFuncSetAttribute((const void*)fwd, hipFuncAttributeMaxDynamicSharedMemorySize, LDS_BYTES) != hipSuccess) { fprintf(stderr, "kernel_launch: hipFuncSetAttribute failed\n"); grid = -1; return; }
        if (hipOccupancyMaxActiveBlocksPerMultiprocessor(&per_cu, (const void*)fwd, 512, LDS_BYTES) != hipSuccess || per_cu < 1) fprintf(stderr, "kernel_launch: note: occupancy query reports %d workgroups per CU\n", per_cu);
        (void)hipGetLastError();
        grid = cus;
    }
    if (grid < 0) return;
    if (hipMemsetAsync((char*)d_ws + WS_CTL, 0, CTL_BYTES, stream) != hipSuccess) { fprintf(stderr, "kernel_launch: memset failed\n"); return; }
    Args a{};
    for (int i = 0; i < 23; ++i) a.in[i] = (const float*)d_in[i];
    a.out = (float*)d_out; a.ws = (unsigned char*)d_ws;
#if MK_PER_PHASE
    for (int ph = 0; ph < NPH; ++ph) { a.ph_lo = ph; a.ph_hi = ph + 1; hipLaunchKernelGGL(fwd, dim3(grid), dim3(512), LDS_BYTES, stream, a); }
#else
    a.ph_lo = 0; a.ph_hi = NPH; hipLaunchKernelGGL(fwd, dim3(grid), dim3(512), LDS_BYTES, stream, a);
#endif
    const hipError_t le = hipPeekAtLastError();
    if (le != hipSuccess) fprintf(stderr, "kernel_launch: launch failed: %s\n", hipGetErrorName(le));
}
```

```cpp
#include <hip/hip_runtime.h>
#include <cstdio>
#include <cstdint>

#ifndef MK_PER_PHASE
#define MK_PER_PHASE 0
#endif

#ifndef MK_REP_MASK
#define MK_REP_MASK 0u
#endif
#define REPS(bit) (1 + (int)(((MK_REP_MASK) >> (bit)) & 1u))
#define REPS2(bit) REPS(bit)

#define LAS __attribute__((address_space(3)))
typedef unsigned short bf16_t;
typedef short bf16x8 __attribute__((ext_vector_type(8)));
typedef float f32x4 __attribute__((ext_vector_type(4)));
typedef float f32x2 __attribute__((ext_vector_type(2)));
typedef unsigned u32x4 __attribute__((ext_vector_type(4)));
typedef unsigned u32x2 __attribute__((ext_vector_type(2)));

constexpr int M = 16384, D = 1024, SEQ = 8192, INC = 9216, DFF = 3584, NE = 8;
constexpr float RMS_EPS = 1e-6f, LN_EPS = 1e-5f;
constexpr int MAXSLOT = 34816;
constexpr float F8_W13_MUL = 128.f, F8_ACT_MUL = 4.f, F8_W2_MUL = 256.f, F8_Y_MUL = 32.f;
constexpr int F8_ONE = 0x7f7f7f7f, F8_W13_SC = 0x78787878  , F8_ACT_SC = 0x7d7d7d7d  , F8_W2_SC = 0x77777777  ;

constexpr size_t MiB = 1u << 20;
constexpr size_t WS_CTL = 0, CTL_BYTES = 64 * 1024;
constexpr size_t CTL_BAR = 16384;
constexpr size_t CTL_CNT = 32768;
constexpr size_t WS_SMALL = 1 * MiB;
constexpr size_t SM_TOPE = 0, SM_TOPP = 64 * 1024, SM_TSLOT = 192 * 1024, SM_SSPERM = 320 * 1024, SM_META = 512 * 1024;
constexpr size_t WS_X8 = 2 * MiB;
constexpr size_t WS_YP = 18 * MiB;
constexpr size_t WS_WG8 = 492 * MiB;
constexpr size_t WS_XB = 66 * MiB;
constexpr size_t WS_W0 = 98 * MiB;
constexpr size_t W0_WIN = 0;
constexpr size_t W0_WOUT = 36 * MiB;
constexpr size_t W0_WO = 48 * MiB;
constexpr size_t W0_POOL = 52 * MiB;
constexpr size_t W0_D13 = 53 * MiB;
constexpr size_t W0_D2 = 67 * MiB;
constexpr size_t WS_ACT = 172 * MiB;
constexpr size_t A_SCB = WS_ACT, A_SCX = WS_ACT + 32 * MiB, A_GLU = WS_ACT + 64 * MiB, A_PU = WS_ACT + 96 * MiB, A_GATES = WS_ACT + 128 * MiB,
                 A_YA = WS_ACT + 224 * MiB, A_VB = WS_ACT + 256 * MiB, A_PP = WS_ACT + 288 * MiB, A_MERGED = A_SCX, A_FFN = WS_ACT;
constexpr size_t WS_HALO = 528 * MiB;
constexpr size_t WS_WC = 524 * MiB;
constexpr size_t WS_ACTP = 98 * MiB;
constexpr size_t WS_WMOE = 304 * MiB, WMOE_W2 = 56 * MiB;
constexpr size_t WS_Y = 400 * MiB;
constexpr size_t WS_APERM = 472 * MiB;
constexpr size_t WS_SS = 540 * MiB;
constexpr size_t WS_END = 541 * MiB;

typedef __bf16 bf16x2_t __attribute__((ext_vector_type(2)));
__device__ __forceinline__ unsigned pk_bf16(float lo, float hi) { const bf16x2_t v = {(__bf16)lo, (__bf16)hi}; return __builtin_bit_cast(unsigned, v); }
__device__ __forceinline__ unsigned pk_fp8x4(const f32x4 v) {
    const float a = __builtin_amdgcn_fmed3f(v[0], -448.f, 448.f), b = __builtin_amdgcn_fmed3f(v[1], -448.f, 448.f), c = __builtin_amdgcn_fmed3f(v[2], -448.f, 448.f), d = __builtin_amdgcn_fmed3f(v[3], -448.f, 448.f);
    int w = 0; w = __builtin_amdgcn_cvt_pk_fp8_f32(a, b, w, false); w = __builtin_amdgcn_cvt_pk_fp8_f32(c, d, w, true); return (unsigned)w; }
__device__ __forceinline__ float bf_lo(unsigned u) { return __uint_as_float(u << 16); }
__device__ __forceinline__ float bf_hi(unsigned u) { return __uint_as_float(u & 0xffff0000u); }
__device__ __forceinline__ float sigm(float x) { return __builtin_amdgcn_rcpf(1.f + __builtin_amdgcn_exp2f(-1.44269504f * x)); }
constexpr float LOG2E = 1.44269504f;
__device__ __forceinline__ float sigm2(float xl) { return __builtin_amdgcn_rcpf(1.f + __builtin_amdgcn_exp2f(-xl)); }
__device__ __forceinline__ float wave_sum(float v) {
#pragma unroll
    for (int o = 1; o < 64; o <<= 1) v += __shfl_xor(v, o);
    return v;
}
#define LDS_WAIT() asm volatile("s_waitcnt lgkmcnt(0)" ::: "memory")

namespace pg8 {
constexpr int BM = 256, BK = 64, HALF = 128, HTB = HALF * BK * 2, STAGE_BYTES = 8 * HTB, NXCD = 8;
__host__ __device__ __forceinline__ int lds_byte(int r, int c) { const int st = (r >> 4) * 2 + (c >> 5), rr = r & 15, cc = c & 31, ob = rr * 64 + cc * 2; return st * 1024 + (ob ^ (((ob >> 9) & 1) << 5)); }
__host__ __device__ __forceinline__ void stage_rc(int b, int& R, int& C) { const int st = b / 1024, sb = b % 1024, swz = sb ^ (((sb >> 9) & 1) << 5); R = (st >> 1) * 16 + swz / 64; C = (st & 1) * 32 + (swz % 64) / 2; }
__host__ __device__ __forceinline__ int perm32(int rho) { const int n = rho >> 4, i = rho & 15; return 8 * (i >> 2) + 4 * n + (i & 3); }

struct Unit { int pm, pn, aux, nt; const char* A; const char* B; };
struct Gemm { int Kb, lda, ldb; int sa, sb; };

__device__ __forceinline__ bool tile_of(int L, int nM, int nN, int& pm, int& pn, int WGM = 4) {
    const int nwg = nM * nN; if (L >= nwg) return false;
    int wgid = L; { const int q = nwg / NXCD, r = nwg % NXCD, xcd = wgid % NXCD, off = wgid / NXCD; wgid = (xcd < r ? xcd * (q + 1) : r * (q + 1) + (xcd - r) * q) + off; }
    const int nig = WGM * nN, gid = wgid / nig, fm = gid * WGM, gsz = (nM - fm) < WGM ? (nM - fm) : WGM;
    pm = fm + ((wgid % nig) % gsz); pn = (wgid % nig) / gsz; return true;
}
struct PlainSched {
    int nM, nN, G, c; const char* A0; const char* B0; size_t astep, bstep; int wgm; int bsplit, badd;
    __device__ __forceinline__ bool next(int i, Unit& u) const { int pm, pn; if (!tile_of(i * G + c, nM, nN, pm, pn, wgm)) return false; u.pm = pm; u.pn = pn; u.aux = 0; u.nt = 0; u.A = A0 + (size_t)pm * astep; u.B = B0 + (size_t)(pn + (pn >= bsplit ? badd : 0)) * bstep; return true; }
};
struct PoolSched {
    int G, c; const char* A0; const char* B0;
    __device__ __forceinline__ bool next(int i, Unit& u) const { int pm, pn; if (!tile_of(i * G + c, M / 256, 4, pm, pn)) return false; u.pm = pm; u.pn = pn; u.aux = 0; u.nt = 0;
        u.A = A0 + (size_t)pm * (256 * 1024 * 2) + (size_t)pn * 512; u.B = B0 + (size_t)pn * (256 * 256 * 2); return true; }
};
struct MergeSched {
    int G, c; const char *A0, *B0, *B2; size_t astr, bstr;
    __device__ __forceinline__ bool next(int i, Unit& u) const { const int t = i / 3, b = i - 3 * t; int pm, pn; if (!tile_of(t * G + c, M / 256, 4, pm, pn)) return false; u.pm = pm; u.pn = pn; u.aux = b; u.nt = 0;
        const char* w = b == 2 ? B2 : B0 + (size_t)b * bstr;
        u.A = A0 + (size_t)b * astr + (size_t)pm * (256 * 1024 * 2); u.B = w + (size_t)pn * (256 * 1024 * 2); return true; }
};
struct FoldSched {
    int G, c; const char *A0, *B0;
    __device__ __forceinline__ bool next(int i, Unit& u) const { const int idx = i * G + c; if (idx >= 32) return false; const int L = idx >> 4, pm = (idx >> 2) & 3, g = idx & 3; u.pm = pm; u.pn = g; u.aux = L; u.nt = 0;
        u.A = A0 + (size_t)L * (6 * MiB) + (size_t)pm * (256 * 1024 * 2) + (size_t)g * 512; u.B = B0 + (size_t)L * (512 * 1024) + (size_t)g * (256 * 256 * 2); return true; }
};
struct GroupSched {
    int nM, nN, G, c; int o1, o2, o3, o4, o5, o6, o7; const char* A0; const char* B0; size_t astep, bstep, estep; int wgm;
    __device__ __forceinline__ bool next(int i, Unit& u) const { int pm, pn; if (!tile_of(i * G + c, nM, nN, pm, pn, wgm)) return false; u.pm = pm; u.pn = pn; u.aux = 0; u.nt = 0;
        const int e = (pm >= o1) + (pm >= o2) + (pm >= o3) + (pm >= o4) + (pm >= o5) + (pm >= o6) + (pm >= o7);
        u.A = A0 + (size_t)pm * astep; u.B = B0 + (size_t)e * estep + (size_t)pn * bstep; return true; }
};

constexpr int MOE2_SPL = 7, MOE2_SNT = 4;
struct Moe2Sched {
    int nM, G, c, R, tail, split; int o1, o2, o3, o4, o5, o6, o7; const char* A0; const char* B0; size_t astep, bstep, estep;
    __device__ __forceinline__ bool next(int i, Unit& u) const {
        int L = i * G + c, part = -1, sub = 0;
        if (split && i >= R) { if (i > R || c >= MOE2_SPL * tail) return false; sub = c; L = R * G + c / MOE2_SPL; part = c % MOE2_SPL; }
        int pm, pn; if (!tile_of(L, nM, 4, pm, pn, 4)) return false; u.pm = pm; u.pn = pn;
        const int e = (pm >= o1) + (pm >= o2) + (pm >= o3) + (pm >= o4) + (pm >= o5) + (pm >= o6) + (pm >= o7);
        u.A = A0 + (size_t)pm * astep; u.B = B0 + (size_t)e * estep + (size_t)pn * bstep; u.aux = 0; u.nt = 0;
        if (part >= 0) { u.A += part * (MOE2_SNT * 128); u.B += part * (MOE2_SNT * 128); u.aux = 1 + sub; u.nt = MOE2_SNT; }
        return true; }
};

typedef f32x4 Acc[2][2][4][2];
__device__ __forceinline__ u32x4 pack8(const f32x4 v0, const f32x4 v1) { u32x4 w; w.x = pk_bf16(v0[0], v0[1]); w.y = pk_bf16(v0[2], v0[3]); w.z = pk_bf16(v1[0], v1[1]); w.w = pk_bf16(v1[2], v1[3]); return w; }
__device__ __forceinline__ f32x4 sig4l(const f32x4 v) { f32x4 r; r[0] = sigm2(v[0]); r[1] = sigm2(v[1]); r[2] = sigm2(v[2]); r[3] = sigm2(v[3]); return r; }
__device__ __forceinline__ void unpack8(const u32x4 g, f32x4& lo, f32x4& hi) { lo[0] = bf_lo(g.x); lo[1] = bf_hi(g.x); lo[2] = bf_lo(g.y); lo[3] = bf_hi(g.y); hi[0] = bf_lo(g.z); hi[1] = bf_hi(g.z); hi[2] = bf_lo(g.w); hi[3] = bf_hi(g.w); }

__device__ __forceinline__ size_t gate_frag(int pm, int q, int wid, int ai, int m, int lane) { return ((size_t)(((((pm * 12 + q) * 8 + wid) * 2 + ai) * 4 + m) * 64 + lane)) * 16; }
__device__ __forceinline__ unsigned pk_fp8x4_raw(const f32x4 v) { int w = 0; w = __builtin_amdgcn_cvt_pk_fp8_f32(v[0], v[1], w, false); w = __builtin_amdgcn_cvt_pk_fp8_f32(v[2], v[3], w, true); return (unsigned)w; }
__device__ __forceinline__ f32x4 un_fp8x4(unsigned w) { const f32x2 lo = __builtin_amdgcn_cvt_pk_f32_fp8((int)w, false), hi = __builtin_amdgcn_cvt_pk_f32_fp8((int)w, true); return (f32x4){lo[0], lo[1], hi[0], hi[1]}; }
struct EpiProj {
    static constexpr bool INIT = false;
    bf16_t *glu, *gates; const f32x4* ss;
    __device__ __forceinline__ bool operator()(Acc& acc, const Unit& u, int wr, int wc, int fr, int fq) const {
        const int row0 = u.pm * BM + wr * 64 + fr, pn = u.pn;
        float rs[2][4];
#pragma unroll
        for (int ai = 0; ai < 2; ++ai)
#pragma unroll
            for (int m = 0; m < 4; ++m) { const f32x4 p = ss[row0 + ai * HALF + m * 16]; rs[ai][m] = __builtin_amdgcn_rsqf(((p[0] + p[1]) + (p[2] + p[3])) * (1.0f / D) + RMS_EPS); }
        if (pn < 8) {
            const int col0 = pn * 128 + wc * 32 + 8 * fq;
#pragma unroll
            for (int ai = 0; ai < 2; ++ai)
#pragma unroll
                for (int m = 0; m < 4; ++m) { const float r = rs[ai][m];
                    const f32x4 a0 = acc[ai][0][m][0] * r, a1 = acc[ai][0][m][1] * r, b0 = sig4l(acc[ai][1][m][0] * r), b1 = sig4l(acc[ai][1][m][1] * r);
                    *(u32x4*)(glu + (size_t)(row0 + ai * HALF + m * 16) * D + col0) = pack8(a0 * b0, a1 * b1); }
        } else {
#pragma unroll
            for (int ai = 0; ai < 2; ++ai)
#pragma unroll
                for (int m = 0; m < 4; ++m) { const float r = -1.44269504f * rs[ai][m]; u32x4 w;
#pragma unroll
                    for (int bj = 0; bj < 2; ++bj) { f32x4 e0 = acc[ai][bj][m][0] * r, e1 = acc[ai][bj][m][1] * r;
#pragma unroll
                        for (int j = 0; j < 4; ++j) { e0[j] = __builtin_amdgcn_exp2f(__builtin_amdgcn_fmed3f(e0[j], -8.65617f, 8.65617f)); e1[j] = __builtin_amdgcn_exp2f(__builtin_amdgcn_fmed3f(e1[j], -8.65617f, 8.65617f)); }
                        w[2 * bj] = pk_fp8x4_raw(e0); w[2 * bj + 1] = pk_fp8x4_raw(e1); }
                    *(u32x4*)((unsigned char*)gates + gate_frag(u.pm, pn - 8, wr * 4 + wc, ai, m, fr + 16 * fq)) = w; }
        }
        return false;
    }
};
template <int CTRL> __device__ __forceinline__ float dpp_f(float old, float src) { return __int_as_float(__builtin_amdgcn_update_dpp(__float_as_int(old), __float_as_int(src), CTRL, 0xf, 0xf, false)); }
struct EpiSc {
    static constexpr bool INIT = false;
    bf16_t *ya, *pp, *pu; const f32x4* ss; const float* scw; float* halo; LAS float* ex; LAS float* px;
    __device__ __forceinline__ bool operator()(Acc& acc, const Unit& u, int wr, int wc, int fr, int fq) const {
        const int row0 = u.pm * BM + wr * 64 + fr, ch0 = u.pn * 64 + wc * 16 + fq * 4;
        const int g = __builtin_amdgcn_readfirstlane(u.pn >> 2);
#pragma unroll
        for (int ai = 0; ai < 2; ++ai)
#pragma unroll
            for (int m = 0; m < 4; ++m) { const f32x4 p = ss[row0 + ai * HALF + m * 16]; const float r = __builtin_amdgcn_rsqf(((p[0] + p[1]) + (p[2] + p[3])) * (1.0f / D) + RMS_EPS);
                acc[ai][0][m][0] = acc[ai][0][m][0] * r; acc[ai][0][m][1] = (acc[ai][0][m][1] * r) * (acc[ai][1][m][0] * r); acc[ai][1][m][1] = acc[ai][1][m][1] * r; acc[ai][1][m][0] = acc[ai][1][m][1]; }
        if (fr >= 14) {
#pragma unroll
            for (int ai = 0; ai < 2; ++ai) *(LAS f32x4*)(ex + ((((ai * 2 + wr) * 4 + wc) * 4 + fq) * 2 + (fr - 14)) * 4) = acc[ai][0][3][1];
            if (wr == 1) *(f32x4*)(halo + ((size_t)((2 * 64 + u.pm) * 2 + (fr - 14))) * D + ch0) = acc[1][0][3][1];
        }
        if (wr == 0 && fr < 2) { *(f32x4*)(halo + ((size_t)((0 * 64 + u.pm) * 2 + fr)) * D + ch0) = acc[0][0][0][0]; *(f32x4*)(halo + ((size_t)((1 * 64 + u.pm) * 2 + fr)) * D + ch0) = acc[0][0][0][1]; }
        if (wr == 0) { const f32x4 v = acc[0][1][0][1]; *(u32x2*)(pu + (size_t)row0 * D + ch0) = (u32x2){pk_bf16(v[0], v[1]), pk_bf16(v[2], v[3])}; }
        else { const f32x4 v = acc[1][1][3][1]; *(u32x2*)(pu + (size_t)(row0 + HALF + 48) * D + ch0) = (u32x2){pk_bf16(v[0], v[1]), pk_bf16(v[2], v[3])}; }
#pragma unroll
        for (int ai = 0; ai < 2; ++ai) { LAS float* eb = px + ((((ai * 2 + wr) * 4 + wc) * 4 + fq) * 15) * 4;
#define POOL_STEP(DSH, ROR, SHR) do { if (fr >= 16 - DSH) *(LAS f32x4*)(eb + (DSH - 1 + fr - (16 - DSH)) * 4) = acc[ai][1][3][0]; \
            _Pragma("unroll") for (int m = 3; m >= 0; --m) { _Pragma("unroll") for (int j = 0; j < 4; ++j) { float f = 0.f; if (m > 0) f = dpp_f<ROR>(0.f, acc[ai][1][m - 1][0][j]); acc[ai][1][m][0][j] += dpp_f<SHR>(f, acc[ai][1][m][0][j]); } } } while (0)
            POOL_STEP(1, 0x121, 0x111);
            if (g >= 1) POOL_STEP(2, 0x122, 0x112);
            if (g >= 2) POOL_STEP(4, 0x124, 0x114);
            if (g >= 3) POOL_STEP(8, 0x128, 0x118);
#undef POOL_STEP
        }
        const f32x4 w0 = *(const f32x4*)(scw + ch0), w1 = *(const f32x4*)(scw + D + ch0), w2 = *(const f32x4*)(scw + 2 * D + ch0);
        asm volatile("s_waitcnt lgkmcnt(0)" ::: "memory"); __builtin_amdgcn_s_barrier(); asm volatile("" ::: "memory");
        const float invw = 0.5f / (float)(1 << g);
#pragma unroll
        for (int ai = 0; ai < 2; ++ai) {
            f32x4 F1 = (f32x4){0.f, 0.f, 0.f, 0.f}, F2 = F1;
            if (ai + wr > 0) { const int pb = 2 * ai + wr - 1; const LAS float* e = ex + (((pb * 4 + wc) * 4 + fq) * 2) * 4; const f32x4 E0 = *(const LAS f32x4*)e, E1 = *(const LAS f32x4*)(e + 4); F1 = E1; F2 = fr == 0 ? E0 : E1;
                const LAS float* pe = px + (((pb * 4 + wc) * 4 + fq) * 15) * 4; f32x4 t = acc[ai][1][0][1];
#define POOL_REDO(DSH, SHR) do { const f32x4 f = *(const LAS f32x4*)(pe + (DSH - 1 + (fr & (DSH - 1))) * 4); _Pragma("unroll") for (int j = 0; j < 4; ++j) t[j] += dpp_f<SHR>(f[j], t[j]); } while (0)
                POOL_REDO(1, 0x111);
                if (g >= 1) POOL_REDO(2, 0x112);
                if (g >= 2) POOL_REDO(4, 0x114);
                if (g >= 3) POOL_REDO(8, 0x118);
#undef POOL_REDO
                acc[ai][1][0][0] = t; }
#pragma unroll
            for (int m = 0; m < 4; ++m) { const f32x4 pr = acc[ai][0][m][1]; f32x4 y;
                if (m > 0) { const f32x4 pv = acc[ai][0][m - 1][1];
#pragma unroll
                    for (int j = 0; j < 4; ++j) { F1[j] = dpp_f<0x121>(0.f, pv[j]); F2[j] = dpp_f<0x122>(0.f, pv[j]); } }
#pragma unroll
                for (int j = 0; j < 4; ++j) { const float p1 = dpp_f<0x111>(F1[j], pr[j]), p2 = dpp_f<0x112>(F2[j], pr[j]); y[j] = acc[ai][0][m][0][j] * (w0[j] * p2 + w1[j] * p1 + w2[j] * pr[j]); }
                const f32x4 q = acc[ai][1][m][0] * invw - acc[ai][1][m][1];
                const auto s0 = __builtin_amdgcn_permlane16_swap(pk_bf16(y[0], y[1]), pk_bf16(q[0], q[1]), false, false), s1 = __builtin_amdgcn_permlane16_swap(pk_bf16(y[2], y[3]), pk_bf16(q[2], q[3]), false, false);
                *(u32x4*)(ya + (ptrdiff_t)(fq & 1) * (pp - ya) + (size_t)(row0 + ai * HALF + m * 16) * D + (ch0 & ~7)) = (u32x4){s0[0], s1[0], s0[1], s1[1]}; }
        }
        return false;
    }
};
struct EpiPlain {
    static constexpr bool INIT = false;
    bf16_t* Ob; int ldc; size_t aux_stride;
    __device__ __forceinline__ bool operator()(Acc& acc, const Unit& u, int wr, int wc, int fr, int fq) const {
        bf16_t* O = Ob + (size_t)u.aux * aux_stride;
        const int row0 = u.pm * BM + wr * 64 + fr, col0 = u.pn * BM + wc * 32 + 8 * fq;
#pragma unroll
        for (int ai = 0; ai < 2; ++ai)
#pragma unroll
            for (int m = 0; m < 4; ++m) { bf16_t* rowp = O + (size_t)(row0 + ai * HALF + m * 16) * ldc + col0;
#pragma unroll
                for (int bj = 0; bj < 2; ++bj) *(u32x4*)(rowp + bj * HALF) = pack8(acc[ai][bj][m][0], acc[ai][bj][m][1]); }
        return false;
    }
};
struct EpiMoe2 {
    static constexpr bool INIT = false;
    unsigned char* Y; bf16_t* YP;
    __device__ __forceinline__ bool operator()(Acc& acc, const Unit& u, int wr, int wc, int fr, int fq) const {
        if (u.aux) { bf16_t* O = YP + (size_t)(u.aux - 1) * 65536 + (size_t)(wr * 64 + fr) * 256 + wc * 32 + 8 * fq;
#pragma unroll
            for (int ai = 0; ai < 2; ++ai)
#pragma unroll
                for (int m = 0; m < 4; ++m) { bf16_t* rowp = O + (size_t)(ai * HALF + m * 16) * 256;
#pragma unroll
                    for (int bj = 0; bj < 2; ++bj) *(u32x4*)(rowp + bj * HALF) = pack8(acc[ai][bj][m][0], acc[ai][bj][m][1]); }
        } else {
            unsigned char* O = Y + (size_t)(u.pm * BM + wr * 64 + fr) * D + u.pn * BM + wc * 32 + 8 * (fq & ~1) + (fq & 1) * HALF;
#pragma unroll
            for (int ai = 0; ai < 2; ++ai)
#pragma unroll
                for (int m = 0; m < 4; ++m) {
                    const auto s0 = __builtin_amdgcn_permlane16_swap(pk_fp8x4(acc[ai][0][m][0] * F8_Y_MUL), pk_fp8x4(acc[ai][1][m][0] * F8_Y_MUL), false, false),
                               s1 = __builtin_amdgcn_permlane16_swap(pk_fp8x4(acc[ai][0][m][1] * F8_Y_MUL), pk_fp8x4(acc[ai][1][m][1] * F8_Y_MUL), false, false);
                    *(u32x4*)(O + (size_t)(ai * HALF + m * 16) * D) = (u32x4){s0[0], s1[0], s0[1], s1[1]}; }
        }
        return false;
    }
};
struct EpiMerge {
    static constexpr bool INIT = false;
    const bf16_t* gates; bf16_t* O;
    __device__ __forceinline__ bool operator()(Acc& acc, const Unit& u, int wr, int wc, int fr, int fq) const {
        const int row0 = u.pm * BM + wr * 64 + fr, col0 = u.pn * BM + wc * 32 + 8 * fq, b = u.aux;
#pragma unroll
        for (int ai = 0; ai < 2; ++ai)
#pragma unroll
            for (int m = 0; m < 4; ++m) { const size_t row = (size_t)(row0 + ai * HALF + m * 16);
                const unsigned char* gp = (const unsigned char*)gates + gate_frag(u.pm, 4 * b + u.pn, wr * 4 + wc, ai, m, fr + 16 * fq);
                const u32x4 gw = *(const u32x4*)gp;
                if (b < 2) { const u32x4 hw = *(const u32x4*)(gp + gate_frag(0, 4, 0, 0, 0, 0));
#pragma unroll
                    for (int bj = 0; bj < 2; ++bj) { const f32x4 g0 = un_fp8x4(gw[2 * bj]), g1 = un_fp8x4(gw[2 * bj + 1]), h0 = un_fp8x4(hw[2 * bj]), h1 = un_fp8x4(hw[2 * bj + 1]);
#pragma unroll
                        for (int j = 0; j < 4; ++j) { acc[ai][bj][m][0][j] *= (1.f + h0[j]) * __builtin_amdgcn_rcpf(1.f + g0[j]); acc[ai][bj][m][1][j] *= (1.f + h1[j]) * __builtin_amdgcn_rcpf(1.f + g1[j]); } }
                } else {
#pragma unroll
                    for (int bj = 0; bj < 2; ++bj) { f32x4 g0 = un_fp8x4(gw[2 * bj]), g1 = un_fp8x4(gw[2 * bj + 1]);
#pragma unroll
                        for (int j = 0; j < 4; ++j) { g0[j] = __builtin_amdgcn_rcpf(1.f + g0[j]); g1[j] = __builtin_amdgcn_rcpf(1.f + g1[j]); }
                        *(u32x4*)(O + row * D + col0 + bj * HALF) = pack8(acc[ai][bj][m][0] * g0, acc[ai][bj][m][1] * g1); } } }
        return b < 2;
    }
};
struct EpiResid {
    static constexpr bool INIT = true;
    bf16_t* xb; float* ssp; LAS float* red; unsigned char* x8;
    __device__ __forceinline__ void init_load(Acc& acc, u32x4 (&raw)[16], const Unit& u, int wr, int wc, int fr, int fq) const {
        const int row0 = u.pm * BM + wr * 64 + fr, col0 = u.pn * BM + wc * 32 + 8 * fq;
#pragma unroll
        for (int ai = 0; ai < 2; ++ai)
#pragma unroll
            for (int m = 0; m < 4; ++m)
#pragma unroll
                for (int bj = 0; bj < 2; ++bj) { const size_t off = (size_t)(row0 + ai * HALF + m * 16) * D + col0 + bj * HALF;
                    raw[(ai * 4 + m) * 2 + bj] = *(const u32x4*)(xb + off); }
    }
    __device__ __forceinline__ void init_finish(Acc& acc, const u32x4 (&raw)[16]) const {
        {
#pragma unroll
            for (int ai = 0; ai < 2; ++ai)
#pragma unroll
                for (int m = 0; m < 4; ++m)
#pragma unroll
                    for (int bj = 0; bj < 2; ++bj) unpack8(raw[(ai * 4 + m) * 2 + bj], acc[ai][bj][m][0], acc[ai][bj][m][1]); }
    }
    __device__ __forceinline__ bool operator()(Acc& acc, const Unit& u, int wr, int wc, int fr, int fq) const {
        const int row0 = u.pm * BM + wr * 64 + fr, col0 = u.pn * BM + wc * 32 + 8 * fq;
#pragma unroll
        for (int ai = 0; ai < 2; ++ai)
#pragma unroll
            for (int m = 0; m < 4; ++m) { const size_t row = (size_t)(row0 + ai * HALF + m * 16); float q = 0.f;
#pragma unroll
                for (int bj = 0; bj < 2; ++bj) { const size_t off = row * D + col0 + bj * HALF;
                    const u32x4 pk = pack8(acc[ai][bj][m][0], acc[ai][bj][m][1]); *(u32x4*)(xb + off) = pk;
                    f32x4 o0, o1; unpack8(pk, o0, o1); if (x8) *(u32x2*)(x8 + off) = (u32x2){pk_fp8x4(o0), pk_fp8x4(o1)};
                    q += (o0[0] * o0[0] + o0[1] * o0[1]) + (o0[2] * o0[2] + o0[3] * o0[3]) + (o1[0] * o1[0] + o1[1] * o1[1]) + (o1[2] * o1[2] + o1[3] * o1[3]); }
                q += __shfl_xor(q, 16); q += __shfl_xor(q, 32);
                if (fq == 0) red[(ai * HALF + wr * 64 + m * 16 + fr) * 4 + wc] = q; }
        asm volatile("s_waitcnt lgkmcnt(0)" ::: "memory"); __builtin_amdgcn_s_barrier(); asm volatile("" ::: "memory");
        int tid = threadIdx.x; asm volatile("" : "+v"(tid));
        if (tid < 256) { const f32x4 v = *(const LAS f32x4*)(red + tid * 4); ssp[(size_t)(u.pm * BM + tid) * 4 + u.pn] = (v[0] + v[1]) + (v[2] + v[3]); }
        return false;
    }
};
template <bool PART4, bool OUT8> struct EpiSwiGLU {
    static constexpr bool INIT = false;
    bf16_t* O; int ldc; const float* ss;
    __device__ __forceinline__ bool operator()(Acc& acc, const Unit& u, int wr, int wc, int fr, int fq) const {
        const int row0 = u.pm * BM + wr * 64 + fr, col0 = u.pn * 128 + wc * 32 + 8 * fq;
#pragma unroll
        for (int ai = 0; ai < 2; ++ai)
#pragma unroll
            for (int m = 0; m < 4; ++m) { const size_t row = (size_t)(row0 + ai * HALF + m * 16); float r = 1.f;
                if (PART4) { const f32x4 p = *(const f32x4*)(ss + row * 4); r = __builtin_amdgcn_rsqf(((p[0] + p[1]) + (p[2] + p[3])) * (1.0f / D) + RMS_EPS); }
                f32x4 a0 = acc[ai][0][m][0], a1 = acc[ai][0][m][1], c0 = acc[ai][1][m][0], c1 = acc[ai][1][m][1];
                if (PART4) { a0 = a0 * r; a1 = a1 * r; c0 = c0 * r; c1 = c1 * r; }
                const f32x4 h0 = a0 * sig4l(a0) * c0, h1 = a1 * sig4l(a1) * c1;
                if (OUT8) { *(u32x2*)((unsigned char*)O + row * ldc + col0) = (u32x2){pk_fp8x4(h0), pk_fp8x4(h1)}; }
                else *(u32x4*)(O + row * ldc + col0) = pack8(h0, h1); }
        return false;
    }
};

typedef int i32x4 __attribute__((ext_vector_type(4)));
typedef int i32x8 __attribute__((ext_vector_type(8)));
__device__ __forceinline__ i32x8 join16(const bf16x8 lo, const bf16x8 hi) { return __builtin_shufflevector(__builtin_bit_cast(i32x4, lo), __builtin_bit_cast(i32x4, hi), 0, 1, 2, 3, 4, 5, 6, 7); }
template <class Epi, class Sched, bool F8 = false>
__device__ __forceinline__ void gemm_phase(LAS unsigned char* lds, const Gemm g, const Sched& S, const Epi& E) {
    int tid_ = threadIdx.x; asm volatile("" : "+v"(tid_));
    const int tid = tid_, wid = __builtin_amdgcn_readfirstlane(tid >> 6), lane = tid & 63, wr = wid >> 2, wc = wid & 3, fr = lane & 15, fq = lane >> 4;
    const int nt = g.Kb / 128;
    int vsa = g.sa, vsb = g.sb; asm volatile("" : "+v"(vsa), "+v"(vsb));
    unsigned voffA[2], voffB[2];
#pragma unroll
    for (int i = 0; i < 2; ++i) { int R, C; stage_rc(tid * 16 + i * 8192, R, C); const int Rb = (R & ~31) + perm32(R & 31);
        voffA[i] = (unsigned)(R * g.lda + C * 2); voffB[i] = (unsigned)(Rb * g.ldb + C * 2); }
    const size_t kstep = (size_t)(BK * 2);
    const size_t hstepA = (size_t)HALF * g.lda, hstepB = (size_t)HALF * g.ldb;
    const unsigned ldsw = (unsigned)wid * 1024u;
    const int aoff = lds_byte(wr * 64 + fr, fq * 8), boff = lds_byte(wc * 32 + fr, fq * 8);
#define PG8_SA(b, h) (((b) * 2 + (h)) * HTB)
#define PG8_SB(b, h) ((4 + (b) * 2 + (h)) * HTB)
#define PG8_STAGE(bufoff, gbase, voff) do { _Pragma("unroll") for (int _i = 0; _i < 2; ++_i) \
        __builtin_amdgcn_global_load_lds((const unsigned*)((const char*)(gbase) + (voff)[_i]), (LAS unsigned*)(lds + (bufoff) + ldsw + _i * 8192), 16, 0, 0); } while (0)
#define PG8_LDA(dst, b, h) do { _Pragma("unroll") for (int m = 0; m < 4; ++m) _Pragma("unroll") for (int k = 0; k < 2; ++k) dst[m][k] = *(const LAS bf16x8*)(lds + PG8_SA(b, h) + aoff + m * 2048 + k * 1024); } while (0)
#define PG8_LDB(dst, b, h) do { _Pragma("unroll") for (int n = 0; n < 2; ++n) _Pragma("unroll") for (int k = 0; k < 2; ++k) dst[n][k] = *(const LAS bf16x8*)(lds + PG8_SB(b, h) + boff + n * 2048 + k * 1024); } while (0)
#define PG8_MMA(ai, bj, At, Bt) do { __builtin_amdgcn_s_setprio(1); _Pragma("unroll") for (int m = 0; m < 4; ++m) _Pragma("unroll") for (int n = 0; n < 2; ++n) { \
        if constexpr (F8) { const i32x8 b8_ = join16(Bt[n][0], Bt[n][1]), a8_ = join16(At[m][0], At[m][1]); \
            asm volatile("v_mfma_scale_f32_16x16x128_f8f6f4 %0, %1, %2, %0, %3, %4 op_sel_hi:[0,0,0]" : "+v"(acc[ai][bj][m][n]) : "v"(b8_), "v"(a8_), "v"(vsb), "v"(vsa)); } \
        else { _Pragma("unroll") for (int k = 0; k < 2; ++k) acc[ai][bj][m][n] = __builtin_amdgcn_mfma_f32_16x16x32_bf16(Bt[n][k], At[m][k], acc[ai][bj][m][n], 0, 0, 0); } } __builtin_amdgcn_s_setprio(0); } while (0)
#define PG8_WAIT_V(n) asm volatile("s_waitcnt vmcnt(" #n ")" ::: "memory")
#define PG8_WAIT_L(n) asm volatile("s_waitcnt lgkmcnt(" #n ")" ::: "memory")
#define PG8_BAR __builtin_amdgcn_s_barrier()
#define PG8_SCHED __builtin_amdgcn_sched_barrier(0)
    Unit cur, nxt; int ui = 0;
    if (!S.next(0, cur)) return;
    Acc acc;
    u32x4 iraw[16];
    if constexpr (Epi::INIT) E.init_load(acc, iraw, cur, wr, wc, fr, fq);
    else {
#pragma unroll
    for (int a = 0; a < 2; ++a)
#pragma unroll
        for (int b = 0; b < 2; ++b)
#pragma unroll
            for (int m = 0; m < 4; ++m)
#pragma unroll
                for (int n = 0; n < 2; ++n) acc[a][b][m][n] = (f32x4){0.f, 0.f, 0.f, 0.f};
    }
    bf16x8 At[4][2], B0[2][2], B1[2][2];
    const char* cA = cur.A; const char* cB = cur.B;
    PG8_STAGE(PG8_SB(0, 0), cB, voffB); PG8_STAGE(PG8_SB(0, 1), cB + hstepB, voffB); PG8_STAGE(PG8_SA(0, 0), cA, voffA); PG8_STAGE(PG8_SA(0, 1), cA + hstepA, voffA);
    if constexpr (Epi::INIT) { PG8_SCHED; E.init_finish(acc, iraw); PG8_SCHED; }
    if (wr == 1) PG8_BAR;
    PG8_WAIT_V(2); PG8_BAR;
    PG8_STAGE(PG8_SB(1, 0), cB + kstep, voffB); PG8_STAGE(PG8_SA(1, 0), cA + kstep, voffA); PG8_STAGE(PG8_SB(1, 1), cB + hstepB + kstep, voffB);
    PG8_WAIT_V(6); PG8_BAR;
    for (;;) {
        const bool has_next = S.next(ui + 1, nxt);
        const char* nA = has_next ? nxt.A : cA; const char* nB = has_next ? nxt.B : cB;
        const int unt = cur.nt ? cur.nt : nt;
#pragma nounroll
        for (int t = 0; t < unt; t += 2) {
            const bool last = (t == unt - 2);
            const char* a1 = cA + (size_t)(t + 1) * kstep;
            const char* a2 = last ? nA : cA + (size_t)(t + 2) * kstep; const char* b2 = last ? nB : cB + (size_t)(t + 2) * kstep;
            const char* a3 = a2 + kstep; const char* b3 = b2 + kstep;
            PG8_LDB(B0, 0, 0); PG8_LDB(B1, 0, 1); PG8_SCHED; PG8_LDA(At, 0, 0); PG8_STAGE(PG8_SA(1, 1), a1 + hstepA, voffA);
            PG8_WAIT_V(8); PG8_WAIT_L(0); PG8_BAR; PG8_MMA(0, 0, At, B0); PG8_MMA(0, 1, At, B1); PG8_BAR; PG8_SCHED;
            PG8_LDA(At, 0, 1); PG8_STAGE(PG8_SB(0, 0), b2, voffB); PG8_STAGE(PG8_SB(0, 1), b2 + hstepB, voffB); PG8_STAGE(PG8_SA(0, 0), a2, voffA);
            PG8_WAIT_V(8); PG8_WAIT_L(0); PG8_BAR; PG8_MMA(1, 0, At, B0); PG8_MMA(1, 1, At, B1); PG8_BAR; PG8_SCHED;
            PG8_LDB(B0, 1, 0); PG8_LDB(B1, 1, 1); PG8_SCHED; PG8_LDA(At, 1, 0); PG8_STAGE(PG8_SA(0, 1), a2 + hstepA, voffA);
            PG8_WAIT_V(8); PG8_WAIT_L(0); PG8_BAR; PG8_MMA(0, 0, At, B0); PG8_MMA(0, 1, At, B1); PG8_BAR; PG8_SCHED;
            PG8_LDA(At, 1, 1); PG8_STAGE(PG8_SB(1, 0), b3, voffB); PG8_STAGE(PG8_SB(1, 1), b3 + hstepB, voffB); PG8_STAGE(PG8_SA(1, 0), a3, voffA);
            PG8_WAIT_V(8); PG8_WAIT_L(0); PG8_BAR; PG8_MMA(1, 0, At, B0); PG8_MMA(1, 1, At, B1); PG8_BAR; PG8_SCHED;
        }
        if constexpr (F8) asm volatile("s_nop 15\n\ts_nop 15" ::: "memory");
        if (wr == 0) PG8_BAR;
        const bool keep = E(acc, cur, wr, wc, fr, fq);
        if (!has_next) break;
        if constexpr (Epi::INIT) { E.init_load(acc, iraw, nxt, wr, wc, fr, fq); E.init_finish(acc, iraw); }
        else if (!keep) {
#pragma unroll
            for (int a = 0; a < 2; ++a)
#pragma unroll
                for (int b = 0; b < 2; ++b)
#pragma unroll
                    for (int m = 0; m < 4; ++m)
#pragma unroll
                        for (int n = 0; n < 2; ++n) acc[a][b][m][n] = (f32x4){0.f, 0.f, 0.f, 0.f};
        }
        cur = nxt; cA = nA; cB = nB; ++ui;
        if (wr == 1) PG8_BAR;
    }
    PG8_WAIT_V(0);
    PG8_BAR;
#undef PG8_SA
#undef PG8_SB
#undef PG8_STAGE
#undef PG8_LDA
#undef PG8_LDB
#undef PG8_MMA
#undef PG8_WAIT_V
#undef PG8_WAIT_L
#undef PG8_BAR
#undef PG8_SCHED
}
}

constexpr int RING_BYTES = 131072, MISC_OFF = RING_BYTES, RED_OFF = RING_BYTES + 1024, POOLX_OFF = RED_OFF + 4096, LDS_BYTES = 163840;

#define XB_TMO      128
#define XB_XCNT(j)  (256  + 64 * (j))
#define XB_XSUB(j)  (1280 + 64 * (j))
#define XB_XGEN(j)  (2304 + 64 * (j))
#define XB_TOP      3328
#define XB_TOPGEN   3392
#define XCD_BAR_WORDS 3456
#define XB_SPIN_CAP (1u << 18)
__device__ __forceinline__ unsigned xb_ld(unsigned* p)              { return __hip_atomic_load(p, __ATOMIC_RELAXED, __HIP_MEMORY_SCOPE_AGENT); }
__device__ __forceinline__ unsigned xb_add(unsigned* p, unsigned v) { return __hip_atomic_fetch_add(p, v, __ATOMIC_RELAXED, __HIP_MEMORY_SCOPE_AGENT); }
__device__ __forceinline__ unsigned xb_xcc_id() { return (unsigned)__builtin_amdgcn_s_getreg((3 << 11) | 20) & 0xFu; }
#define XB_SPIN(cond, bar) do { unsigned _sp = 0; while (cond) { __builtin_amdgcn_s_sleep(1); \
    if ((++_sp & 255u) == 0u) { if (xb_ld(&(bar)[XB_TMO])) break; if (_sp > XB_SPIN_CAP) { atomicAdd(&(bar)[XB_TMO], 1u); break; } } } } while (0)
struct XcdBarrier { unsigned* bar; unsigned x; volatile LAS unsigned* st; };
__device__ __forceinline__ XcdBarrier xcd_barrier_post(unsigned* bar, volatile LAS unsigned* st) {
    XcdBarrier b; b.bar = bar; b.x = xb_xcc_id(); b.st = st;
    if (threadIdx.x == 0) (void)xb_add(&bar[XB_XCNT(b.x)], 1u);
    return b;
}
__device__ __forceinline__ void xcd_barrier_complete(unsigned* bar, unsigned x, unsigned& nloc, unsigned& nx) {
    const unsigned G = gridDim.x * gridDim.y * gridDim.z;
    unsigned sum, cnt, mine, sp = 0u;
    for (;;) {
        sum = 0u; cnt = 0u; mine = 0u;
#pragma nounroll
        for (unsigned j = 0; j < 16; ++j) { const unsigned c = xb_ld(&bar[XB_XCNT(j)]); sum += c; cnt += (c > 0u) ? 1u : 0u; mine = (j == x) ? c : mine; }
        if (sum == G) break;
        __builtin_amdgcn_s_sleep(1);
        if ((++sp & 255u) == 0u) { if (xb_ld(&bar[XB_TMO])) break; if (sp > XB_SPIN_CAP) { atomicAdd(&bar[XB_TMO], 1u); break; } }
    }
    nloc = mine > 0u ? mine : 1u; nx = cnt > 0u ? cnt : 1u;
}
template <bool LIGHT = false> __device__ __forceinline__ void xcd_barrier(const XcdBarrier& b) {
    asm volatile("s_waitcnt vmcnt(0)" ::: "memory");
    __syncthreads();
    if (threadIdx.x == 0) {
        unsigned* bar = b.bar;
        __builtin_amdgcn_s_waitcnt(0);
        unsigned nloc = b.st[0], nx = b.st[1];
        if (nloc == 0u) { xcd_barrier_complete(bar, b.x, nloc, nx); b.st[0] = nloc; b.st[1] = nx; }
        const unsigned old = xb_add(&bar[XB_XSUB(b.x)], 1u);
        const unsigned gen = old / nloc;
        if (old + 1u == (gen + 1u) * nloc) {
            if (!LIGHT) __builtin_amdgcn_fence(__ATOMIC_RELEASE, "agent");
            asm volatile("s_waitcnt vmcnt(0)" ::: "memory");
            const unsigned og = xb_add(&bar[XB_TOP], 1u);
            const unsigned tg = og / nx;
            if (og + 1u == (tg + 1u) * nx) xb_add(&bar[XB_TOPGEN], 1u);
            else XB_SPIN(xb_ld(&bar[XB_TOPGEN]) == tg, bar);
            if (!LIGHT) __builtin_amdgcn_fence(__ATOMIC_ACQUIRE, "agent");
            xb_add(&bar[XB_XGEN(b.x)], 1u);
            asm volatile("s_waitcnt vmcnt(0)" ::: "memory");
        } else {
            XB_SPIN(xb_ld(&bar[XB_XGEN(b.x)]) == gen, bar);
            if (!LIGHT) __builtin_amdgcn_fence(__ATOMIC_ACQUIRE, "agent");
            asm volatile("s_waitcnt vmcnt(0)" ::: "memory");
        }
    }
    __syncthreads();
}

struct Args { const float* in[23]; float* out; unsigned char* ws; int ph_lo, ph_hi; };
static_assert(sizeof(Args) == 23 * 8 + 8 + 8 + 8, "Args has no padding");
typedef const __attribute__((address_space(4))) Args* KArgs;
__device__ __forceinline__ KArgs kargs() { KArgs p = (KArgs)__builtin_amdgcn_kernarg_segment_ptr(); asm volatile("" : "+s"(p)); return p; }

__device__ __forceinline__ void transpose_item(const float* src, int ldn, int k0, int n0, bf16_t* dst, int ldk, const float* kscale, const float* nscale, int lane, bool perm = false, float mul = 1.f) {
    const int r4 = lane >> 4, q = lane & 15, rq = perm ? 32 * (q >> 2) + 8 * (q & 3) : 4 * q;
    f32x4 v[16];
    const float* sp = src + (size_t)(k0 + 16 * r4) * ldn + n0 + 4 * q;
#pragma unroll
    for (int i = 0; i < 16; ++i) v[i] = __builtin_nontemporal_load((const f32x4*)(sp + (size_t)i * ldn));
    f32x4 ns = (f32x4){mul, mul, mul, mul}; if (nscale) ns = *(const f32x4*)(nscale + n0 + 4 * q) * mul;
    if (kscale) {
        const f32x4* kp = (const f32x4*)(kscale + k0 + 16 * r4);
#pragma unroll
        for (int g = 0; g < 4; ++g) { const f32x4 ks = kp[g];
#pragma unroll
            for (int j = 0; j < 4; ++j) v[4 * g + j] = v[4 * g + j] * ks[j]; }
    }
#pragma unroll
    for (int e = 0; e < 4; ++e) { u32x4 lo, hi;
#pragma unroll
        for (int w = 0; w < 4; ++w) { lo[w] = pk_bf16(v[2 * w][e] * ns[e], v[2 * w + 1][e] * ns[e]); hi[w] = pk_bf16(v[8 + 2 * w][e] * ns[e], v[9 + 2 * w][e] * ns[e]); }
        bf16_t* o = dst + (size_t)(rq + e) * ldk + k0 + 16 * r4; *(u32x4*)o = lo; *(u32x4*)(o + 8) = hi; }
}
__device__ __forceinline__ void transpose_item_f8(const float* src, int ldn, int k0, int n0, unsigned char* dst, int ldk, const float* kscale, float mul, int lane) {
    const int r4 = lane >> 4, q = lane & 15;
    f32x4 v[16];
    const float* sp = src + (size_t)(k0 + 16 * r4) * ldn + n0 + 4 * q;
#pragma unroll
    for (int i = 0; i < 16; ++i) v[i] = __builtin_nontemporal_load((const f32x4*)(sp + (size_t)i * ldn));
    {
        const f32x4* kp = (const f32x4*)(kscale + k0 + 16 * r4);
#pragma unroll
        for (int g = 0; g < 4; ++g) { f32x4 ks = (f32x4){mul, mul, mul, mul}; if (kscale) ks = kp[g] * mul;
#pragma unroll
            for (int j = 0; j < 4; ++j) v[4 * g + j] = v[4 * g + j] * ks[j]; }
    }
#pragma unroll
    for (int e = 0; e < 4; ++e) { u32x4 o;
#pragma unroll
        for (int w = 0; w < 4; ++w) o[w] = pk_fp8x4((f32x4){v[4 * w][e], v[4 * w + 1][e], v[4 * w + 2][e], v[4 * w + 3][e]});
        *(u32x4*)(dst + (size_t)(4 * q + e) * ldk + k0 + 16 * r4) = o; }
}
__device__ __forceinline__ int win_row(int n0) {
    const int seg = n0 >> 10, c = n0 & 1023;
    if (seg == 1 || seg == 2) return 1024 + (c >> 7) * 256 + (seg == 2 ? 128 : 0) + (c & 127);
    if (seg == 3 || seg == 4) return 3072 + (c >> 7) * 256 + (seg == 4 ? 128 : 0) + (c & 127);
    return n0;
}
__device__ __forceinline__ int pair_row(int f, int second) { return (f >> 7) * 256 + (second ? 128 : 0) + (f & 127); }

__device__ __forceinline__ void prologue_phase(KArgs a, LAS unsigned char* lds, int wid, int lane) {
    asm volatile("" : "+v"(lane));
    const int gw = blockIdx.x * 8 + wid, NGW = gridDim.x * 8;
    unsigned char* ws = a->ws;
    constexpr int I_WIN = 16 * 144, I_SQ = 16 * 16, I_PW = 16, I_D1 = 16 * 56, I_D2 = 56 * 16;
    constexpr int NIT = 2 * I_WIN + 8 * I_SQ + 8 * I_PW + 2 * I_D1 + I_D2;
    for (int it = gw; it < NIT; it += NGW) {
        int r = it;
        if (r < 2 * I_WIN) { const int L = r / I_WIN; r -= L * I_WIN; const int kb = r / 144, nb = r % 144, n0 = 64 * nb;
            if (n0 >= 6144 || (n0 >= 3072 && n0 < 5120)) transpose_item_f8(a->in[2] + (size_t)L * D * INC, INC, 64 * kb, n0, ws + WS_WG8 + (size_t)L * 5 * MiB + (size_t)(n0 >= 6144 ? 2048 + (n0 - 6144) : win_row(n0) - 3072) * D, D, a->in[1] + L * D, (n0 >= 4096 && n0 < 5120) ? F8_W13_MUL * LOG2E : F8_W13_MUL, lane);
            else { const int ty = n0 < 3072 ? n0 >> 10 : 3, T = (n0 & 1023) >> 6;
                transpose_item(a->in[2] + (size_t)L * D * INC, INC, 64 * kb, n0, (bf16_t*)(ws + WS_W0 + W0_WIN + (size_t)L * 18 * MiB) + (size_t)(256 * T + 128 * (ty >> 1) + 4 * (ty & 1)) * D, D, a->in[1] + L * D, nullptr, lane, true); }
            continue; }
        r -= 2 * I_WIN;
        if (r < 8 * I_SQ) { const int j = r / I_SQ; r -= j * I_SQ; const int L = j >> 2, w = j & 3, kb = r / 16, nb = r % 16, n0 = 64 * nb;
            bf16_t* dst = w < 3 ? (bf16_t*)(ws + WS_W0 + W0_WOUT + (size_t)(L * 3 + w) * 2 * MiB) : (bf16_t*)(ws + WS_W0 + W0_WO + (size_t)L * 2 * MiB);
            transpose_item(a->in[10 + w] + (size_t)L * D * D, D, 64 * kb, n0, dst + (size_t)n0 * D, D, nullptr, nullptr, lane); continue; }
        r -= 8 * I_SQ;
        if (r < 8 * I_PW) { const int j = r / I_PW; r -= j * I_PW; const int L = j >> 2, g = j & 3;
            const float* src = a->in[8] + (size_t)(L * 4 + g) * 65536 + (size_t)r * 16 * 256; const float* sc = a->in[9] + L * D + g * 256;
            bf16_t* dst = (bf16_t*)(ws + WS_W0 + W0_POOL + (size_t)L * 512 * 1024) + (size_t)g * 65536 + (size_t)r * 16 * 256; const f32x4 s4 = *(const f32x4*)(sc + 4 * lane);
#pragma unroll
            for (int i = 0; i < 16; ++i) { const f32x4 v = *(const f32x4*)(src + i * 256 + 4 * lane) * s4; u32x2 w; w.x = pk_bf16(v[0], v[1]); w.y = pk_bf16(v[2], v[3]); *(u32x2*)(dst + i * 256 + 4 * lane) = w; }
            continue; }
        r -= 8 * I_PW;
        if (r < 2 * I_D1) { const int w = r / I_D1; r -= w * I_D1; const int kb = r / 56, nb = r % 56, n0 = 64 * nb;
            transpose_item(a->in[15 + w], DFF, 64 * kb, n0, (bf16_t*)(ws + WS_W0 + W0_D13) + (size_t)pair_row(n0, w) * D, D, a->in[14], nullptr, lane, false, w ? 1.0f / LOG2E : LOG2E); continue; }
        r -= 2 * I_D1;
        { const int kb = r / 16, nb = r % 16, n0 = 64 * nb;
            transpose_item(a->in[17], D, 64 * kb, n0, (bf16_t*)(ws + WS_W0 + W0_D2) + (size_t)n0 * DFF, DFF, nullptr, nullptr, lane); }
    }
    const float* x = a->in[0]; bf16_t* xb = (bf16_t*)(ws + WS_XB); f32x4* ss0 = (f32x4*)(ws + WS_SS); unsigned char* x8 = ws + WS_X8;
    for (int m = gw; m < M; m += NGW) {
        const f32x4* xr = (const f32x4*)(x + (size_t)m * D) + lane; u32x2* o = (u32x2*)(xb + (size_t)m * D) + lane; float s = 0.f;
#pragma unroll
        for (int j = 0; j < 4; ++j) { const f32x4 v = xr[64 * j]; s += (v[0] * v[0] + v[1] * v[1]) + (v[2] * v[2] + v[3] * v[3]); u32x2 w; w.x = pk_bf16(v[0], v[1]); w.y = pk_bf16(v[2], v[3]); o[64 * j] = w;
            *((unsigned*)(x8 + (size_t)m * D) + lane + 64 * j) = pk_fp8x4(v); }
        s = wave_sum(s); if (lane == 0) ss0[m] = (f32x4){s, 0.f, 0.f, 0.f};
    }
}

__device__ __forceinline__ void dma_block16(const bf16_t* src, LAS unsigned char* dst, int wid, int lane) {
#pragma unroll
    for (int k = 0; k < 4; ++k) { const int h = wid * 4 + k;
        __builtin_amdgcn_global_load_lds((const unsigned*)((const char*)src + h * 1024 + lane * 16), (LAS unsigned*)(dst + h * 1024), 16, 0, 0); }
}
__device__ __forceinline__ void zero_block16(LAS unsigned char* dst, int tid) {
#pragma unroll
    for (int k = 0; k < 4; ++k) *(LAS u32x4*)(dst + (size_t)(tid + 512 * k) * 16) = (u32x4){0u, 0u, 0u, 0u};
}
template <int I> __device__ __forceinline__ void conv31_pair(const LAS unsigned char* col, const unsigned (&wp)[31], f32x2 bias, f32x2 (&acc)[16]) {
    f32x2 x[46];
#pragma unroll
    for (int i = 0; i < 46; ++i) { const int r = i - 30, j = I + (r >> 4); const unsigned u = *(const LAS unsigned*)(col + ((j + 2) & 3) * 32768 + (r & 15) * 2048); x[i] = (f32x2){bf_lo(u), bf_hi(u)}; }
#pragma unroll
    for (int j = 0; j < 16; ++j) acc[j] = bias;
#pragma unroll
    for (int k = 0; k < 31; ++k) { const f32x2 wk = (f32x2){bf_lo(wp[k]), bf_hi(wp[k])};
#pragma unroll
        for (int j = 0; j < 16; ++j) acc[j] = __builtin_elementwise_fma(wk, x[j + k], acc[j]); }
}
template <int I, int CH> __device__ __forceinline__ void pool_ch(const LAS unsigned char* col, int g, int s0, float (&p)[16]) {
    float x[31], tv[16];
#pragma unroll
    for (int i = 0; i < 31; ++i) { const int r = i - 15, j = I + (r >> 4); const unsigned u = *(const LAS unsigned*)(col + ((j + 1) % 3) * 32768 + (r & 15) * 2048); x[i] = CH ? bf_hi(u) : bf_lo(u); }
#pragma unroll
    for (int j = 0; j < 16; ++j) tv[j] = x[15 + j];
#pragma unroll
    for (int i = 30; i >= 1; --i) x[i] += x[i - 1];
    if (g >= 1) {
#pragma unroll
        for (int i = 30; i >= 2; --i) x[i] += x[i - 2]; }
    if (g >= 2) {
#pragma unroll
        for (int i = 30; i >= 4; --i) x[i] += x[i - 4]; }
    if (g >= 3) {
#pragma unroll
        for (int i = 30; i >= 8; --i) x[i] += x[i - 8]; }
    const int w = 2 << g;
#pragma unroll
    for (int j = 0; j < 16; ++j) { const int cnt = min(s0 + j + 1, w); p[j] = x[15 + j] * (1.0f / (float)cnt) - tv[j]; }
}
struct ConvB { const bf16_t* GLU; __amdgpu_buffer_rsrc_t rVB; LAS unsigned char* lds; LAS float* red; LAS float* stat; f32x2 bb, gg, be; };
template <int I> __device__ __forceinline__ void convB_tile(const ConvB& c, unsigned (&wp)[31], int T0, int tid, int wid, int lane) {
    const int t0 = T0 + 16 * I; const LAS unsigned char* col = c.lds + 4 * tid;
#pragma unroll
    for (int k = 0; k < 31; ++k) asm volatile("" : "+v"(wp[k]));
    if (I < 3) dma_block16(c.GLU + (size_t)(t0 + 16) * D, c.lds + ((I + 3) & 3) * 32768, wid, lane);
    float a0[16], a1[16];
    { f32x2 ap[16]; conv31_pair<I>(col, wp, c.bb, ap);
#pragma unroll
      for (int j = 0; j < 16; ++j) { a0[j] = ap[j].x; a1[j] = ap[j].y; } }
    {
        float v[32];
#pragma unroll
        for (int j = 0; j < 16; ++j) { v[j] = a0[j] + a1[j]; v[16 + j] = a0[j] * a0[j] + a1[j] * a1[j]; }
#pragma unroll
        for (int i = 0; i < 16; ++i) { const bool b = lane & 32; const float send = b ? v[i] : v[i + 16], keep = b ? v[i + 16] : v[i]; v[i] = keep + __shfl_xor(send, 32); }
#pragma unroll
        for (int i = 0; i < 8; ++i) { const bool b = lane & 16; const float send = b ? v[i] : v[i + 8], keep = b ? v[i + 8] : v[i]; v[i] = keep + __shfl_xor(send, 16); }
#pragma unroll
        for (int i = 0; i < 4; ++i) { const bool b = lane & 8; const float send = b ? v[i] : v[i + 4], keep = b ? v[i + 4] : v[i]; v[i] = keep + __shfl_xor(send, 8); }
#pragma unroll
        for (int i = 0; i < 2; ++i) { const bool b = lane & 4; const float send = b ? v[i] : v[i + 2], keep = b ? v[i + 2] : v[i]; v[i] = keep + __shfl_xor(send, 4); }
        { const bool b = lane & 2; const float send = b ? v[0] : v[1], keep = b ? v[1] : v[0]; v[0] = keep + __shfl_xor(send, 2); }
        v[0] += __shfl_xor(v[0], 1);
        const int idx = ((lane >> 5) & 1) * 16 + ((lane >> 4) & 1) * 8 + ((lane >> 3) & 1) * 4 + ((lane >> 2) & 1) * 2 + ((lane >> 1) & 1);
        if (!(lane & 1)) c.red[wid * 32 + idx] = v[0];
    }
    __syncthreads();
    if (tid < 16) { float s = 0.f, q = 0.f;
#pragma unroll
        for (int w = 0; w < 8; ++w) { s += c.red[w * 32 + tid]; q += c.red[w * 32 + 16 + tid]; }
        const float mean = s * (1.0f / D), var = fmaxf(q * (1.0f / D) - mean * mean, 0.f);
        c.stat[2 * tid] = mean; c.stat[2 * tid + 1] = __builtin_amdgcn_rsqf(var + LN_EPS); }
    asm volatile("s_waitcnt vmcnt(0)" ::: "memory");
    __syncthreads();
#pragma unroll
    for (int j = 0; j < 16; ++j) { const float mean = c.stat[2 * j], rstd = c.stat[2 * j + 1];
        const float y0 = (a0[j] - mean) * rstd * c.gg.x + c.be.x, y1 = (a1[j] - mean) * rstd * c.gg.y + c.be.y;
        __builtin_amdgcn_raw_buffer_store_b32(pk_bf16(y0 * sigm(y0), y1 * sigm(y1)), c.rVB, 4 * tid, (t0 + j) * (D * 2), 0); }
}
struct ConvAC { const bf16_t* PU; __amdgpu_buffer_rsrc_t rPP; LAS unsigned char* lds; };
__device__ __forceinline__ void conv_phase(KArgs a, int layer, LAS unsigned char* lds, int tid, int wid, int lane) {
    asm volatile("" : "+v"(tid), "+v"(lane));
    unsigned char* ws = a->ws;
    const int G = gridDim.x;
    const int vcu = (G % 8 == 0) ? (int)(blockIdx.x % 8) * (G / 8) + (int)(blockIdx.x / 8) : (int)blockIdx.x;
    const int c2 = 2 * tid;
    {
        const float* cfw = a->in[4] + layer * 31 * D; const float* cfb = a->in[5] + layer * D; const float* lng = a->in[6] + layer * D; const float* lnb = a->in[7] + layer * D;
        ConvB c; c.GLU = (const bf16_t*)(ws + A_GLU); c.rVB = __builtin_amdgcn_make_buffer_rsrc((void*)(ws + A_VB), 0, 0x7fffffff, 0x00020000);
        c.lds = lds; c.red = (LAS float*)(lds + RED_OFF); c.stat = c.red + 256;
        unsigned wp[31];
#pragma unroll
        for (int k = 0; k < 31; ++k) { const f32x2 w = *(const f32x2*)(cfw + k * D + c2); wp[k] = pk_bf16(w.x, w.y); }
        c.bb = *(const f32x2*)(cfb + c2); c.gg = *(const f32x2*)(lng + c2); c.be = *(const f32x2*)(lnb + c2);
        asm volatile("" :: "v"(c.bb.x), "v"(c.bb.y), "v"(c.gg.x), "v"(c.gg.y), "v"(c.be.x), "v"(c.be.y));
        for (int rp2 = 0; rp2 < REPS2(21); ++rp2)
        for (int sup = vcu; sup < M / 64; sup += G) {
            const int T0 = sup * 64; const bool seq0 = (T0 & (SEQ - 1)) == 0;
            if (seq0) { zero_block16(lds, tid); zero_block16(lds + 32768, tid); } else { dma_block16(c.GLU + (size_t)(T0 - 32) * D, lds, wid, lane); dma_block16(c.GLU + (size_t)(T0 - 16) * D, lds + 32768, wid, lane); }
            dma_block16(c.GLU + (size_t)T0 * D, lds + 65536, wid, lane);
            asm volatile("s_waitcnt vmcnt(0)" ::: "memory");
            __syncthreads();
            convB_tile<0>(c, wp, T0, tid, wid, lane); convB_tile<1>(c, wp, T0, tid, wid, lane); convB_tile<2>(c, wp, T0, tid, wid, lane); convB_tile<3>(c, wp, T0, tid, wid, lane);
            __syncthreads();
        }
    }
    __syncthreads();
    if (blockIdx.x < M / 256) {
        int pm_ = blockIdx.x; asm volatile("" : "+s"(pm_));
        const int pm = pm_, T0 = pm * 256, s0 = T0 & (SEQ - 1); const bool seq0 = s0 == 0;
        const float* scw = a->in[3] + layer * 3 * D; const float* halo = (const float*)(ws + WS_HALO); bf16_t* YA = (bf16_t*)(ws + A_YA);
        ConvAC c; c.PU = (const bf16_t*)(ws + A_PU); c.lds = lds;
        c.rPP = __builtin_amdgcn_make_buffer_rsrc((void*)(ws + A_PP), 0, 0x7fffffff, 0x00020000);
        if (seq0) zero_block16(lds, tid); else dma_block16(c.PU + (size_t)(T0 - 16) * D, lds, wid, lane);
        dma_block16(c.PU + (size_t)T0 * D, lds + 32768, wid, lane);
        {   const f32x2 s0w = *(const f32x2*)(scw + c2), s1w = *(const f32x2*)(scw + D + c2), s2w = *(const f32x2*)(scw + 2 * D + c2);
            const f32x2 b0 = *(const f32x2*)(halo + (size_t)((0 * 64 + pm) * 2 + 0) * D + c2), b1 = *(const f32x2*)(halo + (size_t)((0 * 64 + pm) * 2 + 1) * D + c2);
            const f32x2 q0 = *(const f32x2*)(halo + (size_t)((1 * 64 + pm) * 2 + 0) * D + c2), q1 = *(const f32x2*)(halo + (size_t)((1 * 64 + pm) * 2 + 1) * D + c2);
            f32x2 pa = (f32x2){0.f, 0.f}, pb = pa;
            if (!seq0) { pa = *(const f32x2*)(halo + (size_t)((2 * 64 + pm - 1) * 2 + 0) * D + c2); pb = *(const f32x2*)(halo + (size_t)((2 * 64 + pm - 1) * 2 + 1) * D + c2); }
            const f32x2 y0 = b0 * (s0w * pa + s1w * pb + s2w * q0), y1 = b1 * (s0w * pb + s1w * q0 + s2w * q1);
            *(unsigned*)(YA + (size_t)T0 * D + c2) = pk_bf16(y0.x, y0.y); *(unsigned*)(YA + (size_t)(T0 + 1) * D + c2) = pk_bf16(y1.x, y1.y); }
        asm volatile("s_waitcnt vmcnt(0)" ::: "memory");
        __syncthreads();
        {
            const LAS unsigned char* col = lds + 4 * tid;
            float p0[16], p1[16];
            pool_ch<0, 0>(col, wid >> 1, s0, p0);
#pragma unroll
            for (int j = 0; j < 16; ++j) asm volatile("" : "+v"(p0[j]) :: "memory");
            pool_ch<0, 1>(col, wid >> 1, s0, p1);
#pragma unroll
            for (int j = 0; j < 16; ++j) __builtin_amdgcn_raw_buffer_store_b32(pk_bf16(p0[j], p1[j]), c.rPP, 4 * tid, (T0 + j) * (D * 2), 0);
        }
        __syncthreads();
    }
}

__device__ __forceinline__ void route_phase(KArgs a, LAS unsigned char* lds, int tid, int wid, int lane) {
    asm volatile("" : "+v"(tid), "+v"(lane));
    unsigned char* ws = a->ws;
    const bf16_t* X = (const bf16_t*)(ws + WS_XB); const float* gn = a->in[14] + D; const float* R = a->in[18];
    const f32x4* ss3 = (const f32x4*)(ws + WS_SS) + 3 * M;
    int* tope = (int*)(ws + WS_SMALL + SM_TOPE); f32x2* topp = (f32x2*)(ws + WS_SMALL + SM_TOPP); int* cntb = (int*)(ws + WS_CTL + CTL_CNT);
    LAS int* lcnt = (LAS int*)(lds + 98304);
    float wgt[2][8][8];
#pragma unroll
    for (int h = 0; h < 2; ++h)
#pragma unroll
        for (int i = 0; i < 8; ++i) { const int k = 8 * lane + 512 * h + i; const float g = gn[k]; const f32x4 r0 = *(const f32x4*)(R + k * 8), r1 = *(const f32x4*)(R + k * 8 + 4);
#pragma unroll
            for (int e = 0; e < 4; ++e) { wgt[h][i][e] = g * r0[e]; wgt[h][i][4 + e] = g * r1[e]; } }
    for (int vb = blockIdx.x; vb < 256; vb += gridDim.x) {
        if (tid < 8) lcnt[tid] = 0;
        __syncthreads();
        for (int i8 = 0; i8 < 8; ++i8) {
            const int t = vb * 64 + wid * 8 + i8;
            float lg[8];
#pragma unroll
            for (int e = 0; e < 8; ++e) lg[e] = 0.f;
#pragma unroll
            for (int h = 0; h < 2; ++h) { f32x4 v0, v1; pg8::unpack8(*(const u32x4*)(X + (size_t)t * D + 512 * h + 8 * lane), v0, v1);
#pragma unroll
                for (int i = 0; i < 4; ++i)
#pragma unroll
                    for (int e = 0; e < 8; ++e) { lg[e] = fmaf(v0[i], wgt[h][i][e], lg[e]); lg[e] = fmaf(v1[i], wgt[h][4 + i][e], lg[e]); } }
#pragma unroll
            for (int e = 0; e < 8; ++e) lg[e] = wave_sum(lg[e]);
            const f32x4 sp = ss3[t]; const float rstd = __builtin_amdgcn_rsqf(((sp[0] + sp[1]) + (sp[2] + sp[3])) * (1.0f / D) + RMS_EPS);
            int e1 = 0; float v1 = lg[0];
#pragma unroll
            for (int e = 1; e < 8; ++e) if (lg[e] > v1) { v1 = lg[e]; e1 = e; }
            int e2 = e1 == 0 ? 1 : 0; float v2 = -__builtin_inff();
#pragma unroll
            for (int e = 0; e < 8; ++e) if (e != e1 && lg[e] > v2) { v2 = lg[e]; e2 = e; }
            const float ex = __expf((v2 - v1) * rstd), p1 = 1.0f / (1.0f + ex), p2 = ex * p1;
            if (lane == 0) { tope[t] = e1 | (e2 << 8); topp[t] = (f32x2){p1, p2}; atomicAdd((int*)&lcnt[e1], 1); atomicAdd((int*)&lcnt[e2], 1); }
        }
        __syncthreads();
        if (tid < 8) __hip_atomic_store(cntb + vb * 8 + tid, lcnt[tid], __ATOMIC_RELAXED, __HIP_MEMORY_SCOPE_AGENT);
        __syncthreads();
    }
    const int gw = blockIdx.x * 8 + wid, NGW = gridDim.x * 8;
    constexpr int I_1 = 16 * 56, I_13 = 2 * I_1, I_2 = 56 * 16;
    unsigned char* w13 = ws + WS_WMOE; unsigned char* w2t = ws + WS_WMOE + WMOE_W2;
    for (int it = gw; it < NE * (I_13 + I_2); it += NGW) {
        int r = it;
        if (r < NE * I_13) { const int e = r / I_13; r -= e * I_13; const int w = r / I_1; r -= w * I_1; const int kb = r / 56, nb = r % 56, n0 = 64 * nb;
            transpose_item_f8(a->in[19 + w] + (size_t)e * D * DFF, DFF, 64 * kb, n0, w13 + (size_t)e * (2 * DFF) * D + (size_t)pair_row(n0, w) * D, D, gn, w ? F8_W13_MUL * F8_ACT_MUL / LOG2E : F8_W13_MUL * LOG2E, lane); continue; }
        r -= NE * I_13;
        { const int e = r / I_2; r -= e * I_2; const int kb = r / 16, nb = r % 16, n0 = 64 * nb;
            transpose_item_f8(a->in[21] + (size_t)e * DFF * D, D, 64 * kb, n0, w2t + (size_t)e * D * DFF + (size_t)n0 * DFF, DFF, nullptr, F8_W2_MUL, lane); }
    }
}

__device__ __forceinline__ void scatter_phase(KArgs a, LAS unsigned char* lds, int tid, int wid, int lane) {
    asm volatile("" : "+v"(tid), "+v"(lane));
    unsigned char* ws = a->ws;
    const int* tope = (const int*)(ws + WS_SMALL + SM_TOPE); int* tslot = (int*)(ws + WS_SMALL + SM_TSLOT); float* ssperm = (float*)(ws + WS_SMALL + SM_SSPERM); int* meta = (int*)(ws + WS_SMALL + SM_META);
    const int* cntb = (const int*)(ws + WS_CTL + CTL_CNT); const f32x4* ss3 = (const f32x4*)(ws + WS_SS) + 3 * M;
    const bf16_t* X = (const bf16_t*)(ws + WS_XB); unsigned char* AP = ws + WS_APERM;
    LAS int* lc = (LAS int*)lds;
    LAS int* lbase = lc + 2048;
    LAS int* lslot = lc + 2064;
    LAS int* ltot = lc + 2200;
    for (int i = tid; i < 2048; i += 512) lc[i] = __hip_atomic_load(cntb + i, __ATOMIC_RELAXED, __HIP_MEMORY_SCOPE_AGENT);
    __syncthreads();
    for (int vb = blockIdx.x; vb < 256; vb += gridDim.x) {
        if (tid < 8) { int tot = 0, pre = 0;
#pragma unroll 8
            for (int b = 0; b < 256; ++b) { const int v = lc[b * 8 + tid]; tot += v; pre += (b < vb) ? v : 0; }
            ltot[tid] = tot; lbase[tid] = pre; }
        __syncthreads();
        if (tid == 0) { int off = 0;
            for (int e = 0; e < 8; ++e) { lbase[e] += off; if (vb == 0) meta[e] = off >> 8; off += (ltot[e] + 255) & ~255; }
            if (vb == 0) meta[8] = off >> 8; }
        __syncthreads();
        if (wid == 0) {
            const int t = vb * 64 + lane; const int te = tope[t]; const int e1 = te & 0xff, e2 = (te >> 8) & 0xff;
            int s1 = 0, s2 = 0;
#pragma unroll
            for (int k = 0; k < 2; ++k) { const int ek = k ? e2 : e1; int sk = 0;
#pragma unroll
                for (int e = 0; e < 8; ++e) { const unsigned long long mask = __ballot(ek == e); const int base = lbase[e]; LDS_WAIT();
                    const int rank = __popcll(mask & ((1ull << lane) - 1ull)); if (ek == e) sk = base + rank;
                    if (lane == 0) lbase[e] = base + __popcll(mask); LDS_WAIT(); }
                if (k) s2 = sk; else s1 = sk; }
            *(int2*)(tslot + 2 * t) = make_int2(s1, s2); lslot[lane] = s1; lslot[64 + lane] = s2;
        }
        __syncthreads();
        {
            u32x4 xv[8][2]; f32x4 sp[8];
#pragma unroll
            for (int i = 0; i < 8; ++i) { const int t = vb * 64 + wid + 8 * i; const u32x4* src = (const u32x4*)(X + (size_t)t * D) + 2 * lane; xv[i][0] = src[0]; xv[i][1] = src[1]; sp[i] = ss3[t]; }
#pragma unroll
            for (int i = 0; i < 8; ++i) { const int r = wid + 8 * i, s1 = lslot[r], s2 = lslot[64 + r];
                const float rstd = __builtin_amdgcn_rsqf(((sp[i][0] + sp[i][1]) + (sp[i][2] + sp[i][3])) * (1.0f / D) + RMS_EPS);
                f32x4 v0, v1, v2, v3; pg8::unpack8(xv[i][0], v0, v1); pg8::unpack8(xv[i][1], v2, v3);
                const u32x4 q = (u32x4){pk_fp8x4(v0 * rstd), pk_fp8x4(v1 * rstd), pk_fp8x4(v2 * rstd), pk_fp8x4(v3 * rstd)};
                *((u32x4*)(AP + (size_t)s1 * D) + lane) = q; *((u32x4*)(AP + (size_t)s2 * D) + lane) = q; } }
        __syncthreads();
    }
}

__device__ __forceinline__ void combine_phase(KArgs a, LAS unsigned char* lds, int tid, int wid, int lane) {
    asm volatile("" : "+v"(lane), "+v"(tid));
    unsigned char* ws = a->ws;
    LAS int* tmap = (LAS int*)lds; const bf16_t* YP = (const bf16_t*)(ws + WS_YP);
    int split;
    { const int nMraw = __builtin_amdgcn_readfirstlane(__hip_atomic_load((const int*)(ws + WS_SMALL + SM_META) + 8, __ATOMIC_RELAXED, __HIP_MEMORY_SCOPE_AGENT)); const int nM = nMraw > MAXSLOT / 256 ? MAXSLOT / 256 : nMraw;
      const int G = (int)gridDim.x, nU = 4 * nM, R = nU / G, tail = nU - R * G; split = (tail > 0 && pg8::MOE2_SPL * tail <= G) ? 1 : 0;
      for (int i = tid; i < 4 * (MAXSLOT / 256); i += 512) tmap[i] = -1;
      __syncthreads();
      if (split && tid < tail) { int pm, pn; if (pg8::tile_of(R * G + tid, nM, 4, pm, pn, 4)) tmap[4 * pm + pn] = tid; }
      __syncthreads(); }
    const bf16_t* X = (const bf16_t*)(ws + WS_XB); const unsigned char* Y = ws + WS_Y; const int* tslot = (const int*)(ws + WS_SMALL + SM_TSLOT); const f32x2* topp = (const f32x2*)(ws + WS_SMALL + SM_TOPP);
    const float* gf = a->in[22]; float* out = a->out;
    const int gw = blockIdx.x * 8 + wid, NGW = gridDim.x * 8;
    f32x4 gv[4];
#pragma unroll
    for (int h = 0; h < 2; ++h) { gv[2 * h] = *(const f32x4*)(gf + 512 * h + 8 * lane); gv[2 * h + 1] = *(const f32x4*)(gf + 512 * h + 8 * lane + 4); }
    for (int tb = gw; tb < M; tb += 4 * NGW) {
        int2 sl[4]; f32x2 p[4];
#pragma unroll
        for (int i = 0; i < 4; ++i) { const int t = min(tb + i * NGW, M - 1); sl[i] = *(const int2*)(tslot + 2 * t); p[i] = topp[t]; }
        u32x4 xr[4][2]; u32x2 ya[4][2], yb[4][2];
#pragma unroll
        for (int i = 0; i < 4; ++i) { const int t = min(tb + i * NGW, M - 1);
#pragma unroll
            for (int h = 0; h < 2; ++h) { const int col = 512 * h + 8 * lane;
                xr[i][h] = *(const u32x4*)(X + (size_t)t * D + col); ya[i][h] = *(const u32x2*)(Y + (size_t)sl[i].x * D + col); yb[i][h] = *(const u32x2*)(Y + (size_t)sl[i].y * D + col); } }
#pragma unroll
        for (int i = 0; i < 4; ++i) { const int t = tb + i * NGW; if (t < M) {
            f32x4 v[4]; float s = 0.f;
#pragma unroll
            for (int h = 0; h < 2; ++h) { f32x4 x0, x1; pg8::unpack8(xr[i][h], x0, x1); f32x4 a0 = pg8::un_fp8x4(ya[i][h].x) * (1.0f / F8_Y_MUL), a1 = pg8::un_fp8x4(ya[i][h].y) * (1.0f / F8_Y_MUL), b0 = pg8::un_fp8x4(yb[i][h].x) * (1.0f / F8_Y_MUL), b1 = pg8::un_fp8x4(yb[i][h].y) * (1.0f / F8_Y_MUL);
                if (split) { const int pn = 2 * h + (lane >> 5), cl = 8 * (lane & 31);
                    const int ka = tmap[4 * (sl[i].x >> 8) + pn], kb = tmap[4 * (sl[i].y >> 8) + pn];
                    if (ka >= 0) { a0 = (f32x4){0.f, 0.f, 0.f, 0.f}; a1 = a0;
                        for (int p = 0; p < pg8::MOE2_SPL; ++p) { f32x4 t0, t1; pg8::unpack8(*(const u32x4*)(YP + (size_t)(ka * pg8::MOE2_SPL + p) * 65536 + (size_t)(sl[i].x & 255) * 256 + cl), t0, t1); a0 += t0; a1 += t1; } }
                    if (kb >= 0) { b0 = (f32x4){0.f, 0.f, 0.f, 0.f}; b1 = b0;
                        for (int p = 0; p < pg8::MOE2_SPL; ++p) { f32x4 t0, t1; pg8::unpack8(*(const u32x4*)(YP + (size_t)(kb * pg8::MOE2_SPL + p) * 65536 + (size_t)(sl[i].y & 255) * 256 + cl), t0, t1); b0 += t0; b1 += t1; } } }
                v[2 * h] = x0 + a0 * p[i].x + b0 * p[i].y; v[2 * h + 1] = x1 + a1 * p[i].x + b1 * p[i].y; }
#pragma unroll
            for (int k = 0; k < 4; ++k) s += (v[k][0] * v[k][0] + v[k][1] * v[k][1]) + (v[k][2] * v[k][2] + v[k][3] * v[k][3]);
            const float rstd = __builtin_amdgcn_rsqf(wave_sum(s) * (1.0f / D) + RMS_EPS);
#pragma unroll
            for (int h = 0; h < 2; ++h) { const int col = 512 * h + 8 * lane;
                *(f32x4*)(out + (size_t)t * D + col) = v[2 * h] * rstd * gv[2 * h]; *(f32x4*)(out + (size_t)t * D + col + 4) = v[2 * h + 1] * rstd * gv[2 * h + 1]; } } }
    }
}

#ifndef WGM_INPROJ
#define WGM_INPROJ 4
#endif
#ifndef WGM_FFN1
#define WGM_FFN1 4
#endif
#ifndef WGM_MOE1
#define WGM_MOE1 4
#endif
constexpr int NPH = 18;
#ifndef MK_PH_MASK
#define MK_PH_MASK 0xFFFFFFFFu
#endif
#define PHON(bit) ((((MK_PH_MASK) >> (bit)) & 1u) != 0u)


__device__ __forceinline__ void ph_inproj(KArgs a, int layer, LAS unsigned char* lds) {
    unsigned char* ws = a->ws;
    {
        pg8::Gemm g{2 * D, 2 * D, 2 * D, 0, 0}; pg8::PlainSched S{M / 256, 16, (int)gridDim.x, (int)blockIdx.x, (const char*)(ws + WS_XB), (const char*)(ws + WS_W0 + W0_WIN + (size_t)layer * 18 * MiB), (size_t)256 * D * 2, (size_t)256 * D * 2, WGM_INPROJ, 1 << 30, 0};
        pg8::EpiSc E{(bf16_t*)(ws + A_YA), (bf16_t*)(ws + A_PP), (bf16_t*)(ws + A_PU), (const f32x4*)(ws + WS_SS) + (size_t)(layer * 2) * M, a->in[3] + layer * 3 * D, (float*)(ws + WS_HALO), (LAS float*)(lds + RED_OFF), (LAS float*)(lds + POOLX_OFF)};
        pg8::gemm_phase(lds, g, S, E);
    }
    __syncthreads();
    {
        pg8::Gemm g{D, D, D, F8_ONE, F8_W13_SC}; pg8::PlainSched S{M / 256, 20, (int)gridDim.x, (int)blockIdx.x, (const char*)(ws + WS_X8), (const char*)(ws + WS_WG8 + (size_t)layer * 5 * MiB), (size_t)256 * D, (size_t)256 * D, WGM_INPROJ, 1 << 30, 0};
        pg8::EpiProj E{(bf16_t*)(ws + A_GLU), (bf16_t*)(ws + A_GATES), (const f32x4*)(ws + WS_SS) + (size_t)(layer * 2) * M};
        pg8::gemm_phase<pg8::EpiProj, pg8::PlainSched, true>(lds, g, S, E);
    }
}
__device__ __forceinline__ void ph_fold(KArgs a, LAS unsigned char* lds) {
    unsigned char* ws = a->ws;
    pg8::Gemm g{512, 2 * D, 512, 0, 0}; pg8::FoldSched S{(int)gridDim.x, (int)blockIdx.x, (const char*)(ws + WS_W0 + W0_WOUT + 2 * 2 * MiB), (const char*)(ws + WS_W0 + W0_POOL)};
    pg8::EpiPlain E{(bf16_t*)(ws + WS_WC), D, (size_t)D * D};
    pg8::gemm_phase(lds, g, S, E);
}
__device__ __forceinline__ void ph_merge(KArgs a, int layer, LAS unsigned char* lds) {
    unsigned char* ws = a->ws;
    pg8::Gemm g{2 * D, 2 * D, 2 * D, 0, 0}; pg8::MergeSched S{(int)gridDim.x, (int)blockIdx.x, (const char*)(ws + A_YA), (const char*)(ws + WS_W0 + W0_WOUT + (size_t)(layer * 3) * 2 * MiB), (const char*)(ws + WS_WC + (size_t)layer * 2 * MiB), (size_t)32 * MiB, (size_t)2 * MiB};
    pg8::EpiMerge E{(const bf16_t*)(ws + A_GATES), (bf16_t*)(ws + A_MERGED)};
    pg8::gemm_phase(lds, g, S, E);
}
__device__ __forceinline__ void ph_wo(KArgs a, int layer, LAS unsigned char* lds) {
    unsigned char* ws = a->ws;
    pg8::Gemm g{2 * D, 2 * D, 2 * D, 0, 0}; pg8::PlainSched S{M / 256, D / 256, (int)gridDim.x, (int)blockIdx.x, (const char*)(ws + A_MERGED), (const char*)(ws + WS_W0 + W0_WO + (size_t)layer * 2 * MiB), (size_t)256 * D * 2, (size_t)256 * D * 2, 4, 1 << 30, 0};
    pg8::EpiResid E{(bf16_t*)(ws + WS_XB), (float*)(ws + WS_SS) + (size_t)(layer * 2 + 1) * M * 4, (LAS float*)(lds + RED_OFF), nullptr};
    pg8::gemm_phase(lds, g, S, E);
}
__device__ __forceinline__ void ph_ffn1(KArgs a, LAS unsigned char* lds) {
    unsigned char* ws = a->ws;
    pg8::Gemm g{2 * D, 2 * D, 2 * D, 0, 0}; pg8::PlainSched S{M / 256, 2 * DFF / 256, (int)gridDim.x, (int)blockIdx.x, (const char*)(ws + WS_XB), (const char*)(ws + WS_W0 + W0_D13), (size_t)256 * D * 2, (size_t)256 * D * 2, WGM_FFN1, 1 << 30, 0};
    pg8::EpiSwiGLU<true, false> E{(bf16_t*)(ws + A_FFN), DFF, (const float*)(ws + WS_SS) + (size_t)1 * M * 4};
    pg8::gemm_phase(lds, g, S, E);
}
__device__ __forceinline__ void ph_ffn2(KArgs a, LAS unsigned char* lds) {
    unsigned char* ws = a->ws;
    pg8::Gemm g{2 * DFF, 2 * DFF, 2 * DFF, 0, 0}; pg8::PlainSched S{M / 256, D / 256, (int)gridDim.x, (int)blockIdx.x, (const char*)(ws + A_FFN), (const char*)(ws + WS_W0 + W0_D2), (size_t)256 * DFF * 2, (size_t)256 * DFF * 2, 4, 1 << 30, 0};
    pg8::EpiResid E{(bf16_t*)(ws + WS_XB), (float*)(ws + WS_SS) + (size_t)2 * M * 4, (LAS float*)(lds + RED_OFF), ws + WS_X8};
    pg8::gemm_phase(lds, g, S, E);
}
__device__ __forceinline__ void ph_moe(KArgs a, int which, LAS unsigned char* lds) {
    unsigned char* ws = a->ws;
    const int* meta = (const int*)(ws + WS_SMALL + SM_META); int o[9];
#pragma unroll
    for (int e = 0; e < 9; ++e) o[e] = __builtin_amdgcn_readfirstlane(__hip_atomic_load(meta + e, __ATOMIC_RELAXED, __HIP_MEMORY_SCOPE_AGENT));
    const int nM = o[8] > MAXSLOT / 256 ? MAXSLOT / 256 : o[8];
    if (which == 0) {
        pg8::Gemm g{D, D, D, F8_ONE, F8_W13_SC}; pg8::GroupSched S{nM, 2 * DFF / 256, (int)gridDim.x, (int)blockIdx.x, o[1], o[2], o[3], o[4], o[5], o[6], o[7], (const char*)(ws + WS_APERM), (const char*)(ws + WS_WMOE), (size_t)256 * D, (size_t)256 * D, (size_t)2 * DFF * D, WGM_MOE1};
        pg8::EpiSwiGLU<false, true> E{(bf16_t*)(ws + WS_ACTP), DFF, nullptr};
        pg8::gemm_phase<pg8::EpiSwiGLU<false, true>, pg8::GroupSched, true>(lds, g, S, E);
    } else {
        const int G = (int)gridDim.x, nU = 4 * nM, R = nU / G, tail = nU - R * G, split = (tail > 0 && pg8::MOE2_SPL * tail <= G) ? 1 : 0;
        pg8::Gemm g{DFF, DFF, DFF, F8_ACT_SC, F8_W2_SC}; pg8::Moe2Sched S{nM, G, (int)blockIdx.x, R, tail, split, o[1], o[2], o[3], o[4], o[5], o[6], o[7], (const char*)(ws + WS_ACTP), (const char*)(ws + WS_WMOE + WMOE_W2), (size_t)256 * DFF, (size_t)256 * DFF, (size_t)D * DFF};
        pg8::EpiMoe2 E{ws + WS_Y, (bf16_t*)(ws + WS_YP)};
        pg8::gemm_phase<pg8::EpiMoe2, pg8::Moe2Sched, true>(lds, g, S, E);
    }
}

__global__ void __launch_bounds__(512, 2) fwd(Args unused_args_read_through_kargs) {
    extern __shared__ __attribute__((aligned(16))) unsigned char lds_raw[];
    LAS unsigned char* lds = (LAS unsigned char*)lds_raw;
    volatile LAS unsigned* MISC = (volatile LAS unsigned*)(lds + MISC_OFF);
    const int tid = threadIdx.x, lane = tid & 63, wid = __builtin_amdgcn_readfirstlane(tid >> 6);
    if (tid < 64) MISC[tid] = 0u;
    __syncthreads();
    int lo, hi; XcdBarrier bar;
    { KArgs a = kargs(); lo = a->ph_lo; hi = a->ph_hi; unsigned* bw = (unsigned*)(a->ws + WS_CTL + CTL_BAR); bar.bar = bw; bar.x = 0; bar.st = nullptr; if (hi - lo > 1) bar = xcd_barrier_post(bw, MISC + 8); }
#define IN(k) (lo <= (k) && (k) < hi)
#define SEAM(k) do { if (IN(k) && IN((k) + 1)) xcd_barrier(bar); } while (0)

    if (PHON(0) && IN(0)) { for (int rp = 0; rp < REPS(0); ++rp) { prologue_phase(kargs(), lds, wid, lane); __syncthreads(); } } SEAM(0);
#pragma nounroll
    for (int layer = 0; layer < 2; ++layer) {
        const int pb = 1 + 7 * layer;
        if (PHON(1) && IN(pb + 0)) { for (int rp = 0; rp < REPS(1); ++rp) { if (layer == 0) { ph_fold(kargs(), lds); __syncthreads(); } ph_inproj(kargs(), layer, lds); __syncthreads(); } } SEAM(pb + 0);
        if (PHON(2) && IN(pb + 1)) { for (int rp = 0; rp < REPS(2); ++rp) { conv_phase(kargs(), layer, lds, tid, wid, lane); __syncthreads(); } } SEAM(pb + 1);
        if (PHON(4) && IN(pb + 3)) { for (int rp = 0; rp < REPS(4); ++rp) { ph_merge(kargs(), layer, lds); __syncthreads(); } } SEAM(pb + 3);
        if (PHON(5) && IN(pb + 4)) { for (int rp = 0; rp < (layer == 0 ? REPS(5) : 1); ++rp) { ph_wo(kargs(), layer, lds); __syncthreads(); } } SEAM(pb + 4);
        if (layer == 0) {
            if (PHON(6) && IN(6)) { for (int rp = 0; rp < REPS(6); ++rp) { ph_ffn1(kargs(), lds); __syncthreads(); } } SEAM(6);
            if (PHON(7) && IN(7)) { ph_ffn2(kargs(), lds); } SEAM(7);
        }
    }
    if (PHON(13) && IN(13)) { for (int rp = 0; rp < REPS(13); ++rp) { route_phase(kargs(), lds, tid, wid, lane); __syncthreads(); } } if (IN(13) && IN(14)) xcd_barrier<true>(bar);
    if (PHON(14) && IN(14)) { for (int rp = 0; rp < REPS(14); ++rp) { scatter_phase(kargs(), lds, tid, wid, lane); __syncthreads(); } } SEAM(14);
    if (PHON(15) && IN(15)) { for (int rp = 0; rp < REPS(15); ++rp) { ph_moe(kargs(), 0, lds); __syncthreads(); } } SEAM(15);
    if (PHON(16) && IN(16)) { for (int rp = 0; rp < REPS(16); ++rp) { ph_moe(kargs(), 1, lds); __syncthreads(); } } SEAM(16);
    if (PHON(17) && IN(17)) { for (int rp = 0; rp < REPS(17); ++rp) { combine_phase(kargs(), lds, tid, wid, lane); __syncthreads(); } }
#undef IN
#undef SEAM
}

extern "C" void kernel_launch(void* const* d_in, const int* in_sizes, int n_in, void* d_out, int out_size, void* d_ws, size_t ws_size, hipStream_t stream) {
    static int grid = 0;
    if (grid == 0) {
        if (n_in != 23 || in_sizes[0] != M * D || out_size != M * D || ws_size < WS_END) { fprintf(stderr, "kernel_launch: unexpected shapes: n_in %d in0 %d out %d ws %zu (need %zu); nothing launched\n", n_in, n_in > 0 ? in_sizes[0] : -1, out_size, ws_size, (size_t)WS_END); grid = -1; return; }
        int dev = 0, cus = 0, per_cu = 0;
        if (hipGetDevice(&dev) != hipSuccess || hipDeviceGetAttribute(&cus, hipDeviceAttributeMultiprocessorCount, dev) != hipSuccess) { fprintf(stderr, "kernel_launch: device query failed\n"); grid = -1; return; }
        if (hipFuncSetAttribute((const void*)fwd, hipFuncAttributeMaxDynamicSharedMemorySize, LDS_BYTES) != hipSuccess) { fprintf(stderr, "kernel_launch: hipFuncSetAttribute failed\n"); grid = -1; return; }
        if (hipOccupancyMaxActiveBlocksPerMultiprocessor(&per_cu, (const void*)fwd, 512, LDS_BYTES) != hipSuccess || per_cu < 1) fprintf(stderr, "kernel_launch: note: occupancy query reports %d workgroups per CU\n", per_cu);
        (void)hipGetLastError();
        grid = cus;
    }
    if (grid < 0) return;
    if (hipMemsetAsync((char*)d_ws + WS_CTL, 0, CTL_BYTES, stream) != hipSuccess) { fprintf(stderr, "kernel_launch: memset failed\n"); return; }
    Args a{};
    for (int i = 0; i < 23; ++i) a.in[i] = (const float*)d_in[i];
    a.out = (float*)d_out; a.ws = (unsigned char*)d_ws;
#if MK_PER_PHASE
    for (int ph = 0; ph < NPH; ++ph) { a.ph_lo = ph; a.ph_hi = ph + 1; hipLaunchKernelGGL(fwd, dim3(grid), dim3(512), LDS_BYTES, stream, a); }
#else
    a.ph_lo = 0; a.ph_hi = NPH; hipLaunchKernelGGL(fwd, dim3(grid), dim3(512), LDS_BYTES, stream, a);
#endif
    const hipError_t le = hipPeekAtLastError();
    if (le != hipSuccess) fprintf(stderr, "kernel_launch: launch failed: %s\n", hipGetErrorName(le));
}
```
